# Optimizing an MI355X kernel written in HIP

```python
import math
import jax
import jax.numpy as jnp
from jax import lax
import numpy as np

D_MODEL = 1024
BATCH = 1
SEQ = 16384
DEPTH = 1

CHUNK = 64
EPS = 1e-6
D_CONV = D_MODEL
CONV_K = 31
SSM_EXPAND = 2
D_INNER = SSM_EXPAND * D_MODEL
SSM_HEADDIM = 64
SSM_HEADS = D_INNER // SSM_HEADDIM
SSM_GROUPS = 4
SSM_HPG = SSM_HEADS // SSM_GROUPS
SSM_STATE = 128
SSM_CONV_K = 4
N_BRANCHES = 2
IN_GLU = 2 * D_CONV
IN_Z = D_INNER
IN_XBC = D_INNER + 2 * SSM_GROUPS * SSM_STATE
IN_DT = SSM_HEADS
IN_GATE = N_BRANCHES * D_MODEL
D_IN_PROJ = IN_GLU + IN_Z + IN_XBC + IN_DT + IN_GATE
MOE_GROUPS = 8
MOE_EXPERTS_PER_GROUP = 8
N_EXPERTS = MOE_GROUPS * MOE_EXPERTS_PER_GROUP
MOE_TOP_K = 2
D_FF_EXPERT = D_MODEL // 2
MOE_BLOCK = 128

kernel_name = 'hybrid_conformer_ssd_hmoe_block'


def _rmsnorm(x, g):
    xf = x.astype(jnp.float32)
    y = xf * lax.rsqrt(jnp.mean(xf * xf, axis=-1, keepdims=True) + EPS)
    return (y * g.astype(jnp.float32)).astype(x.dtype)


def _layernorm(x, g, b):
    xf = x.astype(jnp.float32)
    mu = jnp.mean(xf, axis=-1, keepdims=True)
    var = jnp.mean(jnp.square(xf - mu), axis=-1, keepdims=True)
    y = (xf - mu) * lax.rsqrt(var + EPS)
    return (y * g.astype(jnp.float32) + b.astype(jnp.float32)).astype(x.dtype)


def _causal_dwconv(x, w, b):
    k = w.shape[0]
    xp = jnp.pad(x, ((0, 0), (k - 1, 0), (0, 0)))
    y = lax.conv_general_dilated(xp, w[:, None, :].astype(x.dtype), (1,), 'VALID',
                                 dimension_numbers=('NWC', 'WIO', 'NWC'),
                                 feature_group_count=x.shape[-1])
    return y + b.astype(x.dtype)


def _ssd(xh, dt, a, bm, cm):
    bsz, seq = xh.shape[0], xh.shape[1]
    nc = seq // CHUNK
    x = (xh * dt[..., None]).reshape(bsz, nc, CHUNK, SSM_GROUPS, SSM_HPG, SSM_HEADDIM)
    ad = (dt * a).reshape(bsz, nc, CHUNK, SSM_GROUPS, SSM_HPG)
    bc = bm.reshape(bsz, nc, CHUNK, SSM_GROUPS, SSM_STATE)
    cc = cm.reshape(bsz, nc, CHUNK, SSM_GROUPS, SSM_STATE)
    a_cs = jnp.cumsum(ad, axis=2)
    causal = jnp.tril(jnp.ones((CHUNK, CHUNK), dtype=bool))[:, :, None, None]
    seg = a_cs[:, :, :, None] - a_cs[:, :, None, :]
    lmat = jnp.exp(jnp.where(causal, seg, -jnp.inf))
    cb = jnp.einsum('bclgn,bcsgn->bclsg', cc, bc)
    y_diag = jnp.einsum('bclsgr,bcsgrp->bclgrp', cb[..., None] * lmat, x)
    decay = jnp.exp(a_cs[:, :, -1:] - a_cs)
    states = jnp.einsum('bclgn,bclgrp->bcgrpn', bc, x * decay[..., None])
    chunk_decay = jnp.exp(a_cs[:, :, -1])

    def step(carry, inp):
        st, dec = inp
        return carry * dec[..., None, None] + st, carry

    init = jnp.zeros((bsz, SSM_GROUPS, SSM_HPG, SSM_HEADDIM, SSM_STATE), jnp.float32)
    _, prev = lax.scan(step, init, (jnp.moveaxis(states, 1, 0), jnp.moveaxis(chunk_decay, 1, 0)))
    prev = jnp.moveaxis(prev, 0, 1)
    y_off = jnp.einsum('bclgn,bcgrpn->bclgrp', cc, prev) * jnp.exp(a_cs)[..., None]
    return (y_diag + y_off).reshape(bsz, seq, SSM_HEADS, SSM_HEADDIM)


def _mixer(n, w_in, cv_dw_w, cv_dw_b, cv_ln_g, cv_ln_b, w_cv_out, ssm_conv_w, ssm_conv_b,
           dt_bias, a_log, d_skip, ssm_norm_g, w_ssm_out, w_mix_out):
    bsz, seq, _ = n.shape
    f32 = jnp.float32
    cuts = [IN_GLU, IN_GLU + IN_Z, IN_GLU + IN_Z + IN_XBC, IN_GLU + IN_Z + IN_XBC + IN_DT]
    glu_in, z, xbc, dt_raw, gate_in = jnp.split(n @ w_in, cuts, axis=-1)
    u_a, u_b = jnp.split(glu_in, 2, axis=-1)
    u = u_a * jax.nn.sigmoid(u_b)
    u = jax.nn.silu(_layernorm(_causal_dwconv(u, cv_dw_w, cv_dw_b), cv_ln_g, cv_ln_b))
    y_cv = u @ w_cv_out
    xbc = jax.nn.silu(_causal_dwconv(xbc, ssm_conv_w, ssm_conv_b))
    xs, bm, cm = jnp.split(xbc, [D_INNER, D_INNER + SSM_GROUPS * SSM_STATE], axis=-1)
    dt = jax.nn.softplus(dt_raw.astype(f32) + dt_bias.astype(f32))
    a = -jnp.exp(a_log.astype(f32))
    xh = xs.reshape(bsz, seq, SSM_HEADS, SSM_HEADDIM).astype(f32)
    y = _ssd(xh, dt, a,
             bm.reshape(bsz, seq, SSM_GROUPS, SSM_STATE).astype(f32),
             cm.reshape(bsz, seq, SSM_GROUPS, SSM_STATE).astype(f32))
    y = y + d_skip.astype(f32)[:, None] * xh
    y = y.reshape(bsz, seq, D_INNER).astype(n.dtype) * jax.nn.silu(z)
    gs = D_INNER // SSM_GROUPS
    y = _rmsnorm(y.reshape(bsz, seq, SSM_GROUPS, gs), ssm_norm_g.reshape(SSM_GROUPS, gs))
    y_ssm = y.reshape(bsz, seq, D_INNER) @ w_ssm_out
    g_cv, g_ssm = jnp.split(jax.nn.sigmoid(gate_in), 2, axis=-1)
    return (g_cv * y_cv + g_ssm * y_ssm) @ w_mix_out


def _hier_moe(xt, w_grp, b_grp, w_er, b_er, w1, w3, w2):
    t, d = xt.shape
    f32 = jnp.float32
    gp = jax.nn.softmax((xt @ w_grp + b_grp).astype(f32), axis=-1)
    g_p, g_idx = lax.top_k(gp, 1)
    el = (xt @ w_er + b_er).astype(f32).reshape(t, MOE_GROUPS, MOE_EXPERTS_PER_GROUP)
    idx = jnp.broadcast_to(g_idx[:, :, None], (t, 1, MOE_EXPERTS_PER_GROUP))
    el_sel = jnp.take_along_axis(el, idx, axis=1)[:, 0]
    ep = jax.nn.softmax(el_sel, axis=-1)
    e_p, e_loc = lax.top_k(ep, MOE_TOP_K)
    e_p = e_p / jnp.sum(e_p, axis=-1, keepdims=True)
    weights = g_p * e_p
    e_glob = g_idx * MOE_EXPERTS_PER_GROUP + e_loc
    n_asg = t * MOE_TOP_K
    e_flat = e_glob.reshape(-1)
    tok_flat = jnp.repeat(jnp.arange(t, dtype=jnp.int32), MOE_TOP_K)
    w_flat = weights.reshape(-1)
    order = jnp.argsort(e_flat)
    e_sorted = e_flat[order]
    counts = jnp.bincount(e_flat, length=N_EXPERTS)
    starts = jnp.cumsum(counts) - counts
    pcounts = (counts + MOE_BLOCK - 1) // MOE_BLOCK * MOE_BLOCK
    pends = jnp.cumsum(pcounts)
    pstarts = pends - pcounts
    dest = pstarts[e_sorted] + (jnp.arange(n_asg) - starts[e_sorted])
    n_blocks = -(-n_asg // MOE_BLOCK) + N_EXPERTS
    n_rows = n_blocks * MOE_BLOCK
    buf_tok = jnp.zeros((n_rows,), jnp.int32).at[dest].set(tok_flat[order])
    buf_w = jnp.zeros((n_rows,), xt.dtype).at[dest].set(w_flat[order].astype(xt.dtype))
    blk_e = jnp.minimum(jnp.searchsorted(pends, jnp.arange(n_blocks) * MOE_BLOCK, side='right'),
                        N_EXPERTS - 1)
    xb = xt[buf_tok].reshape(n_blocks, MOE_BLOCK, d)

    def expert_block(args):
        xblk, e = args
        hdn = jax.nn.silu(xblk @ w1[e]) * (xblk @ w3[e])
        return hdn @ w2[e]

    yb = lax.map(expert_block, (xb, blk_e)).reshape(n_rows, d)
    return jnp.zeros_like(xt).at[buf_tok].add(yb * buf_w[:, None])


def setup_inputs(seed: int = 0) -> dict:
    key = jax.random.key(seed)
    ks = jax.random.split(key, 30)
    f = jnp.float32
    L = DEPTH

    def nrm(k, shape, scale):
        return jax.random.normal(k, shape, f) * scale

    dt0 = jnp.exp(jax.random.uniform(ks[14], (L, SSM_HEADS), f, math.log(1e-3), math.log(1e-1)))
    return {
        'x': nrm(ks[0], (BATCH, SEQ, D_MODEL), 1.0),
        'c': nrm(ks[1], (BATCH, D_MODEL), 1.0),
        'w_ada': nrm(ks[2], (L, D_MODEL, 6 * D_MODEL), 0.5 * D_MODEL ** -0.5),
        'b_ada': nrm(ks[3], (L, 6 * D_MODEL), 0.02),
        'norm1_g': 1.0 + nrm(ks[4], (L, D_MODEL), 0.02),
        'w_in': nrm(ks[5], (L, D_MODEL, D_IN_PROJ), D_MODEL ** -0.5),
        'cv_dw_w': nrm(ks[6], (L, CONV_K, D_CONV), CONV_K ** -0.5),
        'cv_dw_b': nrm(ks[7], (L, D_CONV), 0.02),
        'cv_ln_g': 1.0 + nrm(ks[8], (L, D_CONV), 0.02),
        'cv_ln_b': nrm(ks[9], (L, D_CONV), 0.02),
        'w_cv_out': nrm(ks[10], (L, D_CONV, D_MODEL), D_CONV ** -0.5),
        'ssm_conv_w': nrm(ks[11], (L, SSM_CONV_K, IN_XBC), SSM_CONV_K ** -0.5),
        'ssm_conv_b': nrm(ks[12], (L, IN_XBC), 0.02),
        'dt_bias': dt0 + jnp.log(-jnp.expm1(-dt0)),
        'a_log': jnp.log(jax.random.uniform(ks[15], (L, SSM_HEADS), f, 1.0, 16.0)),
        'd_skip': 1.0 + nrm(ks[16], (L, SSM_HEADS), 0.1),
        'ssm_norm_g': 1.0 + nrm(ks[17], (L, D_INNER), 0.02),
        'w_ssm_out': nrm(ks[18], (L, D_INNER, D_MODEL), D_INNER ** -0.5),
        'w_mix_out': nrm(ks[19], (L, D_MODEL, D_MODEL), D_MODEL ** -0.5),
        'norm2_g': 1.0 + nrm(ks[20], (L, D_MODEL), 0.02),
        'w_grp': nrm(ks[21], (L, D_MODEL, MOE_GROUPS), D_MODEL ** -0.5),
        'b_grp': nrm(ks[22], (L, MOE_GROUPS), 0.01),
        'w_er': nrm(ks[23], (L, D_MODEL, N_EXPERTS), D_MODEL ** -0.5),
        'b_er': nrm(ks[24], (L, N_EXPERTS), 0.01),
        'w1': nrm(ks[25], (L, N_EXPERTS, D_MODEL, D_FF_EXPERT), D_MODEL ** -0.5),
        'w3': nrm(ks[26], (L, N_EXPERTS, D_MODEL, D_FF_EXPERT), D_MODEL ** -0.5),
        'w2': nrm(ks[27], (L, N_EXPERTS, D_FF_EXPERT, D_MODEL), D_FF_EXPERT ** -0.5),
        'final_g': 1.0 + nrm(ks[28], (D_MODEL,), 0.02),
    }


def reference(x, c, w_ada, b_ada, norm1_g, w_in, cv_dw_w, cv_dw_b, cv_ln_g, cv_ln_b, w_cv_out,
              ssm_conv_w, ssm_conv_b, dt_bias, a_log, d_skip, ssm_norm_g, w_ssm_out, w_mix_out,
              norm2_g, w_grp, b_grp, w_er, b_er, w1, w3, w2, final_g):
    bsz, seq, d = x.shape
    h = x
    for i in range(DEPTH):
        mod = jax.nn.silu(c) @ w_ada[i] + b_ada[i]
        sh1, sc1, g1, sh2, sc2, g2 = jnp.split(mod[:, None, :], 6, axis=-1)
        n1 = _rmsnorm(h, norm1_g[i]) * (1.0 + sc1) + sh1
        h = h + g1 * _mixer(n1, w_in[i], cv_dw_w[i], cv_dw_b[i], cv_ln_g[i], cv_ln_b[i], w_cv_out[i],
                            ssm_conv_w[i], ssm_conv_b[i], dt_bias[i], a_log[i], d_skip[i],
                            ssm_norm_g[i], w_ssm_out[i], w_mix_out[i])
        n2 = _rmsnorm(h, norm2_g[i]) * (1.0 + sc2) + sh2
        moe = _hier_moe(n2.reshape(bsz * seq, d), w_grp[i], b_grp[i], w_er[i], b_er[i],
                        w1[i], w3[i], w2[i])
        h = h + g2 * moe.reshape(bsz, seq, d)
    return _rmsnorm(h, final_g)
```

```cpp
#include <hip/hip_runtime.h>
#include <hip/hip_cooperative_groups.h>
#include <cstdio>
#include <cstdint>
namespace pg8 {
#define PG8_LAS __attribute__((address_space(3)))
typedef unsigned short bf16_t;
typedef short bf16x8 __attribute__((ext_vector_type(8)));
typedef float f32x4 __attribute__((ext_vector_type(4)));
typedef unsigned u32x4 __attribute__((ext_vector_type(4)));
typedef int v4i_ __attribute__((ext_vector_type(4)));
typedef int v8i_ __attribute__((ext_vector_type(8)));
constexpr int BM = 256, BK = 64, HALF = 128, HTB = HALF * BK * 2  , STAGE_BYTES = 8 * HTB, NXCD = 8, WGM = 8;

__host__ __device__ __forceinline__ int lds_byte(int r, int c) { const int st = (r >> 4) * 2 + (c >> 5), rr = r & 15, cc = c & 31, ob = rr * 64 + cc * 2; return st * 1024 + (ob ^ (((ob >> 9) & 1) << 5)); }
__host__ __device__ __forceinline__ void stage_rc(int b, int& R, int& C) { const int st = b / 1024, sb = b % 1024, swz = sb ^ (((sb >> 9) & 1) << 5); R = (st >> 1) * 16 + swz / 64; C = (st & 1) * 32 + (swz % 64) / 2; }
__host__ __device__ __forceinline__ int perm32(int rho) { const int n = rho >> 4, i = rho & 15; return 8 * (i >> 2) + 4 * n + (i & 3); }

struct Unit { int pm, pn; };
struct Gemm { const bf16_t* A; const bf16_t* Bt; int M, N, K; };

struct StaticOrder {
    int nM, nN, nwg, G, c;
    __host__ __device__ void init(int M, int N, int G_, int c_) { nM = M / BM; nN = N / BM; nwg = nM * nN; G = G_; c = c_; }
    __host__ __device__ bool next(int i, Unit& u) const {
        const long L = (long)i * G + c; if (L >= nwg) return false;
        int wgid = (int)L; { const int q = nwg / NXCD, r = nwg % NXCD, xcd = wgid % NXCD, off = wgid / NXCD; wgid = (xcd < r ? xcd * (q + 1) : r * (q + 1) + (xcd - r) * q) + off; }
        const int nig = WGM * nN, gid = wgid / nig, fm = gid * WGM, gsz = (nM - fm) < WGM ? (nM - fm) : WGM;
        u.pm = fm + ((wgid % nig) % gsz); u.pn = (wgid % nig) / gsz; return true;
    }
    __device__ __forceinline__ void a_ready(const Unit&) const {}
    __device__ __forceinline__ void done(const Unit&) const {}
};

__device__ __forceinline__ unsigned cvt_pk_bf16(float lo, float hi) { unsigned r; asm volatile("v_cvt_pk_bf16_f32 %0, %1, %2" : "=v"(r) : "v"(lo), "v"(hi)); return r; }
typedef float f32x2 __attribute__((ext_vector_type(2)));
template <class Epi, class Sched, bool ALIGN_EPI = false, bool SP2 = false, bool FP8 = false, bool GATHER = false>
__device__ __forceinline__ void gemm_phase(PG8_LAS unsigned char* lds, const Gemm g, const Sched& S, const Epi& E, const int wave_in) {
    const int lane = (int)__builtin_amdgcn_mbcnt_hi(~0u, __builtin_amdgcn_mbcnt_lo(~0u, 0u)), wid = wave_in, tid = wid * 64 + lane, wr = wid >> 2, wc = wid & 3, fr = lane & 15, fq = lane >> 4;
    const int K = g.K, nt = K / BK;
    unsigned voffA[2], voffB[2];
#pragma unroll
    for (int i = 0; i < 2; ++i) { int R, C; stage_rc(tid * 16 + i * 8192, R, C); const int Rb = Epi::PERM ? ((R & ~31) + perm32(R & 31)) : R;
        voffA[i] = (unsigned)(R * K + C) * 2u; voffB[i] = (unsigned)(Rb * K + C) * 2u; }
    static_assert(!GATHER || SP2, "GATHER is implemented in the SP2 loop");
    unsigned gA[2][2], ngA[2][2]; int RA[2]; unsigned CA2[2];
#pragma unroll
    for (int i = 0; i < 2; ++i) { int R, C; stage_rc(tid * 16 + i * 8192, R, C); RA[i] = R; CA2[i] = (unsigned)C * 2u; }
    auto load_g = [&](int ui_, unsigned (&dst)[2][2]) {
        if constexpr (GATHER) {
#pragma unroll
            for (int h = 0; h < 2; ++h)
#pragma unroll
                for (int i = 0; i < 2; ++i) dst[h][i] = (unsigned)S.tokl[ui_ * 256 + 128 * h + RA[i]] * (unsigned)(K * 2) + CA2[i];
        }
    };
    const size_t kstep = (size_t)(BK * 2);
    const size_t hstep = (size_t)HALF * K * 2;
    const size_t tstep = 2 * hstep;
    const size_t hstepA = GATHER ? (size_t)0 : hstep, tstepA = GATHER ? (size_t)0 : 2 * hstep;
    const unsigned ldsw = (unsigned)wid * 1024u;
    const int aoff = lds_byte(wr * 64 + fr, fq * 8), boff = lds_byte(wc * 32 + fr, fq * 8);
#define PG8_SA(b, h) (((b) * 2 + (h)) * HTB)
#define PG8_SB(b, h) ((4 + (b) * 2 + (h)) * HTB)
#define PG8_STAGE(bufoff, gbase, voff) do { _Pragma("unroll") for (int _i = 0; _i < 2; ++_i) \
        __builtin_amdgcn_global_load_lds((const unsigned*)((const char*)(gbase) + (voff)[_i]), (PG8_LAS unsigned*)(lds + (bufoff) + ldsw + _i * 8192), 16, 0, 0); } while (0)
#define PG8_STAGE_A(bufoff, gbase, gvoff) do { if constexpr (GATHER) { PG8_STAGE(bufoff, gbase, gvoff); } else { PG8_STAGE(bufoff, gbase, voffA); } } while (0)
#define PG8_LDA(dst, b, h) do { if constexpr (FP8) { _Pragma("unroll") for (int m = 0; m < 4; ++m) dst##8[m] = __builtin_shufflevector(*(const PG8_LAS v4i_*)(lds + PG8_SA(b, h) + aoff + m * 2048), *(const PG8_LAS v4i_*)(lds + PG8_SA(b, h) + aoff + m * 2048 + 1024), 0, 1, 2, 3, 4, 5, 6, 7); } \
        else { _Pragma("unroll") for (int m = 0; m < 4; ++m) _Pragma("unroll") for (int k = 0; k < 2; ++k) dst[m][k] = *(const PG8_LAS bf16x8*)(lds + PG8_SA(b, h) + aoff + m * 2048 + k * 1024); } } while (0)
#define PG8_LDB(dst, b, h) do { if constexpr (FP8) { _Pragma("unroll") for (int n = 0; n < 2; ++n) dst##8[n] = __builtin_shufflevector(*(const PG8_LAS v4i_*)(lds + PG8_SB(b, h) + boff + n * 2048), *(const PG8_LAS v4i_*)(lds + PG8_SB(b, h) + boff + n * 2048 + 1024), 0, 1, 2, 3, 4, 5, 6, 7); } \
        else { _Pragma("unroll") for (int n = 0; n < 2; ++n) _Pragma("unroll") for (int k = 0; k < 2; ++k) dst[n][k] = *(const PG8_LAS bf16x8*)(lds + PG8_SB(b, h) + boff + n * 2048 + k * 1024); } } while (0)
#define PG8_MMA(ai, bj, At, Bt) do { __builtin_amdgcn_s_setprio(1); \
        if constexpr (FP8) {   \
              \
            _Pragma("unroll") for (int m = 0; m < 4; ++m) _Pragma("unroll") for (int n = 0; n < 2; ++n) \
                asm volatile("v_mfma_scale_f32_16x16x128_f8f6f4 %0, %1, %2, %0, %3, %4 op_sel_hi:[0,0,0]" : "+v"(acc[ai][bj][m][n]) : "v"(Bt##8[n]), "v"(At##8[m]), "v"(scale_w), "v"(scale_x)); \
        } else { \
        _Pragma("unroll") for (int m = 0; m < 4; ++m) _Pragma("unroll") for (int n = 0; n < 2; ++n) _Pragma("unroll") for (int k = 0; k < 2; ++k) \
        acc[ai][bj][m][n] = __builtin_amdgcn_mfma_f32_16x16x32_bf16(Bt[n][k], At[m][k], acc[ai][bj][m][n], 0, 0, 0); } __builtin_amdgcn_s_setprio(0); } while (0)
#define PG8_WAIT_V(n) asm volatile("s_waitcnt vmcnt(" #n ")" ::: "memory")
#define PG8_WAIT_L(n) asm volatile("s_waitcnt lgkmcnt(" #n ")" ::: "memory")
#define PG8_BAR __builtin_amdgcn_s_barrier()
#define PG8_SCHED __builtin_amdgcn_sched_barrier(0)
    Unit cur, nxt; int ui = 0;
    if (!S.next(0, cur)) return;
    f32x4 acc[2][2][4][2];
#pragma unroll
    for (int a = 0; a < 2; ++a)
#pragma unroll
        for (int b = 0; b < 2; ++b)
#pragma unroll
            for (int m = 0; m < 4; ++m)
#pragma unroll
                for (int n = 0; n < 2; ++n) acc[a][b][m][n] = (f32x4){0.f, 0.f, 0.f, 0.f};
    const int scale_w = 0x79797979, scale_x = 0x7f7f7f7f;
    bf16x8 At[4][2], B0[2][2], B1[2][2]; v8i_ At8[4], B08[2], B18[2];
    const char* cA = (const char*)g.A + (size_t)cur.pm * tstepA; const char* cB = (const char*)g.Bt + (size_t)cur.pn * tstep;
    load_g(0, gA);
    S.a_ready(cur);
    if constexpr (SP2) {
        PG8_STAGE(PG8_SB(0, 0), cB, voffB); PG8_STAGE(PG8_SB(0, 1), cB + hstep, voffB); PG8_STAGE_A(PG8_SA(0, 0), cA, gA[0]); PG8_STAGE_A(PG8_SA(0, 1), cA + hstepA, gA[1]);
        if (wr == 1) PG8_BAR;
        PG8_WAIT_V(2); PG8_BAR;
        PG8_STAGE(PG8_SB(1, 0), cB + kstep, voffB); PG8_STAGE_A(PG8_SA(1, 0), cA + kstep, gA[0]); PG8_STAGE(PG8_SB(1, 1), cB + hstep + kstep, voffB);
        PG8_WAIT_V(6); PG8_BAR;
    } else {
        PG8_STAGE(PG8_SB(0, 0), cB, voffB); PG8_STAGE(PG8_SA(0, 0), cA, voffA); PG8_STAGE(PG8_SB(0, 1), cB + hstep, voffB); PG8_STAGE(PG8_SA(0, 1), cA + hstep, voffA);
        if (wr == 1) PG8_BAR;
        PG8_WAIT_V(4); PG8_BAR;
        PG8_STAGE(PG8_SB(1, 0), cB + kstep, voffB); PG8_STAGE(PG8_SA(1, 0), cA + kstep, voffA); PG8_STAGE(PG8_SB(1, 1), cB + hstep + kstep, voffB);
        PG8_WAIT_V(6); PG8_BAR;
    }
    for (;;) {
        const bool has_next = S.next(ui + 1, nxt);
        const char* nA = has_next ? (const char*)g.A + (size_t)nxt.pm * tstepA : cA; const char* nB = has_next ? (const char*)g.Bt + (size_t)nxt.pn * tstep : cB;
        if constexpr (GATHER) { if (has_next) load_g(ui + 1, ngA); else {
#pragma unroll
            for (int h = 0; h < 2; ++h)
#pragma unroll
                for (int i = 0; i < 2; ++i) ngA[h][i] = gA[h][i]; } }
        for (int t = 0; t < nt; t += 2) {
            const bool last = (t == nt - 2);
            const char* a1 = cA + (size_t)(t + 1) * kstep;
            const char* a2 = last ? nA : cA + (size_t)(t + 2) * kstep; const char* b2 = last ? nB : cB + (size_t)(t + 2) * kstep;
            const char* a3 = a2 + kstep; const char* b3 = b2 + kstep;
            if (last && has_next) S.a_ready(nxt);
            unsigned sN[2][2];
#pragma unroll
            for (int h = 0; h < 2; ++h)
#pragma unroll
                for (int i = 0; i < 2; ++i) sN[h][i] = last ? ngA[h][i] : gA[h][i];
            if constexpr (SP2) {
            PG8_LDB(B0, 0, 0); PG8_LDB(B1, 0, 1); PG8_SCHED; PG8_LDA(At, 0, 0); PG8_STAGE_A(PG8_SA(1, 1), a1 + hstepA, gA[1]);
            PG8_WAIT_V(8); PG8_WAIT_L(0); PG8_BAR; PG8_MMA(0, 0, At, B0); PG8_MMA(0, 1, At, B1); PG8_BAR; PG8_SCHED;
            PG8_LDA(At, 0, 1); PG8_STAGE(PG8_SB(0, 0), b2, voffB); PG8_STAGE(PG8_SB(0, 1), b2 + hstep, voffB); PG8_STAGE_A(PG8_SA(0, 0), a2, sN[0]);
            PG8_WAIT_V(8); PG8_WAIT_L(0); PG8_BAR; PG8_MMA(1, 0, At, B0); PG8_MMA(1, 1, At, B1); PG8_BAR; PG8_SCHED;
            PG8_LDB(B0, 1, 0); PG8_LDB(B1, 1, 1); PG8_SCHED; PG8_LDA(At, 1, 0); PG8_STAGE_A(PG8_SA(0, 1), a2 + hstepA, sN[1]);
            PG8_WAIT_V(8); PG8_WAIT_L(0); PG8_BAR; PG8_MMA(0, 0, At, B0); PG8_MMA(0, 1, At, B1); PG8_BAR; PG8_SCHED;
            PG8_LDA(At, 1, 1); PG8_STAGE(PG8_SB(1, 0), b3, voffB); PG8_STAGE(PG8_SB(1, 1), b3 + hstep, voffB); PG8_STAGE_A(PG8_SA(1, 0), a3, sN[0]);
            PG8_WAIT_V(8); PG8_WAIT_L(0); PG8_BAR; PG8_MMA(1, 0, At, B0); PG8_MMA(1, 1, At, B1); PG8_BAR; PG8_SCHED;
            } else {
            PG8_LDB(B0, 0, 0); PG8_SCHED; PG8_LDA(At, 0, 0); PG8_STAGE(PG8_SA(1, 1), a1 + hstep, voffA);
            PG8_WAIT_L(8); PG8_BAR; PG8_WAIT_L(0); PG8_MMA(0, 0, At, B0); PG8_BAR; PG8_SCHED;
            PG8_LDB(B1, 0, 1); PG8_STAGE(PG8_SB(0, 0), b2, voffB);
            PG8_BAR; PG8_WAIT_L(0); PG8_MMA(0, 1, At, B1); PG8_BAR;
            PG8_LDA(At, 0, 1); PG8_STAGE(PG8_SA(0, 0), a2, voffA);
            PG8_BAR; PG8_WAIT_L(0); PG8_MMA(1, 0, At, B0); PG8_BAR; PG8_SCHED;
            PG8_STAGE(PG8_SB(0, 1), b2 + hstep, voffB);
            PG8_WAIT_V(6); PG8_BAR; PG8_MMA(1, 1, At, B1); PG8_BAR;
            PG8_LDB(B0, 1, 0); PG8_SCHED; PG8_LDA(At, 1, 0); PG8_STAGE(PG8_SA(0, 1), a2 + hstep, voffA);
            PG8_WAIT_L(8); PG8_BAR; PG8_WAIT_L(0); PG8_MMA(0, 0, At, B0); PG8_BAR; PG8_SCHED;
            PG8_LDB(B1, 1, 1); PG8_STAGE(PG8_SB(1, 0), b3, voffB);
            PG8_BAR; PG8_WAIT_L(0); PG8_MMA(0, 1, At, B1); PG8_BAR;
            PG8_LDA(At, 1, 1); PG8_STAGE(PG8_SA(1, 0), a3, voffA);
            PG8_BAR; PG8_WAIT_L(0); PG8_MMA(1, 0, At, B0); PG8_BAR; PG8_SCHED;
            PG8_STAGE(PG8_SB(1, 1), b3 + hstep, voffB);
            PG8_WAIT_V(6); PG8_BAR; PG8_MMA(1, 1, At, B1); PG8_BAR;
            }
            if constexpr (Epi::KHOOK) { if ((((t + 2) & 7) == 0) && (t + 2 < nt)) E.khook(acc, ((t + 2) >> 3) - 1, wr, fr); }
        }
        if constexpr (ALIGN_EPI) { if (wr == 0) PG8_BAR; }
        if constexpr (FP8) {
            asm volatile("s_nop 15\n\ts_nop 15" : "+v"(acc[0][0][0][0]), "+v"(acc[0][0][0][1]), "+v"(acc[0][0][1][0]), "+v"(acc[0][0][1][1]), "+v"(acc[0][0][2][0]), "+v"(acc[0][0][2][1]), "+v"(acc[0][0][3][0]), "+v"(acc[0][0][3][1]), "+v"(acc[0][1][0][0]), "+v"(acc[0][1][0][1]), "+v"(acc[0][1][1][0]), "+v"(acc[0][1][1][1]), "+v"(acc[0][1][2][0]), "+v"(acc[0][1][2][1]), "+v"(acc[0][1][3][0]), "+v"(acc[0][1][3][1]));
            asm volatile("s_nop 0" : "+v"(acc[1][0][0][0]), "+v"(acc[1][0][0][1]), "+v"(acc[1][0][1][0]), "+v"(acc[1][0][1][1]), "+v"(acc[1][0][2][0]), "+v"(acc[1][0][2][1]), "+v"(acc[1][0][3][0]), "+v"(acc[1][0][3][1]), "+v"(acc[1][1][0][0]), "+v"(acc[1][1][0][1]), "+v"(acc[1][1][1][0]), "+v"(acc[1][1][1][1]), "+v"(acc[1][1][2][0]), "+v"(acc[1][1][2][1]), "+v"(acc[1][1][3][0]), "+v"(acc[1][1][3][1]));
        }
        if constexpr (!Epi::AFTER_DRAIN) { E(acc, cur, wr, wc, fr, fq); S.done(cur); }
        if (!has_next) break;
#pragma unroll
        for (int a = 0; a < 2; ++a)
#pragma unroll
            for (int b = 0; b < 2; ++b)
#pragma unroll
                for (int m = 0; m < 4; ++m)
#pragma unroll
                    for (int n = 0; n < 2; ++n) acc[a][b][m][n] = (f32x4){0.f, 0.f, 0.f, 0.f};
        cur = nxt; cA = nA; cB = nB; ++ui;
        if constexpr (GATHER) {
#pragma unroll
            for (int h = 0; h < 2; ++h)
#pragma unroll
                for (int i = 0; i < 2; ++i) gA[h][i] = ngA[h][i]; }
        if constexpr (ALIGN_EPI) { if (wr == 1) PG8_BAR; }
    }
    PG8_WAIT_V(0);
    if constexpr (!ALIGN_EPI) { if (wr == 0) PG8_BAR; }
    PG8_BAR;
    if constexpr (Epi::AFTER_DRAIN) { E.fused(acc, cur, wr, wc, fr, fq, lds, wid, lane); S.done(cur); }
#undef PG8_SA
#undef PG8_SB
#undef PG8_STAGE
#undef PG8_STAGE_A
#undef PG8_LDA
#undef PG8_LDB
#undef PG8_MMA
#undef PG8_WAIT_V
#undef PG8_WAIT_L
#undef PG8_BAR
#undef PG8_SCHED
}
}

#define DI __device__ __forceinline__
#define GAS __attribute__((address_space(1)))
#define LAS __attribute__((address_space(3)))
typedef unsigned short bf16;
typedef unsigned v4u __attribute__((ext_vector_type(4)));
typedef unsigned v2u __attribute__((ext_vector_type(2)));
typedef float f32x4 __attribute__((ext_vector_type(4)));
typedef float f32x16 __attribute__((ext_vector_type(16)));
typedef short bf16x8 __attribute__((ext_vector_type(8)));
typedef __bf16 bf2v __attribute__((ext_vector_type(2)));
typedef float f2v __attribute__((ext_vector_type(2)));
typedef GAS unsigned gu32;

constexpr int NWAVES = 8, NTHREADS = 512;
constexpr int M = 16384, D = 1024, DIN = 2048, NH = 32, HD = 64, NGRP = 4, NST = 128, XBCW = 3072;
constexpr int NPROJ = 9216, WIN_LD = 9248;
constexpr int LCH = 128, NCH = M / LCH;
constexpr int NE = 64, DFF = 512;
constexpr float EPS = 1e-6f;
constexpr float LOG2E = 1.4426950408889634f;

constexpr size_t MiB = 1u << 20;
constexpr size_t WS_CTL = 0, CTL_ZERO_BYTES = 65536;
constexpr size_t WS_WIN = 1 * MiB, WS_WDT = 19 * MiB, WS_WCV = 20 * MiB, WS_WMIX = 22 * MiB, WS_WSSM = 24 * MiB;
constexpr size_t WS_RSTD = 31 * MiB + 524288;
constexpr size_t WS_DT = 28 * MiB, WS_CD = 30 * MiB, WS_WRH = 30 * MiB + 65536, WS_WRL = WS_WRH + 262144, WS_ROUTE = 31 * MiB;
constexpr size_t WS_ST = 32 * MiB, WS_YS = 96 * MiB, WS_TMP = 160 * MiB, WS_MG = 192 * MiB;
constexpr size_t WS_W13 = 32 * MiB, WS_W2 = 160 * MiB, WS_H16 = 96 * MiB;
constexpr size_t WS_XN = 224 * MiB;
constexpr size_t WS_U = 256 * MiB, WS_ZS = 288 * MiB, WS_XBC = 352 * MiB, WS_GATE = 448 * MiB;
constexpr size_t WS_LIST = 256 * MiB, WS_HDN = 352 * MiB, WS_YEXP = 400 * MiB;
constexpr size_t WS_END = 512 * MiB;
constexpr int CW_BAR = 4096;
constexpr int CW_CNT = 8192;
constexpr int CW_MODC = 40960;
constexpr int CW_MOD = 16384;

constexpr int RING_BYTES = 131072;
constexpr int LDSCTL_OFF = 147456;
constexpr int TB_OFF = LDSCTL_OFF + 256;
constexpr int CNTL_OFF = TB_OFF + 320;
constexpr int TOKL_OFF = LDSCTL_OFF + 1024;
constexpr int RT_OFF = 148480;
constexpr int LDS_BYTES = 152576;

#define LDS_WAIT() asm volatile("s_waitcnt lgkmcnt(0)" ::: "memory")
#define VM_WAIT() asm volatile("s_waitcnt vmcnt(0)" ::: "memory")

DI unsigned pk2(float lo, float hi) { f2v v = {lo, hi}; return __builtin_bit_cast(unsigned, __builtin_convertvector(v, bf2v)); }
DI unsigned pk4_fp8(float a, float b, float c, float d) {
    a = __builtin_fminf(__builtin_fmaxf(a, -448.f), 448.f); b = __builtin_fminf(__builtin_fmaxf(b, -448.f), 448.f);
    c = __builtin_fminf(__builtin_fmaxf(c, -448.f), 448.f); d = __builtin_fminf(__builtin_fmaxf(d, -448.f), 448.f);
    unsigned w = 0u; w = __builtin_amdgcn_cvt_pk_fp8_f32(a, b, w, false); w = __builtin_amdgcn_cvt_pk_fp8_f32(c, d, w, true); return w; }
DI unsigned pk4_fp8_nc(float a, float b, float c, float d) { unsigned w = 0u; w = __builtin_amdgcn_cvt_pk_fp8_f32(a, b, w, false); w = __builtin_amdgcn_cvt_pk_fp8_f32(c, d, w, true); return w; }
DI float bflo(unsigned u) { return __uint_as_float(u << 16); }
DI float bfhi(unsigned u) { return __uint_as_float(u & 0xffff0000u); }
DI float sigmoidf_(float x) { return __builtin_amdgcn_rcpf(1.f + __builtin_amdgcn_exp2f(x * -LOG2E)); }
DI float siluf_(float x) { return x * __builtin_amdgcn_rcpf(1.f + __builtin_amdgcn_exp2f(x * -LOG2E)); }
DI float wave_sum(float v) {
#pragma unroll
    for (int o = 1; o < 64; o <<= 1) v += __shfl_xor(v, o);
    return v;
}
DI f32x4 mod4(const float* modp, int k) { return (*(const f32x4*)(modp + k) + *(const f32x4*)(modp + 6144 + k)) + (*(const f32x4*)(modp + 2 * 6144 + k) + *(const f32x4*)(modp + 3 * 6144 + k)); }
DI int crow(int reg, int hh) { return (reg & 3) + 8 * (reg >> 2) + 4 * hh; }
DI int swz(int row, int chunk) { return chunk ^ ((row ^ (row >> 3)) & 15); }
#define MFMA32(a, b, c) __builtin_amdgcn_mfma_f32_32x32x16_bf16((a), (b), (c), 0, 0, 0)

DI int lane_id() { return (int)__builtin_amdgcn_mbcnt_hi(~0u, __builtin_amdgcn_mbcnt_lo(~0u, 0u)); }
#define XB_TMO      128
#define XB_XCNT(j)  (256  + 64 * (j))
#define XB_XSUB(j)  (1280 + 64 * (j))
#define XB_XGEN(j)  (2304 + 64 * (j))
#define XB_TOP      3328
#define XB_TOPGEN   3392
#define XCD_BAR_WORDS 3456
#define XB_SPIN_CAP (1u << 18)
DI unsigned xb_ld(unsigned* p)              { return __hip_atomic_load(p, __ATOMIC_RELAXED, __HIP_MEMORY_SCOPE_AGENT); }
DI unsigned xb_add(unsigned* p, unsigned v) { return __hip_atomic_fetch_add(p, v, __ATOMIC_RELAXED, __HIP_MEMORY_SCOPE_AGENT); }
DI unsigned xb_xcc_id() { return (unsigned)__builtin_amdgcn_s_getreg((3 << 11) | 20) & 0xFu; }
#define XB_SPIN(cond, bar) do { unsigned _sp = 0; while (cond) { __builtin_amdgcn_s_sleep(1); \
    if ((++_sp & 255u) == 0u) { if (xb_ld(&(bar)[XB_TMO])) break; if (_sp > XB_SPIN_CAP) { atomicAdd(&(bar)[XB_TMO], 1u); break; } } } } while (0)
struct XcdBarrier { unsigned* bar; unsigned x; volatile LAS unsigned* st; int wave; };
DI XcdBarrier xcd_barrier_post(unsigned* bar, volatile LAS unsigned* st) {
    XcdBarrier b; b.bar = bar; b.x = xb_xcc_id(); b.st = st; b.wave = 0;
    if (threadIdx.x == 0) (void)xb_add(&bar[XB_XCNT(b.x)], 1u);
    return b;
}
DI void xcd_barrier_complete(unsigned* bar, unsigned x, unsigned& nloc, unsigned& nx) {
    const unsigned G = gridDim.x * gridDim.y * gridDim.z;
    unsigned sum, cnt, mine, sp = 0u;
    for (;;) {
        sum = 0u; cnt = 0u; mine = 0u;
#pragma unroll
        for (unsigned j = 0; j < 16; ++j) { const unsigned c = xb_ld(&bar[XB_XCNT(j)]); sum += c; cnt += (c > 0u) ? 1u : 0u; mine = (j == x) ? c : mine; }
        if (sum == G) break;
        __builtin_amdgcn_s_sleep(1);
        if ((++sp & 255u) == 0u) { if (xb_ld(&bar[XB_TMO])) break; if (sp > XB_SPIN_CAP) { atomicAdd(&bar[XB_TMO], 1u); break; } }
    }
    nloc = mine > 0u ? mine : 1u; nx = cnt > 0u ? cnt : 1u;
}
DI void xcd_barrier(const XcdBarrier& b) {
    asm volatile("s_waitcnt vmcnt(0)" ::: "memory");
    __syncthreads();
    if (b.wave == 0 && lane_id() == 0) {
        unsigned* bar = b.bar;
        __builtin_amdgcn_s_waitcnt(0);
        unsigned nloc = b.st[0], nx = b.st[1];
        if (nloc == 0u) { xcd_barrier_complete(bar, b.x, nloc, nx); b.st[0] = nloc; b.st[1] = nx; }
        const unsigned old = xb_add(&bar[XB_XSUB(b.x)], 1u);
        const unsigned gen = old / nloc;
        if (old + 1u == (gen + 1u) * nloc) {
            __builtin_amdgcn_fence(__ATOMIC_RELEASE, "agent");
            asm volatile("s_waitcnt vmcnt(0)" ::: "memory");
            const unsigned og = xb_add(&bar[XB_TOP], 1u);
            const unsigned tg = og / nx;
            if (og + 1u == (tg + 1u) * nx) xb_add(&bar[XB_TOPGEN], 1u);
            else XB_SPIN(xb_ld(&bar[XB_TOPGEN]) == tg, bar);
            __builtin_amdgcn_fence(__ATOMIC_ACQUIRE, "agent");
            xb_add(&bar[XB_XGEN(b.x)], 1u);
            asm volatile("s_waitcnt vmcnt(0)" ::: "memory");
        } else {
            XB_SPIN(xb_ld(&bar[XB_XGEN(b.x)]) == gen, bar);
            __builtin_amdgcn_fence(__ATOMIC_ACQUIRE, "agent");
            asm volatile("s_waitcnt vmcnt(0)" ::: "memory");
        }
    }
    __syncthreads();
}

enum { I_X = 0, I_C, I_WADA, I_BADA, I_N1G, I_WIN, I_CVW, I_CVB, I_LNG, I_LNB, I_WCV, I_SCW, I_SCB, I_DTB, I_ALOG, I_DSKIP, I_SNG, I_WSSM, I_WMIX,
       I_N2G, I_WGRP, I_BGRP, I_WER, I_BER, I_W1, I_W3, I_W2, I_FG, N_IN };
struct Args { const float* in[N_IN]; float* out; unsigned char* ws; int ph_lo, ph_hi; };

template <int I> DI const float* argp() {
    auto kp = __builtin_amdgcn_kernarg_segment_ptr();
    unsigned long long v;
    asm volatile("s_load_dwordx2 %0, %1, %2\n\ts_waitcnt lgkmcnt(0)" : "=s"(v) : "s"(kp), "i"(I * 8));
    return (const float*)(const GAS float*)v;
}
#define ARG(i) argp<i>()
struct Ctx {
    LAS unsigned char* lds;
    int wave, vcu, G, xcd, xj;
    unsigned char* ws;
};

DI int xcd_unit(int x, int j, int gx, int i, int N) { const int u = i * gx + j; return (u < (N >> 3)) ? x * (N >> 3) + u : -1; }
DI int inproj_tile(int p) { return p < 8 ? p + 8 : (p < 16 ? p + 20 : (p < 24 ? p - 16 : p - 8)); }
struct EpiInProj {
    static constexpr bool PERM = true, AFTER_DRAIN = false, KHOOK = false;
    unsigned char* ws;
    DI void operator()(const pg8::f32x4 (&acc)[2][2][4][2], const pg8::Unit& u, int wr, int wc, int fr, int fq) const {
        const int pn = inproj_tile(u.pn), row0 = u.pm * 256 + wr * 64 + fr;
        if (pn < 8) {
            bf16* U = (bf16*)(ws + WS_U);
#pragma unroll
            for (int ai = 0; ai < 2; ++ai)
#pragma unroll
                for (int m = 0; m < 4; ++m) {
                    bf16* rowp = U + (size_t)(row0 + ai * 128 + m * 16) * D + pn * 128 + wc * 16 + fq * 4;
#pragma unroll
                    for (int bj = 0; bj < 2; ++bj) { const pg8::f32x4 a = acc[ai][bj][m][0], b = acc[ai][bj][m][1];
                        v2u w; w.x = pk2(a[0] * sigmoidf_(b[0]), a[1] * sigmoidf_(b[1])); w.y = pk2(a[2] * sigmoidf_(b[2]), a[3] * sigmoidf_(b[3]));
                        *(v2u*)(rowp + bj * 64) = w; } }
        } else {
            const bool isz = pn < 16, isx = (pn >= 16) && (pn < 28);
            const size_t boff = isz ? WS_ZS : (isx ? WS_XBC : WS_GATE);
            const int ldc = isx ? XBCW : DIN;
            const int colt = (pn - (isz ? 8 : (isx ? 16 : 28))) * 256;
            bf16* base = (bf16*)(ws + boff);
            const int col0 = colt + wc * 32 + fq * 8;
#pragma unroll
            for (int ai = 0; ai < 2; ++ai)
#pragma unroll
                for (int m = 0; m < 4; ++m) {
                    bf16* rowp = base + (size_t)(row0 + ai * 128 + m * 16) * ldc + col0;
#pragma unroll
                    for (int bj = 0; bj < 2; ++bj) { pg8::f32x4 v0 = acc[ai][bj][m][0], v1 = acc[ai][bj][m][1];
                        if (!isx) {
#pragma unroll
                            for (int i = 0; i < 4; ++i) { const float s0 = sigmoidf_(v0[i]), s1 = sigmoidf_(v1[i]); v0[i] = isz ? v0[i] * s0 : s0; v1[i] = isz ? v1[i] * s1 : s1; }
                        }
                        v4u w; w.x = pk2(v0[0], v0[1]); w.y = pk2(v0[2], v0[3]); w.z = pk2(v1[0], v1[1]); w.w = pk2(v1[2], v1[3]);
                        *(v4u*)(rowp + bj * 128) = w; } }
        }
    }
};
template <bool NORM> struct EpiGate {
    static constexpr bool PERM = true, AFTER_DRAIN = false, KHOOK = NORM;
    bf16* O; const bf16* P; const bf16* GATE; int gcol; const LAS float* rt;
    DI void khook(pg8::f32x4 (&acc)[2][2][4][2], int b, int wr, int fr) const {
#pragma unroll
        for (int ai = 0; ai < 2; ++ai)
#pragma unroll
            for (int m = 0; m < 4; ++m) { const float f = rt[(ai * 128 + wr * 64 + m * 16 + fr) * 4 + b];
#pragma unroll
                for (int bj = 0; bj < 2; ++bj)
#pragma unroll
                    for (int n = 0; n < 2; ++n) acc[ai][bj][m][n] = acc[ai][bj][m][n] * f; }
    }
    DI void operator()(const pg8::f32x4 (&acc)[2][2][4][2], const pg8::Unit& u, int wr, int wc, int fr, int fq) const {
        const int row0 = u.pm * 256 + wr * 64 + fr, col0 = u.pn * 256 + wc * 32 + fq * 8;
#pragma unroll
        for (int ai = 0; ai < 2; ++ai)
#pragma unroll
            for (int m = 0; m < 4; ++m) { const size_t r = (size_t)(row0 + ai * 128 + m * 16);
                float f = 1.0f; if (NORM) f = rt[(ai * 128 + wr * 64 + m * 16 + fr) * 4 + 3];
#pragma unroll
                for (int bj = 0; bj < 2; ++bj) { const int c = col0 + bj * 128;
                    const v4u g = *(const v4u*)(GATE + r * (2 * D) + gcol + c);
                    pg8::f32x4 v0 = acc[ai][bj][m][0] * f, v1 = acc[ai][bj][m][1] * f;
                    float o[8] = {v0[0] * bflo(g.x), v0[1] * bfhi(g.x), v0[2] * bflo(g.y), v0[3] * bfhi(g.y), v1[0] * bflo(g.z), v1[1] * bfhi(g.z), v1[2] * bflo(g.w), v1[3] * bfhi(g.w)};
                    if (P) { const v4u p = *(const v4u*)(P + r * D + c);
                        o[0] += bflo(p.x); o[1] += bfhi(p.x); o[2] += bflo(p.y); o[3] += bfhi(p.y); o[4] += bflo(p.z); o[5] += bfhi(p.z); o[6] += bflo(p.w); o[7] += bfhi(p.w); }
                    v4u w; w.x = pk2(o[0], o[1]); w.y = pk2(o[2], o[3]); w.z = pk2(o[4], o[5]); w.w = pk2(o[6], o[7]);
                    *(v4u*)(O + r * D + c) = w; } }
    }
};
struct EpiMix {
    static constexpr bool PERM = true, AFTER_DRAIN = false, KHOOK = false;
    bf16* H; const float* X; const float* g1;
    DI void operator()(const pg8::f32x4 (&acc)[2][2][4][2], const pg8::Unit& u, int wr, int wc, int fr, int fq) const {
        const int row0 = u.pm * 256 + wr * 64 + fr, col0 = u.pn * 256 + wc * 32 + fq * 8;
#pragma unroll
        for (int bj = 0; bj < 2; ++bj) { const int c = col0 + bj * 128;
            const f32x4 ga = *(const f32x4*)(g1 + c), gb = *(const f32x4*)(g1 + c + 4);
#pragma unroll
            for (int ai = 0; ai < 2; ++ai)
#pragma unroll
                for (int m = 0; m < 4; ++m) { const size_t off = (size_t)(row0 + ai * 128 + m * 16) * D + c;
                    const f32x4 xa = __builtin_nontemporal_load((const f32x4*)(X + off)), xb = __builtin_nontemporal_load((const f32x4*)(X + off + 4));
                    const f32x4 ha = xa + ga * acc[ai][bj][m][0], hb = xb + gb * acc[ai][bj][m][1];
                    v4u w; w.x = pk2(ha.x, ha.y); w.y = pk2(ha.z, ha.w); w.z = pk2(hb.x, hb.y); w.w = pk2(hb.z, hb.w);
                    *(v4u*)(H + off) = w; } }
    }
};
struct EpiUp {
    static constexpr bool PERM = true, AFTER_DRAIN = false, KHOOK = false;
    unsigned char* HDN;
    DI void operator()(const pg8::f32x4 (&acc)[2][2][4][2], const pg8::Unit& u, int wr, int wc, int fr, int fq) const {
        const int j = u.pn & 3, row0 = u.pm * 256 + wr * 64 + fr, col0 = j * 128 + wc * 16 + fq * 4;
#pragma unroll
        for (int ai = 0; ai < 2; ++ai)
#pragma unroll
            for (int m = 0; m < 4; ++m) { unsigned char* rowp = HDN + (size_t)(row0 + ai * 128 + m * 16) * DFF + col0;
#pragma unroll
                for (int bj = 0; bj < 2; ++bj) { const pg8::f32x4 a = acc[ai][bj][m][0], b = acc[ai][bj][m][1];
                    *(unsigned*)(rowp + bj * 64) = pk4_fp8(siluf_(a[0]) * b[0], siluf_(a[1]) * b[1], siluf_(a[2]) * b[2], siluf_(a[3]) * b[3]); } }
    }
};
struct EpiDown {
    static constexpr bool PERM = true, AFTER_DRAIN = false, KHOOK = false;
    unsigned char* Y;
    DI void operator()(const pg8::f32x4 (&acc)[2][2][4][2], const pg8::Unit& u, int wr, int wc, int fr, int fq) const {
        const int j = u.pn & 3, row0 = u.pm * 256 + wr * 64 + fr, col0 = j * 256 + wc * 32 + fq * 8;
#pragma unroll
        for (int ai = 0; ai < 2; ++ai)
#pragma unroll
            for (int m = 0; m < 4; ++m) { unsigned char* rowp = Y + (size_t)(row0 + ai * 128 + m * 16) * D + col0;
#pragma unroll
                for (int bj = 0; bj < 2; ++bj) { const pg8::f32x4 v0 = acc[ai][bj][m][0] * 16.0f, v1 = acc[ai][bj][m][1] * 16.0f;
                    v2u w; w.x = pk4_fp8(v0[0], v0[1], v0[2], v0[3]); w.y = pk4_fp8(v1[0], v1[1], v1[2], v1[3]);
                    *(v2u*)(rowp + bj * 128) = w; } }
    }
};
struct MoeOrder {
    const LAS int* tb; int G, c, total, reps; const LAS int* tokl;
    DI bool next(int i0, pg8::Unit& u) const {
        const int n = (total - c + G - 1) / G; if (n <= 0 || i0 >= n * reps) return false;
        const int i = i0 % n; const int uu = i * G + c;
        const int T = uu >> 2; int e = 0;
        while (e < NE - 1 && tb[e + 1] <= T) ++e;
        u.pm = T; u.pn = 4 * e + (uu & 3); return true;
    }
    DI void a_ready(const pg8::Unit&) const {}
    DI void done(const pg8::Unit&) const {}
};

struct OneUnit { pg8::Unit u;
    DI bool next(int i, pg8::Unit& o) const { if (i != 0) return false; o = u; return true; }
    DI void a_ready(const pg8::Unit&) const {}
    DI void done(const pg8::Unit&) const {} };

template <class SrcF>
DI void transpose_item(SrcF src, int K, bf16* WT, LAS float* scr, int kb, int n0, int lane) {
    const int k0 = 64 * kb;
#pragma unroll 8
    for (int i = 0; i < 32; ++i) { const int kk = 2 * i + (lane >> 5); scr[kk * 33 + (lane & 31)] = src(k0 + kk, n0 + (lane & 31)); }
    LDS_WAIT(); asm volatile("" ::: "memory");
    const int c = lane & 7;
#pragma unroll
    for (int j = 0; j < 4; ++j) { const int n = (lane >> 3) + 8 * j; const LAS float* s = scr + (8 * c) * 33 + n;
        v4u o; o.x = pk2(s[0 * 33], s[1 * 33]); o.y = pk2(s[2 * 33], s[3 * 33]); o.z = pk2(s[4 * 33], s[5 * 33]); o.w = pk2(s[6 * 33], s[7 * 33]);
        *(v4u*)(WT + (size_t)(n0 + n) * K + k0 + 8 * c) = o; }
    LDS_WAIT(); asm volatile("" ::: "memory");
}

template <class SrcF>
DI void transpose_item8(SrcF src, int K, unsigned char* WT, LAS float* scr, int kb, int n0, int lane) {
    const int k0 = 64 * kb;
#pragma unroll 8
    for (int i = 0; i < 32; ++i) { const int kk = 2 * i + (lane >> 5); scr[kk * 33 + (lane & 31)] = src(k0 + kk, n0 + (lane & 31)) * 64.0f; }
    LDS_WAIT(); asm volatile("" ::: "memory");
#pragma unroll
    for (int i = 0; i < 2; ++i) { const int p = lane + 64 * i, n = p >> 2, c = p & 3; const LAS float* s = scr + (16 * c) * 33 + n;
        v4u o; o.x = pk4_fp8(s[0 * 33], s[1 * 33], s[2 * 33], s[3 * 33]); o.y = pk4_fp8(s[4 * 33], s[5 * 33], s[6 * 33], s[7 * 33]);
        o.z = pk4_fp8(s[8 * 33], s[9 * 33], s[10 * 33], s[11 * 33]); o.w = pk4_fp8(s[12 * 33], s[13 * 33], s[14 * 33], s[15 * 33]);
        *(v4u*)(WT + (size_t)(n0 + n) * K + k0 + 16 * c) = o; }
    LDS_WAIT(); asm volatile("" ::: "memory");
}

DI void ph0_prologue(const Ctx& F, const Args& a, int reps) {
    const int gw = F.vcu * NWAVES + F.wave, NGW = F.G * NWAVES, lane = lane_id();
    float* mod = (float*)(F.ws + WS_CTL) + CW_MOD;
    {
        const float* cvec = ARG(I_C); const float* wada = ARG(I_WADA); const float* bada = ARG(I_BADA);
        const int r8 = lane >> 3, c4 = lane & 7;
        for (int item0 = gw; item0 < 768 * reps; item0 += NGW) {
            const int item = item0 % 768; const int cc = item % 192, kq = item / 192;
            f32x4 acc = {0.f, 0.f, 0.f, 0.f};
#pragma unroll 8
            for (int i = 0; i < 32; ++i) { const int k = kq * 256 + i * 8 + r8; const float cv = cvec[k]; const float s = siluf_(cv);
                const f32x4 w = *(const f32x4*)(wada + (size_t)k * (6 * D) + cc * 32 + c4 * 4); acc += s * w; }
#pragma unroll
            for (int j = 0; j < 4; ++j) { float v = acc[j]; v += __shfl_xor(v, 8); v += __shfl_xor(v, 16); v += __shfl_xor(v, 32); acc[j] = v; }
            if (lane < 8) {
#pragma unroll
                for (int j = 0; j < 4; ++j) { float v = acc[j]; if (kq == 0) v += bada[cc * 32 + c4 * 4 + j]; mod[kq * 6144 + cc * 32 + c4 * 4 + j] = v; }
            }
        }
    }
    LAS float* scr = (LAS float*)(F.lds + F.wave * 16384);
    const float* win = ARG(I_WIN); const float* wcv = ARG(I_WCV); const float* wmix = ARG(I_WMIX); const float* wssm = ARG(I_WSSM);
    bf16* Win_t = (bf16*)(F.ws + WS_WIN); bf16* Wdt_t = (bf16*)(F.ws + WS_WDT); bf16* Wcv_t = (bf16*)(F.ws + WS_WCV);
    bf16* Wmix_t = (bf16*)(F.ws + WS_WMIX); bf16* Wssm_t = (bf16*)(F.ws + WS_WSSM);
    constexpr int I_IN = 16 * 288, I_DT = 16, I_CV = 16 * 32, I_MX = 16 * 32, I_SS = 32 * 32, I_RT = 16 * 3 * 2;
    constexpr int NITEMS = I_IN + I_DT + I_CV + I_MX + I_SS + I_RT;
    const float* wer = ARG(I_WER); const float* wgrp = ARG(I_WGRP); const float* sng0 = ARG(I_SNG);
    for (int it0 = gw; it0 < NITEMS * reps; it0 += NGW) {
        int r = it0 % NITEMS;
        if (r < I_IN) { const int kb = r / 288, nb = r % 288;
            transpose_item([&](int k, int npp) -> float {
                const int np = inproj_tile(npp >> 8) * 256 + (npp & 255);
                int col; if (np < 2048) { const int q = np >> 3, rr = np & 7; col = (rr >> 2) * 1024 + 4 * q + (rr & 3); } else if (np < 7168) col = np; else col = np + 32;
                return win[(size_t)k * WIN_LD + col]; }, D, Win_t, scr, kb, nb * 32, lane);
            continue; } r -= I_IN;
        if (r < I_DT) { transpose_item([&](int k, int np) -> float { return win[(size_t)k * WIN_LD + 7168 + np]; }, D, Wdt_t, scr, r, 0, lane); continue; } r -= I_DT;
        if (r < I_CV) { transpose_item([&](int k, int np) -> float { return wcv[(size_t)k * D + np]; }, D, Wcv_t, scr, r / 32, (r % 32) * 32, lane); continue; } r -= I_CV;
        if (r < I_MX) { transpose_item([&](int k, int np) -> float { return wmix[(size_t)k * D + np]; }, D, Wmix_t, scr, r / 32, (r % 32) * 32, lane); continue; } r -= I_MX;
        if (r < I_SS) { transpose_item([&](int k, int np) -> float { return wssm[(size_t)k * D + np] * sng0[k]; }, DIN, Wssm_t, scr, r / 32, (r % 32) * 32, lane); continue; } r -= I_SS;
        {
            const int lo = r / 48, rr = r % 48, kb = rr / 3, nb = rr % 3;
            auto wsrc = [&](int k, int np) -> float { float w = 0.f; if (np < 64) w = wer[(size_t)k * NE + np]; else if (np < 72) w = wgrp[(size_t)k * 8 + (np - 64)];
                const float hi = bflo(pk2(w, 0.f)); return lo ? (w - hi) : hi; };
            transpose_item(wsrc, D, (bf16*)(F.ws + (lo ? WS_WRL : WS_WRH)), scr, kb, nb * 32, lane);
        }
    }
}

DI void convert_experts(const Ctx& F, const Args& a) {
    const int gw = F.vcu * NWAVES + F.wave, NGW = F.G * NWAVES, lane = lane_id();
    LAS float* scr = (LAS float*)(F.lds + F.wave * 17408);
    const float* w1 = ARG(I_W1); const float* w3 = ARG(I_W3); const float* w2 = ARG(I_W2);
    unsigned char* W13_t = F.ws + WS_W13; unsigned char* W2_t = F.ws + WS_W2;
    constexpr int I_13 = NE * 4 * 16, I_2 = NE * 2 * 16, NIT = I_13 + I_2;
    const int ch = lane & 15, kq = lane >> 4;
    for (int it = gw; it < NIT; it += NGW) {
        const float* src; size_t ld; unsigned char* dst;
        if (it < I_13) { const int e = it >> 6, r = it & 63, kb = r >> 4, cb = r & 15;
            src = ((ch & 1) ? w3 : w1) + (size_t)e * D * DFF + (size_t)(256 * kb + kq) * DFF + 32 * cb + 4 * (ch >> 1); ld = DFF;
            dst = W13_t + (size_t)e * D * D + (size_t)(64 * cb + lane) * D + 256 * kb;
        } else { const int r0 = it - I_13, e = r0 >> 5, r = r0 & 31, kb = r >> 4, nb = r & 15;
            src = w2 + (size_t)e * DFF * D + (size_t)(256 * kb + kq) * D + 64 * nb + 4 * ch; ld = D;
            dst = W2_t + (size_t)e * D * DFF + (size_t)(64 * nb + lane) * DFF + 256 * kb;
        }
        f32x4 va[16], vb[16]; v4u o[16];
#pragma unroll
        for (int i = 0; i < 16; ++i) va[i] = __builtin_nontemporal_load((const f32x4*)(src + (size_t)(4 * i) * ld));
#pragma unroll
        for (int sub = 0; sub < 4; ++sub) {
            f32x4 (&cur)[16] = (sub & 1) ? vb : va; f32x4 (&nxt)[16] = (sub & 1) ? va : vb;
            if (sub < 3) {
#pragma unroll
                for (int i = 0; i < 16; ++i) nxt[i] = __builtin_nontemporal_load((const f32x4*)(src + (size_t)(64 * (sub + 1) + 4 * i) * ld));
            }
#pragma unroll
            for (int i = 0; i < 16; ++i) *(LAS f32x4*)(scr + (4 * i + kq) * 68 + 4 * ch) = cur[i] * 64.0f;
            LDS_WAIT(); asm volatile("" ::: "memory");
#pragma unroll
            for (int j = 0; j < 4; ++j) {
                unsigned w[4];
#pragma unroll
                for (int q = 0; q < 4; ++q) { const LAS float* sp = scr + (16 * j + 4 * q) * 68 + lane; w[q] = pk4_fp8(sp[0], sp[68], sp[136], sp[204]); }
                o[4 * sub + j].x = w[0]; o[4 * sub + j].y = w[1]; o[4 * sub + j].z = w[2]; o[4 * sub + j].w = w[3];
            }
            LDS_WAIT(); asm volatile("" ::: "memory");
        }
#pragma unroll
        for (int j = 0; j < 16; ++j) *(v4u*)(dst + 16 * j) = o[j];
    }
}

DI void ph1_norm_dt(const Ctx& F, const Args& a) {
    const float* mod = (const float*)(F.ws + WS_CTL) + CW_MOD;
    const float* x = ARG(I_X); const float* n1g = ARG(I_N1G); const float* dtb = ARG(I_DTB);
    bf16* XN = (bf16*)(F.ws + WS_XN); const bf16* Wdt_t = (const bf16*)(F.ws + WS_WDT); float* DT = (float*)(F.ws + WS_DT);
    const int lane = lane_id(), wave = F.wave;
    f32x4 gm[4], ga[4];
#pragma unroll
    for (int j = 0; j < 4; ++j) { const int k = 256 * j + 4 * lane; const f32x4 g = *(const f32x4*)(n1g + k), sc = mod4(mod, 1024 + k);
        gm[j] = g * (sc + 1.0f); ga[j] = mod4(mod, k); }
    if (F.vcu == 0) { float* modc = (float*)(F.ws + WS_CTL) + CW_MODC; for (int k = (F.wave * 64 + lane_id()) * 4; k < 6 * D; k += NTHREADS * 4) *(f32x4*)(modc + k) = mod4(mod, k); }
    for (int unit = F.vcu; unit < M / 64; unit += F.G) {
        const int row0 = unit * 64;
#pragma unroll 1
        for (int rh = 0; rh < 2; ++rh) {
            f32x4 v[4][4];
#pragma unroll
            for (int rr = 0; rr < 4; ++rr)
#pragma unroll
                for (int j = 0; j < 4; ++j) v[rr][j] = __builtin_nontemporal_load((const f32x4*)(x + (size_t)(row0 + wave * 8 + rh * 4 + rr) * D + 256 * j + 4 * lane));
#pragma unroll
            for (int rr = 0; rr < 4; ++rr) {
                const int rl = wave * 8 + rh * 4 + rr, row = row0 + rl; float ss = 0.f;
#pragma unroll
                for (int j = 0; j < 4; ++j) ss += (v[rr][j].x * v[rr][j].x + v[rr][j].y * v[rr][j].y) + (v[rr][j].z * v[rr][j].z + v[rr][j].w * v[rr][j].w);
                const float rstd = 1.0f / sqrtf(wave_sum(ss) * (1.0f / D) + EPS);
#pragma unroll
                for (int j = 0; j < 4; ++j) { const f32x4 n = v[rr][j] * rstd * gm[j] + ga[j];
                    v2u w; w.x = pk2(n.x, n.y); w.y = pk2(n.z, n.w);
                    *(v2u*)(XN + (size_t)row * D + 256 * j + 4 * lane) = w;
                    const int chunk = (32 * j + (lane >> 1)) ^ (rl & 15);
                    *(LAS v2u*)(F.lds + rl * 2048 + chunk * 16 + 8 * (lane & 1)) = w; }
            }
        }
        __syncthreads();
        {
            const int rt = wave & 3, ct = wave >> 2, fr = lane & 15, fq = lane >> 4;
            pg8::f32x4 acc = {0.f, 0.f, 0.f, 0.f};
            const bf16* wrow = Wdt_t + (size_t)(16 * ct + fr) * D + 8 * fq;
#pragma unroll 4
            for (int ks = 0; ks < 32; ++ks) {
                const bf16x8 av = *(const LAS bf16x8*)(F.lds + (16 * rt + fr) * 2048 + (((4 * ks + fq) ^ fr) * 16));
                const bf16x8 bv = *(const bf16x8*)(wrow + 32 * ks);
                acc = __builtin_amdgcn_mfma_f32_16x16x32_bf16(av, bv, acc, 0, 0, 0);
            }
            const float bias = dtb[16 * ct + fr];
#pragma unroll
            for (int r = 0; r < 4; ++r) { const float v = acc[r] + bias; const float sp = v > 20.f ? v : log1pf(__expf(v));
                DT[(size_t)(row0 + 16 * rt + 4 * fq + r) * NH + 16 * ct + fr] = sp; }
        }
        __syncthreads();
    }
}

DI void ph3_convbranch(const Ctx& F, const Args& a, int reps) {
    const bf16* U = (const bf16*)(F.ws + WS_U); bf16* UC = (bf16*)(F.ws + WS_XN);
    const float* cw = ARG(I_CVW); const float* cb = ARG(I_CVB); const float* lg = ARG(I_LNG); const float* lb = ARG(I_LNB);
    const int tid = F.wave * 64 + lane_id(), lane = lane_id(), wave = F.wave;
    LAS unsigned char* tile = F.lds;
    LAS float* red = (LAS float*)(F.lds + 62 * 2048);
    LAS float* stat = red + 32 * 8 * 2;
    f2v w[31];
#pragma unroll
    for (int j = 0; j < 31; ++j) w[j] = *(const f2v*)(cw + j * D + 2 * tid);
    const f2v bias = *(const f2v*)(cb + 2 * tid), gam = *(const f2v*)(lg + 2 * tid), bet = *(const f2v*)(lb + 2 * tid);
    const int RU = (M / 32 + F.G - 1) / F.G;
    for (int it = 0; it < RU * reps; ++it) {
        const int unit = xcd_unit(F.xcd, F.xj, F.G >> 3, (it >= RU ? it - RU : it), M / 32); if (unit < 0) break; const int t0 = unit * 32;
        for (int piece = tid; piece < 62 * 128; piece += NTHREADS) { const int r = piece >> 7, cch = piece & 127, t = t0 - 30 + r;
            v4u v = {0u, 0u, 0u, 0u}; if (t >= 0) v = *(const v4u*)(U + (size_t)t * D + cch * 8);
            *(LAS v4u*)(tile + r * 2048 + cch * 16) = v; }
        __syncthreads();
        f2v o[32];
#pragma unroll
        for (int tg = 0; tg < 8; ++tg) {
            f2v acc[4];
#pragma unroll
            for (int i = 0; i < 4; ++i) acc[i] = bias;
#pragma unroll
            for (int j = 0; j < 34; ++j) {
                const unsigned uu = *(const LAS unsigned*)(tile + (4 * tg + j) * 2048 + tid * 4);
                const f2v u2 = {bflo(uu), bfhi(uu)};
#pragma unroll
                for (int i = 0; i < 4; ++i) { const int jj = j - i; if (jj >= 0 && jj <= 30) acc[i] = __builtin_elementwise_fma(w[jj], u2, acc[i]); }
            }
#pragma unroll
            for (int i = 0; i < 4; ++i) o[4 * tg + i] = acc[i];
        }
        {
            float r5[64];
#pragma unroll
            for (int tk = 0; tk < 32; ++tk) { r5[2 * tk] = o[tk].x + o[tk].y; r5[2 * tk + 1] = o[tk].x * o[tk].x + o[tk].y * o[tk].y; }
            float r4[32], r3[16], r2[8], r1[4], r0[2];
            { const bool up = (lane & 32) != 0;
#pragma unroll
              for (int i = 0; i < 32; ++i) { const float keep = up ? r5[i + 32] : r5[i], send = up ? r5[i] : r5[i + 32]; r4[i] = keep + __shfl_xor(send, 32); } }
            { const bool up = (lane & 16) != 0;
#pragma unroll
              for (int i = 0; i < 16; ++i) { const float keep = up ? r4[i + 16] : r4[i], send = up ? r4[i] : r4[i + 16]; r3[i] = keep + __shfl_xor(send, 16); } }
            { const bool up = (lane & 8) != 0;
#pragma unroll
              for (int i = 0; i < 8; ++i) { const float keep = up ? r3[i + 8] : r3[i], send = up ? r3[i] : r3[i + 8]; r2[i] = keep + __shfl_xor(send, 8); } }
            { const bool up = (lane & 4) != 0;
#pragma unroll
              for (int i = 0; i < 4; ++i) { const float keep = up ? r2[i + 4] : r2[i], send = up ? r2[i] : r2[i + 4]; r1[i] = keep + __shfl_xor(send, 4); } }
            { const bool up = (lane & 2) != 0;
#pragma unroll
              for (int i = 0; i < 2; ++i) { const float keep = up ? r1[i + 2] : r1[i], send = up ? r1[i] : r1[i + 2]; r0[i] = keep + __shfl_xor(send, 2); } }
            const bool up0 = (lane & 1) != 0;
            const float tot = (up0 ? r0[1] : r0[0]) + __shfl_xor(up0 ? r0[0] : r0[1], 1);
            red[((lane >> 1) * 8 + wave) * 2 + (lane & 1)] = tot;
        }
        __syncthreads();
        if (tid < 32) { float s = 0.f, q = 0.f;
#pragma unroll
            for (int wv = 0; wv < 8; ++wv) { s += red[(tid * 8 + wv) * 2]; q += red[(tid * 8 + wv) * 2 + 1]; }
            const float mean = s * (1.0f / D); const float var = fmaxf(q * (1.0f / D) - mean * mean, 0.f);
            stat[tid * 2] = mean; stat[tid * 2 + 1] = 1.0f / sqrtf(var + EPS); }
        __syncthreads();
#pragma unroll
        for (int tk = 0; tk < 32; ++tk) { const float mean = stat[tk * 2], rstd = stat[tk * 2 + 1];
            const float y0 = (o[tk].x - mean) * rstd * gam.x + bet.x, y1 = (o[tk].y - mean) * rstd * gam.y + bet.y;
            *(unsigned*)(UC + (size_t)(t0 + tk) * D + 2 * tid) = pk2(siluf_(y0), siluf_(y1)); }
        __syncthreads();
    }
}

DI void conv_block(const bf16* XBC, const float* cw, const float* cb, int t_first, int col, float (&o)[8][8]) {
    v4u raw[11];
#pragma unroll
    for (int r = 0; r < 11; ++r) { const int t = t_first - 3 + r; const int tc = t < 0 ? 0 : t; v4u v = *(const v4u*)(XBC + (size_t)tc * XBCW + col);
        const unsigned msk = t < 0 ? 0u : 0xffffffffu; v.x &= msk; v.y &= msk; v.z &= msk; v.w &= msk; raw[r] = v; }
    float w[4][8], b[8];
#pragma unroll
    for (int j = 0; j < 4; ++j) { const f32x4 lo = *(const f32x4*)(cw + j * XBCW + col), hi = *(const f32x4*)(cw + j * XBCW + col + 4);
        w[j][0] = lo.x; w[j][1] = lo.y; w[j][2] = lo.z; w[j][3] = lo.w; w[j][4] = hi.x; w[j][5] = hi.y; w[j][6] = hi.z; w[j][7] = hi.w; }
    { const f32x4 lo = *(const f32x4*)(cb + col), hi = *(const f32x4*)(cb + col + 4); b[0] = lo.x; b[1] = lo.y; b[2] = lo.z; b[3] = lo.w; b[4] = hi.x; b[5] = hi.y; b[6] = hi.z; b[7] = hi.w; }
#pragma unroll
    for (int tk = 0; tk < 8; ++tk)
#pragma unroll
        for (int ch = 0; ch < 8; ++ch) {
            float acc = b[ch];
#pragma unroll
            for (int j = 0; j < 4; ++j) { const unsigned wd = raw[tk + j][ch >> 1]; const float xv = (ch & 1) ? bfhi(wd) : bflo(wd); acc += w[j][ch] * xv; }
            o[tk][ch] = siluf_(acc);
        }
}
DI float head_scan(const float* DT, const float* alog, int t0, int h, int lane, LAS float* acs_h, LAS float* dtv_h, float& d0o, float& d1o, float& c0o, float& c1o) {
    const float d0 = DT[(size_t)(t0 + 2 * lane) * NH + h], d1 = DT[(size_t)(t0 + 2 * lane + 1) * NH + h];
    const float A2 = -__expf(alog[h]) * LOG2E;
    const float a0 = d0 * A2, a1 = d1 * A2; float inc = a0 + a1;
#pragma unroll
    for (int o = 1; o < 64; o <<= 1) { const float t = __shfl_up(inc, o); if (lane >= o) inc += t; }
    acs_h[2 * lane] = inc - a1; acs_h[2 * lane + 1] = inc; dtv_h[2 * lane] = d0; dtv_h[2 * lane + 1] = d1;
    d0o = d0; d1o = d1; c0o = inc - a1; c1o = inc;
    return __shfl(inc, 63);
}

constexpr int S_CN = 0, S_BN = 32768, S_XT = 65536, S_ACS = 131072, S_DTV = 135168, S_SSQ = 139264, S_FS = 139776;

DI void ph3_chunk_states(const Ctx& F, const Args& a, int reps) {
    const bf16* XBC = (const bf16*)(F.ws + WS_XBC); const float* DT = (const float*)(F.ws + WS_DT);
    bf16* ST = (bf16*)(F.ws + WS_ST); float* CD = (float*)(F.ws + WS_CD);
    const float* scw = ARG(I_SCW); const float* scb = ARG(I_SCB); const float* alog = ARG(I_ALOG);
    const int tid = F.wave * 64 + lane_id(), lane = lane_id(), wave = F.wave, hh = lane >> 5;
    LAS unsigned char* lds = F.lds;
    LAS float* acs = (LAS float*)(lds + S_ACS); LAS float* wsc = (LAS float*)(lds + S_DTV);
    const int RU = (NCH * NGRP + F.G - 1) / F.G;
    for (int it = 0; it < RU * reps; ++it) {
        const int unit = xcd_unit(F.xcd, F.xj, F.G >> 3, (it >= RU ? it - RU : it), NCH * NGRP); if (unit < 0) break; const int c = unit >> 2, g = unit & 3, t0 = c * LCH;
        {
            const int h = 8 * g + wave; float d0, d1, c0, c1;
            const float total = head_scan(DT, alog, t0, h, lane, acs + wave * 128, wsc + wave * 128, d0, d1, c0, c1);
            wsc[wave * 128 + 2 * lane] = d0 * __builtin_amdgcn_exp2f(total - c0); wsc[wave * 128 + 2 * lane + 1] = d1 * __builtin_amdgcn_exp2f(total - c1);
            if (lane == 0) CD[c * NH + h] = __builtin_amdgcn_exp2f(total);
        }
        __syncthreads();
        if (tid < 256) { const int co = tid & 15, to = tid >> 4; float o[8][8];
            conv_block(XBC, scw, scb, t0 + 8 * to, 2048 + 128 * g + 8 * co, o);
#pragma unroll
            for (int ch = 0; ch < 8; ++ch) { const int row = 8 * co + ch;
                v4u w; w.x = pk2(o[0][ch], o[1][ch]); w.y = pk2(o[2][ch], o[3][ch]); w.z = pk2(o[4][ch], o[5][ch]); w.w = pk2(o[6][ch], o[7][ch]);
                *(LAS v4u*)(lds + S_BN + row * 256 + swz(row, to) * 16) = w; } }
        for (int ps = 0; ps < 2; ++ps) {
            {
                const int co = tid & 31, to = tid >> 5, hd = co >> 3, p0 = (co & 7) * 8; float o[8][8];
                conv_block(XBC, scw, scb, t0 + 8 * to, 512 * g + 64 * (4 * ps + hd) + p0, o);
                float sc[8];
#pragma unroll
                for (int tk = 0; tk < 8; ++tk) sc[tk] = wsc[(4 * ps + hd) * 128 + 8 * to + tk];
#pragma unroll
                for (int ch = 0; ch < 8; ++ch) { const int row = hd * 64 + p0 + ch;
                    v4u w; w.x = pk2(o[0][ch] * sc[0], o[1][ch] * sc[1]); w.y = pk2(o[2][ch] * sc[2], o[3][ch] * sc[3]);
                    w.z = pk2(o[4][ch] * sc[4], o[5][ch] * sc[5]); w.w = pk2(o[6][ch] * sc[6], o[7][ch] * sc[7]);
                    *(LAS v4u*)(lds + S_XT + row * 256 + swz(row, to) * 16) = w; }
            }
            __syncthreads();
            {
                const int hd = wave & 3, ph = wave >> 2, h = 8 * g + 4 * ps + hd;
                f32x16 acc[4];
#pragma unroll
                for (int nt = 0; nt < 4; ++nt)
#pragma unroll
                    for (int i = 0; i < 16; ++i) acc[nt][i] = 0.f;
                const int arow = hd * 64 + 32 * ph + (lane & 31);
#pragma unroll
                for (int ks = 0; ks < 8; ++ks) {
                    const bf16x8 av = *(const LAS bf16x8*)(lds + S_XT + arow * 256 + swz(arow, 2 * ks + hh) * 16);
#pragma unroll
                    for (int nt = 0; nt < 4; ++nt) { const int brow = 32 * nt + (lane & 31);
                        const bf16x8 bv = *(const LAS bf16x8*)(lds + S_BN + brow * 256 + swz(brow, 2 * ks + hh) * 16);
                        acc[nt] = MFMA32(av, bv, acc[nt]); }
                }
                bf16* dst = ST + ((size_t)(c * NH + h) * HD) * NST;
#pragma unroll
                for (int nt = 0; nt < 4; ++nt)
#pragma unroll
                    for (int i = 0; i < 16; i += 2) { const int p = 32 * ph + crow(i, hh); const unsigned pk = pk2(acc[nt][i], acc[nt][i + 1]);
                        dst[(size_t)p * NST + 32 * nt + (lane & 31)] = (bf16)(pk & 0xffffu); dst[(size_t)(p + 1) * NST + 32 * nt + (lane & 31)] = (bf16)(pk >> 16); }
            }
            __syncthreads();
        }
    }
}

DI void ph4_scan(const Ctx& F, size_t dst_off) {
    unsigned* ST32 = (unsigned*)(F.ws + WS_ST); unsigned* DST32 = (unsigned*)(F.ws + dst_off); const float* CD = (const float*)(F.ws + WS_CD);
    constexpr int NPAIR = NH * HD * NST / 2;
    for (int e = F.vcu * NTHREADS + (F.wave * 64 + lane_id()); e < NPAIR; e += F.G * NTHREADS) {
        const int h = e >> 12; float c0 = 0.f, c1 = 0.f;
#pragma unroll 1
        for (int cb = 0; cb < NCH; cb += 32) {
            unsigned v[32]; float dec[32];
#pragma unroll
            for (int i = 0; i < 32; ++i) { v[i] = __builtin_nontemporal_load(ST32 + (size_t)(cb + i) * NPAIR + e); dec[i] = CD[(cb + i) * NH + h]; }
#pragma unroll
            for (int i = 0; i < 32; ++i) { DST32[(size_t)(cb + i) * NPAIR + e] = pk2(c0, c1); c0 = c0 * dec[i] + bflo(v[i]); c1 = c1 * dec[i] + bfhi(v[i]); }
        }
    }
}

DI void ph5_ssd_out(const Ctx& F, const Args& a, int reps) {
    const bf16* XBC = (const bf16*)(F.ws + WS_XBC); const float* DT = (const float*)(F.ws + WS_DT);
    const bf16* ST = (const bf16*)(F.ws + WS_ST); const bf16* ZS = (const bf16*)(F.ws + WS_ZS); bf16* YS = (bf16*)(F.ws + WS_YS);
    const float* scw = ARG(I_SCW); const float* scb = ARG(I_SCB); const float* alog = ARG(I_ALOG); const float* dskip = ARG(I_DSKIP);
    const int tid = F.wave * 64 + lane_id(), lane = lane_id(), wave = F.wave, hh = lane >> 5, l31 = lane & 31;
    LAS unsigned char* lds = F.lds;
    LAS float* acs = (LAS float*)(lds + S_ACS); LAS float* dtv = (LAS float*)(lds + S_DTV); LAS float* ssq = (LAS float*)(lds + S_SSQ);
    const int RU = (NCH * NGRP + F.G - 1) / F.G;
    for (int it = 0; it < RU * reps; ++it) {
        const int unit = xcd_unit(F.xcd, F.xj, F.G >> 3, (it >= RU ? it - RU : it), NCH * NGRP); if (unit < 0) break; const int c = unit >> 2, g = unit & 3, t0 = c * LCH;
        { const int h = 8 * g + wave; float d0, d1, c0, c1; (void)head_scan(DT, alog, t0, h, lane, acs + wave * 128, dtv + wave * 128, d0, d1, c0, c1);
          const float cend = __shfl(c1, (lane & 48) | 15);
          LAS float* fsw = (LAS float*)(lds + S_FS) + wave * 128;
          fsw[2 * lane] = d0 * __builtin_amdgcn_exp2f(cend - c0); fsw[2 * lane + 1] = d1 * __builtin_amdgcn_exp2f(cend - c1); }
        if (tid < 128) ssq[tid] = 0.f;
        { const int which = tid >> 8, t8 = tid & 255, co = t8 & 15; int to = t8 >> 4; asm volatile("" : "+v"(to)); float o[8][8];
            conv_block(XBC, scw, scb, t0 + 8 * to, (which ? 2560 : 2048) + 128 * g + 8 * co, o);
            const int base = which ? S_CN : S_BN;
#pragma unroll
            for (int tk = 0; tk < 8; ++tk) { const int row = 8 * to + tk;
                v4u w; w.x = pk2(o[tk][0], o[tk][1]); w.y = pk2(o[tk][2], o[tk][3]); w.z = pk2(o[tk][4], o[tk][5]); w.w = pk2(o[tk][6], o[tk][7]);
                *(LAS v4u*)(lds + base + row * 256 + swz(row, co) * 16) = w; } }
#pragma unroll 1
        for (int ps = 0; ps < 2; ++ps) {
            {
                const int co = tid & 31; int to = tid >> 5; asm volatile("" : "+v"(to));
                const int hd = co >> 3, p0 = (co & 7) * 8; float o[8][8];
                conv_block(XBC, scw, scb, t0 + 8 * to, 512 * g + 64 * (4 * ps + hd) + p0, o);
#pragma unroll
                for (int ch = 0; ch < 8; ++ch) { const int row = hd * 64 + p0 + ch;
                    v4u w; w.x = pk2(o[0][ch], o[1][ch]); w.y = pk2(o[2][ch], o[3][ch]); w.z = pk2(o[4][ch], o[5][ch]); w.w = pk2(o[6][ch], o[7][ch]);
                    *(LAS v4u*)(lds + S_XT + row * 256 + swz(row, to) * 16) = w; }
            }
            __syncthreads();
            const int hd = wave & 3, lp = wave >> 2, hl = 4 * ps + hd, h = 8 * g + hl;
            const float Dh = dskip[h];
            const LAS float* acs_h = acs + hl * 128; const LAS float* dt_h = dtv + hl * 128; const LAS float* fs_h = (const LAS float*)(lds + S_FS) + hl * 128;
            const bf16* prev = ST + ((size_t)(c * NH + h) * HD) * NST;
            const int erow = lane >> 1, ehalf = lane & 1;
            f32x16 acc[2][2];
            {
#pragma unroll
                for (int which = 0; which < 2; ++which)
#pragma unroll
                    for (int pt = 0; pt < 2; ++pt)
#pragma unroll
                        for (int i = 0; i < 16; ++i) acc[which][pt][i] = 0.f;
                const int rowA = 32 * lp + l31, rowB = 32 * (3 - lp) + l31;
#pragma unroll
                for (int ks = 0; ks < 8; ++ks) {
                    const bf16x8 b0 = *(const bf16x8*)(prev + (size_t)l31 * NST + 16 * ks + 8 * hh), b1 = *(const bf16x8*)(prev + (size_t)(32 + l31) * NST + 16 * ks + 8 * hh);
                    const bf16x8 a0 = *(const LAS bf16x8*)(lds + S_CN + rowA * 256 + swz(rowA, 2 * ks + hh) * 16);
                    const bf16x8 a1 = *(const LAS bf16x8*)(lds + S_CN + rowB * 256 + swz(rowB, 2 * ks + hh) * 16);
                    acc[0][0] = MFMA32(a0, b0, acc[0][0]); acc[0][1] = MFMA32(a0, b1, acc[0][1]);
                    acc[1][0] = MFMA32(a1, b0, acc[1][0]); acc[1][1] = MFMA32(a1, b1, acc[1][1]);
                }
#pragma unroll
                for (int which = 0; which < 2; ++which) { const int li = which == 0 ? lp : 3 - lp;
#pragma unroll
                    for (int i = 0; i < 16; ++i) { const float e = __builtin_amdgcn_exp2f(acs_h[32 * li + crow(i, hh)]); acc[which][0][i] *= e; acc[which][1][i] *= e; } }
            }
            {
                const int liA = lp, liB = 3 - lp;
                const int rowA = 32 * liA + l31, rowB = 32 * liB + l31;
                const float alA = acs_h[rowA], alB = acs_h[rowB];
#pragma unroll 1
                for (int sj = 0; sj <= liB; ++sj) {
                    const bool doA = sj <= liA;
                    f32x16 GA, GB;
#pragma unroll
                    for (int i = 0; i < 16; ++i) { GA[i] = 0.f; GB[i] = 0.f; }
                    const int brow = 32 * sj + l31;
                    if (doA) {
#pragma unroll 2
                        for (int ks = 0; ks < 8; ++ks) {
                            const bf16x8 av = *(const LAS bf16x8*)(lds + S_BN + brow * 256 + swz(brow, 2 * ks + hh) * 16);
                            const bf16x8 ca = *(const LAS bf16x8*)(lds + S_CN + rowA * 256 + swz(rowA, 2 * ks + hh) * 16);
                            const bf16x8 cb = *(const LAS bf16x8*)(lds + S_CN + rowB * 256 + swz(rowB, 2 * ks + hh) * 16);
                            GA = MFMA32(av, ca, GA); GB = MFMA32(av, cb, GB);
                        }
                    } else {
#pragma unroll 2
                        for (int ks = 0; ks < 8; ++ks) {
                            const bf16x8 av = *(const LAS bf16x8*)(lds + S_BN + brow * 256 + swz(brow, 2 * ks + hh) * 16);
                            const bf16x8 cb = *(const LAS bf16x8*)(lds + S_CN + rowB * 256 + swz(rowB, 2 * ks + hh) * 16);
                            GB = MFMA32(av, cb, GB);
                        }
                    }
                    auto mask = [&](f32x16& G, int li, int row_l, float al) {
                        if (sj < li) {
                            const float fl = __builtin_amdgcn_exp2f(al - acs_h[32 * sj + 31]);
#pragma unroll
                            for (int i = 0; i < 16; ++i) G[i] = G[i] * (fs_h[32 * sj + crow(i, hh)] * fl);
                        } else {
#pragma unroll
                            for (int i = 0; i < 16; ++i) { const int s = 32 * sj + crow(i, hh);
                                float v = G[i] * __builtin_amdgcn_exp2f(fminf(al - acs_h[s], 0.f)) * dt_h[s];
                                v = (s > row_l) ? 0.f : v; v = (s == row_l) ? v + Dh : v; G[i] = v; }
                        }
                    };
                    auto pv = [&](const f32x16& G, f32x16 (&ac)[2]) {
#pragma unroll
                        for (int s2 = 0; s2 < 2; ++s2) {
                            v4u fa; fa.x = pk2(G[8 * s2 + 0], G[8 * s2 + 1]); fa.y = pk2(G[8 * s2 + 2], G[8 * s2 + 3]); fa.z = pk2(G[8 * s2 + 4], G[8 * s2 + 5]); fa.w = pk2(G[8 * s2 + 6], G[8 * s2 + 7]);
#pragma unroll
                            for (int pt = 0; pt < 2; ++pt) { const int xrow = hd * 64 + 32 * pt + l31; const int sc0 = 32 * sj + 16 * s2;
                                const v2u lo = *(const LAS v2u*)(lds + S_XT + xrow * 256 + swz(xrow, (sc0 >> 3)) * 16 + 8 * hh);
                                const v2u hi = *(const LAS v2u*)(lds + S_XT + xrow * 256 + swz(xrow, (sc0 >> 3) + 1) * 16 + 8 * hh);
                                v4u bfr; bfr.x = lo.x; bfr.y = lo.y; bfr.z = hi.x; bfr.w = hi.y;
                                ac[pt] = MFMA32(__builtin_bit_cast(bf16x8, fa), __builtin_bit_cast(bf16x8, bfr), ac[pt]); }
                        }
                    };
                    if (doA) { mask(GA, liA, rowA, alA); pv(GA, acc[0]); }
                    mask(GB, liB, rowB, alB); pv(GB, acc[1]);
                }
            }
            asm volatile("" ::: "memory");
            v4u zs[2][4];
#pragma unroll
            for (int which = 0; which < 2; ++which) { const int li = which == 0 ? lp : 3 - lp; const size_t t = (size_t)(t0 + 32 * li + erow);
#pragma unroll
                for (int j = 0; j < 4; ++j) zs[which][j] = *(const v4u*)(ZS + t * DIN + 64 * h + 32 * ehalf + 8 * j); }
            __syncthreads();
            {
                LAS unsigned char* stg = lds + S_XT + wave * 8192;
#pragma unroll
                for (int which = 0; which < 2; ++which)
#pragma unroll
                    for (int pt = 0; pt < 2; ++pt)
#pragma unroll
                        for (int i = 0; i < 16; ++i) *(LAS bf16*)(stg + ((which * 32 + crow(i, hh)) * 64 + 32 * pt + l31) * 2) = (bf16)(pk2(acc[which][pt][i], 0.f) & 0xffffu);
                LDS_WAIT(); asm volatile("" ::: "memory");
#pragma unroll
                for (int which = 0; which < 2; ++which) { const int li = which == 0 ? lp : 3 - lp; const int l = 32 * li + erow; const size_t t = (size_t)(t0 + l);
                    float q = 0.f;
#pragma unroll
                    for (int j = 0; j < 4; ++j) { const v4u yv = *(const LAS v4u*)(stg + ((which * 32 + erow) * 64 + 32 * ehalf + 8 * j) * 2); const v4u zv = zs[which][j];
                        float y[8] = {bflo(yv.x) * bflo(zv.x), bfhi(yv.x) * bfhi(zv.x), bflo(yv.y) * bflo(zv.y), bfhi(yv.y) * bfhi(zv.y), bflo(yv.z) * bflo(zv.z), bfhi(yv.z) * bfhi(zv.z), bflo(yv.w) * bflo(zv.w), bfhi(yv.w) * bfhi(zv.w)};
#pragma unroll
                        for (int k = 0; k < 8; ++k) q += y[k] * y[k];
                        v4u w; w.x = pk2(y[0], y[1]); w.y = pk2(y[2], y[3]); w.z = pk2(y[4], y[5]); w.w = pk2(y[6], y[7]);
                        *(v4u*)(YS + t * DIN + 64 * h + 32 * ehalf + 8 * j) = w; }
                    q += __shfl_xor(q, 1);
                    if (ehalf == 0) __hip_atomic_fetch_add(ssq + l, q, __ATOMIC_RELAXED, __HIP_MEMORY_SCOPE_WORKGROUP);
                }
            }
            __syncthreads();
        }
        if (tid < 128) ((float*)(F.ws + WS_RSTD))[(size_t)(t0 + tid) * 4 + g] = 1.0f / sqrtf(ssq[tid] * (1.0f / 512.f) + EPS);
        __syncthreads();
    }
}

constexpr int RT_LD = 1028;
DI void ph8_router(const Ctx& F, const Args& a, int reps) {
    const float* mod = (const float*)(F.ws + WS_CTL) + CW_MODC;
    const bf16* H = (const bf16*)(F.ws + WS_H16); const float* n2g = ARG(I_N2G); const float* bgrp = ARG(I_BGRP); const float* ber = ARG(I_BER);
    unsigned char* XN2 = F.ws + WS_XN; int* cnt0 = (int*)(F.ws + WS_CTL) + CW_CNT;
    int* RE = (int*)(F.ws + WS_ROUTE); int* RP = RE + 2 * M; float* RW = (float*)(RP + 2 * M); int* LIST = (int*)(F.ws + WS_LIST);
    const int lane = lane_id(), wave = F.wave;
    LAS float* tile = (LAS float*)F.lds;
    LAS float* pe = (LAS float*)F.lds;
    f32x4 gm[4], ga[4];
#pragma unroll
    for (int j = 0; j < 4; ++j) { const int k = 256 * j + 4 * lane; const f32x4 g = *(const f32x4*)(n2g + k), sc = *(const f32x4*)(mod + 4096 + k);
        gm[j] = g * (sc + 1.0f); ga[j] = *(const f32x4*)(mod + 3072 + k); }
    const int RU = (M / 32 + F.G - 1) / F.G;
    for (int it = 0; it < RU * reps; ++it) {
        const int unit = xcd_unit(F.xcd, F.xj, F.G >> 3, (it >= RU ? it - RU : it), M / 32); if (unit < 0) break; int* cnt = cnt0 + ((it >= RU * (reps - 1)) ? 0 : 4096);
        const int row0 = unit * 32;
        {
            f32x4 v[4][4];
#pragma unroll
            for (int rr = 0; rr < 4; ++rr)
#pragma unroll
                for (int j = 0; j < 4; ++j) { const v2u hw = *(const v2u*)(H + (size_t)(row0 + wave * 4 + rr) * D + 256 * j + 4 * lane); v[rr][j] = (f32x4){bflo(hw.x), bfhi(hw.x), bflo(hw.y), bfhi(hw.y)}; }
#pragma unroll
            for (int rr = 0; rr < 4; ++rr) { const int rl = wave * 4 + rr, row = row0 + rl; float ss = 0.f;
#pragma unroll
                for (int j = 0; j < 4; ++j) ss += (v[rr][j].x * v[rr][j].x + v[rr][j].y * v[rr][j].y) + (v[rr][j].z * v[rr][j].z + v[rr][j].w * v[rr][j].w);
                const float rstd = 1.0f / sqrtf(wave_sum(ss) * (1.0f / D) + EPS);
#pragma unroll
                for (int j = 0; j < 4; ++j) { const f32x4 n = v[rr][j] * rstd * gm[j] + ga[j];
                    *(LAS f32x4*)(tile + rl * RT_LD + 256 * j + 4 * lane) = n;
                    *(unsigned*)(XN2 + (size_t)row * D + 256 * j + 4 * lane) = pk4_fp8(n.x, n.y, n.z, n.w); }
            }
        }
        __syncthreads();
        pg8::f32x4 acc[2][5];
#pragma unroll
        for (int rt = 0; rt < 2; ++rt)
#pragma unroll
            for (int ct = 0; ct < 5; ++ct) acc[rt][ct] = (pg8::f32x4){0.f, 0.f, 0.f, 0.f};
        const int kb = wave * 128, fr = lane & 15, kq = lane >> 4;
        const bf16* WRH = (const bf16*)(F.ws + WS_WRH); const bf16* WRL = (const bf16*)(F.ws + WS_WRL);
#pragma unroll 2
        for (int ks = 0; ks < 4; ++ks) {
            const int k0 = kb + 32 * ks + 8 * kq;
            bf16x8 bh[5], bl[5];
#pragma unroll
            for (int ct = 0; ct < 5; ++ct) { bh[ct] = *(const bf16x8*)(WRH + (size_t)(16 * ct + fr) * D + k0); bl[ct] = *(const bf16x8*)(WRL + (size_t)(16 * ct + fr) * D + k0); }
#pragma unroll
            for (int rt = 0; rt < 2; ++rt) {
                const f32x4 x0 = *(const LAS f32x4*)(tile + (16 * rt + fr) * RT_LD + k0), x1 = *(const LAS f32x4*)(tile + (16 * rt + fr) * RT_LD + k0 + 4);
                v4u hv, lv;
                hv.x = pk2(x0.x, x0.y); hv.y = pk2(x0.z, x0.w); hv.z = pk2(x1.x, x1.y); hv.w = pk2(x1.z, x1.w);
                lv.x = pk2(x0.x - bflo(hv.x), x0.y - bfhi(hv.x)); lv.y = pk2(x0.z - bflo(hv.y), x0.w - bfhi(hv.y));
                lv.z = pk2(x1.x - bflo(hv.z), x1.y - bfhi(hv.z)); lv.w = pk2(x1.z - bflo(hv.w), x1.w - bfhi(hv.w));
                const bf16x8 ah = __builtin_bit_cast(bf16x8, hv), al = __builtin_bit_cast(bf16x8, lv);
#pragma unroll
                for (int ct = 0; ct < 5; ++ct) {
                    acc[rt][ct] = __builtin_amdgcn_mfma_f32_16x16x32_bf16(ah, bh[ct], acc[rt][ct], 0, 0, 0);
                    acc[rt][ct] = __builtin_amdgcn_mfma_f32_16x16x32_bf16(ah, bl[ct], acc[rt][ct], 0, 0, 0);
                    acc[rt][ct] = __builtin_amdgcn_mfma_f32_16x16x32_bf16(al, bh[ct], acc[rt][ct], 0, 0, 0); }
            }
        }
        __syncthreads();
#pragma unroll
        for (int rt = 0; rt < 2; ++rt)
#pragma unroll
            for (int ct = 0; ct < 5; ++ct)
#pragma unroll
                for (int r = 0; r < 4; ++r) pe[(wave * 32 + 16 * rt + 4 * kq + r) * 80 + 16 * ct + fr] = acc[rt][ct][r];
        __syncthreads();
        int e0s[4], e1s[4]; float w0s[4], w1s[4];
#pragma unroll
        for (int rr = 0; rr < 4; ++rr) { const int rl = wave * 4 + rr;
            float le = ber[lane], lgv = (lane < 8) ? bgrp[lane] : 0.f;
#pragma unroll
            for (int wv = 0; wv < 8; ++wv) { le += pe[(wv * 32 + rl) * 80 + lane]; if (lane < 8) lgv += pe[(wv * 32 + rl) * 80 + 64 + lane]; }
            float gl[8];
#pragma unroll
            for (int i = 0; i < 8; ++i) gl[i] = __shfl(lgv, i);
            int gi = 0; float gmax = gl[0];
#pragma unroll
            for (int i = 1; i < 8; ++i) if (gl[i] > gmax) { gmax = gl[i]; gi = i; }
            float den = 0.f;
#pragma unroll
            for (int i = 0; i < 8; ++i) den += __expf(gl[i] - gmax);
            const float gp = 1.0f / den;
            float el[8];
#pragma unroll
            for (int i = 0; i < 8; ++i) el[i] = __shfl(le, gi * 8 + i);
            int i0 = 0; float m0 = el[0];
#pragma unroll
            for (int i = 1; i < 8; ++i) if (el[i] > m0) { m0 = el[i]; i0 = i; }
            int i1 = -1; float m1 = -INFINITY;
#pragma unroll
            for (int i = 0; i < 8; ++i) if (i != i0 && el[i] > m1) { m1 = el[i]; i1 = i; }
            const float dd = __expf(m1 - m0);
            w0s[rr] = gp / (1.0f + dd); w1s[rr] = gp * dd / (1.0f + dd); e0s[rr] = gi * 8 + i0; e1s[rr] = gi * 8 + i1;
        }
        if (lane == 0) {
            int p0[4], p1[4];
#pragma unroll
            for (int rr = 0; rr < 4; ++rr) { p0[rr] = atomicAdd(cnt + 64 * e0s[rr], 1); p1[rr] = atomicAdd(cnt + 64 * e1s[rr], 1); }
#pragma unroll
            for (int rr = 0; rr < 4; ++rr) { const int row = row0 + wave * 4 + rr;
                RE[2 * row] = e0s[rr]; RE[2 * row + 1] = e1s[rr]; RP[2 * row] = p0[rr]; RP[2 * row + 1] = p1[rr]; RW[2 * row] = w0s[rr]; RW[2 * row + 1] = w1s[rr];
                LIST[e0s[rr] * 16384 + p0[rr]] = row; LIST[e1s[rr] * 16384 + p1[rr]] = row; }
        }
        __syncthreads();
    }
}

DI void build_tilebase(const Ctx& F) {
    const int* cnt = (const int*)(F.ws + WS_CTL) + CW_CNT; LAS int* tb = (LAS int*)(F.lds + TB_OFF);
    if (F.wave == 0) {
        const int lane = lane_id(); const int tiles = (cnt[64 * lane] + 255) >> 8; int inc = tiles;
#pragma unroll
        for (int o = 1; o < 64; o <<= 1) { const int t = __shfl_up(inc, o); if (lane >= o) inc += t; }
        tb[lane] = inc - tiles; if (lane == 63) tb[NE] = inc; ((LAS int*)(F.lds + CNTL_OFF))[lane] = cnt[64 * lane];
    }
    __syncthreads();
}
DI void fill_tokl(const Ctx& F, const MoeOrder& S) {
    const LAS int* tb = (const LAS int*)(F.lds + TB_OFF); const LAS int* cntl = (const LAS int*)(F.lds + CNTL_OFF); LAS int* tokl = (LAS int*)(F.lds + TOKL_OFF);
    const int* LIST = (const int*)(F.ws + WS_LIST); const int tid = F.wave * 64 + lane_id();
    for (int i = 0; i < 4; ++i) { pg8::Unit u; if (!S.next(i, u)) break;
        const int e = u.pn >> 2, r = 256 * (u.pm - tb[e]) + tid;
        if (tid < 256) tokl[256 * i + tid] = (r < cntl[e]) ? LIST[e * 16384 + r] : 0; }
    asm volatile("s_waitcnt vmcnt(0) lgkmcnt(0)" ::: "memory"); __syncthreads();
}
DI void ph12_final(const Ctx& F, const Args& a, int reps) {
    const float* mod = (const float*)(F.ws + WS_CTL) + CW_MODC; float* H = (float*)argp<N_IN>(); const bf16* H16 = (const bf16*)(F.ws + WS_H16); const float* fg = ARG(I_FG);
    const unsigned char* YE = F.ws + WS_YEXP; const int* RE = (const int*)(F.ws + WS_ROUTE); const int* RP = RE + 2 * M; const float* RW = (const float*)(F.ws + WS_ROUTE) + 4 * M;
    const LAS int* tb = (const LAS int*)(F.lds + TB_OFF);
    float* OUT2 = (float*)(F.ws + WS_U);
    const int gw = F.vcu * NWAVES + F.wave, NGW = F.G * NWAVES, lane = lane_id();
    f32x4 g2[4], fgv[4];
#pragma unroll
    for (int j = 0; j < 4; ++j) { g2[j] = *(const f32x4*)(mod + 5 * 1024 + 256 * j + 4 * lane); fgv[j] = *(const f32x4*)(fg + 256 * j + 4 * lane); }
    const int RT = (M / 2 + NGW - 1) / NGW;
    for (int it = 0; it < RT * reps; ++it) {
        const int t0 = 2 * xcd_unit(F.xcd, F.xj * NWAVES + F.wave, NGW >> 3, (it >= RT ? it - RT : it), M / 2); if (t0 < 0) break;
        float* O = (it >= RT * (reps - 1)) ? H : OUT2;
        int tt[2], d0[2], d1[2]; float w0[2], w1[2];
#pragma unroll
        for (int u = 0; u < 2; ++u) { tt[u] = (t0 + u) % M; d0[u] = 256 * tb[RE[2 * tt[u]]] + RP[2 * tt[u]]; d1[u] = 256 * tb[RE[2 * tt[u] + 1]] + RP[2 * tt[u] + 1]; w0[u] = RW[2 * tt[u]]; w1[u] = RW[2 * tt[u] + 1]; }
        f32x4 hv[2][4]; unsigned ya[2][4], yb[2][4];
#pragma unroll
        for (int u = 0; u < 2; ++u)
#pragma unroll
            for (int j = 0; j < 4; ++j) { const v2u hw = *(const v2u*)(H16 + (size_t)tt[u] * D + 256 * j + 4 * lane); hv[u][j] = (f32x4){bflo(hw.x), bfhi(hw.x), bflo(hw.y), bfhi(hw.y)};
                ya[u][j] = *(const unsigned*)(YE + (size_t)d0[u] * D + 256 * j + 4 * lane); yb[u][j] = *(const unsigned*)(YE + (size_t)d1[u] * D + 256 * j + 4 * lane); }
#pragma unroll
        for (int u = 0; u < 2; ++u) {
            f32x4 v[4]; float ss = 0.f;
#pragma unroll
            for (int j = 0; j < 4; ++j) { const unsigned a4 = ya[u][j], b4 = yb[u][j];
                const f2v a01 = __builtin_amdgcn_cvt_pk_f32_fp8(a4, false), a23 = __builtin_amdgcn_cvt_pk_f32_fp8(a4, true), b01 = __builtin_amdgcn_cvt_pk_f32_fp8(b4, false), b23 = __builtin_amdgcn_cvt_pk_f32_fp8(b4, true);
                f32x4 mo; mo.x = w0[u] * a01.x + w1[u] * b01.x; mo.y = w0[u] * a01.y + w1[u] * b01.y; mo.z = w0[u] * a23.x + w1[u] * b23.x; mo.w = w0[u] * a23.y + w1[u] * b23.y;
                mo = mo * 0.0625f;
                v[j] = hv[u][j] + g2[j] * mo; ss += (v[j].x * v[j].x + v[j].y * v[j].y) + (v[j].z * v[j].z + v[j].w * v[j].w); }
            const float rstd = 1.0f / sqrtf(wave_sum(ss) * (1.0f / D) + EPS);
#pragma unroll
            for (int j = 0; j < 4; ++j) *(f32x4*)(O + (size_t)tt[u] * D + 256 * j + 4 * lane) = v[j] * rstd * fgv[j];
        }
    }
}

constexpr int N_PHASES = 13;
#ifndef REP_MASK
#define REP_MASK 0
#endif
#define REPS(k) (((REP_MASK >> (k)) & 1) ? 2 : 1)
#ifndef MK_ONE_LAUNCH
#define MK_ONE_LAUNCH 1
#endif

struct RepOrder { pg8::StaticOrder s; int n, reps;
    DI bool next(int i, pg8::Unit& u) const { if (i >= n * reps) return false; return s.next(i % n, u); }
    DI void a_ready(const pg8::Unit&) const {}
    DI void done(const pg8::Unit&) const {} };

__global__ void __launch_bounds__(NTHREADS, 2) fwd_kernel(Args args) {
    extern __shared__ __attribute__((aligned(16))) unsigned char lds_raw[];
    Ctx F;
    F.lds = (LAS unsigned char*)lds_raw;
    F.wave = __builtin_amdgcn_readfirstlane((int)threadIdx.x >> 6);
    F.G = gridDim.x; { const int bx = blockIdx.x; F.xcd = bx & 7; F.xj = bx >> 3; F.vcu = F.xcd * (F.G >> 3) + F.xj; }
    F.ws = (unsigned char*)argp<N_IN + 1>();
    volatile LAS unsigned* MISC = (volatile LAS unsigned*)(F.lds + LDSCTL_OFF);
    for (int u = threadIdx.x; u < (LDS_BYTES - LDSCTL_OFF) / 4; u += NTHREADS) ((LAS unsigned*)(F.lds + LDSCTL_OFF))[u] = 0u;
    __syncthreads();
    const int lo = args.ph_lo, hi = args.ph_hi;
    unsigned* barw = (unsigned*)(F.ws + WS_CTL) + CW_BAR;
    XcdBarrier bar; bar.bar = barw; bar.x = 0; bar.st = nullptr;
    if (hi - lo > 1) bar = xcd_barrier_post(barw, MISC + 8);
    bar.wave = F.wave;
#define IN(k) (lo <= (k) && (k) < hi)
#define SEAM(k) do { if (IN(k) && IN((k) + 1)) { xcd_barrier(bar); if (REPS(14) > 1) xcd_barrier(bar); } } while (0)
    unsigned char* ws = F.ws;
    bf16* XN = (bf16*)(ws + WS_XN);
    const float* mod = (const float*)(ws + WS_CTL) + CW_MOD;

    if (IN(0)) { ph0_prologue(F, args, REPS(0)); SEAM(0); }
    if (IN(1)) { for (int rep = 0; rep < REPS(1); ++rep) { ph1_norm_dt(F, args); __syncthreads(); } SEAM(1); }
    if (IN(2)) {
        pg8::Gemm g{XN, (const bf16*)(ws + WS_WIN), M, NPROJ, D}; pg8::StaticOrder S; S.init(M, NPROJ, F.G, (int)blockIdx.x);
        EpiInProj E{ws};
        RepOrder R{S, (S.nwg - S.c + S.G - 1) / S.G, REPS(2)};
        pg8::gemm_phase<EpiInProj, RepOrder, true, true>(F.lds, g, R, E, F.wave);
        SEAM(2);
    }
    if (IN(3)) { ph3_chunk_states(F, args, REPS(13)); __syncthreads(); ph3_convbranch(F, args, REPS(3)); __syncthreads(); SEAM(3); }
    if (IN(4)) {
        if (REPS(4) > 1) ph4_scan(F, WS_YS);
        ph4_scan(F, WS_ST);
        pg8::Gemm g{XN, (const bf16*)(ws + WS_WCV), M, D, D}; pg8::StaticOrder S; S.init(M, D, F.G, (int)blockIdx.x);
        EpiGate<false> E{(bf16*)(ws + WS_TMP), nullptr, (const bf16*)(ws + WS_GATE), 0, nullptr};
        RepOrder R{S, (S.nwg - S.c + S.G - 1) / S.G, REPS(15)};
        pg8::gemm_phase<EpiGate<false>, RepOrder, false, true>(F.lds, g, R, E, F.wave);
        SEAM(4);
    }
    if (IN(5)) { ph5_ssd_out(F, args, REPS(5)); SEAM(5); }
    if (IN(6)) {
        pg8::Gemm g{(const bf16*)(ws + WS_YS), (const bf16*)(ws + WS_WSSM), M, D, DIN}; pg8::StaticOrder S; S.init(M, D, F.G, (int)blockIdx.x);
        LAS float* rt = (LAS float*)(F.lds + RT_OFF);
        EpiGate<true> E{(bf16*)(ws + WS_MG), (const bf16*)(ws + WS_TMP), (const bf16*)(ws + WS_GATE), 1024, rt};
        for (int i = 0;; ++i) {
            OneUnit S1; if (!S.next(i, S1.u)) break;
            if (F.wave < 4) { const int tid = F.wave * 64 + lane_id(); const f32x4 r = *(const f32x4*)((const float*)(ws + WS_RSTD) + (size_t)(S1.u.pm * 256 + tid) * 4);
                *(LAS f32x4*)(rt + tid * 4) = (f32x4){r.x / r.y, r.y / r.z, r.z / r.w, r.w}; }
            asm volatile("s_waitcnt vmcnt(0) lgkmcnt(0)" ::: "memory"); __syncthreads();
            pg8::gemm_phase<EpiGate<true>, OneUnit, false, true>(F.lds, g, S1, E, F.wave);
            __syncthreads();
        }
        SEAM(6);
    }
    if (IN(7)) {
        pg8::Gemm g{(const bf16*)(ws + WS_MG), (const bf16*)(ws + WS_WMIX), M, D, D}; pg8::StaticOrder S; S.init(M, D, F.G, (int)blockIdx.x);
        EpiMix E{(bf16*)(ws + WS_H16), ARG(I_X), (const float*)(ws + WS_CTL) + CW_MODC + 2 * 1024};
        RepOrder R{S, (S.nwg - S.c + S.G - 1) / S.G, REPS(7)};
        pg8::gemm_phase<EpiMix, RepOrder, false, true>(F.lds, g, R, E, F.wave);
        SEAM(7);
    }
    if (IN(8)) { for (int rep = 0; rep < REPS(8); ++rep) { convert_experts(F, args); __syncthreads(); } ph8_router(F, args, REPS(9)); if (IN(8) && IN(10)) xcd_barrier(bar); }
    if (IN(10)) {
        build_tilebase(F);
        const LAS int* tb = (const LAS int*)(F.lds + TB_OFF);
        pg8::Gemm g{(const bf16*)(ws + WS_XN), (const bf16*)(ws + WS_W13), M, NE * 1024, D / 2};
        MoeOrder S{tb, F.G, F.vcu, tb[NE] * 4, 1, (const LAS int*)(F.lds + TOKL_OFF)};
        fill_tokl(F, S);
        EpiUp E{ws + WS_HDN};
        pg8::gemm_phase<EpiUp, MoeOrder, true, true, true, true>(F.lds, g, S, E, F.wave);
        SEAM(10);
    }
    if (IN(11)) {
        build_tilebase(F);
        const LAS int* tb = (const LAS int*)(F.lds + TB_OFF);
        pg8::Gemm g{(const bf16*)(ws + WS_HDN), (const bf16*)(ws + WS_W2), 49152, NE * 1024, DFF / 2};
        MoeOrder S{tb, F.G, F.vcu, tb[NE] * 4, 1, nullptr};
        EpiDown E{ws + WS_YEXP};
        pg8::gemm_phase<EpiDown, MoeOrder, true, true, true>(F.lds, g, S, E, F.wave);
        SEAM(11);
    }
    if (IN(12)) { build_tilebase(F); ph12_final(F, args, REPS(12)); }
#undef IN
#undef SEAM
}

extern "C" void kernel_launch(void* const* d_in, const int* in_sizes, int n_in, void* d_out, int out_size, void* d_ws, size_t ws_size, hipStream_t stream) {
    static int grid = 0;
    if (grid == 0) {
        if (n_in != N_IN || in_sizes[0] != M * D || out_size != M * D || ws_size < WS_END) {
            fprintf(stderr, "kernel_launch: unexpected shapes: n_in %d in0 %d out %d ws %zu (need %zu)\n", n_in, n_in > 0 ? in_sizes[0] : -1, out_size, ws_size, (size_t)WS_END); grid = -1; return; }
        int dev = 0, cus = 0, per_cu = 0;
        if (hipGetDevice(&dev) != hipSuccess || hipDeviceGetAttribute(&cus, hipDeviceAttributeMultiprocessorCount, dev) != hipSuccess) { fprintf(stderr, "kernel_launch: device query failed\n"); grid = -1; return; }
        if (hipFuncSetAttribute((const void*)fwd_kernel, hipFuncAttributeMaxDynamicSharedMemorySize, LDS_BYTES) != hipSuccess) { fprintf(stderr, "kernel_launch: hipFuncSetAttribute failed\n"); grid = -1; return; }
        if (hipOccupancyMaxActiveBlocksPerMultiprocessor(&per_cu, (const void*)fwd_kernel, NTHREADS, LDS_BYTES) != hipSuccess || per_cu < 1) {
            fprintf(stderr, "kernel_launch: the occupancy query admits no workgroup of this kernel per CU (%d); nothing launched\n", per_cu); (void)hipGetLastError(); grid = -1; return; }
        grid = cus;
        if (cus < 192 || (cus & 7)) { fprintf(stderr, "kernel_launch: built for a 256-CU device (the MoE unit table holds 4 units per workgroup); %d CUs: nothing launched\n", cus); grid = -1; return; }
        fprintf(stderr, "kernel_launch: grid %d (cus %d, per_cu %d)\n", grid, cus, per_cu);
    }
    if (grid < 0) return;
    (void)hipMemsetAsync((char*)d_ws + WS_CTL, 0, CTL_ZERO_BYTES, stream);
    Args a{};
    for (int i = 0; i < N_IN; ++i) a.in[i] = (const float*)d_in[i];
    a.out = (float*)d_out; a.ws = (unsigned char*)d_ws;
#if MK_ONE_LAUNCH
    a.ph_lo = 0; a.ph_hi = N_PHASES;
    void* kargs[] = {&a};
    hipError_t e = hipLaunchCooperativeKernel((const void*)fwd_kernel, dim3(grid), dim3(NTHREADS), kargs, LDS_BYTES, stream);
    if (e != hipSuccess) fprintf(stderr, "kernel_launch: cooperative launch failed: %s\n", hipGetErrorString(e));
#else
    for (int ph = 0; ph < N_PHASES; ++ph) {
        a.ph_lo = ph; a.ph_hi = ph + 1;
        hipLaunchKernelGGL(fwd_kernel, dim3(grid), dim3(NTHREADS), LDS_BYTES, stream, a);
    }
#endif
}
```

```cpp
#include <hip/hip_runtime.h>
#include <hip/hip_cooperative_groups.h>
#include <cstdio>
#include <cstdint>
namespace pg8 {
#define PG8_LAS __attribute__((address_space(3)))
typedef unsigned short bf16_t;
typedef short bf16x8 __attribute__((ext_vector_type(8)));
typedef float f32x4 __attribute__((ext_vector_type(4)));
typedef unsigned u32x4 __attribute__((ext_vector_type(4)));
typedef int v4i_ __attribute__((ext_vector_type(4)));
typedef int v8i_ __attribute__((ext_vector_type(8)));
constexpr int BM = 256, BK = 64, HALF = 128, HTB = HALF * BK * 2  , STAGE_BYTES = 8 * HTB, NXCD = 8, WGM = 8;

__host__ __device__ __forceinline__ int lds_byte(int r, int c) { const int st = (r >> 4) * 2 + (c >> 5), rr = r & 15, cc = c & 31, ob = rr * 64 + cc * 2; return st * 1024 + (ob ^ (((ob >> 9) & 1) << 5)); }
__host__ __device__ __forceinline__ void stage_rc(int b, int& R, int& C) { const int st = b / 1024, sb = b % 1024, swz = sb ^ (((sb >> 9) & 1) << 5); R = (st >> 1) * 16 + swz / 64; C = (st & 1) * 32 + (swz % 64) / 2; }
__host__ __device__ __forceinline__ int perm32(int rho) { const int n = rho >> 4, i = rho & 15; return 8 * (i >> 2) + 4 * n + (i & 3); }

struct Unit { int pm, pn; };
struct Gemm { const bf16_t* A; const bf16_t* Bt; int M, N, K; };

struct StaticOrder {
    int nM, nN, nwg, G, c;
    __host__ __device__ void init(int M, int N, int G_, int c_) { nM = M / BM; nN = N / BM; nwg = nM * nN; G = G_; c = c_; }
    __host__ __device__ bool next(int i, Unit& u) const {
        const long L = (long)i * G + c; if (L >= nwg) return false;
        int wgid = (int)L; { const int q = nwg / NXCD, r = nwg % NXCD, xcd = wgid % NXCD, off = wgid / NXCD; wgid = (xcd < r ? xcd * (q + 1) : r * (q + 1) + (xcd - r) * q) + off; }
        const int nig = WGM * nN, gid = wgid / nig, fm = gid * WGM, gsz = (nM - fm) < WGM ? (nM - fm) : WGM;
        u.pm = fm + ((wgid % nig) % gsz); u.pn = (wgid % nig) / gsz; return true;
    }
    __device__ __forceinline__ void a_ready(const Unit&) const {}
    __device__ __forceinline__ void done(const Unit&) const {}
};

__device__ __forceinline__ unsigned cvt_pk_bf16(float lo, float hi) { unsigned r; asm volatile("v_cvt_pk_bf16_f32 %0, %1, %2" : "=v"(r) : "v"(lo), "v"(hi)); return r; }
typedef float f32x2 __attribute__((ext_vector_type(2)));
template <class Epi, class Sched, bool ALIGN_EPI = false, bool SP2 = false, bool FP8 = false, bool GATHER = false>
__device__ __forceinline__ void gemm_phase(PG8_LAS unsigned char* lds, const Gemm g, const Sched& S, const Epi& E, const int wave_in) {
    const int lane = (int)__builtin_amdgcn_mbcnt_hi(~0u, __builtin_amdgcn_mbcnt_lo(~0u, 0u)), wid = wave_in, tid = wid * 64 + lane, wr = wid >> 2, wc = wid & 3, fr = lane & 15, fq = lane >> 4;
    const int K = g.K, nt = K / BK;
    unsigned voffA[2], voffB[2];
#pragma unroll
    for (int i = 0; i < 2; ++i) { int R, C; stage_rc(tid * 16 + i * 8192, R, C); const int Rb = Epi::PERM ? ((R & ~31) + perm32(R & 31)) : R;
        voffA[i] = (unsigned)(R * K + C) * 2u; voffB[i] = (unsigned)(Rb * K + C) * 2u; }
    static_assert(!GATHER || SP2, "GATHER is implemented in the SP2 loop");
    unsigned gA[2][2], ngA[2][2]; int RA[2]; unsigned CA2[2];
#pragma unroll
    for (int i = 0; i < 2; ++i) { int R, C; stage_rc(tid * 16 + i * 8192, R, C); RA[i] = R; CA2[i] = (unsigned)C * 2u; }
    auto load_g = [&](int ui_, unsigned (&dst)[2][2]) {
        if constexpr (GATHER) {
#pragma unroll
            for (int h = 0; h < 2; ++h)
#pragma unroll
                for (int i = 0; i < 2; ++i) dst[h][i] = (unsigned)S.tokl[ui_ * 256 + 128 * h + RA[i]] * (unsigned)(K * 2) + CA2[i];
        }
    };
    const size_t kstep = (size_t)(BK * 2);
    const size_t hstep = (size_t)HALF * K * 2;
    const size_t tstep = 2 * hstep;
    const size_t hstepA = GATHER ? (size_t)0 : hstep, tstepA = GATHER ? (size_t)0 : 2 * hstep;
    const unsigned ldsw = (unsigned)wid * 1024u;
    const int aoff = lds_byte(wr * 64 + fr, fq * 8), boff = lds_byte(wc * 32 + fr, fq * 8);
#define PG8_SA(b, h) (((b) * 2 + (h)) * HTB)
#define PG8_SB(b, h) ((4 + (b) * 2 + (h)) * HTB)
#define PG8_STAGE(bufoff, gbase, voff) do { _Pragma("unroll") for (int _i = 0; _i < 2; ++_i) \
        __builtin_amdgcn_global_load_lds((const unsigned*)((const char*)(gbase) + (voff)[_i]), (PG8_LAS unsigned*)(lds + (bufoff) + ldsw + _i * 8192), 16, 0, 0); } while (0)
#define PG8_STAGE_A(bufoff, gbase, gvoff) do { if constexpr (GATHER) { PG8_STAGE(bufoff, gbase, gvoff); } else { PG8_STAGE(bufoff, gbase, voffA); } } while (0)
#define PG8_LDA(dst, b, h) do { if constexpr (FP8) { _Pragma("unroll") for (int m = 0; m < 4; ++m) dst##8[m] = __builtin_shufflevector(*(const PG8_LAS v4i_*)(lds + PG8_SA(b, h) + aoff + m * 2048), *(const PG8_LAS v4i_*)(lds + PG8_SA(b, h) + aoff + m * 2048 + 1024), 0, 1, 2, 3, 4, 5, 6, 7); } \
        else { _Pragma("unroll") for (int m = 0; m < 4; ++m) _Pragma("unroll") for (int k = 0; k < 2; ++k) dst[m][k] = *(const PG8_LAS bf16x8*)(lds + PG8_SA(b, h) + aoff + m * 2048 + k * 1024); } } while (0)
#define PG8_LDB(dst, b, h) do { if constexpr (FP8) { _Pragma("unroll") for (int n = 0; n < 2; ++n) dst##8[n] = __builtin_shufflevector(*(const PG8_LAS v4i_*)(lds + PG8_SB(b, h) + boff + n * 2048), *(const PG8_LAS v4i_*)(lds + PG8_SB(b, h) + boff + n * 2048 + 1024), 0, 1, 2, 3, 4, 5, 6, 7); } \
        else { _Pragma("unroll") for (int n = 0; n < 2; ++n) _Pragma("unroll") for (int k = 0; k < 2; ++k) dst[n][k] = *(const PG8_LAS bf16x8*)(lds + PG8_SB(b, h) + boff + n * 2048 + k * 1024); } } while (0)
#define PG8_MMA(ai, bj, At, Bt) do { __builtin_amdgcn_s_setprio(1); \
        if constexpr (FP8) {   \
              \
            _Pragma("unroll") for (int m = 0; m < 4; ++m) _Pragma("unroll") for (int n = 0; n < 2; ++n) \
                asm volatile("v_mfma_scale_f32_16x16x128_f8f6f4 %0, %1, %2, %0, %3, %4 op_sel_hi:[0,0,0]" : "+v"(acc[ai][bj][m][n]) : "v"(Bt##8[n]), "v"(At##8[m]), "v"(scale_w), "v"(scale_x)); \
        } else { \
        _Pragma("unroll") for (int m = 0; m < 4; ++m) _Pragma("unroll") for (int n = 0; n < 2; ++n) _Pragma("unroll") for (int k = 0; k < 2; ++k) \
        acc[ai][bj][m][n] = __builtin_amdgcn_mfma_f32_16x16x32_bf16(Bt[n][k], At[m][k], acc[ai][bj][m][n], 0, 0, 0); } __builtin_amdgcn_s_setprio(0); } while (0)
#define PG8_WAIT_V(n) asm volatile("s_waitcnt vmcnt(" #n ")" ::: "memory")
#define PG8_WAIT_L(n) asm volatile("s_waitcnt lgkmcnt(" #n ")" ::: "memory")
#define PG8_BAR __builtin_amdgcn_s_barrier()
#define PG8_SCHED __builtin_amdgcn_sched_barrier(0)
    Unit cur, nxt; int ui = 0;
    if (!S.next(0, cur)) return;
    f32x4 acc[2][2][4][2];
#pragma unroll
    for (int a = 0; a < 2; ++a)
#pragma unroll
        for (int b = 0; b < 2; ++b)
#pragma unroll
            for (int m = 0; m < 4; ++m)
#pragma unroll
                for (int n = 0; n < 2; ++n) acc[a][b][m][n] = (f32x4){0.f, 0.f, 0.f, 0.f};
    const int scale_w = 0x79797979, scale_x = 0x7f7f7f7f;
    bf16x8 At[4][2], B0[2][2], B1[2][2]; v8i_ At8[4], B08[2], B18[2];
    const char* cA = (const char*)g.A + (size_t)cur.pm * tstepA; const char* cB = (const char*)g.Bt + (size_t)cur.pn * tstep;
    load_g(0, gA);
    S.a_ready(cur);
    if constexpr (SP2) {
        PG8_STAGE(PG8_SB(0, 0), cB, voffB); PG8_STAGE(PG8_SB(0, 1), cB + hstep, voffB); PG8_STAGE_A(PG8_SA(0, 0), cA, gA[0]); PG8_STAGE_A(PG8_SA(0, 1), cA + hstepA, gA[1]);
        if (wr == 1) PG8_BAR;
        PG8_WAIT_V(2); PG8_BAR;
        PG8_STAGE(PG8_SB(1, 0), cB + kstep, voffB); PG8_STAGE_A(PG8_SA(1, 0), cA + kstep, gA[0]); PG8_STAGE(PG8_SB(1, 1), cB + hstep + kstep, voffB);
        PG8_WAIT_V(6); PG8_BAR;
    } else {
        PG8_STAGE(PG8_SB(0, 0), cB, voffB); PG8_STAGE(PG8_SA(0, 0), cA, voffA); PG8_STAGE(PG8_SB(0, 1), cB + hstep, voffB); PG8_STAGE(PG8_SA(0, 1), cA + hstep, voffA);
        if (wr == 1) PG8_BAR;
        PG8_WAIT_V(4); PG8_BAR;
        PG8_STAGE(PG8_SB(1, 0), cB + kstep, voffB); PG8_STAGE(PG8_SA(1, 0), cA + kstep, voffA); PG8_STAGE(PG8_SB(1, 1), cB + hstep + kstep, voffB);
        PG8_WAIT_V(6); PG8_BAR;
    }
    for (;;) {
        const bool has_next = S.next(ui + 1, nxt);
        const char* nA = has_next ? (const char*)g.A + (size_t)nxt.pm * tstepA : cA; const char* nB = has_next ? (const char*)g.Bt + (size_t)nxt.pn * tstep : cB;
        if constexpr (GATHER) { if (has_next) load_g(ui + 1, ngA); else {
#pragma unroll
            for (int h = 0; h < 2; ++h)
#pragma unroll
                for (int i = 0; i < 2; ++i) ngA[h][i] = gA[h][i]; } }
        for (int t = 0; t < nt; t += 2) {
            const bool last = (t == nt - 2);
            const char* a1 = cA + (size_t)(t + 1) * kstep;
            const char* a2 = last ? nA : cA + (size_t)(t + 2) * kstep; const char* b2 = last ? nB : cB + (size_t)(t + 2) * kstep;
            const char* a3 = a2 + kstep; const char* b3 = b2 + kstep;
            if (last && has_next) S.a_ready(nxt);
            unsigned sN[2][2];
#pragma unroll
            for (int h = 0; h < 2; ++h)
#pragma unroll
                for (int i = 0; i < 2; ++i) sN[h][i] = last ? ngA[h][i] : gA[h][i];
            if constexpr (SP2) {
            PG8_LDB(B0, 0, 0); PG8_LDB(B1, 0, 1); PG8_SCHED; PG8_LDA(At, 0, 0); PG8_STAGE_A(PG8_SA(1, 1), a1 + hstepA, gA[1]);
            PG8_WAIT_V(8); PG8_WAIT_L(0); PG8_BAR; PG8_MMA(0, 0, At, B0); PG8_MMA(0, 1, At, B1); PG8_BAR; PG8_SCHED;
            PG8_LDA(At, 0, 1); PG8_STAGE(PG8_SB(0, 0), b2, voffB); PG8_STAGE(PG8_SB(0, 1), b2 + hstep, voffB); PG8_STAGE_A(PG8_SA(0, 0), a2, sN[0]);
            PG8_WAIT_V(8); PG8_WAIT_L(0); PG8_BAR; PG8_MMA(1, 0, At, B0); PG8_MMA(1, 1, At, B1); PG8_BAR; PG8_SCHED;
            PG8_LDB(B0, 1, 0); PG8_LDB(B1, 1, 1); PG8_SCHED; PG8_LDA(At, 1, 0); PG8_STAGE_A(PG8_SA(0, 1), a2 + hstepA, sN[1]);
            PG8_WAIT_V(8); PG8_WAIT_L(0); PG8_BAR; PG8_MMA(0, 0, At, B0); PG8_MMA(0, 1, At, B1); PG8_BAR; PG8_SCHED;
            PG8_LDA(At, 1, 1); PG8_STAGE(PG8_SB(1, 0), b3, voffB); PG8_STAGE(PG8_SB(1, 1), b3 + hstep, voffB); PG8_STAGE_A(PG8_SA(1, 0), a3, sN[0]);
            PG8_WAIT_V(8); PG8_WAIT_L(0); PG8_BAR; PG8_MMA(1, 0, At, B0); PG8_MMA(1, 1, At, B1); PG8_BAR; PG8_SCHED;
            } else {
            PG8_LDB(B0, 0, 0); PG8_SCHED; PG8_LDA(At, 0, 0); PG8_STAGE(PG8_SA(1, 1), a1 + hstep, voffA);
            PG8_WAIT_L(8); PG8_BAR; PG8_WAIT_L(0); PG8_MMA(0, 0, At, B0); PG8_BAR; PG8_SCHED;
            PG8_LDB(B1, 0, 1); PG8_STAGE(PG8_SB(0, 0), b2, voffB);
            PG8_BAR; PG8_WAIT_L(0); PG8_MMA(0, 1, At, B1); PG8_BAR;
            PG8_LDA(At, 0, 1); PG8_STAGE(PG8_SA(0, 0), a2, voffA);
            PG8_BAR; PG8_WAIT_L(0); PG8_MMA(1, 0, At, B0); PG8_BAR; PG8_SCHED;
            PG8_STAGE(PG8_SB(0, 1), b2 + hstep, voffB);
            PG8_WAIT_V(6); PG8_BAR; PG8_MMA(1, 1, At, B1); PG8_BAR;
            PG8_LDB(B0, 1, 0); PG8_SCHED; PG8_LDA(At, 1, 0); PG8_STAGE(PG8_SA(0, 1), a2 + hstep, voffA);
            PG8_WAIT_L(8); PG8_BAR; PG8_WAIT_L(0); PG8_MMA(0, 0, At, B0); PG8_BAR; PG8_SCHED;
            PG8_LDB(B1, 1, 1); PG8_STAGE(PG8_SB(1, 0), b3, voffB);
            PG8_BAR; PG8_WAIT_L(0); PG8_MMA(0, 1, At, B1); PG8_BAR;
            PG8_LDA(At, 1, 1); PG8_STAGE(PG8_SA(1, 0), a3, voffA);
            PG8_BAR; PG8_WAIT_L(0); PG8_MMA(1, 0, At, B0); PG8_BAR; PG8_SCHED;
            PG8_STAGE(PG8_SB(1, 1), b3 + hstep, voffB);
            PG8_WAIT_V(6); PG8_BAR; PG8_MMA(1, 1, At, B1); PG8_BAR;
            }
            if constexpr (Epi::KHOOK) { if ((((t + 2) & 7) == 0) && (t + 2 < nt)) E.khook(acc, ((t + 2) >> 3) - 1, wr, fr); }
        }
        if constexpr (ALIGN_EPI) { if (wr == 0) PG8_BAR; }
        if constexpr (FP8) {
            asm volatile("s_nop 15\n\ts_nop 15" : "+v"(acc[0][0][0][0]), "+v"(acc[0][0][0][1]), "+v"(acc[0][0][1][0]), "+v"(acc[0][0][1][1]), "+v"(acc[0][0][2][0]), "+v"(acc[0][0][2][1]), "+v"(acc[0][0][3][0]), "+v"(acc[0][0][3][1]), "+v"(acc[0][1][0][0]), "+v"(acc[0][1][0][1]), "+v"(acc[0][1][1][0]), "+v"(acc[0][1][1][1]), "+v"(acc[0][1][2][0]), "+v"(acc[0][1][2][1]), "+v"(acc[0][1][3][0]), "+v"(acc[0][1][3][1]));
            asm volatile("s_nop 0" : "+v"(acc[1][0][0][0]), "+v"(acc[1][0][0][1]), "+v"(acc[1][0][1][0]), "+v"(acc[1][0][1][1]), "+v"(acc[1][0][2][0]), "+v"(acc[1][0][2][1]), "+v"(acc[1][0][3][0]), "+v"(acc[1][0][3][1]), "+v"(acc[1][1][0][0]), "+v"(acc[1][1][0][1]), "+v"(acc[1][1][1][0]), "+v"(acc[1][1][1][1]), "+v"(acc[1][1][2][0]), "+v"(acc[1][1][2][1]), "+v"(acc[1][1][3][0]), "+v"(acc[1][1][3][1]));
        }
        if constexpr (!Epi::AFTER_DRAIN) { E(acc, cur, wr, wc, fr, fq); S.done(cur); }
        if (!has_next) break;
#pragma unroll
        for (int a = 0; a < 2; ++a)
#pragma unroll
            for (int b = 0; b < 2; ++b)
#pragma unroll
                for (int m = 0; m < 4; ++m)
#pragma unroll
                    for (int n = 0; n < 2; ++n) acc[a][b][m][n] = (f32x4){0.f, 0.f, 0.f, 0.f};
        cur = nxt; cA = nA; cB = nB; ++ui;
        if constexpr (GATHER) {
#pragma unroll
            for (int h = 0; h < 2; ++h)
#pragma unroll
                for (int i = 0; i < 2; ++i) gA[h][i] = ngA[h][i]; }
        if constexpr (ALIGN_EPI) { if (wr == 1) PG8_BAR; }
    }
    PG8_WAIT_V(0);
    if constexpr (!ALIGN_EPI) { if (wr == 0) PG8_BAR; }
    PG8_BAR;
    if constexpr (Epi::AFTER_DRAIN) { E.fused(acc, cur, wr, wc, fr, fq, lds, wid, lane); S.done(cur); }
#undef PG8_SA
#undef PG8_SB
#undef PG8_STAGE
#undef PG8_STAGE_A
#undef PG8_LDA
#undef PG8_LDB
#undef PG8_MMA
#undef PG8_WAIT_V
#undef PG8_WAIT_L
#undef PG8_BAR
#undef PG8_SCHED
}
}

#define DI __device__ __forceinline__
#define GAS __attribute__((address_space(1)))
#define LAS __attribute__((address_space(3)))
typedef unsigned short bf16;
typedef unsigned v4u __attribute__((ext_vector_type(4)));
typedef unsigned v2u __attribute__((ext_vector_type(2)));
typedef float f32x4 __attribute__((ext_vector_type(4)));
typedef float f32x16 __attribute__((ext_vector_type(16)));
typedef short bf16x8 __attribute__((ext_vector_type(8)));
typedef __bf16 bf2v __attribute__((ext_vector_type(2)));
typedef float f2v __attribute__((ext_vector_type(2)));
typedef GAS unsigned gu32;

constexpr int NWAVES = 8, NTHREADS = 512;
constexpr int M = 16384, D = 1024, DIN = 2048, NH = 32, HD = 64, NGRP = 4, NST = 128, XBCW = 3072;
constexpr int NPROJ = 9216, WIN_LD = 9248;
constexpr int LCH = 128, NCH = M / LCH;
constexpr int NE = 64, DFF = 512;
constexpr float EPS = 1e-6f;
constexpr float LOG2E = 1.4426950408889634f;

constexpr size_t MiB = 1u << 20;
constexpr size_t WS_CTL = 0, CTL_ZERO_BYTES = 65536;
constexpr size_t WS_WIN = 1 * MiB, WS_WDT = 19 * MiB, WS_WCV = 20 * MiB, WS_WMIX = 22 * MiB, WS_WSSM = 24 * MiB;
constexpr size_t WS_RSTD = 31 * MiB + 524288;
constexpr size_t WS_DT = 28 * MiB, WS_CD = 30 * MiB, WS_WRH = 30 * MiB + 65536, WS_WRL = WS_WRH + 262144, WS_ROUTE = 31 * MiB;
constexpr size_t WS_ST = 32 * MiB, WS_YS = 96 * MiB, WS_TMP = 160 * MiB, WS_MG = 192 * MiB;
constexpr size_t WS_W13 = 32 * MiB, WS_W2 = 160 * MiB, WS_H16 = 96 * MiB;
constexpr size_t WS_XN8 = 32 * MiB, WS_W8IN = 48 * MiB;
constexpr size_t WS_XN = 224 * MiB;
constexpr size_t WS_U = 256 * MiB, WS_ZS = 288 * MiB, WS_XBC = 352 * MiB, WS_GATE = 448 * MiB;
constexpr size_t WS_LIST = 256 * MiB, WS_HDN = 352 * MiB, WS_YEXP = 400 * MiB;
constexpr size_t WS_END = 512 * MiB;
constexpr int CW_BAR = 4096;
constexpr int CW_CNT = 8192;
constexpr int CW_MODC = 40960;
constexpr int CW_MOD = 16384;

constexpr int RING_BYTES = 131072;
constexpr int LDSCTL_OFF = 147456;
constexpr int TB_OFF = LDSCTL_OFF + 256;
constexpr int CNTL_OFF = TB_OFF + 320;
constexpr int TOKL_OFF = LDSCTL_OFF + 1024;
constexpr int RT_OFF = 148480;
constexpr int LDS_BYTES = 152576;

#define LDS_WAIT() asm volatile("s_waitcnt lgkmcnt(0)" ::: "memory")
#define VM_WAIT() asm volatile("s_waitcnt vmcnt(0)" ::: "memory")

DI unsigned pk2(float lo, float hi) { f2v v = {lo, hi}; return __builtin_bit_cast(unsigned, __builtin_convertvector(v, bf2v)); }
DI unsigned pk4_fp8(float a, float b, float c, float d) {
    a = __builtin_fminf(__builtin_fmaxf(a, -448.f), 448.f); b = __builtin_fminf(__builtin_fmaxf(b, -448.f), 448.f);
    c = __builtin_fminf(__builtin_fmaxf(c, -448.f), 448.f); d = __builtin_fminf(__builtin_fmaxf(d, -448.f), 448.f);
    unsigned w = 0u; w = __builtin_amdgcn_cvt_pk_fp8_f32(a, b, w, false); w = __builtin_amdgcn_cvt_pk_fp8_f32(c, d, w, true); return w; }
DI unsigned pk4_fp8_nc(float a, float b, float c, float d) { unsigned w = 0u; w = __builtin_amdgcn_cvt_pk_fp8_f32(a, b, w, false); w = __builtin_amdgcn_cvt_pk_fp8_f32(c, d, w, true); return w; }
DI float bflo(unsigned u) { return __uint_as_float(u << 16); }
DI float bfhi(unsigned u) { return __uint_as_float(u & 0xffff0000u); }
DI float sigmoidf_(float x) { return __builtin_amdgcn_rcpf(1.f + __builtin_amdgcn_exp2f(x * -LOG2E)); }
DI float siluf_(float x) { return x * __builtin_amdgcn_rcpf(1.f + __builtin_amdgcn_exp2f(x * -LOG2E)); }
DI float wave_sum(float v) {
#pragma unroll
    for (int o = 1; o < 64; o <<= 1) v += __shfl_xor(v, o);
    return v;
}
DI f32x4 mod4(const float* modp, int k) { return (*(const f32x4*)(modp + k) + *(const f32x4*)(modp + 6144 + k)) + (*(const f32x4*)(modp + 2 * 6144 + k) + *(const f32x4*)(modp + 3 * 6144 + k)); }
DI int crow(int reg, int hh) { return (reg & 3) + 8 * (reg >> 2) + 4 * hh; }
DI int swz(int row, int chunk) { return chunk ^ ((row ^ (row >> 3)) & 15); }
#define MFMA32(a, b, c) __builtin_amdgcn_mfma_f32_32x32x16_bf16((a), (b), (c), 0, 0, 0)

DI int lane_id() { return (int)__builtin_amdgcn_mbcnt_hi(~0u, __builtin_amdgcn_mbcnt_lo(~0u, 0u)); }
#define XB_TMO      128
#define XB_XCNT(j)  (256  + 64 * (j))
#define XB_XSUB(j)  (1280 + 64 * (j))
#define XB_XGEN(j)  (2304 + 64 * (j))
#define XB_TOP      3328
#define XB_TOPGEN   3392
#define XCD_BAR_WORDS 3456
#define XB_SPIN_CAP (1u << 18)
DI unsigned xb_ld(unsigned* p)              { return __hip_atomic_load(p, __ATOMIC_RELAXED, __HIP_MEMORY_SCOPE_AGENT); }
DI unsigned xb_add(unsigned* p, unsigned v) { return __hip_atomic_fetch_add(p, v, __ATOMIC_RELAXED, __HIP_MEMORY_SCOPE_AGENT); }
DI unsigned xb_xcc_id() { return (unsigned)__builtin_amdgcn_s_getreg((3 << 11) | 20) & 0xFu; }
#define XB_SPIN(cond, bar) do { unsigned _sp = 0; while (cond) { __builtin_amdgcn_s_sleep(1); \
    if ((++_sp & 255u) == 0u) { if (xb_ld(&(bar)[XB_TMO])) break; if (_sp > XB_SPIN_CAP) { atomicAdd(&(bar)[XB_TMO], 1u); break; } } } } while (0)
struct XcdBarrier { unsigned* bar; unsigned x; volatile LAS unsigned* st; int wave; };
DI XcdBarrier xcd_barrier_post(unsigned* bar, volatile LAS unsigned* st) {
    XcdBarrier b; b.bar = bar; b.x = xb_xcc_id(); b.st = st; b.wave = 0;
    if (threadIdx.x == 0) (void)xb_add(&bar[XB_XCNT(b.x)], 1u);
    return b;
}
DI void xcd_barrier_complete(unsigned* bar, unsigned x, unsigned& nloc, unsigned& nx) {
    const unsigned G = gridDim.x * gridDim.y * gridDim.z;
    unsigned sum, cnt, mine, sp = 0u;
    for (;;) {
        sum = 0u; cnt = 0u; mine = 0u;
#pragma unroll
        for (unsigned j = 0; j < 16; ++j) { const unsigned c = xb_ld(&bar[XB_XCNT(j)]); sum += c; cnt += (c > 0u) ? 1u : 0u; mine = (j == x) ? c : mine; }
        if (sum == G) break;
        __builtin_amdgcn_s_sleep(1);
        if ((++sp & 255u) == 0u) { if (xb_ld(&bar[XB_TMO])) break; if (sp > XB_SPIN_CAP) { atomicAdd(&bar[XB_TMO], 1u); break; } }
    }
    nloc = mine > 0u ? mine : 1u; nx = cnt > 0u ? cnt : 1u;
}
DI void xcd_barrier(const XcdBarrier& b) {
    asm volatile("s_waitcnt vmcnt(0)" ::: "memory");
    __syncthreads();
    if (b.wave == 0 && lane_id() == 0) {
        unsigned* bar = b.bar;
        __builtin_amdgcn_s_waitcnt(0);
        unsigned nloc = b.st[0], nx = b.st[1];
        if (nloc == 0u) { xcd_barrier_complete(bar, b.x, nloc, nx); b.st[0] = nloc; b.st[1] = nx; }
        const unsigned old = xb_add(&bar[XB_XSUB(b.x)], 1u);
        const unsigned gen = old / nloc;
        if (old + 1u == (gen + 1u) * nloc) {
            __builtin_amdgcn_fence(__ATOMIC_RELEASE, "agent");
            asm volatile("s_waitcnt vmcnt(0)" ::: "memory");
            const unsigned og = xb_add(&bar[XB_TOP], 1u);
            const unsigned tg = og / nx;
            if (og + 1u == (tg + 1u) * nx) xb_add(&bar[XB_TOPGEN], 1u);
            else XB_SPIN(xb_ld(&bar[XB_TOPGEN]) == tg, bar);
            __builtin_amdgcn_fence(__ATOMIC_ACQUIRE, "agent");
            xb_add(&bar[XB_XGEN(b.x)], 1u);
            asm volatile("s_waitcnt vmcnt(0)" ::: "memory");
        } else {
            XB_SPIN(xb_ld(&bar[XB_XGEN(b.x)]) == gen, bar);
            __builtin_amdgcn_fence(__ATOMIC_ACQUIRE, "agent");
            asm volatile("s_waitcnt vmcnt(0)" ::: "memory");
        }
    }
    __syncthreads();
}

enum { I_X = 0, I_C, I_WADA, I_BADA, I_N1G, I_WIN, I_CVW, I_CVB, I_LNG, I_LNB, I_WCV, I_SCW, I_SCB, I_DTB, I_ALOG, I_DSKIP, I_SNG, I_WSSM, I_WMIX,
       I_N2G, I_WGRP, I_BGRP, I_WER, I_BER, I_W1, I_W3, I_W2, I_FG, N_IN };
struct Args { const float* in[N_IN]; float* out; unsigned char* ws; int ph_lo, ph_hi; };

template <int I> DI const float* argp() {
    auto kp = __builtin_amdgcn_kernarg_segment_ptr();
    unsigned long long v;
    asm volatile("s_load_dwordx2 %0, %1, %2\n\ts_waitcnt lgkmcnt(0)" : "=s"(v) : "s"(kp), "i"(I * 8));
    return (const float*)(const GAS float*)v;
}
#define ARG(i) argp<i>()
struct Ctx {
    LAS unsigned char* lds;
    int wave, vcu, G, xcd, xj;
    unsigned char* ws;
};

DI int xcd_unit(int x, int j, int gx, int i, int N) { const int u = i * gx + j; return (u < (N >> 3)) ? x * (N >> 3) + u : -1; }
DI int inproj_tile(int p) { return p < 8 ? p + 28 : p - 8; }
constexpr int NP8 = 16;
struct EpiInProj {
    static constexpr bool PERM = true, AFTER_DRAIN = false, KHOOK = false;
    unsigned char* ws; int p0;
    DI void operator()(const pg8::f32x4 (&acc)[2][2][4][2], const pg8::Unit& u, int wr, int wc, int fr, int fq) const {
        const int pn = inproj_tile(u.pn + p0), row0 = u.pm * 256 + wr * 64 + fr;
        if (pn < 8) {
            bf16* U = (bf16*)(ws + WS_U);
#pragma unroll
            for (int ai = 0; ai < 2; ++ai)
#pragma unroll
                for (int m = 0; m < 4; ++m) {
                    bf16* rowp = U + (size_t)(row0 + ai * 128 + m * 16) * D + pn * 128 + wc * 16 + fq * 4;
#pragma unroll
                    for (int bj = 0; bj < 2; ++bj) { const pg8::f32x4 a = acc[ai][bj][m][0], b = acc[ai][bj][m][1];
                        v2u w; w.x = pk2(a[0] * sigmoidf_(b[0]), a[1] * sigmoidf_(b[1])); w.y = pk2(a[2] * sigmoidf_(b[2]), a[3] * sigmoidf_(b[3]));
                        *(v2u*)(rowp + bj * 64) = w; } }
        } else {
            const bool isz = pn < 16, isx = (pn >= 16) && (pn < 28);
            const size_t boff = isz ? WS_ZS : (isx ? WS_XBC : WS_GATE);
            const int ldc = isx ? XBCW : DIN;
            const int colt = (pn - (isz ? 8 : (isx ? 16 : 28))) * 256;
            bf16* base = (bf16*)(ws + boff);
            const int col0 = colt + wc * 32 + fq * 8;
#pragma unroll
            for (int ai = 0; ai < 2; ++ai)
#pragma unroll
                for (int m = 0; m < 4; ++m) {
                    bf16* rowp = base + (size_t)(row0 + ai * 128 + m * 16) * ldc + col0;
#pragma unroll
                    for (int bj = 0; bj < 2; ++bj) { pg8::f32x4 v0 = acc[ai][bj][m][0], v1 = acc[ai][bj][m][1];
                        if (!isx) {
#pragma unroll
                            for (int i = 0; i < 4; ++i) { const float s0 = sigmoidf_(v0[i]), s1 = sigmoidf_(v1[i]); v0[i] = isz ? v0[i] * s0 : s0; v1[i] = isz ? v1[i] * s1 : s1; }
                        }
                        v4u w; w.x = pk2(v0[0], v0[1]); w.y = pk2(v0[2], v0[3]); w.z = pk2(v1[0], v1[1]); w.w = pk2(v1[2], v1[3]);
                        *(v4u*)(rowp + bj * 128) = w; } }
        }
    }
};
template <bool NORM> struct EpiGate {
    static constexpr bool PERM = true, AFTER_DRAIN = false, KHOOK = NORM;
    bf16* O; const bf16* P; const bf16* GATE; int gcol; const LAS float* rt;
    DI void khook(pg8::f32x4 (&acc)[2][2][4][2], int b, int wr, int fr) const {
#pragma unroll
        for (int ai = 0; ai < 2; ++ai)
#pragma unroll
            for (int m = 0; m < 4; ++m) { const float f = rt[(ai * 128 + wr * 64 + m * 16 + fr) * 4 + b];
#pragma unroll
                for (int bj = 0; bj < 2; ++bj)
#pragma unroll
                    for (int n = 0; n < 2; ++n) acc[ai][bj][m][n] = acc[ai][bj][m][n] * f; }
    }
    DI void operator()(const pg8::f32x4 (&acc)[2][2][4][2], const pg8::Unit& u, int wr, int wc, int fr, int fq) const {
        const int row0 = u.pm * 256 + wr * 64 + fr, col0 = u.pn * 256 + wc * 32 + fq * 8;
#pragma unroll
        for (int ai = 0; ai < 2; ++ai)
#pragma unroll
            for (int m = 0; m < 4; ++m) { const size_t r = (size_t)(row0 + ai * 128 + m * 16);
                float f = 1.0f; if (NORM) f = rt[(ai * 128 + wr * 64 + m * 16 + fr) * 4 + 3];
#pragma unroll
                for (int bj = 0; bj < 2; ++bj) { const int c = col0 + bj * 128;
                    const v4u g = *(const v4u*)(GATE + r * (2 * D) + gcol + c);
                    pg8::f32x4 v0 = acc[ai][bj][m][0] * f, v1 = acc[ai][bj][m][1] * f;
                    float o[8] = {v0[0] * bflo(g.x), v0[1] * bfhi(g.x), v0[2] * bflo(g.y), v0[3] * bfhi(g.y), v1[0] * bflo(g.z), v1[1] * bfhi(g.z), v1[2] * bflo(g.w), v1[3] * bfhi(g.w)};
                    if (P) { const v4u p = *(const v4u*)(P + r * D + c);
                        o[0] += bflo(p.x); o[1] += bfhi(p.x); o[2] += bflo(p.y); o[3] += bfhi(p.y); o[4] += bflo(p.z); o[5] += bfhi(p.z); o[6] += bflo(p.w); o[7] += bfhi(p.w); }
                    v4u w; w.x = pk2(o[0], o[1]); w.y = pk2(o[2], o[3]); w.z = pk2(o[4], o[5]); w.w = pk2(o[6], o[7]);
                    *(v4u*)(O + r * D + c) = w; } }
    }
};
struct EpiMix {
    static constexpr bool PERM = true, AFTER_DRAIN = false, KHOOK = false;
    bf16* H; const float* X; const float* g1;
    DI void operator()(const pg8::f32x4 (&acc)[2][2][4][2], const pg8::Unit& u, int wr, int wc, int fr, int fq) const {
        const int row0 = u.pm * 256 + wr * 64 + fr, col0 = u.pn * 256 + wc * 32 + fq * 8;
#pragma unroll
        for (int bj = 0; bj < 2; ++bj) { const int c = col0 + bj * 128;
            const f32x4 ga = *(const f32x4*)(g1 + c), gb = *(const f32x4*)(g1 + c + 4);
#pragma unroll
            for (int ai = 0; ai < 2; ++ai)
#pragma unroll
                for (int m = 0; m < 4; ++m) { const size_t off = (size_t)(row0 + ai * 128 + m * 16) * D + c;
                    const f32x4 xa = __builtin_nontemporal_load((const f32x4*)(X + off)), xb = __builtin_nontemporal_load((const f32x4*)(X + off + 4));
                    const f32x4 ha = xa + ga * acc[ai][bj][m][0], hb = xb + gb * acc[ai][bj][m][1];
                    v4u w; w.x = pk2(ha.x, ha.y); w.y = pk2(ha.z, ha.w); w.z = pk2(hb.x, hb.y); w.w = pk2(hb.z, hb.w);
                    *(v4u*)(H + off) = w; } }
    }
};
struct EpiUp {
    static constexpr bool PERM = true, AFTER_DRAIN = false, KHOOK = false;
    unsigned char* HDN;
    DI void operator()(const pg8::f32x4 (&acc)[2][2][4][2], const pg8::Unit& u, int wr, int wc, int fr, int fq) const {
        const int j = u.pn & 3, row0 = u.pm * 256 + wr * 64 + fr, col0 = j * 128 + wc * 16 + fq * 4;
#pragma unroll
        for (int ai = 0; ai < 2; ++ai)
#pragma unroll
            for (int m = 0; m < 4; ++m) { unsigned char* rowp = HDN + (size_t)(row0 + ai * 128 + m * 16) * DFF + col0;
#pragma unroll
                for (int bj = 0; bj < 2; ++bj) { const pg8::f32x4 a = acc[ai][bj][m][0], b = acc[ai][bj][m][1];
                    *(unsigned*)(rowp + bj * 64) = pk4_fp8(siluf_(a[0]) * b[0], siluf_(a[1]) * b[1], siluf_(a[2]) * b[2], siluf_(a[3]) * b[3]); } }
    }
};
struct EpiDown {
    static constexpr bool PERM = true, AFTER_DRAIN = false, KHOOK = false;
    unsigned char* Y;
    DI void operator()(const pg8::f32x4 (&acc)[2][2][4][2], const pg8::Unit& u, int wr, int wc, int fr, int fq) const {
        const int j = u.pn & 3, row0 = u.pm * 256 + wr * 64 + fr, col0 = j * 256 + wc * 32 + fq * 8;
#pragma unroll
        for (int ai = 0; ai < 2; ++ai)
#pragma unroll
            for (int m = 0; m < 4; ++m) { unsigned char* rowp = Y + (size_t)(row0 + ai * 128 + m * 16) * D + col0;
#pragma unroll
                for (int bj = 0; bj < 2; ++bj) { const pg8::f32x4 v0 = acc[ai][bj][m][0] * 16.0f, v1 = acc[ai][bj][m][1] * 16.0f;
                    v2u w; w.x = pk4_fp8(v0[0], v0[1], v0[2], v0[3]); w.y = pk4_fp8(v1[0], v1[1], v1[2], v1[3]);
                    *(v2u*)(rowp + bj * 128) = w; } }
    }
};
struct MoeOrder {
    const LAS int* tb; int G, c, total, reps; const LAS int* tokl;
    DI bool next(int i0, pg8::Unit& u) const {
        const int n = (total - c + G - 1) / G; if (n <= 0 || i0 >= n * reps) return false;
        const int i = i0 % n; const int uu = i * G + c;
        const int T = uu >> 2; int e = 0;
        while (e < NE - 1 && tb[e + 1] <= T) ++e;
        u.pm = T; u.pn = 4 * e + (uu & 3); return true;
    }
    DI void a_ready(const pg8::Unit&) const {}
    DI void done(const pg8::Unit&) const {}
};

struct OneUnit { pg8::Unit u;
    DI bool next(int i, pg8::Unit& o) const { if (i != 0) return false; o = u; return true; }
    DI void a_ready(const pg8::Unit&) const {}
    DI void done(const pg8::Unit&) const {} };

template <class SrcF>
DI void transpose_item(SrcF src, int K, bf16* WT, LAS float* scr, int kb, int n0, int lane) {
    const int k0 = 64 * kb;
#pragma unroll 8
    for (int i = 0; i < 32; ++i) { const int kk = 2 * i + (lane >> 5); scr[kk * 33 + (lane & 31)] = src(k0 + kk, n0 + (lane & 31)); }
    LDS_WAIT(); asm volatile("" ::: "memory");
    const int c = lane & 7;
#pragma unroll
    for (int j = 0; j < 4; ++j) { const int n = (lane >> 3) + 8 * j; const LAS float* s = scr + (8 * c) * 33 + n;
        v4u o; o.x = pk2(s[0 * 33], s[1 * 33]); o.y = pk2(s[2 * 33], s[3 * 33]); o.z = pk2(s[4 * 33], s[5 * 33]); o.w = pk2(s[6 * 33], s[7 * 33]);
        *(v4u*)(WT + (size_t)(n0 + n) * K + k0 + 8 * c) = o; }
    LDS_WAIT(); asm volatile("" ::: "memory");
}

template <class SrcF>
DI void transpose_item8(SrcF src, int K, unsigned char* WT, LAS float* scr, int kb, int n0, int lane) {
    const int k0 = 64 * kb;
#pragma unroll 8
    for (int i = 0; i < 32; ++i) { const int kk = 2 * i + (lane >> 5); scr[kk * 33 + (lane & 31)] = src(k0 + kk, n0 + (lane & 31)) * 64.0f; }
    LDS_WAIT(); asm volatile("" ::: "memory");
#pragma unroll
    for (int i = 0; i < 2; ++i) { const int p = lane + 64 * i, n = p >> 2, c = p & 3; const LAS float* s = scr + (16 * c) * 33 + n;
        v4u o; o.x = pk4_fp8(s[0 * 33], s[1 * 33], s[2 * 33], s[3 * 33]); o.y = pk4_fp8(s[4 * 33], s[5 * 33], s[6 * 33], s[7 * 33]);
        o.z = pk4_fp8(s[8 * 33], s[9 * 33], s[10 * 33], s[11 * 33]); o.w = pk4_fp8(s[12 * 33], s[13 * 33], s[14 * 33], s[15 * 33]);
        *(v4u*)(WT + (size_t)(n0 + n) * K + k0 + 16 * c) = o; }
    LDS_WAIT(); asm volatile("" ::: "memory");
}

DI void ph0_prologue(const Ctx& F, const Args& a, int reps) {
    const int gw = F.vcu * NWAVES + F.wave, NGW = F.G * NWAVES, lane = lane_id();
    float* mod = (float*)(F.ws + WS_CTL) + CW_MOD;
    {
        const float* cvec = ARG(I_C); const float* wada = ARG(I_WADA); const float* bada = ARG(I_BADA);
        const int r8 = lane >> 3, c4 = lane & 7;
        for (int item0 = gw; item0 < 768 * reps; item0 += NGW) {
            const int item = item0 % 768; const int cc = item % 192, kq = item / 192;
            f32x4 acc = {0.f, 0.f, 0.f, 0.f};
#pragma unroll 8
            for (int i = 0; i < 32; ++i) { const int k = kq * 256 + i * 8 + r8; const float cv = cvec[k]; const float s = siluf_(cv);
                const f32x4 w = *(const f32x4*)(wada + (size_t)k * (6 * D) + cc * 32 + c4 * 4); acc += s * w; }
#pragma unroll
            for (int j = 0; j < 4; ++j) { float v = acc[j]; v += __shfl_xor(v, 8); v += __shfl_xor(v, 16); v += __shfl_xor(v, 32); acc[j] = v; }
            if (lane < 8) {
#pragma unroll
                for (int j = 0; j < 4; ++j) { float v = acc[j]; if (kq == 0) v += bada[cc * 32 + c4 * 4 + j]; mod[kq * 6144 + cc * 32 + c4 * 4 + j] = v; }
            }
        }
    }
    LAS float* scr = (LAS float*)(F.lds + F.wave * 16384);
    const float* win = ARG(I_WIN); const float* wcv = ARG(I_WCV); const float* wmix = ARG(I_WMIX); const float* wssm = ARG(I_WSSM);
    bf16* Win_t = (bf16*)(F.ws + WS_WIN); bf16* Wdt_t = (bf16*)(F.ws + WS_WDT); bf16* Wcv_t = (bf16*)(F.ws + WS_WCV);
    bf16* Wmix_t = (bf16*)(F.ws + WS_WMIX); bf16* Wssm_t = (bf16*)(F.ws + WS_WSSM);
    constexpr int I_IN = 16 * 288, I_DT = 16, I_CV = 16 * 32, I_MX = 16 * 32, I_SS = 32 * 32, I_RT = 16 * 3 * 2;
    constexpr int NITEMS = I_IN + I_DT + I_CV + I_MX + I_SS + I_RT;
    const float* wer = ARG(I_WER); const float* wgrp = ARG(I_WGRP); const float* sng0 = ARG(I_SNG);
    for (int it0 = gw; it0 < NITEMS * reps; it0 += NGW) {
        int r = it0 % NITEMS;
        if (r < I_IN) { const int kb = r / 288, nb = r % 288;
            auto wsrc = [&](int k, int npp) -> float {
                const int np = inproj_tile(npp >> 8) * 256 + (npp & 255);
                int col; if (np < 2048) { const int q = np >> 3, rr = np & 7; col = (rr >> 2) * 1024 + 4 * q + (rr & 3); } else if (np < 7168) col = np; else col = np + 32;
                return win[(size_t)k * WIN_LD + col]; };
            if (nb < NP8 * 8) transpose_item8(wsrc, D, F.ws + WS_W8IN, scr, kb, nb * 32, lane); else transpose_item(wsrc, D, Win_t, scr, kb, nb * 32, lane);
            continue; } r -= I_IN;
        if (r < I_DT) { transpose_item([&](int k, int np) -> float { return win[(size_t)k * WIN_LD + 7168 + np]; }, D, Wdt_t, scr, r, 0, lane); continue; } r -= I_DT;
        if (r < I_CV) { transpose_item([&](int k, int np) -> float { return wcv[(size_t)k * D + np]; }, D, Wcv_t, scr, r / 32, (r % 32) * 32, lane); continue; } r -= I_CV;
        if (r < I_MX) { transpose_item([&](int k, int np) -> float { return wmix[(size_t)k * D + np]; }, D, Wmix_t, scr, r / 32, (r % 32) * 32, lane); continue; } r -= I_MX;
        if (r < I_SS) { transpose_item([&](int k, int np) -> float { return wssm[(size_t)k * D + np] * sng0[k]; }, DIN, Wssm_t, scr, r / 32, (r % 32) * 32, lane); continue; } r -= I_SS;
        {
            const int lo = r / 48, rr = r % 48, kb = rr / 3, nb = rr % 3;
            auto wsrc = [&](int k, int np) -> float { float w = 0.f; if (np < 64) w = wer[(size_t)k * NE + np]; else if (np < 72) w = wgrp[(size_t)k * 8 + (np - 64)];
                const float hi = bflo(pk2(w, 0.f)); return lo ? (w - hi) : hi; };
            transpose_item(wsrc, D, (bf16*)(F.ws + (lo ? WS_WRL : WS_WRH)), scr, kb, nb * 32, lane);
        }
    }
}

DI void convert_experts(const Ctx& F, const Args& a) {
    const int gw = F.vcu * NWAVES + F.wave, NGW = F.G * NWAVES, lane = lane_id();
    LAS float* scr = (LAS float*)(F.lds + F.wave * 17408);
    const float* w1 = ARG(I_W1); const float* w3 = ARG(I_W3); const float* w2 = ARG(I_W2);
    unsigned char* W13_t = F.ws + WS_W13; unsigned char* W2_t = F.ws + WS_W2;
    constexpr int I_13 = NE * 4 * 16, I_2 = NE * 2 * 16, NIT = I_13 + I_2;
    const int ch = lane & 15, kq = lane >> 4;
    for (int it = gw; it < NIT; it += NGW) {
        const float* src; size_t ld; unsigned char* dst;
        if (it < I_13) { const int e = it >> 6, r = it & 63, kb = r >> 4, cb = r & 15;
            src = ((ch & 1) ? w3 : w1) + (size_t)e * D * DFF + (size_t)(256 * kb + kq) * DFF + 32 * cb + 4 * (ch >> 1); ld = DFF;
            dst = W13_t + (size_t)e * D * D + (size_t)(64 * cb + lane) * D + 256 * kb;
        } else { const int r0 = it - I_13, e = r0 >> 5, r = r0 & 31, kb = r >> 4, nb = r & 15;
            src = w2 + (size_t)e * DFF * D + (size_t)(256 * kb + kq) * D + 64 * nb + 4 * ch; ld = D;
            dst = W2_t + (size_t)e * D * DFF + (size_t)(64 * nb + lane) * DFF + 256 * kb;
        }
        f32x4 va[16], vb[16]; v4u o[16];
#pragma unroll
        for (int i = 0; i < 16; ++i) va[i] = __builtin_nontemporal_load((const f32x4*)(src + (size_t)(4 * i) * ld));
#pragma unroll
        for (int sub = 0; sub < 4; ++sub) {
            f32x4 (&cur)[16] = (sub & 1) ? vb : va; f32x4 (&nxt)[16] = (sub & 1) ? va : vb;
            if (sub < 3) {
#pragma unroll
                for (int i = 0; i < 16; ++i) nxt[i] = __builtin_nontemporal_load((const f32x4*)(src + (size_t)(64 * (sub + 1) + 4 * i) * ld));
            }
#pragma unroll
            for (int i = 0; i < 16; ++i) *(LAS f32x4*)(scr + (4 * i + kq) * 68 + 4 * ch) = cur[i] * 64.0f;
            LDS_WAIT(); asm volatile("" ::: "memory");
#pragma unroll
            for (int j = 0; j < 4; ++j) {
                unsigned w[4];
#pragma unroll
                for (int q = 0; q < 4; ++q) { const LAS float* sp = scr + (16 * j + 4 * q) * 68 + lane; w[q] = pk4_fp8(sp[0], sp[68], sp[136], sp[204]); }
                o[4 * sub + j].x = w[0]; o[4 * sub + j].y = w[1]; o[4 * sub + j].z = w[2]; o[4 * sub + j].w = w[3];
            }
            LDS_WAIT(); asm volatile("" ::: "memory");
        }
#pragma unroll
        for (int j = 0; j < 16; ++j) *(v4u*)(dst + 16 * j) = o[j];
    }
}

DI void ph1_norm_dt(const Ctx& F, const Args& a) {
    const float* mod = (const float*)(F.ws + WS_CTL) + CW_MOD;
    const float* x = ARG(I_X); const float* n1g = ARG(I_N1G); const float* dtb = ARG(I_DTB);
    bf16* XN = (bf16*)(F.ws + WS_XN); const bf16* Wdt_t = (const bf16*)(F.ws + WS_WDT); float* DT = (float*)(F.ws + WS_DT);
    const int lane = lane_id(), wave = F.wave;
    f32x4 gm[4], ga[4];
#pragma unroll
    for (int j = 0; j < 4; ++j) { const int k = 256 * j + 4 * lane; const f32x4 g = *(const f32x4*)(n1g + k), sc = mod4(mod, 1024 + k);
        gm[j] = g * (sc + 1.0f); ga[j] = mod4(mod, k); }
    if (F.vcu == 0) { float* modc = (float*)(F.ws + WS_CTL) + CW_MODC; for (int k = (F.wave * 64 + lane_id()) * 4; k < 6 * D; k += NTHREADS * 4) *(f32x4*)(modc + k) = mod4(mod, k); }
    for (int unit = F.vcu; unit < M / 64; unit += F.G) {
        const int row0 = unit * 64;
#pragma unroll 1
        for (int rh = 0; rh < 2; ++rh) {
            f32x4 v[4][4];
#pragma unroll
            for (int rr = 0; rr < 4; ++rr)
#pragma unroll
                for (int j = 0; j < 4; ++j) v[rr][j] = __builtin_nontemporal_load((const f32x4*)(x + (size_t)(row0 + wave * 8 + rh * 4 + rr) * D + 256 * j + 4 * lane));
#pragma unroll
            for (int rr = 0; rr < 4; ++rr) {
                const int rl = wave * 8 + rh * 4 + rr, row = row0 + rl; float ss = 0.f;
#pragma unroll
                for (int j = 0; j < 4; ++j) ss += (v[rr][j].x * v[rr][j].x + v[rr][j].y * v[rr][j].y) + (v[rr][j].z * v[rr][j].z + v[rr][j].w * v[rr][j].w);
                const float rstd = 1.0f / sqrtf(wave_sum(ss) * (1.0f / D) + EPS);
#pragma unroll
                for (int j = 0; j < 4; ++j) { const f32x4 n = v[rr][j] * rstd * gm[j] + ga[j];
                    v2u w; w.x = pk2(n.x, n.y); w.y = pk2(n.z, n.w);
                    *(v2u*)(XN + (size_t)row * D + 256 * j + 4 * lane) = w;
                    *(unsigned*)(F.ws + WS_XN8 + (size_t)row * D + 256 * j + 4 * lane) = pk4_fp8(n.x, n.y, n.z, n.w);
                    const int chunk = (32 * j + (lane >> 1)) ^ (rl & 15);
                    *(LAS v2u*)(F.lds + rl * 2048 + chunk * 16 + 8 * (lane & 1)) = w; }
            }
        }
        __syncthreads();
        {
            const int rt = wave & 3, ct = wave >> 2, fr = lane & 15, fq = lane >> 4;
            pg8::f32x4 acc = {0.f, 0.f, 0.f, 0.f};
            const bf16* wrow = Wdt_t + (size_t)(16 * ct + fr) * D + 8 * fq;
#pragma unroll 4
            for (int ks = 0; ks < 32; ++ks) {
                const bf16x8 av = *(const LAS bf16x8*)(F.lds + (16 * rt + fr) * 2048 + (((4 * ks + fq) ^ fr) * 16));
                const bf16x8 bv = *(const bf16x8*)(wrow + 32 * ks);
                acc = __builtin_amdgcn_mfma_f32_16x16x32_bf16(av, bv, acc, 0, 0, 0);
            }
            const float bias = dtb[16 * ct + fr];
#pragma unroll
            for (int r = 0; r < 4; ++r) { const float v = acc[r] + bias; const float sp = v > 20.f ? v : log1pf(__expf(v));
                DT[(size_t)(row0 + 16 * rt + 4 * fq + r) * NH + 16 * ct + fr] = sp; }
        }
        __syncthreads();
    }
}

DI void ph3_convbranch(const Ctx& F, const Args& a, int reps) {
    const bf16* U = (const bf16*)(F.ws + WS_U); bf16* UC = (bf16*)(F.ws + WS_XN);
    const float* cw = ARG(I_CVW); const float* cb = ARG(I_CVB); const float* lg = ARG(I_LNG); const float* lb = ARG(I_LNB);
    const int tid = F.wave * 64 + lane_id(), lane = lane_id(), wave = F.wave;
    LAS unsigned char* tile = F.lds;
    LAS float* red = (LAS float*)(F.lds + 62 * 2048);
    LAS float* stat = red + 32 * 8 * 2;
    f2v w[31];
#pragma unroll
    for (int j = 0; j < 31; ++j) w[j] = *(const f2v*)(cw + j * D + 2 * tid);
    const f2v bias = *(const f2v*)(cb + 2 * tid), gam = *(const f2v*)(lg + 2 * tid), bet = *(const f2v*)(lb + 2 * tid);
    const int RU = (M / 32 + F.G - 1) / F.G;
    for (int it = 0; it < RU * reps; ++it) {
        const int unit = xcd_unit(F.xcd, F.xj, F.G >> 3, (it >= RU ? it - RU : it), M / 32); if (unit < 0) break; const int t0 = unit * 32;
        for (int piece = tid; piece < 62 * 128; piece += NTHREADS) { const int r = piece >> 7, cch = piece & 127, t = t0 - 30 + r;
            v4u v = {0u, 0u, 0u, 0u}; if (t >= 0) v = *(const v4u*)(U + (size_t)t * D + cch * 8);
            *(LAS v4u*)(tile + r * 2048 + cch * 16) = v; }
        __syncthreads();
        f2v o[32];
#pragma unroll
        for (int tg = 0; tg < 8; ++tg) {
            f2v acc[4];
#pragma unroll
            for (int i = 0; i < 4; ++i) acc[i] = bias;
#pragma unroll
            for (int j = 0; j < 34; ++j) {
                const unsigned uu = *(const LAS unsigned*)(tile + (4 * tg + j) * 2048 + tid * 4);
                const f2v u2 = {bflo(uu), bfhi(uu)};
#pragma unroll
                for (int i = 0; i < 4; ++i) { const int jj = j - i; if (jj >= 0 && jj <= 30) acc[i] = __builtin_elementwise_fma(w[jj], u2, acc[i]); }
            }
#pragma unroll
            for (int i = 0; i < 4; ++i) o[4 * tg + i] = acc[i];
        }
        {
            float r5[64];
#pragma unroll
            for (int tk = 0; tk < 32; ++tk) { r5[2 * tk] = o[tk].x + o[tk].y; r5[2 * tk + 1] = o[tk].x * o[tk].x + o[tk].y * o[tk].y; }
            float r4[32], r3[16], r2[8], r1[4], r0[2];
            { const bool up = (lane & 32) != 0;
#pragma unroll
              for (int i = 0; i < 32; ++i) { const float keep = up ? r5[i + 32] : r5[i], send = up ? r5[i] : r5[i + 32]; r4[i] = keep + __shfl_xor(send, 32); } }
            { const bool up = (lane & 16) != 0;
#pragma unroll
              for (int i = 0; i < 16; ++i) { const float keep = up ? r4[i + 16] : r4[i], send = up ? r4[i] : r4[i + 16]; r3[i] = keep + __shfl_xor(send, 16); } }
            { const bool up = (lane & 8) != 0;
#pragma unroll
              for (int i = 0; i < 8; ++i) { const float keep = up ? r3[i + 8] : r3[i], send = up ? r3[i] : r3[i + 8]; r2[i] = keep + __shfl_xor(send, 8); } }
            { const bool up = (lane & 4) != 0;
#pragma unroll
              for (int i = 0; i < 4; ++i) { const float keep = up ? r2[i + 4] : r2[i], send = up ? r2[i] : r2[i + 4]; r1[i] = keep + __shfl_xor(send, 4); } }
            { const bool up = (lane & 2) != 0;
#pragma unroll
              for (int i = 0; i < 2; ++i) { const float keep = up ? r1[i + 2] : r1[i], send = up ? r1[i] : r1[i + 2]; r0[i] = keep + __shfl_xor(send, 2); } }
            const bool up0 = (lane & 1) != 0;
            const float tot = (up0 ? r0[1] : r0[0]) + __shfl_xor(up0 ? r0[0] : r0[1], 1);
            red[((lane >> 1) * 8 + wave) * 2 + (lane & 1)] = tot;
        }
        __syncthreads();
        if (tid < 32) { float s = 0.f, q = 0.f;
#pragma unroll
            for (int wv = 0; wv < 8; ++wv) { s += red[(tid * 8 + wv) * 2]; q += red[(tid * 8 + wv) * 2 + 1]; }
            const float mean = s * (1.0f / D); const float var = fmaxf(q * (1.0f / D) - mean * mean, 0.f);
            stat[tid * 2] = mean; stat[tid * 2 + 1] = 1.0f / sqrtf(var + EPS); }
        __syncthreads();
#pragma unroll
        for (int tk = 0; tk < 32; ++tk) { const float mean = stat[tk * 2], rstd = stat[tk * 2 + 1];
            const float y0 = (o[tk].x - mean) * rstd * gam.x + bet.x, y1 = (o[tk].y - mean) * rstd * gam.y + bet.y;
            *(unsigned*)(UC + (size_t)(t0 + tk) * D + 2 * tid) = pk2(siluf_(y0), siluf_(y1)); }
        __syncthreads();
    }
}

DI void conv_block(const bf16* XBC, const float* cw, const float* cb, int t_first, int col, float (&o)[8][8]) {
    v4u raw[11];
#pragma unroll
    for (int r = 0; r < 11; ++r) { const int t = t_first - 3 + r; const int tc = t < 0 ? 0 : t; v4u v = *(const v4u*)(XBC + (size_t)tc * XBCW + col);
        const unsigned msk = t < 0 ? 0u : 0xffffffffu; v.x &= msk; v.y &= msk; v.z &= msk; v.w &= msk; raw[r] = v; }
    float w[4][8], b[8];
#pragma unroll
    for (int j = 0; j < 4; ++j) { const f32x4 lo = *(const f32x4*)(cw + j * XBCW + col), hi = *(const f32x4*)(cw + j * XBCW + col + 4);
        w[j][0] = lo.x; w[j][1] = lo.y; w[j][2] = lo.z; w[j][3] = lo.w; w[j][4] = hi.x; w[j][5] = hi.y; w[j][6] = hi.z; w[j][7] = hi.w; }
    { const f32x4 lo = *(const f32x4*)(cb + col), hi = *(const f32x4*)(cb + col + 4); b[0] = lo.x; b[1] = lo.y; b[2] = lo.z; b[3] = lo.w; b[4] = hi.x; b[5] = hi.y; b[6] = hi.z; b[7] = hi.w; }
#pragma unroll
    for (int tk = 0; tk < 8; ++tk)
#pragma unroll
        for (int ch = 0; ch < 8; ++ch) {
            float acc = b[ch];
#pragma unroll
            for (int j = 0; j < 4; ++j) { const unsigned wd = raw[tk + j][ch >> 1]; const float xv = (ch & 1) ? bfhi(wd) : bflo(wd); acc += w[j][ch] * xv; }
            o[tk][ch] = siluf_(acc);
        }
}
DI float head_scan(const float* DT, const float* alog, int t0, int h, int lane, LAS float* acs_h, LAS float* dtv_h, float& d0o, float& d1o, float& c0o, float& c1o) {
    const float d0 = DT[(size_t)(t0 + 2 * lane) * NH + h], d1 = DT[(size_t)(t0 + 2 * lane + 1) * NH + h];
    const float A2 = -__expf(alog[h]) * LOG2E;
    const float a0 = d0 * A2, a1 = d1 * A2; float inc = a0 + a1;
#pragma unroll
    for (int o = 1; o < 64; o <<= 1) { const float t = __shfl_up(inc, o); if (lane >= o) inc += t; }
    acs_h[2 * lane] = inc - a1; acs_h[2 * lane + 1] = inc; dtv_h[2 * lane] = d0; dtv_h[2 * lane + 1] = d1;
    d0o = d0; d1o = d1; c0o = inc - a1; c1o = inc;
    return __shfl(inc, 63);
}

constexpr int S_CN = 0, S_BN = 32768, S_XT = 65536, S_ACS = 131072, S_DTV = 135168, S_SSQ = 139264, S_FS = 139776;

DI void ph3_chunk_states(const Ctx& F, const Args& a, int reps) {
    const bf16* XBC = (const bf16*)(F.ws + WS_XBC); const float* DT = (const float*)(F.ws + WS_DT);
    bf16* ST = (bf16*)(F.ws + WS_ST); float* CD = (float*)(F.ws + WS_CD);
    const float* scw = ARG(I_SCW); const float* scb = ARG(I_SCB); const float* alog = ARG(I_ALOG);
    const int tid = F.wave * 64 + lane_id(), lane = lane_id(), wave = F.wave, hh = lane >> 5;
    LAS unsigned char* lds = F.lds;
    LAS float* acs = (LAS float*)(lds + S_ACS); LAS float* wsc = (LAS float*)(lds + S_DTV);
    const int RU = (NCH * NGRP + F.G - 1) / F.G;
    for (int it = 0; it < RU * reps; ++it) {
        const int unit = xcd_unit(F.xcd, F.xj, F.G >> 3, (it >= RU ? it - RU : it), NCH * NGRP); if (unit < 0) break; const int c = unit >> 2, g = unit & 3, t0 = c * LCH;
        {
            const int h = 8 * g + wave; float d0, d1, c0, c1;
            const float total = head_scan(DT, alog, t0, h, lane, acs + wave * 128, wsc + wave * 128, d0, d1, c0, c1);
            wsc[wave * 128 + 2 * lane] = d0 * __builtin_amdgcn_exp2f(total - c0); wsc[wave * 128 + 2 * lane + 1] = d1 * __builtin_amdgcn_exp2f(total - c1);
            if (lane == 0) CD[c * NH + h] = __builtin_amdgcn_exp2f(total);
        }
        __syncthreads();
        if (tid < 256) { const int co = tid & 15, to = tid >> 4; float o[8][8];
            conv_block(XBC, scw, scb, t0 + 8 * to, 2048 + 128 * g + 8 * co, o);
#pragma unroll
            for (int ch = 0; ch < 8; ++ch) { const int row = 8 * co + ch;
                v4u w; w.x = pk2(o[0][ch], o[1][ch]); w.y = pk2(o[2][ch], o[3][ch]); w.z = pk2(o[4][ch], o[5][ch]); w.w = pk2(o[6][ch], o[7][ch]);
                *(LAS v4u*)(lds + S_BN + row * 256 + swz(row, to) * 16) = w; } }
        for (int ps = 0; ps < 2; ++ps) {
            {
                const int co = tid & 31, to = tid >> 5, hd = co >> 3, p0 = (co & 7) * 8; float o[8][8];
                conv_block(XBC, scw, scb, t0 + 8 * to, 512 * g + 64 * (4 * ps + hd) + p0, o);
                float sc[8];
#pragma unroll
                for (int tk = 0; tk < 8; ++tk) sc[tk] = wsc[(4 * ps + hd) * 128 + 8 * to + tk];
#pragma unroll
                for (int ch = 0; ch < 8; ++ch) { const int row = hd * 64 + p0 + ch;
                    v4u w; w.x = pk2(o[0][ch] * sc[0], o[1][ch] * sc[1]); w.y = pk2(o[2][ch] * sc[2], o[3][ch] * sc[3]);
                    w.z = pk2(o[4][ch] * sc[4], o[5][ch] * sc[5]); w.w = pk2(o[6][ch] * sc[6], o[7][ch] * sc[7]);
                    *(LAS v4u*)(lds + S_XT + row * 256 + swz(row, to) * 16) = w; }
            }
            __syncthreads();
            {
                const int hd = wave & 3, ph = wave >> 2, h = 8 * g + 4 * ps + hd;
                f32x16 acc[4];
#pragma unroll
                for (int nt = 0; nt < 4; ++nt)
#pragma unroll
                    for (int i = 0; i < 16; ++i) acc[nt][i] = 0.f;
                const int arow = hd * 64 + 32 * ph + (lane & 31);
#pragma unroll
                for (int ks = 0; ks < 8; ++ks) {
                    const bf16x8 av = *(const LAS bf16x8*)(lds + S_XT + arow * 256 + swz(arow, 2 * ks + hh) * 16);
#pragma unroll
                    for (int nt = 0; nt < 4; ++nt) { const int brow = 32 * nt + (lane & 31);
                        const bf16x8 bv = *(const LAS bf16x8*)(lds + S_BN + brow * 256 + swz(brow, 2 * ks + hh) * 16);
                        acc[nt] = MFMA32(av, bv, acc[nt]); }
                }
                bf16* dst = ST + ((size_t)(c * NH + h) * HD) * NST;
#pragma unroll
                for (int nt = 0; nt < 4; ++nt)
#pragma unroll
                    for (int i = 0; i < 16; i += 2) { const int p = 32 * ph + crow(i, hh); const unsigned pk = pk2(acc[nt][i], acc[nt][i + 1]);
                        dst[(size_t)p * NST + 32 * nt + (lane & 31)] = (bf16)(pk & 0xffffu); dst[(size_t)(p + 1) * NST + 32 * nt + (lane & 31)] = (bf16)(pk >> 16); }
            }
            __syncthreads();
        }
    }
}

DI void ph4_scan(const Ctx& F, size_t dst_off) {
    unsigned* ST32 = (unsigned*)(F.ws + WS_ST); unsigned* DST32 = (unsigned*)(F.ws + dst_off); const float* CD = (const float*)(F.ws + WS_CD);
    constexpr int NPAIR = NH * HD * NST / 2;
    for (int e = F.vcu * NTHREADS + (F.wave * 64 + lane_id()); e < NPAIR; e += F.G * NTHREADS) {
        const int h = e >> 12; float c0 = 0.f, c1 = 0.f;
#pragma unroll 1
        for (int cb = 0; cb < NCH; cb += 32) {
            unsigned v[32]; float dec[32];
#pragma unroll
            for (int i = 0; i < 32; ++i) { v[i] = __builtin_nontemporal_load(ST32 + (size_t)(cb + i) * NPAIR + e); dec[i] = CD[(cb + i) * NH + h]; }
#pragma unroll
            for (int i = 0; i < 32; ++i) { DST32[(size_t)(cb + i) * NPAIR + e] = pk2(c0, c1); c0 = c0 * dec[i] + bflo(v[i]); c1 = c1 * dec[i] + bfhi(v[i]); }
        }
    }
}

DI void ph5_ssd_out(const Ctx& F, const Args& a, int reps) {
    const bf16* XBC = (const bf16*)(F.ws + WS_XBC); const float* DT = (const float*)(F.ws + WS_DT);
    const bf16* ST = (const bf16*)(F.ws + WS_ST); const bf16* ZS = (const bf16*)(F.ws + WS_ZS); bf16* YS = (bf16*)(F.ws + WS_YS);
    const float* scw = ARG(I_SCW); const float* scb = ARG(I_SCB); const float* alog = ARG(I_ALOG); const float* dskip = ARG(I_DSKIP);
    const int tid = F.wave * 64 + lane_id(), lane = lane_id(), wave = F.wave, hh = lane >> 5, l31 = lane & 31;
    LAS unsigned char* lds = F.lds;
    LAS float* acs = (LAS float*)(lds + S_ACS); LAS float* dtv = (LAS float*)(lds + S_DTV); LAS float* ssq = (LAS float*)(lds + S_SSQ);
    const int RU = (NCH * NGRP + F.G - 1) / F.G;
    for (int it = 0; it < RU * reps; ++it) {
        const int unit = xcd_unit(F.xcd, F.xj, F.G >> 3, (it >= RU ? it - RU : it), NCH * NGRP); if (unit < 0) break; const int c = unit >> 2, g = unit & 3, t0 = c * LCH;
        { const int h = 8 * g + wave; float d0, d1, c0, c1; (void)head_scan(DT, alog, t0, h, lane, acs + wave * 128, dtv + wave * 128, d0, d1, c0, c1);
          const float cend = __shfl(c1, (lane & 48) | 15);
          LAS float* fsw = (LAS float*)(lds + S_FS) + wave * 128;
          fsw[2 * lane] = d0 * __builtin_amdgcn_exp2f(cend - c0); fsw[2 * lane + 1] = d1 * __builtin_amdgcn_exp2f(cend - c1); }
        if (tid < 128) ssq[tid] = 0.f;
        { const int which = tid >> 8, t8 = tid & 255, co = t8 & 15; int to = t8 >> 4; asm volatile("" : "+v"(to)); float o[8][8];
            conv_block(XBC, scw, scb, t0 + 8 * to, (which ? 2560 : 2048) + 128 * g + 8 * co, o);
            const int base = which ? S_CN : S_BN;
#pragma unroll
            for (int tk = 0; tk < 8; ++tk) { const int row = 8 * to + tk;
                v4u w; w.x = pk2(o[tk][0], o[tk][1]); w.y = pk2(o[tk][2], o[tk][3]); w.z = pk2(o[tk][4], o[tk][5]); w.w = pk2(o[tk][6], o[tk][7]);
                *(LAS v4u*)(lds + base + row * 256 + swz(row, co) * 16) = w; } }
#pragma unroll 1
        for (int ps = 0; ps < 2; ++ps) {
            {
                const int co = tid & 31; int to = tid >> 5; asm volatile("" : "+v"(to));
                const int hd = co >> 3, p0 = (co & 7) * 8; float o[8][8];
                conv_block(XBC, scw, scb, t0 + 8 * to, 512 * g + 64 * (4 * ps + hd) + p0, o);
#pragma unroll
                for (int ch = 0; ch < 8; ++ch) { const int row = hd * 64 + p0 + ch;
                    v4u w; w.x = pk2(o[0][ch], o[1][ch]); w.y = pk2(o[2][ch], o[3][ch]); w.z = pk2(o[4][ch], o[5][ch]); w.w = pk2(o[6][ch], o[7][ch]);
                    *(LAS v4u*)(lds + S_XT + row * 256 + swz(row, to) * 16) = w; }
            }
            __syncthreads();
            const int hd = wave & 3, lp = wave >> 2, hl = 4 * ps + hd, h = 8 * g + hl;
            const float Dh = dskip[h];
            const LAS float* acs_h = acs + hl * 128; const LAS float* dt_h = dtv + hl * 128; const LAS float* fs_h = (const LAS float*)(lds + S_FS) + hl * 128;
            const bf16* prev = ST + ((size_t)(c * NH + h) * HD) * NST;
            const int erow = lane >> 1, ehalf = lane & 1;
            f32x16 acc[2][2];
            {
#pragma unroll
                for (int which = 0; which < 2; ++which)
#pragma unroll
                    for (int pt = 0; pt < 2; ++pt)
#pragma unroll
                        for (int i = 0; i < 16; ++i) acc[which][pt][i] = 0.f;
                const int rowA = 32 * lp + l31, rowB = 32 * (3 - lp) + l31;
#pragma unroll
                for (int ks = 0; ks < 8; ++ks) {
                    const bf16x8 b0 = *(const bf16x8*)(prev + (size_t)l31 * NST + 16 * ks + 8 * hh), b1 = *(const bf16x8*)(prev + (size_t)(32 + l31) * NST + 16 * ks + 8 * hh);
                    const bf16x8 a0 = *(const LAS bf16x8*)(lds + S_CN + rowA * 256 + swz(rowA, 2 * ks + hh) * 16);
                    const bf16x8 a1 = *(const LAS bf16x8*)(lds + S_CN + rowB * 256 + swz(rowB, 2 * ks + hh) * 16);
                    acc[0][0] = MFMA32(a0, b0, acc[0][0]); acc[0][1] = MFMA32(a0, b1, acc[0][1]);
                    acc[1][0] = MFMA32(a1, b0, acc[1][0]); acc[1][1] = MFMA32(a1, b1, acc[1][1]);
                }
#pragma unroll
                for (int which = 0; which < 2; ++which) { const int li = which == 0 ? lp : 3 - lp;
#pragma unroll
                    for (int i = 0; i < 16; ++i) { const float e = __builtin_amdgcn_exp2f(acs_h[32 * li + crow(i, hh)]); acc[which][0][i] *= e; acc[which][1][i] *= e; } }
            }
            {
                const int liA = lp, liB = 3 - lp;
                const int rowA = 32 * liA + l31, rowB = 32 * liB + l31;
                const float alA = acs_h[rowA], alB = acs_h[rowB];
#pragma unroll 1
                for (int sj = 0; sj <= liB; ++sj) {
                    const bool doA = sj <= liA;
                    f32x16 GA, GB;
#pragma unroll
                    for (int i = 0; i < 16; ++i) { GA[i] = 0.f; GB[i] = 0.f; }
                    const int brow = 32 * sj + l31;
                    if (doA) {
#pragma unroll 2
                        for (int ks = 0; ks < 8; ++ks) {
                            const bf16x8 av = *(const LAS bf16x8*)(lds + S_BN + brow * 256 + swz(brow, 2 * ks + hh) * 16);
                            const bf16x8 ca = *(const LAS bf16x8*)(lds + S_CN + rowA * 256 + swz(rowA, 2 * ks + hh) * 16);
                            const bf16x8 cb = *(const LAS bf16x8*)(lds + S_CN + rowB * 256 + swz(rowB, 2 * ks + hh) * 16);
                            GA = MFMA32(av, ca, GA); GB = MFMA32(av, cb, GB);
                        }
                    } else {
#pragma unroll 2
                        for (int ks = 0; ks < 8; ++ks) {
                            const bf16x8 av = *(const LAS bf16x8*)(lds + S_BN + brow * 256 + swz(brow, 2 * ks + hh) * 16);
                            const bf16x8 cb = *(const LAS bf16x8*)(lds + S_CN + rowB * 256 + swz(rowB, 2 * ks + hh) * 16);
                            GB = MFMA32(av, cb, GB);
                        }
                    }
                    auto mask = [&](f32x16& G, int li, int row_l, float al) {
                        if (sj < li) {
                            const float fl = __builtin_amdgcn_exp2f(al - acs_h[32 * sj + 31]);
#pragma unroll
                            for (int i = 0; i < 16; ++i) G[i] = G[i] * (fs_h[32 * sj + crow(i, hh)] * fl);
                        } else {
#pragma unroll
                            for (int i = 0; i < 16; ++i) { const int s = 32 * sj + crow(i, hh);
                                float v = G[i] * __builtin_amdgcn_exp2f(fminf(al - acs_h[s], 0.f)) * dt_h[s];
                                v = (s > row_l) ? 0.f : v; v = (s == row_l) ? v + Dh : v; G[i] = v; }
                        }
                    };
                    auto pv = [&](const f32x16& G, f32x16 (&ac)[2]) {
#pragma unroll
                        for (int s2 = 0; s2 < 2; ++s2) {
                            v4u fa; fa.x = pk2(G[8 * s2 + 0], G[8 * s2 + 1]); fa.y = pk2(G[8 * s2 + 2], G[8 * s2 + 3]); fa.z = pk2(G[8 * s2 + 4], G[8 * s2 + 5]); fa.w = pk2(G[8 * s2 + 6], G[8 * s2 + 7]);
#pragma unroll
                            for (int pt = 0; pt < 2; ++pt) { const int xrow = hd * 64 + 32 * pt + l31; const int sc0 = 32 * sj + 16 * s2;
                                const v2u lo = *(const LAS v2u*)(lds + S_XT + xrow * 256 + swz(xrow, (sc0 >> 3)) * 16 + 8 * hh);
                                const v2u hi = *(const LAS v2u*)(lds + S_XT + xrow * 256 + swz(xrow, (sc0 >> 3) + 1) * 16 + 8 * hh);
                                v4u bfr; bfr.x = lo.x; bfr.y = lo.y; bfr.z = hi.x; bfr.w = hi.y;
                                ac[pt] = MFMA32(__builtin_bit_cast(bf16x8, fa), __builtin_bit_cast(bf16x8, bfr), ac[pt]); }
                        }
                    };
                    if (doA) { mask(GA, liA, rowA, alA); pv(GA, acc[0]); }
                    mask(GB, liB, rowB, alB); pv(GB, acc[1]);
                }
            }
            asm volatile("" ::: "memory");
            v4u zs[2][4];
#pragma unroll
            for (int which = 0; which < 2; ++which) { const int li = which == 0 ? lp : 3 - lp; const size_t t = (size_t)(t0 + 32 * li + erow);
#pragma unroll
                for (int j = 0; j < 4; ++j) zs[which][j] = *(const v4u*)(ZS + t * DIN + 64 * h + 32 * ehalf + 8 * j); }
            __syncthreads();
            {
                LAS unsigned char* stg = lds + S_XT + wave * 8192;
#pragma unroll
                for (int which = 0; which < 2; ++which)
#pragma unroll
                    for (int pt = 0; pt < 2; ++pt)
#pragma unroll
                        for (int i = 0; i < 16; ++i) *(LAS bf16*)(stg + ((which * 32 + crow(i, hh)) * 64 + 32 * pt + l31) * 2) = (bf16)(pk2(acc[which][pt][i], 0.f) & 0xffffu);
                LDS_WAIT(); asm volatile("" ::: "memory");
#pragma unroll
                for (int which = 0; which < 2; ++which) { const int li = which == 0 ? lp : 3 - lp; const int l = 32 * li + erow; const size_t t = (size_t)(t0 + l);
                    float q = 0.f;
#pragma unroll
                    for (int j = 0; j < 4; ++j) { const v4u yv = *(const LAS v4u*)(stg + ((which * 32 + erow) * 64 + 32 * ehalf + 8 * j) * 2); const v4u zv = zs[which][j];
                        float y[8] = {bflo(yv.x) * bflo(zv.x), bfhi(yv.x) * bfhi(zv.x), bflo(yv.y) * bflo(zv.y), bfhi(yv.y) * bfhi(zv.y), bflo(yv.z) * bflo(zv.z), bfhi(yv.z) * bfhi(zv.z), bflo(yv.w) * bflo(zv.w), bfhi(yv.w) * bfhi(zv.w)};
#pragma unroll
                        for (int k = 0; k < 8; ++k) q += y[k] * y[k];
                        v4u w; w.x = pk2(y[0], y[1]); w.y = pk2(y[2], y[3]); w.z = pk2(y[4], y[5]); w.w = pk2(y[6], y[7]);
                        *(v4u*)(YS + t * DIN + 64 * h + 32 * ehalf + 8 * j) = w; }
                    q += __shfl_xor(q, 1);
                    if (ehalf == 0) __hip_atomic_fetch_add(ssq + l, q, __ATOMIC_RELAXED, __HIP_MEMORY_SCOPE_WORKGROUP);
                }
            }
            __syncthreads();
        }
        if (tid < 128) ((float*)(F.ws + WS_RSTD))[(size_t)(t0 + tid) * 4 + g] = 1.0f / sqrtf(ssq[tid] * (1.0f / 512.f) + EPS);
        __syncthreads();
    }
}

constexpr int RT_LD = 1028;
DI void ph8_router(const Ctx& F, const Args& a, int reps) {
    const float* mod = (const float*)(F.ws + WS_CTL) + CW_MODC;
    const bf16* H = (const bf16*)(F.ws + WS_H16); const float* n2g = ARG(I_N2G); const float* bgrp = ARG(I_BGRP); const float* ber = ARG(I_BER);
    unsigned char* XN2 = F.ws + WS_XN; int* cnt0 = (int*)(F.ws + WS_CTL) + CW_CNT;
    int* RE = (int*)(F.ws + WS_ROUTE); int* RP = RE + 2 * M; float* RW = (float*)(RP + 2 * M); int* LIST = (int*)(F.ws + WS_LIST);
    const int lane = lane_id(), wave = F.wave;
    LAS float* tile = (LAS float*)F.lds;
    LAS float* pe = (LAS float*)F.lds;
    f32x4 gm[4], ga[4];
#pragma unroll
    for (int j = 0; j < 4; ++j) { const int k = 256 * j + 4 * lane; const f32x4 g = *(const f32x4*)(n2g + k), sc = *(const f32x4*)(mod + 4096 + k);
        gm[j] = g * (sc + 1.0f); ga[j] = *(const f32x4*)(mod + 3072 + k); }
    const int RU = (M / 32 + F.G - 1) / F.G;
    for (int it = 0; it < RU * reps; ++it) {
        const int unit = xcd_unit(F.xcd, F.xj, F.G >> 3, (it >= RU ? it - RU : it), M / 32); if (unit < 0) break; int* cnt = cnt0 + ((it >= RU * (reps - 1)) ? 0 : 4096);
        const int row0 = unit * 32;
        {
            f32x4 v[4][4];
#pragma unroll
            for (int rr = 0; rr < 4; ++rr)
#pragma unroll
                for (int j = 0; j < 4; ++j) { const v2u hw = *(const v2u*)(H + (size_t)(row0 + wave * 4 + rr) * D + 256 * j + 4 * lane); v[rr][j] = (f32x4){bflo(hw.x), bfhi(hw.x), bflo(hw.y), bfhi(hw.y)}; }
#pragma unroll
            for (int rr = 0; rr < 4; ++rr) { const int rl = wave * 4 + rr, row = row0 + rl; float ss = 0.f;
#pragma unroll
                for (int j = 0; j < 4; ++j) ss += (v[rr][j].x * v[rr][j].x + v[rr][j].y * v[rr][j].y) + (v[rr][j].z * v[rr][j].z + v[rr][j].w * v[rr][j].w);
                const float rstd = 1.0f / sqrtf(wave_sum(ss) * (1.0f / D) + EPS);
#pragma unroll
                for (int j = 0; j < 4; ++j) { const f32x4 n = v[rr][j] * rstd * gm[j] + ga[j];
                    *(LAS f32x4*)(tile + rl * RT_LD + 256 * j + 4 * lane) = n;
                    *(unsigned*)(XN2 + (size_t)row * D + 256 * j + 4 * lane) = pk4_fp8(n.x, n.y, n.z, n.w); }
            }
        }
        __syncthreads();
        pg8::f32x4 acc[2][5];
#pragma unroll
        for (int rt = 0; rt < 2; ++rt)
#pragma unroll
            for (int ct = 0; ct < 5; ++ct) acc[rt][ct] = (pg8::f32x4){0.f, 0.f, 0.f, 0.f};
        const int kb = wave * 128, fr = lane & 15, kq = lane >> 4;
        const bf16* WRH = (const bf16*)(F.ws + WS_WRH); const bf16* WRL = (const bf16*)(F.ws + WS_WRL);
#pragma unroll 2
        for (int ks = 0; ks < 4; ++ks) {
            const int k0 = kb + 32 * ks + 8 * kq;
            bf16x8 bh[5], bl[5];
#pragma unroll
            for (int ct = 0; ct < 5; ++ct) { bh[ct] = *(const bf16x8*)(WRH + (size_t)(16 * ct + fr) * D + k0); bl[ct] = *(const bf16x8*)(WRL + (size_t)(16 * ct + fr) * D + k0); }
#pragma unroll
            for (int rt = 0; rt < 2; ++rt) {
                const f32x4 x0 = *(const LAS f32x4*)(tile + (16 * rt + fr) * RT_LD + k0), x1 = *(const LAS f32x4*)(tile + (16 * rt + fr) * RT_LD + k0 + 4);
                v4u hv, lv;
                hv.x = pk2(x0.x, x0.y); hv.y = pk2(x0.z, x0.w); hv.z = pk2(x1.x, x1.y); hv.w = pk2(x1.z, x1.w);
                lv.x = pk2(x0.x - bflo(hv.x), x0.y - bfhi(hv.x)); lv.y = pk2(x0.z - bflo(hv.y), x0.w - bfhi(hv.y));
                lv.z = pk2(x1.x - bflo(hv.z), x1.y - bfhi(hv.z)); lv.w = pk2(x1.z - bflo(hv.w), x1.w - bfhi(hv.w));
                const bf16x8 ah = __builtin_bit_cast(bf16x8, hv), al = __builtin_bit_cast(bf16x8, lv);
#pragma unroll
                for (int ct = 0; ct < 5; ++ct) {
                    acc[rt][ct] = __builtin_amdgcn_mfma_f32_16x16x32_bf16(ah, bh[ct], acc[rt][ct], 0, 0, 0);
                    acc[rt][ct] = __builtin_amdgcn_mfma_f32_16x16x32_bf16(ah, bl[ct], acc[rt][ct], 0, 0, 0);
                    acc[rt][ct] = __builtin_amdgcn_mfma_f32_16x16x32_bf16(al, bh[ct], acc[rt][ct], 0, 0, 0); }
            }
        }
        __syncthreads();
#pragma unroll
        for (int rt = 0; rt < 2; ++rt)
#pragma unroll
            for (int ct = 0; ct < 5; ++ct)
#pragma unroll
                for (int r = 0; r < 4; ++r) pe[(wave * 32 + 16 * rt + 4 * kq + r) * 80 + 16 * ct + fr] = acc[rt][ct][r];
        __syncthreads();
        int e0s[4], e1s[4]; float w0s[4], w1s[4];
#pragma unroll
        for (int rr = 0; rr < 4; ++rr) { const int rl = wave * 4 + rr;
            float le = ber[lane], lgv = (lane < 8) ? bgrp[lane] : 0.f;
#pragma unroll
            for (int wv = 0; wv < 8; ++wv) { le += pe[(wv * 32 + rl) * 80 + lane]; if (lane < 8) lgv += pe[(wv * 32 + rl) * 80 + 64 + lane]; }
            float gl[8];
#pragma unroll
            for (int i = 0; i < 8; ++i) gl[i] = __shfl(lgv, i);
            int gi = 0; float gmax = gl[0];
#pragma unroll
            for (int i = 1; i < 8; ++i) if (gl[i] > gmax) { gmax = gl[i]; gi = i; }
            float den = 0.f;
#pragma unroll
            for (int i = 0; i < 8; ++i) den += __expf(gl[i] - gmax);
            const float gp = 1.0f / den;
            float el[8];
#pragma unroll
            for (int i = 0; i < 8; ++i) el[i] = __shfl(le, gi * 8 + i);
            int i0 = 0; float m0 = el[0];
#pragma unroll
            for (int i = 1; i < 8; ++i) if (el[i] > m0) { m0 = el[i]; i0 = i; }
            int i1 = -1; float m1 = -INFINITY;
#pragma unroll
            for (int i = 0; i < 8; ++i) if (i != i0 && el[i] > m1) { m1 = el[i]; i1 = i; }
            const float dd = __expf(m1 - m0);
            w0s[rr] = gp / (1.0f + dd); w1s[rr] = gp * dd / (1.0f + dd); e0s[rr] = gi * 8 + i0; e1s[rr] = gi * 8 + i1;
        }
        if (lane == 0) {
            int p0[4], p1[4];
#pragma unroll
            for (int rr = 0; rr < 4; ++rr) { p0[rr] = atomicAdd(cnt + 64 * e0s[rr], 1); p1[rr] = atomicAdd(cnt + 64 * e1s[rr], 1); }
#pragma unroll
            for (int rr = 0; rr < 4; ++rr) { const int row = row0 + wave * 4 + rr;
                RE[2 * row] = e0s[rr]; RE[2 * row + 1] = e1s[rr]; RP[2 * row] = p0[rr]; RP[2 * row + 1] = p1[rr]; RW[2 * row] = w0s[rr]; RW[2 * row + 1] = w1s[rr];
                LIST[e0s[rr] * 16384 + p0[rr]] = row; LIST[e1s[rr] * 16384 + p1[rr]] = row; }
        }
        __syncthreads();
    }
}

DI void build_tilebase(const Ctx& F) {
    const int* cnt = (const int*)(F.ws + WS_CTL) + CW_CNT; LAS int* tb = (LAS int*)(F.lds + TB_OFF);
    if (F.wave == 0) {
        const int lane = lane_id(); const int tiles = (cnt[64 * lane] + 255) >> 8; int inc = tiles;
#pragma unroll
        for (int o = 1; o < 64; o <<= 1) { const int t = __shfl_up(inc, o); if (lane >= o) inc += t; }
        tb[lane] = inc - tiles; if (lane == 63) tb[NE] = inc; ((LAS int*)(F.lds + CNTL_OFF))[lane] = cnt[64 * lane];
    }
    __syncthreads();
}
DI void fill_tokl(const Ctx& F, const MoeOrder& S) {
    const LAS int* tb = (const LAS int*)(F.lds + TB_OFF); const LAS int* cntl = (const LAS int*)(F.lds + CNTL_OFF); LAS int* tokl = (LAS int*)(F.lds + TOKL_OFF);
    const int* LIST = (const int*)(F.ws + WS_LIST); const int tid = F.wave * 64 + lane_id();
    for (int i = 0; i < 4; ++i) { pg8::Unit u; if (!S.next(i, u)) break;
        const int e = u.pn >> 2, r = 256 * (u.pm - tb[e]) + tid;
        if (tid < 256) tokl[256 * i + tid] = (r < cntl[e]) ? LIST[e * 16384 + r] : 0; }
    asm volatile("s_waitcnt vmcnt(0) lgkmcnt(0)" ::: "memory"); __syncthreads();
}
DI void ph12_final(const Ctx& F, const Args& a, int reps) {
    const float* mod = (const float*)(F.ws + WS_CTL) + CW_MODC; float* H = (float*)argp<N_IN>(); const bf16* H16 = (const bf16*)(F.ws + WS_H16); const float* fg = ARG(I_FG);
    const unsigned char* YE = F.ws + WS_YEXP; const int* RE = (const int*)(F.ws + WS_ROUTE); const int* RP = RE + 2 * M; const float* RW = (const float*)(F.ws + WS_ROUTE) + 4 * M;
    const LAS int* tb = (const LAS int*)(F.lds + TB_OFF);
    float* OUT2 = (float*)(F.ws + WS_U);
    const int gw = F.vcu * NWAVES + F.wave, NGW = F.G * NWAVES, lane = lane_id();
    f32x4 g2[4], fgv[4];
#pragma unroll
    for (int j = 0; j < 4; ++j) { g2[j] = *(const f32x4*)(mod + 5 * 1024 + 256 * j + 4 * lane); fgv[j] = *(const f32x4*)(fg + 256 * j + 4 * lane); }
    const int RT = (M / 2 + NGW - 1) / NGW;
    for (int it = 0; it < RT * reps; ++it) {
        const int t0 = 2 * xcd_unit(F.xcd, F.xj * NWAVES + F.wave, NGW >> 3, (it >= RT ? it - RT : it), M / 2); if (t0 < 0) break;
        float* O = (it >= RT * (reps - 1)) ? H : OUT2;
        int tt[2], d0[2], d1[2]; float w0[2], w1[2];
#pragma unroll
        for (int u = 0; u < 2; ++u) { tt[u] = (t0 + u) % M; d0[u] = 256 * tb[RE[2 * tt[u]]] + RP[2 * tt[u]]; d1[u] = 256 * tb[RE[2 * tt[u] + 1]] + RP[2 * tt[u] + 1]; w0[u] = RW[2 * tt[u]]; w1[u] = RW[2 * tt[u] + 1]; }
        f32x4 hv[2][4]; unsigned ya[2][4], yb[2][4];
#pragma unroll
        for (int u = 0; u < 2; ++u)
#pragma unroll
            for (int j = 0; j < 4; ++j) { const v2u hw = *(const v2u*)(H16 + (size_t)tt[u] * D + 256 * j + 4 * lane); hv[u][j] = (f32x4){bflo(hw.x), bfhi(hw.x), bflo(hw.y), bfhi(hw.y)};
                ya[u][j] = *(const unsigned*)(YE + (size_t)d0[u] * D + 256 * j + 4 * lane); yb[u][j] = *(const unsigned*)(YE + (size_t)d1[u] * D + 256 * j + 4 * lane); }
#pragma unroll
        for (int u = 0; u < 2; ++u) {
            f32x4 v[4]; float ss = 0.f;
#pragma unroll
            for (int j = 0; j < 4; ++j) { const unsigned a4 = ya[u][j], b4 = yb[u][j];
                const f2v a01 = __builtin_amdgcn_cvt_pk_f32_fp8(a4, false), a23 = __builtin_amdgcn_cvt_pk_f32_fp8(a4, true), b01 = __builtin_amdgcn_cvt_pk_f32_fp8(b4, false), b23 = __builtin_amdgcn_cvt_pk_f32_fp8(b4, true);
                f32x4 mo; mo.x = w0[u] * a01.x + w1[u] * b01.x; mo.y = w0[u] * a01.y + w1[u] * b01.y; mo.z = w0[u] * a23.x + w1[u] * b23.x; mo.w = w0[u] * a23.y + w1[u] * b23.y;
                mo = mo * 0.0625f;
                v[j] = hv[u][j] + g2[j] * mo; ss += (v[j].x * v[j].x + v[j].y * v[j].y) + (v[j].z * v[j].z + v[j].w * v[j].w); }
            const float rstd = 1.0f / sqrtf(wave_sum(ss) * (1.0f / D) + EPS);
#pragma unroll
            for (int j = 0; j < 4; ++j) *(f32x4*)(O + (size_t)tt[u] * D + 256 * j + 4 * lane) = v[j] * rstd * fgv[j];
        }
    }
}

constexpr int N_PHASES = 13;
#ifndef REP_MASK
#define REP_MASK 0
#endif
#define REPS(k) (((REP_MASK >> (k)) & 1) ? 2 : 1)
#ifndef MK_ONE_LAUNCH
#define MK_ONE_LAUNCH 1
#endif

struct RepOrder { pg8::StaticOrder s; int n, reps;
    DI bool next(int i, pg8::Unit& u) const { if (i >= n * reps) return false; return s.next(i % n, u); }
    DI void a_ready(const pg8::Unit&) const {}
    DI void done(const pg8::Unit&) const {} };

__global__ void __launch_bounds__(NTHREADS, 2) fwd_kernel(Args args) {
    extern __shared__ __attribute__((aligned(16))) unsigned char lds_raw[];
    Ctx F;
    F.lds = (LAS unsigned char*)lds_raw;
    F.wave = __builtin_amdgcn_readfirstlane((int)threadIdx.x >> 6);
    F.G = gridDim.x; { const int bx = blockIdx.x; F.xcd = bx & 7; F.xj = bx >> 3; F.vcu = F.xcd * (F.G >> 3) + F.xj; }
    F.ws = (unsigned char*)argp<N_IN + 1>();
    volatile LAS unsigned* MISC = (volatile LAS unsigned*)(F.lds + LDSCTL_OFF);
    for (int u = threadIdx.x; u < (LDS_BYTES - LDSCTL_OFF) / 4; u += NTHREADS) ((LAS unsigned*)(F.lds + LDSCTL_OFF))[u] = 0u;
    __syncthreads();
    const int lo = args.ph_lo, hi = args.ph_hi;
    unsigned* barw = (unsigned*)(F.ws + WS_CTL) + CW_BAR;
    XcdBarrier bar; bar.bar = barw; bar.x = 0; bar.st = nullptr;
    if (hi - lo > 1) bar = xcd_barrier_post(barw, MISC + 8);
    bar.wave = F.wave;
#define IN(k) (lo <= (k) && (k) < hi)
#define SEAM(k) do { if (IN(k) && IN((k) + 1)) { xcd_barrier(bar); if (REPS(14) > 1) xcd_barrier(bar); } } while (0)
    unsigned char* ws = F.ws;
    bf16* XN = (bf16*)(ws + WS_XN);
    const float* mod = (const float*)(ws + WS_CTL) + CW_MOD;

    if (IN(0)) { ph0_prologue(F, args, REPS(0)); SEAM(0); }
    if (IN(1)) { for (int rep = 0; rep < REPS(1); ++rep) { ph1_norm_dt(F, args); __syncthreads(); } SEAM(1); }
    if (IN(2)) {
        {
            pg8::Gemm g{(const bf16*)(ws + WS_XN8), (const bf16*)(ws + WS_W8IN), M, NP8 * 256, D / 2}; pg8::StaticOrder S; S.init(M, NP8 * 256, F.G, (int)blockIdx.x);
            EpiInProj E{ws, 0};
            RepOrder R{S, (S.nwg - S.c + S.G - 1) / S.G, REPS(2)};
            pg8::gemm_phase<EpiInProj, RepOrder, true, true, true>(F.lds, g, R, E, F.wave);
        }
        __syncthreads();
        {
            pg8::Gemm g{XN, (const bf16*)(ws + WS_WIN) + (size_t)NP8 * 256 * D, M, NPROJ - NP8 * 256, D}; pg8::StaticOrder S; S.init(M, NPROJ - NP8 * 256, F.G, (int)blockIdx.x);
            EpiInProj E{ws, NP8};
            RepOrder R{S, (S.nwg - S.c + S.G - 1) / S.G, REPS(2)};
            pg8::gemm_phase<EpiInProj, RepOrder, true, true>(F.lds, g, R, E, F.wave);
        }
        SEAM(2);
    }
    if (IN(3)) { ph3_chunk_states(F, args, REPS(13)); __syncthreads(); ph3_convbranch(F, args, REPS(3)); __syncthreads(); SEAM(3); }
    if (IN(4)) {
        if (REPS(4) > 1) ph4_scan(F, WS_YS);
        ph4_scan(F, WS_ST);
        pg8::Gemm g{XN, (const bf16*)(ws + WS_WCV), M, D, D}; pg8::StaticOrder S; S.init(M, D, F.G, (int)blockIdx.x);
        EpiGate<false> E{(bf16*)(ws + WS_TMP), nullptr, (const bf16*)(ws + WS_GATE), 0, nullptr};
        RepOrder R{S, (S.nwg - S.c + S.G - 1) / S.G, REPS(15)};
        pg8::gemm_phase<EpiGate<false>, RepOrder, false, true>(F.lds, g, R, E, F.wave);
        SEAM(4);
    }
    if (IN(5)) { ph5_ssd_out(F, args, REPS(5)); SEAM(5); }
    if (IN(6)) {
        pg8::Gemm g{(const bf16*)(ws + WS_YS), (const bf16*)(ws + WS_WSSM), M, D, DIN}; pg8::StaticOrder S; S.init(M, D, F.G, (int)blockIdx.x);
        LAS float* rt = (LAS float*)(F.lds + RT_OFF);
        EpiGate<true> E{(bf16*)(ws + WS_MG), (const bf16*)(ws + WS_TMP), (const bf16*)(ws + WS_GATE), 1024, rt};
        for (int i = 0;; ++i) {
            OneUnit S1; if (!S.next(i, S1.u)) break;
            if (F.wave < 4) { const int tid = F.wave * 64 + lane_id(); const f32x4 r = *(const f32x4*)((const float*)(ws + WS_RSTD) + (size_t)(S1.u.pm * 256 + tid) * 4);
                *(LAS f32x4*)(rt + tid * 4) = (f32x4){r.x / r.y, r.y / r.z, r.z / r.w, r.w}; }
            asm volatile("s_waitcnt vmcnt(0) lgkmcnt(0)" ::: "memory"); __syncthreads();
            pg8::gemm_phase<EpiGate<true>, OneUnit, false, true>(F.lds, g, S1, E, F.wave);
            __syncthreads();
        }
        SEAM(6);
    }
    if (IN(7)) {
        pg8::Gemm g{(const bf16*)(ws + WS_MG), (const bf16*)(ws + WS_WMIX), M, D, D}; pg8::StaticOrder S; S.init(M, D, F.G, (int)blockIdx.x);
        EpiMix E{(bf16*)(ws + WS_H16), ARG(I_X), (const float*)(ws + WS_CTL) + CW_MODC + 2 * 1024};
        RepOrder R{S, (S.nwg - S.c + S.G - 1) / S.G, REPS(7)};
        pg8::gemm_phase<EpiMix, RepOrder, false, true>(F.lds, g, R, E, F.wave);
        SEAM(7);
    }
    if (IN(8)) { for (int rep = 0; rep < REPS(8); ++rep) { convert_experts(F, args); __syncthreads(); } ph8_router(F, args, REPS(9)); if (IN(8) && IN(10)) xcd_barrier(bar); }
    if (IN(10)) {
        build_tilebase(F);
        const LAS int* tb = (const LAS int*)(F.lds + TB_OFF);
        pg8::Gemm g{(const bf16*)(ws + WS_XN), (const bf16*)(ws + WS_W13), M, NE * 1024, D / 2};
        MoeOrder S{tb, F.G, F.vcu, tb[NE] * 4, 1, (const LAS int*)(F.lds + TOKL_OFF)};
        fill_tokl(F, S);
        EpiUp E{ws + WS_HDN};
        pg8::gemm_phase<EpiUp, MoeOrder, true, true, true, true>(F.lds, g, S, E, F.wave);
        SEAM(10);
    }
    if (IN(11)) {
        build_tilebase(F);
        const LAS int* tb = (const LAS int*)(F.lds + TB_OFF);
        pg8::Gemm g{(const bf16*)(ws + WS_HDN), (const bf16*)(ws + WS_W2), 49152, NE * 1024, DFF / 2};
        MoeOrder S{tb, F.G, F.vcu, tb[NE] * 4, 1, nullptr};
        EpiDown E{ws + WS_YEXP};
        pg8::gemm_phase<EpiDown, MoeOrder, true, true, true>(F.lds, g, S, E, F.wave);
        SEAM(11);
    }
    if (IN(12)) { build_tilebase(F); ph12_final(F, args, REPS(12)); }
#undef IN
#undef SEAM
}

extern "C" void kernel_launch(void* const* d_in, const int* in_sizes, int n_in, void* d_out, int out_size, void* d_ws, size_t ws_size, hipStream_t stream) {
    static int grid = 0;
    if (grid == 0) {
        if (n_in != N_IN || in_sizes[0] != M * D || out_size != M * D || ws_size < WS_END) {
            fprintf(stderr, "kernel_launch: unexpected shapes: n_in %d in0 %d out %d ws %zu (need %zu)\n", n_in, n_in > 0 ? in_sizes[0] : -1, out_size, ws_size, (size_t)WS_END); grid = -1; return; }
        int dev = 0, cus = 0, per_cu = 0;
        if (hipGetDevice(&dev) != hipSuccess || hipDeviceGetAttribute(&cus, hipDeviceAttributeMultiprocessorCount, dev) != hipSuccess) { fprintf(stderr, "kernel_launch: device query failed\n"); grid = -1; return; }
        if (hipFuncSetAttribute((const void*)fwd_kernel, hipFuncAttributeMaxDynamicSharedMemorySize, LDS_BYTES) != hipSuccess) { fprintf(stderr, "kernel_launch: hipFuncSetAttribute failed\n"); grid = -1; return; }
        if (hipOccupancyMaxActiveBlocksPerMultiprocessor(&per_cu, (const void*)fwd_kernel, NTHREADS, LDS_BYTES) != hipSuccess || per_cu < 1) {
            fprintf(stderr, "kernel_launch: the occupancy query admits no workgroup of this kernel per CU (%d); nothing launched\n", per_cu); (void)hipGetLastError(); grid = -1; return; }
        grid = cus;
        if (cus < 192 || (cus & 7)) { fprintf(stderr, "kernel_launch: built for a 256-CU device (the MoE unit table holds 4 units per workgroup); %d CUs: nothing launched\n", cus); grid = -1; return; }
        fprintf(stderr, "kernel_launch: grid %d (cus %d, per_cu %d)\n", grid, cus, per_cu);
    }
    if (grid < 0) return;
    (void)hipMemsetAsync((char*)d_ws + WS_CTL, 0, CTL_ZERO_BYTES, stream);
    Args a{};
    for (int i = 0; i < N_IN; ++i) a.in[i] = (const float*)d_in[i];
    a.out = (float*)d_out; a.ws = (unsigned char*)d_ws;
#if MK_ONE_LAUNCH
    a.ph_lo = 0; a.ph_hi = N_PHASES;
    void* kargs[] = {&a};
    hipError_t e = hipLaunchCooperativeKernel((const void*)fwd_kernel, dim3(grid), dim3(NTHREADS), kargs, LDS_BYTES, stream);
    if (e != hipSuccess) fprintf(stderr, "kernel_launch: cooperative launch failed: %s\n", hipGetErrorString(e));
#else
    for (int ph = 0; ph < N_PHASES; ++ph) {
        a.ph_lo = ph; a.ph_hi = ph + 1;
        hipLaunchKernelGGL(fwd_kernel, dim3(grid), dim3(NTHREADS), LDS_BYTES, stream, a);
    }
#endif
}
```

```cpp
#include <hip/hip_runtime.h>
#include <hip/hip_cooperative_groups.h>
#include <cstdio>
#include <cstdint>
namespace pg8 {
#define PG8_LAS __attribute__((address_space(3)))
typedef unsigned short bf16_t;
typedef short bf16x8 __attribute__((ext_vector_type(8)));
typedef float f32x4 __attribute__((ext_vector_type(4)));
typedef unsigned u32x4 __attribute__((ext_vector_type(4)));
typedef int v4i_ __attribute__((ext_vector_type(4)));
typedef int v8i_ __attribute__((ext_vector_type(8)));
constexpr int BM = 256, BK = 64, HALF = 128, HTB = HALF * BK * 2  , STAGE_BYTES = 8 * HTB, NXCD = 8, WGM = 8;

__host__ __device__ __forceinline__ int lds_byte(int r, int c) { const int st = (r >> 4) * 2 + (c >> 5), rr = r & 15, cc = c & 31, ob = rr * 64 + cc * 2; return st * 1024 + (ob ^ (((ob >> 9) & 1) << 5)); }
__host__ __device__ __forceinline__ void stage_rc(int b, int& R, int& C) { const int st = b / 1024, sb = b % 1024, swz = sb ^ (((sb >> 9) & 1) << 5); R = (st >> 1) * 16 + swz / 64; C = (st & 1) * 32 + (swz % 64) / 2; }
__host__ __device__ __forceinline__ int perm32(int rho) { const int n = rho >> 4, i = rho & 15; return 8 * (i >> 2) + 4 * n + (i & 3); }

struct Unit { int pm, pn; };
struct Gemm { const bf16_t* A; const bf16_t* Bt; int M, N, K; };

struct StaticOrder {
    int nM, nN, nwg, G, c;
    __host__ __device__ void init(int M, int N, int G_, int c_) { nM = M / BM; nN = N / BM; nwg = nM * nN; G = G_; c = c_; }
    __host__ __device__ bool next(int i, Unit& u) const {
        const long L = (long)i * G + c; if (L >= nwg) return false;
        int wgid = (int)L; { const int q = nwg / NXCD, r = nwg % NXCD, xcd = wgid % NXCD, off = wgid / NXCD; wgid = (xcd < r ? xcd * (q + 1) : r * (q + 1) + (xcd - r) * q) + off; }
        const int nig = WGM * nN, gid = wgid / nig, fm = gid * WGM, gsz = (nM - fm) < WGM ? (nM - fm) : WGM;
        u.pm = fm + ((wgid % nig) % gsz); u.pn = (wgid % nig) / gsz; return true;
    }
    __device__ __forceinline__ void a_ready(const Unit&) const {}
    __device__ __forceinline__ void done(const Unit&) const {}
};

__device__ __forceinline__ unsigned cvt_pk_bf16(float lo, float hi) { unsigned r; asm volatile("v_cvt_pk_bf16_f32 %0, %1, %2" : "=v"(r) : "v"(lo), "v"(hi)); return r; }
typedef float f32x2 __attribute__((ext_vector_type(2)));
template <class Epi, class Sched, bool ALIGN_EPI = false, bool SP2 = false, bool FP8 = false, bool GATHER = false>
__device__ __forceinline__ void gemm_phase(PG8_LAS unsigned char* lds, const Gemm g, const Sched& S, const Epi& E, const int wave_in) {
    const int lane = (int)__builtin_amdgcn_mbcnt_hi(~0u, __builtin_amdgcn_mbcnt_lo(~0u, 0u)), wid = wave_in, tid = wid * 64 + lane, wr = wid >> 2, wc = wid & 3, fr = lane & 15, fq = lane >> 4;
    const int K = g.K, nt = K / BK;
    unsigned voffA[2], voffB[2];
#pragma unroll
    for (int i = 0; i < 2; ++i) { int R, C; stage_rc(tid * 16 + i * 8192, R, C); const int Rb = Epi::PERM ? ((R & ~31) + perm32(R & 31)) : R;
        voffA[i] = (unsigned)(R * K + C) * 2u; voffB[i] = (unsigned)(Rb * K + C) * 2u; }
    static_assert(!GATHER || SP2, "GATHER is implemented in the SP2 loop");
    unsigned gA[2][2], ngA[2][2]; int RA[2]; unsigned CA2[2];
#pragma unroll
    for (int i = 0; i < 2; ++i) { int R, C; stage_rc(tid * 16 + i * 8192, R, C); RA[i] = R; CA2[i] = (unsigned)C * 2u; }
    auto load_g = [&](int ui_, unsigned (&dst)[2][2]) {
        if constexpr (GATHER) {
#pragma unroll
            for (int h = 0; h < 2; ++h)
#pragma unroll
                for (int i = 0; i < 2; ++i) dst[h][i] = (unsigned)S.tokl[ui_ * 256 + 128 * h + RA[i]] * (unsigned)(K * 2) + CA2[i];
        }
    };
    const size_t kstep = (size_t)(BK * 2);
    const size_t hstep = (size_t)HALF * K * 2;
    const size_t tstep = 2 * hstep;
    const size_t hstepA = GATHER ? (size_t)0 : hstep, tstepA = GATHER ? (size_t)0 : 2 * hstep;
    const unsigned ldsw = (unsigned)wid * 1024u;
    const int aoff = lds_byte(wr * 64 + fr, fq * 8), boff = lds_byte(wc * 32 + fr, fq * 8);
#define PG8_SA(b, h) (((b) * 2 + (h)) * HTB)
#define PG8_SB(b, h) ((4 + (b) * 2 + (h)) * HTB)
#define PG8_STAGE(bufoff, gbase, voff) do { _Pragma("unroll") for (int _i = 0; _i < 2; ++_i) \
        __builtin_amdgcn_global_load_lds((const unsigned*)((const char*)(gbase) + (voff)[_i]), (PG8_LAS unsigned*)(lds + (bufoff) + ldsw + _i * 8192), 16, 0, 0); } while (0)
#define PG8_STAGE_A(bufoff, gbase, gvoff) do { if constexpr (GATHER) { PG8_STAGE(bufoff, gbase, gvoff); } else { PG8_STAGE(bufoff, gbase, voffA); } } while (0)
#define PG8_LDA(dst, b, h) do { if constexpr (FP8) { _Pragma("unroll") for (int m = 0; m < 4; ++m) dst##8[m] = __builtin_shufflevector(*(const PG8_LAS v4i_*)(lds + PG8_SA(b, h) + aoff + m * 2048), *(const PG8_LAS v4i_*)(lds + PG8_SA(b, h) + aoff + m * 2048 + 1024), 0, 1, 2, 3, 4, 5, 6, 7); } \
        else { _Pragma("unroll") for (int m = 0; m < 4; ++m) _Pragma("unroll") for (int k = 0; k < 2; ++k) dst[m][k] = *(const PG8_LAS bf16x8*)(lds + PG8_SA(b, h) + aoff + m * 2048 + k * 1024); } } while (0)
#define PG8_LDB(dst, b, h) do { if constexpr (FP8) { _Pragma("unroll") for (int n = 0; n < 2; ++n) dst##8[n] = __builtin_shufflevector(*(const PG8_LAS v4i_*)(lds + PG8_SB(b, h) + boff + n * 2048), *(const PG8_LAS v4i_*)(lds + PG8_SB(b, h) + boff + n * 2048 + 1024), 0, 1, 2, 3, 4, 5, 6, 7); } \
        else { _Pragma("unroll") for (int n = 0; n < 2; ++n) _Pragma("unroll") for (int k = 0; k < 2; ++k) dst[n][k] = *(const PG8_LAS bf16x8*)(lds + PG8_SB(b, h) + boff + n * 2048 + k * 1024); } } while (0)
#define PG8_MMA(ai, bj, At, Bt) do { __builtin_amdgcn_s_setprio(1); \
        if constexpr (FP8) {   \
              \
            _Pragma("unroll") for (int m = 0; m < 4; ++m) _Pragma("unroll") for (int n = 0; n < 2; ++n) \
                asm volatile("v_mfma_scale_f32_16x16x128_f8f6f4 %0, %1, %2, %0, %3, %4 op_sel_hi:[0,0,0]" : "+v"(acc[ai][bj][m][n]) : "v"(Bt##8[n]), "v"(At##8[m]), "v"(scale_w), "v"(scale_x)); \
        } else { \
        _Pragma("unroll") for (int m = 0; m < 4; ++m) _Pragma("unroll") for (int n = 0; n < 2; ++n) _Pragma("unroll") for (int k = 0; k < 2; ++k) \
        acc[ai][bj][m][n] = __builtin_amdgcn_mfma_f32_16x16x32_bf16(Bt[n][k], At[m][k], acc[ai][bj][m][n], 0, 0, 0); } __builtin_amdgcn_s_setprio(0); } while (0)
#define PG8_WAIT_V(n) asm volatile("s_waitcnt vmcnt(" #n ")" ::: "memory")
#define PG8_WAIT_L(n) asm volatile("s_waitcnt lgkmcnt(" #n ")" ::: "memory")
#define PG8_BAR __builtin_amdgcn_s_barrier()
#define PG8_SCHED __builtin_amdgcn_sched_barrier(0)
    Unit cur, nxt; int ui = 0;
    if (!S.next(0, cur)) return;
    f32x4 acc[2][2][4][2];
#pragma unroll
    for (int a = 0; a < 2; ++a)
#pragma unroll
        for (int b = 0; b < 2; ++b)
#pragma unroll
            for (int m = 0; m < 4; ++m)
#pragma unroll
                for (int n = 0; n < 2; ++n) acc[a][b][m][n] = (f32x4){0.f, 0.f, 0.f, 0.f};
    const int scale_w = 0x79797979, scale_x = 0x7f7f7f7f;
    bf16x8 At[4][2], B0[2][2], B1[2][2]; v8i_ At8[4], B08[2], B18[2];
    const char* cA = (const char*)g.A + (size_t)cur.pm * tstepA; const char* cB = (const char*)g.Bt + (size_t)cur.pn * tstep;
    load_g(0, gA);
    S.a_ready(cur);
    if constexpr (SP2) {
        PG8_STAGE(PG8_SB(0, 0), cB, voffB); PG8_STAGE(PG8_SB(0, 1), cB + hstep, voffB); PG8_STAGE_A(PG8_SA(0, 0), cA, gA[0]); PG8_STAGE_A(PG8_SA(0, 1), cA + hstepA, gA[1]);
        if (wr == 1) PG8_BAR;
        PG8_WAIT_V(2); PG8_BAR;
        PG8_STAGE(PG8_SB(1, 0), cB + kstep, voffB); PG8_STAGE_A(PG8_SA(1, 0), cA + kstep, gA[0]); PG8_STAGE(PG8_SB(1, 1), cB + hstep + kstep, voffB);
        PG8_WAIT_V(6); PG8_BAR;
    } else {
        PG8_STAGE(PG8_SB(0, 0), cB, voffB); PG8_STAGE(PG8_SA(0, 0), cA, voffA); PG8_STAGE(PG8_SB(0, 1), cB + hstep, voffB); PG8_STAGE(PG8_SA(0, 1), cA + hstep, voffA);
        if (wr == 1) PG8_BAR;
        PG8_WAIT_V(4); PG8_BAR;
        PG8_STAGE(PG8_SB(1, 0), cB + kstep, voffB); PG8_STAGE(PG8_SA(1, 0), cA + kstep, voffA); PG8_STAGE(PG8_SB(1, 1), cB + hstep + kstep, voffB);
        PG8_WAIT_V(6); PG8_BAR;
    }
    for (;;) {
        const bool has_next = S.next(ui + 1, nxt);
        const char* nA = has_next ? (const char*)g.A + (size_t)nxt.pm * tstepA : cA; const char* nB = has_next ? (const char*)g.Bt + (size_t)nxt.pn * tstep : cB;
        if constexpr (GATHER) { if (has_next) load_g(ui + 1, ngA); else {
#pragma unroll
            for (int h = 0; h < 2; ++h)
#pragma unroll
                for (int i = 0; i < 2; ++i) ngA[h][i] = gA[h][i]; } }
        for (int t = 0; t < nt; t += 2) {
            const bool last = (t == nt - 2);
            const char* a1 = cA + (size_t)(t + 1) * kstep;
            const char* a2 = last ? nA : cA + (size_t)(t + 2) * kstep; const char* b2 = last ? nB : cB + (size_t)(t + 2) * kstep;
            const char* a3 = a2 + kstep; const char* b3 = b2 + kstep;
            if (last && has_next) S.a_ready(nxt);
            unsigned sN[2][2];
#pragma unroll
            for (int h = 0; h < 2; ++h)
#pragma unroll
                for (int i = 0; i < 2; ++i) sN[h][i] = last ? ngA[h][i] : gA[h][i];
            if constexpr (SP2) {
            PG8_LDB(B0, 0, 0); PG8_LDB(B1, 0, 1); PG8_SCHED; PG8_LDA(At, 0, 0); PG8_STAGE_A(PG8_SA(1, 1), a1 + hstepA, gA[1]);
            PG8_WAIT_V(8); PG8_WAIT_L(0); PG8_BAR; PG8_MMA(0, 0, At, B0); PG8_MMA(0, 1, At, B1); PG8_BAR; PG8_SCHED;
            PG8_LDA(At, 0, 1); PG8_STAGE(PG8_SB(0, 0), b2, voffB); PG8_STAGE(PG8_SB(0, 1), b2 + hstep, voffB); PG8_STAGE_A(PG8_SA(0, 0), a2, sN[0]);
            PG8_WAIT_V(8); PG8_WAIT_L(0); PG8_BAR; PG8_MMA(1, 0, At, B0); PG8_MMA(1, 1, At, B1); PG8_BAR; PG8_SCHED;
            PG8_LDB(B0, 1, 0); PG8_LDB(B1, 1, 1); PG8_SCHED; PG8_LDA(At, 1, 0); PG8_STAGE_A(PG8_SA(0, 1), a2 + hstepA, sN[1]);
            PG8_WAIT_V(8); PG8_WAIT_L(0); PG8_BAR; PG8_MMA(0, 0, At, B0); PG8_MMA(0, 1, At, B1); PG8_BAR; PG8_SCHED;
            PG8_LDA(At, 1, 1); PG8_STAGE(PG8_SB(1, 0), b3, voffB); PG8_STAGE(PG8_SB(1, 1), b3 + hstep, voffB); PG8_STAGE_A(PG8_SA(1, 0), a3, sN[0]);
            PG8_WAIT_V(8); PG8_WAIT_L(0); PG8_BAR; PG8_MMA(1, 0, At, B0); PG8_MMA(1, 1, At, B1); PG8_BAR; PG8_SCHED;
            } else {
            PG8_LDB(B0, 0, 0); PG8_SCHED; PG8_LDA(At, 0, 0); PG8_STAGE(PG8_SA(1, 1), a1 + hstep, voffA);
            PG8_WAIT_L(8); PG8_BAR; PG8_WAIT_L(0); PG8_MMA(0, 0, At, B0); PG8_BAR; PG8_SCHED;
            PG8_LDB(B1, 0, 1); PG8_STAGE(PG8_SB(0, 0), b2, voffB);
            PG8_BAR; PG8_WAIT_L(0); PG8_MMA(0, 1, At, B1); PG8_BAR;
            PG8_LDA(At, 0, 1); PG8_STAGE(PG8_SA(0, 0), a2, voffA);
            PG8_BAR; PG8_WAIT_L(0); PG8_MMA(1, 0, At, B0); PG8_BAR; PG8_SCHED;
            PG8_STAGE(PG8_SB(0, 1), b2 + hstep, voffB);
            PG8_WAIT_V(6); PG8_BAR; PG8_MMA(1, 1, At, B1); PG8_BAR;
            PG8_LDB(B0, 1, 0); PG8_SCHED; PG8_LDA(At, 1, 0); PG8_STAGE(PG8_SA(0, 1), a2 + hstep, voffA);
            PG8_WAIT_L(8); PG8_BAR; PG8_WAIT_L(0); PG8_MMA(0, 0, At, B0); PG8_BAR; PG8_SCHED;
            PG8_LDB(B1, 1, 1); PG8_STAGE(PG8_SB(1, 0), b3, voffB);
            PG8_BAR; PG8_WAIT_L(0); PG8_MMA(0, 1, At, B1); PG8_BAR;
            PG8_LDA(At, 1, 1); PG8_STAGE(PG8_SA(1, 0), a3, voffA);
            PG8_BAR; PG8_WAIT_L(0); PG8_MMA(1, 0, At, B0); PG8_BAR; PG8_SCHED;
            PG8_STAGE(PG8_SB(1, 1), b3 + hstep, voffB);
            PG8_WAIT_V(6); PG8_BAR; PG8_MMA(1, 1, At, B1); PG8_BAR;
            }
            if constexpr (Epi::KHOOK) { if ((((t + 2) & 7) == 0) && (t + 2 < nt)) E.khook(acc, ((t + 2) >> 3) - 1, wr, fr); }
        }
        if constexpr (ALIGN_EPI) { if (wr == 0) PG8_BAR; }
        if constexpr (FP8) {
            asm volatile("s_nop 15\n\ts_nop 15" : "+v"(acc[0][0][0][0]), "+v"(acc[0][0][0][1]), "+v"(acc[0][0][1][0]), "+v"(acc[0][0][1][1]), "+v"(acc[0][0][2][0]), "+v"(acc[0][0][2][1]), "+v"(acc[0][0][3][0]), "+v"(acc[0][0][3][1]), "+v"(acc[0][1][0][0]), "+v"(acc[0][1][0][1]), "+v"(acc[0][1][1][0]), "+v"(acc[0][1][1][1]), "+v"(acc[0][1][2][0]), "+v"(acc[0][1][2][1]), "+v"(acc[0][1][3][0]), "+v"(acc[0][1][3][1]));
            asm volatile("s_nop 0" : "+v"(acc[1][0][0][0]), "+v"(acc[1][0][0][1]), "+v"(acc[1][0][1][0]), "+v"(acc[1][0][1][1]), "+v"(acc[1][0][2][0]), "+v"(acc[1][0][2][1]), "+v"(acc[1][0][3][0]), "+v"(acc[1][0][3][1]), "+v"(acc[1][1][0][0]), "+v"(acc[1][1][0][1]), "+v"(acc[1][1][1][0]), "+v"(acc[1][1][1][1]), "+v"(acc[1][1][2][0]), "+v"(acc[1][1][2][1]), "+v"(acc[1][1][3][0]), "+v"(acc[1][1][3][1]));
        }
        if constexpr (!Epi::AFTER_DRAIN) { E(acc, cur, wr, wc, fr, fq); S.done(cur); }
        if (!has_next) break;
#pragma unroll
        for (int a = 0; a < 2; ++a)
#pragma unroll
            for (int b = 0; b < 2; ++b)
#pragma unroll
                for (int m = 0; m < 4; ++m)
#pragma unroll
                    for (int n = 0; n < 2; ++n) acc[a][b][m][n] = (f32x4){0.f, 0.f, 0.f, 0.f};
        cur = nxt; cA = nA; cB = nB; ++ui;
        if constexpr (GATHER) {
#pragma unroll
            for (int h = 0; h < 2; ++h)
#pragma unroll
                for (int i = 0; i < 2; ++i) gA[h][i] = ngA[h][i]; }
        if constexpr (ALIGN_EPI) { if (wr == 1) PG8_BAR; }
    }
    PG8_WAIT_V(0);
    if constexpr (!ALIGN_EPI) { if (wr == 0) PG8_BAR; }
    PG8_BAR;
    if constexpr (Epi::AFTER_DRAIN) { E.fused(acc, cur, wr, wc, fr, fq, lds, wid, lane); S.done(cur); }
#undef PG8_SA
#undef PG8_SB
#undef PG8_STAGE
#undef PG8_STAGE_A
#undef PG8_LDA
#undef PG8_LDB
#undef PG8_MMA
#undef PG8_WAIT_V
#undef PG8_WAIT_L
#undef PG8_BAR
#undef PG8_SCHED
}
}

#define DI __device__ __forceinline__
#define GAS __attribute__((address_space(1)))
#define LAS __attribute__((address_space(3)))
typedef unsigned short bf16;
typedef unsigned v4u __attribute__((ext_vector_type(4)));
typedef unsigned v2u __attribute__((ext_vector_type(2)));
typedef float f32x4 __attribute__((ext_vector_type(4)));
typedef float f32x16 __attribute__((ext_vector_type(16)));
typedef short bf16x8 __attribute__((ext_vector_type(8)));
typedef __bf16 bf2v __attribute__((ext_vector_type(2)));
typedef float f2v __attribute__((ext_vector_type(2)));
typedef GAS unsigned gu32;

constexpr int NWAVES = 8, NTHREADS = 512;
constexpr int M = 16384, D = 1024, DIN = 2048, NH = 32, HD = 64, NGRP = 4, NST = 128, XBCW = 3072;
constexpr int NPROJ = 9216, WIN_LD = 9248;
constexpr int LCH = 128, NCH = M / LCH;
constexpr int NE = 64, DFF = 512;
constexpr float EPS = 1e-6f;
constexpr float LOG2E = 1.4426950408889634f;

constexpr size_t MiB = 1u << 20;
constexpr size_t WS_CTL = 0, CTL_ZERO_BYTES = 65536;
constexpr size_t WS_WIN = 1 * MiB, WS_WDT = 19 * MiB, WS_WCV = 20 * MiB, WS_WMIX = 22 * MiB, WS_WSSM = 24 * MiB;
constexpr size_t WS_RSTD = 31 * MiB + 524288;
constexpr size_t WS_DT = 28 * MiB, WS_CD = 30 * MiB, WS_WRH = 30 * MiB + 65536, WS_WRL = WS_WRH + 262144, WS_ROUTE = 31 * MiB;
constexpr size_t WS_ST = 32 * MiB, WS_YS = 96 * MiB, WS_TMP = 160 * MiB, WS_MG = 192 * MiB;
constexpr size_t WS_W13 = 32 * MiB, WS_W2 = 160 * MiB, WS_H16 = 96 * MiB;
constexpr size_t WS_XN8 = 32 * MiB, WS_W8IN = 48 * MiB;
constexpr size_t WS_XN = 224 * MiB;
constexpr size_t WS_U = 256 * MiB, WS_ZS = 288 * MiB, WS_XBC = 352 * MiB, WS_GATE = 448 * MiB;
constexpr size_t WS_LIST = 256 * MiB, WS_HDN = 352 * MiB, WS_YEXP = 400 * MiB;
constexpr size_t WS_END = 512 * MiB;
constexpr int CW_BAR = 4096;
constexpr int CW_CNT = 8192;
constexpr int CW_MODC = 40960;
constexpr int CW_MOD = 16384;

constexpr int RING_BYTES = 131072;
constexpr int LDSCTL_OFF = 147456;
constexpr int TB_OFF = LDSCTL_OFF + 256;
constexpr int CNTL_OFF = TB_OFF + 320;
constexpr int TOKL_OFF = LDSCTL_OFF + 1024;
constexpr int RT_OFF = 148480;
constexpr int LDS_BYTES = 152576;

#define LDS_WAIT() asm volatile("s_waitcnt lgkmcnt(0)" ::: "memory")
#define VM_WAIT() asm volatile("s_waitcnt vmcnt(0)" ::: "memory")

DI unsigned pk2(float lo, float hi) { f2v v = {lo, hi}; return __builtin_bit_cast(unsigned, __builtin_convertvector(v, bf2v)); }
DI unsigned pk4_fp8(float a, float b, float c, float d) {
    a = __builtin_fminf(__builtin_fmaxf(a, -448.f), 448.f); b = __builtin_fminf(__builtin_fmaxf(b, -448.f), 448.f);
    c = __builtin_fminf(__builtin_fmaxf(c, -448.f), 448.f); d = __builtin_fminf(__builtin_fmaxf(d, -448.f), 448.f);
    unsigned w = 0u; w = __builtin_amdgcn_cvt_pk_fp8_f32(a, b, w, false); w = __builtin_amdgcn_cvt_pk_fp8_f32(c, d, w, true); return w; }
DI unsigned pk4_fp8_nc(float a, float b, float c, float d) { unsigned w = 0u; w = __builtin_amdgcn_cvt_pk_fp8_f32(a, b, w, false); w = __builtin_amdgcn_cvt_pk_fp8_f32(c, d, w, true); return w; }
DI float bflo(unsigned u) { return __uint_as_float(u << 16); }
DI float bfhi(unsigned u) { return __uint_as_float(u & 0xffff0000u); }
DI float sigmoidf_(float x) { return __builtin_amdgcn_rcpf(1.f + __builtin_amdgcn_exp2f(x * -LOG2E)); }
DI float siluf_(float x) { return x * __builtin_amdgcn_rcpf(1.f + __builtin_amdgcn_exp2f(x * -LOG2E)); }
DI float wave_sum(float v) {
#pragma unroll
    for (int o = 1; o < 64; o <<= 1) v += __shfl_xor(v, o);
    return v;
}
DI f32x4 mod4(const float* modp, int k) { return (*(const f32x4*)(modp + k) + *(const f32x4*)(modp + 6144 + k)) + (*(const f32x4*)(modp + 2 * 6144 + k) + *(const f32x4*)(modp + 3 * 6144 + k)); }
DI int crow(int reg, int hh) { return (reg & 3) + 8 * (reg >> 2) + 4 * hh; }
DI int swz(int row, int chunk) { return chunk ^ ((row ^ (row >> 3)) & 15); }
#define MFMA32(a, b, c) __builtin_amdgcn_mfma_f32_32x32x16_bf16((a), (b), (c), 0, 0, 0)

DI int lane_id() { return (int)__builtin_amdgcn_mbcnt_hi(~0u, __builtin_amdgcn_mbcnt_lo(~0u, 0u)); }
#define XB_TMO      128
#define XB_XCNT(j)  (256  + 64 * (j))
#define XB_XSUB(j)  (1280 + 64 * (j))
#define XB_XGEN(j)  (2304 + 64 * (j))
#define XB_TOP      3328
#define XB_TOPGEN   3392
#define XCD_BAR_WORDS 3456
#define XB_SPIN_CAP (1u << 18)
DI unsigned xb_ld(unsigned* p)              { return __hip_atomic_load(p, __ATOMIC_RELAXED, __HIP_MEMORY_SCOPE_AGENT); }
DI unsigned xb_add(unsigned* p, unsigned v) { return __hip_atomic_fetch_add(p, v, __ATOMIC_RELAXED, __HIP_MEMORY_SCOPE_AGENT); }
DI unsigned xb_xcc_id() { return (unsigned)__builtin_amdgcn_s_getreg((3 << 11) | 20) & 0xFu; }
#define XB_SPIN(cond, bar) do { unsigned _sp = 0; while (cond) { __builtin_amdgcn_s_sleep(1); \
    if ((++_sp & 255u) == 0u) { if (xb_ld(&(bar)[XB_TMO])) break; if (_sp > XB_SPIN_CAP) { atomicAdd(&(bar)[XB_TMO], 1u); break; } } } } while (0)
struct XcdBarrier { unsigned* bar; unsigned x; volatile LAS unsigned* st; int wave; };
DI XcdBarrier xcd_barrier_post(unsigned* bar, volatile LAS unsigned* st) {
    XcdBarrier b; b.bar = bar; b.x = xb_xcc_id(); b.st = st; b.wave = 0;
    if (threadIdx.x == 0) (void)xb_add(&bar[XB_XCNT(b.x)], 1u);
    return b;
}
DI void xcd_barrier_complete(unsigned* bar, unsigned x, unsigned& nloc, unsigned& nx) {
    const unsigned G = gridDim.x * gridDim.y * gridDim.z;
    unsigned sum, cnt, mine, sp = 0u;
    for (;;) {
        sum = 0u; cnt = 0u; mine = 0u;
#pragma unroll
        for (unsigned j = 0; j < 16; ++j) { const unsigned c = xb_ld(&bar[XB_XCNT(j)]); sum += c; cnt += (c > 0u) ? 1u : 0u; mine = (j == x) ? c : mine; }
        if (sum == G) break;
        __builtin_amdgcn_s_sleep(1);
        if ((++sp & 255u) == 0u) { if (xb_ld(&bar[XB_TMO])) break; if (sp > XB_SPIN_CAP) { atomicAdd(&bar[XB_TMO], 1u); break; } }
    }
    nloc = mine > 0u ? mine : 1u; nx = cnt > 0u ? cnt : 1u;
}
DI void xcd_barrier(const XcdBarrier& b) {
    asm volatile("s_waitcnt vmcnt(0)" ::: "memory");
    __syncthreads();
    if (b.wave == 0 && lane_id() == 0) {
        unsigned* bar = b.bar;
        __builtin_amdgcn_s_waitcnt(0);
        unsigned nloc = b.st[0], nx = b.st[1];
        if (nloc == 0u) { xcd_barrier_complete(bar, b.x, nloc, nx); b.st[0] = nloc; b.st[1] = nx; }
        const unsigned old = xb_add(&bar[XB_XSUB(b.x)], 1u);
        const unsigned gen = old / nloc;
        if (old + 1u == (gen + 1u) * nloc) {
            __builtin_amdgcn_fence(__ATOMIC_RELEASE, "agent");
            asm volatile("s_waitcnt vmcnt(0)" ::: "memory");
            const unsigned og = xb_add(&bar[XB_TOP], 1u);
            const unsigned tg = og / nx;
            if (og + 1u == (tg + 1u) * nx) xb_add(&bar[XB_TOPGEN], 1u);
            else XB_SPIN(xb_ld(&bar[XB_TOPGEN]) == tg, bar);
            __builtin_amdgcn_fence(__ATOMIC_ACQUIRE, "agent");
            xb_add(&bar[XB_XGEN(b.x)], 1u);
            asm volatile("s_waitcnt vmcnt(0)" ::: "memory");
        } else {
            XB_SPIN(xb_ld(&bar[XB_XGEN(b.x)]) == gen, bar);
            __builtin_amdgcn_fence(__ATOMIC_ACQUIRE, "agent");
            asm volatile("s_waitcnt vmcnt(0)" ::: "memory");
        }
    }
    __syncthreads();
}

enum { I_X = 0, I_C, I_WADA, I_BADA, I_N1G, I_WIN, I_CVW, I_CVB, I_LNG, I_LNB, I_WCV, I_SCW, I_SCB, I_DTB, I_ALOG, I_DSKIP, I_SNG, I_WSSM, I_WMIX,
       I_N2G, I_WGRP, I_BGRP, I_WER, I_BER, I_W1, I_W3, I_W2, I_FG, N_IN };
struct Args { const float* in[N_IN]; float* out; unsigned char* ws; int ph_lo, ph_hi; };

template <int I> DI const float* argp() {
    auto kp = __builtin_amdgcn_kernarg_segment_ptr();
    unsigned long long v;
    asm volatile("s_load_dwordx2 %0, %1, %2\n\ts_waitcnt lgkmcnt(0)" : "=s"(v) : "s"(kp), "i"(I * 8));
    return (const float*)(const GAS float*)v;
}
#define ARG(i) argp<i>()
struct Ctx {
    LAS unsigned char* lds;
    int wave, vcu, G, xcd, xj;
    unsigned char* ws;
};

DI int xcd_unit(int x, int j, int gx, int i, int N) { const int u = i * gx + j; return (u < (N >> 3)) ? x * (N >> 3) + u : -1; }
DI int inproj_tile(int p) { return p < 8 ? p + 28 : p - 8; }
constexpr int NP8 = 16;
struct EpiInProj {
    static constexpr bool PERM = true, AFTER_DRAIN = false, KHOOK = false;
    unsigned char* ws; int p0;
    DI void operator()(const pg8::f32x4 (&acc)[2][2][4][2], const pg8::Unit& u, int wr, int wc, int fr, int fq) const {
        const int pn = inproj_tile(u.pn + p0), row0 = u.pm * 256 + wr * 64 + fr;
        if (pn < 8) {
            bf16* U = (bf16*)(ws + WS_U);
#pragma unroll
            for (int ai = 0; ai < 2; ++ai)
#pragma unroll
                for (int m = 0; m < 4; ++m) {
                    bf16* rowp = U + (size_t)(row0 + ai * 128 + m * 16) * D + pn * 128 + wc * 16 + fq * 4;
#pragma unroll
                    for (int bj = 0; bj < 2; ++bj) { const pg8::f32x4 a = acc[ai][bj][m][0], b = acc[ai][bj][m][1];
                        v2u w; w.x = pk2(a[0] * sigmoidf_(b[0]), a[1] * sigmoidf_(b[1])); w.y = pk2(a[2] * sigmoidf_(b[2]), a[3] * sigmoidf_(b[3]));
                        *(v2u*)(rowp + bj * 64) = w; } }
        } else {
            const bool isz = pn < 16, isx = (pn >= 16) && (pn < 28);
            const size_t boff = isz ? WS_ZS : (isx ? WS_XBC : WS_GATE);
            const int ldc = isx ? XBCW : DIN;
            const int colt = (pn - (isz ? 8 : (isx ? 16 : 28))) * 256;
            bf16* base = (bf16*)(ws + boff);
            const int col0 = colt + wc * 32 + fq * 8;
#pragma unroll
            for (int ai = 0; ai < 2; ++ai)
#pragma unroll
                for (int m = 0; m < 4; ++m) {
                    bf16* rowp = base + (size_t)(row0 + ai * 128 + m * 16) * ldc + col0;
#pragma unroll
                    for (int bj = 0; bj < 2; ++bj) { pg8::f32x4 v0 = acc[ai][bj][m][0], v1 = acc[ai][bj][m][1];
                        if (!isx) {
#pragma unroll
                            for (int i = 0; i < 4; ++i) { const float s0 = sigmoidf_(v0[i]), s1 = sigmoidf_(v1[i]); v0[i] = isz ? v0[i] * s0 : s0; v1[i] = isz ? v1[i] * s1 : s1; }
                        }
                        v4u w; w.x = pk2(v0[0], v0[1]); w.y = pk2(v0[2], v0[3]); w.z = pk2(v1[0], v1[1]); w.w = pk2(v1[2], v1[3]);
                        *(v4u*)(rowp + bj * 128) = w; } }
        }
    }
};
template <bool NORM> struct EpiGate {
    static constexpr bool PERM = true, AFTER_DRAIN = false, KHOOK = NORM;
    bf16* O; const bf16* P; const bf16* GATE; int gcol; const LAS float* rt;
    DI void khook(pg8::f32x4 (&acc)[2][2][4][2], int b, int wr, int fr) const {
#pragma unroll
        for (int ai = 0; ai < 2; ++ai)
#pragma unroll
            for (int m = 0; m < 4; ++m) { const float f = rt[(ai * 128 + wr * 64 + m * 16 + fr) * 4 + b];
#pragma unroll
                for (int bj = 0; bj < 2; ++bj)
#pragma unroll
                    for (int n = 0; n < 2; ++n) acc[ai][bj][m][n] = acc[ai][bj][m][n] * f; }
    }
    DI void operator()(const pg8::f32x4 (&acc)[2][2][4][2], const pg8::Unit& u, int wr, int wc, int fr, int fq) const {
        const int row0 = u.pm * 256 + wr * 64 + fr, col0 = u.pn * 256 + wc * 32 + fq * 8;
#pragma unroll
        for (int ai = 0; ai < 2; ++ai)
#pragma unroll
            for (int m = 0; m < 4; ++m) { const size_t r = (size_t)(row0 + ai * 128 + m * 16);
                float f = 1.0f; if (NORM) f = rt[(ai * 128 + wr * 64 + m * 16 + fr) * 4 + 3];
#pragma unroll
                for (int bj = 0; bj < 2; ++bj) { const int c = col0 + bj * 128;
                    const v4u g = *(const v4u*)(GATE + r * (2 * D) + gcol + c);
                    pg8::f32x4 v0 = acc[ai][bj][m][0] * f, v1 = acc[ai][bj][m][1] * f;
                    float o[8] = {v0[0] * bflo(g.x), v0[1] * bfhi(g.x), v0[2] * bflo(g.y), v0[3] * bfhi(g.y), v1[0] * bflo(g.z), v1[1] * bfhi(g.z), v1[2] * bflo(g.w), v1[3] * bfhi(g.w)};
                    if (P) { const v4u p = *(const v4u*)(P + r * D + c);
                        o[0] += bflo(p.x); o[1] += bfhi(p.x); o[2] += bflo(p.y); o[3] += bfhi(p.y); o[4] += bflo(p.z); o[5] += bfhi(p.z); o[6] += bflo(p.w); o[7] += bfhi(p.w); }
                    v4u w; w.x = pk2(o[0], o[1]); w.y = pk2(o[2], o[3]); w.z = pk2(o[4], o[5]); w.w = pk2(o[6], o[7]);
                    *(v4u*)(O + r * D + c) = w; } }
    }
};
struct EpiMix {
    static constexpr bool PERM = true, AFTER_DRAIN = false, KHOOK = false;
    bf16* H; const float* X; const float* g1;
    DI void operator()(const pg8::f32x4 (&acc)[2][2][4][2], const pg8::Unit& u, int wr, int wc, int fr, int fq) const {
        const int row0 = u.pm * 256 + wr * 64 + fr, col0 = u.pn * 256 + wc * 32 + fq * 8;
#pragma unroll
        for (int bj = 0; bj < 2; ++bj) { const int c = col0 + bj * 128;
            const f32x4 ga = *(const f32x4*)(g1 + c), gb = *(const f32x4*)(g1 + c + 4);
#pragma unroll
            for (int ai = 0; ai < 2; ++ai)
#pragma unroll
                for (int m = 0; m < 4; ++m) { const size_t off = (size_t)(row0 + ai * 128 + m * 16) * D + c;
                    const f32x4 xa = __builtin_nontemporal_load((const f32x4*)(X + off)), xb = __builtin_nontemporal_load((const f32x4*)(X + off + 4));
                    const f32x4 ha = xa + ga * acc[ai][bj][m][0], hb = xb + gb * acc[ai][bj][m][1];
                    v4u w; w.x = pk2(ha.x, ha.y); w.y = pk2(ha.z, ha.w); w.z = pk2(hb.x, hb.y); w.w = pk2(hb.z, hb.w);
                    *(v4u*)(H + off) = w; } }
    }
};
struct EpiUp {
    static constexpr bool PERM = true, AFTER_DRAIN = false, KHOOK = false;
    unsigned char* HDN;
    DI void operator()(const pg8::f32x4 (&acc)[2][2][4][2], const pg8::Unit& u, int wr, int wc, int fr, int fq) const {
        const int j = u.pn & 3, row0 = u.pm * 256 + wr * 64 + fr, col0 = j * 128 + wc * 16 + fq * 4;
#pragma unroll
        for (int ai = 0; ai < 2; ++ai)
#pragma unroll
            for (int m = 0; m < 4; ++m) { unsigned char* rowp = HDN + (size_t)(row0 + ai * 128 + m * 16) * DFF + col0;
#pragma unroll
                for (int bj = 0; bj < 2; ++bj) { const pg8::f32x4 a = acc[ai][bj][m][0], b = acc[ai][bj][m][1];
                    *(unsigned*)(rowp + bj * 64) = pk4_fp8(siluf_(a[0]) * b[0], siluf_(a[1]) * b[1], siluf_(a[2]) * b[2], siluf_(a[3]) * b[3]); } }
    }
};
struct EpiDown {
    static constexpr bool PERM = true, AFTER_DRAIN = false, KHOOK = false;
    unsigned char* Y;
    DI void operator()(const pg8::f32x4 (&acc)[2][2][4][2], const pg8::Unit& u, int wr, int wc, int fr, int fq) const {
        const int j = u.pn & 3, row0 = u.pm * 256 + wr * 64 + fr, col0 = j * 256 + wc * 32 + fq * 8;
#pragma unroll
        for (int ai = 0; ai < 2; ++ai)
#pragma unroll
            for (int m = 0; m < 4; ++m) { unsigned char* rowp = Y + (size_t)(row0 + ai * 128 + m * 16) * D + col0;
#pragma unroll
                for (int bj = 0; bj < 2; ++bj) { const pg8::f32x4 v0 = acc[ai][bj][m][0] * 16.0f, v1 = acc[ai][bj][m][1] * 16.0f;
                    v2u w; w.x = pk4_fp8(v0[0], v0[1], v0[2], v0[3]); w.y = pk4_fp8(v1[0], v1[1], v1[2], v1[3]);
                    *(v2u*)(rowp + bj * 128) = w; } }
    }
};
struct MoeOrder {
    const LAS int* tb; int G, c, total, reps; const LAS int* tokl;
    DI bool next(int i0, pg8::Unit& u) const {
        const int n = (total - c + G - 1) / G; if (n <= 0 || i0 >= n * reps) return false;
        const int i = i0 % n; const int uu = i * G + c;
        const int T = uu >> 2; int e = 0;
        while (e < NE - 1 && tb[e + 1] <= T) ++e;
        u.pm = T; u.pn = 4 * e + (uu & 3); return true;
    }
    DI void a_ready(const pg8::Unit&) const {}
    DI void done(const pg8::Unit&) const {}
};

struct OneUnit { pg8::Unit u;
    DI bool next(int i, pg8::Unit& o) const { if (i != 0) return false; o = u; return true; }
    DI void a_ready(const pg8::Unit&) const {}
    DI void done(const pg8::Unit&) const {} };

template <class SrcF>
DI void transpose_item(SrcF src, int K, bf16* WT, LAS float* scr, int kb, int n0, int lane) {
    const int k0 = 64 * kb;
#pragma unroll 8
    for (int i = 0; i < 32; ++i) { const int kk = 2 * i + (lane >> 5); scr[kk * 33 + (lane & 31)] = src(k0 + kk, n0 + (lane & 31)); }
    LDS_WAIT(); asm volatile("" ::: "memory");
    const int c = lane & 7;
#pragma unroll
    for (int j = 0; j < 4; ++j) { const int n = (lane >> 3) + 8 * j; const LAS float* s = scr + (8 * c) * 33 + n;
        v4u o; o.x = pk2(s[0 * 33], s[1 * 33]); o.y = pk2(s[2 * 33], s[3 * 33]); o.z = pk2(s[4 * 33], s[5 * 33]); o.w = pk2(s[6 * 33], s[7 * 33]);
        *(v4u*)(WT + (size_t)(n0 + n) * K + k0 + 8 * c) = o; }
    LDS_WAIT(); asm volatile("" ::: "memory");
}

template <class SrcF>
DI void transpose_item8(SrcF src, int K, unsigned char* WT, LAS float* scr, int kb, int n0, int lane) {
    const int k0 = 64 * kb;
#pragma unroll 8
    for (int i = 0; i < 32; ++i) { const int kk = 2 * i + (lane >> 5); scr[kk * 33 + (lane & 31)] = src(k0 + kk, n0 + (lane & 31)) * 64.0f; }
    LDS_WAIT(); asm volatile("" ::: "memory");
#pragma unroll
    for (int i = 0; i < 2; ++i) { const int p = lane + 64 * i, n = p >> 2, c = p & 3; const LAS float* s = scr + (16 * c) * 33 + n;
        v4u o; o.x = pk4_fp8(s[0 * 33], s[1 * 33], s[2 * 33], s[3 * 33]); o.y = pk4_fp8(s[4 * 33], s[5 * 33], s[6 * 33], s[7 * 33]);
        o.z = pk4_fp8(s[8 * 33], s[9 * 33], s[10 * 33], s[11 * 33]); o.w = pk4_fp8(s[12 * 33], s[13 * 33], s[14 * 33], s[15 * 33]);
        *(v4u*)(WT + (size_t)(n0 + n) * K + k0 + 16 * c) = o; }
    LDS_WAIT(); asm volatile("" ::: "memory");
}

DI void ph0_prologue(const Ctx& F, const Args& a, int reps) {
    const int gw = F.vcu * NWAVES + F.wave, NGW = F.G * NWAVES, lane = lane_id();
    float* mod = (float*)(F.ws + WS_CTL) + CW_MOD;
    {
        const float* cvec = ARG(I_C); const float* wada = ARG(I_WADA); const float* bada = ARG(I_BADA);
        const int r8 = lane >> 3, c4 = lane & 7;
        for (int item0 = gw; item0 < 768 * reps; item0 += NGW) {
            const int item = item0 % 768; const int cc = item % 192, kq = item / 192;
            f32x4 acc = {0.f, 0.f, 0.f, 0.f};
#pragma unroll 8
            for (int i = 0; i < 32; ++i) { const int k = kq * 256 + i * 8 + r8; const float cv = cvec[k]; const float s = siluf_(cv);
                const f32x4 w = *(const f32x4*)(wada + (size_t)k * (6 * D) + cc * 32 + c4 * 4); acc += s * w; }
#pragma unroll
            for (int j = 0; j < 4; ++j) { float v = acc[j]; v += __shfl_xor(v, 8); v += __shfl_xor(v, 16); v += __shfl_xor(v, 32); acc[j] = v; }
            if (lane < 8) {
#pragma unroll
                for (int j = 0; j < 4; ++j) { float v = acc[j]; if (kq == 0) v += bada[cc * 32 + c4 * 4 + j]; mod[kq * 6144 + cc * 32 + c4 * 4 + j] = v; }
            }
        }
    }
    LAS float* scr = (LAS float*)(F.lds + F.wave * 16384);
    const float* win = ARG(I_WIN); const float* wcv = ARG(I_WCV); const float* wmix = ARG(I_WMIX); const float* wssm = ARG(I_WSSM);
    bf16* Win_t = (bf16*)(F.ws + WS_WIN); bf16* Wdt_t = (bf16*)(F.ws + WS_WDT); bf16* Wcv_t = (bf16*)(F.ws + WS_WCV);
    bf16* Wmix_t = (bf16*)(F.ws + WS_WMIX); bf16* Wssm_t = (bf16*)(F.ws + WS_WSSM);
    constexpr int I_IN = 16 * 288, I_DT = 16, I_CV = 16 * 32, I_MX = 16 * 32, I_SS = 32 * 32, I_RT = 16 * 3 * 2;
    constexpr int NITEMS = I_IN + I_DT + I_CV + I_MX + I_SS + I_RT;
    const float* wer = ARG(I_WER); const float* wgrp = ARG(I_WGRP); const float* sng0 = ARG(I_SNG);
    for (int it0 = gw; it0 < NITEMS * reps; it0 += NGW) {
        int r = it0 % NITEMS;
        if (r < I_IN) { const int kb = r / 288, nb = r % 288;
            auto wsrc = [&](int k, int npp) -> float {
                const int np = inproj_tile(npp >> 8) * 256 + (npp & 255);
                int col; if (np < 2048) { const int q = np >> 3, rr = np & 7; col = (rr >> 2) * 1024 + 4 * q + (rr & 3); } else if (np < 7168) col = np; else col = np + 32;
                return win[(size_t)k * WIN_LD + col]; };
            if (nb < NP8 * 8) transpose_item8(wsrc, D, F.ws + WS_W8IN, scr, kb, nb * 32, lane); else transpose_item(wsrc, D, Win_t, scr, kb, nb * 32, lane);
            continue; } r -= I_IN;
        if (r < I_DT) { transpose_item([&](int k, int np) -> float { return win[(size_t)k * WIN_LD + 7168 + np]; }, D, Wdt_t, scr, r, 0, lane); continue; } r -= I_DT;
        if (r < I_CV) { transpose_item([&](int k, int np) -> float { return wcv[(size_t)k * D + np]; }, D, Wcv_t, scr, r / 32, (r % 32) * 32, lane); continue; } r -= I_CV;
        if (r < I_MX) { transpose_item([&](int k, int np) -> float { return wmix[(size_t)k * D + np]; }, D, Wmix_t, scr, r / 32, (r % 32) * 32, lane); continue; } r -= I_MX;
        if (r < I_SS) { transpose_item([&](int k, int np) -> float { return wssm[(size_t)k * D + np] * sng0[k]; }, DIN, Wssm_t, scr, r / 32, (r % 32) * 32, lane); continue; } r -= I_SS;
        {
            const int lo = r / 48, rr = r % 48, kb = rr / 3, nb = rr % 3;
            auto wsrc = [&](int k, int np) -> float { float w = 0.f; if (np < 64) w = wer[(size_t)k * NE + np]; else if (np < 72) w = wgrp[(size_t)k * 8 + (np - 64)];
                const float hi = bflo(pk2(w, 0.f)); return lo ? (w - hi) : hi; };
            transpose_item(wsrc, D, (bf16*)(F.ws + (lo ? WS_WRL : WS_WRH)), scr, kb, nb * 32, lane);
        }
    }
}

DI void convert_experts(const Ctx& F, const Args& a) {
    const int gw = F.vcu * NWAVES + F.wave, NGW = F.G * NWAVES, lane = lane_id();
    LAS float* scr = (LAS float*)(F.lds + F.wave * 17408);
    const float* w1 = ARG(I_W1); const float* w3 = ARG(I_W3); const float* w2 = ARG(I_W2);
    unsigned char* W13_t = F.ws + WS_W13; unsigned char* W2_t = F.ws + WS_W2;
    constexpr int I_13 = NE * 4 * 16, I_2 = NE * 2 * 16, NIT = I_13 + I_2;
    const int ch = lane & 15, kq = lane >> 4;
    for (int it = gw; it < NIT; it += NGW) {
        const float* src; size_t ld; unsigned char* dst;
        if (it < I_13) { const int e = it >> 6, r = it & 63, kb = r >> 4, cb = r & 15;
            src = ((ch & 1) ? w3 : w1) + (size_t)e * D * DFF + (size_t)(256 * kb + kq) * DFF + 32 * cb + 4 * (ch >> 1); ld = DFF;
            dst = W13_t + (size_t)e * D * D + (size_t)(64 * cb + lane) * D + 256 * kb;
        } else { const int r0 = it - I_13, e = r0 >> 5, r = r0 & 31, kb = r >> 4, nb = r & 15;
            src = w2 + (size_t)e * DFF * D + (size_t)(256 * kb + kq) * D + 64 * nb + 4 * ch; ld = D;
            dst = W2_t + (size_t)e * D * DFF + (size_t)(64 * nb + lane) * DFF + 256 * kb;
        }
        f32x4 va[16], vb[16]; v4u o[16];
#pragma unroll
        for (int i = 0; i < 16; ++i) va[i] = __builtin_nontemporal_load((const f32x4*)(src + (size_t)(4 * i) * ld));
#pragma unroll
        for (int sub = 0; sub < 4; ++sub) {
            f32x4 (&cur)[16] = (sub & 1) ? vb : va; f32x4 (&nxt)[16] = (sub & 1) ? va : vb;
            if (sub < 3) {
#pragma unroll
                for (int i = 0; i < 16; ++i) nxt[i] = __builtin_nontemporal_load((const f32x4*)(src + (size_t)(64 * (sub + 1) + 4 * i) * ld));
            }
#pragma unroll
            for (int i = 0; i < 16; ++i) *(LAS f32x4*)(scr + (4 * i + kq) * 68 + 4 * ch) = cur[i] * 64.0f;
            LDS_WAIT(); asm volatile("" ::: "memory");
#pragma unroll
            for (int j = 0; j < 4; ++j) {
                unsigned w[4];
#pragma unroll
                for (int q = 0; q < 4; ++q) { const LAS float* sp = scr + (16 * j + 4 * q) * 68 + lane; w[q] = pk4_fp8(sp[0], sp[68], sp[136], sp[204]); }
                o[4 * sub + j].x = w[0]; o[4 * sub + j].y = w[1]; o[4 * sub + j].z = w[2]; o[4 * sub + j].w = w[3];
            }
            LDS_WAIT(); asm volatile("" ::: "memory");
        }
#pragma unroll
        for (int j = 0; j < 16; ++j) *(v4u*)(dst + 16 * j) = o[j];
    }
}

DI void ph1_norm_dt(const Ctx& F, const Args& a) {
    const float* mod = (const float*)(F.ws + WS_CTL) + CW_MOD;
    const float* x = ARG(I_X); const float* n1g = ARG(I_N1G); const float* dtb = ARG(I_DTB);
    bf16* XN = (bf16*)(F.ws + WS_XN); const bf16* Wdt_t = (const bf16*)(F.ws + WS_WDT); float* DT = (float*)(F.ws + WS_DT);
    const int lane = lane_id(), wave = F.wave;
    f32x4 gm[4], ga[4];
#pragma unroll
    for (int j = 0; j < 4; ++j) { const int k = 256 * j + 4 * lane; const f32x4 g = *(const f32x4*)(n1g + k), sc = mod4(mod, 1024 + k);
        gm[j] = g * (sc + 1.0f); ga[j] = mod4(mod, k); }
    if (F.vcu == 0) { float* modc = (float*)(F.ws + WS_CTL) + CW_MODC; for (int k = (F.wave * 64 + lane_id()) * 4; k < 6 * D; k += NTHREADS * 4) *(f32x4*)(modc + k) = mod4(mod, k); }
    for (int unit = F.vcu; unit < M / 64; unit += F.G) {
        const int row0 = unit * 64;
#pragma unroll 1
        for (int rh = 0; rh < 2; ++rh) {
            f32x4 v[4][4];
#pragma unroll
            for (int rr = 0; rr < 4; ++rr)
#pragma unroll
                for (int j = 0; j < 4; ++j) v[rr][j] = __builtin_nontemporal_load((const f32x4*)(x + (size_t)(row0 + wave * 8 + rh * 4 + rr) * D + 256 * j + 4 * lane));
#pragma unroll
            for (int rr = 0; rr < 4; ++rr) {
                const int rl = wave * 8 + rh * 4 + rr, row = row0 + rl; float ss = 0.f;
#pragma unroll
                for (int j = 0; j < 4; ++j) ss += (v[rr][j].x * v[rr][j].x + v[rr][j].y * v[rr][j].y) + (v[rr][j].z * v[rr][j].z + v[rr][j].w * v[rr][j].w);
                const float rstd = 1.0f / sqrtf(wave_sum(ss) * (1.0f / D) + EPS);
#pragma unroll
                for (int j = 0; j < 4; ++j) { const f32x4 n = v[rr][j] * rstd * gm[j] + ga[j];
                    v2u w; w.x = pk2(n.x, n.y); w.y = pk2(n.z, n.w);
                    *(v2u*)(XN + (size_t)row * D + 256 * j + 4 * lane) = w;
                    *(unsigned*)(F.ws + WS_XN8 + (size_t)row * D + 256 * j + 4 * lane) = pk4_fp8(n.x, n.y, n.z, n.w);
                    const int chunk = (32 * j + (lane >> 1)) ^ (rl & 15);
                    *(LAS v2u*)(F.lds + rl * 2048 + chunk * 16 + 8 * (lane & 1)) = w; }
            }
        }
        __syncthreads();
        {
            const int rt = wave & 3, ct = wave >> 2, fr = lane & 15, fq = lane >> 4;
            pg8::f32x4 acc = {0.f, 0.f, 0.f, 0.f};
            const bf16* wrow = Wdt_t + (size_t)(16 * ct + fr) * D + 8 * fq;
#pragma unroll 4
            for (int ks = 0; ks < 32; ++ks) {
                const bf16x8 av = *(const LAS bf16x8*)(F.lds + (16 * rt + fr) * 2048 + (((4 * ks + fq) ^ fr) * 16));
                const bf16x8 bv = *(const bf16x8*)(wrow + 32 * ks);
                acc = __builtin_amdgcn_mfma_f32_16x16x32_bf16(av, bv, acc, 0, 0, 0);
            }
            const float bias = dtb[16 * ct + fr];
#pragma unroll
            for (int r = 0; r < 4; ++r) { const float v = acc[r] + bias; const float sp = v > 20.f ? v : log1pf(__expf(v));
                DT[(size_t)(row0 + 16 * rt + 4 * fq + r) * NH + 16 * ct + fr] = sp; }
        }
        __syncthreads();
    }
}

DI void ph3_convbranch(const Ctx& F, const Args& a, int reps) {
    const bf16* U = (const bf16*)(F.ws + WS_U); bf16* UC = (bf16*)(F.ws + WS_XN);
    const float* cw = ARG(I_CVW); const float* cb = ARG(I_CVB); const float* lg = ARG(I_LNG); const float* lb = ARG(I_LNB);
    const int tid = F.wave * 64 + lane_id(), lane = lane_id(), wave = F.wave;
    LAS unsigned char* tile = F.lds;
    LAS float* red = (LAS float*)(F.lds + 62 * 2048);
    LAS float* stat = red + 32 * 8 * 2;
    f2v w[31];
#pragma unroll
    for (int j = 0; j < 31; ++j) w[j] = *(const f2v*)(cw + j * D + 2 * tid);
    const f2v bias = *(const f2v*)(cb + 2 * tid), gam = *(const f2v*)(lg + 2 * tid), bet = *(const f2v*)(lb + 2 * tid);
    const int RU = (M / 32 + F.G - 1) / F.G;
    for (int it = 0; it < RU * reps; ++it) {
        const int unit = xcd_unit(F.xcd, F.xj, F.G >> 3, (it >= RU ? it - RU : it), M / 32); if (unit < 0) break; const int t0 = unit * 32;
        for (int piece = tid; piece < 62 * 128; piece += NTHREADS) { const int r = piece >> 7, cch = piece & 127, t = t0 - 30 + r;
            v4u v = {0u, 0u, 0u, 0u}; if (t >= 0) v = *(const v4u*)(U + (size_t)t * D + cch * 8);
            *(LAS v4u*)(tile + r * 2048 + cch * 16) = v; }
        __syncthreads();
        f2v o[32];
#pragma unroll
        for (int tg = 0; tg < 8; ++tg) {
            f2v acc[4];
#pragma unroll
            for (int i = 0; i < 4; ++i) acc[i] = bias;
#pragma unroll
            for (int j = 0; j < 34; ++j) {
                const unsigned uu = *(const LAS unsigned*)(tile + (4 * tg + j) * 2048 + tid * 4);
                const f2v u2 = {bflo(uu), bfhi(uu)};
#pragma unroll
                for (int i = 0; i < 4; ++i) { const int jj = j - i; if (jj >= 0 && jj <= 30) acc[i] = __builtin_elementwise_fma(w[jj], u2, acc[i]); }
            }
#pragma unroll
            for (int i = 0; i < 4; ++i) o[4 * tg + i] = acc[i];
        }
        {
            float r5[64];
#pragma unroll
            for (int tk = 0; tk < 32; ++tk) { r5[2 * tk] = o[tk].x + o[tk].y; r5[2 * tk + 1] = o[tk].x * o[tk].x + o[tk].y * o[tk].y; }
            float r4[32], r3[16], r2[8], r1[4], r0[2];
            { const bool up = (lane & 32) != 0;
#pragma unroll
              for (int i = 0; i < 32; ++i) { const float keep = up ? r5[i + 32] : r5[i], send = up ? r5[i] : r5[i + 32]; r4[i] = keep + __shfl_xor(send, 32); } }
            { const bool up = (lane & 16) != 0;
#pragma unroll
              for (int i = 0; i < 16; ++i) { const float keep = up ? r4[i + 16] : r4[i], send = up ? r4[i] : r4[i + 16]; r3[i] = keep + __shfl_xor(send, 16); } }
            { const bool up = (lane & 8) != 0;
#pragma unroll
              for (int i = 0; i < 8; ++i) { const float keep = up ? r3[i + 8] : r3[i], send = up ? r3[i] : r3[i + 8]; r2[i] = keep + __shfl_xor(send, 8); } }
            { const bool up = (lane & 4) != 0;
#pragma unroll
              for (int i = 0; i < 4; ++i) { const float keep = up ? r2[i + 4] : r2[i], send = up ? r2[i] : r2[i + 4]; r1[i] = keep + __shfl_xor(send, 4); } }
            { const bool up = (lane & 2) != 0;
#pragma unroll
              for (int i = 0; i < 2; ++i) { const float keep = up ? r1[i + 2] : r1[i], send = up ? r1[i] : r1[i + 2]; r0[i] = keep + __shfl_xor(send, 2); } }
            const bool up0 = (lane & 1) != 0;
            const float tot = (up0 ? r0[1] : r0[0]) + __shfl_xor(up0 ? r0[0] : r0[1], 1);
            red[((lane >> 1) * 8 + wave) * 2 + (lane & 1)] = tot;
        }
        __syncthreads();
        if (tid < 32) { float s = 0.f, q = 0.f;
#pragma unroll
            for (int wv = 0; wv < 8; ++wv) { s += red[(tid * 8 + wv) * 2]; q += red[(tid * 8 + wv) * 2 + 1]; }
            const float mean = s * (1.0f / D); const float var = fmaxf(q * (1.0f / D) - mean * mean, 0.f);
            stat[tid * 2] = mean; stat[tid * 2 + 1] = 1.0f / sqrtf(var + EPS); }
        __syncthreads();
#pragma unroll
        for (int tk = 0; tk < 32; ++tk) { const float mean = stat[tk * 2], rstd = stat[tk * 2 + 1];
            const float y0 = (o[tk].x - mean) * rstd * gam.x + bet.x, y1 = (o[tk].y - mean) * rstd * gam.y + bet.y;
            *(unsigned*)(UC + (size_t)(t0 + tk) * D + 2 * tid) = pk2(siluf_(y0), siluf_(y1)); }
        __syncthreads();
    }
}

DI void conv_block(const bf16* XBC, const float* cw, const float* cb, int t_first, int col, float (&o)[8][8]) {
    v4u raw[11];
#pragma unroll
    for (int r = 0; r < 11; ++r) { const int t = t_first - 3 + r; const int tc = t < 0 ? 0 : t; v4u v = *(const v4u*)(XBC + (size_t)tc * XBCW + col);
        const unsigned msk = t < 0 ? 0u : 0xffffffffu; v.x &= msk; v.y &= msk; v.z &= msk; v.w &= msk; raw[r] = v; }
    float w[4][8], b[8];
#pragma unroll
    for (int j = 0; j < 4; ++j) { const f32x4 lo = *(const f32x4*)(cw + j * XBCW + col), hi = *(const f32x4*)(cw + j * XBCW + col + 4);
        w[j][0] = lo.x; w[j][1] = lo.y; w[j][2] = lo.z; w[j][3] = lo.w; w[j][4] = hi.x; w[j][5] = hi.y; w[j][6] = hi.z; w[j][7] = hi.w; }
    { const f32x4 lo = *(const f32x4*)(cb + col), hi = *(const f32x4*)(cb + col + 4); b[0] = lo.x; b[1] = lo.y; b[2] = lo.z; b[3] = lo.w; b[4] = hi.x; b[5] = hi.y; b[6] = hi.z; b[7] = hi.w; }
#pragma unroll
    for (int tk = 0; tk < 8; ++tk)
#pragma unroll
        for (int ch = 0; ch < 8; ++ch) {
            float acc = b[ch];
#pragma unroll
            for (int j = 0; j < 4; ++j) { const unsigned wd = raw[tk + j][ch >> 1]; const float xv = (ch & 1) ? bfhi(wd) : bflo(wd); acc += w[j][ch] * xv; }
            o[tk][ch] = siluf_(acc);
        }
}
DI float head_scan(const float* DT, const float* alog, int t0, int h, int lane, LAS float* acs_h, LAS float* dtv_h, float& d0o, float& d1o, float& c0o, float& c1o) {
    const float d0 = DT[(size_t)(t0 + 2 * lane) * NH + h], d1 = DT[(size_t)(t0 + 2 * lane + 1) * NH + h];
    const float A2 = -__expf(alog[h]) * LOG2E;
    const float a0 = d0 * A2, a1 = d1 * A2; float inc = a0 + a1;
#pragma unroll
    for (int o = 1; o < 64; o <<= 1) { const float t = __shfl_up(inc, o); if (lane >= o) inc += t; }
    acs_h[2 * lane] = inc - a1; acs_h[2 * lane + 1] = inc; dtv_h[2 * lane] = d0; dtv_h[2 * lane + 1] = d1;
    d0o = d0; d1o = d1; c0o = inc - a1; c1o = inc;
    return __shfl(inc, 63);
}

constexpr int S_CN = 0, S_BN = 32768, S_XT = 65536, S_ACS = 131072, S_DTV = 135168, S_SSQ = 139264, S_FS = 139776;

DI void ph3_chunk_states(const Ctx& F, const Args& a, int reps) {
    const bf16* XBC = (const bf16*)(F.ws + WS_XBC); const float* DT = (const float*)(F.ws + WS_DT);
    bf16* ST = (bf16*)(F.ws + WS_ST); float* CD = (float*)(F.ws + WS_CD);
    const float* scw = ARG(I_SCW); const float* scb = ARG(I_SCB); const float* alog = ARG(I_ALOG);
    const int tid = F.wave * 64 + lane_id(), lane = lane_id(), wave = F.wave, hh = lane >> 5;
    LAS unsigned char* lds = F.lds;
    LAS float* acs = (LAS float*)(lds + S_ACS); LAS float* wsc = (LAS float*)(lds + S_DTV);
    const int RU = (NCH * NGRP + F.G - 1) / F.G;
    for (int it = 0; it < RU * reps; ++it) {
        const int unit = xcd_unit(F.xcd, F.xj, F.G >> 3, (it >= RU ? it - RU : it), NCH * NGRP); if (unit < 0) break; const int c = unit >> 2, g = unit & 3, t0 = c * LCH;
        {
            const int h = 8 * g + wave; float d0, d1, c0, c1;
            const float total = head_scan(DT, alog, t0, h, lane, acs + wave * 128, wsc + wave * 128, d0, d1, c0, c1);
            wsc[wave * 128 + 2 * lane] = d0 * __builtin_amdgcn_exp2f(total - c0); wsc[wave * 128 + 2 * lane + 1] = d1 * __builtin_amdgcn_exp2f(total - c1);
            if (lane == 0) CD[c * NH + h] = __builtin_amdgcn_exp2f(total);
        }
        __syncthreads();
        if (tid < 256) { const int co = tid & 15, to = tid >> 4; float o[8][8];
            conv_block(XBC, scw, scb, t0 + 8 * to, 2048 + 128 * g + 8 * co, o);
#pragma unroll
            for (int ch = 0; ch < 8; ++ch) { const int row = 8 * co + ch;
                v4u w; w.x = pk2(o[0][ch], o[1][ch]); w.y = pk2(o[2][ch], o[3][ch]); w.z = pk2(o[4][ch], o[5][ch]); w.w = pk2(o[6][ch], o[7][ch]);
                *(LAS v4u*)(lds + S_BN + row * 256 + swz(row, to) * 16) = w; } }
        for (int ps = 0; ps < 2; ++ps) {
            {
                const int co = tid & 31, to = tid >> 5, hd = co >> 3, p0 = (co & 7) * 8; float o[8][8];
                conv_block(XBC, scw, scb, t0 + 8 * to, 512 * g + 64 * (4 * ps + hd) + p0, o);
                float sc[8];
#pragma unroll
                for (int tk = 0; tk < 8; ++tk) sc[tk] = wsc[(4 * ps + hd) * 128 + 8 * to + tk];
#pragma unroll
                for (int ch = 0; ch < 8; ++ch) { const int row = hd * 64 + p0 + ch;
                    v4u w; w.x = pk2(o[0][ch] * sc[0], o[1][ch] * sc[1]); w.y = pk2(o[2][ch] * sc[2], o[3][ch] * sc[3]);
                    w.z = pk2(o[4][ch] * sc[4], o[5][ch] * sc[5]); w.w = pk2(o[6][ch] * sc[6], o[7][ch] * sc[7]);
                    *(LAS v4u*)(lds + S_XT + row * 256 + swz(row, to) * 16) = w; }
            }
            __syncthreads();
            {
                const int hd = wave & 3, ph = wave >> 2, h = 8 * g + 4 * ps + hd;
                f32x16 acc[4];
#pragma unroll
                for (int nt = 0; nt < 4; ++nt)
#pragma unroll
                    for (int i = 0; i < 16; ++i) acc[nt][i] = 0.f;
                const int arow = hd * 64 + 32 * ph + (lane & 31);
#pragma unroll
                for (int ks = 0; ks < 8; ++ks) {
                    const bf16x8 av = *(const LAS bf16x8*)(lds + S_XT + arow * 256 + swz(arow, 2 * ks + hh) * 16);
#pragma unroll
                    for (int nt = 0; nt < 4; ++nt) { const int brow = 32 * nt + (lane & 31);
                        const bf16x8 bv = *(const LAS bf16x8*)(lds + S_BN + brow * 256 + swz(brow, 2 * ks + hh) * 16);
                        acc[nt] = MFMA32(av, bv, acc[nt]); }
                }
                bf16* dst = ST + ((size_t)(c * NH + h) * HD) * NST;
#pragma unroll
                for (int nt = 0; nt < 4; ++nt)
#pragma unroll
                    for (int i = 0; i < 16; i += 2) { const int p = 32 * ph + crow(i, hh); const unsigned pk = pk2(acc[nt][i], acc[nt][i + 1]);
                        dst[(size_t)p * NST + 32 * nt + (lane & 31)] = (bf16)(pk & 0xffffu); dst[(size_t)(p + 1) * NST + 32 * nt + (lane & 31)] = (bf16)(pk >> 16); }
            }
            __syncthreads();
        }
    }
}

DI void ph4_scan(const Ctx& F, size_t dst_off) {
    unsigned* ST32 = (unsigned*)(F.ws + WS_ST); unsigned* DST32 = (unsigned*)(F.ws + dst_off); const float* CD = (const float*)(F.ws + WS_CD);
    constexpr int NPAIR = NH * HD * NST / 2;
    for (int e = F.vcu * NTHREADS + (F.wave * 64 + lane_id()); e < NPAIR; e += F.G * NTHREADS) {
        const int h = e >> 12; float c0 = 0.f, c1 = 0.f;
#pragma unroll 1
        for (int cb = 0; cb < NCH; cb += 32) {
            unsigned v[32]; float dec[32];
#pragma unroll
            for (int i = 0; i < 32; ++i) { v[i] = __builtin_nontemporal_load(ST32 + (size_t)(cb + i) * NPAIR + e); dec[i] = CD[(cb + i) * NH + h]; }
#pragma unroll
            for (int i = 0; i < 32; ++i) { DST32[(size_t)(cb + i) * NPAIR + e] = pk2(c0, c1); c0 = c0 * dec[i] + bflo(v[i]); c1 = c1 * dec[i] + bfhi(v[i]); }
        }
    }
}

DI void ph5_ssd_out(const Ctx& F, const Args& a, int reps) {
    const bf16* XBC = (const bf16*)(F.ws + WS_XBC); const float* DT = (const float*)(F.ws + WS_DT);
    const bf16* ST = (const bf16*)(F.ws + WS_ST); const bf16* ZS = (const bf16*)(F.ws + WS_ZS); bf16* YS = (bf16*)(F.ws + WS_YS);
    const float* scw = ARG(I_SCW); const float* scb = ARG(I_SCB); const float* alog = ARG(I_ALOG); const float* dskip = ARG(I_DSKIP);
    const int tid = F.wave * 64 + lane_id(), lane = lane_id(), wave = F.wave, hh = lane >> 5, l31 = lane & 31;
    LAS unsigned char* lds = F.lds;
    LAS float* acs = (LAS float*)(lds + S_ACS); LAS float* dtv = (LAS float*)(lds + S_DTV); LAS float* ssq = (LAS float*)(lds + S_SSQ);
    const int RU = (NCH * NGRP + F.G - 1) / F.G;
    for (int it = 0; it < RU * reps; ++it) {
        const int unit = xcd_unit(F.xcd, F.xj, F.G >> 3, (it >= RU ? it - RU : it), NCH * NGRP); if (unit < 0) break; const int c = unit >> 2, g = unit & 3, t0 = c * LCH;
        { const int h = 8 * g + wave; float d0, d1, c0, c1; (void)head_scan(DT, alog, t0, h, lane, acs + wave * 128, dtv + wave * 128, d0, d1, c0, c1);
          const float cend = __shfl(c1, (lane & 48) | 15);
          LAS float* fsw = (LAS float*)(lds + S_FS) + wave * 128;
          fsw[2 * lane] = d0 * __builtin_amdgcn_exp2f(cend - c0); fsw[2 * lane + 1] = d1 * __builtin_amdgcn_exp2f(cend - c1); }
        if (tid < 128) ssq[tid] = 0.f;
        { const int which = tid >> 8, t8 = tid & 255, co = t8 & 15; int to = t8 >> 4; asm volatile("" : "+v"(to)); float o[8][8];
            conv_block(XBC, scw, scb, t0 + 8 * to, (which ? 2560 : 2048) + 128 * g + 8 * co, o);
            const int base = which ? S_CN : S_BN;
#pragma unroll
            for (int tk = 0; tk < 8; ++tk) { const int row = 8 * to + tk;
                v4u w; w.x = pk2(o[tk][0], o[tk][1]); w.y = pk2(o[tk][2], o[tk][3]); w.z = pk2(o[tk][4], o[tk][5]); w.w = pk2(o[tk][6], o[tk][7]);
                *(LAS v4u*)(lds + base + row * 256 + swz(row, co) * 16) = w; } }
#pragma unroll 1
        for (int ps = 0; ps < 2; ++ps) {
            {
                const int co = tid & 31; int to = tid >> 5; asm volatile("" : "+v"(to));
                const int hd = co >> 3, p0 = (co & 7) * 8; float o[8][8];
                conv_block(XBC, scw, scb, t0 + 8 * to, 512 * g + 64 * (4 * ps + hd) + p0, o);
#pragma unroll
                for (int ch = 0; ch < 8; ++ch) { const int row = hd * 64 + p0 + ch;
                    v4u w; w.x = pk2(o[0][ch], o[1][ch]); w.y = pk2(o[2][ch], o[3][ch]); w.z = pk2(o[4][ch], o[5][ch]); w.w = pk2(o[6][ch], o[7][ch]);
                    *(LAS v4u*)(lds + S_XT + row * 256 + swz(row, to) * 16) = w; }
            }
            __syncthreads();
            const int hd = wave & 3, lp = wave >> 2, hl = 4 * ps + hd, h = 8 * g + hl;
            const float Dh = dskip[h];
            const LAS float* acs_h = acs + hl * 128; const LAS float* dt_h = dtv + hl * 128; const LAS float* fs_h = (const LAS float*)(lds + S_FS) + hl * 128;
            const bf16* prev = ST + ((size_t)(c * NH + h) * HD) * NST;
            const int erow = lane >> 1, ehalf = lane & 1;
            f32x16 acc[2][2];
            {
#pragma unroll
                for (int which = 0; which < 2; ++which)
#pragma unroll
                    for (int pt = 0; pt < 2; ++pt)
#pragma unroll
                        for (int i = 0; i < 16; ++i) acc[which][pt][i] = 0.f;
                const int rowA = 32 * lp + l31, rowB = 32 * (3 - lp) + l31;
#pragma unroll
                for (int ks = 0; ks < 8; ++ks) {
                    const bf16x8 b0 = *(const bf16x8*)(prev + (size_t)l31 * NST + 16 * ks + 8 * hh), b1 = *(const bf16x8*)(prev + (size_t)(32 + l31) * NST + 16 * ks + 8 * hh);
                    const bf16x8 a0 = *(const LAS bf16x8*)(lds + S_CN + rowA * 256 + swz(rowA, 2 * ks + hh) * 16);
                    const bf16x8 a1 = *(const LAS bf16x8*)(lds + S_CN + rowB * 256 + swz(rowB, 2 * ks + hh) * 16);
                    acc[0][0] = MFMA32(a0, b0, acc[0][0]); acc[0][1] = MFMA32(a0, b1, acc[0][1]);
                    acc[1][0] = MFMA32(a1, b0, acc[1][0]); acc[1][1] = MFMA32(a1, b1, acc[1][1]);
                }
#pragma unroll
                for (int which = 0; which < 2; ++which) { const int li = which == 0 ? lp : 3 - lp;
#pragma unroll
                    for (int i = 0; i < 16; ++i) { const float e = __builtin_amdgcn_exp2f(acs_h[32 * li + crow(i, hh)]); acc[which][0][i] *= e; acc[which][1][i] *= e; } }
            }
            {
                const int liA = lp, liB = 3 - lp;
                const int rowA = 32 * liA + l31, rowB = 32 * liB + l31;
                const float alA = acs_h[rowA], alB = acs_h[rowB];
#pragma unroll 1
                for (int sj = 0; sj <= liB; ++sj) {
                    const bool doA = sj <= liA;
                    f32x16 GA, GB;
#pragma unroll
                    for (int i = 0; i < 16; ++i) { GA[i] = 0.f; GB[i] = 0.f; }
                    const int brow = 32 * sj + l31;
                    if (doA) {
#pragma unroll 2
                        for (int ks = 0; ks < 8; ++ks) {
                            const bf16x8 av = *(const LAS bf16x8*)(lds + S_BN + brow * 256 + swz(brow, 2 * ks + hh) * 16);
                            const bf16x8 ca = *(const LAS bf16x8*)(lds + S_CN + rowA * 256 + swz(rowA, 2 * ks + hh) * 16);
                            const bf16x8 cb = *(const LAS bf16x8*)(lds + S_CN + rowB * 256 + swz(rowB, 2 * ks + hh) * 16);
                            GA = MFMA32(av, ca, GA); GB = MFMA32(av, cb, GB);
                        }
                    } else {
#pragma unroll 2
                        for (int ks = 0; ks < 8; ++ks) {
                            const bf16x8 av = *(const LAS bf16x8*)(lds + S_BN + brow * 256 + swz(brow, 2 * ks + hh) * 16);
                            const bf16x8 cb = *(const LAS bf16x8*)(lds + S_CN + rowB * 256 + swz(rowB, 2 * ks + hh) * 16);
                            GB = MFMA32(av, cb, GB);
                        }
                    }
                    auto mask = [&](f32x16& G, int li, int row_l, float al) {
                        if (sj < li) {
                            const float fl = __builtin_amdgcn_exp2f(al - acs_h[32 * sj + 31]);
#pragma unroll
                            for (int i = 0; i < 16; ++i) G[i] = G[i] * (fs_h[32 * sj + crow(i, hh)] * fl);
                        } else {
#pragma unroll
                            for (int i = 0; i < 16; ++i) { const int s = 32 * sj + crow(i, hh);
                                float v = G[i] * __builtin_amdgcn_exp2f(fminf(al - acs_h[s], 0.f)) * dt_h[s];
                                v = (s > row_l) ? 0.f : v; v = (s == row_l) ? v + Dh : v; G[i] = v; }
                        }
                    };
                    auto pv = [&](const f32x16& G, f32x16 (&ac)[2]) {
#pragma unroll
                        for (int s2 = 0; s2 < 2; ++s2) {
                            v4u fa; fa.x = pk2(G[8 * s2 + 0], G[8 * s2 + 1]); fa.y = pk2(G[8 * s2 + 2], G[8 * s2 + 3]); fa.z = pk2(G[8 * s2 + 4], G[8 * s2 + 5]); fa.w = pk2(G[8 * s2 + 6], G[8 * s2 + 7]);
#pragma unroll
                            for (int pt = 0; pt < 2; ++pt) { const int xrow = hd * 64 + 32 * pt + l31; const int sc0 = 32 * sj + 16 * s2;
                                const v2u lo = *(const LAS v2u*)(lds + S_XT + xrow * 256 + swz(xrow, (sc0 >> 3)) * 16 + 8 * hh);
                                const v2u hi = *(const LAS v2u*)(lds + S_XT + xrow * 256 + swz(xrow, (sc0 >> 3) + 1) * 16 + 8 * hh);
                                v4u bfr; bfr.x = lo.x; bfr.y = lo.y; bfr.z = hi.x; bfr.w = hi.y;
                                ac[pt] = MFMA32(__builtin_bit_cast(bf16x8, fa), __builtin_bit_cast(bf16x8, bfr), ac[pt]); }
                        }
                    };
                    if (doA) { mask(GA, liA, rowA, alA); pv(GA, acc[0]); }
                    mask(GB, liB, rowB, alB); pv(GB, acc[1]);
                }
            }
            asm volatile("" ::: "memory");
            v4u zs[2][4];
#pragma unroll
            for (int which = 0; which < 2; ++which) { const int li = which == 0 ? lp : 3 - lp; const size_t t = (size_t)(t0 + 32 * li + erow);
#pragma unroll
                for (int j = 0; j < 4; ++j) zs[which][j] = *(const v4u*)(ZS + t * DIN + 64 * h + 32 * ehalf + 8 * j); }
            __syncthreads();
            {
                LAS unsigned char* stg = lds + S_XT + wave * 8192;
#pragma unroll
                for (int which = 0; which < 2; ++which)
#pragma unroll
                    for (int pt = 0; pt < 2; ++pt)
#pragma unroll
                        for (int i = 0; i < 16; ++i) *(LAS bf16*)(stg + ((which * 32 + crow(i, hh)) * 64 + 32 * pt + l31) * 2) = (bf16)(pk2(acc[which][pt][i], 0.f) & 0xffffu);
                LDS_WAIT(); asm volatile("" ::: "memory");
#pragma unroll
                for (int which = 0; which < 2; ++which) { const int li = which == 0 ? lp : 3 - lp; const int l = 32 * li + erow; const size_t t = (size_t)(t0 + l);
                    float q = 0.f;
#pragma unroll
                    for (int j = 0; j < 4; ++j) { const v4u yv = *(const LAS v4u*)(stg + ((which * 32 + erow) * 64 + 32 * ehalf + 8 * j) * 2); const v4u zv = zs[which][j];
                        float y[8] = {bflo(yv.x) * bflo(zv.x), bfhi(yv.x) * bfhi(zv.x), bflo(yv.y) * bflo(zv.y), bfhi(yv.y) * bfhi(zv.y), bflo(yv.z) * bflo(zv.z), bfhi(yv.z) * bfhi(zv.z), bflo(yv.w) * bflo(zv.w), bfhi(yv.w) * bfhi(zv.w)};
#pragma unroll
                        for (int k = 0; k < 8; ++k) q += y[k] * y[k];
                        v4u w; w.x = pk2(y[0], y[1]); w.y = pk2(y[2], y[3]); w.z = pk2(y[4], y[5]); w.w = pk2(y[6], y[7]);
                        *(v4u*)(YS + t * DIN + 64 * h + 32 * ehalf + 8 * j) = w; }
                    q += __shfl_xor(q, 1);
                    if (ehalf == 0) __hip_atomic_fetch_add(ssq + l, q, __ATOMIC_RELAXED, __HIP_MEMORY_SCOPE_WORKGROUP);
                }
            }
            __syncthreads();
        }
        if (tid < 128) ((float*)(F.ws + WS_RSTD))[(size_t)(t0 + tid) * 4 + g] = 1.0f / sqrtf(ssq[tid] * (1.0f / 512.f) + EPS);
        __syncthreads();
    }
}

constexpr int RT_LD = 1028;
DI void ph8_router(const Ctx& F, const Args& a, int reps) {
    const float* mod = (const float*)(F.ws + WS_CTL) + CW_MODC;
    const bf16* H = (const bf16*)(F.ws + WS_H16); const float* n2g = ARG(I_N2G); const float* bgrp = ARG(I_BGRP); const float* ber = ARG(I_BER);
    unsigned char* XN2 = F.ws + WS_XN; int* cnt0 = (int*)(F.ws + WS_CTL) + CW_CNT;
    int* RE = (int*)(F.ws + WS_ROUTE); int* RP = RE + 2 * M; float* RW = (float*)(RP + 2 * M); int* LIST = (int*)(F.ws + WS_LIST);
    const int lane = lane_id(), wave = F.wave;
    LAS float* tile = (LAS float*)F.lds;
    LAS float* pe = (LAS float*)F.lds;
    f32x4 gm[4], ga[4];
#pragma unroll
    for (int j = 0; j < 4; ++j) { const int k = 256 * j + 4 * lane; const f32x4 g = *(const f32x4*)(n2g + k), sc = *(const f32x4*)(mod + 4096 + k);
        gm[j] = g * (sc + 1.0f); ga[j] = *(const f32x4*)(mod + 3072 + k); }
    const int RU = (M / 32 + F.G - 1) / F.G;
    for (int it = 0; it < RU * reps; ++it) {
        const int unit = xcd_unit(F.xcd, F.xj, F.G >> 3, (it >= RU ? it - RU : it), M / 32); if (unit < 0) break; int* cnt = cnt0 + ((it >= RU * (reps - 1)) ? 0 : 4096);
        const int row0 = unit * 32;
        {
            f32x4 v[4][4];
#pragma unroll
            for (int rr = 0; rr < 4; ++rr)
#pragma unroll
                for (int j = 0; j < 4; ++j) { const v2u hw = *(const v2u*)(H + (size_t)(row0 + wave * 4 + rr) * D + 256 * j + 4 * lane); v[rr][j] = (f32x4){bflo(hw.x), bfhi(hw.x), bflo(hw.y), bfhi(hw.y)}; }
#pragma unroll
            for (int rr = 0; rr < 4; ++rr) { const int rl = wave * 4 + rr, row = row0 + rl; float ss = 0.f;
#pragma unroll
                for (int j = 0; j < 4; ++j) ss += (v[rr][j].x * v[rr][j].x + v[rr][j].y * v[rr][j].y) + (v[rr][j].z * v[rr][j].z + v[rr][j].w * v[rr][j].w);
                const float rstd = 1.0f / sqrtf(wave_sum(ss) * (1.0f / D) + EPS);
#pragma unroll
                for (int j = 0; j < 4; ++j) { const f32x4 n = v[rr][j] * rstd * gm[j] + ga[j];
                    *(LAS f32x4*)(tile + rl * RT_LD + 256 * j + 4 * lane) = n;
                    *(unsigned*)(XN2 + (size_t)row * D + 256 * j + 4 * lane) = pk4_fp8(n.x, n.y, n.z, n.w); }
            }
        }
        __syncthreads();
        pg8::f32x4 acc[2][5];
#pragma unroll
        for (int rt = 0; rt < 2; ++rt)
#pragma unroll
            for (int ct = 0; ct < 5; ++ct) acc[rt][ct] = (pg8::f32x4){0.f, 0.f, 0.f, 0.f};
        const int kb = wave * 128, fr = lane & 15, kq = lane >> 4;
        const bf16* WRH = (const bf16*)(F.ws + WS_WRH); const bf16* WRL = (const bf16*)(F.ws + WS_WRL);
#pragma unroll 2
        for (int ks = 0; ks < 4; ++ks) {
            const int k0 = kb + 32 * ks + 8 * kq;
            bf16x8 bh[5], bl[5];
#pragma unroll
            for (int ct = 0; ct < 5; ++ct) { bh[ct] = *(const bf16x8*)(WRH + (size_t)(16 * ct + fr) * D + k0); bl[ct] = *(const bf16x8*)(WRL + (size_t)(16 * ct + fr) * D + k0); }
#pragma unroll
            for (int rt = 0; rt < 2; ++rt) {
                const f32x4 x0 = *(const LAS f32x4*)(tile + (16 * rt + fr) * RT_LD + k0), x1 = *(const LAS f32x4*)(tile + (16 * rt + fr) * RT_LD + k0 + 4);
                v4u hv, lv;
                hv.x = pk2(x0.x, x0.y); hv.y = pk2(x0.z, x0.w); hv.z = pk2(x1.x, x1.y); hv.w = pk2(x1.z, x1.w);
                lv.x = pk2(x0.x - bflo(hv.x), x0.y - bfhi(hv.x)); lv.y = pk2(x0.z - bflo(hv.y), x0.w - bfhi(hv.y));
                lv.z = pk2(x1.x - bflo(hv.z), x1.y - bfhi(hv.z)); lv.w = pk2(x1.z - bflo(hv.w), x1.w - bfhi(hv.w));
                const bf16x8 ah = __builtin_bit_cast(bf16x8, hv), al = __builtin_bit_cast(bf16x8, lv);
#pragma unroll
                for (int ct = 0; ct < 5; ++ct) {
                    acc[rt][ct] = __builtin_amdgcn_mfma_f32_16x16x32_bf16(ah, bh[ct], acc[rt][ct], 0, 0, 0);
                    acc[rt][ct] = __builtin_amdgcn_mfma_f32_16x16x32_bf16(ah, bl[ct], acc[rt][ct], 0, 0, 0);
                    acc[rt][ct] = __builtin_amdgcn_mfma_f32_16x16x32_bf16(al, bh[ct], acc[rt][ct], 0, 0, 0); }
            }
        }
        __syncthreads();
#pragma unroll
        for (int rt = 0; rt < 2; ++rt)
#pragma unroll
            for (int ct = 0; ct < 5; ++ct)
#pragma unroll
                for (int r = 0; r < 4; ++r) pe[(wave * 32 + 16 * rt + 4 * kq + r) * 80 + 16 * ct + fr] = acc[rt][ct][r];
        __syncthreads();
        int e0s[4], e1s[4]; float w0s[4], w1s[4];
#pragma unroll
        for (int rr = 0; rr < 4; ++rr) { const int rl = wave * 4 + rr;
            float le = ber[lane], lgv = (lane < 8) ? bgrp[lane] : 0.f;
#pragma unroll
            for (int wv = 0; wv < 8; ++wv) { le += pe[(wv * 32 + rl) * 80 + lane]; if (lane < 8) lgv += pe[(wv * 32 + rl) * 80 + 64 + lane]; }
            float gl[8];
#pragma unroll
            for (int i = 0; i < 8; ++i) gl[i] = __shfl(lgv, i);
            int gi = 0; float gmax = gl[0];
#pragma unroll
            for (int i = 1; i < 8; ++i) if (gl[i] > gmax) { gmax = gl[i]; gi = i; }
            float den = 0.f;
#pragma unroll
            for (int i = 0; i < 8; ++i) den += __expf(gl[i] - gmax);
            const float gp = 1.0f / den;
            float el[8];
#pragma unroll
            for (int i = 0; i < 8; ++i) el[i] = __shfl(le, gi * 8 + i);
            int i0 = 0; float m0 = el[0];
#pragma unroll
            for (int i = 1; i < 8; ++i) if (el[i] > m0) { m0 = el[i]; i0 = i; }
            int i1 = -1; float m1 = -INFINITY;
#pragma unroll
            for (int i = 0; i < 8; ++i) if (i != i0 && el[i] > m1) { m1 = el[i]; i1 = i; }
            const float dd = __expf(m1 - m0);
            w0s[rr] = gp / (1.0f + dd); w1s[rr] = gp * dd / (1.0f + dd); e0s[rr] = gi * 8 + i0; e1s[rr] = gi * 8 + i1;
        }
        if (lane == 0) {
            int p0[4], p1[4];
#pragma unroll
            for (int rr = 0; rr < 4; ++rr) { p0[rr] = atomicAdd(cnt + 64 * e0s[rr], 1); p1[rr] = atomicAdd(cnt + 64 * e1s[rr], 1); }
#pragma unroll
            for (int rr = 0; rr < 4; ++rr) { const int row = row0 + wave * 4 + rr;
                RE[2 * row] = e0s[rr]; RE[2 * row + 1] = e1s[rr]; RP[2 * row] = p0[rr]; RP[2 * row + 1] = p1[rr]; RW[2 * row] = w0s[rr]; RW[2 * row + 1] = w1s[rr];
                LIST[e0s[rr] * 16384 + p0[rr]] = row; LIST[e1s[rr] * 16384 + p1[rr]] = row; }
        }
        __syncthreads();
    }
}

DI void build_tilebase(const Ctx& F) {
    const int* cnt = (const int*)(F.ws + WS_CTL) + CW_CNT; LAS int* tb = (LAS int*)(F.lds + TB_OFF);
    if (F.wave == 0) {
        const int lane = lane_id(); const int tiles = (cnt[64 * lane] + 255) >> 8; int inc = tiles;
#pragma unroll
        for (int o = 1; o < 64; o <<= 1) { const int t = __shfl_up(inc, o); if (lane >= o) inc += t; }
        tb[lane] = inc - tiles; if (lane == 63) tb[NE] = inc; ((LAS int*)(F.lds + CNTL_OFF))[lane] = cnt[64 * lane];
    }
    __syncthreads();
}
DI void fill_tokl(const Ctx& F, const MoeOrder& S) {
    const LAS int* tb = (const LAS int*)(F.lds + TB_OFF); const LAS int* cntl = (const LAS int*)(F.lds + CNTL_OFF); LAS int* tokl = (LAS int*)(F.lds + TOKL_OFF);
    const int* LIST = (const int*)(F.ws + WS_LIST); const int tid = F.wave * 64 + lane_id();
    for (int i = 0; i < 4; ++i) { pg8::Unit u; if (!S.next(i, u)) break;
        const int e = u.pn >> 2, r = 256 * (u.pm - tb[e]) + tid;
        if (tid < 256) tokl[256 * i + tid] = (r < cntl[e]) ? LIST[e * 16384 + r] : 0; }
    asm volatile("s_waitcnt vmcnt(0) lgkmcnt(0)" ::: "memory"); __syncthreads();
}
DI void ph12_final(const Ctx& F, const Args& a, int reps) {
    const float* mod = (const float*)(F.ws + WS_CTL) + CW_MODC; float* H = (float*)argp<N_IN>(); const bf16* H16 = (const bf16*)(F.ws + WS_H16); const float* fg = ARG(I_FG);
    const unsigned char* YE = F.ws + WS_YEXP; const int* RE = (const int*)(F.ws + WS_ROUTE); const int* RP = RE + 2 * M; const float* RW = (const float*)(F.ws + WS_ROUTE) + 4 * M;
    const LAS int* tb = (const LAS int*)(F.lds + TB_OFF);
    float* OUT2 = (float*)(F.ws + WS_U);
    const int gw = F.vcu * NWAVES + F.wave, NGW = F.G * NWAVES, lane = lane_id();
    f32x4 g2[4], fgv[4];
#pragma unroll
    for (int j = 0; j < 4; ++j) { g2[j] = *(const f32x4*)(mod + 5 * 1024 + 256 * j + 4 * lane); fgv[j] = *(const f32x4*)(fg + 256 * j + 4 * lane); }
    const int RT = (M / 2 + NGW - 1) / NGW;
    for (int it = 0; it < RT * reps; ++it) {
        const int t0 = 2 * xcd_unit(F.xcd, F.xj * NWAVES + F.wave, NGW >> 3, (it >= RT ? it - RT : it), M / 2); if (t0 < 0) break;
        float* O = (it >= RT * (reps - 1)) ? H : OUT2;
        int tt[2], d0[2], d1[2]; float w0[2], w1[2];
#pragma unroll
        for (int u = 0; u < 2; ++u) { tt[u] = (t0 + u) % M; d0[u] = 256 * tb[RE[2 * tt[u]]] + RP[2 * tt[u]]; d1[u] = 256 * tb[RE[2 * tt[u] + 1]] + RP[2 * tt[u] + 1]; w0[u] = RW[2 * tt[u]]; w1[u] = RW[2 * tt[u] + 1]; }
        f32x4 hv[2][4]; unsigned ya[2][4], yb[2][4];
#pragma unroll
        for (int u = 0; u < 2; ++u)
#pragma unroll
            for (int j = 0; j < 4; ++j) { const v2u hw = *(const v2u*)(H16 + (size_t)tt[u] * D + 256 * j + 4 * lane); hv[u][j] = (f32x4){bflo(hw.x), bfhi(hw.x), bflo(hw.y), bfhi(hw.y)};
                ya[u][j] = *(const unsigned*)(YE + (size_t)d0[u] * D + 256 * j + 4 * lane); yb[u][j] = *(const unsigned*)(YE + (size_t)d1[u] * D + 256 * j + 4 * lane); }
#pragma unroll
        for (int u = 0; u < 2; ++u) {
            f32x4 v[4]; float ss = 0.f;
#pragma unroll
            for (int j = 0; j < 4; ++j) { const unsigned a4 = ya[u][j], b4 = yb[u][j];
                const f2v a01 = __builtin_amdgcn_cvt_pk_f32_fp8(a4, false), a23 = __builtin_amdgcn_cvt_pk_f32_fp8(a4, true), b01 = __builtin_amdgcn_cvt_pk_f32_fp8(b4, false), b23 = __builtin_amdgcn_cvt_pk_f32_fp8(b4, true);
                f32x4 mo; mo.x = w0[u] * a01.x + w1[u] * b01.x; mo.y = w0[u] * a01.y + w1[u] * b01.y; mo.z = w0[u] * a23.x + w1[u] * b23.x; mo.w = w0[u] * a23.y + w1[u] * b23.y;
                mo = mo * 0.0625f;
                v[j] = hv[u][j] + g2[j] * mo; ss += (v[j].x * v[j].x + v[j].y * v[j].y) + (v[j].z * v[j].z + v[j].w * v[j].w); }
            const float rstd = 1.0f / sqrtf(wave_sum(ss) * (1.0f / D) + EPS);
#pragma unroll
            for (int j = 0; j < 4; ++j) *(f32x4*)(O + (size_t)tt[u] * D + 256 * j + 4 * lane) = v[j] * rstd * fgv[j];
        }
    }
}

constexpr int N_PHASES = 13;
#ifndef REP_MASK
#define REP_MASK 0
#endif
#define REPS(k) (((REP_MASK >> (k)) & 1) ? 2 : 1)
#ifndef MK_ONE_LAUNCH
#define MK_ONE_LAUNCH 1
#endif

struct RepOrder { pg8::StaticOrder s; int n, reps;
    DI bool next(int i, pg8::Unit& u) const { if (i >= n * reps) return false; return s.next(i % n, u); }
    DI void a_ready(const pg8::Unit&) const {}
    DI void done(const pg8::Unit&) const {} };

__global__ void __launch_bounds__(NTHREADS, 2) fwd_kernel(Args args) {
    extern __shared__ __attribute__((aligned(16))) unsigned char lds_raw[];
    Ctx F;
    F.lds = (LAS unsigned char*)lds_raw;
    F.wave = __builtin_amdgcn_readfirstlane((int)threadIdx.x >> 6);
    F.G = gridDim.x; { const int bx = blockIdx.x; F.xcd = bx & 7; F.xj = bx >> 3; F.vcu = F.xcd * (F.G >> 3) + F.xj; }
    F.ws = (unsigned char*)argp<N_IN + 1>();
    volatile LAS unsigned* MISC = (volatile LAS unsigned*)(F.lds + LDSCTL_OFF);
    for (int u = threadIdx.x; u < (LDS_BYTES - LDSCTL_OFF) / 4; u += NTHREADS) ((LAS unsigned*)(F.lds + LDSCTL_OFF))[u] = 0u;
    __syncthreads();
    const int lo = args.ph_lo, hi = args.ph_hi;
    unsigned* barw = (unsigned*)(F.ws + WS_CTL) + CW_BAR;
    XcdBarrier bar; bar.bar = barw; bar.x = 0; bar.st = nullptr;
    if (hi - lo > 1) bar = xcd_barrier_post(barw, MISC + 8);
    bar.wave = F.wave;
#define IN(k) (lo <= (k) && (k) < hi)
#define SEAM(k) do { if (IN(k) && IN((k) + 1)) { xcd_barrier(bar); if (REPS(14) > 1) xcd_barrier(bar); } } while (0)
    unsigned char* ws = F.ws;
    bf16* XN = (bf16*)(ws + WS_XN);
    const float* mod = (const float*)(ws + WS_CTL) + CW_MOD;

    if (IN(0)) { ph0_prologue(F, args, REPS(0)); SEAM(0); }
    if (IN(1)) { for (int rep = 0; rep < REPS(1); ++rep) { ph1_norm_dt(F, args); __syncthreads(); } SEAM(1); }
    if (IN(2)) {
        {
            pg8::Gemm g{XN, (const bf16*)(ws + WS_WIN) + (size_t)NP8 * 256 * D, M, NPROJ - NP8 * 256, D}; pg8::StaticOrder S; S.init(M, NPROJ - NP8 * 256, F.G, (int)blockIdx.x);
            EpiInProj E{ws, NP8};
            RepOrder R{S, (S.nwg - S.c + S.G - 1) / S.G, REPS(2)};
            pg8::gemm_phase<EpiInProj, RepOrder, true, true>(F.lds, g, R, E, F.wave);
        }
        __syncthreads();
        {
            pg8::Gemm g{(const bf16*)(ws + WS_XN8), (const bf16*)(ws + WS_W8IN), M, NP8 * 256, D / 2}; pg8::StaticOrder S; S.init(M, NP8 * 256, F.G, (int)blockIdx.x);
            EpiInProj E{ws, 0};
            RepOrder R{S, (S.nwg - S.c + S.G - 1) / S.G, REPS(2)};
            pg8::gemm_phase<EpiInProj, RepOrder, true, true, true>(F.lds, g, R, E, F.wave);
        }
        SEAM(2);
    }
    if (IN(3)) { ph3_convbranch(F, args, REPS(3)); __syncthreads(); ph3_chunk_states(F, args, REPS(13)); __syncthreads(); SEAM(3); }
    if (IN(4)) {
        if (REPS(4) > 1) ph4_scan(F, WS_YS);
        ph4_scan(F, WS_ST);
        pg8::Gemm g{XN, (const bf16*)(ws + WS_WCV), M, D, D}; pg8::StaticOrder S; S.init(M, D, F.G, (int)blockIdx.x);
        EpiGate<false> E{(bf16*)(ws + WS_TMP), nullptr, (const bf16*)(ws + WS_GATE), 0, nullptr};
        RepOrder R{S, (S.nwg - S.c + S.G - 1) / S.G, REPS(15)};
        pg8::gemm_phase<EpiGate<false>, RepOrder, false, true>(F.lds, g, R, E, F.wave);
        SEAM(4);
    }
    if (IN(5)) { ph5_ssd_out(F, args, REPS(5)); SEAM(5); }
    if (IN(6)) {
        pg8::Gemm g{(const bf16*)(ws + WS_YS), (const bf16*)(ws + WS_WSSM), M, D, DIN}; pg8::StaticOrder S; S.init(M, D, F.G, (int)blockIdx.x);
        LAS float* rt = (LAS float*)(F.lds + RT_OFF);
        EpiGate<true> E{(bf16*)(ws + WS_MG), (const bf16*)(ws + WS_TMP), (const bf16*)(ws + WS_GATE), 1024, rt};
        for (int i = 0;; ++i) {
            OneUnit S1; if (!S.next(i, S1.u)) break;
            if (F.wave < 4) { const int tid = F.wave * 64 + lane_id(); const f32x4 r = *(const f32x4*)((const float*)(ws + WS_RSTD) + (size_t)(S1.u.pm * 256 + tid) * 4);
                *(LAS f32x4*)(rt + tid * 4) = (f32x4){r.x / r.y, r.y / r.z, r.z / r.w, r.w}; }
            asm volatile("s_waitcnt vmcnt(0) lgkmcnt(0)" ::: "memory"); __syncthreads();
            pg8::gemm_phase<EpiGate<true>, OneUnit, false, true>(F.lds, g, S1, E, F.wave);
            __syncthreads();
        }
        SEAM(6);
    }
    if (IN(7)) {
        pg8::Gemm g{(const bf16*)(ws + WS_MG), (const bf16*)(ws + WS_WMIX), M, D, D}; pg8::StaticOrder S; S.init(M, D, F.G, (int)blockIdx.x);
        EpiMix E{(bf16*)(ws + WS_H16), ARG(I_X), (const float*)(ws + WS_CTL) + CW_MODC + 2 * 1024};
        RepOrder R{S, (S.nwg - S.c + S.G - 1) / S.G, REPS(7)};
        pg8::gemm_phase<EpiMix, RepOrder, false, true>(F.lds, g, R, E, F.wave);
        SEAM(7);
    }
    if (IN(8)) { for (int rep = 0; rep < REPS(8); ++rep) { convert_experts(F, args); __syncthreads(); } ph8_router(F, args, REPS(9)); if (IN(8) && IN(10)) xcd_barrier(bar); }
    if (IN(10)) {
        build_tilebase(F);
        const LAS int* tb = (const LAS int*)(F.lds + TB_OFF);
        pg8::Gemm g{(const bf16*)(ws + WS_XN), (const bf16*)(ws + WS_W13), M, NE * 1024, D / 2};
        MoeOrder S{tb, F.G, F.vcu, tb[NE] * 4, 1, (const LAS int*)(F.lds + TOKL_OFF)};
        fill_tokl(F, S);
        EpiUp E{ws + WS_HDN};
        pg8::gemm_phase<EpiUp, MoeOrder, true, true, true, true>(F.lds, g, S, E, F.wave);
        SEAM(10);
    }
    if (IN(11)) {
        build_tilebase(F);
        const LAS int* tb = (const LAS int*)(F.lds + TB_OFF);
        pg8::Gemm g{(const bf16*)(ws + WS_HDN), (const bf16*)(ws + WS_W2), 49152, NE * 1024, DFF / 2};
        MoeOrder S{tb, F.G, F.vcu, tb[NE] * 4, 1, nullptr};
        EpiDown E{ws + WS_YEXP};
        pg8::gemm_phase<EpiDown, MoeOrder, true, true, true>(F.lds, g, S, E, F.wave);
        SEAM(11);
    }
    if (IN(12)) { build_tilebase(F); ph12_final(F, args, REPS(12)); }
#undef IN
#undef SEAM
}

extern "C" void kernel_launch(void* const* d_in, const int* in_sizes, int n_in, void* d_out, int out_size, void* d_ws, size_t ws_size, hipStream_t stream) {
    static int grid = 0;
    if (grid == 0) {
        if (n_in != N_IN || in_sizes[0] != M * D || out_size != M * D || ws_size < WS_END) {
            fprintf(stderr, "kernel_launch: unexpected shapes: n_in %d in0 %d out %d ws %zu (need %zu)\n", n_in, n_in > 0 ? in_sizes[0] : -1, out_size, ws_size, (size_t)WS_END); grid = -1; return; }
        int dev = 0, cus = 0, per_cu = 0;
        if (hipGetDevice(&dev) != hipSuccess || hipDeviceGetAttribute(&cus, hipDeviceAttributeMultiprocessorCount, dev) != hipSuccess) { fprintf(stderr, "kernel_launch: device query failed\n"); grid = -1; return; }
        if (hipFuncSetAttribute((const void*)fwd_kernel, hipFuncAttributeMaxDynamicSharedMemorySize, LDS_BYTES) != hipSuccess) { fprintf(stderr, "kernel_launch: hipFuncSetAttribute failed\n"); grid = -1; return; }
        if (hipOccupancyMaxActiveBlocksPerMultiprocessor(&per_cu, (const void*)fwd_kernel, NTHREADS, LDS_BYTES) != hipSuccess || per_cu < 1) {
            fprintf(stderr, "kernel_launch: the occupancy query admits no workgroup of this kernel per CU (%d); nothing launched\n", per_cu); (void)hipGetLastError(); grid = -1; return; }
        grid = cus;
        if (cus < 192 || (cus & 7)) { fprintf(stderr, "kernel_launch: built for a 256-CU device (the MoE unit table holds 4 units per workgroup); %d CUs: nothing launched\n", cus); grid = -1; return; }
        fprintf(stderr, "kernel_launch: grid %d (cus %d, per_cu %d)\n", grid, cus, per_cu);
    }
    if (grid < 0) return;
    (void)hipMemsetAsync((char*)d_ws + WS_CTL, 0, CTL_ZERO_BYTES, stream);
    Args a{};
    for (int i = 0; i < N_IN; ++i) a.in[i] = (const float*)d_in[i];
    a.out = (float*)d_out; a.ws = (unsigned char*)d_ws;
#if MK_ONE_LAUNCH
    a.ph_lo = 0; a.ph_hi = N_PHASES;
    void* kargs[] = {&a};
    hipError_t e = hipLaunchCooperativeKernel((const void*)fwd_kernel, dim3(grid), dim3(NTHREADS), kargs, LDS_BYTES, stream);
    if (e != hipSuccess) fprintf(stderr, "kernel_launch: cooperative launch failed: %s\n", hipGetErrorString(e));
#else
    for (int ph = 0; ph < N_PHASES; ++ph) {
        a.ph_lo = ph; a.ph_hi = ph + 1;
        hipLaunchKernelGGL(fwd_kernel, dim3(grid), dim3(NTHREADS), LDS_BYTES, stream, a);
    }
#endif
}
```

```cpp
#include <hip/hip_runtime.h>
#include <hip/hip_cooperative_groups.h>
#include <cstdio>
#include <cstdint>
namespace pg8 {
#define PG8_LAS __attribute__((address_space(3)))
typedef unsigned short bf16_t;
typedef short bf16x8 __attribute__((ext_vector_type(8)));
typedef float f32x4 __attribute__((ext_vector_type(4)));
typedef unsigned u32x4 __attribute__((ext_vector_type(4)));
typedef int v4i_ __attribute__((ext_vector_type(4)));
typedef int v8i_ __attribute__((ext_vector_type(8)));
constexpr int BM = 256, BK = 64, HALF = 128, HTB = HALF * BK * 2  , STAGE_BYTES = 8 * HTB, NXCD = 8, WGM = 8;

__host__ __device__ __forceinline__ int lds_byte(int r, int c) { const int st = (r >> 4) * 2 + (c >> 5), rr = r & 15, cc = c & 31, ob = rr * 64 + cc * 2; return st * 1024 + (ob ^ (((ob >> 9) & 1) << 5)); }
__host__ __device__ __forceinline__ void stage_rc(int b, int& R, int& C) { const int st = b / 1024, sb = b % 1024, swz = sb ^ (((sb >> 9) & 1) << 5); R = (st >> 1) * 16 + swz / 64; C = (st & 1) * 32 + (swz % 64) / 2; }
__host__ __device__ __forceinline__ int perm32(int rho) { const int n = rho >> 4, i = rho & 15; return 8 * (i >> 2) + 4 * n + (i & 3); }

struct Unit { int pm, pn; };
struct Gemm { const bf16_t* A; const bf16_t* Bt; int M, N, K; };

struct StaticOrder {
    int nM, nN, nwg, G, c;
    __host__ __device__ void init(int M, int N, int G_, int c_) { nM = M / BM; nN = N / BM; nwg = nM * nN; G = G_; c = c_; }
    __host__ __device__ bool next(int i, Unit& u) const {
        const long L = (long)i * G + c; if (L >= nwg) return false;
        int wgid = (int)L; { const int q = nwg / NXCD, r = nwg % NXCD, xcd = wgid % NXCD, off = wgid / NXCD; wgid = (xcd < r ? xcd * (q + 1) : r * (q + 1) + (xcd - r) * q) + off; }
        const int nig = WGM * nN, gid = wgid / nig, fm = gid * WGM, gsz = (nM - fm) < WGM ? (nM - fm) : WGM;
        u.pm = fm + ((wgid % nig) % gsz); u.pn = (wgid % nig) / gsz; return true;
    }
    __device__ __forceinline__ void a_ready(const Unit&) const {}
    __device__ __forceinline__ void done(const Unit&) const {}
};

__device__ __forceinline__ unsigned cvt_pk_bf16(float lo, float hi) { unsigned r; asm volatile("v_cvt_pk_bf16_f32 %0, %1, %2" : "=v"(r) : "v"(lo), "v"(hi)); return r; }
typedef float f32x2 __attribute__((ext_vector_type(2)));
template <class Epi, class Sched, bool ALIGN_EPI = false, bool SP2 = false, bool FP8 = false, bool GATHER = false>
__device__ __forceinline__ void gemm_phase(PG8_LAS unsigned char* lds, const Gemm g, const Sched& S, const Epi& E, const int wave_in) {
    const int lane = (int)__builtin_amdgcn_mbcnt_hi(~0u, __builtin_amdgcn_mbcnt_lo(~0u, 0u)), wid = wave_in, tid = wid * 64 + lane, wr = wid >> 2, wc = wid & 3, fr = lane & 15, fq = lane >> 4;
    const int K = g.K, nt = K / BK;
    unsigned voffA[2], voffB[2];
#pragma unroll
    for (int i = 0; i < 2; ++i) { int R, C; stage_rc(tid * 16 + i * 8192, R, C); const int Rb = Epi::PERM ? ((R & ~31) + perm32(R & 31)) : R;
        voffA[i] = (unsigned)(R * K + C) * 2u; voffB[i] = (unsigned)(Rb * K + C) * 2u; }
    static_assert(!GATHER || SP2, "GATHER is implemented in the SP2 loop");
    unsigned gA[2][2], ngA[2][2]; int RA[2]; unsigned CA2[2];
#pragma unroll
    for (int i = 0; i < 2; ++i) { int R, C; stage_rc(tid * 16 + i * 8192, R, C); RA[i] = R; CA2[i] = (unsigned)C * 2u; }
    auto load_g = [&](int ui_, unsigned (&dst)[2][2]) {
        if constexpr (GATHER) {
#pragma unroll
            for (int h = 0; h < 2; ++h)
#pragma unroll
                for (int i = 0; i < 2; ++i) dst[h][i] = (unsigned)S.tokl[ui_ * 256 + 128 * h + RA[i]] * (unsigned)(K * 2) + CA2[i];
        }
    };
    const size_t kstep = (size_t)(BK * 2);
    const size_t hstep = (size_t)HALF * K * 2;
    const size_t tstep = 2 * hstep;
    const size_t hstepA = GATHER ? (size_t)0 : hstep, tstepA = GATHER ? (size_t)0 : 2 * hstep;
    const unsigned ldsw = (unsigned)wid * 1024u;
    const int aoff = lds_byte(wr * 64 + fr, fq * 8), boff = lds_byte(wc * 32 + fr, fq * 8);
#define PG8_SA(b, h) (((b) * 2 + (h)) * HTB)
#define PG8_SB(b, h) ((4 + (b) * 2 + (h)) * HTB)
#define PG8_STAGE(bufoff, gbase, voff) do { _Pragma("unroll") for (int _i = 0; _i < 2; ++_i) \
        __builtin_amdgcn_global_load_lds((const unsigned*)((const char*)(gbase) + (voff)[_i]), (PG8_LAS unsigned*)(lds + (bufoff) + ldsw + _i * 8192), 16, 0, 0); } while (0)
#define PG8_STAGE_A(bufoff, gbase, gvoff) do { if constexpr (GATHER) { PG8_STAGE(bufoff, gbase, gvoff); } else { PG8_STAGE(bufoff, gbase, voffA); } } while (0)
#define PG8_LDA(dst, b, h) do { if constexpr (FP8) { _Pragma("unroll") for (int m = 0; m < 4; ++m) dst##8[m] = __builtin_shufflevector(*(const PG8_LAS v4i_*)(lds + PG8_SA(b, h) + aoff + m * 2048), *(const PG8_LAS v4i_*)(lds + PG8_SA(b, h) + aoff + m * 2048 + 1024), 0, 1, 2, 3, 4, 5, 6, 7); } \
        else { _Pragma("unroll") for (int m = 0; m < 4; ++m) _Pragma("unroll") for (int k = 0; k < 2; ++k) dst[m][k] = *(const PG8_LAS bf16x8*)(lds + PG8_SA(b, h) + aoff + m * 2048 + k * 1024); } } while (0)
#define PG8_LDB(dst, b, h) do { if constexpr (FP8) { _Pragma("unroll") for (int n = 0; n < 2; ++n) dst##8[n] = __builtin_shufflevector(*(const PG8_LAS v4i_*)(lds + PG8_SB(b, h) + boff + n * 2048), *(const PG8_LAS v4i_*)(lds + PG8_SB(b, h) + boff + n * 2048 + 1024), 0, 1, 2, 3, 4, 5, 6, 7); } \
        else { _Pragma("unroll") for (int n = 0; n < 2; ++n) _Pragma("unroll") for (int k = 0; k < 2; ++k) dst[n][k] = *(const PG8_LAS bf16x8*)(lds + PG8_SB(b, h) + boff + n * 2048 + k * 1024); } } while (0)
#define PG8_MMA(ai, bj, At, Bt) do { __builtin_amdgcn_s_setprio(1); \
        if constexpr (FP8) {   \
              \
            _Pragma("unroll") for (int m = 0; m < 4; ++m) _Pragma("unroll") for (int n = 0; n < 2; ++n) \
                asm volatile("v_mfma_scale_f32_16x16x128_f8f6f4 %0, %1, %2, %0, %3, %4 op_sel_hi:[0,0,0]" : "+v"(acc[ai][bj][m][n]) : "v"(Bt##8[n]), "v"(At##8[m]), "v"(scale_w), "v"(scale_x)); \
        } else { \
        _Pragma("unroll") for (int m = 0; m < 4; ++m) _Pragma("unroll") for (int n = 0; n < 2; ++n) _Pragma("unroll") for (int k = 0; k < 2; ++k) \
        acc[ai][bj][m][n] = __builtin_amdgcn_mfma_f32_16x16x32_bf16(Bt[n][k], At[m][k], acc[ai][bj][m][n], 0, 0, 0); } __builtin_amdgcn_s_setprio(0); } while (0)
#define PG8_WAIT_V(n) asm volatile("s_waitcnt vmcnt(" #n ")" ::: "memory")
#define PG8_WAIT_L(n) asm volatile("s_waitcnt lgkmcnt(" #n ")" ::: "memory")
#define PG8_BAR __builtin_amdgcn_s_barrier()
#define PG8_SCHED __builtin_amdgcn_sched_barrier(0)
    Unit cur, nxt; int ui = 0;
    if (!S.next(0, cur)) return;
    f32x4 acc[2][2][4][2];
#pragma unroll
    for (int a = 0; a < 2; ++a)
#pragma unroll
        for (int b = 0; b < 2; ++b)
#pragma unroll
            for (int m = 0; m < 4; ++m)
#pragma unroll
                for (int n = 0; n < 2; ++n) acc[a][b][m][n] = (f32x4){0.f, 0.f, 0.f, 0.f};
    const int scale_w = 0x79797979, scale_x = 0x7f7f7f7f;
    bf16x8 At[4][2], B0[2][2], B1[2][2]; v8i_ At8[4], B08[2], B18[2];
    const char* cA = (const char*)g.A + (size_t)cur.pm * tstepA; const char* cB = (const char*)g.Bt + (size_t)cur.pn * tstep;
    load_g(0, gA);
    S.a_ready(cur);
    if constexpr (SP2) {
        PG8_STAGE(PG8_SB(0, 0), cB, voffB); PG8_STAGE(PG8_SB(0, 1), cB + hstep, voffB); PG8_STAGE_A(PG8_SA(0, 0), cA, gA[0]); PG8_STAGE_A(PG8_SA(0, 1), cA + hstepA, gA[1]);
        if (wr == 1) PG8_BAR;
        PG8_WAIT_V(2); PG8_BAR;
        PG8_STAGE(PG8_SB(1, 0), cB + kstep, voffB); PG8_STAGE_A(PG8_SA(1, 0), cA + kstep, gA[0]); PG8_STAGE(PG8_SB(1, 1), cB + hstep + kstep, voffB);
        PG8_WAIT_V(6); PG8_BAR;
    } else {
        PG8_STAGE(PG8_SB(0, 0), cB, voffB); PG8_STAGE(PG8_SA(0, 0), cA, voffA); PG8_STAGE(PG8_SB(0, 1), cB + hstep, voffB); PG8_STAGE(PG8_SA(0, 1), cA + hstep, voffA);
        if (wr == 1) PG8_BAR;
        PG8_WAIT_V(4); PG8_BAR;
        PG8_STAGE(PG8_SB(1, 0), cB + kstep, voffB); PG8_STAGE(PG8_SA(1, 0), cA + kstep, voffA); PG8_STAGE(PG8_SB(1, 1), cB + hstep + kstep, voffB);
        PG8_WAIT_V(6); PG8_BAR;
    }
    for (;;) {
        const bool has_next = S.next(ui + 1, nxt);
        const char* nA = has_next ? (const char*)g.A + (size_t)nxt.pm * tstepA : cA; const char* nB = has_next ? (const char*)g.Bt + (size_t)nxt.pn * tstep : cB;
        if constexpr (GATHER) { if (has_next) load_g(ui + 1, ngA); else {
#pragma unroll
            for (int h = 0; h < 2; ++h)
#pragma unroll
                for (int i = 0; i < 2; ++i) ngA[h][i] = gA[h][i]; } }
        for (int t = 0; t < nt; t += 2) {
            const bool last = (t == nt - 2);
            const char* a1 = cA + (size_t)(t + 1) * kstep;
            const char* a2 = last ? nA : cA + (size_t)(t + 2) * kstep; const char* b2 = last ? nB : cB + (size_t)(t + 2) * kstep;
            const char* a3 = a2 + kstep; const char* b3 = b2 + kstep;
            if (last && has_next) S.a_ready(nxt);
            unsigned sN[2][2];
#pragma unroll
            for (int h = 0; h < 2; ++h)
#pragma unroll
                for (int i = 0; i < 2; ++i) sN[h][i] = last ? ngA[h][i] : gA[h][i];
            if constexpr (SP2) {
            PG8_LDB(B0, 0, 0); PG8_LDB(B1, 0, 1); PG8_SCHED; PG8_LDA(At, 0, 0); PG8_STAGE_A(PG8_SA(1, 1), a1 + hstepA, gA[1]);
            PG8_WAIT_V(8); PG8_WAIT_L(0); PG8_BAR; PG8_MMA(0, 0, At, B0); PG8_MMA(0, 1, At, B1); PG8_BAR; PG8_SCHED;
            PG8_LDA(At, 0, 1); PG8_STAGE(PG8_SB(0, 0), b2, voffB); PG8_STAGE(PG8_SB(0, 1), b2 + hstep, voffB); PG8_STAGE_A(PG8_SA(0, 0), a2, sN[0]);
            PG8_WAIT_V(8); PG8_WAIT_L(0); PG8_BAR; PG8_MMA(1, 0, At, B0); PG8_MMA(1, 1, At, B1); PG8_BAR; PG8_SCHED;
            PG8_LDB(B0, 1, 0); PG8_LDB(B1, 1, 1); PG8_SCHED; PG8_LDA(At, 1, 0); PG8_STAGE_A(PG8_SA(0, 1), a2 + hstepA, sN[1]);
            PG8_WAIT_V(8); PG8_WAIT_L(0); PG8_BAR; PG8_MMA(0, 0, At, B0); PG8_MMA(0, 1, At, B1); PG8_BAR; PG8_SCHED;
            PG8_LDA(At, 1, 1); PG8_STAGE(PG8_SB(1, 0), b3, voffB); PG8_STAGE(PG8_SB(1, 1), b3 + hstep, voffB); PG8_STAGE_A(PG8_SA(1, 0), a3, sN[0]);
            PG8_WAIT_V(8); PG8_WAIT_L(0); PG8_BAR; PG8_MMA(1, 0, At, B0); PG8_MMA(1, 1, At, B1); PG8_BAR; PG8_SCHED;
            } else {
            PG8_LDB(B0, 0, 0); PG8_SCHED; PG8_LDA(At, 0, 0); PG8_STAGE(PG8_SA(1, 1), a1 + hstep, voffA);
            PG8_WAIT_L(8); PG8_BAR; PG8_WAIT_L(0); PG8_MMA(0, 0, At, B0); PG8_BAR; PG8_SCHED;
            PG8_LDB(B1, 0, 1); PG8_STAGE(PG8_SB(0, 0), b2, voffB);
            PG8_BAR; PG8_WAIT_L(0); PG8_MMA(0, 1, At, B1); PG8_BAR;
            PG8_LDA(At, 0, 1); PG8_STAGE(PG8_SA(0, 0), a2, voffA);
            PG8_BAR; PG8_WAIT_L(0); PG8_MMA(1, 0, At, B0); PG8_BAR; PG8_SCHED;
            PG8_STAGE(PG8_SB(0, 1), b2 + hstep, voffB);
            PG8_WAIT_V(6); PG8_BAR; PG8_MMA(1, 1, At, B1); PG8_BAR;
            PG8_LDB(B0, 1, 0); PG8_SCHED; PG8_LDA(At, 1, 0); PG8_STAGE(PG8_SA(0, 1), a2 + hstep, voffA);
            PG8_WAIT_L(8); PG8_BAR; PG8_WAIT_L(0); PG8_MMA(0, 0, At, B0); PG8_BAR; PG8_SCHED;
            PG8_LDB(B1, 1, 1); PG8_STAGE(PG8_SB(1, 0), b3, voffB);
            PG8_BAR; PG8_WAIT_L(0); PG8_MMA(0, 1, At, B1); PG8_BAR;
            PG8_LDA(At, 1, 1); PG8_STAGE(PG8_SA(1, 0), a3, voffA);
            PG8_BAR; PG8_WAIT_L(0); PG8_MMA(1, 0, At, B0); PG8_BAR; PG8_SCHED;
            PG8_STAGE(PG8_SB(1, 1), b3 + hstep, voffB);
            PG8_WAIT_V(6); PG8_BAR; PG8_MMA(1, 1, At, B1); PG8_BAR;
            }
            if constexpr (Epi::KHOOK) { if ((((t + 2) & 7) == 0) && (t + 2 < nt)) E.khook(acc, ((t + 2) >> 3) - 1, wr, fr); }
        }
        if constexpr (ALIGN_EPI) { if (wr == 0) PG8_BAR; }
        if constexpr (FP8) {
            asm volatile("s_nop 15\n\ts_nop 15" : "+v"(acc[0][0][0][0]), "+v"(acc[0][0][0][1]), "+v"(acc[0][0][1][0]), "+v"(acc[0][0][1][1]), "+v"(acc[0][0][2][0]), "+v"(acc[0][0][2][1]), "+v"(acc[0][0][3][0]), "+v"(acc[0][0][3][1]), "+v"(acc[0][1][0][0]), "+v"(acc[0][1][0][1]), "+v"(acc[0][1][1][0]), "+v"(acc[0][1][1][1]), "+v"(acc[0][1][2][0]), "+v"(acc[0][1][2][1]), "+v"(acc[0][1][3][0]), "+v"(acc[0][1][3][1]));
            asm volatile("s_nop 0" : "+v"(acc[1][0][0][0]), "+v"(acc[1][0][0][1]), "+v"(acc[1][0][1][0]), "+v"(acc[1][0][1][1]), "+v"(acc[1][0][2][0]), "+v"(acc[1][0][2][1]), "+v"(acc[1][0][3][0]), "+v"(acc[1][0][3][1]), "+v"(acc[1][1][0][0]), "+v"(acc[1][1][0][1]), "+v"(acc[1][1][1][0]), "+v"(acc[1][1][1][1]), "+v"(acc[1][1][2][0]), "+v"(acc[1][1][2][1]), "+v"(acc[1][1][3][0]), "+v"(acc[1][1][3][1]));
        }
        if constexpr (!Epi::AFTER_DRAIN) { E(acc, cur, wr, wc, fr, fq); S.done(cur); }
        if (!has_next) break;
#pragma unroll
        for (int a = 0; a < 2; ++a)
#pragma unroll
            for (int b = 0; b < 2; ++b)
#pragma unroll
                for (int m = 0; m < 4; ++m)
#pragma unroll
                    for (int n = 0; n < 2; ++n) acc[a][b][m][n] = (f32x4){0.f, 0.f, 0.f, 0.f};
        cur = nxt; cA = nA; cB = nB; ++ui;
        if constexpr (GATHER) {
#pragma unroll
            for (int h = 0; h < 2; ++h)
#pragma unroll
                for (int i = 0; i < 2; ++i) gA[h][i] = ngA[h][i]; }
        if constexpr (ALIGN_EPI) { if (wr == 1) PG8_BAR; }
    }
    PG8_WAIT_V(0);
    if constexpr (!ALIGN_EPI) { if (wr == 0) PG8_BAR; }
    PG8_BAR;
    if constexpr (Epi::AFTER_DRAIN) { E.fused(acc, cur, wr, wc, fr, fq, lds, wid, lane); S.done(cur); }
#undef PG8_SA
#undef PG8_SB
#undef PG8_STAGE
#undef PG8_STAGE_A
#undef PG8_LDA
#undef PG8_LDB
#undef PG8_MMA
#undef PG8_WAIT_V
#undef PG8_WAIT_L
#undef PG8_BAR
#undef PG8_SCHED
}
}

#define DI __device__ __forceinline__
#define GAS __attribute__((address_space(1)))
#define LAS __attribute__((address_space(3)))
typedef unsigned short bf16;
typedef unsigned v4u __attribute__((ext_vector_type(4)));
typedef unsigned v2u __attribute__((ext_vector_type(2)));
typedef float f32x4 __attribute__((ext_vector_type(4)));
typedef float f32x16 __attribute__((ext_vector_type(16)));
typedef short bf16x8 __attribute__((ext_vector_type(8)));
typedef __bf16 bf2v __attribute__((ext_vector_type(2)));
typedef float f2v __attribute__((ext_vector_type(2)));
typedef GAS unsigned gu32;

constexpr int NWAVES = 8, NTHREADS = 512;
constexpr int M = 16384, D = 1024, DIN = 2048, NH = 32, HD = 64, NGRP = 4, NST = 128, XBCW = 3072;
constexpr int NPROJ = 9216, WIN_LD = 9248;
constexpr int LCH = 128, NCH = M / LCH;
constexpr int NE = 64, DFF = 512;
constexpr float EPS = 1e-6f;
constexpr float LOG2E = 1.4426950408889634f;

constexpr size_t MiB = 1u << 20;
constexpr size_t WS_CTL = 0, CTL_ZERO_BYTES = 65536;
constexpr size_t WS_WIN = 1 * MiB, WS_WDT = 19 * MiB, WS_WCV = 20 * MiB, WS_WMIX = 22 * MiB, WS_WSSM = 24 * MiB;
constexpr size_t WS_RSTD = 31 * MiB + 524288;
constexpr size_t WS_DT = 28 * MiB, WS_CD = 30 * MiB, WS_WRH = 30 * MiB + 65536, WS_WRL = WS_WRH + 262144, WS_ROUTE = 31 * MiB;
constexpr size_t WS_ST = 32 * MiB, WS_YS = 96 * MiB, WS_TMP = 160 * MiB, WS_MG = 192 * MiB;
constexpr size_t WS_W13 = 32 * MiB, WS_W2 = 160 * MiB, WS_H16 = 96 * MiB;
constexpr size_t WS_XN8 = 32 * MiB, WS_W8IN = 48 * MiB;
constexpr size_t WS_XN = 224 * MiB;
constexpr size_t WS_U = 256 * MiB, WS_ZS = 288 * MiB, WS_XBC = 352 * MiB, WS_GATE = 448 * MiB;
constexpr size_t WS_LIST = 256 * MiB, WS_HDN = 352 * MiB, WS_YEXP = 400 * MiB;
constexpr size_t WS_END = 512 * MiB;
constexpr int CW_BAR = 4096;
constexpr int CW_CNT = 8192;
constexpr int CW_MODC = 40960;
constexpr int CW_MOD = 16384;

constexpr int RING_BYTES = 131072;
constexpr int LDSCTL_OFF = 147456;
constexpr int TB_OFF = LDSCTL_OFF + 256;
constexpr int CNTL_OFF = TB_OFF + 320;
constexpr int TOKL_OFF = LDSCTL_OFF + 1024;
constexpr int RT_OFF = 148480;
constexpr int LDS_BYTES = 152576;

#define LDS_WAIT() asm volatile("s_waitcnt lgkmcnt(0)" ::: "memory")
#define VM_WAIT() asm volatile("s_waitcnt vmcnt(0)" ::: "memory")

DI unsigned pk2(float lo, float hi) { f2v v = {lo, hi}; return __builtin_bit_cast(unsigned, __builtin_convertvector(v, bf2v)); }
DI unsigned pk4_fp8(float a, float b, float c, float d) {
    a = __builtin_fminf(__builtin_fmaxf(a, -448.f), 448.f); b = __builtin_fminf(__builtin_fmaxf(b, -448.f), 448.f);
    c = __builtin_fminf(__builtin_fmaxf(c, -448.f), 448.f); d = __builtin_fminf(__builtin_fmaxf(d, -448.f), 448.f);
    unsigned w = 0u; w = __builtin_amdgcn_cvt_pk_fp8_f32(a, b, w, false); w = __builtin_amdgcn_cvt_pk_fp8_f32(c, d, w, true); return w; }
DI unsigned pk4_fp8_nc(float a, float b, float c, float d) { unsigned w = 0u; w = __builtin_amdgcn_cvt_pk_fp8_f32(a, b, w, false); w = __builtin_amdgcn_cvt_pk_fp8_f32(c, d, w, true); return w; }
DI float bflo(unsigned u) { return __uint_as_float(u << 16); }
DI float bfhi(unsigned u) { return __uint_as_float(u & 0xffff0000u); }
DI float sigmoidf_(float x) { return __builtin_amdgcn_rcpf(1.f + __builtin_amdgcn_exp2f(x * -LOG2E)); }
DI float siluf_(float x) { return x * __builtin_amdgcn_rcpf(1.f + __builtin_amdgcn_exp2f(x * -LOG2E)); }
DI float wave_sum(float v) {
#pragma unroll
    for (int o = 1; o < 64; o <<= 1) v += __shfl_xor(v, o);
    return v;
}
DI f32x4 mod4(const float* modp, int k) { return (*(const f32x4*)(modp + k) + *(const f32x4*)(modp + 6144 + k)) + (*(const f32x4*)(modp + 2 * 6144 + k) + *(const f32x4*)(modp + 3 * 6144 + k)); }
DI int crow(int reg, int hh) { return (reg & 3) + 8 * (reg >> 2) + 4 * hh; }
DI int swz(int row, int chunk) { return chunk ^ ((row ^ (row >> 3)) & 15); }
#define MFMA32(a, b, c) __builtin_amdgcn_mfma_f32_32x32x16_bf16((a), (b), (c), 0, 0, 0)

DI int lane_id() { return (int)__builtin_amdgcn_mbcnt_hi(~0u, __builtin_amdgcn_mbcnt_lo(~0u, 0u)); }
#define XB_TMO      128
#define XB_XCNT(j)  (256  + 64 * (j))
#define XB_XSUB(j)  (1280 + 64 * (j))
#define XB_XGEN(j)  (2304 + 64 * (j))
#define XB_TOP      3328
#define XB_TOPGEN   3392
#define XCD_BAR_WORDS 3456
#define XB_SPIN_CAP (1u << 18)
DI unsigned xb_ld(unsigned* p)              { return __hip_atomic_load(p, __ATOMIC_RELAXED, __HIP_MEMORY_SCOPE_AGENT); }
DI unsigned xb_add(unsigned* p, unsigned v) { return __hip_atomic_fetch_add(p, v, __ATOMIC_RELAXED, __HIP_MEMORY_SCOPE_AGENT); }
DI unsigned xb_xcc_id() { return (unsigned)__builtin_amdgcn_s_getreg((3 << 11) | 20) & 0xFu; }
#define XB_SPIN(cond, bar) do { unsigned _sp = 0; while (cond) { __builtin_amdgcn_s_sleep(1); \
    if ((++_sp & 255u) == 0u) { if (xb_ld(&(bar)[XB_TMO])) break; if (_sp > XB_SPIN_CAP) { atomicAdd(&(bar)[XB_TMO], 1u); break; } } } } while (0)
struct XcdBarrier { unsigned* bar; unsigned x; volatile LAS unsigned* st; int wave; };
DI XcdBarrier xcd_barrier_post(unsigned* bar, volatile LAS unsigned* st) {
    XcdBarrier b; b.bar = bar; b.x = xb_xcc_id(); b.st = st; b.wave = 0;
    if (threadIdx.x == 0) (void)xb_add(&bar[XB_XCNT(b.x)], 1u);
    return b;
}
DI void xcd_barrier_complete(unsigned* bar, unsigned x, unsigned& nloc, unsigned& nx) {
    const unsigned G = gridDim.x * gridDim.y * gridDim.z;
    unsigned sum, cnt, mine, sp = 0u;
    for (;;) {
        sum = 0u; cnt = 0u; mine = 0u;
#pragma unroll
        for (unsigned j = 0; j < 16; ++j) { const unsigned c = xb_ld(&bar[XB_XCNT(j)]); sum += c; cnt += (c > 0u) ? 1u : 0u; mine = (j == x) ? c : mine; }
        if (sum == G) break;
        __builtin_amdgcn_s_sleep(1);
        if ((++sp & 255u) == 0u) { if (xb_ld(&bar[XB_TMO])) break; if (sp > XB_SPIN_CAP) { atomicAdd(&bar[XB_TMO], 1u); break; } }
    }
    nloc = mine > 0u ? mine : 1u; nx = cnt > 0u ? cnt : 1u;
}
DI void xcd_barrier(const XcdBarrier& b) {
    asm volatile("s_waitcnt vmcnt(0)" ::: "memory");
    __syncthreads();
    if (b.wave == 0 && lane_id() == 0) {
        unsigned* bar = b.bar;
        __builtin_amdgcn_s_waitcnt(0);
        unsigned nloc = b.st[0], nx = b.st[1];
        if (nloc == 0u) { xcd_barrier_complete(bar, b.x, nloc, nx); b.st[0] = nloc; b.st[1] = nx; }
        const unsigned old = xb_add(&bar[XB_XSUB(b.x)], 1u);
        const unsigned gen = old / nloc;
        if (old + 1u == (gen + 1u) * nloc) {
            __builtin_amdgcn_fence(__ATOMIC_RELEASE, "agent");
            asm volatile("s_waitcnt vmcnt(0)" ::: "memory");
            const unsigned og = xb_add(&bar[XB_TOP], 1u);
            const unsigned tg = og / nx;
            if (og + 1u == (tg + 1u) * nx) xb_add(&bar[XB_TOPGEN], 1u);
            else XB_SPIN(xb_ld(&bar[XB_TOPGEN]) == tg, bar);
            __builtin_amdgcn_fence(__ATOMIC_ACQUIRE, "agent");
            xb_add(&bar[XB_XGEN(b.x)], 1u);
            asm volatile("s_waitcnt vmcnt(0)" ::: "memory");
        } else {
            XB_SPIN(xb_ld(&bar[XB_XGEN(b.x)]) == gen, bar);
            __builtin_amdgcn_fence(__ATOMIC_ACQUIRE, "agent");
            asm volatile("s_waitcnt vmcnt(0)" ::: "memory");
        }
    }
    __syncthreads();
}

enum { I_X = 0, I_C, I_WADA, I_BADA, I_N1G, I_WIN, I_CVW, I_CVB, I_LNG, I_LNB, I_WCV, I_SCW, I_SCB, I_DTB, I_ALOG, I_DSKIP, I_SNG, I_WSSM, I_WMIX,
       I_N2G, I_WGRP, I_BGRP, I_WER, I_BER, I_W1, I_W3, I_W2, I_FG, N_IN };
struct Args { const float* in[N_IN]; float* out; unsigned char* ws; int ph_lo, ph_hi; };

template <int I> DI const float* argp() {
    auto kp = __builtin_amdgcn_kernarg_segment_ptr();
    unsigned long long v;
    asm volatile("s_load_dwordx2 %0, %1, %2\n\ts_waitcnt lgkmcnt(0)" : "=s"(v) : "s"(kp), "i"(I * 8));
    return (const float*)(const GAS float*)v;
}
#define ARG(i) argp<i>()
struct Ctx {
    LAS unsigned char* lds;
    int wave, vcu, G, xcd, xj;
    unsigned char* ws;
};

DI int xcd_unit(int x, int j, int gx, int i, int N) { const int u = i * gx + j; return (u < (N >> 3)) ? x * (N >> 3) + u : -1; }
DI int inproj_tile(int p) { return p < 8 ? p + 28 : p - 8; }
constexpr int NP8 = 16;
struct EpiInProj {
    static constexpr bool PERM = true, AFTER_DRAIN = false, KHOOK = false;
    unsigned char* ws; int p0;
    DI void operator()(const pg8::f32x4 (&acc)[2][2][4][2], const pg8::Unit& u, int wr, int wc, int fr, int fq) const {
        const int pn = inproj_tile(u.pn + p0), row0 = u.pm * 256 + wr * 64 + fr;
        if (pn < 8) {
            bf16* U = (bf16*)(ws + WS_U);
#pragma unroll
            for (int ai = 0; ai < 2; ++ai)
#pragma unroll
                for (int m = 0; m < 4; ++m) {
                    bf16* rowp = U + (size_t)(row0 + ai * 128 + m * 16) * D + pn * 128 + wc * 16 + fq * 4;
#pragma unroll
                    for (int bj = 0; bj < 2; ++bj) { const pg8::f32x4 a = acc[ai][bj][m][0], b = acc[ai][bj][m][1];
                        v2u w; w.x = pk2(a[0] * sigmoidf_(b[0]), a[1] * sigmoidf_(b[1])); w.y = pk2(a[2] * sigmoidf_(b[2]), a[3] * sigmoidf_(b[3]));
                        *(v2u*)(rowp + bj * 64) = w; } }
        } else {
            const bool isz = pn < 16, isx = (pn >= 16) && (pn < 28);
            const size_t boff = isz ? WS_ZS : (isx ? WS_XBC : WS_GATE);
            const int ldc = isx ? XBCW : DIN;
            const int colt = (pn - (isz ? 8 : (isx ? 16 : 28))) * 256;
            bf16* base = (bf16*)(ws + boff);
            const int col0 = colt + wc * 32 + fq * 8;
#pragma unroll
            for (int ai = 0; ai < 2; ++ai)
#pragma unroll
                for (int m = 0; m < 4; ++m) {
                    bf16* rowp = base + (size_t)(row0 + ai * 128 + m * 16) * ldc + col0;
#pragma unroll
                    for (int bj = 0; bj < 2; ++bj) { pg8::f32x4 v0 = acc[ai][bj][m][0], v1 = acc[ai][bj][m][1];
                        if (!isx) {
#pragma unroll
                            for (int i = 0; i < 4; ++i) { const float s0 = sigmoidf_(v0[i]), s1 = sigmoidf_(v1[i]); v0[i] = isz ? v0[i] * s0 : s0; v1[i] = isz ? v1[i] * s1 : s1; }
                        }
                        v4u w; w.x = pk2(v0[0], v0[1]); w.y = pk2(v0[2], v0[3]); w.z = pk2(v1[0], v1[1]); w.w = pk2(v1[2], v1[3]);
                        *(v4u*)(rowp + bj * 128) = w; } }
        }
    }
};
template <bool NORM> struct EpiGate {
    static constexpr bool PERM = true, AFTER_DRAIN = false, KHOOK = NORM;
    bf16* O; const bf16* P; const bf16* GATE; int gcol; const LAS float* rt;
    DI void khook(pg8::f32x4 (&acc)[2][2][4][2], int b, int wr, int fr) const {
#pragma unroll
        for (int ai = 0; ai < 2; ++ai)
#pragma unroll
            for (int m = 0; m < 4; ++m) { const float f = rt[(ai * 128 + wr * 64 + m * 16 + fr) * 4 + b];
#pragma unroll
                for (int bj = 0; bj < 2; ++bj)
#pragma unroll
                    for (int n = 0; n < 2; ++n) acc[ai][bj][m][n] = acc[ai][bj][m][n] * f; }
    }
    DI void operator()(const pg8::f32x4 (&acc)[2][2][4][2], const pg8::Unit& u, int wr, int wc, int fr, int fq) const {
        const int row0 = u.pm * 256 + wr * 64 + fr, col0 = u.pn * 256 + wc * 32 + fq * 8;
        v4u g[4], p[4], wA[4], wB[4];
        auto loadq = [&](int bj, int ai) {
#pragma unroll
            for (int m = 0; m < 4; ++m) { const size_t r = (size_t)(row0 + ai * 128 + m * 16); const int c = col0 + bj * 128;
                g[m] = *(const v4u*)(GATE + r * (2 * D) + gcol + c); if (NORM) p[m] = *(const v4u*)(P + r * D + c); }
        };
        auto calcq = [&](int bj, int ai, v4u (&w)[4]) {
#pragma unroll
            for (int m = 0; m < 4; ++m) {
                float f = 1.0f; if (NORM) f = rt[(ai * 128 + wr * 64 + m * 16 + fr) * 4 + 3];
                const v4u gg = g[m];
                pg8::f32x4 v0 = acc[ai][bj][m][0] * f, v1 = acc[ai][bj][m][1] * f;
                float o[8] = {v0[0] * bflo(gg.x), v0[1] * bfhi(gg.x), v0[2] * bflo(gg.y), v0[3] * bfhi(gg.y), v1[0] * bflo(gg.z), v1[1] * bfhi(gg.z), v1[2] * bflo(gg.w), v1[3] * bfhi(gg.w)};
                if (NORM) { const v4u pp = p[m];
                    o[0] += bflo(pp.x); o[1] += bfhi(pp.x); o[2] += bflo(pp.y); o[3] += bfhi(pp.y); o[4] += bflo(pp.z); o[5] += bfhi(pp.z); o[6] += bflo(pp.w); o[7] += bfhi(pp.w); }
                w[m].x = pk2(o[0], o[1]); w[m].y = pk2(o[2], o[3]); w[m].z = pk2(o[4], o[5]); w[m].w = pk2(o[6], o[7]); }
        };
        auto storeq = [&](int bj, int ai, const v4u (&w)[4]) {
#pragma unroll
            for (int m = 0; m < 4; ++m) *(v4u*)(O + (size_t)(row0 + ai * 128 + m * 16) * D + col0 + bj * 128) = w[m];
        };
        loadq(0, 0); calcq(0, 0, wA); loadq(0, 1); storeq(0, 0, wA); calcq(0, 1, wB); loadq(1, 0); storeq(0, 1, wB); calcq(1, 0, wA); loadq(1, 1); storeq(1, 0, wA); calcq(1, 1, wB); storeq(1, 1, wB);
    }
};
struct EpiMix {
    static constexpr bool PERM = true, AFTER_DRAIN = false, KHOOK = false;
    bf16* H; const float* X; const float* g1;
    DI void operator()(const pg8::f32x4 (&acc)[2][2][4][2], const pg8::Unit& u, int wr, int wc, int fr, int fq) const {
        const int row0 = u.pm * 256 + wr * 64 + fr, col0 = u.pn * 256 + wc * 32 + fq * 8;
        f32x4 xa[4], xb[4]; v4u wA[4], wB[4];
        auto loadq = [&](int bj, int ai) {
#pragma unroll
            for (int m = 0; m < 4; ++m) { const size_t off = (size_t)(row0 + ai * 128 + m * 16) * D + col0 + bj * 128;
                xa[m] = __builtin_nontemporal_load((const f32x4*)(X + off)); xb[m] = __builtin_nontemporal_load((const f32x4*)(X + off + 4)); }
        };
        auto calcq = [&](int bj, int ai, v4u (&w)[4]) { const int c = col0 + bj * 128;
            const f32x4 ga = *(const f32x4*)(g1 + c), gb = *(const f32x4*)(g1 + c + 4);
#pragma unroll
            for (int m = 0; m < 4; ++m) { const f32x4 ha = xa[m] + ga * acc[ai][bj][m][0], hb = xb[m] + gb * acc[ai][bj][m][1];
                w[m].x = pk2(ha.x, ha.y); w[m].y = pk2(ha.z, ha.w); w[m].z = pk2(hb.x, hb.y); w[m].w = pk2(hb.z, hb.w); }
        };
        auto storeq = [&](int bj, int ai, const v4u (&w)[4]) {
#pragma unroll
            for (int m = 0; m < 4; ++m) *(v4u*)(H + (size_t)(row0 + ai * 128 + m * 16) * D + col0 + bj * 128) = w[m];
        };
        loadq(0, 0); calcq(0, 0, wA); loadq(0, 1); storeq(0, 0, wA); calcq(0, 1, wB); loadq(1, 0); storeq(0, 1, wB); calcq(1, 0, wA); loadq(1, 1); storeq(1, 0, wA); calcq(1, 1, wB); storeq(1, 1, wB);
    }
};
struct EpiUp {
    static constexpr bool PERM = true, AFTER_DRAIN = false, KHOOK = false;
    unsigned char* HDN;
    DI void operator()(const pg8::f32x4 (&acc)[2][2][4][2], const pg8::Unit& u, int wr, int wc, int fr, int fq) const {
        const int j = u.pn & 3, row0 = u.pm * 256 + wr * 64 + fr, col0 = j * 128 + wc * 16 + fq * 4;
#pragma unroll
        for (int ai = 0; ai < 2; ++ai)
#pragma unroll
            for (int m = 0; m < 4; ++m) { unsigned char* rowp = HDN + (size_t)(row0 + ai * 128 + m * 16) * DFF + col0;
#pragma unroll
                for (int bj = 0; bj < 2; ++bj) { const pg8::f32x4 a = acc[ai][bj][m][0], b = acc[ai][bj][m][1];
                    *(unsigned*)(rowp + bj * 64) = pk4_fp8(siluf_(a[0]) * b[0], siluf_(a[1]) * b[1], siluf_(a[2]) * b[2], siluf_(a[3]) * b[3]); } }
    }
};
struct EpiDown {
    static constexpr bool PERM = true, AFTER_DRAIN = false, KHOOK = false;
    unsigned char* Y;
    DI void operator()(const pg8::f32x4 (&acc)[2][2][4][2], const pg8::Unit& u, int wr, int wc, int fr, int fq) const {
        const int j = u.pn & 3, row0 = u.pm * 256 + wr * 64 + fr, col0 = j * 256 + wc * 32 + fq * 8;
#pragma unroll
        for (int ai = 0; ai < 2; ++ai)
#pragma unroll
            for (int m = 0; m < 4; ++m) { unsigned char* rowp = Y + (size_t)(row0 + ai * 128 + m * 16) * D + col0;
#pragma unroll
                for (int bj = 0; bj < 2; ++bj) { const pg8::f32x4 v0 = acc[ai][bj][m][0] * 16.0f, v1 = acc[ai][bj][m][1] * 16.0f;
                    v2u w; w.x = pk4_fp8(v0[0], v0[1], v0[2], v0[3]); w.y = pk4_fp8(v1[0], v1[1], v1[2], v1[3]);
                    *(v2u*)(rowp + bj * 128) = w; } }
    }
};
struct MoeOrder {
    const LAS int* tb; int G, c, total, reps; const LAS int* tokl;
    DI bool next(int i0, pg8::Unit& u) const {
        const int n = (total - c + G - 1) / G; if (n <= 0 || i0 >= n * reps) return false;
        const int i = i0 % n; const int uu = i * G + c;
        const int T = uu >> 2; int e = 0;
        while (e < NE - 1 && tb[e + 1] <= T) ++e;
        u.pm = T; u.pn = 4 * e + (uu & 3); return true;
    }
    DI void a_ready(const pg8::Unit&) const {}
    DI void done(const pg8::Unit&) const {}
};

struct OneUnit { pg8::Unit u;
    DI bool next(int i, pg8::Unit& o) const { if (i != 0) return false; o = u; return true; }
    DI void a_ready(const pg8::Unit&) const {}
    DI void done(const pg8::Unit&) const {} };

template <class SrcF>
DI void transpose_item(SrcF src, int K, bf16* WT, LAS float* scr, int kb, int n0, int lane) {
    const int k0 = 64 * kb;
#pragma unroll 8
    for (int i = 0; i < 32; ++i) { const int kk = 2 * i + (lane >> 5); scr[kk * 33 + (lane & 31)] = src(k0 + kk, n0 + (lane & 31)); }
    LDS_WAIT(); asm volatile("" ::: "memory");
    const int c = lane & 7;
#pragma unroll
    for (int j = 0; j < 4; ++j) { const int n = (lane >> 3) + 8 * j; const LAS float* s = scr + (8 * c) * 33 + n;
        v4u o; o.x = pk2(s[0 * 33], s[1 * 33]); o.y = pk2(s[2 * 33], s[3 * 33]); o.z = pk2(s[4 * 33], s[5 * 33]); o.w = pk2(s[6 * 33], s[7 * 33]);
        *(v4u*)(WT + (size_t)(n0 + n) * K + k0 + 8 * c) = o; }
    LDS_WAIT(); asm volatile("" ::: "memory");
}

template <class SrcF>
DI void transpose_item8(SrcF src, int K, unsigned char* WT, LAS float* scr, int kb, int n0, int lane) {
    const int k0 = 64 * kb;
#pragma unroll 8
    for (int i = 0; i < 32; ++i) { const int kk = 2 * i + (lane >> 5); scr[kk * 33 + (lane & 31)] = src(k0 + kk, n0 + (lane & 31)) * 64.0f; }
    LDS_WAIT(); asm volatile("" ::: "memory");
#pragma unroll
    for (int i = 0; i < 2; ++i) { const int p = lane + 64 * i, n = p >> 2, c = p & 3; const LAS float* s = scr + (16 * c) * 33 + n;
        v4u o; o.x = pk4_fp8(s[0 * 33], s[1 * 33], s[2 * 33], s[3 * 33]); o.y = pk4_fp8(s[4 * 33], s[5 * 33], s[6 * 33], s[7 * 33]);
        o.z = pk4_fp8(s[8 * 33], s[9 * 33], s[10 * 33], s[11 * 33]); o.w = pk4_fp8(s[12 * 33], s[13 * 33], s[14 * 33], s[15 * 33]);
        *(v4u*)(WT + (size_t)(n0 + n) * K + k0 + 16 * c) = o; }
    LDS_WAIT(); asm volatile("" ::: "memory");
}

DI void ph0_prologue(const Ctx& F, const Args& a, int reps) {
    const int gw = F.vcu * NWAVES + F.wave, NGW = F.G * NWAVES, lane = lane_id();
    float* mod = (float*)(F.ws + WS_CTL) + CW_MOD;
    {
        const float* cvec = ARG(I_C); const float* wada = ARG(I_WADA); const float* bada = ARG(I_BADA);
        const int r8 = lane >> 3, c4 = lane & 7;
        for (int item0 = gw; item0 < 768 * reps; item0 += NGW) {
            const int item = item0 % 768; const int cc = item % 192, kq = item / 192;
            f32x4 acc = {0.f, 0.f, 0.f, 0.f};
#pragma unroll 8
            for (int i = 0; i < 32; ++i) { const int k = kq * 256 + i * 8 + r8; const float cv = cvec[k]; const float s = siluf_(cv);
                const f32x4 w = *(const f32x4*)(wada + (size_t)k * (6 * D) + cc * 32 + c4 * 4); acc += s * w; }
#pragma unroll
            for (int j = 0; j < 4; ++j) { float v = acc[j]; v += __shfl_xor(v, 8); v += __shfl_xor(v, 16); v += __shfl_xor(v, 32); acc[j] = v; }
            if (lane < 8) {
#pragma unroll
                for (int j = 0; j < 4; ++j) { float v = acc[j]; if (kq == 0) v += bada[cc * 32 + c4 * 4 + j]; mod[kq * 6144 + cc * 32 + c4 * 4 + j] = v; }
            }
        }
    }
    LAS float* scr = (LAS float*)(F.lds + F.wave * 16384);
    const float* win = ARG(I_WIN); const float* wcv = ARG(I_WCV); const float* wmix = ARG(I_WMIX); const float* wssm = ARG(I_WSSM);
    bf16* Win_t = (bf16*)(F.ws + WS_WIN); bf16* Wdt_t = (bf16*)(F.ws + WS_WDT); bf16* Wcv_t = (bf16*)(F.ws + WS_WCV);
    bf16* Wmix_t = (bf16*)(F.ws + WS_WMIX); bf16* Wssm_t = (bf16*)(F.ws + WS_WSSM);
    constexpr int I_IN = 16 * 288, I_DT = 16, I_CV = 16 * 32, I_MX = 16 * 32, I_SS = 32 * 32, I_RT = 16 * 3 * 2;
    constexpr int NITEMS = I_IN + I_DT + I_CV + I_MX + I_SS + I_RT;
    const float* wer = ARG(I_WER); const float* wgrp = ARG(I_WGRP); const float* sng0 = ARG(I_SNG);
    for (int it0 = gw; it0 < NITEMS * reps; it0 += NGW) {
        int r = it0 % NITEMS;
        if (r < I_IN) { const int kb = r / 288, nb = r % 288;
            auto wsrc = [&](int k, int npp) -> float {
                const int np = inproj_tile(npp >> 8) * 256 + (npp & 255);
                int col; if (np < 2048) { const int q = np >> 3, rr = np & 7; col = (rr >> 2) * 1024 + 4 * q + (rr & 3); } else if (np < 7168) col = np; else col = np + 32;
                return win[(size_t)k * WIN_LD + col]; };
            if (nb < NP8 * 8) transpose_item8(wsrc, D, F.ws + WS_W8IN, scr, kb, nb * 32, lane); else transpose_item(wsrc, D, Win_t, scr, kb, nb * 32, lane);
            continue; } r -= I_IN;
        if (r < I_DT) { transpose_item([&](int k, int np) -> float { return win[(size_t)k * WIN_LD + 7168 + np]; }, D, Wdt_t, scr, r, 0, lane); continue; } r -= I_DT;
        if (r < I_CV) { transpose_item([&](int k, int np) -> float { return wcv[(size_t)k * D + np]; }, D, Wcv_t, scr, r / 32, (r % 32) * 32, lane); continue; } r -= I_CV;
        if (r < I_MX) { transpose_item([&](int k, int np) -> float { return wmix[(size_t)k * D + np]; }, D, Wmix_t, scr, r / 32, (r % 32) * 32, lane); continue; } r -= I_MX;
        if (r < I_SS) { transpose_item([&](int k, int np) -> float { return wssm[(size_t)k * D + np] * sng0[k]; }, DIN, Wssm_t, scr, r / 32, (r % 32) * 32, lane); continue; } r -= I_SS;
        {
            const int lo = r / 48, rr = r % 48, kb = rr / 3, nb = rr % 3;
            auto wsrc = [&](int k, int np) -> float { float w = 0.f; if (np < 64) w = wer[(size_t)k * NE + np]; else if (np < 72) w = wgrp[(size_t)k * 8 + (np - 64)];
                const float hi = bflo(pk2(w, 0.f)); return lo ? (w - hi) : hi; };
            transpose_item(wsrc, D, (bf16*)(F.ws + (lo ? WS_WRL : WS_WRH)), scr, kb, nb * 32, lane);
        }
    }
}

DI void convert_experts(const Ctx& F, const Args& a) {
    const int gw = F.vcu * NWAVES + F.wave, NGW = F.G * NWAVES, lane = lane_id();
    LAS float* scr = (LAS float*)(F.lds + F.wave * 17408);
    const float* w1 = ARG(I_W1); const float* w3 = ARG(I_W3); const float* w2 = ARG(I_W2);
    unsigned char* W13_t = F.ws + WS_W13; unsigned char* W2_t = F.ws + WS_W2;
    constexpr int I_13 = NE * 4 * 16, I_2 = NE * 2 * 16, NIT = I_13 + I_2;
    const int ch = lane & 15, kq = lane >> 4;
    for (int it = gw; it < NIT; it += NGW) {
        const float* src; size_t ld; unsigned char* dst;
        if (it < I_13) { const int e = it >> 6, r = it & 63, kb = r >> 4, cb = r & 15;
            src = ((ch & 1) ? w3 : w1) + (size_t)e * D * DFF + (size_t)(256 * kb + kq) * DFF + 32 * cb + 4 * (ch >> 1); ld = DFF;
            dst = W13_t + (size_t)e * D * D + (size_t)(64 * cb + lane) * D + 256 * kb;
        } else { const int r0 = it - I_13, e = r0 >> 5, r = r0 & 31, kb = r >> 4, nb = r & 15;
            src = w2 + (size_t)e * DFF * D + (size_t)(256 * kb + kq) * D + 64 * nb + 4 * ch; ld = D;
            dst = W2_t + (size_t)e * D * DFF + (size_t)(64 * nb + lane) * DFF + 256 * kb;
        }
        f32x4 va[16], vb[16]; v4u o[16];
#pragma unroll
        for (int i = 0; i < 16; ++i) va[i] = __builtin_nontemporal_load((const f32x4*)(src + (size_t)(4 * i) * ld));
#pragma unroll
        for (int sub = 0; sub < 4; ++sub) {
            f32x4 (&cur)[16] = (sub & 1) ? vb : va; f32x4 (&nxt)[16] = (sub & 1) ? va : vb;
            if (sub < 3) {
#pragma unroll
                for (int i = 0; i < 16; ++i) nxt[i] = __builtin_nontemporal_load((const f32x4*)(src + (size_t)(64 * (sub + 1) + 4 * i) * ld));
            }
#pragma unroll
            for (int i = 0; i < 16; ++i) *(LAS f32x4*)(scr + (4 * i + kq) * 68 + 4 * ch) = cur[i] * 64.0f;
            LDS_WAIT(); asm volatile("" ::: "memory");
#pragma unroll
            for (int j = 0; j < 4; ++j) {
                unsigned w[4];
#pragma unroll
                for (int q = 0; q < 4; ++q) { const LAS float* sp = scr + (16 * j + 4 * q) * 68 + lane; w[q] = pk4_fp8(sp[0], sp[68], sp[136], sp[204]); }
                o[4 * sub + j].x = w[0]; o[4 * sub + j].y = w[1]; o[4 * sub + j].z = w[2]; o[4 * sub + j].w = w[3];
            }
            LDS_WAIT(); asm volatile("" ::: "memory");
        }
#pragma unroll
        for (int j = 0; j < 16; ++j) *(v4u*)(dst + 16 * j) = o[j];
    }
}

DI void ph1_norm_dt(const Ctx& F, const Args& a) {
    const float* mod = (const float*)(F.ws + WS_CTL) + CW_MOD;
    const float* x = ARG(I_X); const float* n1g = ARG(I_N1G); const float* dtb = ARG(I_DTB);
    bf16* XN = (bf16*)(F.ws + WS_XN); const bf16* Wdt_t = (const bf16*)(F.ws + WS_WDT); float* DT = (float*)(F.ws + WS_DT);
    const int lane = lane_id(), wave = F.wave;
    f32x4 gm[4], ga[4];
#pragma unroll
    for (int j = 0; j < 4; ++j) { const int k = 256 * j + 4 * lane; const f32x4 g = *(const f32x4*)(n1g + k), sc = mod4(mod, 1024 + k);
        gm[j] = g * (sc + 1.0f); ga[j] = mod4(mod, k); }
    if (F.vcu == 0) { float* modc = (float*)(F.ws + WS_CTL) + CW_MODC; for (int k = (F.wave * 64 + lane_id()) * 4; k < 6 * D; k += NTHREADS * 4) *(f32x4*)(modc + k) = mod4(mod, k); }
    for (int unit = F.vcu; unit < M / 64; unit += F.G) {
        const int row0 = unit * 64;
#pragma unroll 1
        for (int rh = 0; rh < 2; ++rh) {
            f32x4 v[4][4];
#pragma unroll
            for (int rr = 0; rr < 4; ++rr)
#pragma unroll
                for (int j = 0; j < 4; ++j) v[rr][j] = __builtin_nontemporal_load((const f32x4*)(x + (size_t)(row0 + wave * 8 + rh * 4 + rr) * D + 256 * j + 4 * lane));
#pragma unroll
            for (int rr = 0; rr < 4; ++rr) {
                const int rl = wave * 8 + rh * 4 + rr, row = row0 + rl; float ss = 0.f;
#pragma unroll
                for (int j = 0; j < 4; ++j) ss += (v[rr][j].x * v[rr][j].x + v[rr][j].y * v[rr][j].y) + (v[rr][j].z * v[rr][j].z + v[rr][j].w * v[rr][j].w);
                const float rstd = 1.0f / sqrtf(wave_sum(ss) * (1.0f / D) + EPS);
#pragma unroll
                for (int j = 0; j < 4; ++j) { const f32x4 n = v[rr][j] * rstd * gm[j] + ga[j];
                    v2u w; w.x = pk2(n.x, n.y); w.y = pk2(n.z, n.w);
                    *(v2u*)(XN + (size_t)row * D + 256 * j + 4 * lane) = w;
                    *(unsigned*)(F.ws + WS_XN8 + (size_t)row * D + 256 * j + 4 * lane) = pk4_fp8(n.x, n.y, n.z, n.w);
                    const int chunk = (32 * j + (lane >> 1)) ^ (rl & 15);
                    *(LAS v2u*)(F.lds + rl * 2048 + chunk * 16 + 8 * (lane & 1)) = w; }
            }
        }
        __syncthreads();
        {
            const int rt = wave & 3, ct = wave >> 2, fr = lane & 15, fq = lane >> 4;
            pg8::f32x4 acc = {0.f, 0.f, 0.f, 0.f};
            const bf16* wrow = Wdt_t + (size_t)(16 * ct + fr) * D + 8 * fq;
#pragma unroll 4
            for (int ks = 0; ks < 32; ++ks) {
                const bf16x8 av = *(const LAS bf16x8*)(F.lds + (16 * rt + fr) * 2048 + (((4 * ks + fq) ^ fr) * 16));
                const bf16x8 bv = *(const bf16x8*)(wrow + 32 * ks);
                acc = __builtin_amdgcn_mfma_f32_16x16x32_bf16(av, bv, acc, 0, 0, 0);
            }
            const float bias = dtb[16 * ct + fr];
#pragma unroll
            for (int r = 0; r < 4; ++r) { const float v = acc[r] + bias; const float sp = v > 20.f ? v : log1pf(__expf(v));
                DT[(size_t)(row0 + 16 * rt + 4 * fq + r) * NH + 16 * ct + fr] = sp; }
        }
        __syncthreads();
    }
}

DI void ph3_convbranch(const Ctx& F, const Args& a, int reps) {
    const bf16* U = (const bf16*)(F.ws + WS_U); bf16* UC = (bf16*)(F.ws + WS_XN);
    const float* cw = ARG(I_CVW); const float* cb = ARG(I_CVB); const float* lg = ARG(I_LNG); const float* lb = ARG(I_LNB);
    const int tid = F.wave * 64 + lane_id(), lane = lane_id(), wave = F.wave;
    LAS unsigned char* tile = F.lds;
    LAS float* red = (LAS float*)(F.lds + 62 * 2048);
    LAS float* stat = red + 32 * 8 * 2;
    f2v w[31];
#pragma unroll
    for (int j = 0; j < 31; ++j) w[j] = *(const f2v*)(cw + j * D + 2 * tid);
    const f2v bias = *(const f2v*)(cb + 2 * tid), gam = *(const f2v*)(lg + 2 * tid), bet = *(const f2v*)(lb + 2 * tid);
    const int RU = (M / 32 + F.G - 1) / F.G;
    for (int it = 0; it < RU * reps; ++it) {
        const int unit = xcd_unit(F.xcd, F.xj, F.G >> 3, (it >= RU ? it - RU : it), M / 32); if (unit < 0) break; const int t0 = unit * 32;
        for (int piece = tid; piece < 62 * 128; piece += NTHREADS) { const int r = piece >> 7, cch = piece & 127, t = t0 - 30 + r;
            v4u v = {0u, 0u, 0u, 0u}; if (t >= 0) v = *(const v4u*)(U + (size_t)t * D + cch * 8);
            *(LAS v4u*)(tile + r * 2048 + cch * 16) = v; }
        __syncthreads();
        f2v o[32];
#pragma unroll
        for (int tg = 0; tg < 8; ++tg) {
            f2v acc[4];
#pragma unroll
            for (int i = 0; i < 4; ++i) acc[i] = bias;
#pragma unroll
            for (int j = 0; j < 34; ++j) {
                const unsigned uu = *(const LAS unsigned*)(tile + (4 * tg + j) * 2048 + tid * 4);
                const f2v u2 = {bflo(uu), bfhi(uu)};
#pragma unroll
                for (int i = 0; i < 4; ++i) { const int jj = j - i; if (jj >= 0 && jj <= 30) acc[i] = __builtin_elementwise_fma(w[jj], u2, acc[i]); }
            }
#pragma unroll
            for (int i = 0; i < 4; ++i) o[4 * tg + i] = acc[i];
        }
        {
            float r5[64];
#pragma unroll
            for (int tk = 0; tk < 32; ++tk) { r5[2 * tk] = o[tk].x + o[tk].y; r5[2 * tk + 1] = o[tk].x * o[tk].x + o[tk].y * o[tk].y; }
            float r4[32], r3[16], r2[8], r1[4], r0[2];
            { const bool up = (lane & 32) != 0;
#pragma unroll
              for (int i = 0; i < 32; ++i) { const float keep = up ? r5[i + 32] : r5[i], send = up ? r5[i] : r5[i + 32]; r4[i] = keep + __shfl_xor(send, 32); } }
            { const bool up = (lane & 16) != 0;
#pragma unroll
              for (int i = 0; i < 16; ++i) { const float keep = up ? r4[i + 16] : r4[i], send = up ? r4[i] : r4[i + 16]; r3[i] = keep + __shfl_xor(send, 16); } }
            { const bool up = (lane & 8) != 0;
#pragma unroll
              for (int i = 0; i < 8; ++i) { const float keep = up ? r3[i + 8] : r3[i], send = up ? r3[i] : r3[i + 8]; r2[i] = keep + __shfl_xor(send, 8); } }
            { const bool up = (lane & 4) != 0;
#pragma unroll
              for (int i = 0; i < 4; ++i) { const float keep = up ? r2[i + 4] : r2[i], send = up ? r2[i] : r2[i + 4]; r1[i] = keep + __shfl_xor(send, 4); } }
            { const bool up = (lane & 2) != 0;
#pragma unroll
              for (int i = 0; i < 2; ++i) { const float keep = up ? r1[i + 2] : r1[i], send = up ? r1[i] : r1[i + 2]; r0[i] = keep + __shfl_xor(send, 2); } }
            const bool up0 = (lane & 1) != 0;
            const float tot = (up0 ? r0[1] : r0[0]) + __shfl_xor(up0 ? r0[0] : r0[1], 1);
            red[((lane >> 1) * 8 + wave) * 2 + (lane & 1)] = tot;
        }
        __syncthreads();
        if (tid < 32) { float s = 0.f, q = 0.f;
#pragma unroll
            for (int wv = 0; wv < 8; ++wv) { s += red[(tid * 8 + wv) * 2]; q += red[(tid * 8 + wv) * 2 + 1]; }
            const float mean = s * (1.0f / D); const float var = fmaxf(q * (1.0f / D) - mean * mean, 0.f);
            stat[tid * 2] = mean; stat[tid * 2 + 1] = 1.0f / sqrtf(var + EPS); }
        __syncthreads();
#pragma unroll
        for (int tk = 0; tk < 32; ++tk) { const float mean = stat[tk * 2], rstd = stat[tk * 2 + 1];
            const float y0 = (o[tk].x - mean) * rstd * gam.x + bet.x, y1 = (o[tk].y - mean) * rstd * gam.y + bet.y;
            *(unsigned*)(UC + (size_t)(t0 + tk) * D + 2 * tid) = pk2(siluf_(y0), siluf_(y1)); }
        __syncthreads();
    }
}

DI void conv_block(const bf16* XBC, const float* cw, const float* cb, int t_first, int col, float (&o)[8][8]) {
    v4u raw[11];
#pragma unroll
    for (int r = 0; r < 11; ++r) { const int t = t_first - 3 + r; const int tc = t < 0 ? 0 : t; v4u v = *(const v4u*)(XBC + (size_t)tc * XBCW + col);
        const unsigned msk = t < 0 ? 0u : 0xffffffffu; v.x &= msk; v.y &= msk; v.z &= msk; v.w &= msk; raw[r] = v; }
    float w[4][8], b[8];
#pragma unroll
    for (int j = 0; j < 4; ++j) { const f32x4 lo = *(const f32x4*)(cw + j * XBCW + col), hi = *(const f32x4*)(cw + j * XBCW + col + 4);
        w[j][0] = lo.x; w[j][1] = lo.y; w[j][2] = lo.z; w[j][3] = lo.w; w[j][4] = hi.x; w[j][5] = hi.y; w[j][6] = hi.z; w[j][7] = hi.w; }
    { const f32x4 lo = *(const f32x4*)(cb + col), hi = *(const f32x4*)(cb + col + 4); b[0] = lo.x; b[1] = lo.y; b[2] = lo.z; b[3] = lo.w; b[4] = hi.x; b[5] = hi.y; b[6] = hi.z; b[7] = hi.w; }
#pragma unroll
    for (int tk = 0; tk < 8; ++tk)
#pragma unroll
        for (int ch = 0; ch < 8; ++ch) {
            float acc = b[ch];
#pragma unroll
            for (int j = 0; j < 4; ++j) { const unsigned wd = raw[tk + j][ch >> 1]; const float xv = (ch & 1) ? bfhi(wd) : bflo(wd); acc += w[j][ch] * xv; }
            o[tk][ch] = siluf_(acc);
        }
}
DI float head_scan(const float* DT, const float* alog, int t0, int h, int lane, LAS float* acs_h, LAS float* dtv_h, float& d0o, float& d1o, float& c0o, float& c1o) {
    const float d0 = DT[(size_t)(t0 + 2 * lane) * NH + h], d1 = DT[(size_t)(t0 + 2 * lane + 1) * NH + h];
    const float A2 = -__expf(alog[h]) * LOG2E;
    const float a0 = d0 * A2, a1 = d1 * A2; float inc = a0 + a1;
#pragma unroll
    for (int o = 1; o < 64; o <<= 1) { const float t = __shfl_up(inc, o); if (lane >= o) inc += t; }
    acs_h[2 * lane] = inc - a1; acs_h[2 * lane + 1] = inc; dtv_h[2 * lane] = d0; dtv_h[2 * lane + 1] = d1;
    d0o = d0; d1o = d1; c0o = inc - a1; c1o = inc;
    return __shfl(inc, 63);
}

constexpr int S_CN = 0, S_BN = 32768, S_XT = 65536, S_ACS = 131072, S_DTV = 135168, S_SSQ = 139264, S_FS = 139776;

DI void ph3_chunk_states(const Ctx& F, const Args& a, int reps) {
    const bf16* XBC = (const bf16*)(F.ws + WS_XBC); const float* DT = (const float*)(F.ws + WS_DT);
    bf16* ST = (bf16*)(F.ws + WS_ST); float* CD = (float*)(F.ws + WS_CD);
    const float* scw = ARG(I_SCW); const float* scb = ARG(I_SCB); const float* alog = ARG(I_ALOG);
    const int tid = F.wave * 64 + lane_id(), lane = lane_id(), wave = F.wave, hh = lane >> 5;
    LAS unsigned char* lds = F.lds;
    LAS float* acs = (LAS float*)(lds + S_ACS); LAS float* wsc = (LAS float*)(lds + S_DTV);
    const int RU = (NCH * NGRP + F.G - 1) / F.G;
    for (int it = 0; it < RU * reps; ++it) {
        const int unit = xcd_unit(F.xcd, F.xj, F.G >> 3, (it >= RU ? it - RU : it), NCH * NGRP); if (unit < 0) break; const int c = unit >> 2, g = unit & 3, t0 = c * LCH;
        {
            const int h = 8 * g + wave; float d0, d1, c0, c1;
            const float total = head_scan(DT, alog, t0, h, lane, acs + wave * 128, wsc + wave * 128, d0, d1, c0, c1);
            wsc[wave * 128 + 2 * lane] = d0 * __builtin_amdgcn_exp2f(total - c0); wsc[wave * 128 + 2 * lane + 1] = d1 * __builtin_amdgcn_exp2f(total - c1);
            if (lane == 0) CD[c * NH + h] = __builtin_amdgcn_exp2f(total);
        }
        __syncthreads();
        if (tid < 256) { const int co = tid & 15, to = tid >> 4; float o[8][8];
            conv_block(XBC, scw, scb, t0 + 8 * to, 2048 + 128 * g + 8 * co, o);
#pragma unroll
            for (int ch = 0; ch < 8; ++ch) { const int row = 8 * co + ch;
                v4u w; w.x = pk2(o[0][ch], o[1][ch]); w.y = pk2(o[2][ch], o[3][ch]); w.z = pk2(o[4][ch], o[5][ch]); w.w = pk2(o[6][ch], o[7][ch]);
                *(LAS v4u*)(lds + S_BN + row * 256 + swz(row, to) * 16) = w; } }
        for (int ps = 0; ps < 2; ++ps) {
            {
                const int co = tid & 31, to = tid >> 5, hd = co >> 3, p0 = (co & 7) * 8; float o[8][8];
                conv_block(XBC, scw, scb, t0 + 8 * to, 512 * g + 64 * (4 * ps + hd) + p0, o);
                float sc[8];
#pragma unroll
                for (int tk = 0; tk < 8; ++tk) sc[tk] = wsc[(4 * ps + hd) * 128 + 8 * to + tk];
#pragma unroll
                for (int ch = 0; ch < 8; ++ch) { const int row = hd * 64 + p0 + ch;
                    v4u w; w.x = pk2(o[0][ch] * sc[0], o[1][ch] * sc[1]); w.y = pk2(o[2][ch] * sc[2], o[3][ch] * sc[3]);
                    w.z = pk2(o[4][ch] * sc[4], o[5][ch] * sc[5]); w.w = pk2(o[6][ch] * sc[6], o[7][ch] * sc[7]);
                    *(LAS v4u*)(lds + S_XT + row * 256 + swz(row, to) * 16) = w; }
            }
            __syncthreads();
            {
                const int hd = wave & 3, ph = wave >> 2, h = 8 * g + 4 * ps + hd;
                f32x16 acc[4];
#pragma unroll
                for (int nt = 0; nt < 4; ++nt)
#pragma unroll
                    for (int i = 0; i < 16; ++i) acc[nt][i] = 0.f;
                const int arow = hd * 64 + 32 * ph + (lane & 31);
#pragma unroll
                for (int ks = 0; ks < 8; ++ks) {
                    const bf16x8 av = *(const LAS bf16x8*)(lds + S_XT + arow * 256 + swz(arow, 2 * ks + hh) * 16);
#pragma unroll
                    for (int nt = 0; nt < 4; ++nt) { const int brow = 32 * nt + (lane & 31);
                        const bf16x8 bv = *(const LAS bf16x8*)(lds + S_BN + brow * 256 + swz(brow, 2 * ks + hh) * 16);
                        acc[nt] = MFMA32(av, bv, acc[nt]); }
                }
                bf16* dst = ST + ((size_t)(c * NH + h) * HD) * NST;
#pragma unroll
                for (int nt = 0; nt < 4; ++nt)
#pragma unroll
                    for (int i = 0; i < 16; i += 2) { const int p = 32 * ph + crow(i, hh); const unsigned pk = pk2(acc[nt][i], acc[nt][i + 1]);
                        dst[(size_t)p * NST + 32 * nt + (lane & 31)] = (bf16)(pk & 0xffffu); dst[(size_t)(p + 1) * NST + 32 * nt + (lane & 31)] = (bf16)(pk >> 16); }
            }
            __syncthreads();
        }
    }
}

DI void ph4_scan(const Ctx& F, size_t dst_off) {
    unsigned* ST32 = (unsigned*)(F.ws + WS_ST); unsigned* DST32 = (unsigned*)(F.ws + dst_off); const float* CD = (const float*)(F.ws + WS_CD);
    constexpr int NPAIR = NH * HD * NST / 2;
    for (int e = F.vcu * NTHREADS + (F.wave * 64 + lane_id()); e < NPAIR; e += F.G * NTHREADS) {
        const int h = e >> 12; float c0 = 0.f, c1 = 0.f;
#pragma unroll 1
        for (int cb = 0; cb < NCH; cb += 32) {
            unsigned v[32]; float dec[32];
#pragma unroll
            for (int i = 0; i < 32; ++i) { v[i] = __builtin_nontemporal_load(ST32 + (size_t)(cb + i) * NPAIR + e); dec[i] = CD[(cb + i) * NH + h]; }
#pragma unroll
            for (int i = 0; i < 32; ++i) { DST32[(size_t)(cb + i) * NPAIR + e] = pk2(c0, c1); c0 = c0 * dec[i] + bflo(v[i]); c1 = c1 * dec[i] + bfhi(v[i]); }
        }
    }
}

DI void ph5_ssd_out(const Ctx& F, const Args& a, int reps) {
    const bf16* XBC = (const bf16*)(F.ws + WS_XBC); const float* DT = (const float*)(F.ws + WS_DT);
    const bf16* ST = (const bf16*)(F.ws + WS_ST); const bf16* ZS = (const bf16*)(F.ws + WS_ZS); bf16* YS = (bf16*)(F.ws + WS_YS);
    const float* scw = ARG(I_SCW); const float* scb = ARG(I_SCB); const float* alog = ARG(I_ALOG); const float* dskip = ARG(I_DSKIP);
    const int tid = F.wave * 64 + lane_id(), lane = lane_id(), wave = F.wave, hh = lane >> 5, l31 = lane & 31;
    LAS unsigned char* lds = F.lds;
    LAS float* acs = (LAS float*)(lds + S_ACS); LAS float* dtv = (LAS float*)(lds + S_DTV); LAS float* ssq = (LAS float*)(lds + S_SSQ);
    const int RU = (NCH * NGRP + F.G - 1) / F.G;
    for (int it = 0; it < RU * reps; ++it) {
        const int unit = xcd_unit(F.xcd, F.xj, F.G >> 3, (it >= RU ? it - RU : it), NCH * NGRP); if (unit < 0) break; const int c = unit >> 2, g = unit & 3, t0 = c * LCH;
        { const int h = 8 * g + wave; float d0, d1, c0, c1; (void)head_scan(DT, alog, t0, h, lane, acs + wave * 128, dtv + wave * 128, d0, d1, c0, c1);
          const float cend = __shfl(c1, (lane & 48) | 15);
          LAS float* fsw = (LAS float*)(lds + S_FS) + wave * 128;
          fsw[2 * lane] = d0 * __builtin_amdgcn_exp2f(cend - c0); fsw[2 * lane + 1] = d1 * __builtin_amdgcn_exp2f(cend - c1); }
        if (tid < 128) ssq[tid] = 0.f;
        { const int which = tid >> 8, t8 = tid & 255, co = t8 & 15; int to = t8 >> 4; asm volatile("" : "+v"(to)); float o[8][8];
            conv_block(XBC, scw, scb, t0 + 8 * to, (which ? 2560 : 2048) + 128 * g + 8 * co, o);
            const int base = which ? S_CN : S_BN;
#pragma unroll
            for (int tk = 0; tk < 8; ++tk) { const int row = 8 * to + tk;
                v4u w; w.x = pk2(o[tk][0], o[tk][1]); w.y = pk2(o[tk][2], o[tk][3]); w.z = pk2(o[tk][4], o[tk][5]); w.w = pk2(o[tk][6], o[tk][7]);
                *(LAS v4u*)(lds + base + row * 256 + swz(row, co) * 16) = w; } }
#pragma unroll 1
        for (int ps = 0; ps < 2; ++ps) {
            {
                const int co = tid & 31; int to = tid >> 5; asm volatile("" : "+v"(to));
                const int hd = co >> 3, p0 = (co & 7) * 8; float o[8][8];
                conv_block(XBC, scw, scb, t0 + 8 * to, 512 * g + 64 * (4 * ps + hd) + p0, o);
#pragma unroll
                for (int ch = 0; ch < 8; ++ch) { const int row = hd * 64 + p0 + ch;
                    v4u w; w.x = pk2(o[0][ch], o[1][ch]); w.y = pk2(o[2][ch], o[3][ch]); w.z = pk2(o[4][ch], o[5][ch]); w.w = pk2(o[6][ch], o[7][ch]);
                    *(LAS v4u*)(lds + S_XT + row * 256 + swz(row, to) * 16) = w; }
            }
            __syncthreads();
            const int hd = wave & 3, lp = wave >> 2, hl = 4 * ps + hd, h = 8 * g + hl;
            const float Dh = dskip[h];
            const LAS float* acs_h = acs + hl * 128; const LAS float* dt_h = dtv + hl * 128; const LAS float* fs_h = (const LAS float*)(lds + S_FS) + hl * 128;
            const bf16* prev = ST + ((size_t)(c * NH + h) * HD) * NST;
            const int erow = lane >> 1, ehalf = lane & 1;
            f32x16 acc[2][2];
            {
#pragma unroll
                for (int which = 0; which < 2; ++which)
#pragma unroll
                    for (int pt = 0; pt < 2; ++pt)
#pragma unroll
                        for (int i = 0; i < 16; ++i) acc[which][pt][i] = 0.f;
                const int rowA = 32 * lp + l31, rowB = 32 * (3 - lp) + l31;
#pragma unroll
                for (int ks = 0; ks < 8; ++ks) {
                    const bf16x8 b0 = *(const bf16x8*)(prev + (size_t)l31 * NST + 16 * ks + 8 * hh), b1 = *(const bf16x8*)(prev + (size_t)(32 + l31) * NST + 16 * ks + 8 * hh);
                    const bf16x8 a0 = *(const LAS bf16x8*)(lds + S_CN + rowA * 256 + swz(rowA, 2 * ks + hh) * 16);
                    const bf16x8 a1 = *(const LAS bf16x8*)(lds + S_CN + rowB * 256 + swz(rowB, 2 * ks + hh) * 16);
                    acc[0][0] = MFMA32(a0, b0, acc[0][0]); acc[0][1] = MFMA32(a0, b1, acc[0][1]);
                    acc[1][0] = MFMA32(a1, b0, acc[1][0]); acc[1][1] = MFMA32(a1, b1, acc[1][1]);
                }
#pragma unroll
                for (int which = 0; which < 2; ++which) { const int li = which == 0 ? lp : 3 - lp;
#pragma unroll
                    for (int i = 0; i < 16; ++i) { const float e = __builtin_amdgcn_exp2f(acs_h[32 * li + crow(i, hh)]); acc[which][0][i] *= e; acc[which][1][i] *= e; } }
            }
            {
                const int liA = lp, liB = 3 - lp;
                const int rowA = 32 * liA + l31, rowB = 32 * liB + l31;
                const float alA = acs_h[rowA], alB = acs_h[rowB];
#pragma unroll 1
                for (int sj = 0; sj <= liB; ++sj) {
                    const bool doA = sj <= liA;
                    f32x16 GA, GB;
#pragma unroll
                    for (int i = 0; i < 16; ++i) { GA[i] = 0.f; GB[i] = 0.f; }
                    const int brow = 32 * sj + l31;
                    if (doA) {
#pragma unroll 2
                        for (int ks = 0; ks < 8; ++ks) {
                            const bf16x8 av = *(const LAS bf16x8*)(lds + S_BN + brow * 256 + swz(brow, 2 * ks + hh) * 16);
                            const bf16x8 ca = *(const LAS bf16x8*)(lds + S_CN + rowA * 256 + swz(rowA, 2 * ks + hh) * 16);
                            const bf16x8 cb = *(const LAS bf16x8*)(lds + S_CN + rowB * 256 + swz(rowB, 2 * ks + hh) * 16);
                            GA = MFMA32(av, ca, GA); GB = MFMA32(av, cb, GB);
                        }
                    } else {
#pragma unroll 2
                        for (int ks = 0; ks < 8; ++ks) {
                            const bf16x8 av = *(const LAS bf16x8*)(lds + S_BN + brow * 256 + swz(brow, 2 * ks + hh) * 16);
                            const bf16x8 cb = *(const LAS bf16x8*)(lds + S_CN + rowB * 256 + swz(rowB, 2 * ks + hh) * 16);
                            GB = MFMA32(av, cb, GB);
                        }
                    }
                    auto mask = [&](f32x16& G, int li, int row_l, float al) {
                        if (sj < li) {
                            const float fl = __builtin_amdgcn_exp2f(al - acs_h[32 * sj + 31]);
#pragma unroll
                            for (int i = 0; i < 16; ++i) G[i] = G[i] * (fs_h[32 * sj + crow(i, hh)] * fl);
                        } else {
#pragma unroll
                            for (int i = 0; i < 16; ++i) { const int s = 32 * sj + crow(i, hh);
                                float v = G[i] * __builtin_amdgcn_exp2f(fminf(al - acs_h[s], 0.f)) * dt_h[s];
                                v = (s > row_l) ? 0.f : v; v = (s == row_l) ? v + Dh : v; G[i] = v; }
                        }
                    };
                    auto pv = [&](const f32x16& G, f32x16 (&ac)[2]) {
#pragma unroll
                        for (int s2 = 0; s2 < 2; ++s2) {
                            v4u fa; fa.x = pk2(G[8 * s2 + 0], G[8 * s2 + 1]); fa.y = pk2(G[8 * s2 + 2], G[8 * s2 + 3]); fa.z = pk2(G[8 * s2 + 4], G[8 * s2 + 5]); fa.w = pk2(G[8 * s2 + 6], G[8 * s2 + 7]);
#pragma unroll
                            for (int pt = 0; pt < 2; ++pt) { const int xrow = hd * 64 + 32 * pt + l31; const int sc0 = 32 * sj + 16 * s2;
                                const v2u lo = *(const LAS v2u*)(lds + S_XT + xrow * 256 + swz(xrow, (sc0 >> 3)) * 16 + 8 * hh);
                                const v2u hi = *(const LAS v2u*)(lds + S_XT + xrow * 256 + swz(xrow, (sc0 >> 3) + 1) * 16 + 8 * hh);
                                v4u bfr; bfr.x = lo.x; bfr.y = lo.y; bfr.z = hi.x; bfr.w = hi.y;
                                ac[pt] = MFMA32(__builtin_bit_cast(bf16x8, fa), __builtin_bit_cast(bf16x8, bfr), ac[pt]); }
                        }
                    };
                    if (doA) { mask(GA, liA, rowA, alA); pv(GA, acc[0]); }
                    mask(GB, liB, rowB, alB); pv(GB, acc[1]);
                }
            }
            asm volatile("" ::: "memory");
            v4u zs[2][4];
#pragma unroll
            for (int which = 0; which < 2; ++which) { const int li = which == 0 ? lp : 3 - lp; const size_t t = (size_t)(t0 + 32 * li + erow);
#pragma unroll
                for (int j = 0; j < 4; ++j) zs[which][j] = *(const v4u*)(ZS + t * DIN + 64 * h + 32 * ehalf + 8 * j); }
            __syncthreads();
            {
                LAS unsigned char* stg = lds + S_XT + wave * 8192;
#pragma unroll
                for (int which = 0; which < 2; ++which)
#pragma unroll
                    for (int pt = 0; pt < 2; ++pt)
#pragma unroll
                        for (int i = 0; i < 16; ++i) *(LAS bf16*)(stg + ((which * 32 + crow(i, hh)) * 64 + 32 * pt + l31) * 2) = (bf16)(pk2(acc[which][pt][i], 0.f) & 0xffffu);
                LDS_WAIT(); asm volatile("" ::: "memory");
#pragma unroll
                for (int which = 0; which < 2; ++which) { const int li = which == 0 ? lp : 3 - lp; const int l = 32 * li + erow; const size_t t = (size_t)(t0 + l);
                    float q = 0.f;
#pragma unroll
                    for (int j = 0; j < 4; ++j) { const v4u yv = *(const LAS v4u*)(stg + ((which * 32 + erow) * 64 + 32 * ehalf + 8 * j) * 2); const v4u zv = zs[which][j];
                        float y[8] = {bflo(yv.x) * bflo(zv.x), bfhi(yv.x) * bfhi(zv.x), bflo(yv.y) * bflo(zv.y), bfhi(yv.y) * bfhi(zv.y), bflo(yv.z) * bflo(zv.z), bfhi(yv.z) * bfhi(zv.z), bflo(yv.w) * bflo(zv.w), bfhi(yv.w) * bfhi(zv.w)};
#pragma unroll
                        for (int k = 0; k < 8; ++k) q += y[k] * y[k];
                        v4u w; w.x = pk2(y[0], y[1]); w.y = pk2(y[2], y[3]); w.z = pk2(y[4], y[5]); w.w = pk2(y[6], y[7]);
                        *(v4u*)(YS + t * DIN + 64 * h + 32 * ehalf + 8 * j) = w; }
                    q += __shfl_xor(q, 1);
                    if (ehalf == 0) __hip_atomic_fetch_add(ssq + l, q, __ATOMIC_RELAXED, __HIP_MEMORY_SCOPE_WORKGROUP);
                }
            }
            __syncthreads();
        }
        if (tid < 128) ((float*)(F.ws + WS_RSTD))[(size_t)(t0 + tid) * 4 + g] = 1.0f / sqrtf(ssq[tid] * (1.0f / 512.f) + EPS);
        __syncthreads();
    }
}

constexpr int RT_LD = 1028;
DI void ph8_router(const Ctx& F, const Args& a, int reps) {
    const float* mod = (const float*)(F.ws + WS_CTL) + CW_MODC;
    const bf16* H = (const bf16*)(F.ws + WS_H16); const float* n2g = ARG(I_N2G); const float* bgrp = ARG(I_BGRP); const float* ber = ARG(I_BER);
    unsigned char* XN2 = F.ws + WS_XN; int* cnt0 = (int*)(F.ws + WS_CTL) + CW_CNT;
    int* RE = (int*)(F.ws + WS_ROUTE); int* RP = RE + 2 * M; float* RW = (float*)(RP + 2 * M); int* LIST = (int*)(F.ws + WS_LIST);
    const int lane = lane_id(), wave = F.wave;
    LAS float* tile = (LAS float*)F.lds;
    LAS float* pe = (LAS float*)F.lds;
    f32x4 gm[4], ga[4];
#pragma unroll
    for (int j = 0; j < 4; ++j) { const int k = 256 * j + 4 * lane; const f32x4 g = *(const f32x4*)(n2g + k), sc = *(const f32x4*)(mod + 4096 + k);
        gm[j] = g * (sc + 1.0f); ga[j] = *(const f32x4*)(mod + 3072 + k); }
    const int RU = (M / 32 + F.G - 1) / F.G;
    for (int it = 0; it < RU * reps; ++it) {
        const int unit = xcd_unit(F.xcd, F.xj, F.G >> 3, (it >= RU ? it - RU : it), M / 32); if (unit < 0) break; int* cnt = cnt0 + ((it >= RU * (reps - 1)) ? 0 : 4096);
        const int row0 = unit * 32;
        {
            f32x4 v[4][4];
#pragma unroll
            for (int rr = 0; rr < 4; ++rr)
#pragma unroll
                for (int j = 0; j < 4; ++j) { const v2u hw = *(const v2u*)(H + (size_t)(row0 + wave * 4 + rr) * D + 256 * j + 4 * lane); v[rr][j] = (f32x4){bflo(hw.x), bfhi(hw.x), bflo(hw.y), bfhi(hw.y)}; }
#pragma unroll
            for (int rr = 0; rr < 4; ++rr) { const int rl = wave * 4 + rr, row = row0 + rl; float ss = 0.f;
#pragma unroll
                for (int j = 0; j < 4; ++j) ss += (v[rr][j].x * v[rr][j].x + v[rr][j].y * v[rr][j].y) + (v[rr][j].z * v[rr][j].z + v[rr][j].w * v[rr][j].w);
                const float rstd = 1.0f / sqrtf(wave_sum(ss) * (1.0f / D) + EPS);
#pragma unroll
                for (int j = 0; j < 4; ++j) { const f32x4 n = v[rr][j] * rstd * gm[j] + ga[j];
                    *(LAS f32x4*)(tile + rl * RT_LD + 256 * j + 4 * lane) = n;
                    *(unsigned*)(XN2 + (size_t)row * D + 256 * j + 4 * lane) = pk4_fp8(n.x, n.y, n.z, n.w); }
            }
        }
        __syncthreads();
        pg8::f32x4 acc[2][5];
#pragma unroll
        for (int rt = 0; rt < 2; ++rt)
#pragma unroll
            for (int ct = 0; ct < 5; ++ct) acc[rt][ct] = (pg8::f32x4){0.f, 0.f, 0.f, 0.f};
        const int kb = wave * 128, fr = lane & 15, kq = lane >> 4;
        const bf16* WRH = (const bf16*)(F.ws + WS_WRH); const bf16* WRL = (const bf16*)(F.ws + WS_WRL);
#pragma unroll 2
        for (int ks = 0; ks < 4; ++ks) {
            const int k0 = kb + 32 * ks + 8 * kq;
            bf16x8 bh[5], bl[5];
#pragma unroll
            for (int ct = 0; ct < 5; ++ct) { bh[ct] = *(const bf16x8*)(WRH + (size_t)(16 * ct + fr) * D + k0); bl[ct] = *(const bf16x8*)(WRL + (size_t)(16 * ct + fr) * D + k0); }
#pragma unroll
            for (int rt = 0; rt < 2; ++rt) {
                const f32x4 x0 = *(const LAS f32x4*)(tile + (16 * rt + fr) * RT_LD + k0), x1 = *(const LAS f32x4*)(tile + (16 * rt + fr) * RT_LD + k0 + 4);
                v4u hv, lv;
                hv.x = pk2(x0.x, x0.y); hv.y = pk2(x0.z, x0.w); hv.z = pk2(x1.x, x1.y); hv.w = pk2(x1.z, x1.w);
                lv.x = pk2(x0.x - bflo(hv.x), x0.y - bfhi(hv.x)); lv.y = pk2(x0.z - bflo(hv.y), x0.w - bfhi(hv.y));
                lv.z = pk2(x1.x - bflo(hv.z), x1.y - bfhi(hv.z)); lv.w = pk2(x1.z - bflo(hv.w), x1.w - bfhi(hv.w));
                const bf16x8 ah = __builtin_bit_cast(bf16x8, hv), al = __builtin_bit_cast(bf16x8, lv);
#pragma unroll
                for (int ct = 0; ct < 5; ++ct) {
                    acc[rt][ct] = __builtin_amdgcn_mfma_f32_16x16x32_bf16(ah, bh[ct], acc[rt][ct], 0, 0, 0);
                    acc[rt][ct] = __builtin_amdgcn_mfma_f32_16x16x32_bf16(ah, bl[ct], acc[rt][ct], 0, 0, 0);
                    acc[rt][ct] = __builtin_amdgcn_mfma_f32_16x16x32_bf16(al, bh[ct], acc[rt][ct], 0, 0, 0); }
            }
        }
        __syncthreads();
#pragma unroll
        for (int rt = 0; rt < 2; ++rt)
#pragma unroll
            for (int ct = 0; ct < 5; ++ct)
#pragma unroll
                for (int r = 0; r < 4; ++r) pe[(wave * 32 + 16 * rt + 4 * kq + r) * 80 + 16 * ct + fr] = acc[rt][ct][r];
        __syncthreads();
        int e0s[4], e1s[4]; float w0s[4], w1s[4];
#pragma unroll
        for (int rr = 0; rr < 4; ++rr) { const int rl = wave * 4 + rr;
            float le = ber[lane], lgv = (lane < 8) ? bgrp[lane] : 0.f;
#pragma unroll
            for (int wv = 0; wv < 8; ++wv) { le += pe[(wv * 32 + rl) * 80 + lane]; if (lane < 8) lgv += pe[(wv * 32 + rl) * 80 + 64 + lane]; }
            float gl[8];
#pragma unroll
            for (int i = 0; i < 8; ++i) gl[i] = __shfl(lgv, i);
            int gi = 0; float gmax = gl[0];
#pragma unroll
            for (int i = 1; i < 8; ++i) if (gl[i] > gmax) { gmax = gl[i]; gi = i; }
            float den = 0.f;
#pragma unroll
            for (int i = 0; i < 8; ++i) den += __expf(gl[i] - gmax);
            const float gp = 1.0f / den;
            float el[8];
#pragma unroll
            for (int i = 0; i < 8; ++i) el[i] = __shfl(le, gi * 8 + i);
            int i0 = 0; float m0 = el[0];
#pragma unroll
            for (int i = 1; i < 8; ++i) if (el[i] > m0) { m0 = el[i]; i0 = i; }
            int i1 = -1; float m1 = -INFINITY;
#pragma unroll
            for (int i = 0; i < 8; ++i) if (i != i0 && el[i] > m1) { m1 = el[i]; i1 = i; }
            const float dd = __expf(m1 - m0);
            w0s[rr] = gp / (1.0f + dd); w1s[rr] = gp * dd / (1.0f + dd); e0s[rr] = gi * 8 + i0; e1s[rr] = gi * 8 + i1;
        }
        if (lane == 0) {
            int p0[4], p1[4];
#pragma unroll
            for (int rr = 0; rr < 4; ++rr) { p0[rr] = atomicAdd(cnt + 64 * e0s[rr], 1); p1[rr] = atomicAdd(cnt + 64 * e1s[rr], 1); }
#pragma unroll
            for (int rr = 0; rr < 4; ++rr) { const int row = row0 + wave * 4 + rr;
                RE[2 * row] = e0s[rr]; RE[2 * row + 1] = e1s[rr]; RP[2 * row] = p0[rr]; RP[2 * row + 1] = p1[rr]; RW[2 * row] = w0s[rr]; RW[2 * row + 1] = w1s[rr];
                LIST[e0s[rr] * 16384 + p0[rr]] = row; LIST[e1s[rr] * 16384 + p1[rr]] = row; }
        }
        __syncthreads();
    }
}

DI void build_tilebase(const Ctx& F) {
    const int* cnt = (const int*)(F.ws + WS_CTL) + CW_CNT; LAS int* tb = (LAS int*)(F.lds + TB_OFF);
    if (F.wave == 0) {
        const int lane = lane_id(); const int tiles = (cnt[64 * lane] + 255) >> 8; int inc = tiles;
#pragma unroll
        for (int o = 1; o < 64; o <<= 1) { const int t = __shfl_up(inc, o); if (lane >= o) inc += t; }
        tb[lane] = inc - tiles; if (lane == 63) tb[NE] = inc; ((LAS int*)(F.lds + CNTL_OFF))[lane] = cnt[64 * lane];
    }
    __syncthreads();
}
DI void fill_tokl(const Ctx& F, const MoeOrder& S) {
    const LAS int* tb = (const LAS int*)(F.lds + TB_OFF); const LAS int* cntl = (const LAS int*)(F.lds + CNTL_OFF); LAS int* tokl = (LAS int*)(F.lds + TOKL_OFF);
    const int* LIST = (const int*)(F.ws + WS_LIST); const int tid = F.wave * 64 + lane_id();
    for (int i = 0; i < 4; ++i) { pg8::Unit u; if (!S.next(i, u)) break;
        const int e = u.pn >> 2, r = 256 * (u.pm - tb[e]) + tid;
        if (tid < 256) tokl[256 * i + tid] = (r < cntl[e]) ? LIST[e * 16384 + r] : 0; }
    asm volatile("s_waitcnt vmcnt(0) lgkmcnt(0)" ::: "memory"); __syncthreads();
}
DI void ph12_final(const Ctx& F, const Args& a, int reps) {
    const float* mod = (const float*)(F.ws + WS_CTL) + CW_MODC; float* H = (float*)argp<N_IN>(); const bf16* H16 = (const bf16*)(F.ws + WS_H16); const float* fg = ARG(I_FG);
    const unsigned char* YE = F.ws + WS_YEXP; const int* RE = (const int*)(F.ws + WS_ROUTE); const int* RP = RE + 2 * M; const float* RW = (const float*)(F.ws + WS_ROUTE) + 4 * M;
    const LAS int* tb = (const LAS int*)(F.lds + TB_OFF);
    float* OUT2 = (float*)(F.ws + WS_U);
    const int gw = F.vcu * NWAVES + F.wave, NGW = F.G * NWAVES, lane = lane_id();
    f32x4 g2[4], fgv[4];
#pragma unroll
    for (int j = 0; j < 4; ++j) { g2[j] = *(const f32x4*)(mod + 5 * 1024 + 256 * j + 4 * lane); fgv[j] = *(const f32x4*)(fg + 256 * j + 4 * lane); }
    const int RT = (M / 2 + NGW - 1) / NGW;
    for (int it = 0; it < RT * reps; ++it) {
        const int t0 = 2 * xcd_unit(F.xcd, F.xj * NWAVES + F.wave, NGW >> 3, (it >= RT ? it - RT : it), M / 2); if (t0 < 0) break;
        float* O = (it >= RT * (reps - 1)) ? H : OUT2;
        int tt[2], d0[2], d1[2]; float w0[2], w1[2];
#pragma unroll
        for (int u = 0; u < 2; ++u) { tt[u] = (t0 + u) % M; d0[u] = 256 * tb[RE[2 * tt[u]]] + RP[2 * tt[u]]; d1[u] = 256 * tb[RE[2 * tt[u] + 1]] + RP[2 * tt[u] + 1]; w0[u] = RW[2 * tt[u]]; w1[u] = RW[2 * tt[u] + 1]; }
        f32x4 hv[2][4]; unsigned ya[2][4], yb[2][4];
#pragma unroll
        for (int u = 0; u < 2; ++u)
#pragma unroll
            for (int j = 0; j < 4; ++j) { const v2u hw = *(const v2u*)(H16 + (size_t)tt[u] * D + 256 * j + 4 * lane); hv[u][j] = (f32x4){bflo(hw.x), bfhi(hw.x), bflo(hw.y), bfhi(hw.y)};
                ya[u][j] = *(const unsigned*)(YE + (size_t)d0[u] * D + 256 * j + 4 * lane); yb[u][j] = *(const unsigned*)(YE + (size_t)d1[u] * D + 256 * j + 4 * lane); }
#pragma unroll
        for (int u = 0; u < 2; ++u) {
            f32x4 v[4]; float ss = 0.f;
#pragma unroll
            for (int j = 0; j < 4; ++j) { const unsigned a4 = ya[u][j], b4 = yb[u][j];
                const f2v a01 = __builtin_amdgcn_cvt_pk_f32_fp8(a4, false), a23 = __builtin_amdgcn_cvt_pk_f32_fp8(a4, true), b01 = __builtin_amdgcn_cvt_pk_f32_fp8(b4, false), b23 = __builtin_amdgcn_cvt_pk_f32_fp8(b4, true);
                f32x4 mo; mo.x = w0[u] * a01.x + w1[u] * b01.x; mo.y = w0[u] * a01.y + w1[u] * b01.y; mo.z = w0[u] * a23.x + w1[u] * b23.x; mo.w = w0[u] * a23.y + w1[u] * b23.y;
                mo = mo * 0.0625f;
                v[j] = hv[u][j] + g2[j] * mo; ss += (v[j].x * v[j].x + v[j].y * v[j].y) + (v[j].z * v[j].z + v[j].w * v[j].w); }
            const float rstd = 1.0f / sqrtf(wave_sum(ss) * (1.0f / D) + EPS);
#pragma unroll
            for (int j = 0; j < 4; ++j) *(f32x4*)(O + (size_t)tt[u] * D + 256 * j + 4 * lane) = v[j] * rstd * fgv[j];
        }
    }
}

constexpr int N_PHASES = 13;
#ifndef REP_MASK
#define REP_MASK 0
#endif
#define REPS(k) (((REP_MASK >> (k)) & 1) ? 2 : 1)
#ifndef MK_ONE_LAUNCH
#define MK_ONE_LAUNCH 1
#endif

struct RepOrder { pg8::StaticOrder s; int n, reps;
    DI bool next(int i, pg8::Unit& u) const { if (i >= n * reps) return false; return s.next(i % n, u); }
    DI void a_ready(const pg8::Unit&) const {}
    DI void done(const pg8::Unit&) const {} };

__global__ void __launch_bounds__(NTHREADS, 2) fwd_kernel(Args args) {
    extern __shared__ __attribute__((aligned(16))) unsigned char lds_raw[];
    Ctx F;
    F.lds = (LAS unsigned char*)lds_raw;
    F.wave = __builtin_amdgcn_readfirstlane((int)threadIdx.x >> 6);
    F.G = gridDim.x; { const int bx = blockIdx.x; F.xcd = bx & 7; F.xj = bx >> 3; F.vcu = F.xcd * (F.G >> 3) + F.xj; }
    F.ws = (unsigned char*)argp<N_IN + 1>();
    volatile LAS unsigned* MISC = (volatile LAS unsigned*)(F.lds + LDSCTL_OFF);
    for (int u = threadIdx.x; u < (LDS_BYTES - LDSCTL_OFF) / 4; u += NTHREADS) ((LAS unsigned*)(F.lds + LDSCTL_OFF))[u] = 0u;
    __syncthreads();
    const int lo = args.ph_lo, hi = args.ph_hi;
    unsigned* barw = (unsigned*)(F.ws + WS_CTL) + CW_BAR;
    XcdBarrier bar; bar.bar = barw; bar.x = 0; bar.st = nullptr;
    if (hi - lo > 1) bar = xcd_barrier_post(barw, MISC + 8);
    bar.wave = F.wave;
#define IN(k) (lo <= (k) && (k) < hi)
#define SEAM(k) do { if (IN(k) && IN((k) + 1)) { xcd_barrier(bar); if (REPS(14) > 1) xcd_barrier(bar); } } while (0)
    unsigned char* ws = F.ws;
    bf16* XN = (bf16*)(ws + WS_XN);
    const float* mod = (const float*)(ws + WS_CTL) + CW_MOD;

    if (IN(0)) { ph0_prologue(F, args, REPS(0)); SEAM(0); }
    if (IN(1)) { for (int rep = 0; rep < REPS(1); ++rep) { ph1_norm_dt(F, args); __syncthreads(); } SEAM(1); }
    if (IN(2)) {
        {
            pg8::Gemm g{XN, (const bf16*)(ws + WS_WIN) + (size_t)NP8 * 256 * D, M, NPROJ - NP8 * 256, D}; pg8::StaticOrder S; S.init(M, NPROJ - NP8 * 256, F.G, (int)blockIdx.x);
            EpiInProj E{ws, NP8};
            RepOrder R{S, (S.nwg - S.c + S.G - 1) / S.G, REPS(2)};
            pg8::gemm_phase<EpiInProj, RepOrder, true, true>(F.lds, g, R, E, F.wave);
        }
        __syncthreads();
        {
            pg8::Gemm g{(const bf16*)(ws + WS_XN8), (const bf16*)(ws + WS_W8IN), M, NP8 * 256, D / 2}; pg8::StaticOrder S; S.init(M, NP8 * 256, F.G, (int)blockIdx.x);
            EpiInProj E{ws, 0};
            RepOrder R{S, (S.nwg - S.c + S.G - 1) / S.G, REPS(2)};
            pg8::gemm_phase<EpiInProj, RepOrder, true, true, true>(F.lds, g, R, E, F.wave);
        }
        SEAM(2);
    }
    if (IN(3)) { ph3_convbranch(F, args, REPS(3)); __syncthreads(); ph3_chunk_states(F, args, REPS(13)); __syncthreads(); SEAM(3); }
    if (IN(4)) {
        if (REPS(4) > 1) ph4_scan(F, WS_YS);
        ph4_scan(F, WS_ST);
        pg8::Gemm g{XN, (const bf16*)(ws + WS_WCV), M, D, D}; pg8::StaticOrder S; S.init(M, D, F.G, (int)blockIdx.x);
        EpiGate<false> E{(bf16*)(ws + WS_TMP), nullptr, (const bf16*)(ws + WS_GATE), 0, nullptr};
        RepOrder R{S, (S.nwg - S.c + S.G - 1) / S.G, REPS(15)};
        pg8::gemm_phase<EpiGate<false>, RepOrder, false, true>(F.lds, g, R, E, F.wave);
        SEAM(4);
    }
    if (IN(5)) { ph5_ssd_out(F, args, REPS(5)); SEAM(5); }
    if (IN(6)) {
        pg8::Gemm g{(const bf16*)(ws + WS_YS), (const bf16*)(ws + WS_WSSM), M, D, DIN}; pg8::StaticOrder S; S.init(M, D, F.G, (int)blockIdx.x);
        LAS float* rt = (LAS float*)(F.lds + RT_OFF);
        EpiGate<true> E{(bf16*)(ws + WS_MG), (const bf16*)(ws + WS_TMP), (const bf16*)(ws + WS_GATE), 1024, rt};
        for (int i = 0;; ++i) {
            OneUnit S1; if (!S.next(i, S1.u)) break;
            if (F.wave < 4) { const int tid = F.wave * 64 + lane_id(); const f32x4 r = *(const f32x4*)((const float*)(ws + WS_RSTD) + (size_t)(S1.u.pm * 256 + tid) * 4);
                *(LAS f32x4*)(rt + tid * 4) = (f32x4){r.x / r.y, r.y / r.z, r.z / r.w, r.w}; }
            asm volatile("s_waitcnt vmcnt(0) lgkmcnt(0)" ::: "memory"); __syncthreads();
            pg8::gemm_phase<EpiGate<true>, OneUnit, false, true>(F.lds, g, S1, E, F.wave);
            __syncthreads();
        }
        SEAM(6);
    }
    if (IN(7)) {
        pg8::Gemm g{(const bf16*)(ws + WS_MG), (const bf16*)(ws + WS_WMIX), M, D, D}; pg8::StaticOrder S; S.init(M, D, F.G, (int)blockIdx.x);
        EpiMix E{(bf16*)(ws + WS_H16), ARG(I_X), (const float*)(ws + WS_CTL) + CW_MODC + 2 * 1024};
        RepOrder R{S, (S.nwg - S.c + S.G - 1) / S.G, REPS(7)};
        pg8::gemm_phase<EpiMix, RepOrder, false, true>(F.lds, g, R, E, F.wave);
        SEAM(7);
    }
    if (IN(8)) { for (int rep = 0; rep < REPS(8); ++rep) { convert_experts(F, args); __syncthreads(); } ph8_router(F, args, REPS(9)); if (IN(8) && IN(10)) xcd_barrier(bar); }
    if (IN(10)) {
        build_tilebase(F);
        const LAS int* tb = (const LAS int*)(F.lds + TB_OFF);
        pg8::Gemm g{(const bf16*)(ws + WS_XN), (const bf16*)(ws + WS_W13), M, NE * 1024, D / 2};
        MoeOrder S{tb, F.G, F.vcu, tb[NE] * 4, 1, (const LAS int*)(F.lds + TOKL_OFF)};
        fill_tokl(F, S);
        EpiUp E{ws + WS_HDN};
        pg8::gemm_phase<EpiUp, MoeOrder, true, true, true, true>(F.lds, g, S, E, F.wave);
        SEAM(10);
    }
    if (IN(11)) {
        build_tilebase(F);
        const LAS int* tb = (const LAS int*)(F.lds + TB_OFF);
        pg8::Gemm g{(const bf16*)(ws + WS_HDN), (const bf16*)(ws + WS_W2), 49152, NE * 1024, DFF / 2};
        MoeOrder S{tb, F.G, F.vcu, tb[NE] * 4, 1, nullptr};
        EpiDown E{ws + WS_YEXP};
        pg8::gemm_phase<EpiDown, MoeOrder, true, true, true>(F.lds, g, S, E, F.wave);
        SEAM(11);
    }
    if (IN(12)) { build_tilebase(F); ph12_final(F, args, REPS(12)); }
#undef IN
#undef SEAM
}

extern "C" void kernel_launch(void* const* d_in, const int* in_sizes, int n_in, void* d_out, int out_size, void* d_ws, size_t ws_size, hipStream_t stream) {
    static int grid = 0;
    if (grid == 0) {
        if (n_in != N_IN || in_sizes[0] != M * D || out_size != M * D || ws_size < WS_END) {
            fprintf(stderr, "kernel_launch: unexpected shapes: n_in %d in0 %d out %d ws %zu (need %zu)\n", n_in, n_in > 0 ? in_sizes[0] : -1, out_size, ws_size, (size_t)WS_END); grid = -1; return; }
        int dev = 0, cus = 0, per_cu = 0;
        if (hipGetDevice(&dev) != hipSuccess || hipDeviceGetAttribute(&cus, hipDeviceAttributeMultiprocessorCount, dev) != hipSuccess) { fprintf(stderr, "kernel_launch: device query failed\n"); grid = -1; return; }
        if (hipFuncSetAttribute((const void*)fwd_kernel, hipFuncAttributeMaxDynamicSharedMemorySize, LDS_BYTES) != hipSuccess) { fprintf(stderr, "kernel_launch: hipFuncSetAttribute failed\n"); grid = -1; return; }
        if (hipOccupancyMaxActiveBlocksPerMultiprocessor(&per_cu, (const void*)fwd_kernel, NTHREADS, LDS_BYTES) != hipSuccess || per_cu < 1) {
            fprintf(stderr, "kernel_launch: the occupancy query admits no workgroup of this kernel per CU (%d); nothing launched\n", per_cu); (void)hipGetLastError(); grid = -1; return; }
        grid = cus;
        if (cus < 192 || (cus & 7)) { fprintf(stderr, "kernel_launch: built for a 256-CU device (the MoE unit table holds 4 units per workgroup); %d CUs: nothing launched\n", cus); grid = -1; return; }
        fprintf(stderr, "kernel_launch: grid %d (cus %d, per_cu %d)\n", grid, cus, per_cu);
    }
    if (grid < 0) return;
    (void)hipMemsetAsync((char*)d_ws + WS_CTL, 0, CTL_ZERO_BYTES, stream);
    Args a{};
    for (int i = 0; i < N_IN; ++i) a.in[i] = (const float*)d_in[i];
    a.out = (float*)d_out; a.ws = (unsigned char*)d_ws;
#if MK_ONE_LAUNCH
    a.ph_lo = 0; a.ph_hi = N_PHASES;
    void* kargs[] = {&a};
    hipError_t e = hipLaunchCooperativeKernel((const void*)fwd_kernel, dim3(grid), dim3(NTHREADS), kargs, LDS_BYTES, stream);
    if (e != hipSuccess) fprintf(stderr, "kernel_launch: cooperative launch failed: %s\n", hipGetErrorString(e));
#else
    for (int ph = 0; ph < N_PHASES; ++ph) {
        a.ph_lo = ph; a.ph_hi = ph + 1;
        hipLaunchKernelGGL(fwd_kernel, dim3(grid), dim3(NTHREADS), LDS_BYTES, stream, a);
    }
#endif
}
```

```cpp
#include <hip/hip_runtime.h>
#include <hip/hip_cooperative_groups.h>
#include <cstdio>
#include <cstdint>
namespace pg8 {
#define PG8_LAS __attribute__((address_space(3)))
typedef unsigned short bf16_t;
typedef short bf16x8 __attribute__((ext_vector_type(8)));
typedef float f32x4 __attribute__((ext_vector_type(4)));
typedef unsigned u32x4 __attribute__((ext_vector_type(4)));
typedef int v4i_ __attribute__((ext_vector_type(4)));
typedef int v8i_ __attribute__((ext_vector_type(8)));
constexpr int BM = 256, BK = 64, HALF = 128, HTB = HALF * BK * 2  , STAGE_BYTES = 8 * HTB, NXCD = 8, WGM = 8;

__host__ __device__ __forceinline__ int lds_byte(int r, int c) { const int st = (r >> 4) * 2 + (c >> 5), rr = r & 15, cc = c & 31, ob = rr * 64 + cc * 2; return st * 1024 + (ob ^ (((ob >> 9) & 1) << 5)); }
__host__ __device__ __forceinline__ void stage_rc(int b, int& R, int& C) { const int st = b / 1024, sb = b % 1024, swz = sb ^ (((sb >> 9) & 1) << 5); R = (st >> 1) * 16 + swz / 64; C = (st & 1) * 32 + (swz % 64) / 2; }
__host__ __device__ __forceinline__ int perm32(int rho) { const int n = rho >> 4, i = rho & 15; return 8 * (i >> 2) + 4 * n + (i & 3); }

struct Unit { int pm, pn; };
struct Gemm { const bf16_t* A; const bf16_t* Bt; int M, N, K; };

struct StaticOrder {
    int nM, nN, nwg, G, c;
    __host__ __device__ void init(int M, int N, int G_, int c_) { nM = M / BM; nN = N / BM; nwg = nM * nN; G = G_; c = c_; }
    __host__ __device__ bool next(int i, Unit& u) const {
        const long L = (long)i * G + c; if (L >= nwg) return false;
        int wgid = (int)L; { const int q = nwg / NXCD, r = nwg % NXCD, xcd = wgid % NXCD, off = wgid / NXCD; wgid = (xcd < r ? xcd * (q + 1) : r * (q + 1) + (xcd - r) * q) + off; }
        const int nig = WGM * nN, gid = wgid / nig, fm = gid * WGM, gsz = (nM - fm) < WGM ? (nM - fm) : WGM;
        u.pm = fm + ((wgid % nig) % gsz); u.pn = (wgid % nig) / gsz; return true;
    }
    __device__ __forceinline__ void a_ready(const Unit&) const {}
    __device__ __forceinline__ void done(const Unit&) const {}
};

__device__ __forceinline__ unsigned cvt_pk_bf16(float lo, float hi) { unsigned r; asm volatile("v_cvt_pk_bf16_f32 %0, %1, %2" : "=v"(r) : "v"(lo), "v"(hi)); return r; }
typedef float f32x2 __attribute__((ext_vector_type(2)));
template <class Epi, class Sched, bool ALIGN_EPI = false, bool SP2 = false, bool FP8 = false, bool GATHER = false>
__device__ __forceinline__ void gemm_phase(PG8_LAS unsigned char* lds, const Gemm g, const Sched& S, const Epi& E, const int wave_in) {
    const int lane = (int)__builtin_amdgcn_mbcnt_hi(~0u, __builtin_amdgcn_mbcnt_lo(~0u, 0u)), wid = wave_in, tid = wid * 64 + lane, wr = wid >> 2, wc = wid & 3, fr = lane & 15, fq = lane >> 4;
    const int K = g.K, nt = K / BK;
    unsigned voffA[2], voffB[2];
#pragma unroll
    for (int i = 0; i < 2; ++i) { int R, C; stage_rc(tid * 16 + i * 8192, R, C); const int Rb = Epi::PERM ? ((R & ~31) + perm32(R & 31)) : R;
        voffA[i] = (unsigned)(R * K + C) * 2u; voffB[i] = (unsigned)(Rb * K + C) * 2u; }
    static_assert(!GATHER || SP2, "GATHER is implemented in the SP2 loop");
    unsigned gA[2][2], ngA[2][2]; int RA[2]; unsigned CA2[2];
#pragma unroll
    for (int i = 0; i < 2; ++i) { int R, C; stage_rc(tid * 16 + i * 8192, R, C); RA[i] = R; CA2[i] = (unsigned)C * 2u; }
    auto load_g = [&](int ui_, unsigned (&dst)[2][2]) {
        if constexpr (GATHER) {
#pragma unroll
            for (int h = 0; h < 2; ++h)
#pragma unroll
                for (int i = 0; i < 2; ++i) dst[h][i] = (unsigned)S.tokl[ui_ * 256 + 128 * h + RA[i]] * (unsigned)(K * 2) + CA2[i];
        }
    };
    const size_t kstep = (size_t)(BK * 2);
    const size_t hstep = (size_t)HALF * K * 2;
    const size_t tstep = 2 * hstep;
    const size_t hstepA = GATHER ? (size_t)0 : hstep, tstepA = GATHER ? (size_t)0 : 2 * hstep;
    const unsigned ldsw = (unsigned)wid * 1024u;
    const int aoff = lds_byte(wr * 64 + fr, fq * 8), boff = lds_byte(wc * 32 + fr, fq * 8);
#define PG8_SA(b, h) (((b) * 2 + (h)) * HTB)
#define PG8_SB(b, h) ((4 + (b) * 2 + (h)) * HTB)
#define PG8_STAGE(bufoff, gbase, voff) do { _Pragma("unroll") for (int _i = 0; _i < 2; ++_i) \
        __builtin_amdgcn_global_load_lds((const unsigned*)((const char*)(gbase) + (voff)[_i]), (PG8_LAS unsigned*)(lds + (bufoff) + ldsw + _i * 8192), 16, 0, 0); } while (0)
#define PG8_STAGE_A(bufoff, gbase, gvoff) do { if constexpr (GATHER) { PG8_STAGE(bufoff, gbase, gvoff); } else { PG8_STAGE(bufoff, gbase, voffA); } } while (0)
#define PG8_LDA(dst, b, h) do { if constexpr (FP8) { _Pragma("unroll") for (int m = 0; m < 4; ++m) dst##8[m] = __builtin_shufflevector(*(const PG8_LAS v4i_*)(lds + PG8_SA(b, h) + aoff + m * 2048), *(const PG8_LAS v4i_*)(lds + PG8_SA(b, h) + aoff + m * 2048 + 1024), 0, 1, 2, 3, 4, 5, 6, 7); } \
        else { _Pragma("unroll") for (int m = 0; m < 4; ++m) _Pragma("unroll") for (int k = 0; k < 2; ++k) dst[m][k] = *(const PG8_LAS bf16x8*)(lds + PG8_SA(b, h) + aoff + m * 2048 + k * 1024); } } while (0)
#define PG8_LDB(dst, b, h) do { if constexpr (FP8) { _Pragma("unroll") for (int n = 0; n < 2; ++n) dst##8[n] = __builtin_shufflevector(*(const PG8_LAS v4i_*)(lds + PG8_SB(b, h) + boff + n * 2048), *(const PG8_LAS v4i_*)(lds + PG8_SB(b, h) + boff + n * 2048 + 1024), 0, 1, 2, 3, 4, 5, 6, 7); } \
        else { _Pragma("unroll") for (int n = 0; n < 2; ++n) _Pragma("unroll") for (int k = 0; k < 2; ++k) dst[n][k] = *(const PG8_LAS bf16x8*)(lds + PG8_SB(b, h) + boff + n * 2048 + k * 1024); } } while (0)
#define PG8_MMA(ai, bj, At, Bt) do { __builtin_amdgcn_s_setprio(1); \
        if constexpr (FP8) {   \
              \
            _Pragma("unroll") for (int m = 0; m < 4; ++m) _Pragma("unroll") for (int n = 0; n < 2; ++n) \
                asm volatile("v_mfma_scale_f32_16x16x128_f8f6f4 %0, %1, %2, %0, %3, %4 op_sel_hi:[0,0,0]" : "+v"(acc[ai][bj][m][n]) : "v"(Bt##8[n]), "v"(At##8[m]), "v"(scale_w), "v"(scale_x)); \
        } else { \
        _Pragma("unroll") for (int m = 0; m < 4; ++m) _Pragma("unroll") for (int n = 0; n < 2; ++n) _Pragma("unroll") for (int k = 0; k < 2; ++k) \
        acc[ai][bj][m][n] = __builtin_amdgcn_mfma_f32_16x16x32_bf16(Bt[n][k], At[m][k], acc[ai][bj][m][n], 0, 0, 0); } __builtin_amdgcn_s_setprio(0); } while (0)
#define PG8_WAIT_V(n) asm volatile("s_waitcnt vmcnt(" #n ")" ::: "memory")
#define PG8_WAIT_L(n) asm volatile("s_waitcnt lgkmcnt(" #n ")" ::: "memory")
#define PG8_BAR __builtin_amdgcn_s_barrier()
#define PG8_SCHED __builtin_amdgcn_sched_barrier(0)
    Unit cur, nxt; int ui = 0;
    if (!S.next(0, cur)) return;
    f32x4 acc[2][2][4][2];
#pragma unroll
    for (int a = 0; a < 2; ++a)
#pragma unroll
        for (int b = 0; b < 2; ++b)
#pragma unroll
            for (int m = 0; m < 4; ++m)
#pragma unroll
                for (int n = 0; n < 2; ++n) acc[a][b][m][n] = (f32x4){0.f, 0.f, 0.f, 0.f};
    auto xdl_settle = [&]() {
        asm volatile("s_nop 15\n\ts_nop 15" : "+v"(acc[0][0][0][0]), "+v"(acc[0][0][0][1]), "+v"(acc[0][0][1][0]), "+v"(acc[0][0][1][1]), "+v"(acc[0][0][2][0]), "+v"(acc[0][0][2][1]), "+v"(acc[0][0][3][0]), "+v"(acc[0][0][3][1]), "+v"(acc[0][1][0][0]), "+v"(acc[0][1][0][1]), "+v"(acc[0][1][1][0]), "+v"(acc[0][1][1][1]), "+v"(acc[0][1][2][0]), "+v"(acc[0][1][2][1]), "+v"(acc[0][1][3][0]), "+v"(acc[0][1][3][1]));
        asm volatile("s_nop 0" : "+v"(acc[1][0][0][0]), "+v"(acc[1][0][0][1]), "+v"(acc[1][0][1][0]), "+v"(acc[1][0][1][1]), "+v"(acc[1][0][2][0]), "+v"(acc[1][0][2][1]), "+v"(acc[1][0][3][0]), "+v"(acc[1][0][3][1]), "+v"(acc[1][1][0][0]), "+v"(acc[1][1][0][1]), "+v"(acc[1][1][1][0]), "+v"(acc[1][1][1][1]), "+v"(acc[1][1][2][0]), "+v"(acc[1][1][2][1]), "+v"(acc[1][1][3][0]), "+v"(acc[1][1][3][1]));
    };
    const int scale_w = 0x79797979, scale_x = 0x7f7f7f7f;
    bf16x8 At[4][2], B0[2][2], B1[2][2]; v8i_ At8[4], B08[2], B18[2];
    const char* cA = (const char*)g.A + (size_t)cur.pm * tstepA; const char* cB = (const char*)g.Bt + (size_t)cur.pn * tstep;
    load_g(0, gA);
    S.a_ready(cur);
    if constexpr (SP2) {
        PG8_STAGE(PG8_SB(0, 0), cB, voffB); PG8_STAGE(PG8_SB(0, 1), cB + hstep, voffB); PG8_STAGE_A(PG8_SA(0, 0), cA, gA[0]); PG8_STAGE_A(PG8_SA(0, 1), cA + hstepA, gA[1]);
        if (wr == 1) PG8_BAR;
        PG8_WAIT_V(2); PG8_BAR;
        PG8_STAGE(PG8_SB(1, 0), cB + kstep, voffB); PG8_STAGE_A(PG8_SA(1, 0), cA + kstep, gA[0]); PG8_STAGE(PG8_SB(1, 1), cB + hstep + kstep, voffB);
        PG8_WAIT_V(6); PG8_BAR;
    } else {
        PG8_STAGE(PG8_SB(0, 0), cB, voffB); PG8_STAGE(PG8_SA(0, 0), cA, voffA); PG8_STAGE(PG8_SB(0, 1), cB + hstep, voffB); PG8_STAGE(PG8_SA(0, 1), cA + hstep, voffA);
        if (wr == 1) PG8_BAR;
        PG8_WAIT_V(4); PG8_BAR;
        PG8_STAGE(PG8_SB(1, 0), cB + kstep, voffB); PG8_STAGE(PG8_SA(1, 0), cA + kstep, voffA); PG8_STAGE(PG8_SB(1, 1), cB + hstep + kstep, voffB);
        PG8_WAIT_V(6); PG8_BAR;
    }
    for (;;) {
        const bool has_next = S.next(ui + 1, nxt);
        const char* nA = has_next ? (const char*)g.A + (size_t)nxt.pm * tstepA : cA; const char* nB = has_next ? (const char*)g.Bt + (size_t)nxt.pn * tstep : cB;
        if constexpr (GATHER) { if (has_next) load_g(ui + 1, ngA); else {
#pragma unroll
            for (int h = 0; h < 2; ++h)
#pragma unroll
                for (int i = 0; i < 2; ++i) ngA[h][i] = gA[h][i]; } }
        for (int t = 0; t < nt; t += 2) {
            const bool last = (t == nt - 2);
            const char* a1 = cA + (size_t)(t + 1) * kstep;
            const char* a2 = last ? nA : cA + (size_t)(t + 2) * kstep; const char* b2 = last ? nB : cB + (size_t)(t + 2) * kstep;
            const char* a3 = a2 + kstep; const char* b3 = b2 + kstep;
            if (last && has_next) S.a_ready(nxt);
            unsigned sN[2][2];
#pragma unroll
            for (int h = 0; h < 2; ++h)
#pragma unroll
                for (int i = 0; i < 2; ++i) sN[h][i] = last ? ngA[h][i] : gA[h][i];
            if constexpr (SP2) {
            PG8_LDB(B0, 0, 0); PG8_LDB(B1, 0, 1); PG8_SCHED; PG8_LDA(At, 0, 0); PG8_STAGE_A(PG8_SA(1, 1), a1 + hstepA, gA[1]);
            PG8_WAIT_V(8); PG8_WAIT_L(0); PG8_BAR; PG8_MMA(0, 0, At, B0); PG8_MMA(0, 1, At, B1); PG8_BAR; PG8_SCHED;
            PG8_LDA(At, 0, 1); PG8_STAGE(PG8_SB(0, 0), b2, voffB); PG8_STAGE(PG8_SB(0, 1), b2 + hstep, voffB); PG8_STAGE_A(PG8_SA(0, 0), a2, sN[0]);
            PG8_WAIT_V(8); PG8_WAIT_L(0); PG8_BAR; PG8_MMA(1, 0, At, B0); PG8_MMA(1, 1, At, B1); PG8_BAR; PG8_SCHED;
            PG8_LDB(B0, 1, 0); PG8_LDB(B1, 1, 1); PG8_SCHED; PG8_LDA(At, 1, 0); PG8_STAGE_A(PG8_SA(0, 1), a2 + hstepA, sN[1]);
            PG8_WAIT_V(8); PG8_WAIT_L(0); PG8_BAR; PG8_MMA(0, 0, At, B0); PG8_MMA(0, 1, At, B1); PG8_BAR; PG8_SCHED;
            PG8_LDA(At, 1, 1); PG8_STAGE(PG8_SB(1, 0), b3, voffB); PG8_STAGE(PG8_SB(1, 1), b3 + hstep, voffB); PG8_STAGE_A(PG8_SA(1, 0), a3, sN[0]);
            PG8_WAIT_V(8); PG8_WAIT_L(0); PG8_BAR; PG8_MMA(1, 0, At, B0); PG8_MMA(1, 1, At, B1); PG8_BAR; PG8_SCHED;
            } else {
            PG8_LDB(B0, 0, 0); PG8_SCHED; PG8_LDA(At, 0, 0); PG8_STAGE(PG8_SA(1, 1), a1 + hstep, voffA);
            PG8_WAIT_L(8); PG8_BAR; PG8_WAIT_L(0); PG8_MMA(0, 0, At, B0); PG8_BAR; PG8_SCHED;
            PG8_LDB(B1, 0, 1); PG8_STAGE(PG8_SB(0, 0), b2, voffB);
            PG8_BAR; PG8_WAIT_L(0); PG8_MMA(0, 1, At, B1); PG8_BAR;
            PG8_LDA(At, 0, 1); PG8_STAGE(PG8_SA(0, 0), a2, voffA);
            PG8_BAR; PG8_WAIT_L(0); PG8_MMA(1, 0, At, B0); PG8_BAR; PG8_SCHED;
            PG8_STAGE(PG8_SB(0, 1), b2 + hstep, voffB);
            PG8_WAIT_V(6); PG8_BAR; PG8_MMA(1, 1, At, B1); PG8_BAR;
            PG8_LDB(B0, 1, 0); PG8_SCHED; PG8_LDA(At, 1, 0); PG8_STAGE(PG8_SA(0, 1), a2 + hstep, voffA);
            PG8_WAIT_L(8); PG8_BAR; PG8_WAIT_L(0); PG8_MMA(0, 0, At, B0); PG8_BAR; PG8_SCHED;
            PG8_LDB(B1, 1, 1); PG8_STAGE(PG8_SB(1, 0), b3, voffB);
            PG8_BAR; PG8_WAIT_L(0); PG8_MMA(0, 1, At, B1); PG8_BAR;
            PG8_LDA(At, 1, 1); PG8_STAGE(PG8_SA(1, 0), a3, voffA);
            PG8_BAR; PG8_WAIT_L(0); PG8_MMA(1, 0, At, B0); PG8_BAR; PG8_SCHED;
            PG8_STAGE(PG8_SB(1, 1), b3 + hstep, voffB);
            PG8_WAIT_V(6); PG8_BAR; PG8_MMA(1, 1, At, B1); PG8_BAR;
            }
            if constexpr (Epi::KHOOK) { constexpr int HK = FP8 ? 4 : 8, HS = FP8 ? 2 : 3;
                if ((((t + 2) & (HK - 1)) == 0) && (t + 2 < nt)) { if constexpr (FP8) xdl_settle(); E.khook(acc, ((t + 2) >> HS) - 1, wr, fr); if constexpr (FP8) xdl_settle(); } }
        }
        if constexpr (ALIGN_EPI) { if (wr == 0) PG8_BAR; }
        if constexpr (FP8) {
            xdl_settle();
        }
        if constexpr (!Epi::AFTER_DRAIN) { E(acc, cur, wr, wc, fr, fq); S.done(cur); }
        if (!has_next) break;
#pragma unroll
        for (int a = 0; a < 2; ++a)
#pragma unroll
            for (int b = 0; b < 2; ++b)
#pragma unroll
                for (int m = 0; m < 4; ++m)
#pragma unroll
                    for (int n = 0; n < 2; ++n) acc[a][b][m][n] = (f32x4){0.f, 0.f, 0.f, 0.f};
        cur = nxt; cA = nA; cB = nB; ++ui;
        if constexpr (GATHER) {
#pragma unroll
            for (int h = 0; h < 2; ++h)
#pragma unroll
                for (int i = 0; i < 2; ++i) gA[h][i] = ngA[h][i]; }
        if constexpr (ALIGN_EPI) { if (wr == 1) PG8_BAR; }
    }
    PG8_WAIT_V(0);
    if constexpr (!ALIGN_EPI) { if (wr == 0) PG8_BAR; }
    PG8_BAR;
    if constexpr (Epi::AFTER_DRAIN) { E.fused(acc, cur, wr, wc, fr, fq, lds, wid, lane); S.done(cur); }
#undef PG8_SA
#undef PG8_SB
#undef PG8_STAGE
#undef PG8_STAGE_A
#undef PG8_LDA
#undef PG8_LDB
#undef PG8_MMA
#undef PG8_WAIT_V
#undef PG8_WAIT_L
#undef PG8_BAR
#undef PG8_SCHED
}
}

#define DI __device__ __forceinline__
#define GAS __attribute__((address_space(1)))
#define LAS __attribute__((address_space(3)))
typedef unsigned short bf16;
typedef unsigned v4u __attribute__((ext_vector_type(4)));
typedef unsigned v2u __attribute__((ext_vector_type(2)));
typedef float f32x4 __attribute__((ext_vector_type(4)));
typedef float f32x16 __attribute__((ext_vector_type(16)));
typedef short bf16x8 __attribute__((ext_vector_type(8)));
typedef __bf16 bf2v __attribute__((ext_vector_type(2)));
typedef float f2v __attribute__((ext_vector_type(2)));
typedef GAS unsigned gu32;

constexpr int NWAVES = 8, NTHREADS = 512;
constexpr int M = 16384, D = 1024, DIN = 2048, NH = 32, HD = 64, NGRP = 4, NST = 128, XBCW = 3072;
constexpr int NPROJ = 9216, WIN_LD = 9248;
constexpr int LCH = 128, NCH = M / LCH;
constexpr int NE = 64, DFF = 512;
constexpr float EPS = 1e-6f;
constexpr float LOG2E = 1.4426950408889634f;

constexpr size_t MiB = 1u << 20;
constexpr size_t WS_CTL = 0, CTL_ZERO_BYTES = 65536;
constexpr size_t WS_WIN = 1 * MiB, WS_WDT = 19 * MiB, WS_WCV = 20 * MiB, WS_WMIX = 22 * MiB, WS_WSSM = 24 * MiB;
constexpr size_t WS_RSTD = 31 * MiB + 524288;
constexpr size_t WS_DT = 28 * MiB, WS_CD = 30 * MiB, WS_WRH = 30 * MiB + 65536, WS_WRL = WS_WRH + 262144, WS_ROUTE = 31 * MiB;
constexpr size_t WS_ST = 32 * MiB, WS_YS = 96 * MiB, WS_TMP = 160 * MiB, WS_MG = 192 * MiB;
constexpr size_t WS_W13 = 32 * MiB, WS_W2 = 160 * MiB, WS_H16 = 96 * MiB;
constexpr size_t WS_XN8 = 32 * MiB, WS_W8IN = 48 * MiB;
constexpr size_t WS_XN = 224 * MiB;
constexpr size_t WS_U = 256 * MiB, WS_ZS = 288 * MiB, WS_XBC = 352 * MiB, WS_GATE = 448 * MiB;
constexpr size_t WS_LIST = 256 * MiB, WS_HDN = 352 * MiB, WS_YEXP = 400 * MiB;
constexpr size_t WS_END = 512 * MiB;
constexpr int CW_BAR = 4096;
constexpr int CW_CNT = 8192;
constexpr int CW_MODC = 40960;
constexpr int CW_MOD = 16384;

constexpr int RING_BYTES = 131072;
constexpr int LDSCTL_OFF = 147456;
constexpr int TB_OFF = LDSCTL_OFF + 256;
constexpr int CNTL_OFF = TB_OFF + 320;
constexpr int TOKL_OFF = LDSCTL_OFF + 1024;
constexpr int RT_OFF = 148480;
constexpr int LDS_BYTES = 152576;

#define LDS_WAIT() asm volatile("s_waitcnt lgkmcnt(0)" ::: "memory")
#define VM_WAIT() asm volatile("s_waitcnt vmcnt(0)" ::: "memory")

DI unsigned pk2(float lo, float hi) { f2v v = {lo, hi}; return __builtin_bit_cast(unsigned, __builtin_convertvector(v, bf2v)); }
DI unsigned pk4_fp8(float a, float b, float c, float d) {
    a = __builtin_fminf(__builtin_fmaxf(a, -448.f), 448.f); b = __builtin_fminf(__builtin_fmaxf(b, -448.f), 448.f);
    c = __builtin_fminf(__builtin_fmaxf(c, -448.f), 448.f); d = __builtin_fminf(__builtin_fmaxf(d, -448.f), 448.f);
    unsigned w = 0u; w = __builtin_amdgcn_cvt_pk_fp8_f32(a, b, w, false); w = __builtin_amdgcn_cvt_pk_fp8_f32(c, d, w, true); return w; }
DI unsigned pk4_fp8_nc(float a, float b, float c, float d) { unsigned w = 0u; w = __builtin_amdgcn_cvt_pk_fp8_f32(a, b, w, false); w = __builtin_amdgcn_cvt_pk_fp8_f32(c, d, w, true); return w; }
DI float bflo(unsigned u) { return __uint_as_float(u << 16); }
DI float bfhi(unsigned u) { return __uint_as_float(u & 0xffff0000u); }
DI float sigmoidf_(float x) { return __builtin_amdgcn_rcpf(1.f + __builtin_amdgcn_exp2f(x * -LOG2E)); }
DI float siluf_(float x) { return x * __builtin_amdgcn_rcpf(1.f + __builtin_amdgcn_exp2f(x * -LOG2E)); }
DI float wave_sum(float v) {
#pragma unroll
    for (int o = 1; o < 64; o <<= 1) v += __shfl_xor(v, o);
    return v;
}
DI f32x4 mod4(const float* modp, int k) { return (*(const f32x4*)(modp + k) + *(const f32x4*)(modp + 6144 + k)) + (*(const f32x4*)(modp + 2 * 6144 + k) + *(const f32x4*)(modp + 3 * 6144 + k)); }
DI int crow(int reg, int hh) { return (reg & 3) + 8 * (reg >> 2) + 4 * hh; }
DI int swz(int row, int chunk) { return chunk ^ ((row ^ (row >> 3)) & 15); }
#define MFMA32(a, b, c) __builtin_amdgcn_mfma_f32_32x32x16_bf16((a), (b), (c), 0, 0, 0)

DI int lane_id() { return (int)__builtin_amdgcn_mbcnt_hi(~0u, __builtin_amdgcn_mbcnt_lo(~0u, 0u)); }
#define XB_TMO      128
#define XB_XCNT(j)  (256  + 64 * (j))
#define XB_XSUB(j)  (1280 + 64 * (j))
#define XB_XGEN(j)  (2304 + 64 * (j))
#define XB_TOP      3328
#define XB_TOPGEN   3392
#define XCD_BAR_WORDS 3456
#define XB_SPIN_CAP (1u << 18)
DI unsigned xb_ld(unsigned* p)              { return __hip_atomic_load(p, __ATOMIC_RELAXED, __HIP_MEMORY_SCOPE_AGENT); }
DI unsigned xb_add(unsigned* p, unsigned v) { return __hip_atomic_fetch_add(p, v, __ATOMIC_RELAXED, __HIP_MEMORY_SCOPE_AGENT); }
DI unsigned xb_xcc_id() { return (unsigned)__builtin_amdgcn_s_getreg((3 << 11) | 20) & 0xFu; }
#define XB_SPIN(cond, bar) do { unsigned _sp = 0; while (cond) { __builtin_amdgcn_s_sleep(1); \
    if ((++_sp & 255u) == 0u) { if (xb_ld(&(bar)[XB_TMO])) break; if (_sp > XB_SPIN_CAP) { atomicAdd(&(bar)[XB_TMO], 1u); break; } } } } while (0)
struct XcdBarrier { unsigned* bar; unsigned x; volatile LAS unsigned* st; int wave; };
DI XcdBarrier xcd_barrier_post(unsigned* bar, volatile LAS unsigned* st) {
    XcdBarrier b; b.bar = bar; b.x = xb_xcc_id(); b.st = st; b.wave = 0;
    if (threadIdx.x == 0) (void)xb_add(&bar[XB_XCNT(b.x)], 1u);
    return b;
}
DI void xcd_barrier_complete(unsigned* bar, unsigned x, unsigned& nloc, unsigned& nx) {
    const unsigned G = gridDim.x * gridDim.y * gridDim.z;
    unsigned sum, cnt, mine, sp = 0u;
    for (;;) {
        sum = 0u; cnt = 0u; mine = 0u;
#pragma unroll
        for (unsigned j = 0; j < 16; ++j) { const unsigned c = xb_ld(&bar[XB_XCNT(j)]); sum += c; cnt += (c > 0u) ? 1u : 0u; mine = (j == x) ? c : mine; }
        if (sum == G) break;
        __builtin_amdgcn_s_sleep(1);
        if ((++sp & 255u) == 0u) { if (xb_ld(&bar[XB_TMO])) break; if (sp > XB_SPIN_CAP) { atomicAdd(&bar[XB_TMO], 1u); break; } }
    }
    nloc = mine > 0u ? mine : 1u; nx = cnt > 0u ? cnt : 1u;
}
DI void xcd_barrier(const XcdBarrier& b) {
    asm volatile("s_waitcnt vmcnt(0)" ::: "memory");
    __syncthreads();
    if (b.wave == 0 && lane_id() == 0) {
        unsigned* bar = b.bar;
        __builtin_amdgcn_s_waitcnt(0);
        unsigned nloc = b.st[0], nx = b.st[1];
        if (nloc == 0u) { xcd_barrier_complete(bar, b.x, nloc, nx); b.st[0] = nloc; b.st[1] = nx; }
        const unsigned old = xb_add(&bar[XB_XSUB(b.x)], 1u);
        const unsigned gen = old / nloc;
        if (old + 1u == (gen + 1u) * nloc) {
            __builtin_amdgcn_fence(__ATOMIC_RELEASE, "agent");
            asm volatile("s_waitcnt vmcnt(0)" ::: "memory");
            const unsigned og = xb_add(&bar[XB_TOP], 1u);
            const unsigned tg = og / nx;
            if (og + 1u == (tg + 1u) * nx) xb_add(&bar[XB_TOPGEN], 1u);
            else XB_SPIN(xb_ld(&bar[XB_TOPGEN]) == tg, bar);
            __builtin_amdgcn_fence(__ATOMIC_ACQUIRE, "agent");
            xb_add(&bar[XB_XGEN(b.x)], 1u);
            asm volatile("s_waitcnt vmcnt(0)" ::: "memory");
        } else {
            XB_SPIN(xb_ld(&bar[XB_XGEN(b.x)]) == gen, bar);
            __builtin_amdgcn_fence(__ATOMIC_ACQUIRE, "agent");
            asm volatile("s_waitcnt vmcnt(0)" ::: "memory");
        }
    }
    __syncthreads();
}

enum { I_X = 0, I_C, I_WADA, I_BADA, I_N1G, I_WIN, I_CVW, I_CVB, I_LNG, I_LNB, I_WCV, I_SCW, I_SCB, I_DTB, I_ALOG, I_DSKIP, I_SNG, I_WSSM, I_WMIX,
       I_N2G, I_WGRP, I_BGRP, I_WER, I_BER, I_W1, I_W3, I_W2, I_FG, N_IN };
struct Args { const float* in[N_IN]; float* out; unsigned char* ws; int ph_lo, ph_hi; };

template <int I> DI const float* argp() {
    auto kp = __builtin_amdgcn_kernarg_segment_ptr();
    unsigned long long v;
    asm volatile("s_load_dwordx2 %0, %1, %2\n\ts_waitcnt lgkmcnt(0)" : "=s"(v) : "s"(kp), "i"(I * 8));
    return (const float*)(const GAS float*)v;
}
#define ARG(i) argp<i>()
struct Ctx {
    LAS unsigned char* lds;
    int wave, vcu, G, xcd, xj;
    unsigned char* ws;
};

DI int xcd_unit(int x, int j, int gx, int i, int N) { const int u = i * gx + j; return (u < (N >> 3)) ? x * (N >> 3) + u : -1; }
DI int inproj_tile(int p) { return p < 8 ? p + 28 : p - 8; }
constexpr int NP8 = 16;
struct EpiInProj {
    static constexpr bool PERM = true, AFTER_DRAIN = false, KHOOK = false;
    unsigned char* ws; int p0;
    DI void operator()(const pg8::f32x4 (&acc)[2][2][4][2], const pg8::Unit& u, int wr, int wc, int fr, int fq) const {
        const int pn = inproj_tile(u.pn + p0), row0 = u.pm * 256 + wr * 64 + fr;
        if (pn < 8) {
            bf16* U = (bf16*)(ws + WS_U);
#pragma unroll
            for (int ai = 0; ai < 2; ++ai)
#pragma unroll
                for (int m = 0; m < 4; ++m) {
                    bf16* rowp = U + (size_t)(row0 + ai * 128 + m * 16) * D + pn * 128 + wc * 16 + fq * 4;
#pragma unroll
                    for (int bj = 0; bj < 2; ++bj) { const pg8::f32x4 a = acc[ai][bj][m][0], b = acc[ai][bj][m][1];
                        v2u w; w.x = pk2(a[0] * sigmoidf_(b[0]), a[1] * sigmoidf_(b[1])); w.y = pk2(a[2] * sigmoidf_(b[2]), a[3] * sigmoidf_(b[3]));
                        *(v2u*)(rowp + bj * 64) = w; } }
        } else {
            const bool isz = pn < 16, isx = (pn >= 16) && (pn < 28);
            const size_t boff = isz ? WS_ZS : (isx ? WS_XBC : WS_GATE);
            const int ldc = isx ? XBCW : DIN;
            const int colt = (pn - (isz ? 8 : (isx ? 16 : 28))) * 256;
            bf16* base = (bf16*)(ws + boff);
            const int col0 = colt + wc * 32 + fq * 8;
#pragma unroll
            for (int ai = 0; ai < 2; ++ai)
#pragma unroll
                for (int m = 0; m < 4; ++m) {
                    bf16* rowp = base + (size_t)(row0 + ai * 128 + m * 16) * ldc + col0;
#pragma unroll
                    for (int bj = 0; bj < 2; ++bj) { pg8::f32x4 v0 = acc[ai][bj][m][0], v1 = acc[ai][bj][m][1];
                        if (!isx) {
#pragma unroll
                            for (int i = 0; i < 4; ++i) { const float s0 = sigmoidf_(v0[i]), s1 = sigmoidf_(v1[i]); v0[i] = isz ? v0[i] * s0 : s0; v1[i] = isz ? v1[i] * s1 : s1; }
                        }
                        v4u w; w.x = pk2(v0[0], v0[1]); w.y = pk2(v0[2], v0[3]); w.z = pk2(v1[0], v1[1]); w.w = pk2(v1[2], v1[3]);
                        *(v4u*)(rowp + bj * 128) = w; } }
        }
    }
};
template <bool NORM> struct EpiGate {
    static constexpr bool PERM = true, AFTER_DRAIN = false, KHOOK = NORM;
    bf16* O; const bf16* P; const bf16* GATE; int gcol; const LAS float* rt;
    DI void khook(pg8::f32x4 (&acc)[2][2][4][2], int b, int wr, int fr) const {
#pragma unroll
        for (int ai = 0; ai < 2; ++ai)
#pragma unroll
            for (int m = 0; m < 4; ++m) { const float f = rt[(ai * 128 + wr * 64 + m * 16 + fr) * 4 + b];
#pragma unroll
                for (int bj = 0; bj < 2; ++bj)
#pragma unroll
                    for (int n = 0; n < 2; ++n) acc[ai][bj][m][n] = acc[ai][bj][m][n] * f; }
    }
    DI void operator()(const pg8::f32x4 (&acc)[2][2][4][2], const pg8::Unit& u, int wr, int wc, int fr, int fq) const {
        const int row0 = u.pm * 256 + wr * 64 + fr, col0 = u.pn * 256 + wc * 32 + fq * 8;
        v4u g[4], p[4], wA[4], wB[4];
        auto loadq = [&](int bj, int ai) {
#pragma unroll
            for (int m = 0; m < 4; ++m) { const size_t r = (size_t)(row0 + ai * 128 + m * 16); const int c = col0 + bj * 128;
                g[m] = *(const v4u*)(GATE + r * (2 * D) + gcol + c); if (NORM) p[m] = *(const v4u*)(P + r * D + c); }
        };
        auto calcq = [&](int bj, int ai, v4u (&w)[4]) {
#pragma unroll
            for (int m = 0; m < 4; ++m) {
                float f = 1.0f; if (NORM) f = rt[(ai * 128 + wr * 64 + m * 16 + fr) * 4 + 3];
                const v4u gg = g[m];
                pg8::f32x4 v0 = acc[ai][bj][m][0] * f, v1 = acc[ai][bj][m][1] * f;
                float o[8] = {v0[0] * bflo(gg.x), v0[1] * bfhi(gg.x), v0[2] * bflo(gg.y), v0[3] * bfhi(gg.y), v1[0] * bflo(gg.z), v1[1] * bfhi(gg.z), v1[2] * bflo(gg.w), v1[3] * bfhi(gg.w)};
                if (NORM) { const v4u pp = p[m];
                    o[0] += bflo(pp.x); o[1] += bfhi(pp.x); o[2] += bflo(pp.y); o[3] += bfhi(pp.y); o[4] += bflo(pp.z); o[5] += bfhi(pp.z); o[6] += bflo(pp.w); o[7] += bfhi(pp.w); }
                w[m].x = pk2(o[0], o[1]); w[m].y = pk2(o[2], o[3]); w[m].z = pk2(o[4], o[5]); w[m].w = pk2(o[6], o[7]); }
        };
        auto storeq = [&](int bj, int ai, const v4u (&w)[4]) {
#pragma unroll
            for (int m = 0; m < 4; ++m) *(v4u*)(O + (size_t)(row0 + ai * 128 + m * 16) * D + col0 + bj * 128) = w[m];
        };
        loadq(0, 0); calcq(0, 0, wA); loadq(0, 1); storeq(0, 0, wA); calcq(0, 1, wB); loadq(1, 0); storeq(0, 1, wB); calcq(1, 0, wA); loadq(1, 1); storeq(1, 0, wA); calcq(1, 1, wB); storeq(1, 1, wB);
    }
};
struct EpiMix {
    static constexpr bool PERM = true, AFTER_DRAIN = false, KHOOK = false;
    bf16* H; const float* X; const float* g1;
    DI void operator()(const pg8::f32x4 (&acc)[2][2][4][2], const pg8::Unit& u, int wr, int wc, int fr, int fq) const {
        const int row0 = u.pm * 256 + wr * 64 + fr, col0 = u.pn * 256 + wc * 32 + fq * 8;
        f32x4 xa[4], xb[4]; v4u wA[4], wB[4];
        auto loadq = [&](int bj, int ai) {
#pragma unroll
            for (int m = 0; m < 4; ++m) { const size_t off = (size_t)(row0 + ai * 128 + m * 16) * D + col0 + bj * 128;
                xa[m] = __builtin_nontemporal_load((const f32x4*)(X + off)); xb[m] = __builtin_nontemporal_load((const f32x4*)(X + off + 4)); }
        };
        auto calcq = [&](int bj, int ai, v4u (&w)[4]) { const int c = col0 + bj * 128;
            const f32x4 ga = *(const f32x4*)(g1 + c), gb = *(const f32x4*)(g1 + c + 4);
#pragma unroll
            for (int m = 0; m < 4; ++m) { const f32x4 ha = xa[m] + ga * acc[ai][bj][m][0], hb = xb[m] + gb * acc[ai][bj][m][1];
                w[m].x = pk2(ha.x, ha.y); w[m].y = pk2(ha.z, ha.w); w[m].z = pk2(hb.x, hb.y); w[m].w = pk2(hb.z, hb.w); }
        };
        auto storeq = [&](int bj, int ai, const v4u (&w)[4]) {
#pragma unroll
            for (int m = 0; m < 4; ++m) *(v4u*)(H + (size_t)(row0 + ai * 128 + m * 16) * D + col0 + bj * 128) = w[m];
        };
        loadq(0, 0); calcq(0, 0, wA); loadq(0, 1); storeq(0, 0, wA); calcq(0, 1, wB); loadq(1, 0); storeq(0, 1, wB); calcq(1, 0, wA); loadq(1, 1); storeq(1, 0, wA); calcq(1, 1, wB); storeq(1, 1, wB);
    }
};
struct EpiUp {
    static constexpr bool PERM = true, AFTER_DRAIN = false, KHOOK = false;
    unsigned char* HDN;
    DI void operator()(const pg8::f32x4 (&acc)[2][2][4][2], const pg8::Unit& u, int wr, int wc, int fr, int fq) const {
        const int j = u.pn & 3, row0 = u.pm * 256 + wr * 64 + fr, col0 = j * 128 + wc * 16 + fq * 4;
#pragma unroll
        for (int ai = 0; ai < 2; ++ai)
#pragma unroll
            for (int m = 0; m < 4; ++m) { unsigned char* rowp = HDN + (size_t)(row0 + ai * 128 + m * 16) * DFF + col0;
#pragma unroll
                for (int bj = 0; bj < 2; ++bj) { const pg8::f32x4 a = acc[ai][bj][m][0], b = acc[ai][bj][m][1];
                    *(unsigned*)(rowp + bj * 64) = pk4_fp8(siluf_(a[0]) * b[0], siluf_(a[1]) * b[1], siluf_(a[2]) * b[2], siluf_(a[3]) * b[3]); } }
    }
};
struct EpiDown {
    static constexpr bool PERM = true, AFTER_DRAIN = false, KHOOK = false;
    unsigned char* Y;
    DI void operator()(const pg8::f32x4 (&acc)[2][2][4][2], const pg8::Unit& u, int wr, int wc, int fr, int fq) const {
        const int j = u.pn & 3, row0 = u.pm * 256 + wr * 64 + fr, col0 = j * 256 + wc * 32 + fq * 8;
#pragma unroll
        for (int ai = 0; ai < 2; ++ai)
#pragma unroll
            for (int m = 0; m < 4; ++m) { unsigned char* rowp = Y + (size_t)(row0 + ai * 128 + m * 16) * D + col0;
#pragma unroll
                for (int bj = 0; bj < 2; ++bj) { const pg8::f32x4 v0 = acc[ai][bj][m][0] * 16.0f, v1 = acc[ai][bj][m][1] * 16.0f;
                    v2u w; w.x = pk4_fp8(v0[0], v0[1], v0[2], v0[3]); w.y = pk4_fp8(v1[0], v1[1], v1[2], v1[3]);
                    *(v2u*)(rowp + bj * 128) = w; } }
    }
};
struct MoeOrder {
    const LAS int* tb; int G, c, total, reps; const LAS int* tokl;
    DI bool next(int i0, pg8::Unit& u) const {
        const int n = (total - c + G - 1) / G; if (n <= 0 || i0 >= n * reps) return false;
        const int i = i0 % n; const int uu = i * G + c;
        const int T = uu >> 2; int e = 0;
        while (e < NE - 1 && tb[e + 1] <= T) ++e;
        u.pm = T; u.pn = 4 * e + (uu & 3); return true;
    }
    DI void a_ready(const pg8::Unit&) const {}
    DI void done(const pg8::Unit&) const {}
};

struct OneUnit { pg8::Unit u;
    DI bool next(int i, pg8::Unit& o) const { if (i != 0) return false; o = u; return true; }
    DI void a_ready(const pg8::Unit&) const {}
    DI void done(const pg8::Unit&) const {} };

template <class SrcF>
DI void transpose_item(SrcF src, int K, bf16* WT, LAS float* scr, int kb, int n0, int lane) {
    const int k0 = 64 * kb;
#pragma unroll 8
    for (int i = 0; i < 32; ++i) { const int kk = 2 * i + (lane >> 5); scr[kk * 33 + (lane & 31)] = src(k0 + kk, n0 + (lane & 31)); }
    LDS_WAIT(); asm volatile("" ::: "memory");
    const int c = lane & 7;
#pragma unroll
    for (int j = 0; j < 4; ++j) { const int n = (lane >> 3) + 8 * j; const LAS float* s = scr + (8 * c) * 33 + n;
        v4u o; o.x = pk2(s[0 * 33], s[1 * 33]); o.y = pk2(s[2 * 33], s[3 * 33]); o.z = pk2(s[4 * 33], s[5 * 33]); o.w = pk2(s[6 * 33], s[7 * 33]);
        *(v4u*)(WT + (size_t)(n0 + n) * K + k0 + 8 * c) = o; }
    LDS_WAIT(); asm volatile("" ::: "memory");
}

template <class SrcF>
DI void transpose_item8(SrcF src, int K, unsigned char* WT, LAS float* scr, int kb, int n0, int lane) {
    const int k0 = 64 * kb;
#pragma unroll 8
    for (int i = 0; i < 32; ++i) { const int kk = 2 * i + (lane >> 5); scr[kk * 33 + (lane & 31)] = src(k0 + kk, n0 + (lane & 31)) * 64.0f; }
    LDS_WAIT(); asm volatile("" ::: "memory");
#pragma unroll
    for (int i = 0; i < 2; ++i) { const int p = lane + 64 * i, n = p >> 2, c = p & 3; const LAS float* s = scr + (16 * c) * 33 + n;
        v4u o; o.x = pk4_fp8(s[0 * 33], s[1 * 33], s[2 * 33], s[3 * 33]); o.y = pk4_fp8(s[4 * 33], s[5 * 33], s[6 * 33], s[7 * 33]);
        o.z = pk4_fp8(s[8 * 33], s[9 * 33], s[10 * 33], s[11 * 33]); o.w = pk4_fp8(s[12 * 33], s[13 * 33], s[14 * 33], s[15 * 33]);
        *(v4u*)(WT + (size_t)(n0 + n) * K + k0 + 16 * c) = o; }
    LDS_WAIT(); asm volatile("" ::: "memory");
}

DI void ph0_prologue(const Ctx& F, const Args& a, int reps) {
    const int gw = F.vcu * NWAVES + F.wave, NGW = F.G * NWAVES, lane = lane_id();
    float* mod = (float*)(F.ws + WS_CTL) + CW_MOD;
    {
        const float* cvec = ARG(I_C); const float* wada = ARG(I_WADA); const float* bada = ARG(I_BADA);
        const int r8 = lane >> 3, c4 = lane & 7;
        for (int item0 = gw; item0 < 768 * reps; item0 += NGW) {
            const int item = item0 % 768; const int cc = item % 192, kq = item / 192;
            f32x4 acc = {0.f, 0.f, 0.f, 0.f};
#pragma unroll 8
            for (int i = 0; i < 32; ++i) { const int k = kq * 256 + i * 8 + r8; const float cv = cvec[k]; const float s = siluf_(cv);
                const f32x4 w = *(const f32x4*)(wada + (size_t)k * (6 * D) + cc * 32 + c4 * 4); acc += s * w; }
#pragma unroll
            for (int j = 0; j < 4; ++j) { float v = acc[j]; v += __shfl_xor(v, 8); v += __shfl_xor(v, 16); v += __shfl_xor(v, 32); acc[j] = v; }
            if (lane < 8) {
#pragma unroll
                for (int j = 0; j < 4; ++j) { float v = acc[j]; if (kq == 0) v += bada[cc * 32 + c4 * 4 + j]; mod[kq * 6144 + cc * 32 + c4 * 4 + j] = v; }
            }
        }
    }
    LAS float* scr = (LAS float*)(F.lds + F.wave * 16384);
    const float* win = ARG(I_WIN); const float* wcv = ARG(I_WCV); const float* wmix = ARG(I_WMIX); const float* wssm = ARG(I_WSSM);
    bf16* Win_t = (bf16*)(F.ws + WS_WIN); bf16* Wdt_t = (bf16*)(F.ws + WS_WDT); bf16* Wcv_t = (bf16*)(F.ws + WS_WCV);
    bf16* Wmix_t = (bf16*)(F.ws + WS_WMIX); bf16* Wssm_t = (bf16*)(F.ws + WS_WSSM);
    constexpr int I_IN = 16 * 288, I_DT = 16, I_CV = 16 * 32, I_MX = 16 * 32, I_SS = 32 * 32, I_RT = 16 * 3 * 2;
    constexpr int NITEMS = I_IN + I_DT + I_CV + I_MX + I_SS + I_RT;
    const float* wer = ARG(I_WER); const float* wgrp = ARG(I_WGRP); const float* sng0 = ARG(I_SNG);
    for (int it0 = gw; it0 < NITEMS * reps; it0 += NGW) {
        int r = it0 % NITEMS;
        if (r < I_IN) { const int kb = r / 288, nb = r % 288;
            auto wsrc = [&](int k, int npp) -> float {
                const int np = inproj_tile(npp >> 8) * 256 + (npp & 255);
                int col; if (np < 2048) { const int q = np >> 3, rr = np & 7; col = (rr >> 2) * 1024 + 4 * q + (rr & 3); } else if (np < 7168) col = np; else col = np + 32;
                return win[(size_t)k * WIN_LD + col]; };
            if (nb < NP8 * 8) transpose_item8(wsrc, D, F.ws + WS_W8IN, scr, kb, nb * 32, lane); else transpose_item(wsrc, D, Win_t, scr, kb, nb * 32, lane);
            continue; } r -= I_IN;
        if (r < I_DT) { transpose_item([&](int k, int np) -> float { return win[(size_t)k * WIN_LD + 7168 + np]; }, D, Wdt_t, scr, r, 0, lane); continue; } r -= I_DT;
        if (r < I_CV) { transpose_item([&](int k, int np) -> float { return wcv[(size_t)k * D + np]; }, D, Wcv_t, scr, r / 32, (r % 32) * 32, lane); continue; } r -= I_CV;
        if (r < I_MX) { transpose_item([&](int k, int np) -> float { return wmix[(size_t)k * D + np]; }, D, Wmix_t, scr, r / 32, (r % 32) * 32, lane); continue; } r -= I_MX;
        if (r < I_SS) { transpose_item8([&](int k, int np) -> float { return wssm[(size_t)k * D + np] * sng0[k]; }, DIN, (unsigned char*)Wssm_t, scr, r / 32, (r % 32) * 32, lane); continue; } r -= I_SS;
        {
            const int lo = r / 48, rr = r % 48, kb = rr / 3, nb = rr % 3;
            auto wsrc = [&](int k, int np) -> float { float w = 0.f; if (np < 64) w = wer[(size_t)k * NE + np]; else if (np < 72) w = wgrp[(size_t)k * 8 + (np - 64)];
                const float hi = bflo(pk2(w, 0.f)); return lo ? (w - hi) : hi; };
            transpose_item(wsrc, D, (bf16*)(F.ws + (lo ? WS_WRL : WS_WRH)), scr, kb, nb * 32, lane);
        }
    }
}

DI void convert_experts(const Ctx& F, const Args& a) {
    const int gw = F.vcu * NWAVES + F.wave, NGW = F.G * NWAVES, lane = lane_id();
    LAS float* scr = (LAS float*)(F.lds + F.wave * 17408);
    const float* w1 = ARG(I_W1); const float* w3 = ARG(I_W3); const float* w2 = ARG(I_W2);
    unsigned char* W13_t = F.ws + WS_W13; unsigned char* W2_t = F.ws + WS_W2;
    constexpr int I_13 = NE * 4 * 16, I_2 = NE * 2 * 16, NIT = I_13 + I_2;
    const int ch = lane & 15, kq = lane >> 4;
    for (int it = gw; it < NIT; it += NGW) {
        const float* src; size_t ld; unsigned char* dst;
        if (it < I_13) { const int e = it >> 6, r = it & 63, kb = r >> 4, cb = r & 15;
            src = ((ch & 1) ? w3 : w1) + (size_t)e * D * DFF + (size_t)(256 * kb + kq) * DFF + 32 * cb + 4 * (ch >> 1); ld = DFF;
            dst = W13_t + (size_t)e * D * D + (size_t)(64 * cb + lane) * D + 256 * kb;
        } else { const int r0 = it - I_13, e = r0 >> 5, r = r0 & 31, kb = r >> 4, nb = r & 15;
            src = w2 + (size_t)e * DFF * D + (size_t)(256 * kb + kq) * D + 64 * nb + 4 * ch; ld = D;
            dst = W2_t + (size_t)e * D * DFF + (size_t)(64 * nb + lane) * DFF + 256 * kb;
        }
        f32x4 va[16], vb[16]; v4u o[16];
#pragma unroll
        for (int i = 0; i < 16; ++i) va[i] = __builtin_nontemporal_load((const f32x4*)(src + (size_t)(4 * i) * ld));
#pragma unroll
        for (int sub = 0; sub < 4; ++sub) {
            f32x4 (&cur)[16] = (sub & 1) ? vb : va; f32x4 (&nxt)[16] = (sub & 1) ? va : vb;
            if (sub < 3) {
#pragma unroll
                for (int i = 0; i < 16; ++i) nxt[i] = __builtin_nontemporal_load((const f32x4*)(src + (size_t)(64 * (sub + 1) + 4 * i) * ld));
            }
#pragma unroll
            for (int i = 0; i < 16; ++i) *(LAS f32x4*)(scr + (4 * i + kq) * 68 + 4 * ch) = cur[i] * 64.0f;
            LDS_WAIT(); asm volatile("" ::: "memory");
#pragma unroll
            for (int j = 0; j < 4; ++j) {
                unsigned w[4];
#pragma unroll
                for (int q = 0; q < 4; ++q) { const LAS float* sp = scr + (16 * j + 4 * q) * 68 + lane; w[q] = pk4_fp8(sp[0], sp[68], sp[136], sp[204]); }
                o[4 * sub + j].x = w[0]; o[4 * sub + j].y = w[1]; o[4 * sub + j].z = w[2]; o[4 * sub + j].w = w[3];
            }
            LDS_WAIT(); asm volatile("" ::: "memory");
        }
#pragma unroll
        for (int j = 0; j < 16; ++j) *(v4u*)(dst + 16 * j) = o[j];
    }
}

DI void ph1_norm_dt(const Ctx& F, const Args& a) {
    const float* mod = (const float*)(F.ws + WS_CTL) + CW_MOD;
    const float* x = ARG(I_X); const float* n1g = ARG(I_N1G); const float* dtb = ARG(I_DTB);
    bf16* XN = (bf16*)(F.ws + WS_XN); const bf16* Wdt_t = (const bf16*)(F.ws + WS_WDT); float* DT = (float*)(F.ws + WS_DT);
    const int lane = lane_id(), wave = F.wave;
    f32x4 gm[4], ga[4];
#pragma unroll
    for (int j = 0; j < 4; ++j) { const int k = 256 * j + 4 * lane; const f32x4 g = *(const f32x4*)(n1g + k), sc = mod4(mod, 1024 + k);
        gm[j] = g * (sc + 1.0f); ga[j] = mod4(mod, k); }
    if (F.vcu == 0) { float* modc = (float*)(F.ws + WS_CTL) + CW_MODC; for (int k = (F.wave * 64 + lane_id()) * 4; k < 6 * D; k += NTHREADS * 4) *(f32x4*)(modc + k) = mod4(mod, k); }
    for (int unit = F.vcu; unit < M / 64; unit += F.G) {
        const int row0 = unit * 64;
#pragma unroll 1
        for (int rh = 0; rh < 2; ++rh) {
            f32x4 v[4][4];
#pragma unroll
            for (int rr = 0; rr < 4; ++rr)
#pragma unroll
                for (int j = 0; j < 4; ++j) v[rr][j] = __builtin_nontemporal_load((const f32x4*)(x + (size_t)(row0 + wave * 8 + rh * 4 + rr) * D + 256 * j + 4 * lane));
#pragma unroll
            for (int rr = 0; rr < 4; ++rr) {
                const int rl = wave * 8 + rh * 4 + rr, row = row0 + rl; float ss = 0.f;
#pragma unroll
                for (int j = 0; j < 4; ++j) ss += (v[rr][j].x * v[rr][j].x + v[rr][j].y * v[rr][j].y) + (v[rr][j].z * v[rr][j].z + v[rr][j].w * v[rr][j].w);
                const float rstd = 1.0f / sqrtf(wave_sum(ss) * (1.0f / D) + EPS);
#pragma unroll
                for (int j = 0; j < 4; ++j) { const f32x4 n = v[rr][j] * rstd * gm[j] + ga[j];
                    v2u w; w.x = pk2(n.x, n.y); w.y = pk2(n.z, n.w);
                    *(v2u*)(XN + (size_t)row * D + 256 * j + 4 * lane) = w;
                    *(unsigned*)(F.ws + WS_XN8 + (size_t)row * D + 256 * j + 4 * lane) = pk4_fp8(n.x, n.y, n.z, n.w);
                    const int chunk = (32 * j + (lane >> 1)) ^ (rl & 15);
                    *(LAS v2u*)(F.lds + rl * 2048 + chunk * 16 + 8 * (lane & 1)) = w; }
            }
        }
        __syncthreads();
        {
            const int rt = wave & 3, ct = wave >> 2, fr = lane & 15, fq = lane >> 4;
            pg8::f32x4 acc = {0.f, 0.f, 0.f, 0.f};
            const bf16* wrow = Wdt_t + (size_t)(16 * ct + fr) * D + 8 * fq;
#pragma unroll 4
            for (int ks = 0; ks < 32; ++ks) {
                const bf16x8 av = *(const LAS bf16x8*)(F.lds + (16 * rt + fr) * 2048 + (((4 * ks + fq) ^ fr) * 16));
                const bf16x8 bv = *(const bf16x8*)(wrow + 32 * ks);
                acc = __builtin_amdgcn_mfma_f32_16x16x32_bf16(av, bv, acc, 0, 0, 0);
            }
            const float bias = dtb[16 * ct + fr];
#pragma unroll
            for (int r = 0; r < 4; ++r) { const float v = acc[r] + bias; const float sp = v > 20.f ? v : log1pf(__expf(v));
                DT[(size_t)(row0 + 16 * rt + 4 * fq + r) * NH + 16 * ct + fr] = sp; }
        }
        __syncthreads();
    }
}

DI void ph3_convbranch(const Ctx& F, const Args& a, int reps) {
    const bf16* U = (const bf16*)(F.ws + WS_U); bf16* UC = (bf16*)(F.ws + WS_XN);
    const float* cw = ARG(I_CVW); const float* cb = ARG(I_CVB); const float* lg = ARG(I_LNG); const float* lb = ARG(I_LNB);
    const int tid = F.wave * 64 + lane_id(), lane = lane_id(), wave = F.wave;
    LAS unsigned char* tile = F.lds;
    LAS float* red = (LAS float*)(F.lds + 62 * 2048);
    LAS float* stat = red + 32 * 8 * 2;
    f2v w[31];
#pragma unroll
    for (int j = 0; j < 31; ++j) w[j] = *(const f2v*)(cw + j * D + 2 * tid);
    const f2v bias = *(const f2v*)(cb + 2 * tid), gam = *(const f2v*)(lg + 2 * tid), bet = *(const f2v*)(lb + 2 * tid);
    const int RU = (M / 32 + F.G - 1) / F.G;
    for (int it = 0; it < RU * reps; ++it) {
        const int unit = xcd_unit(F.xcd, F.xj, F.G >> 3, (it >= RU ? it - RU : it), M / 32); if (unit < 0) break; const int t0 = unit * 32;
        for (int piece = tid; piece < 62 * 128; piece += NTHREADS) { const int r = piece >> 7, cch = piece & 127, t = t0 - 30 + r;
            v4u v = {0u, 0u, 0u, 0u}; if (t >= 0) v = *(const v4u*)(U + (size_t)t * D + cch * 8);
            *(LAS v4u*)(tile + r * 2048 + cch * 16) = v; }
        __syncthreads();
        f2v o[32];
#pragma unroll
        for (int tg = 0; tg < 8; ++tg) {
            f2v acc[4];
#pragma unroll
            for (int i = 0; i < 4; ++i) acc[i] = bias;
#pragma unroll
            for (int j = 0; j < 34; ++j) {
                const unsigned uu = *(const LAS unsigned*)(tile + (4 * tg + j) * 2048 + tid * 4);
                const f2v u2 = {bflo(uu), bfhi(uu)};
#pragma unroll
                for (int i = 0; i < 4; ++i) { const int jj = j - i; if (jj >= 0 && jj <= 30) acc[i] = __builtin_elementwise_fma(w[jj], u2, acc[i]); }
            }
#pragma unroll
            for (int i = 0; i < 4; ++i) o[4 * tg + i] = acc[i];
        }
        {
            float r5[64];
#pragma unroll
            for (int tk = 0; tk < 32; ++tk) { r5[2 * tk] = o[tk].x + o[tk].y; r5[2 * tk + 1] = o[tk].x * o[tk].x + o[tk].y * o[tk].y; }
            float r4[32], r3[16], r2[8], r1[4], r0[2];
            { const bool up = (lane & 32) != 0;
#pragma unroll
              for (int i = 0; i < 32; ++i) { const float keep = up ? r5[i + 32] : r5[i], send = up ? r5[i] : r5[i + 32]; r4[i] = keep + __shfl_xor(send, 32); } }
            { const bool up = (lane & 16) != 0;
#pragma unroll
              for (int i = 0; i < 16; ++i) { const float keep = up ? r4[i + 16] : r4[i], send = up ? r4[i] : r4[i + 16]; r3[i] = keep + __shfl_xor(send, 16); } }
            { const bool up = (lane & 8) != 0;
#pragma unroll
              for (int i = 0; i < 8; ++i) { const float keep = up ? r3[i + 8] : r3[i], send = up ? r3[i] : r3[i + 8]; r2[i] = keep + __shfl_xor(send, 8); } }
            { const bool up = (lane & 4) != 0;
#pragma unroll
              for (int i = 0; i < 4; ++i) { const float keep = up ? r2[i + 4] : r2[i], send = up ? r2[i] : r2[i + 4]; r1[i] = keep + __shfl_xor(send, 4); } }
            { const bool up = (lane & 2) != 0;
#pragma unroll
              for (int i = 0; i < 2; ++i) { const float keep = up ? r1[i + 2] : r1[i], send = up ? r1[i] : r1[i + 2]; r0[i] = keep + __shfl_xor(send, 2); } }
            const bool up0 = (lane & 1) != 0;
            const float tot = (up0 ? r0[1] : r0[0]) + __shfl_xor(up0 ? r0[0] : r0[1], 1);
            red[((lane >> 1) * 8 + wave) * 2 + (lane & 1)] = tot;
        }
        __syncthreads();
        if (tid < 32) { float s = 0.f, q = 0.f;
#pragma unroll
            for (int wv = 0; wv < 8; ++wv) { s += red[(tid * 8 + wv) * 2]; q += red[(tid * 8 + wv) * 2 + 1]; }
            const float mean = s * (1.0f / D); const float var = fmaxf(q * (1.0f / D) - mean * mean, 0.f);
            stat[tid * 2] = mean; stat[tid * 2 + 1] = 1.0f / sqrtf(var + EPS); }
        __syncthreads();
#pragma unroll
        for (int tk = 0; tk < 32; ++tk) { const float mean = stat[tk * 2], rstd = stat[tk * 2 + 1];
            const float y0 = (o[tk].x - mean) * rstd * gam.x + bet.x, y1 = (o[tk].y - mean) * rstd * gam.y + bet.y;
            *(unsigned*)(UC + (size_t)(t0 + tk) * D + 2 * tid) = pk2(siluf_(y0), siluf_(y1)); }
        __syncthreads();
    }
}

DI void conv_block(const bf16* XBC, const float* cw, const float* cb, int t_first, int col, float (&o)[8][8]) {
    v4u raw[11];
#pragma unroll
    for (int r = 0; r < 11; ++r) { const int t = t_first - 3 + r; const int tc = t < 0 ? 0 : t; v4u v = *(const v4u*)(XBC + (size_t)tc * XBCW + col);
        const unsigned msk = t < 0 ? 0u : 0xffffffffu; v.x &= msk; v.y &= msk; v.z &= msk; v.w &= msk; raw[r] = v; }
    float w[4][8], b[8];
#pragma unroll
    for (int j = 0; j < 4; ++j) { const f32x4 lo = *(const f32x4*)(cw + j * XBCW + col), hi = *(const f32x4*)(cw + j * XBCW + col + 4);
        w[j][0] = lo.x; w[j][1] = lo.y; w[j][2] = lo.z; w[j][3] = lo.w; w[j][4] = hi.x; w[j][5] = hi.y; w[j][6] = hi.z; w[j][7] = hi.w; }
    { const f32x4 lo = *(const f32x4*)(cb + col), hi = *(const f32x4*)(cb + col + 4); b[0] = lo.x; b[1] = lo.y; b[2] = lo.z; b[3] = lo.w; b[4] = hi.x; b[5] = hi.y; b[6] = hi.z; b[7] = hi.w; }
#pragma unroll
    for (int tk = 0; tk < 8; ++tk)
#pragma unroll
        for (int ch = 0; ch < 8; ++ch) {
            float acc = b[ch];
#pragma unroll
            for (int j = 0; j < 4; ++j) { const unsigned wd = raw[tk + j][ch >> 1]; const float xv = (ch & 1) ? bfhi(wd) : bflo(wd); acc += w[j][ch] * xv; }
            o[tk][ch] = siluf_(acc);
        }
}
DI float head_scan(const float* DT, const float* alog, int t0, int h, int lane, LAS float* acs_h, LAS float* dtv_h, float& d0o, float& d1o, float& c0o, float& c1o) {
    const float d0 = DT[(size_t)(t0 + 2 * lane) * NH + h], d1 = DT[(size_t)(t0 + 2 * lane + 1) * NH + h];
    const float A2 = -__expf(alog[h]) * LOG2E;
    const float a0 = d0 * A2, a1 = d1 * A2; float inc = a0 + a1;
#pragma unroll
    for (int o = 1; o < 64; o <<= 1) { const float t = __shfl_up(inc, o); if (lane >= o) inc += t; }
    acs_h[2 * lane] = inc - a1; acs_h[2 * lane + 1] = inc; dtv_h[2 * lane] = d0; dtv_h[2 * lane + 1] = d1;
    d0o = d0; d1o = d1; c0o = inc - a1; c1o = inc;
    return __shfl(inc, 63);
}

constexpr int S_CN = 0, S_BN = 32768, S_XT = 65536, S_ACS = 131072, S_DTV = 135168, S_SSQ = 139264, S_FS = 139776;

DI void ph3_chunk_states(const Ctx& F, const Args& a, int reps) {
    const bf16* XBC = (const bf16*)(F.ws + WS_XBC); const float* DT = (const float*)(F.ws + WS_DT);
    bf16* ST = (bf16*)(F.ws + WS_ST); float* CD = (float*)(F.ws + WS_CD);
    const float* scw = ARG(I_SCW); const float* scb = ARG(I_SCB); const float* alog = ARG(I_ALOG);
    const int tid = F.wave * 64 + lane_id(), lane = lane_id(), wave = F.wave, hh = lane >> 5;
    LAS unsigned char* lds = F.lds;
    LAS float* acs = (LAS float*)(lds + S_ACS); LAS float* wsc = (LAS float*)(lds + S_DTV);
    const int RU = (NCH * NGRP + F.G - 1) / F.G;
    for (int it = 0; it < RU * reps; ++it) {
        const int unit = xcd_unit(F.xcd, F.xj, F.G >> 3, (it >= RU ? it - RU : it), NCH * NGRP); if (unit < 0) break; const int c = unit >> 2, g = unit & 3, t0 = c * LCH;
        {
            const int h = 8 * g + wave; float d0, d1, c0, c1;
            const float total = head_scan(DT, alog, t0, h, lane, acs + wave * 128, wsc + wave * 128, d0, d1, c0, c1);
            wsc[wave * 128 + 2 * lane] = d0 * __builtin_amdgcn_exp2f(total - c0); wsc[wave * 128 + 2 * lane + 1] = d1 * __builtin_amdgcn_exp2f(total - c1);
            if (lane == 0) CD[c * NH + h] = __builtin_amdgcn_exp2f(total);
        }
        __syncthreads();
        if (tid < 256) { const int co = tid & 15, to = tid >> 4; float o[8][8];
            conv_block(XBC, scw, scb, t0 + 8 * to, 2048 + 128 * g + 8 * co, o);
#pragma unroll
            for (int ch = 0; ch < 8; ++ch) { const int row = 8 * co + ch;
                v4u w; w.x = pk2(o[0][ch], o[1][ch]); w.y = pk2(o[2][ch], o[3][ch]); w.z = pk2(o[4][ch], o[5][ch]); w.w = pk2(o[6][ch], o[7][ch]);
                *(LAS v4u*)(lds + S_BN + row * 256 + swz(row, to) * 16) = w; } }
        for (int ps = 0; ps < 2; ++ps) {
            {
                const int co = tid & 31, to = tid >> 5, hd = co >> 3, p0 = (co & 7) * 8; float o[8][8];
                conv_block(XBC, scw, scb, t0 + 8 * to, 512 * g + 64 * (4 * ps + hd) + p0, o);
                float sc[8];
#pragma unroll
                for (int tk = 0; tk < 8; ++tk) sc[tk] = wsc[(4 * ps + hd) * 128 + 8 * to + tk];
#pragma unroll
                for (int ch = 0; ch < 8; ++ch) { const int row = hd * 64 + p0 + ch;
                    v4u w; w.x = pk2(o[0][ch] * sc[0], o[1][ch] * sc[1]); w.y = pk2(o[2][ch] * sc[2], o[3][ch] * sc[3]);
                    w.z = pk2(o[4][ch] * sc[4], o[5][ch] * sc[5]); w.w = pk2(o[6][ch] * sc[6], o[7][ch] * sc[7]);
                    *(LAS v4u*)(lds + S_XT + row * 256 + swz(row, to) * 16) = w; }
            }
            __syncthreads();
            {
                const int hd = wave & 3, ph = wave >> 2, h = 8 * g + 4 * ps + hd;
                f32x16 acc[4];
#pragma unroll
                for (int nt = 0; nt < 4; ++nt)
#pragma unroll
                    for (int i = 0; i < 16; ++i) acc[nt][i] = 0.f;
                const int arow = hd * 64 + 32 * ph + (lane & 31);
#pragma unroll
                for (int ks = 0; ks < 8; ++ks) {
                    const bf16x8 av = *(const LAS bf16x8*)(lds + S_XT + arow * 256 + swz(arow, 2 * ks + hh) * 16);
#pragma unroll
                    for (int nt = 0; nt < 4; ++nt) { const int brow = 32 * nt + (lane & 31);
                        const bf16x8 bv = *(const LAS bf16x8*)(lds + S_BN + brow * 256 + swz(brow, 2 * ks + hh) * 16);
                        acc[nt] = MFMA32(av, bv, acc[nt]); }
                }
                bf16* dst = ST + ((size_t)(c * NH + h) * HD) * NST;
#pragma unroll
                for (int nt = 0; nt < 4; ++nt)
#pragma unroll
                    for (int i = 0; i < 16; i += 2) { const int p = 32 * ph + crow(i, hh); const unsigned pk = pk2(acc[nt][i], acc[nt][i + 1]);
                        dst[(size_t)p * NST + 32 * nt + (lane & 31)] = (bf16)(pk & 0xffffu); dst[(size_t)(p + 1) * NST + 32 * nt + (lane & 31)] = (bf16)(pk >> 16); }
            }
            __syncthreads();
        }
    }
}

DI void ph4_scan(const Ctx& F, size_t dst_off) {
    unsigned* ST32 = (unsigned*)(F.ws + WS_ST); unsigned* DST32 = (unsigned*)(F.ws + dst_off); const float* CD = (const float*)(F.ws + WS_CD);
    constexpr int NPAIR = NH * HD * NST / 2;
    for (int e = F.vcu * NTHREADS + (F.wave * 64 + lane_id()); e < NPAIR; e += F.G * NTHREADS) {
        const int h = e >> 12; float c0 = 0.f, c1 = 0.f;
#pragma unroll 1
        for (int cb = 0; cb < NCH; cb += 32) {
            unsigned v[32]; float dec[32];
#pragma unroll
            for (int i = 0; i < 32; ++i) { v[i] = __builtin_nontemporal_load(ST32 + (size_t)(cb + i) * NPAIR + e); dec[i] = CD[(cb + i) * NH + h]; }
#pragma unroll
            for (int i = 0; i < 32; ++i) { DST32[(size_t)(cb + i) * NPAIR + e] = pk2(c0, c1); c0 = c0 * dec[i] + bflo(v[i]); c1 = c1 * dec[i] + bfhi(v[i]); }
        }
    }
}

DI void ph5_ssd_out(const Ctx& F, const Args& a, int reps) {
    const bf16* XBC = (const bf16*)(F.ws + WS_XBC); const float* DT = (const float*)(F.ws + WS_DT);
    const bf16* ST = (const bf16*)(F.ws + WS_ST); const bf16* ZS = (const bf16*)(F.ws + WS_ZS); bf16* YS = (bf16*)(F.ws + WS_YS);
    const float* scw = ARG(I_SCW); const float* scb = ARG(I_SCB); const float* alog = ARG(I_ALOG); const float* dskip = ARG(I_DSKIP);
    const int tid = F.wave * 64 + lane_id(), lane = lane_id(), wave = F.wave, hh = lane >> 5, l31 = lane & 31;
    LAS unsigned char* lds = F.lds;
    LAS float* acs = (LAS float*)(lds + S_ACS); LAS float* dtv = (LAS float*)(lds + S_DTV); LAS float* ssq = (LAS float*)(lds + S_SSQ);
    const int RU = (NCH * NGRP + F.G - 1) / F.G;
    for (int it = 0; it < RU * reps; ++it) {
        const int unit = xcd_unit(F.xcd, F.xj, F.G >> 3, (it >= RU ? it - RU : it), NCH * NGRP); if (unit < 0) break; const int c = unit >> 2, g = unit & 3, t0 = c * LCH;
        { const int h = 8 * g + wave; float d0, d1, c0, c1; (void)head_scan(DT, alog, t0, h, lane, acs + wave * 128, dtv + wave * 128, d0, d1, c0, c1);
          const float cend = __shfl(c1, (lane & 48) | 15);
          LAS float* fsw = (LAS float*)(lds + S_FS) + wave * 128;
          fsw[2 * lane] = d0 * __builtin_amdgcn_exp2f(cend - c0); fsw[2 * lane + 1] = d1 * __builtin_amdgcn_exp2f(cend - c1); }
        if (tid < 128) ssq[tid] = 0.f;
        { const int which = tid >> 8, t8 = tid & 255, co = t8 & 15; int to = t8 >> 4; asm volatile("" : "+v"(to)); float o[8][8];
            conv_block(XBC, scw, scb, t0 + 8 * to, (which ? 2560 : 2048) + 128 * g + 8 * co, o);
            const int base = which ? S_CN : S_BN;
#pragma unroll
            for (int tk = 0; tk < 8; ++tk) { const int row = 8 * to + tk;
                v4u w; w.x = pk2(o[tk][0], o[tk][1]); w.y = pk2(o[tk][2], o[tk][3]); w.z = pk2(o[tk][4], o[tk][5]); w.w = pk2(o[tk][6], o[tk][7]);
                *(LAS v4u*)(lds + base + row * 256 + swz(row, co) * 16) = w; } }
#pragma unroll 1
        for (int ps = 0; ps < 2; ++ps) {
            {
                const int co = tid & 31; int to = tid >> 5; asm volatile("" : "+v"(to));
                const int hd = co >> 3, p0 = (co & 7) * 8; float o[8][8];
                conv_block(XBC, scw, scb, t0 + 8 * to, 512 * g + 64 * (4 * ps + hd) + p0, o);
#pragma unroll
                for (int ch = 0; ch < 8; ++ch) { const int row = hd * 64 + p0 + ch;
                    v4u w; w.x = pk2(o[0][ch], o[1][ch]); w.y = pk2(o[2][ch], o[3][ch]); w.z = pk2(o[4][ch], o[5][ch]); w.w = pk2(o[6][ch], o[7][ch]);
                    *(LAS v4u*)(lds + S_XT + row * 256 + swz(row, to) * 16) = w; }
            }
            __syncthreads();
            const int hd = wave & 3, lp = wave >> 2, hl = 4 * ps + hd, h = 8 * g + hl;
            const float Dh = dskip[h];
            const LAS float* acs_h = acs + hl * 128; const LAS float* dt_h = dtv + hl * 128; const LAS float* fs_h = (const LAS float*)(lds + S_FS) + hl * 128;
            const bf16* prev = ST + ((size_t)(c * NH + h) * HD) * NST;
            const int erow = lane >> 1, ehalf = lane & 1;
            f32x16 acc[2][2];
            {
#pragma unroll
                for (int which = 0; which < 2; ++which)
#pragma unroll
                    for (int pt = 0; pt < 2; ++pt)
#pragma unroll
                        for (int i = 0; i < 16; ++i) acc[which][pt][i] = 0.f;
                const int rowA = 32 * lp + l31, rowB = 32 * (3 - lp) + l31;
#pragma unroll
                for (int ks = 0; ks < 8; ++ks) {
                    const bf16x8 b0 = *(const bf16x8*)(prev + (size_t)l31 * NST + 16 * ks + 8 * hh), b1 = *(const bf16x8*)(prev + (size_t)(32 + l31) * NST + 16 * ks + 8 * hh);
                    const bf16x8 a0 = *(const LAS bf16x8*)(lds + S_CN + rowA * 256 + swz(rowA, 2 * ks + hh) * 16);
                    const bf16x8 a1 = *(const LAS bf16x8*)(lds + S_CN + rowB * 256 + swz(rowB, 2 * ks + hh) * 16);
                    acc[0][0] = MFMA32(a0, b0, acc[0][0]); acc[0][1] = MFMA32(a0, b1, acc[0][1]);
                    acc[1][0] = MFMA32(a1, b0, acc[1][0]); acc[1][1] = MFMA32(a1, b1, acc[1][1]);
                }
#pragma unroll
                for (int which = 0; which < 2; ++which) { const int li = which == 0 ? lp : 3 - lp;
#pragma unroll
                    for (int i = 0; i < 16; ++i) { const float e = __builtin_amdgcn_exp2f(acs_h[32 * li + crow(i, hh)]); acc[which][0][i] *= e; acc[which][1][i] *= e; } }
            }
            {
                const int liA = lp, liB = 3 - lp;
                const int rowA = 32 * liA + l31, rowB = 32 * liB + l31;
                const float alA = acs_h[rowA], alB = acs_h[rowB];
#pragma unroll 1
                for (int sj = 0; sj <= liB; ++sj) {
                    const bool doA = sj <= liA;
                    f32x16 GA, GB;
#pragma unroll
                    for (int i = 0; i < 16; ++i) { GA[i] = 0.f; GB[i] = 0.f; }
                    const int brow = 32 * sj + l31;
                    if (doA) {
#pragma unroll 2
                        for (int ks = 0; ks < 8; ++ks) {
                            const bf16x8 av = *(const LAS bf16x8*)(lds + S_BN + brow * 256 + swz(brow, 2 * ks + hh) * 16);
                            const bf16x8 ca = *(const LAS bf16x8*)(lds + S_CN + rowA * 256 + swz(rowA, 2 * ks + hh) * 16);
                            const bf16x8 cb = *(const LAS bf16x8*)(lds + S_CN + rowB * 256 + swz(rowB, 2 * ks + hh) * 16);
                            GA = MFMA32(av, ca, GA); GB = MFMA32(av, cb, GB);
                        }
                    } else {
#pragma unroll 2
                        for (int ks = 0; ks < 8; ++ks) {
                            const bf16x8 av = *(const LAS bf16x8*)(lds + S_BN + brow * 256 + swz(brow, 2 * ks + hh) * 16);
                            const bf16x8 cb = *(const LAS bf16x8*)(lds + S_CN + rowB * 256 + swz(rowB, 2 * ks + hh) * 16);
                            GB = MFMA32(av, cb, GB);
                        }
                    }
                    auto mask = [&](f32x16& G, int li, int row_l, float al) {
                        if (sj < li) {
                            const float fl = __builtin_amdgcn_exp2f(al - acs_h[32 * sj + 31]);
#pragma unroll
                            for (int i = 0; i < 16; ++i) G[i] = G[i] * (fs_h[32 * sj + crow(i, hh)] * fl);
                        } else {
#pragma unroll
                            for (int i = 0; i < 16; ++i) { const int s = 32 * sj + crow(i, hh);
                                float v = G[i] * __builtin_amdgcn_exp2f(fminf(al - acs_h[s], 0.f)) * dt_h[s];
                                v = (s > row_l) ? 0.f : v; v = (s == row_l) ? v + Dh : v; G[i] = v; }
                        }
                    };
                    auto pv = [&](const f32x16& G, f32x16 (&ac)[2]) {
#pragma unroll
                        for (int s2 = 0; s2 < 2; ++s2) {
                            v4u fa; fa.x = pk2(G[8 * s2 + 0], G[8 * s2 + 1]); fa.y = pk2(G[8 * s2 + 2], G[8 * s2 + 3]); fa.z = pk2(G[8 * s2 + 4], G[8 * s2 + 5]); fa.w = pk2(G[8 * s2 + 6], G[8 * s2 + 7]);
#pragma unroll
                            for (int pt = 0; pt < 2; ++pt) { const int xrow = hd * 64 + 32 * pt + l31; const int sc0 = 32 * sj + 16 * s2;
                                const v2u lo = *(const LAS v2u*)(lds + S_XT + xrow * 256 + swz(xrow, (sc0 >> 3)) * 16 + 8 * hh);
                                const v2u hi = *(const LAS v2u*)(lds + S_XT + xrow * 256 + swz(xrow, (sc0 >> 3) + 1) * 16 + 8 * hh);
                                v4u bfr; bfr.x = lo.x; bfr.y = lo.y; bfr.z = hi.x; bfr.w = hi.y;
                                ac[pt] = MFMA32(__builtin_bit_cast(bf16x8, fa), __builtin_bit_cast(bf16x8, bfr), ac[pt]); }
                        }
                    };
                    if (doA) { mask(GA, liA, rowA, alA); pv(GA, acc[0]); }
                    mask(GB, liB, rowB, alB); pv(GB, acc[1]);
                }
            }
            asm volatile("" ::: "memory");
            v4u zs[2][4];
#pragma unroll
            for (int which = 0; which < 2; ++which) { const int li = which == 0 ? lp : 3 - lp; const size_t t = (size_t)(t0 + 32 * li + erow);
#pragma unroll
                for (int j = 0; j < 4; ++j) zs[which][j] = *(const v4u*)(ZS + t * DIN + 64 * h + 32 * ehalf + 8 * j); }
            __syncthreads();
            {
                LAS unsigned char* stg = lds + S_XT + wave * 8192;
#pragma unroll
                for (int which = 0; which < 2; ++which)
#pragma unroll
                    for (int pt = 0; pt < 2; ++pt)
#pragma unroll
                        for (int i = 0; i < 16; ++i) *(LAS bf16*)(stg + ((which * 32 + crow(i, hh)) * 64 + 32 * pt + l31) * 2) = (bf16)(pk2(acc[which][pt][i], 0.f) & 0xffffu);
                LDS_WAIT(); asm volatile("" ::: "memory");
#pragma unroll
                for (int which = 0; which < 2; ++which) { const int li = which == 0 ? lp : 3 - lp; const int l = 32 * li + erow; const size_t t = (size_t)(t0 + l);
                    float q = 0.f; unsigned w8[8];
#pragma unroll
                    for (int j = 0; j < 4; ++j) { const v4u yv = *(const LAS v4u*)(stg + ((which * 32 + erow) * 64 + 32 * ehalf + 8 * j) * 2); const v4u zv = zs[which][j];
                        float y[8] = {bflo(yv.x) * bflo(zv.x), bfhi(yv.x) * bfhi(zv.x), bflo(yv.y) * bflo(zv.y), bfhi(yv.y) * bfhi(zv.y), bflo(yv.z) * bflo(zv.z), bfhi(yv.z) * bfhi(zv.z), bflo(yv.w) * bflo(zv.w), bfhi(yv.w) * bfhi(zv.w)};
#pragma unroll
                        for (int k = 0; k < 8; ++k) q += y[k] * y[k];
                        w8[2 * j] = pk4_fp8(y[0], y[1], y[2], y[3]); w8[2 * j + 1] = pk4_fp8(y[4], y[5], y[6], y[7]); }
                    { unsigned char* yp = (unsigned char*)YS + t * DIN + 64 * h + 32 * ehalf;
                      *(v4u*)yp = (v4u){w8[0], w8[1], w8[2], w8[3]}; *(v4u*)(yp + 16) = (v4u){w8[4], w8[5], w8[6], w8[7]}; }
                    q += __shfl_xor(q, 1);
                    if (ehalf == 0) __hip_atomic_fetch_add(ssq + l, q, __ATOMIC_RELAXED, __HIP_MEMORY_SCOPE_WORKGROUP);
                }
            }
            __syncthreads();
        }
        if (tid < 128) ((float*)(F.ws + WS_RSTD))[(size_t)(t0 + tid) * 4 + g] = 1.0f / sqrtf(ssq[tid] * (1.0f / 512.f) + EPS);
        __syncthreads();
    }
}

constexpr int RT_LD = 1028;
DI void ph8_router(const Ctx& F, const Args& a, int reps) {
    const float* mod = (const float*)(F.ws + WS_CTL) + CW_MODC;
    const bf16* H = (const bf16*)(F.ws + WS_H16); const float* n2g = ARG(I_N2G); const float* bgrp = ARG(I_BGRP); const float* ber = ARG(I_BER);
    unsigned char* XN2 = F.ws + WS_XN; int* cnt0 = (int*)(F.ws + WS_CTL) + CW_CNT;
    int* RE = (int*)(F.ws + WS_ROUTE); int* RP = RE + 2 * M; float* RW = (float*)(RP + 2 * M); int* LIST = (int*)(F.ws + WS_LIST);
    const int lane = lane_id(), wave = F.wave;
    LAS float* tile = (LAS float*)F.lds;
    LAS float* pe = (LAS float*)F.lds;
    f32x4 gm[4], ga[4];
#pragma unroll
    for (int j = 0; j < 4; ++j) { const int k = 256 * j + 4 * lane; const f32x4 g = *(const f32x4*)(n2g + k), sc = *(const f32x4*)(mod + 4096 + k);
        gm[j] = g * (sc + 1.0f); ga[j] = *(const f32x4*)(mod + 3072 + k); }
    const int RU = (M / 32 + F.G - 1) / F.G;
    for (int it = 0; it < RU * reps; ++it) {
        const int unit = xcd_unit(F.xcd, F.xj, F.G >> 3, (it >= RU ? it - RU : it), M / 32); if (unit < 0) break; int* cnt = cnt0 + ((it >= RU * (reps - 1)) ? 0 : 4096);
        const int row0 = unit * 32;
        {
            f32x4 v[4][4];
#pragma unroll
            for (int rr = 0; rr < 4; ++rr)
#pragma unroll
                for (int j = 0; j < 4; ++j) { const v2u hw = *(const v2u*)(H + (size_t)(row0 + wave * 4 + rr) * D + 256 * j + 4 * lane); v[rr][j] = (f32x4){bflo(hw.x), bfhi(hw.x), bflo(hw.y), bfhi(hw.y)}; }
#pragma unroll
            for (int rr = 0; rr < 4; ++rr) { const int rl = wave * 4 + rr, row = row0 + rl; float ss = 0.f;
#pragma unroll
                for (int j = 0; j < 4; ++j) ss += (v[rr][j].x * v[rr][j].x + v[rr][j].y * v[rr][j].y) + (v[rr][j].z * v[rr][j].z + v[rr][j].w * v[rr][j].w);
                const float rstd = 1.0f / sqrtf(wave_sum(ss) * (1.0f / D) + EPS);
#pragma unroll
                for (int j = 0; j < 4; ++j) { const f32x4 n = v[rr][j] * rstd * gm[j] + ga[j];
                    *(LAS f32x4*)(tile + rl * RT_LD + 256 * j + 4 * lane) = n;
                    *(unsigned*)(XN2 + (size_t)row * D + 256 * j + 4 * lane) = pk4_fp8(n.x, n.y, n.z, n.w); }
            }
        }
        __syncthreads();
        pg8::f32x4 acc[2][5];
#pragma unroll
        for (int rt = 0; rt < 2; ++rt)
#pragma unroll
            for (int ct = 0; ct < 5; ++ct) acc[rt][ct] = (pg8::f32x4){0.f, 0.f, 0.f, 0.f};
        const int kb = wave * 128, fr = lane & 15, kq = lane >> 4;
        const bf16* WRH = (const bf16*)(F.ws + WS_WRH); const bf16* WRL = (const bf16*)(F.ws + WS_WRL);
#pragma unroll 2
        for (int ks = 0; ks < 4; ++ks) {
            const int k0 = kb + 32 * ks + 8 * kq;
            bf16x8 bh[5], bl[5];
#pragma unroll
            for (int ct = 0; ct < 5; ++ct) { bh[ct] = *(const bf16x8*)(WRH + (size_t)(16 * ct + fr) * D + k0); bl[ct] = *(const bf16x8*)(WRL + (size_t)(16 * ct + fr) * D + k0); }
#pragma unroll
            for (int rt = 0; rt < 2; ++rt) {
                const f32x4 x0 = *(const LAS f32x4*)(tile + (16 * rt + fr) * RT_LD + k0), x1 = *(const LAS f32x4*)(tile + (16 * rt + fr) * RT_LD + k0 + 4);
                v4u hv, lv;
                hv.x = pk2(x0.x, x0.y); hv.y = pk2(x0.z, x0.w); hv.z = pk2(x1.x, x1.y); hv.w = pk2(x1.z, x1.w);
                lv.x = pk2(x0.x - bflo(hv.x), x0.y - bfhi(hv.x)); lv.y = pk2(x0.z - bflo(hv.y), x0.w - bfhi(hv.y));
                lv.z = pk2(x1.x - bflo(hv.z), x1.y - bfhi(hv.z)); lv.w = pk2(x1.z - bflo(hv.w), x1.w - bfhi(hv.w));
                const bf16x8 ah = __builtin_bit_cast(bf16x8, hv), al = __builtin_bit_cast(bf16x8, lv);
#pragma unroll
                for (int ct = 0; ct < 5; ++ct) {
                    acc[rt][ct] = __builtin_amdgcn_mfma_f32_16x16x32_bf16(ah, bh[ct], acc[rt][ct], 0, 0, 0);
                    acc[rt][ct] = __builtin_amdgcn_mfma_f32_16x16x32_bf16(ah, bl[ct], acc[rt][ct], 0, 0, 0);
                    acc[rt][ct] = __builtin_amdgcn_mfma_f32_16x16x32_bf16(al, bh[ct], acc[rt][ct], 0, 0, 0); }
            }
        }
        __syncthreads();
#pragma unroll
        for (int rt = 0; rt < 2; ++rt)
#pragma unroll
            for (int ct = 0; ct < 5; ++ct)
#pragma unroll
                for (int r = 0; r < 4; ++r) pe[(wave * 32 + 16 * rt + 4 * kq + r) * 80 + 16 * ct + fr] = acc[rt][ct][r];
        __syncthreads();
        int e0s[4], e1s[4]; float w0s[4], w1s[4];
#pragma unroll
        for (int rr = 0; rr < 4; ++rr) { const int rl = wave * 4 + rr;
            float le = ber[lane], lgv = (lane < 8) ? bgrp[lane] : 0.f;
#pragma unroll
            for (int wv = 0; wv < 8; ++wv) { le += pe[(wv * 32 + rl) * 80 + lane]; if (lane < 8) lgv += pe[(wv * 32 + rl) * 80 + 64 + lane]; }
            float gl[8];
#pragma unroll
            for (int i = 0; i < 8; ++i) gl[i] = __shfl(lgv, i);
            int gi = 0; float gmax = gl[0];
#pragma unroll
            for (int i = 1; i < 8; ++i) if (gl[i] > gmax) { gmax = gl[i]; gi = i; }
            float den = 0.f;
#pragma unroll
            for (int i = 0; i < 8; ++i) den += __expf(gl[i] - gmax);
            const float gp = 1.0f / den;
            float el[8];
#pragma unroll
            for (int i = 0; i < 8; ++i) el[i] = __shfl(le, gi * 8 + i);
            int i0 = 0; float m0 = el[0];
#pragma unroll
            for (int i = 1; i < 8; ++i) if (el[i] > m0) { m0 = el[i]; i0 = i; }
            int i1 = -1; float m1 = -INFINITY;
#pragma unroll
            for (int i = 0; i < 8; ++i) if (i != i0 && el[i] > m1) { m1 = el[i]; i1 = i; }
            const float dd = __expf(m1 - m0);
            w0s[rr] = gp / (1.0f + dd); w1s[rr] = gp * dd / (1.0f + dd); e0s[rr] = gi * 8 + i0; e1s[rr] = gi * 8 + i1;
        }
        if (lane == 0) {
            int p0[4], p1[4];
#pragma unroll
            for (int rr = 0; rr < 4; ++rr) { p0[rr] = atomicAdd(cnt + 64 * e0s[rr], 1); p1[rr] = atomicAdd(cnt + 64 * e1s[rr], 1); }
#pragma unroll
            for (int rr = 0; rr < 4; ++rr) { const int row = row0 + wave * 4 + rr;
                RE[2 * row] = e0s[rr]; RE[2 * row + 1] = e1s[rr]; RP[2 * row] = p0[rr]; RP[2 * row + 1] = p1[rr]; RW[2 * row] = w0s[rr]; RW[2 * row + 1] = w1s[rr];
                LIST[e0s[rr] * 16384 + p0[rr]] = row; LIST[e1s[rr] * 16384 + p1[rr]] = row; }
        }
        __syncthreads();
    }
}

DI void build_tilebase(const Ctx& F) {
    const int* cnt = (const int*)(F.ws + WS_CTL) + CW_CNT; LAS int* tb = (LAS int*)(F.lds + TB_OFF);
    if (F.wave == 0) {
        const int lane = lane_id(); const int tiles = (cnt[64 * lane] + 255) >> 8; int inc = tiles;
#pragma unroll
        for (int o = 1; o < 64; o <<= 1) { const int t = __shfl_up(inc, o); if (lane >= o) inc += t; }
        tb[lane] = inc - tiles; if (lane == 63) tb[NE] = inc; ((LAS int*)(F.lds + CNTL_OFF))[lane] = cnt[64 * lane];
    }
    __syncthreads();
}
DI void fill_tokl(const Ctx& F, const MoeOrder& S) {
    const LAS int* tb = (const LAS int*)(F.lds + TB_OFF); const LAS int* cntl = (const LAS int*)(F.lds + CNTL_OFF); LAS int* tokl = (LAS int*)(F.lds + TOKL_OFF);
    const int* LIST = (const int*)(F.ws + WS_LIST); const int tid = F.wave * 64 + lane_id();
    for (int i = 0; i < 4; ++i) { pg8::Unit u; if (!S.next(i, u)) break;
        const int e = u.pn >> 2, r = 256 * (u.pm - tb[e]) + tid;
        if (tid < 256) tokl[256 * i + tid] = (r < cntl[e]) ? LIST[e * 16384 + r] : 0; }
    asm volatile("s_waitcnt vmcnt(0) lgkmcnt(0)" ::: "memory"); __syncthreads();
}
DI void ph12_final(const Ctx& F, const Args& a, int reps) {
    const float* mod = (const float*)(F.ws + WS_CTL) + CW_MODC; float* H = (float*)argp<N_IN>(); const bf16* H16 = (const bf16*)(F.ws + WS_H16); const float* fg = ARG(I_FG);
    const unsigned char* YE = F.ws + WS_YEXP; const int* RE = (const int*)(F.ws + WS_ROUTE); const int* RP = RE + 2 * M; const float* RW = (const float*)(F.ws + WS_ROUTE) + 4 * M;
    const LAS int* tb = (const LAS int*)(F.lds + TB_OFF);
    float* OUT2 = (float*)(F.ws + WS_U);
    const int gw = F.vcu * NWAVES + F.wave, NGW = F.G * NWAVES, lane = lane_id();
    f32x4 g2[4], fgv[4];
#pragma unroll
    for (int j = 0; j < 4; ++j) { g2[j] = *(const f32x4*)(mod + 5 * 1024 + 256 * j + 4 * lane); fgv[j] = *(const f32x4*)(fg + 256 * j + 4 * lane); }
    const int RT = (M / 2 + NGW - 1) / NGW;
    for (int it = 0; it < RT * reps; ++it) {
        const int t0 = 2 * xcd_unit(F.xcd, F.xj * NWAVES + F.wave, NGW >> 3, (it >= RT ? it - RT : it), M / 2); if (t0 < 0) break;
        float* O = (it >= RT * (reps - 1)) ? H : OUT2;
        int tt[2], d0[2], d1[2]; float w0[2], w1[2];
#pragma unroll
        for (int u = 0; u < 2; ++u) { tt[u] = (t0 + u) % M; d0[u] = 256 * tb[RE[2 * tt[u]]] + RP[2 * tt[u]]; d1[u] = 256 * tb[RE[2 * tt[u] + 1]] + RP[2 * tt[u] + 1]; w0[u] = RW[2 * tt[u]]; w1[u] = RW[2 * tt[u] + 1]; }
        f32x4 hv[2][4]; unsigned ya[2][4], yb[2][4];
#pragma unroll
        for (int u = 0; u < 2; ++u)
#pragma unroll
            for (int j = 0; j < 4; ++j) { const v2u hw = *(const v2u*)(H16 + (size_t)tt[u] * D + 256 * j + 4 * lane); hv[u][j] = (f32x4){bflo(hw.x), bfhi(hw.x), bflo(hw.y), bfhi(hw.y)};
                ya[u][j] = *(const unsigned*)(YE + (size_t)d0[u] * D + 256 * j + 4 * lane); yb[u][j] = *(const unsigned*)(YE + (size_t)d1[u] * D + 256 * j + 4 * lane); }
#pragma unroll
        for (int u = 0; u < 2; ++u) {
            f32x4 v[4]; float ss = 0.f;
#pragma unroll
            for (int j = 0; j < 4; ++j) { const unsigned a4 = ya[u][j], b4 = yb[u][j];
                const f2v a01 = __builtin_amdgcn_cvt_pk_f32_fp8(a4, false), a23 = __builtin_amdgcn_cvt_pk_f32_fp8(a4, true), b01 = __builtin_amdgcn_cvt_pk_f32_fp8(b4, false), b23 = __builtin_amdgcn_cvt_pk_f32_fp8(b4, true);
                f32x4 mo; mo.x = w0[u] * a01.x + w1[u] * b01.x; mo.y = w0[u] * a01.y + w1[u] * b01.y; mo.z = w0[u] * a23.x + w1[u] * b23.x; mo.w = w0[u] * a23.y + w1[u] * b23.y;
                mo = mo * 0.0625f;
                v[j] = hv[u][j] + g2[j] * mo; ss += (v[j].x * v[j].x + v[j].y * v[j].y) + (v[j].z * v[j].z + v[j].w * v[j].w); }
            const float rstd = 1.0f / sqrtf(wave_sum(ss) * (1.0f / D) + EPS);
#pragma unroll
            for (int j = 0; j < 4; ++j) *(f32x4*)(O + (size_t)tt[u] * D + 256 * j + 4 * lane) = v[j] * rstd * fgv[j];
        }
    }
}

constexpr int N_PHASES = 13;
#ifndef REP_MASK
#define REP_MASK 0
#endif
#define REPS(k) (((REP_MASK >> (k)) & 1) ? 2 : 1)
#ifndef MK_ONE_LAUNCH
#define MK_ONE_LAUNCH 1
#endif

struct RepOrder { pg8::StaticOrder s; int n, reps;
    DI bool next(int i, pg8::Unit& u) const { if (i >= n * reps) return false; return s.next(i % n, u); }
    DI void a_ready(const pg8::Unit&) const {}
    DI void done(const pg8::Unit&) const {} };

__global__ void __launch_bounds__(NTHREADS, 2) fwd_kernel(Args args) {
    extern __shared__ __attribute__((aligned(16))) unsigned char lds_raw[];
    Ctx F;
    F.lds = (LAS unsigned char*)lds_raw;
    F.wave = __builtin_amdgcn_readfirstlane((int)threadIdx.x >> 6);
    F.G = gridDim.x; { const int bx = blockIdx.x; F.xcd = bx & 7; F.xj = bx >> 3; F.vcu = F.xcd * (F.G >> 3) + F.xj; }
    F.ws = (unsigned char*)argp<N_IN + 1>();
    volatile LAS unsigned* MISC = (volatile LAS unsigned*)(F.lds + LDSCTL_OFF);
    for (int u = threadIdx.x; u < (LDS_BYTES - LDSCTL_OFF) / 4; u += NTHREADS) ((LAS unsigned*)(F.lds + LDSCTL_OFF))[u] = 0u;
    __syncthreads();
    const int lo = args.ph_lo, hi = args.ph_hi;
    unsigned* barw = (unsigned*)(F.ws + WS_CTL) + CW_BAR;
    XcdBarrier bar; bar.bar = barw; bar.x = 0; bar.st = nullptr;
    if (hi - lo > 1) bar = xcd_barrier_post(barw, MISC + 8);
    bar.wave = F.wave;
#define IN(k) (lo <= (k) && (k) < hi)
#define SEAM(k) do { if (IN(k) && IN((k) + 1)) { xcd_barrier(bar); if (REPS(14) > 1) xcd_barrier(bar); } } while (0)
    unsigned char* ws = F.ws;
    bf16* XN = (bf16*)(ws + WS_XN);
    const float* mod = (const float*)(ws + WS_CTL) + CW_MOD;

    if (IN(0)) { ph0_prologue(F, args, REPS(0)); SEAM(0); }
    if (IN(1)) { for (int rep = 0; rep < REPS(1); ++rep) { ph1_norm_dt(F, args); __syncthreads(); } SEAM(1); }
    if (IN(2)) {
        {
            pg8::Gemm g{XN, (const bf16*)(ws + WS_WIN) + (size_t)NP8 * 256 * D, M, NPROJ - NP8 * 256, D}; pg8::StaticOrder S; S.init(M, NPROJ - NP8 * 256, F.G, (int)blockIdx.x);
            EpiInProj E{ws, NP8};
            RepOrder R{S, (S.nwg - S.c + S.G - 1) / S.G, REPS(2)};
            pg8::gemm_phase<EpiInProj, RepOrder, true, true>(F.lds, g, R, E, F.wave);
        }
        __syncthreads();
        {
            pg8::Gemm g{(const bf16*)(ws + WS_XN8), (const bf16*)(ws + WS_W8IN), M, NP8 * 256, D / 2}; pg8::StaticOrder S; S.init(M, NP8 * 256, F.G, (int)blockIdx.x);
            EpiInProj E{ws, 0};
            RepOrder R{S, (S.nwg - S.c + S.G - 1) / S.G, REPS(2)};
            pg8::gemm_phase<EpiInProj, RepOrder, true, true, true>(F.lds, g, R, E, F.wave);
        }
        SEAM(2);
    }
    if (IN(3)) { ph3_convbranch(F, args, REPS(3)); __syncthreads(); ph3_chunk_states(F, args, REPS(13)); __syncthreads(); SEAM(3); }
    if (IN(4)) {
        if (REPS(4) > 1) ph4_scan(F, WS_YS);
        ph4_scan(F, WS_ST);
        pg8::Gemm g{XN, (const bf16*)(ws + WS_WCV), M, D, D}; pg8::StaticOrder S; S.init(M, D, F.G, (int)blockIdx.x);
        EpiGate<false> E{(bf16*)(ws + WS_TMP), nullptr, (const bf16*)(ws + WS_GATE), 0, nullptr};
        RepOrder R{S, (S.nwg - S.c + S.G - 1) / S.G, REPS(15)};
        pg8::gemm_phase<EpiGate<false>, RepOrder, false, true>(F.lds, g, R, E, F.wave);
        SEAM(4);
    }
    if (IN(5)) { ph5_ssd_out(F, args, REPS(5)); SEAM(5); }
    if (IN(6)) {
        pg8::Gemm g{(const bf16*)(ws + WS_YS), (const bf16*)(ws + WS_WSSM), M, D, DIN / 2}; pg8::StaticOrder S; S.init(M, D, F.G, (int)blockIdx.x);
        LAS float* rt = (LAS float*)(F.lds + RT_OFF);
        EpiGate<true> E{(bf16*)(ws + WS_MG), (const bf16*)(ws + WS_TMP), (const bf16*)(ws + WS_GATE), 1024, rt};
        for (int i = 0;; ++i) {
            OneUnit S1; if (!S.next(i, S1.u)) break;
            if (F.wave < 4) { const int tid = F.wave * 64 + lane_id(); const f32x4 r = *(const f32x4*)((const float*)(ws + WS_RSTD) + (size_t)(S1.u.pm * 256 + tid) * 4);
                *(LAS f32x4*)(rt + tid * 4) = (f32x4){r.x / r.y, r.y / r.z, r.z / r.w, r.w}; }
            asm volatile("s_waitcnt vmcnt(0) lgkmcnt(0)" ::: "memory"); __syncthreads();
            pg8::gemm_phase<EpiGate<true>, OneUnit, false, true, true>(F.lds, g, S1, E, F.wave);
            __syncthreads();
        }
        SEAM(6);
    }
    if (IN(7)) {
        pg8::Gemm g{(const bf16*)(ws + WS_MG), (const bf16*)(ws + WS_WMIX), M, D, D}; pg8::StaticOrder S; S.init(M, D, F.G, (int)blockIdx.x);
        EpiMix E{(bf16*)(ws + WS_H16), ARG(I_X), (const float*)(ws + WS_CTL) + CW_MODC + 2 * 1024};
        RepOrder R{S, (S.nwg - S.c + S.G - 1) / S.G, REPS(7)};
        pg8::gemm_phase<EpiMix, RepOrder, false, true>(F.lds, g, R, E, F.wave);
        SEAM(7);
    }
    if (IN(8)) { for (int rep = 0; rep < REPS(8); ++rep) { convert_experts(F, args); __syncthreads(); } ph8_router(F, args, REPS(9)); if (IN(8) && IN(10)) xcd_barrier(bar); }
    if (IN(10)) {
        build_tilebase(F);
        const LAS int* tb = (const LAS int*)(F.lds + TB_OFF);
        pg8::Gemm g{(const bf16*)(ws + WS_XN), (const bf16*)(ws + WS_W13), M, NE * 1024, D / 2};
        MoeOrder S{tb, F.G, F.vcu, tb[NE] * 4, 1, (const LAS int*)(F.lds + TOKL_OFF)};
        fill_tokl(F, S);
        EpiUp E{ws + WS_HDN};
        pg8::gemm_phase<EpiUp, MoeOrder, true, true, true, true>(F.lds, g, S, E, F.wave);
        SEAM(10);
    }
    if (IN(11)) {
        build_tilebase(F);
        const LAS int* tb = (const LAS int*)(F.lds + TB_OFF);
        pg8::Gemm g{(const bf16*)(ws + WS_HDN), (const bf16*)(ws + WS_W2), 49152, NE * 1024, DFF / 2};
        MoeOrder S{tb, F.G, F.vcu, tb[NE] * 4, 1, nullptr};
        EpiDown E{ws + WS_YEXP};
        pg8::gemm_phase<EpiDown, MoeOrder, true, true, true>(F.lds, g, S, E, F.wave);
        SEAM(11);
    }
    if (IN(12)) { build_tilebase(F); ph12_final(F, args, REPS(12)); }
#undef IN
#undef SEAM
}

extern "C" void kernel_launch(void* const* d_in, const int* in_sizes, int n_in, void* d_out, int out_size, void* d_ws, size_t ws_size, hipStream_t stream) {
    static int grid = 0;
    if (grid == 0) {
        if (n_in != N_IN || in_sizes[0] != M * D || out_size != M * D || ws_size < WS_END) {
            fprintf(stderr, "kernel_launch: unexpected shapes: n_in %d in0 %d out %d ws %zu (need %zu)\n", n_in, n_in > 0 ? in_sizes[0] : -1, out_size, ws_size, (size_t)WS_END); grid = -1; return; }
        int dev = 0, cus = 0, per_cu = 0;
        if (hipGetDevice(&dev) != hipSuccess || hipDeviceGetAttribute(&cus, hipDeviceAttributeMultiprocessorCount, dev) != hipSuccess) { fprintf(stderr, "kernel_launch: device query failed\n"); grid = -1; return; }
        if (hipFuncSetAttribute((const void*)fwd_kernel, hipFuncAttributeMaxDynamicSharedMemorySize, LDS_BYTES) != hipSuccess) { fprintf(stderr, "kernel_launch: hipFuncSetAttribute failed\n"); grid = -1; return; }
        if (hipOccupancyMaxActiveBlocksPerMultiprocessor(&per_cu, (const void*)fwd_kernel, NTHREADS, LDS_BYTES) != hipSuccess || per_cu < 1) {
            fprintf(stderr, "kernel_launch: the occupancy query admits no workgroup of this kernel per CU (%d); nothing launched\n", per_cu); (void)hipGetLastError(); grid = -1; return; }
        grid = cus;
        if (cus < 192 || (cus & 7)) { fprintf(stderr, "kernel_launch: built for a 256-CU device (the MoE unit table holds 4 units per workgroup); %d CUs: nothing launched\n", cus); grid = -1; return; }
        fprintf(stderr, "kernel_launch: grid %d (cus %d, per_cu %d)\n", grid, cus, per_cu);
    }
    if (grid < 0) return;
    (void)hipMemsetAsync((char*)d_ws + WS_CTL, 0, CTL_ZERO_BYTES, stream);
    Args a{};
    for (int i = 0; i < N_IN; ++i) a.in[i] = (const float*)d_in[i];
    a.out = (float*)d_out; a.ws = (unsigned char*)d_ws;
#if MK_ONE_LAUNCH
    a.ph_lo = 0; a.ph_hi = N_PHASES;
    void* kargs[] = {&a};
    hipError_t e = hipLaunchCooperativeKernel((const void*)fwd_kernel, dim3(grid), dim3(NTHREADS), kargs, LDS_BYTES, stream);
    if (e != hipSuccess) fprintf(stderr, "kernel_launch: cooperative launch failed: %s\n", hipGetErrorString(e));
#else
    for (int ph = 0; ph < N_PHASES; ++ph) {
        a.ph_lo = ph; a.ph_hi = ph + 1;
        hipLaunchKernelGGL(fwd_kernel, dim3(grid), dim3(NTHREADS), LDS_BYTES, stream, a);
    }
#endif
}
```

```cpp
#include <hip/hip_runtime.h>
#include <hip/hip_cooperative_groups.h>
#include <cstdio>
#include <cstdint>
namespace pg8 {
#define PG8_LAS __attribute__((address_space(3)))
typedef unsigned short bf16_t;
typedef short bf16x8 __attribute__((ext_vector_type(8)));
typedef float f32x4 __attribute__((ext_vector_type(4)));
typedef unsigned u32x4 __attribute__((ext_vector_type(4)));
typedef int v4i_ __attribute__((ext_vector_type(4)));
typedef int v8i_ __attribute__((ext_vector_type(8)));
constexpr int BM = 256, BK = 64, HALF = 128, HTB = HALF * BK * 2  , STAGE_BYTES = 8 * HTB, NXCD = 8, WGM = 8;

__host__ __device__ __forceinline__ int lds_byte(int r, int c) { const int st = (r >> 4) * 2 + (c >> 5), rr = r & 15, cc = c & 31, ob = rr * 64 + cc * 2; return st * 1024 + (ob ^ (((ob >> 9) & 1) << 5)); }
__host__ __device__ __forceinline__ void stage_rc(int b, int& R, int& C) { const int st = b / 1024, sb = b % 1024, swz = sb ^ (((sb >> 9) & 1) << 5); R = (st >> 1) * 16 + swz / 64; C = (st & 1) * 32 + (swz % 64) / 2; }
__host__ __device__ __forceinline__ int perm32(int rho) { const int n = rho >> 4, i = rho & 15; return 8 * (i >> 2) + 4 * n + (i & 3); }

struct Unit { int pm, pn; };
struct Gemm { const bf16_t* A; const bf16_t* Bt; int M, N, K; };

struct StaticOrder {
    int nM, nN, nwg, G, c;
    __host__ __device__ void init(int M, int N, int G_, int c_) { nM = M / BM; nN = N / BM; nwg = nM * nN; G = G_; c = c_; }
    __host__ __device__ bool next(int i, Unit& u) const {
        const long L = (long)i * G + c; if (L >= nwg) return false;
        int wgid = (int)L; { const int q = nwg / NXCD, r = nwg % NXCD, xcd = wgid % NXCD, off = wgid / NXCD; wgid = (xcd < r ? xcd * (q + 1) : r * (q + 1) + (xcd - r) * q) + off; }
        const int nig = WGM * nN, gid = wgid / nig, fm = gid * WGM, gsz = (nM - fm) < WGM ? (nM - fm) : WGM;
        u.pm = fm + ((wgid % nig) % gsz); u.pn = (wgid % nig) / gsz; return true;
    }
    __device__ __forceinline__ void a_ready(const Unit&) const {}
    __device__ __forceinline__ void done(const Unit&) const {}
};

__device__ __forceinline__ unsigned cvt_pk_bf16(float lo, float hi) { unsigned r; asm volatile("v_cvt_pk_bf16_f32 %0, %1, %2" : "=v"(r) : "v"(lo), "v"(hi)); return r; }
typedef float f32x2 __attribute__((ext_vector_type(2)));
template <class Epi, class Sched, bool ALIGN_EPI = false, bool SP2 = false, bool FP8 = false, bool GATHER = false, bool I8 = false>
__device__ __forceinline__ void gemm_phase(PG8_LAS unsigned char* lds, const Gemm g, const Sched& S, const Epi& E, const int wave_in) {
    const int lane = (int)__builtin_amdgcn_mbcnt_hi(~0u, __builtin_amdgcn_mbcnt_lo(~0u, 0u)), wid = wave_in, tid = wid * 64 + lane, wr = wid >> 2, wc = wid & 3, fr = lane & 15, fq = lane >> 4;
    const int K = g.K, nt = K / BK;
    unsigned voffA[2], voffB[2];
#pragma unroll
    for (int i = 0; i < 2; ++i) { int R, C; stage_rc(tid * 16 + i * 8192, R, C); const int Rb = Epi::PERM ? ((R & ~31) + perm32(R & 31)) : R;
        voffA[i] = (unsigned)(R * K + C) * 2u; voffB[i] = (unsigned)(Rb * K + C) * 2u; }
    static_assert(!GATHER || SP2, "GATHER is implemented in the SP2 loop");
    unsigned gA[2][2], ngA[2][2]; int RA[2]; unsigned CA2[2];
#pragma unroll
    for (int i = 0; i < 2; ++i) { int R, C; stage_rc(tid * 16 + i * 8192, R, C); RA[i] = R; CA2[i] = (unsigned)C * 2u; }
    auto load_g = [&](int ui_, unsigned (&dst)[2][2]) {
        if constexpr (GATHER) {
#pragma unroll
            for (int h = 0; h < 2; ++h)
#pragma unroll
                for (int i = 0; i < 2; ++i) dst[h][i] = (unsigned)S.tokl[ui_ * 256 + 128 * h + RA[i]] * (unsigned)(K * 2) + CA2[i];
        }
    };
    const size_t kstep = (size_t)(BK * 2);
    const size_t hstep = (size_t)HALF * K * 2;
    const size_t tstep = 2 * hstep;
    const size_t hstepA = GATHER ? (size_t)0 : hstep, tstepA = GATHER ? (size_t)0 : 2 * hstep;
    const unsigned ldsw = (unsigned)wid * 1024u;
    const int aoff = lds_byte(wr * 64 + fr, fq * 8), boff = lds_byte(wc * 32 + fr, fq * 8);
#define PG8_SA(b, h) (((b) * 2 + (h)) * HTB)
#define PG8_SB(b, h) ((4 + (b) * 2 + (h)) * HTB)
#define PG8_STAGE(bufoff, gbase, voff) do { _Pragma("unroll") for (int _i = 0; _i < 2; ++_i) \
        __builtin_amdgcn_global_load_lds((const unsigned*)((const char*)(gbase) + (voff)[_i]), (PG8_LAS unsigned*)(lds + (bufoff) + ldsw + _i * 8192), 16, 0, 0); } while (0)
#define PG8_STAGE_A(bufoff, gbase, gvoff) do { if constexpr (GATHER) { PG8_STAGE(bufoff, gbase, gvoff); } else { PG8_STAGE(bufoff, gbase, voffA); } } while (0)
#define PG8_LDA(dst, b, h) do { if constexpr (FP8) { _Pragma("unroll") for (int m = 0; m < 4; ++m) dst##8[m] = __builtin_shufflevector(*(const PG8_LAS v4i_*)(lds + PG8_SA(b, h) + aoff + m * 2048), *(const PG8_LAS v4i_*)(lds + PG8_SA(b, h) + aoff + m * 2048 + 1024), 0, 1, 2, 3, 4, 5, 6, 7); } \
        else { _Pragma("unroll") for (int m = 0; m < 4; ++m) _Pragma("unroll") for (int k = 0; k < 2; ++k) dst[m][k] = *(const PG8_LAS bf16x8*)(lds + PG8_SA(b, h) + aoff + m * 2048 + k * 1024); } } while (0)
#define PG8_LDB(dst, b, h) do { if constexpr (FP8) { _Pragma("unroll") for (int n = 0; n < 2; ++n) dst##8[n] = __builtin_shufflevector(*(const PG8_LAS v4i_*)(lds + PG8_SB(b, h) + boff + n * 2048), *(const PG8_LAS v4i_*)(lds + PG8_SB(b, h) + boff + n * 2048 + 1024), 0, 1, 2, 3, 4, 5, 6, 7); } \
        else { _Pragma("unroll") for (int n = 0; n < 2; ++n) _Pragma("unroll") for (int k = 0; k < 2; ++k) dst[n][k] = *(const PG8_LAS bf16x8*)(lds + PG8_SB(b, h) + boff + n * 2048 + k * 1024); } } while (0)
#define PG8_MMA(ai, bj, At, Bt) do { __builtin_amdgcn_s_setprio(1); \
        if constexpr (FP8) {   \
              \
            _Pragma("unroll") for (int m = 0; m < 4; ++m) _Pragma("unroll") for (int n = 0; n < 2; ++n) \
                asm volatile("v_mfma_scale_f32_16x16x128_f8f6f4 %0, %1, %2, %0, %3, %4 op_sel_hi:[0,0,0]" : "+v"(acc[ai][bj][m][n]) : "v"(Bt##8[n]), "v"(At##8[m]), "v"(scale_w), "v"(scale_x)); \
        } else { \
        _Pragma("unroll") for (int m = 0; m < 4; ++m) _Pragma("unroll") for (int n = 0; n < 2; ++n) _Pragma("unroll") for (int k = 0; k < 2; ++k) { \
        if constexpr (I8) acc[ai][bj][m][n] = __builtin_bit_cast(f32x4, __builtin_amdgcn_mfma_i32_16x16x64_i8(__builtin_bit_cast(v4i_, Bt[n][k]), __builtin_bit_cast(v4i_, At[m][k]), __builtin_bit_cast(v4i_, acc[ai][bj][m][n]), 0, 0, 0)); \
        else acc[ai][bj][m][n] = __builtin_amdgcn_mfma_f32_16x16x32_bf16(Bt[n][k], At[m][k], acc[ai][bj][m][n], 0, 0, 0); } } __builtin_amdgcn_s_setprio(0); } while (0)
#define PG8_WAIT_V(n) asm volatile("s_waitcnt vmcnt(" #n ")" ::: "memory")
#define PG8_WAIT_L(n) asm volatile("s_waitcnt lgkmcnt(" #n ")" ::: "memory")
#define PG8_BAR __builtin_amdgcn_s_barrier()
#define PG8_SCHED __builtin_amdgcn_sched_barrier(0)
    Unit cur, nxt; int ui = 0;
    if (!S.next(0, cur)) return;
    f32x4 acc[2][2][4][2];
#pragma unroll
    for (int a = 0; a < 2; ++a)
#pragma unroll
        for (int b = 0; b < 2; ++b)
#pragma unroll
            for (int m = 0; m < 4; ++m)
#pragma unroll
                for (int n = 0; n < 2; ++n) acc[a][b][m][n] = (f32x4){0.f, 0.f, 0.f, 0.f};
    auto xdl_settle = [&]() {
        asm volatile("s_nop 15\n\ts_nop 15" : "+v"(acc[0][0][0][0]), "+v"(acc[0][0][0][1]), "+v"(acc[0][0][1][0]), "+v"(acc[0][0][1][1]), "+v"(acc[0][0][2][0]), "+v"(acc[0][0][2][1]), "+v"(acc[0][0][3][0]), "+v"(acc[0][0][3][1]), "+v"(acc[0][1][0][0]), "+v"(acc[0][1][0][1]), "+v"(acc[0][1][1][0]), "+v"(acc[0][1][1][1]), "+v"(acc[0][1][2][0]), "+v"(acc[0][1][2][1]), "+v"(acc[0][1][3][0]), "+v"(acc[0][1][3][1]));
        asm volatile("s_nop 0" : "+v"(acc[1][0][0][0]), "+v"(acc[1][0][0][1]), "+v"(acc[1][0][1][0]), "+v"(acc[1][0][1][1]), "+v"(acc[1][0][2][0]), "+v"(acc[1][0][2][1]), "+v"(acc[1][0][3][0]), "+v"(acc[1][0][3][1]), "+v"(acc[1][1][0][0]), "+v"(acc[1][1][0][1]), "+v"(acc[1][1][1][0]), "+v"(acc[1][1][1][1]), "+v"(acc[1][1][2][0]), "+v"(acc[1][1][2][1]), "+v"(acc[1][1][3][0]), "+v"(acc[1][1][3][1]));
    };
    const int scale_w = 0x79797979, scale_x = 0x7f7f7f7f;
    bf16x8 At[4][2], B0[2][2], B1[2][2]; v8i_ At8[4], B08[2], B18[2];
    const char* cA = (const char*)g.A + (size_t)cur.pm * tstepA; const char* cB = (const char*)g.Bt + (size_t)cur.pn * tstep;
    load_g(0, gA);
    S.a_ready(cur);
    if constexpr (SP2) {
        PG8_STAGE(PG8_SB(0, 0), cB, voffB); PG8_STAGE(PG8_SB(0, 1), cB + hstep, voffB); PG8_STAGE_A(PG8_SA(0, 0), cA, gA[0]); PG8_STAGE_A(PG8_SA(0, 1), cA + hstepA, gA[1]);
        if (wr == 1) PG8_BAR;
        PG8_WAIT_V(2); PG8_BAR;
        PG8_STAGE(PG8_SB(1, 0), cB + kstep, voffB); PG8_STAGE_A(PG8_SA(1, 0), cA + kstep, gA[0]); PG8_STAGE(PG8_SB(1, 1), cB + hstep + kstep, voffB);
        PG8_WAIT_V(6); PG8_BAR;
    } else {
        PG8_STAGE(PG8_SB(0, 0), cB, voffB); PG8_STAGE(PG8_SA(0, 0), cA, voffA); PG8_STAGE(PG8_SB(0, 1), cB + hstep, voffB); PG8_STAGE(PG8_SA(0, 1), cA + hstep, voffA);
        if (wr == 1) PG8_BAR;
        PG8_WAIT_V(4); PG8_BAR;
        PG8_STAGE(PG8_SB(1, 0), cB + kstep, voffB); PG8_STAGE(PG8_SA(1, 0), cA + kstep, voffA); PG8_STAGE(PG8_SB(1, 1), cB + hstep + kstep, voffB);
        PG8_WAIT_V(6); PG8_BAR;
    }
    for (;;) {
        const bool has_next = S.next(ui + 1, nxt);
        const char* nA = has_next ? (const char*)g.A + (size_t)nxt.pm * tstepA : cA; const char* nB = has_next ? (const char*)g.Bt + (size_t)nxt.pn * tstep : cB;
        if constexpr (GATHER) { if (has_next) load_g(ui + 1, ngA); else {
#pragma unroll
            for (int h = 0; h < 2; ++h)
#pragma unroll
                for (int i = 0; i < 2; ++i) ngA[h][i] = gA[h][i]; } }
        for (int t = 0; t < nt; t += 2) {
            const bool last = (t == nt - 2);
            const char* a1 = cA + (size_t)(t + 1) * kstep;
            const char* a2 = last ? nA : cA + (size_t)(t + 2) * kstep; const char* b2 = last ? nB : cB + (size_t)(t + 2) * kstep;
            const char* a3 = a2 + kstep; const char* b3 = b2 + kstep;
            if (last && has_next) S.a_ready(nxt);
            unsigned sN[2][2];
#pragma unroll
            for (int h = 0; h < 2; ++h)
#pragma unroll
                for (int i = 0; i < 2; ++i) sN[h][i] = last ? ngA[h][i] : gA[h][i];
            if constexpr (SP2) {
            PG8_LDB(B0, 0, 0); PG8_LDB(B1, 0, 1); PG8_SCHED; PG8_LDA(At, 0, 0); PG8_STAGE_A(PG8_SA(1, 1), a1 + hstepA, gA[1]);
            PG8_WAIT_V(8); PG8_WAIT_L(0); PG8_BAR; PG8_MMA(0, 0, At, B0); PG8_MMA(0, 1, At, B1); PG8_BAR; PG8_SCHED;
            PG8_LDA(At, 0, 1); PG8_STAGE(PG8_SB(0, 0), b2, voffB); PG8_STAGE(PG8_SB(0, 1), b2 + hstep, voffB); PG8_STAGE_A(PG8_SA(0, 0), a2, sN[0]);
            PG8_WAIT_V(8); PG8_WAIT_L(0); PG8_BAR; PG8_MMA(1, 0, At, B0); PG8_MMA(1, 1, At, B1); PG8_BAR; PG8_SCHED;
            PG8_LDB(B0, 1, 0); PG8_LDB(B1, 1, 1); PG8_SCHED; PG8_LDA(At, 1, 0); PG8_STAGE_A(PG8_SA(0, 1), a2 + hstepA, sN[1]);
            PG8_WAIT_V(8); PG8_WAIT_L(0); PG8_BAR; PG8_MMA(0, 0, At, B0); PG8_MMA(0, 1, At, B1); PG8_BAR; PG8_SCHED;
            PG8_LDA(At, 1, 1); PG8_STAGE(PG8_SB(1, 0), b3, voffB); PG8_STAGE(PG8_SB(1, 1), b3 + hstep, voffB); PG8_STAGE_A(PG8_SA(1, 0), a3, sN[0]);
            PG8_WAIT_V(8); PG8_WAIT_L(0); PG8_BAR; PG8_MMA(1, 0, At, B0); PG8_MMA(1, 1, At, B1); PG8_BAR; PG8_SCHED;
            } else {
            PG8_LDB(B0, 0, 0); PG8_SCHED; PG8_LDA(At, 0, 0); PG8_STAGE(PG8_SA(1, 1), a1 + hstep, voffA);
            PG8_WAIT_L(8); PG8_BAR; PG8_WAIT_L(0); PG8_MMA(0, 0, At, B0); PG8_BAR; PG8_SCHED;
            PG8_LDB(B1, 0, 1); PG8_STAGE(PG8_SB(0, 0), b2, voffB);
            PG8_BAR; PG8_WAIT_L(0); PG8_MMA(0, 1, At, B1); PG8_BAR;
            PG8_LDA(At, 0, 1); PG8_STAGE(PG8_SA(0, 0), a2, voffA);
            PG8_BAR; PG8_WAIT_L(0); PG8_MMA(1, 0, At, B0); PG8_BAR; PG8_SCHED;
            PG8_STAGE(PG8_SB(0, 1), b2 + hstep, voffB);
            PG8_WAIT_V(6); PG8_BAR; PG8_MMA(1, 1, At, B1); PG8_BAR;
            PG8_LDB(B0, 1, 0); PG8_SCHED; PG8_LDA(At, 1, 0); PG8_STAGE(PG8_SA(0, 1), a2 + hstep, voffA);
            PG8_WAIT_L(8); PG8_BAR; PG8_WAIT_L(0); PG8_MMA(0, 0, At, B0); PG8_BAR; PG8_SCHED;
            PG8_LDB(B1, 1, 1); PG8_STAGE(PG8_SB(1, 0), b3, voffB);
            PG8_BAR; PG8_WAIT_L(0); PG8_MMA(0, 1, At, B1); PG8_BAR;
            PG8_LDA(At, 1, 1); PG8_STAGE(PG8_SA(1, 0), a3, voffA);
            PG8_BAR; PG8_WAIT_L(0); PG8_MMA(1, 0, At, B0); PG8_BAR; PG8_SCHED;
            PG8_STAGE(PG8_SB(1, 1), b3 + hstep, voffB);
            PG8_WAIT_V(6); PG8_BAR; PG8_MMA(1, 1, At, B1); PG8_BAR;
            }
            if constexpr (Epi::KHOOK) { constexpr int HK = FP8 ? 4 : 8, HS = FP8 ? 2 : 3;
                if ((((t + 2) & (HK - 1)) == 0) && (t + 2 < nt)) { if constexpr (FP8) xdl_settle(); E.khook(acc, ((t + 2) >> HS) - 1, wr, fr); if constexpr (FP8) xdl_settle(); } }
        }
        if constexpr (ALIGN_EPI) { if (wr == 0) PG8_BAR; }
        if constexpr (FP8) {
            xdl_settle();
        }
        if constexpr (!Epi::AFTER_DRAIN) { E(acc, cur, wr, wc, fr, fq); S.done(cur); }
        if (!has_next) break;
#pragma unroll
        for (int a = 0; a < 2; ++a)
#pragma unroll
            for (int b = 0; b < 2; ++b)
#pragma unroll
                for (int m = 0; m < 4; ++m)
#pragma unroll
                    for (int n = 0; n < 2; ++n) acc[a][b][m][n] = (f32x4){0.f, 0.f, 0.f, 0.f};
        cur = nxt; cA = nA; cB = nB; ++ui;
        if constexpr (GATHER) {
#pragma unroll
            for (int h = 0; h < 2; ++h)
#pragma unroll
                for (int i = 0; i < 2; ++i) gA[h][i] = ngA[h][i]; }
        if constexpr (ALIGN_EPI) { if (wr == 1) PG8_BAR; }
    }
    PG8_WAIT_V(0);
    if constexpr (!ALIGN_EPI) { if (wr == 0) PG8_BAR; }
    PG8_BAR;
    if constexpr (Epi::AFTER_DRAIN) { E.fused(acc, cur, wr, wc, fr, fq, lds, wid, lane); S.done(cur); }
#undef PG8_SA
#undef PG8_SB
#undef PG8_STAGE
#undef PG8_STAGE_A
#undef PG8_LDA
#undef PG8_LDB
#undef PG8_MMA
#undef PG8_WAIT_V
#undef PG8_WAIT_L
#undef PG8_BAR
#undef PG8_SCHED
}
}

#define DI __device__ __forceinline__
#define GAS __attribute__((address_space(1)))
#define LAS __attribute__((address_space(3)))
typedef unsigned short bf16;
typedef unsigned v4u __attribute__((ext_vector_type(4)));
typedef unsigned v2u __attribute__((ext_vector_type(2)));
typedef float f32x4 __attribute__((ext_vector_type(4)));
typedef float f32x16 __attribute__((ext_vector_type(16)));
typedef short bf16x8 __attribute__((ext_vector_type(8)));
typedef __bf16 bf2v __attribute__((ext_vector_type(2)));
typedef float f2v __attribute__((ext_vector_type(2)));
typedef GAS unsigned gu32;

constexpr int NWAVES = 8, NTHREADS = 512;
constexpr int M = 16384, D = 1024, DIN = 2048, NH = 32, HD = 64, NGRP = 4, NST = 128, XBCW = 3072;
constexpr int NPROJ = 9216, WIN_LD = 9248;
constexpr int LCH = 128, NCH = M / LCH;
constexpr int NE = 64, DFF = 512;
constexpr float EPS = 1e-6f;
constexpr float LOG2E = 1.4426950408889634f;

constexpr size_t MiB = 1u << 20;
constexpr size_t WS_CTL = 0, CTL_ZERO_BYTES = 262144;
constexpr size_t WS_WIN = 1 * MiB, WS_WDT = 19 * MiB, WS_WCV = 20 * MiB, WS_WMIX = 22 * MiB, WS_WSSM = 24 * MiB;
constexpr size_t WS_RSTD = 31 * MiB + 524288;
constexpr size_t WS_DT = 28 * MiB, WS_CD = 30 * MiB, WS_WRH = 30 * MiB + 65536, WS_WRL = WS_WRH + 262144, WS_ROUTE = 31 * MiB;
constexpr size_t WS_ST = 32 * MiB, WS_YS = 96 * MiB, WS_TMP = 160 * MiB, WS_MG = 192 * MiB;
constexpr size_t WS_W13 = 32 * MiB, WS_W2 = 160 * MiB, WS_H16 = 96 * MiB;
constexpr size_t WS_XN8 = 32 * MiB, WS_W8IN = 48 * MiB, WS_SA = 60 * MiB, WS_SW = 61 * MiB;
constexpr size_t WS_XN = 224 * MiB;
constexpr size_t WS_U = 256 * MiB, WS_ZS = 288 * MiB, WS_XBC = 352 * MiB, WS_GATE = 448 * MiB;
constexpr size_t WS_LIST = 256 * MiB, WS_HDN = 352 * MiB, WS_YEXP = 400 * MiB;
constexpr size_t WS_END = 512 * MiB;
constexpr int CW_BAR = 4096;
constexpr int CW_CNT = 8192;
constexpr int CW_MODC = 40960;
constexpr int CW_WMAX = 49152;
constexpr int CW_MOD = 16384;

constexpr int RING_BYTES = 131072;
constexpr int LDSCTL_OFF = 147456;
constexpr int TB_OFF = LDSCTL_OFF + 256;
constexpr int CNTL_OFF = TB_OFF + 320;
constexpr int TOKL_OFF = LDSCTL_OFF + 1024;
constexpr int RT_OFF = 148480;
constexpr int LDS_BYTES = 152576;

#define LDS_WAIT() asm volatile("s_waitcnt lgkmcnt(0)" ::: "memory")
#define VM_WAIT() asm volatile("s_waitcnt vmcnt(0)" ::: "memory")

DI unsigned pk2(float lo, float hi) { f2v v = {lo, hi}; return __builtin_bit_cast(unsigned, __builtin_convertvector(v, bf2v)); }
DI unsigned pk4_fp8(float a, float b, float c, float d) {
    a = __builtin_fminf(__builtin_fmaxf(a, -448.f), 448.f); b = __builtin_fminf(__builtin_fmaxf(b, -448.f), 448.f);
    c = __builtin_fminf(__builtin_fmaxf(c, -448.f), 448.f); d = __builtin_fminf(__builtin_fmaxf(d, -448.f), 448.f);
    unsigned w = 0u; w = __builtin_amdgcn_cvt_pk_fp8_f32(a, b, w, false); w = __builtin_amdgcn_cvt_pk_fp8_f32(c, d, w, true); return w; }
DI unsigned pk4_fp8_nc(float a, float b, float c, float d) { unsigned w = 0u; w = __builtin_amdgcn_cvt_pk_fp8_f32(a, b, w, false); w = __builtin_amdgcn_cvt_pk_fp8_f32(c, d, w, true); return w; }
DI unsigned pk4_i8(float a, float b, float c, float d) {
    const int ia = (int)__builtin_rintf(a), ib = (int)__builtin_rintf(b), ic = (int)__builtin_rintf(c), id = (int)__builtin_rintf(d);
    return ((unsigned)ia & 255u) | (((unsigned)ib & 255u) << 8) | (((unsigned)ic & 255u) << 16) | ((unsigned)id << 24); }
DI float bflo(unsigned u) { return __uint_as_float(u << 16); }
DI float bfhi(unsigned u) { return __uint_as_float(u & 0xffff0000u); }
DI float sigmoidf_(float x) { return __builtin_amdgcn_rcpf(1.f + __builtin_amdgcn_exp2f(x * -LOG2E)); }
DI float siluf_(float x) { return x * __builtin_amdgcn_rcpf(1.f + __builtin_amdgcn_exp2f(x * -LOG2E)); }
DI float wave_sum(float v) {
#pragma unroll
    for (int o = 1; o < 64; o <<= 1) v += __shfl_xor(v, o);
    return v;
}
DI f32x4 mod4(const float* modp, int k) { return (*(const f32x4*)(modp + k) + *(const f32x4*)(modp + 6144 + k)) + (*(const f32x4*)(modp + 2 * 6144 + k) + *(const f32x4*)(modp + 3 * 6144 + k)); }
DI int crow(int reg, int hh) { return (reg & 3) + 8 * (reg >> 2) + 4 * hh; }
DI int swz(int row, int chunk) { return chunk ^ ((row ^ (row >> 3)) & 15); }
#define MFMA32(a, b, c) __builtin_amdgcn_mfma_f32_32x32x16_bf16((a), (b), (c), 0, 0, 0)

DI int lane_id() { return (int)__builtin_amdgcn_mbcnt_hi(~0u, __builtin_amdgcn_mbcnt_lo(~0u, 0u)); }
#define XB_TMO      128
#define XB_XCNT(j)  (256  + 64 * (j))
#define XB_XSUB(j)  (1280 + 64 * (j))
#define XB_XGEN(j)  (2304 + 64 * (j))
#define XB_TOP      3328
#define XB_TOPGEN   3392
#define XCD_BAR_WORDS 3456
#define XB_SPIN_CAP (1u << 18)
DI unsigned xb_ld(unsigned* p)              { return __hip_atomic_load(p, __ATOMIC_RELAXED, __HIP_MEMORY_SCOPE_AGENT); }
DI unsigned xb_add(unsigned* p, unsigned v) { return __hip_atomic_fetch_add(p, v, __ATOMIC_RELAXED, __HIP_MEMORY_SCOPE_AGENT); }
DI unsigned xb_xcc_id() { return (unsigned)__builtin_amdgcn_s_getreg((3 << 11) | 20) & 0xFu; }
#define XB_SPIN(cond, bar) do { unsigned _sp = 0; while (cond) { __builtin_amdgcn_s_sleep(1); \
    if ((++_sp & 255u) == 0u) { if (xb_ld(&(bar)[XB_TMO])) break; if (_sp > XB_SPIN_CAP) { atomicAdd(&(bar)[XB_TMO], 1u); break; } } } } while (0)
struct XcdBarrier { unsigned* bar; unsigned x; volatile LAS unsigned* st; int wave; };
DI XcdBarrier xcd_barrier_post(unsigned* bar, volatile LAS unsigned* st) {
    XcdBarrier b; b.bar = bar; b.x = xb_xcc_id(); b.st = st; b.wave = 0;
    if (threadIdx.x == 0) (void)xb_add(&bar[XB_XCNT(b.x)], 1u);
    return b;
}
DI void xcd_barrier_complete(unsigned* bar, unsigned x, unsigned& nloc, unsigned& nx) {
    const unsigned G = gridDim.x * gridDim.y * gridDim.z;
    unsigned sum, cnt, mine, sp = 0u;
    for (;;) {
        sum = 0u; cnt = 0u; mine = 0u;
#pragma unroll
        for (unsigned j = 0; j < 16; ++j) { const unsigned c = xb_ld(&bar[XB_XCNT(j)]); sum += c; cnt += (c > 0u) ? 1u : 0u; mine = (j == x) ? c : mine; }
        if (sum == G) break;
        __builtin_amdgcn_s_sleep(1);
        if ((++sp & 255u) == 0u) { if (xb_ld(&bar[XB_TMO])) break; if (sp > XB_SPIN_CAP) { atomicAdd(&bar[XB_TMO], 1u); break; } }
    }
    nloc = mine > 0u ? mine : 1u; nx = cnt > 0u ? cnt : 1u;
}
DI void xcd_barrier(const XcdBarrier& b) {
    asm volatile("s_waitcnt vmcnt(0)" ::: "memory");
    __syncthreads();
    if (b.wave == 0 && lane_id() == 0) {
        unsigned* bar = b.bar;
        __builtin_amdgcn_s_waitcnt(0);
        unsigned nloc = b.st[0], nx = b.st[1];
        if (nloc == 0u) { xcd_barrier_complete(bar, b.x, nloc, nx); b.st[0] = nloc; b.st[1] = nx; }
        const unsigned old = xb_add(&bar[XB_XSUB(b.x)], 1u);
        const unsigned gen = old / nloc;
        if (old + 1u == (gen + 1u) * nloc) {
            __builtin_amdgcn_fence(__ATOMIC_RELEASE, "agent");
            asm volatile("s_waitcnt vmcnt(0)" ::: "memory");
            const unsigned og = xb_add(&bar[XB_TOP], 1u);
            const unsigned tg = og / nx;
            if (og + 1u == (tg + 1u) * nx) xb_add(&bar[XB_TOPGEN], 1u);
            else XB_SPIN(xb_ld(&bar[XB_TOPGEN]) == tg, bar);
            __builtin_amdgcn_fence(__ATOMIC_ACQUIRE, "agent");
            xb_add(&bar[XB_XGEN(b.x)], 1u);
            asm volatile("s_waitcnt vmcnt(0)" ::: "memory");
        } else {
            XB_SPIN(xb_ld(&bar[XB_XGEN(b.x)]) == gen, bar);
            __builtin_amdgcn_fence(__ATOMIC_ACQUIRE, "agent");
            asm volatile("s_waitcnt vmcnt(0)" ::: "memory");
        }
    }
    __syncthreads();
}

enum { I_X = 0, I_C, I_WADA, I_BADA, I_N1G, I_WIN, I_CVW, I_CVB, I_LNG, I_LNB, I_WCV, I_SCW, I_SCB, I_DTB, I_ALOG, I_DSKIP, I_SNG, I_WSSM, I_WMIX,
       I_N2G, I_WGRP, I_BGRP, I_WER, I_BER, I_W1, I_W3, I_W2, I_FG, N_IN };
struct Args { const float* in[N_IN]; float* out; unsigned char* ws; int ph_lo, ph_hi; };

template <int I> DI const float* argp() {
    auto kp = __builtin_amdgcn_kernarg_segment_ptr();
    unsigned long long v;
    asm volatile("s_load_dwordx2 %0, %1, %2\n\ts_waitcnt lgkmcnt(0)" : "=s"(v) : "s"(kp), "i"(I * 8));
    return (const float*)(const GAS float*)v;
}
#define ARG(i) argp<i>()
struct Ctx {
    LAS unsigned char* lds;
    int wave, vcu, G, xcd, xj;
    unsigned char* ws;
};

DI int xcd_unit(int x, int j, int gx, int i, int N) { const int u = i * gx + j; return (u < (N >> 3)) ? x * (N >> 3) + u : -1; }
DI int inproj_tile(int p) { return p < 8 ? p + 8 : (p < 16 ? p + 20 : (p < 24 ? p - 16 : p - 8)); }
DI int win_col(int npp) { const int np = inproj_tile(npp >> 8) * 256 + (npp & 255);
    if (np < 2048) { const int q = np >> 3, rr = np & 7; return (rr >> 2) * 1024 + 4 * q + (rr & 3); } return np < 7168 ? np : np + 32; }
struct EpiInProj {
    static constexpr bool PERM = true, AFTER_DRAIN = false, KHOOK = false; static constexpr int NPF = 0;
    unsigned char* ws;
    DI static pg8::f32x4 cvt(const pg8::f32x4& a, float sr, const f32x4& sc) { const pg8::v4i_ q = __builtin_bit_cast(pg8::v4i_, a);
        return (pg8::f32x4){(float)q[0] * (sr * sc.x), (float)q[1] * (sr * sc.y), (float)q[2] * (sr * sc.z), (float)q[3] * (sr * sc.w)}; }
    DI void operator()(const pg8::f32x4 (&acc)[2][2][4][2], const pg8::Unit& u, int wr, int wc, int fr, int fq) const {
        const int pn = inproj_tile(u.pn), row0 = u.pm * 256 + wr * 64 + fr;
        const float* SA = (const float*)(ws + WS_SA); const float* SW = (const float*)(ws + WS_SW) + u.pn * 256 + wc * 32 + fq * 8;
        f32x4 sc[2][2];
#pragma unroll
        for (int bj = 0; bj < 2; ++bj) { sc[bj][0] = *(const f32x4*)(SW + bj * 128); sc[bj][1] = *(const f32x4*)(SW + bj * 128 + 4); }
        float sr[2][4];
#pragma unroll
        for (int ai = 0; ai < 2; ++ai)
#pragma unroll
            for (int m = 0; m < 4; ++m) sr[ai][m] = SA[row0 + ai * 128 + m * 16];
        if (pn < 8) {
            bf16* U = (bf16*)(ws + WS_U);
#pragma unroll
            for (int ai = 0; ai < 2; ++ai)
#pragma unroll
                for (int m = 0; m < 4; ++m) {
                    bf16* rowp = U + (size_t)(row0 + ai * 128 + m * 16) * D + pn * 128 + wc * 16 + fq * 4;
#pragma unroll
                    for (int bj = 0; bj < 2; ++bj) { const pg8::f32x4 a = cvt(acc[ai][bj][m][0], sr[ai][m], sc[bj][0]), b = cvt(acc[ai][bj][m][1], sr[ai][m], sc[bj][1]);
                        v2u w; w.x = pk2(a[0] * sigmoidf_(b[0]), a[1] * sigmoidf_(b[1])); w.y = pk2(a[2] * sigmoidf_(b[2]), a[3] * sigmoidf_(b[3]));
                        *(v2u*)(rowp + bj * 64) = w; } }
        } else {
            const bool isz = pn < 16, isx = (pn >= 16) && (pn < 28);
            const size_t boff = isz ? WS_ZS : (isx ? WS_XBC : WS_GATE);
            const int ldc = isx ? XBCW : DIN;
            const int colt = (pn - (isz ? 8 : (isx ? 16 : 28))) * 256;
            bf16* base = (bf16*)(ws + boff);
            const int col0 = colt + wc * 32 + fq * 8;
#pragma unroll
            for (int ai = 0; ai < 2; ++ai)
#pragma unroll
                for (int m = 0; m < 4; ++m) {
                    bf16* rowp = base + (size_t)(row0 + ai * 128 + m * 16) * ldc + col0;
#pragma unroll
                    for (int bj = 0; bj < 2; ++bj) { pg8::f32x4 v0 = cvt(acc[ai][bj][m][0], sr[ai][m], sc[bj][0]), v1 = cvt(acc[ai][bj][m][1], sr[ai][m], sc[bj][1]);
                        if (!isx) {
#pragma unroll
                            for (int i = 0; i < 4; ++i) { const float s0 = sigmoidf_(v0[i]), s1 = sigmoidf_(v1[i]); v0[i] = isz ? v0[i] * s0 : s0; v1[i] = isz ? v1[i] * s1 : s1; }
                        }
                        v4u w; w.x = pk2(v0[0], v0[1]); w.y = pk2(v0[2], v0[3]); w.z = pk2(v1[0], v1[1]); w.w = pk2(v1[2], v1[3]);
                        *(v4u*)(rowp + bj * 128) = w; } }
        }
    }
};
template <bool NORM> struct EpiGate {
    static constexpr bool PERM = true, AFTER_DRAIN = false, KHOOK = NORM;
    bf16* O; const bf16* P; const bf16* GATE; int gcol; const LAS float* rt;
    DI void khook(pg8::f32x4 (&acc)[2][2][4][2], int b, int wr, int fr) const {
#pragma unroll
        for (int ai = 0; ai < 2; ++ai)
#pragma unroll
            for (int m = 0; m < 4; ++m) { const float f = rt[(ai * 128 + wr * 64 + m * 16 + fr) * 4 + b];
#pragma unroll
                for (int bj = 0; bj < 2; ++bj)
#pragma unroll
                    for (int n = 0; n < 2; ++n) acc[ai][bj][m][n] = acc[ai][bj][m][n] * f; }
    }
    DI void operator()(const pg8::f32x4 (&acc)[2][2][4][2], const pg8::Unit& u, int wr, int wc, int fr, int fq) const {
        const int row0 = u.pm * 256 + wr * 64 + fr, col0 = u.pn * 256 + wc * 32 + fq * 8;
        v4u g[4], p[4], wA[4], wB[4];
        auto loadq = [&](int bj, int ai) {
#pragma unroll
            for (int m = 0; m < 4; ++m) { const size_t r = (size_t)(row0 + ai * 128 + m * 16); const int c = col0 + bj * 128;
                g[m] = *(const v4u*)(GATE + r * (2 * D) + gcol + c); if (NORM) p[m] = *(const v4u*)(P + r * D + c); }
        };
        auto calcq = [&](int bj, int ai, v4u (&w)[4]) {
#pragma unroll
            for (int m = 0; m < 4; ++m) {
                float f = 1.0f; if (NORM) f = rt[(ai * 128 + wr * 64 + m * 16 + fr) * 4 + 3];
                const v4u gg = g[m];
                pg8::f32x4 v0 = acc[ai][bj][m][0] * f, v1 = acc[ai][bj][m][1] * f;
                float o[8] = {v0[0] * bflo(gg.x), v0[1] * bfhi(gg.x), v0[2] * bflo(gg.y), v0[3] * bfhi(gg.y), v1[0] * bflo(gg.z), v1[1] * bfhi(gg.z), v1[2] * bflo(gg.w), v1[3] * bfhi(gg.w)};
                if (NORM) { const v4u pp = p[m];
                    o[0] += bflo(pp.x); o[1] += bfhi(pp.x); o[2] += bflo(pp.y); o[3] += bfhi(pp.y); o[4] += bflo(pp.z); o[5] += bfhi(pp.z); o[6] += bflo(pp.w); o[7] += bfhi(pp.w); }
                w[m].x = pk2(o[0], o[1]); w[m].y = pk2(o[2], o[3]); w[m].z = pk2(o[4], o[5]); w[m].w = pk2(o[6], o[7]); }
        };
        auto storeq = [&](int bj, int ai, const v4u (&w)[4]) {
#pragma unroll
            for (int m = 0; m < 4; ++m) *(v4u*)(O + (size_t)(row0 + ai * 128 + m * 16) * D + col0 + bj * 128) = w[m];
        };
        loadq(0, 0); calcq(0, 0, wA); loadq(0, 1); storeq(0, 0, wA); calcq(0, 1, wB); loadq(1, 0); storeq(0, 1, wB); calcq(1, 0, wA); loadq(1, 1); storeq(1, 0, wA); calcq(1, 1, wB); storeq(1, 1, wB);
    }
};
struct EpiMix {
    static constexpr bool PERM = true, AFTER_DRAIN = false, KHOOK = false;
    bf16* H; const float* X; const float* g1;
    DI void operator()(const pg8::f32x4 (&acc)[2][2][4][2], const pg8::Unit& u, int wr, int wc, int fr, int fq) const {
        const int row0 = u.pm * 256 + wr * 64 + fr, col0 = u.pn * 256 + wc * 32 + fq * 8;
        f32x4 xa[4], xb[4]; v4u wA[4], wB[4];
        auto loadq = [&](int bj, int ai) {
#pragma unroll
            for (int m = 0; m < 4; ++m) { const size_t off = (size_t)(row0 + ai * 128 + m * 16) * D + col0 + bj * 128;
                xa[m] = __builtin_nontemporal_load((const f32x4*)(X + off)); xb[m] = __builtin_nontemporal_load((const f32x4*)(X + off + 4)); }
        };
        auto calcq = [&](int bj, int ai, v4u (&w)[4]) { const int c = col0 + bj * 128;
            const f32x4 ga = *(const f32x4*)(g1 + c), gb = *(const f32x4*)(g1 + c + 4);
#pragma unroll
            for (int m = 0; m < 4; ++m) { const f32x4 ha = xa[m] + ga * acc[ai][bj][m][0], hb = xb[m] + gb * acc[ai][bj][m][1];
                w[m].x = pk2(ha.x, ha.y); w[m].y = pk2(ha.z, ha.w); w[m].z = pk2(hb.x, hb.y); w[m].w = pk2(hb.z, hb.w); }
        };
        auto storeq = [&](int bj, int ai, const v4u (&w)[4]) {
#pragma unroll
            for (int m = 0; m < 4; ++m) *(v4u*)(H + (size_t)(row0 + ai * 128 + m * 16) * D + col0 + bj * 128) = w[m];
        };
        loadq(0, 0); calcq(0, 0, wA); loadq(0, 1); storeq(0, 0, wA); calcq(0, 1, wB); loadq(1, 0); storeq(0, 1, wB); calcq(1, 0, wA); loadq(1, 1); storeq(1, 0, wA); calcq(1, 1, wB); storeq(1, 1, wB);
    }
};
struct EpiUp {
    static constexpr bool PERM = true, AFTER_DRAIN = false, KHOOK = false;
    unsigned char* HDN;
    DI void operator()(const pg8::f32x4 (&acc)[2][2][4][2], const pg8::Unit& u, int wr, int wc, int fr, int fq) const {
        const int j = u.pn & 3, row0 = u.pm * 256 + wr * 64 + fr, col0 = j * 128 + wc * 16 + fq * 4;
#pragma unroll
        for (int ai = 0; ai < 2; ++ai)
#pragma unroll
            for (int m = 0; m < 4; ++m) { unsigned char* rowp = HDN + (size_t)(row0 + ai * 128 + m * 16) * DFF + col0;
#pragma unroll
                for (int bj = 0; bj < 2; ++bj) { const pg8::f32x4 a = acc[ai][bj][m][0], b = acc[ai][bj][m][1];
                    *(unsigned*)(rowp + bj * 64) = pk4_fp8(siluf_(a[0]) * b[0], siluf_(a[1]) * b[1], siluf_(a[2]) * b[2], siluf_(a[3]) * b[3]); } }
    }
};
struct EpiDown {
    static constexpr bool PERM = true, AFTER_DRAIN = false, KHOOK = false;
    unsigned char* Y;
    DI void operator()(const pg8::f32x4 (&acc)[2][2][4][2], const pg8::Unit& u, int wr, int wc, int fr, int fq) const {
        const int j = u.pn & 3, row0 = u.pm * 256 + wr * 64 + fr, col0 = j * 256 + wc * 32 + fq * 8;
#pragma unroll
        for (int ai = 0; ai < 2; ++ai)
#pragma unroll
            for (int m = 0; m < 4; ++m) { unsigned char* rowp = Y + (size_t)(row0 + ai * 128 + m * 16) * D + col0;
#pragma unroll
                for (int bj = 0; bj < 2; ++bj) { const pg8::f32x4 v0 = acc[ai][bj][m][0] * 16.0f, v1 = acc[ai][bj][m][1] * 16.0f;
                    v2u w; w.x = pk4_fp8(v0[0], v0[1], v0[2], v0[3]); w.y = pk4_fp8(v1[0], v1[1], v1[2], v1[3]);
                    *(v2u*)(rowp + bj * 128) = w; } }
    }
};
struct MoeOrder {
    const LAS int* tb; int G, c, total, reps; const LAS int* tokl;
    DI bool next(int i0, pg8::Unit& u) const {
        const int n = (total - c + G - 1) / G; if (n <= 0 || i0 >= n * reps) return false;
        const int i = i0 % n; const int uu = i * G + c;
        const int T = uu >> 2; int e = 0;
        while (e < NE - 1 && tb[e + 1] <= T) ++e;
        u.pm = T; u.pn = 4 * e + (uu & 3); return true;
    }
    DI void a_ready(const pg8::Unit&) const {}
    DI void done(const pg8::Unit&) const {}
};

struct OneUnit { pg8::Unit u;
    DI bool next(int i, pg8::Unit& o) const { if (i != 0) return false; o = u; return true; }
    DI void a_ready(const pg8::Unit&) const {}
    DI void done(const pg8::Unit&) const {} };

template <class SrcF>
DI void transpose_item(SrcF src, int K, bf16* WT, LAS float* scr, int kb, int n0, int lane) {
    const int k0 = 64 * kb;
#pragma unroll 8
    for (int i = 0; i < 32; ++i) { const int kk = 2 * i + (lane >> 5); scr[kk * 33 + (lane & 31)] = src(k0 + kk, n0 + (lane & 31)); }
    LDS_WAIT(); asm volatile("" ::: "memory");
    const int c = lane & 7;
#pragma unroll
    for (int j = 0; j < 4; ++j) { const int n = (lane >> 3) + 8 * j; const LAS float* s = scr + (8 * c) * 33 + n;
        v4u o; o.x = pk2(s[0 * 33], s[1 * 33]); o.y = pk2(s[2 * 33], s[3 * 33]); o.z = pk2(s[4 * 33], s[5 * 33]); o.w = pk2(s[6 * 33], s[7 * 33]);
        *(v4u*)(WT + (size_t)(n0 + n) * K + k0 + 8 * c) = o; }
    LDS_WAIT(); asm volatile("" ::: "memory");
}

template <class SrcF>
DI void transpose_item8(SrcF src, int K, unsigned char* WT, LAS float* scr, int kb, int n0, int lane) {
    const int k0 = 64 * kb;
#pragma unroll 8
    for (int i = 0; i < 32; ++i) { const int kk = 2 * i + (lane >> 5); scr[kk * 33 + (lane & 31)] = src(k0 + kk, n0 + (lane & 31)) * 64.0f; }
    LDS_WAIT(); asm volatile("" ::: "memory");
#pragma unroll
    for (int i = 0; i < 2; ++i) { const int p = lane + 64 * i, n = p >> 2, c = p & 3; const LAS float* s = scr + (16 * c) * 33 + n;
        v4u o; o.x = pk4_fp8(s[0 * 33], s[1 * 33], s[2 * 33], s[3 * 33]); o.y = pk4_fp8(s[4 * 33], s[5 * 33], s[6 * 33], s[7 * 33]);
        o.z = pk4_fp8(s[8 * 33], s[9 * 33], s[10 * 33], s[11 * 33]); o.w = pk4_fp8(s[12 * 33], s[13 * 33], s[14 * 33], s[15 * 33]);
        *(v4u*)(WT + (size_t)(n0 + n) * K + k0 + 16 * c) = o; }
    LDS_WAIT(); asm volatile("" ::: "memory");
}

template <class SrcF>
DI void transpose_item_i8(SrcF src, float inv, int K, unsigned char* WT, LAS float* scr, int kb, int n0, int lane) {
    const int k0 = 64 * kb;
#pragma unroll 8
    for (int i = 0; i < 32; ++i) { const int kk = 2 * i + (lane >> 5); scr[kk * 33 + (lane & 31)] = src(k0 + kk, n0 + (lane & 31)) * inv; }
    LDS_WAIT(); asm volatile("" ::: "memory");
#pragma unroll
    for (int i = 0; i < 2; ++i) { const int p = lane + 64 * i, n = p >> 2, c = p & 3; const LAS float* s = scr + (16 * c) * 33 + n;
        v4u o; o.x = pk4_i8(s[0 * 33], s[1 * 33], s[2 * 33], s[3 * 33]); o.y = pk4_i8(s[4 * 33], s[5 * 33], s[6 * 33], s[7 * 33]);
        o.z = pk4_i8(s[8 * 33], s[9 * 33], s[10 * 33], s[11 * 33]); o.w = pk4_i8(s[12 * 33], s[13 * 33], s[14 * 33], s[15 * 33]);
        *(v4u*)(WT + (size_t)(n0 + n) * K + k0 + 16 * c) = o; }
    LDS_WAIT(); asm volatile("" ::: "memory");
}

DI void ph0_prologue(const Ctx& F, const Args& a, int reps) {
    const int gw = F.vcu * NWAVES + F.wave, NGW = F.G * NWAVES, lane = lane_id();
    float* mod = (float*)(F.ws + WS_CTL) + CW_MOD;
    {
        const float* cvec = ARG(I_C); const float* wada = ARG(I_WADA); const float* bada = ARG(I_BADA);
        const int r8 = lane >> 3, c4 = lane & 7;
        for (int item0 = gw; item0 < 768 * reps; item0 += NGW) {
            const int item = item0 % 768; const int cc = item % 192, kq = item / 192;
            f32x4 acc = {0.f, 0.f, 0.f, 0.f};
#pragma unroll 8
            for (int i = 0; i < 32; ++i) { const int k = kq * 256 + i * 8 + r8; const float cv = cvec[k]; const float s = siluf_(cv);
                const f32x4 w = *(const f32x4*)(wada + (size_t)k * (6 * D) + cc * 32 + c4 * 4); acc += s * w; }
#pragma unroll
            for (int j = 0; j < 4; ++j) { float v = acc[j]; v += __shfl_xor(v, 8); v += __shfl_xor(v, 16); v += __shfl_xor(v, 32); acc[j] = v; }
            if (lane < 8) {
#pragma unroll
                for (int j = 0; j < 4; ++j) { float v = acc[j]; if (kq == 0) v += bada[cc * 32 + c4 * 4 + j]; mod[kq * 6144 + cc * 32 + c4 * 4 + j] = v; }
            }
        }
    }
    LAS float* scr = (LAS float*)(F.lds + F.wave * 16384);
    const float* win = ARG(I_WIN); const float* wcv = ARG(I_WCV); const float* wmix = ARG(I_WMIX); const float* wssm = ARG(I_WSSM);
    bf16* Win_t = (bf16*)(F.ws + WS_WIN); bf16* Wdt_t = (bf16*)(F.ws + WS_WDT); bf16* Wcv_t = (bf16*)(F.ws + WS_WCV);
    bf16* Wmix_t = (bf16*)(F.ws + WS_WMIX); bf16* Wssm_t = (bf16*)(F.ws + WS_WSSM);
    constexpr int I_IN = 16 * 288, I_DT = 16, I_CV = 16 * 32, I_MX = 16 * 32, I_SS = 32 * 32, I_RT = 16 * 3 * 2;
    constexpr int NITEMS = I_IN + I_DT + I_CV + I_MX + I_SS + I_RT;
    const float* wer = ARG(I_WER); const float* wgrp = ARG(I_WGRP); const float* sng0 = ARG(I_SNG);
    for (int it0 = gw; it0 < NITEMS * reps; it0 += NGW) {
        int r = it0 % NITEMS;
        if (r < I_IN) { const int kb = r / 288, nb = r % 288;
            const int npp = nb * 32 + (lane & 31), col = win_col(npp);
            float mx = 0.f;
#pragma unroll 8
            for (int i = 0; i < 32; ++i) mx = __builtin_fmaxf(mx, __builtin_fabsf(win[(size_t)(64 * kb + 2 * i + (lane >> 5)) * WIN_LD + col]));
            mx = __builtin_fmaxf(mx, __shfl_xor(mx, 32));
            if (lane < 32) atomicMax((unsigned*)(F.ws + WS_CTL) + CW_WMAX + npp, __float_as_uint(mx));
            continue; } r -= I_IN;
        if (r < I_DT) { transpose_item([&](int k, int np) -> float { return win[(size_t)k * WIN_LD + 7168 + np]; }, D, Wdt_t, scr, r, 0, lane); continue; } r -= I_DT;
        if (r < I_CV) { transpose_item([&](int k, int np) -> float { return wcv[(size_t)k * D + np]; }, D, Wcv_t, scr, r / 32, (r % 32) * 32, lane); continue; } r -= I_CV;
        if (r < I_MX) { transpose_item([&](int k, int np) -> float { return wmix[(size_t)k * D + np]; }, D, Wmix_t, scr, r / 32, (r % 32) * 32, lane); continue; } r -= I_MX;
        if (r < I_SS) { transpose_item8([&](int k, int np) -> float { return wssm[(size_t)k * D + np] * sng0[k]; }, DIN, (unsigned char*)Wssm_t, scr, r / 32, (r % 32) * 32, lane); continue; } r -= I_SS;
        {
            const int lo = r / 48, rr = r % 48, kb = rr / 3, nb = rr % 3;
            auto wsrc = [&](int k, int np) -> float { float w = 0.f; if (np < 64) w = wer[(size_t)k * NE + np]; else if (np < 72) w = wgrp[(size_t)k * 8 + (np - 64)];
                const float hi = bflo(pk2(w, 0.f)); return lo ? (w - hi) : hi; };
            transpose_item(wsrc, D, (bf16*)(F.ws + (lo ? WS_WRL : WS_WRH)), scr, kb, nb * 32, lane);
        }
    }
}

DI void convert_experts(const Ctx& F, const Args& a) {
    const int gw = F.vcu * NWAVES + F.wave, NGW = F.G * NWAVES, lane = lane_id();
    LAS float* scr = (LAS float*)(F.lds + F.wave * 17408);
    const float* w1 = ARG(I_W1); const float* w3 = ARG(I_W3); const float* w2 = ARG(I_W2);
    unsigned char* W13_t = F.ws + WS_W13; unsigned char* W2_t = F.ws + WS_W2;
    constexpr int I_13 = NE * 4 * 16, I_2 = NE * 2 * 16, NIT = I_13 + I_2;
    const int ch = lane & 15, kq = lane >> 4;
    for (int it = gw; it < NIT; it += NGW) {
        const float* src; size_t ld; unsigned char* dst;
        if (it < I_13) { const int e = it >> 6, r = it & 63, kb = r >> 4, cb = r & 15;
            src = ((ch & 1) ? w3 : w1) + (size_t)e * D * DFF + (size_t)(256 * kb + kq) * DFF + 32 * cb + 4 * (ch >> 1); ld = DFF;
            dst = W13_t + (size_t)e * D * D + (size_t)(64 * cb + lane) * D + 256 * kb;
        } else { const int r0 = it - I_13, e = r0 >> 5, r = r0 & 31, kb = r >> 4, nb = r & 15;
            src = w2 + (size_t)e * DFF * D + (size_t)(256 * kb + kq) * D + 64 * nb + 4 * ch; ld = D;
            dst = W2_t + (size_t)e * D * DFF + (size_t)(64 * nb + lane) * DFF + 256 * kb;
        }
        f32x4 va[16], vb[16]; v4u o[16];
#pragma unroll
        for (int i = 0; i < 16; ++i) va[i] = __builtin_nontemporal_load((const f32x4*)(src + (size_t)(4 * i) * ld));
#pragma unroll
        for (int sub = 0; sub < 4; ++sub) {
            f32x4 (&cur)[16] = (sub & 1) ? vb : va; f32x4 (&nxt)[16] = (sub & 1) ? va : vb;
            if (sub < 3) {
#pragma unroll
                for (int i = 0; i < 16; ++i) nxt[i] = __builtin_nontemporal_load((const f32x4*)(src + (size_t)(64 * (sub + 1) + 4 * i) * ld));
            }
#pragma unroll
            for (int i = 0; i < 16; ++i) *(LAS f32x4*)(scr + (4 * i + kq) * 68 + 4 * ch) = cur[i] * 64.0f;
            LDS_WAIT(); asm volatile("" ::: "memory");
#pragma unroll
            for (int j = 0; j < 4; ++j) {
                unsigned w[4];
#pragma unroll
                for (int q = 0; q < 4; ++q) { const LAS float* sp = scr + (16 * j + 4 * q) * 68 + lane; w[q] = pk4_fp8(sp[0], sp[68], sp[136], sp[204]); }
                o[4 * sub + j].x = w[0]; o[4 * sub + j].y = w[1]; o[4 * sub + j].z = w[2]; o[4 * sub + j].w = w[3];
            }
            LDS_WAIT(); asm volatile("" ::: "memory");
        }
#pragma unroll
        for (int j = 0; j < 16; ++j) *(v4u*)(dst + 16 * j) = o[j];
    }
}

DI void ph1_norm_dt(const Ctx& F, const Args& a) {
    const float* mod = (const float*)(F.ws + WS_CTL) + CW_MOD;
    const float* x = ARG(I_X); const float* n1g = ARG(I_N1G); const float* dtb = ARG(I_DTB);
    bf16* XN = (bf16*)(F.ws + WS_XN); const bf16* Wdt_t = (const bf16*)(F.ws + WS_WDT); float* DT = (float*)(F.ws + WS_DT);
    const int lane = lane_id(), wave = F.wave;
    f32x4 gm[4], ga[4];
#pragma unroll
    for (int j = 0; j < 4; ++j) { const int k = 256 * j + 4 * lane; const f32x4 g = *(const f32x4*)(n1g + k), sc = mod4(mod, 1024 + k);
        gm[j] = g * (sc + 1.0f); ga[j] = mod4(mod, k); }
    if (F.vcu == 0) { float* modc = (float*)(F.ws + WS_CTL) + CW_MODC; for (int k = (F.wave * 64 + lane_id()) * 4; k < 6 * D; k += NTHREADS * 4) *(f32x4*)(modc + k) = mod4(mod, k); }
    for (int unit = F.vcu; unit < M / 64; unit += F.G) {
        const int row0 = unit * 64;
#pragma unroll 1
        for (int rh = 0; rh < 2; ++rh) {
            f32x4 v[4][4];
#pragma unroll
            for (int rr = 0; rr < 4; ++rr)
#pragma unroll
                for (int j = 0; j < 4; ++j) v[rr][j] = __builtin_nontemporal_load((const f32x4*)(x + (size_t)(row0 + wave * 8 + rh * 4 + rr) * D + 256 * j + 4 * lane));
#pragma unroll
            for (int rr = 0; rr < 4; ++rr) {
                const int rl = wave * 8 + rh * 4 + rr, row = row0 + rl; float ss = 0.f;
#pragma unroll
                for (int j = 0; j < 4; ++j) ss += (v[rr][j].x * v[rr][j].x + v[rr][j].y * v[rr][j].y) + (v[rr][j].z * v[rr][j].z + v[rr][j].w * v[rr][j].w);
                const float rstd = 1.0f / sqrtf(wave_sum(ss) * (1.0f / D) + EPS);
                float am = 0.f;
#pragma unroll
                for (int j = 0; j < 4; ++j) { const f32x4 n = v[rr][j] * rstd * gm[j] + ga[j]; v[rr][j] = n;
                    am = __builtin_fmaxf(__builtin_fmaxf(am, __builtin_fmaxf(__builtin_fabsf(n.x), __builtin_fabsf(n.y))), __builtin_fmaxf(__builtin_fabsf(n.z), __builtin_fabsf(n.w)));
                    v2u w; w.x = pk2(n.x, n.y); w.y = pk2(n.z, n.w);
                    const int chunk = (32 * j + (lane >> 1)) ^ (rl & 15);
                    *(LAS v2u*)(F.lds + rl * 2048 + chunk * 16 + 8 * (lane & 1)) = w; }
#pragma unroll
                for (int o = 1; o < 64; o <<= 1) am = __builtin_fmaxf(am, __shfl_xor(am, o));
                const float inv = am > 0.f ? 127.0f / am : 0.f;
#pragma unroll
                for (int j = 0; j < 4; ++j) *(unsigned*)(F.ws + WS_XN8 + (size_t)row * D + 256 * j + 4 * lane) = pk4_i8(v[rr][j].x * inv, v[rr][j].y * inv, v[rr][j].z * inv, v[rr][j].w * inv);
                if (lane == 0) ((float*)(F.ws + WS_SA))[row] = am * (1.0f / 127.0f);
            }
        }
        __syncthreads();
        {
            const int rt = wave & 3, ct = wave >> 2, fr = lane & 15, fq = lane >> 4;
            pg8::f32x4 acc = {0.f, 0.f, 0.f, 0.f};
            const bf16* wrow = Wdt_t + (size_t)(16 * ct + fr) * D + 8 * fq;
#pragma unroll 4
            for (int ks = 0; ks < 32; ++ks) {
                const bf16x8 av = *(const LAS bf16x8*)(F.lds + (16 * rt + fr) * 2048 + (((4 * ks + fq) ^ fr) * 16));
                const bf16x8 bv = *(const bf16x8*)(wrow + 32 * ks);
                acc = __builtin_amdgcn_mfma_f32_16x16x32_bf16(av, bv, acc, 0, 0, 0);
            }
            const float bias = dtb[16 * ct + fr];
#pragma unroll
            for (int r = 0; r < 4; ++r) { const float v = acc[r] + bias; const float sp = v > 20.f ? v : log1pf(__expf(v));
                DT[(size_t)(row0 + 16 * rt + 4 * fq + r) * NH + 16 * ct + fr] = sp; }
        }
        __syncthreads();
    }
    {
        const float* win = ARG(I_WIN); const unsigned* wmax = (const unsigned*)(F.ws + WS_CTL) + CW_WMAX;
        const int gw = F.vcu * NWAVES + F.wave, NGW = F.G * NWAVES;
        LAS float* scr = (LAS float*)(F.lds + F.wave * 16384);
        for (int r = gw; r < 16 * 288; r += NGW) { const int kb = r / 288, nb = r % 288;
            const int npp = nb * 32 + (lane & 31), col = win_col(npp);
            const float mx = __uint_as_float(wmax[npp]); const float inv = mx > 0.f ? 127.0f / mx : 0.f;
            if (kb == 0 && lane < 32) ((float*)(F.ws + WS_SW))[npp] = mx * (1.0f / 127.0f);
            transpose_item_i8([&](int k, int) -> float { return win[(size_t)k * WIN_LD + col]; }, inv, D, F.ws + WS_W8IN, scr, kb, nb * 32, lane);
        }
    }
}

DI void ph3_convbranch(const Ctx& F, const Args& a, int reps) {
    const bf16* U = (const bf16*)(F.ws + WS_U); bf16* UC = (bf16*)(F.ws + WS_XN);
    const float* cw = ARG(I_CVW); const float* cb = ARG(I_CVB); const float* lg = ARG(I_LNG); const float* lb = ARG(I_LNB);
    const int tid = F.wave * 64 + lane_id(), lane = lane_id(), wave = F.wave;
    LAS unsigned char* tile = F.lds;
    LAS float* red = (LAS float*)(F.lds + 62 * 2048);
    LAS float* stat = red + 32 * 8 * 2;
    f2v w[31];
#pragma unroll
    for (int j = 0; j < 31; ++j) w[j] = *(const f2v*)(cw + j * D + 2 * tid);
    const f2v bias = *(const f2v*)(cb + 2 * tid), gam = *(const f2v*)(lg + 2 * tid), bet = *(const f2v*)(lb + 2 * tid);
    const int RU = (M / 32 + F.G - 1) / F.G;
    for (int it = 0; it < RU * reps; ++it) {
        const int unit = xcd_unit(F.xcd, F.xj, F.G >> 3, (it >= RU ? it - RU : it), M / 32); if (unit < 0) break; const int t0 = unit * 32;
        for (int piece = tid; piece < 62 * 128; piece += NTHREADS) { const int r = piece >> 7, cch = piece & 127, t = t0 - 30 + r;
            v4u v = {0u, 0u, 0u, 0u}; if (t >= 0) v = *(const v4u*)(U + (size_t)t * D + cch * 8);
            *(LAS v4u*)(tile + r * 2048 + cch * 16) = v; }
        __syncthreads();
        f2v o[32];
#pragma unroll
        for (int tg = 0; tg < 8; ++tg) {
            f2v acc[4];
#pragma unroll
            for (int i = 0; i < 4; ++i) acc[i] = bias;
#pragma unroll
            for (int j = 0; j < 34; ++j) {
                const unsigned uu = *(const LAS unsigned*)(tile + (4 * tg + j) * 2048 + tid * 4);
                const f2v u2 = {bflo(uu), bfhi(uu)};
#pragma unroll
                for (int i = 0; i < 4; ++i) { const int jj = j - i; if (jj >= 0 && jj <= 30) acc[i] = __builtin_elementwise_fma(w[jj], u2, acc[i]); }
            }
#pragma unroll
            for (int i = 0; i < 4; ++i) o[4 * tg + i] = acc[i];
        }
        {
            float r5[64];
#pragma unroll
            for (int tk = 0; tk < 32; ++tk) { r5[2 * tk] = o[tk].x + o[tk].y; r5[2 * tk + 1] = o[tk].x * o[tk].x + o[tk].y * o[tk].y; }
            float r4[32], r3[16], r2[8], r1[4], r0[2];
            { const bool up = (lane & 32) != 0;
#pragma unroll
              for (int i = 0; i < 32; ++i) { const float keep = up ? r5[i + 32] : r5[i], send = up ? r5[i] : r5[i + 32]; r4[i] = keep + __shfl_xor(send, 32); } }
            { const bool up = (lane & 16) != 0;
#pragma unroll
              for (int i = 0; i < 16; ++i) { const float keep = up ? r4[i + 16] : r4[i], send = up ? r4[i] : r4[i + 16]; r3[i] = keep + __shfl_xor(send, 16); } }
            { const bool up = (lane & 8) != 0;
#pragma unroll
              for (int i = 0; i < 8; ++i) { const float keep = up ? r3[i + 8] : r3[i], send = up ? r3[i] : r3[i + 8]; r2[i] = keep + __shfl_xor(send, 8); } }
            { const bool up = (lane & 4) != 0;
#pragma unroll
              for (int i = 0; i < 4; ++i) { const float keep = up ? r2[i + 4] : r2[i], send = up ? r2[i] : r2[i + 4]; r1[i] = keep + __shfl_xor(send, 4); } }
            { const bool up = (lane & 2) != 0;
#pragma unroll
              for (int i = 0; i < 2; ++i) { const float keep = up ? r1[i + 2] : r1[i], send = up ? r1[i] : r1[i + 2]; r0[i] = keep + __shfl_xor(send, 2); } }
            const bool up0 = (lane & 1) != 0;
            const float tot = (up0 ? r0[1] : r0[0]) + __shfl_xor(up0 ? r0[0] : r0[1], 1);
            red[((lane >> 1) * 8 + wave) * 2 + (lane & 1)] = tot;
        }
        __syncthreads();
        if (tid < 32) { float s = 0.f, q = 0.f;
#pragma unroll
            for (int wv = 0; wv < 8; ++wv) { s += red[(tid * 8 + wv) * 2]; q += red[(tid * 8 + wv) * 2 + 1]; }
            const float mean = s * (1.0f / D); const float var = fmaxf(q * (1.0f / D) - mean * mean, 0.f);
            stat[tid * 2] = mean; stat[tid * 2 + 1] = 1.0f / sqrtf(var + EPS); }
        __syncthreads();
#pragma unroll
        for (int tk = 0; tk < 32; ++tk) { const float mean = stat[tk * 2], rstd = stat[tk * 2 + 1];
            const float y0 = (o[tk].x - mean) * rstd * gam.x + bet.x, y1 = (o[tk].y - mean) * rstd * gam.y + bet.y;
            *(unsigned*)(UC + (size_t)(t0 + tk) * D + 2 * tid) = pk2(siluf_(y0), siluf_(y1)); }
        __syncthreads();
    }
}

DI void conv_block(const bf16* XBC, const float* cw, const float* cb, int t_first, int col, float (&o)[8][8]) {
    v4u raw[11];
#pragma unroll
    for (int r = 0; r < 11; ++r) { const int t = t_first - 3 + r; const int tc = t < 0 ? 0 : t; v4u v = *(const v4u*)(XBC + (size_t)tc * XBCW + col);
        const unsigned msk = t < 0 ? 0u : 0xffffffffu; v.x &= msk; v.y &= msk; v.z &= msk; v.w &= msk; raw[r] = v; }
    float w[4][8], b[8];
#pragma unroll
    for (int j = 0; j < 4; ++j) { const f32x4 lo = *(const f32x4*)(cw + j * XBCW + col), hi = *(const f32x4*)(cw + j * XBCW + col + 4);
        w[j][0] = lo.x; w[j][1] = lo.y; w[j][2] = lo.z; w[j][3] = lo.w; w[j][4] = hi.x; w[j][5] = hi.y; w[j][6] = hi.z; w[j][7] = hi.w; }
    { const f32x4 lo = *(const f32x4*)(cb + col), hi = *(const f32x4*)(cb + col + 4); b[0] = lo.x; b[1] = lo.y; b[2] = lo.z; b[3] = lo.w; b[4] = hi.x; b[5] = hi.y; b[6] = hi.z; b[7] = hi.w; }
#pragma unroll
    for (int tk = 0; tk < 8; ++tk)
#pragma unroll
        for (int ch = 0; ch < 8; ++ch) {
            float acc = b[ch];
#pragma unroll
            for (int j = 0; j < 4; ++j) { const unsigned wd = raw[tk + j][ch >> 1]; const float xv = (ch & 1) ? bfhi(wd) : bflo(wd); acc += w[j][ch] * xv; }
            o[tk][ch] = siluf_(acc);
        }
}
DI float head_scan(const float* DT, const float* alog, int t0, int h, int lane, LAS float* acs_h, LAS float* dtv_h, float& d0o, float& d1o, float& c0o, float& c1o) {
    const float d0 = DT[(size_t)(t0 + 2 * lane) * NH + h], d1 = DT[(size_t)(t0 + 2 * lane + 1) * NH + h];
    const float A2 = -__expf(alog[h]) * LOG2E;
    const float a0 = d0 * A2, a1 = d1 * A2; float inc = a0 + a1;
#pragma unroll
    for (int o = 1; o < 64; o <<= 1) { const float t = __shfl_up(inc, o); if (lane >= o) inc += t; }
    acs_h[2 * lane] = inc - a1; acs_h[2 * lane + 1] = inc; dtv_h[2 * lane] = d0; dtv_h[2 * lane + 1] = d1;
    d0o = d0; d1o = d1; c0o = inc - a1; c1o = inc;
    return __shfl(inc, 63);
}

constexpr int S_CN = 0, S_BN = 32768, S_XT = 65536, S_ACS = 131072, S_DTV = 135168, S_SSQ = 139264, S_FS = 139776;

DI void ph3_chunk_states(const Ctx& F, const Args& a, int reps) {
    const bf16* XBC = (const bf16*)(F.ws + WS_XBC); const float* DT = (const float*)(F.ws + WS_DT);
    bf16* ST = (bf16*)(F.ws + WS_ST); float* CD = (float*)(F.ws + WS_CD);
    const float* scw = ARG(I_SCW); const float* scb = ARG(I_SCB); const float* alog = ARG(I_ALOG);
    const int tid = F.wave * 64 + lane_id(), lane = lane_id(), wave = F.wave, hh = lane >> 5;
    LAS unsigned char* lds = F.lds;
    LAS float* acs = (LAS float*)(lds + S_ACS); LAS float* wsc = (LAS float*)(lds + S_DTV);
    const int RU = (NCH * NGRP + F.G - 1) / F.G;
    for (int it = 0; it < RU * reps; ++it) {
        const int unit = xcd_unit(F.xcd, F.xj, F.G >> 3, (it >= RU ? it - RU : it), NCH * NGRP); if (unit < 0) break; const int c = unit >> 2, g = unit & 3, t0 = c * LCH;
        {
            const int h = 8 * g + wave; float d0, d1, c0, c1;
            const float total = head_scan(DT, alog, t0, h, lane, acs + wave * 128, wsc + wave * 128, d0, d1, c0, c1);
            wsc[wave * 128 + 2 * lane] = d0 * __builtin_amdgcn_exp2f(total - c0); wsc[wave * 128 + 2 * lane + 1] = d1 * __builtin_amdgcn_exp2f(total - c1);
            if (lane == 0) CD[c * NH + h] = __builtin_amdgcn_exp2f(total);
        }
        __syncthreads();
        if (tid < 256) { const int co = tid & 15, to = tid >> 4; float o[8][8];
            conv_block(XBC, scw, scb, t0 + 8 * to, 2048 + 128 * g + 8 * co, o);
#pragma unroll
            for (int ch = 0; ch < 8; ++ch) { const int row = 8 * co + ch;
                v4u w; w.x = pk2(o[0][ch], o[1][ch]); w.y = pk2(o[2][ch], o[3][ch]); w.z = pk2(o[4][ch], o[5][ch]); w.w = pk2(o[6][ch], o[7][ch]);
                *(LAS v4u*)(lds + S_BN + row * 256 + swz(row, to) * 16) = w; } }
        for (int ps = 0; ps < 2; ++ps) {
            {
                const int co = tid & 31, to = tid >> 5, hd = co >> 3, p0 = (co & 7) * 8; float o[8][8];
                conv_block(XBC, scw, scb, t0 + 8 * to, 512 * g + 64 * (4 * ps + hd) + p0, o);
                float sc[8];
#pragma unroll
                for (int tk = 0; tk < 8; ++tk) sc[tk] = wsc[(4 * ps + hd) * 128 + 8 * to + tk];
#pragma unroll
                for (int ch = 0; ch < 8; ++ch) { const int row = hd * 64 + p0 + ch;
                    v4u w; w.x = pk2(o[0][ch] * sc[0], o[1][ch] * sc[1]); w.y = pk2(o[2][ch] * sc[2], o[3][ch] * sc[3]);
                    w.z = pk2(o[4][ch] * sc[4], o[5][ch] * sc[5]); w.w = pk2(o[6][ch] * sc[6], o[7][ch] * sc[7]);
                    *(LAS v4u*)(lds + S_XT + row * 256 + swz(row, to) * 16) = w; }
            }
            __syncthreads();
            {
                const int hd = wave & 3, ph = wave >> 2, h = 8 * g + 4 * ps + hd;
                f32x16 acc[4];
#pragma unroll
                for (int nt = 0; nt < 4; ++nt)
#pragma unroll
                    for (int i = 0; i < 16; ++i) acc[nt][i] = 0.f;
                const int arow = hd * 64 + 32 * ph + (lane & 31);
#pragma unroll
                for (int ks = 0; ks < 8; ++ks) {
                    const bf16x8 av = *(const LAS bf16x8*)(lds + S_XT + arow * 256 + swz(arow, 2 * ks + hh) * 16);
#pragma unroll
                    for (int nt = 0; nt < 4; ++nt) { const int brow = 32 * nt + (lane & 31);
                        const bf16x8 bv = *(const LAS bf16x8*)(lds + S_BN + brow * 256 + swz(brow, 2 * ks + hh) * 16);
                        acc[nt] = MFMA32(av, bv, acc[nt]); }
                }
                bf16* dst = ST + ((size_t)(c * NH + h) * HD) * NST;
#pragma unroll
                for (int nt = 0; nt < 4; ++nt)
#pragma unroll
                    for (int i = 0; i < 16; i += 2) { const int p = 32 * ph + crow(i, hh); const unsigned pk = pk2(acc[nt][i], acc[nt][i + 1]);
                        dst[(size_t)p * NST + 32 * nt + (lane & 31)] = (bf16)(pk & 0xffffu); dst[(size_t)(p + 1) * NST + 32 * nt + (lane & 31)] = (bf16)(pk >> 16); }
            }
            __syncthreads();
        }
    }
}

DI void ph4_scan(const Ctx& F, size_t dst_off) {
    unsigned* ST32 = (unsigned*)(F.ws + WS_ST); unsigned* DST32 = (unsigned*)(F.ws + dst_off); const float* CD = (const float*)(F.ws + WS_CD);
    constexpr int NPAIR = NH * HD * NST / 2;
    for (int e = F.vcu * NTHREADS + (F.wave * 64 + lane_id()); e < NPAIR; e += F.G * NTHREADS) {
        const int h = e >> 12; float c0 = 0.f, c1 = 0.f;
#pragma unroll 1
        for (int cb = 0; cb < NCH; cb += 32) {
            unsigned v[32]; float dec[32];
#pragma unroll
            for (int i = 0; i < 32; ++i) { v[i] = __builtin_nontemporal_load(ST32 + (size_t)(cb + i) * NPAIR + e); dec[i] = CD[(cb + i) * NH + h]; }
#pragma unroll
            for (int i = 0; i < 32; ++i) { DST32[(size_t)(cb + i) * NPAIR + e] = pk2(c0, c1); c0 = c0 * dec[i] + bflo(v[i]); c1 = c1 * dec[i] + bfhi(v[i]); }
        }
    }
}

DI void ph5_ssd_out(const Ctx& F, const Args& a, int reps) {
    const bf16* XBC = (const bf16*)(F.ws + WS_XBC); const float* DT = (const float*)(F.ws + WS_DT);
    const bf16* ST = (const bf16*)(F.ws + WS_ST); const bf16* ZS = (const bf16*)(F.ws + WS_ZS); bf16* YS = (bf16*)(F.ws + WS_YS);
    const float* scw = ARG(I_SCW); const float* scb = ARG(I_SCB); const float* alog = ARG(I_ALOG); const float* dskip = ARG(I_DSKIP);
    const int tid = F.wave * 64 + lane_id(), lane = lane_id(), wave = F.wave, hh = lane >> 5, l31 = lane & 31;
    LAS unsigned char* lds = F.lds;
    LAS float* acs = (LAS float*)(lds + S_ACS); LAS float* dtv = (LAS float*)(lds + S_DTV); LAS float* ssq = (LAS float*)(lds + S_SSQ);
    const int RU = (NCH * NGRP + F.G - 1) / F.G;
    for (int it = 0; it < RU * reps; ++it) {
        const int unit = xcd_unit(F.xcd, F.xj, F.G >> 3, (it >= RU ? it - RU : it), NCH * NGRP); if (unit < 0) break; const int c = unit >> 2, g = unit & 3, t0 = c * LCH;
        { const int h = 8 * g + wave; float d0, d1, c0, c1; (void)head_scan(DT, alog, t0, h, lane, acs + wave * 128, dtv + wave * 128, d0, d1, c0, c1);
          const float cend = __shfl(c1, (lane & 48) | 15);
          LAS float* fsw = (LAS float*)(lds + S_FS) + wave * 128;
          fsw[2 * lane] = d0 * __builtin_amdgcn_exp2f(cend - c0); fsw[2 * lane + 1] = d1 * __builtin_amdgcn_exp2f(cend - c1); }
        if (tid < 128) ssq[tid] = 0.f;
        { const int which = tid >> 8, t8 = tid & 255, co = t8 & 15; int to = t8 >> 4; asm volatile("" : "+v"(to)); float o[8][8];
            conv_block(XBC, scw, scb, t0 + 8 * to, (which ? 2560 : 2048) + 128 * g + 8 * co, o);
            const int base = which ? S_CN : S_BN;
#pragma unroll
            for (int tk = 0; tk < 8; ++tk) { const int row = 8 * to + tk;
                v4u w; w.x = pk2(o[tk][0], o[tk][1]); w.y = pk2(o[tk][2], o[tk][3]); w.z = pk2(o[tk][4], o[tk][5]); w.w = pk2(o[tk][6], o[tk][7]);
                *(LAS v4u*)(lds + base + row * 256 + swz(row, co) * 16) = w; } }
#pragma unroll 1
        for (int ps = 0; ps < 2; ++ps) {
            {
                const int co = tid & 31; int to = tid >> 5; asm volatile("" : "+v"(to));
                const int hd = co >> 3, p0 = (co & 7) * 8; float o[8][8];
                conv_block(XBC, scw, scb, t0 + 8 * to, 512 * g + 64 * (4 * ps + hd) + p0, o);
#pragma unroll
                for (int ch = 0; ch < 8; ++ch) { const int row = hd * 64 + p0 + ch;
                    v4u w; w.x = pk2(o[0][ch], o[1][ch]); w.y = pk2(o[2][ch], o[3][ch]); w.z = pk2(o[4][ch], o[5][ch]); w.w = pk2(o[6][ch], o[7][ch]);
                    *(LAS v4u*)(lds + S_XT + row * 256 + swz(row, to) * 16) = w; }
            }
            __syncthreads();
            const int hd = wave & 3, lp = wave >> 2, hl = 4 * ps + hd, h = 8 * g + hl;
            const float Dh = dskip[h];
            const LAS float* acs_h = acs + hl * 128; const LAS float* dt_h = dtv + hl * 128; const LAS float* fs_h = (const LAS float*)(lds + S_FS) + hl * 128;
            const bf16* prev = ST + ((size_t)(c * NH + h) * HD) * NST;
            const int erow = lane >> 1, ehalf = lane & 1;
            f32x16 acc[2][2];
            {
#pragma unroll
                for (int which = 0; which < 2; ++which)
#pragma unroll
                    for (int pt = 0; pt < 2; ++pt)
#pragma unroll
                        for (int i = 0; i < 16; ++i) acc[which][pt][i] = 0.f;
                const int rowA = 32 * lp + l31, rowB = 32 * (3 - lp) + l31;
#pragma unroll
                for (int ks = 0; ks < 8; ++ks) {
                    const bf16x8 b0 = *(const bf16x8*)(prev + (size_t)l31 * NST + 16 * ks + 8 * hh), b1 = *(const bf16x8*)(prev + (size_t)(32 + l31) * NST + 16 * ks + 8 * hh);
                    const bf16x8 a0 = *(const LAS bf16x8*)(lds + S_CN + rowA * 256 + swz(rowA, 2 * ks + hh) * 16);
                    const bf16x8 a1 = *(const LAS bf16x8*)(lds + S_CN + rowB * 256 + swz(rowB, 2 * ks + hh) * 16);
                    acc[0][0] = MFMA32(a0, b0, acc[0][0]); acc[0][1] = MFMA32(a0, b1, acc[0][1]);
                    acc[1][0] = MFMA32(a1, b0, acc[1][0]); acc[1][1] = MFMA32(a1, b1, acc[1][1]);
                }
#pragma unroll
                for (int which = 0; which < 2; ++which) { const int li = which == 0 ? lp : 3 - lp;
#pragma unroll
                    for (int i = 0; i < 16; ++i) { const float e = __builtin_amdgcn_exp2f(acs_h[32 * li + crow(i, hh)]); acc[which][0][i] *= e; acc[which][1][i] *= e; } }
            }
            {
                const int liA = lp, liB = 3 - lp;
                const int rowA = 32 * liA + l31, rowB = 32 * liB + l31;
                const float alA = acs_h[rowA], alB = acs_h[rowB];
#pragma unroll 1
                for (int sj = 0; sj <= liB; ++sj) {
                    const bool doA = sj <= liA;
                    f32x16 GA, GB;
#pragma unroll
                    for (int i = 0; i < 16; ++i) { GA[i] = 0.f; GB[i] = 0.f; }
                    const int brow = 32 * sj + l31;
                    if (doA) {
#pragma unroll 2
                        for (int ks = 0; ks < 8; ++ks) {
                            const bf16x8 av = *(const LAS bf16x8*)(lds + S_BN + brow * 256 + swz(brow, 2 * ks + hh) * 16);
                            const bf16x8 ca = *(const LAS bf16x8*)(lds + S_CN + rowA * 256 + swz(rowA, 2 * ks + hh) * 16);
                            const bf16x8 cb = *(const LAS bf16x8*)(lds + S_CN + rowB * 256 + swz(rowB, 2 * ks + hh) * 16);
                            GA = MFMA32(av, ca, GA); GB = MFMA32(av, cb, GB);
                        }
                    } else {
#pragma unroll 2
                        for (int ks = 0; ks < 8; ++ks) {
                            const bf16x8 av = *(const LAS bf16x8*)(lds + S_BN + brow * 256 + swz(brow, 2 * ks + hh) * 16);
                            const bf16x8 cb = *(const LAS bf16x8*)(lds + S_CN + rowB * 256 + swz(rowB, 2 * ks + hh) * 16);
                            GB = MFMA32(av, cb, GB);
                        }
                    }
                    auto mask = [&](f32x16& G, int li, int row_l, float al) {
                        if (sj < li) {
                            const float fl = __builtin_amdgcn_exp2f(al - acs_h[32 * sj + 31]);
#pragma unroll
                            for (int i = 0; i < 16; ++i) G[i] = G[i] * (fs_h[32 * sj + crow(i, hh)] * fl);
                        } else {
#pragma unroll
                            for (int i = 0; i < 16; ++i) { const int s = 32 * sj + crow(i, hh);
                                float v = G[i] * __builtin_amdgcn_exp2f(fminf(al - acs_h[s], 0.f)) * dt_h[s];
                                v = (s > row_l) ? 0.f : v; v = (s == row_l) ? v + Dh : v; G[i] = v; }
                        }
                    };
                    auto pv = [&](const f32x16& G, f32x16 (&ac)[2]) {
#pragma unroll
                        for (int s2 = 0; s2 < 2; ++s2) {
                            v4u fa; fa.x = pk2(G[8 * s2 + 0], G[8 * s2 + 1]); fa.y = pk2(G[8 * s2 + 2], G[8 * s2 + 3]); fa.z = pk2(G[8 * s2 + 4], G[8 * s2 + 5]); fa.w = pk2(G[8 * s2 + 6], G[8 * s2 + 7]);
#pragma unroll
                            for (int pt = 0; pt < 2; ++pt) { const int xrow = hd * 64 + 32 * pt + l31; const int sc0 = 32 * sj + 16 * s2;
                                const v2u lo = *(const LAS v2u*)(lds + S_XT + xrow * 256 + swz(xrow, (sc0 >> 3)) * 16 + 8 * hh);
                                const v2u hi = *(const LAS v2u*)(lds + S_XT + xrow * 256 + swz(xrow, (sc0 >> 3) + 1) * 16 + 8 * hh);
                                v4u bfr; bfr.x = lo.x; bfr.y = lo.y; bfr.z = hi.x; bfr.w = hi.y;
                                ac[pt] = MFMA32(__builtin_bit_cast(bf16x8, fa), __builtin_bit_cast(bf16x8, bfr), ac[pt]); }
                        }
                    };
                    if (doA) { mask(GA, liA, rowA, alA); pv(GA, acc[0]); }
                    mask(GB, liB, rowB, alB); pv(GB, acc[1]);
                }
            }
            asm volatile("" ::: "memory");
            v4u zs[2][4];
#pragma unroll
            for (int which = 0; which < 2; ++which) { const int li = which == 0 ? lp : 3 - lp; const size_t t = (size_t)(t0 + 32 * li + erow);
#pragma unroll
                for (int j = 0; j < 4; ++j) zs[which][j] = *(const v4u*)(ZS + t * DIN + 64 * h + 32 * ehalf + 8 * j); }
            __syncthreads();
            {
                LAS unsigned char* stg = lds + S_XT + wave * 8192;
#pragma unroll
                for (int which = 0; which < 2; ++which)
#pragma unroll
                    for (int pt = 0; pt < 2; ++pt)
#pragma unroll
                        for (int i = 0; i < 16; ++i) *(LAS bf16*)(stg + ((which * 32 + crow(i, hh)) * 64 + 32 * pt + l31) * 2) = (bf16)(pk2(acc[which][pt][i], 0.f) & 0xffffu);
                LDS_WAIT(); asm volatile("" ::: "memory");
#pragma unroll
                for (int which = 0; which < 2; ++which) { const int li = which == 0 ? lp : 3 - lp; const int l = 32 * li + erow; const size_t t = (size_t)(t0 + l);
                    float q = 0.f; unsigned w8[8];
#pragma unroll
                    for (int j = 0; j < 4; ++j) { const v4u yv = *(const LAS v4u*)(stg + ((which * 32 + erow) * 64 + 32 * ehalf + 8 * j) * 2); const v4u zv = zs[which][j];
                        float y[8] = {bflo(yv.x) * bflo(zv.x), bfhi(yv.x) * bfhi(zv.x), bflo(yv.y) * bflo(zv.y), bfhi(yv.y) * bfhi(zv.y), bflo(yv.z) * bflo(zv.z), bfhi(yv.z) * bfhi(zv.z), bflo(yv.w) * bflo(zv.w), bfhi(yv.w) * bfhi(zv.w)};
#pragma unroll
                        for (int k = 0; k < 8; ++k) q += y[k] * y[k];
                        w8[2 * j] = pk4_fp8(y[0], y[1], y[2], y[3]); w8[2 * j + 1] = pk4_fp8(y[4], y[5], y[6], y[7]); }
                    { unsigned char* yp = (unsigned char*)YS + t * DIN + 64 * h + 32 * ehalf;
                      *(v4u*)yp = (v4u){w8[0], w8[1], w8[2], w8[3]}; *(v4u*)(yp + 16) = (v4u){w8[4], w8[5], w8[6], w8[7]}; }
                    q += __shfl_xor(q, 1);
                    if (ehalf == 0) __hip_atomic_fetch_add(ssq + l, q, __ATOMIC_RELAXED, __HIP_MEMORY_SCOPE_WORKGROUP);
                }
            }
            __syncthreads();
        }
        if (tid < 128) ((float*)(F.ws + WS_RSTD))[(size_t)(t0 + tid) * 4 + g] = 1.0f / sqrtf(ssq[tid] * (1.0f / 512.f) + EPS);
        __syncthreads();
    }
}

constexpr int RT_LD = 1028;
DI void ph8_router(const Ctx& F, const Args& a, int reps) {
    const float* mod = (const float*)(F.ws + WS_CTL) + CW_MODC;
    const bf16* H = (const bf16*)(F.ws + WS_H16); const float* n2g = ARG(I_N2G); const float* bgrp = ARG(I_BGRP); const float* ber = ARG(I_BER);
    unsigned char* XN2 = F.ws + WS_XN; int* cnt0 = (int*)(F.ws + WS_CTL) + CW_CNT;
    int* RE = (int*)(F.ws + WS_ROUTE); int* RP = RE + 2 * M; float* RW = (float*)(RP + 2 * M); int* LIST = (int*)(F.ws + WS_LIST);
    const int lane = lane_id(), wave = F.wave;
    LAS float* tile = (LAS float*)F.lds;
    LAS float* pe = (LAS float*)F.lds;
    f32x4 gm[4], ga[4];
#pragma unroll
    for (int j = 0; j < 4; ++j) { const int k = 256 * j + 4 * lane; const f32x4 g = *(const f32x4*)(n2g + k), sc = *(const f32x4*)(mod + 4096 + k);
        gm[j] = g * (sc + 1.0f); ga[j] = *(const f32x4*)(mod + 3072 + k); }
    const int RU = (M / 32 + F.G - 1) / F.G;
    for (int it = 0; it < RU * reps; ++it) {
        const int unit = xcd_unit(F.xcd, F.xj, F.G >> 3, (it >= RU ? it - RU : it), M / 32); if (unit < 0) break; int* cnt = cnt0 + ((it >= RU * (reps - 1)) ? 0 : 4096);
        const int row0 = unit * 32;
        {
            f32x4 v[4][4];
#pragma unroll
            for (int rr = 0; rr < 4; ++rr)
#pragma unroll
                for (int j = 0; j < 4; ++j) { const v2u hw = *(const v2u*)(H + (size_t)(row0 + wave * 4 + rr) * D + 256 * j + 4 * lane); v[rr][j] = (f32x4){bflo(hw.x), bfhi(hw.x), bflo(hw.y), bfhi(hw.y)}; }
#pragma unroll
            for (int rr = 0; rr < 4; ++rr) { const int rl = wave * 4 + rr, row = row0 + rl; float ss = 0.f;
#pragma unroll
                for (int j = 0; j < 4; ++j) ss += (v[rr][j].x * v[rr][j].x + v[rr][j].y * v[rr][j].y) + (v[rr][j].z * v[rr][j].z + v[rr][j].w * v[rr][j].w);
                const float rstd = 1.0f / sqrtf(wave_sum(ss) * (1.0f / D) + EPS);
#pragma unroll
                for (int j = 0; j < 4; ++j) { const f32x4 n = v[rr][j] * rstd * gm[j] + ga[j];
                    *(LAS f32x4*)(tile + rl * RT_LD + 256 * j + 4 * lane) = n;
                    *(unsigned*)(XN2 + (size_t)row * D + 256 * j + 4 * lane) = pk4_fp8(n.x, n.y, n.z, n.w); }
            }
        }
        __syncthreads();
        pg8::f32x4 acc[2][5];
#pragma unroll
        for (int rt = 0; rt < 2; ++rt)
#pragma unroll
            for (int ct = 0; ct < 5; ++ct) acc[rt][ct] = (pg8::f32x4){0.f, 0.f, 0.f, 0.f};
        const int kb = wave * 128, fr = lane & 15, kq = lane >> 4;
        const bf16* WRH = (const bf16*)(F.ws + WS_WRH); const bf16* WRL = (const bf16*)(F.ws + WS_WRL);
#pragma unroll 2
        for (int ks = 0; ks < 4; ++ks) {
            const int k0 = kb + 32 * ks + 8 * kq;
            bf16x8 bh[5], bl[5];
#pragma unroll
            for (int ct = 0; ct < 5; ++ct) { bh[ct] = *(const bf16x8*)(WRH + (size_t)(16 * ct + fr) * D + k0); bl[ct] = *(const bf16x8*)(WRL + (size_t)(16 * ct + fr) * D + k0); }
#pragma unroll
            for (int rt = 0; rt < 2; ++rt) {
                const f32x4 x0 = *(const LAS f32x4*)(tile + (16 * rt + fr) * RT_LD + k0), x1 = *(const LAS f32x4*)(tile + (16 * rt + fr) * RT_LD + k0 + 4);
                v4u hv, lv;
                hv.x = pk2(x0.x, x0.y); hv.y = pk2(x0.z, x0.w); hv.z = pk2(x1.x, x1.y); hv.w = pk2(x1.z, x1.w);
                lv.x = pk2(x0.x - bflo(hv.x), x0.y - bfhi(hv.x)); lv.y = pk2(x0.z - bflo(hv.y), x0.w - bfhi(hv.y));
                lv.z = pk2(x1.x - bflo(hv.z), x1.y - bfhi(hv.z)); lv.w = pk2(x1.z - bflo(hv.w), x1.w - bfhi(hv.w));
                const bf16x8 ah = __builtin_bit_cast(bf16x8, hv), al = __builtin_bit_cast(bf16x8, lv);
#pragma unroll
                for (int ct = 0; ct < 5; ++ct) {
                    acc[rt][ct] = __builtin_amdgcn_mfma_f32_16x16x32_bf16(ah, bh[ct], acc[rt][ct], 0, 0, 0);
                    acc[rt][ct] = __builtin_amdgcn_mfma_f32_16x16x32_bf16(ah, bl[ct], acc[rt][ct], 0, 0, 0);
                    acc[rt][ct] = __builtin_amdgcn_mfma_f32_16x16x32_bf16(al, bh[ct], acc[rt][ct], 0, 0, 0); }
            }
        }
        __syncthreads();
#pragma unroll
        for (int rt = 0; rt < 2; ++rt)
#pragma unroll
            for (int ct = 0; ct < 5; ++ct)
#pragma unroll
                for (int r = 0; r < 4; ++r) pe[(wave * 32 + 16 * rt + 4 * kq + r) * 80 + 16 * ct + fr] = acc[rt][ct][r];
        __syncthreads();
        int e0s[4], e1s[4]; float w0s[4], w1s[4];
#pragma unroll
        for (int rr = 0; rr < 4; ++rr) { const int rl = wave * 4 + rr;
            float le = ber[lane], lgv = (lane < 8) ? bgrp[lane] : 0.f;
#pragma unroll
            for (int wv = 0; wv < 8; ++wv) { le += pe[(wv * 32 + rl) * 80 + lane]; if (lane < 8) lgv += pe[(wv * 32 + rl) * 80 + 64 + lane]; }
            float gl[8];
#pragma unroll
            for (int i = 0; i < 8; ++i) gl[i] = __shfl(lgv, i);
            int gi = 0; float gmax = gl[0];
#pragma unroll
            for (int i = 1; i < 8; ++i) if (gl[i] > gmax) { gmax = gl[i]; gi = i; }
            float den = 0.f;
#pragma unroll
            for (int i = 0; i < 8; ++i) den += __expf(gl[i] - gmax);
            const float gp = 1.0f / den;
            float el[8];
#pragma unroll
            for (int i = 0; i < 8; ++i) el[i] = __shfl(le, gi * 8 + i);
            int i0 = 0; float m0 = el[0];
#pragma unroll
            for (int i = 1; i < 8; ++i) if (el[i] > m0) { m0 = el[i]; i0 = i; }
            int i1 = -1; float m1 = -INFINITY;
#pragma unroll
            for (int i = 0; i < 8; ++i) if (i != i0 && el[i] > m1) { m1 = el[i]; i1 = i; }
            const float dd = __expf(m1 - m0);
            w0s[rr] = gp / (1.0f + dd); w1s[rr] = gp * dd / (1.0f + dd); e0s[rr] = gi * 8 + i0; e1s[rr] = gi * 8 + i1;
        }
        if (lane == 0) {
            int p0[4], p1[4];
#pragma unroll
            for (int rr = 0; rr < 4; ++rr) { p0[rr] = atomicAdd(cnt + 64 * e0s[rr], 1); p1[rr] = atomicAdd(cnt + 64 * e1s[rr], 1); }
#pragma unroll
            for (int rr = 0; rr < 4; ++rr) { const int row = row0 + wave * 4 + rr;
                RE[2 * row] = e0s[rr]; RE[2 * row + 1] = e1s[rr]; RP[2 * row] = p0[rr]; RP[2 * row + 1] = p1[rr]; RW[2 * row] = w0s[rr]; RW[2 * row + 1] = w1s[rr];
                LIST[e0s[rr] * 16384 + p0[rr]] = row; LIST[e1s[rr] * 16384 + p1[rr]] = row; }
        }
        __syncthreads();
    }
}

DI void build_tilebase(const Ctx& F) {
    const int* cnt = (const int*)(F.ws + WS_CTL) + CW_CNT; LAS int* tb = (LAS int*)(F.lds + TB_OFF);
    if (F.wave == 0) {
        const int lane = lane_id(); const int tiles = (cnt[64 * lane] + 255) >> 8; int inc = tiles;
#pragma unroll
        for (int o = 1; o < 64; o <<= 1) { const int t = __shfl_up(inc, o); if (lane >= o) inc += t; }
        tb[lane] = inc - tiles; if (lane == 63) tb[NE] = inc; ((LAS int*)(F.lds + CNTL_OFF))[lane] = cnt[64 * lane];
    }
    __syncthreads();
}
DI void fill_tokl(const Ctx& F, const MoeOrder& S) {
    const LAS int* tb = (const LAS int*)(F.lds + TB_OFF); const LAS int* cntl = (const LAS int*)(F.lds + CNTL_OFF); LAS int* tokl = (LAS int*)(F.lds + TOKL_OFF);
    const int* LIST = (const int*)(F.ws + WS_LIST); const int tid = F.wave * 64 + lane_id();
    for (int i = 0; i < 4; ++i) { pg8::Unit u; if (!S.next(i, u)) break;
        const int e = u.pn >> 2, r = 256 * (u.pm - tb[e]) + tid;
        if (tid < 256) tokl[256 * i + tid] = (r < cntl[e]) ? LIST[e * 16384 + r] : 0; }
    asm volatile("s_waitcnt vmcnt(0) lgkmcnt(0)" ::: "memory"); __syncthreads();
}
DI void ph12_final(const Ctx& F, const Args& a, int reps) {
    const float* mod = (const float*)(F.ws + WS_CTL) + CW_MODC; float* H = (float*)argp<N_IN>(); const bf16* H16 = (const bf16*)(F.ws + WS_H16); const float* fg = ARG(I_FG);
    const unsigned char* YE = F.ws + WS_YEXP; const int* RE = (const int*)(F.ws + WS_ROUTE); const int* RP = RE + 2 * M; const float* RW = (const float*)(F.ws + WS_ROUTE) + 4 * M;
    const LAS int* tb = (const LAS int*)(F.lds + TB_OFF);
    float* OUT2 = (float*)(F.ws + WS_U);
    const int gw = F.vcu * NWAVES + F.wave, NGW = F.G * NWAVES, lane = lane_id();
    f32x4 g2[4], fgv[4];
#pragma unroll
    for (int j = 0; j < 4; ++j) { g2[j] = *(const f32x4*)(mod + 5 * 1024 + 256 * j + 4 * lane); fgv[j] = *(const f32x4*)(fg + 256 * j + 4 * lane); }
    const int RT = (M / 2 + NGW - 1) / NGW;
    for (int it = 0; it < RT * reps; ++it) {
        const int t0 = 2 * xcd_unit(F.xcd, F.xj * NWAVES + F.wave, NGW >> 3, (it >= RT ? it - RT : it), M / 2); if (t0 < 0) break;
        float* O = (it >= RT * (reps - 1)) ? H : OUT2;
        int tt[2], d0[2], d1[2]; float w0[2], w1[2];
#pragma unroll
        for (int u = 0; u < 2; ++u) { tt[u] = (t0 + u) % M; d0[u] = 256 * tb[RE[2 * tt[u]]] + RP[2 * tt[u]]; d1[u] = 256 * tb[RE[2 * tt[u] + 1]] + RP[2 * tt[u] + 1]; w0[u] = RW[2 * tt[u]]; w1[u] = RW[2 * tt[u] + 1]; }
        f32x4 hv[2][4]; unsigned ya[2][4], yb[2][4];
#pragma unroll
        for (int u = 0; u < 2; ++u)
#pragma unroll
            for (int j = 0; j < 4; ++j) { const v2u hw = *(const v2u*)(H16 + (size_t)tt[u] * D + 256 * j + 4 * lane); hv[u][j] = (f32x4){bflo(hw.x), bfhi(hw.x), bflo(hw.y), bfhi(hw.y)};
                ya[u][j] = *(const unsigned*)(YE + (size_t)d0[u] * D + 256 * j + 4 * lane); yb[u][j] = *(const unsigned*)(YE + (size_t)d1[u] * D + 256 * j + 4 * lane); }
#pragma unroll
        for (int u = 0; u < 2; ++u) {
            f32x4 v[4]; float ss = 0.f;
#pragma unroll
            for (int j = 0; j < 4; ++j) { const unsigned a4 = ya[u][j], b4 = yb[u][j];
                const f2v a01 = __builtin_amdgcn_cvt_pk_f32_fp8(a4, false), a23 = __builtin_amdgcn_cvt_pk_f32_fp8(a4, true), b01 = __builtin_amdgcn_cvt_pk_f32_fp8(b4, false), b23 = __builtin_amdgcn_cvt_pk_f32_fp8(b4, true);
                f32x4 mo; mo.x = w0[u] * a01.x + w1[u] * b01.x; mo.y = w0[u] * a01.y + w1[u] * b01.y; mo.z = w0[u] * a23.x + w1[u] * b23.x; mo.w = w0[u] * a23.y + w1[u] * b23.y;
                mo = mo * 0.0625f;
                v[j] = hv[u][j] + g2[j] * mo; ss += (v[j].x * v[j].x + v[j].y * v[j].y) + (v[j].z * v[j].z + v[j].w * v[j].w); }
            const float rstd = 1.0f / sqrtf(wave_sum(ss) * (1.0f / D) + EPS);
#pragma unroll
            for (int j = 0; j < 4; ++j) *(f32x4*)(O + (size_t)tt[u] * D + 256 * j + 4 * lane) = v[j] * rstd * fgv[j];
        }
    }
}

constexpr int N_PHASES = 13;
#ifndef REP_MASK
#define REP_MASK 0
#endif
#define REPS(k) (((REP_MASK >> (k)) & 1) ? 2 : 1)
#ifndef MK_ONE_LAUNCH
#define MK_ONE_LAUNCH 1
#endif

struct RepOrder { pg8::StaticOrder s; int n, reps;
    DI bool next(int i, pg8::Unit& u) const { if (i >= n * reps) return false; return s.next(i % n, u); }
    DI void a_ready(const pg8::Unit&) const {}
    DI void done(const pg8::Unit&) const {} };

__global__ void __launch_bounds__(NTHREADS, 2) fwd_kernel(Args args) {
    extern __shared__ __attribute__((aligned(16))) unsigned char lds_raw[];
    Ctx F;
    F.lds = (LAS unsigned char*)lds_raw;
    F.wave = __builtin_amdgcn_readfirstlane((int)threadIdx.x >> 6);
    F.G = gridDim.x; { const int bx = blockIdx.x; F.xcd = bx & 7; F.xj = bx >> 3; F.vcu = F.xcd * (F.G >> 3) + F.xj; }
    F.ws = (unsigned char*)argp<N_IN + 1>();
    volatile LAS unsigned* MISC = (volatile LAS unsigned*)(F.lds + LDSCTL_OFF);
    for (int u = threadIdx.x; u < (LDS_BYTES - LDSCTL_OFF) / 4; u += NTHREADS) ((LAS unsigned*)(F.lds + LDSCTL_OFF))[u] = 0u;
    __syncthreads();
    const int lo = args.ph_lo, hi = args.ph_hi;
    unsigned* barw = (unsigned*)(F.ws + WS_CTL) + CW_BAR;
    XcdBarrier bar; bar.bar = barw; bar.x = 0; bar.st = nullptr;
    if (hi - lo > 1) bar = xcd_barrier_post(barw, MISC + 8);
    bar.wave = F.wave;
#define IN(k) (lo <= (k) && (k) < hi)
#define SEAM(k) do { if (IN(k) && IN((k) + 1)) { xcd_barrier(bar); if (REPS(14) > 1) xcd_barrier(bar); } } while (0)
    unsigned char* ws = F.ws;
    bf16* XN = (bf16*)(ws + WS_XN);
    const float* mod = (const float*)(ws + WS_CTL) + CW_MOD;

    if (IN(0)) { ph0_prologue(F, args, REPS(0)); SEAM(0); }
    if (IN(1)) { for (int rep = 0; rep < REPS(1); ++rep) { ph1_norm_dt(F, args); __syncthreads(); } SEAM(1); }
    if (IN(2)) {
        pg8::Gemm g{(const bf16*)(ws + WS_XN8), (const bf16*)(ws + WS_W8IN), M, NPROJ, D / 2}; pg8::StaticOrder S; S.init(M, NPROJ, F.G, (int)blockIdx.x);
        EpiInProj E{ws};
        RepOrder R{S, (S.nwg - S.c + S.G - 1) / S.G, REPS(2)};
        pg8::gemm_phase<EpiInProj, RepOrder, true, true, false, false, true>(F.lds, g, R, E, F.wave);
        SEAM(2);
    }
    if (IN(3)) { ph3_chunk_states(F, args, REPS(13)); __syncthreads(); ph3_convbranch(F, args, REPS(3)); __syncthreads(); SEAM(3); }
    if (IN(4)) {
        if (REPS(4) > 1) ph4_scan(F, WS_YS);
        ph4_scan(F, WS_ST);
        pg8::Gemm g{XN, (const bf16*)(ws + WS_WCV), M, D, D}; pg8::StaticOrder S; S.init(M, D, F.G, (int)blockIdx.x);
        EpiGate<false> E{(bf16*)(ws + WS_TMP), nullptr, (const bf16*)(ws + WS_GATE), 0, nullptr};
        RepOrder R{S, (S.nwg - S.c + S.G - 1) / S.G, REPS(15)};
        pg8::gemm_phase<EpiGate<false>, RepOrder, false, true>(F.lds, g, R, E, F.wave);
        SEAM(4);
    }
    if (IN(5)) { ph5_ssd_out(F, args, REPS(5)); SEAM(5); }
    if (IN(6)) {
        pg8::Gemm g{(const bf16*)(ws + WS_YS), (const bf16*)(ws + WS_WSSM), M, D, DIN / 2}; pg8::StaticOrder S; S.init(M, D, F.G, (int)blockIdx.x);
        LAS float* rt = (LAS float*)(F.lds + RT_OFF);
        EpiGate<true> E{(bf16*)(ws + WS_MG), (const bf16*)(ws + WS_TMP), (const bf16*)(ws + WS_GATE), 1024, rt};
        for (int i = 0;; ++i) {
            OneUnit S1; if (!S.next(i, S1.u)) break;
            if (F.wave < 4) { const int tid = F.wave * 64 + lane_id(); const f32x4 r = *(const f32x4*)((const float*)(ws + WS_RSTD) + (size_t)(S1.u.pm * 256 + tid) * 4);
                *(LAS f32x4*)(rt + tid * 4) = (f32x4){r.x / r.y, r.y / r.z, r.z / r.w, r.w}; }
            asm volatile("s_waitcnt vmcnt(0) lgkmcnt(0)" ::: "memory"); __syncthreads();
            pg8::gemm_phase<EpiGate<true>, OneUnit, false, true, true>(F.lds, g, S1, E, F.wave);
            __syncthreads();
        }
        SEAM(6);
    }
    if (IN(7)) {
        pg8::Gemm g{(const bf16*)(ws + WS_MG), (const bf16*)(ws + WS_WMIX), M, D, D}; pg8::StaticOrder S; S.init(M, D, F.G, (int)blockIdx.x);
        EpiMix E{(bf16*)(ws + WS_H16), ARG(I_X), (const float*)(ws + WS_CTL) + CW_MODC + 2 * 1024};
        RepOrder R{S, (S.nwg - S.c + S.G - 1) / S.G, REPS(7)};
        pg8::gemm_phase<EpiMix, RepOrder, false, true>(F.lds, g, R, E, F.wave);
        SEAM(7);
    }
    if (IN(8)) { for (int rep = 0; rep < REPS(8); ++rep) { convert_experts(F, args); __syncthreads(); } ph8_router(F, args, REPS(9)); if (IN(8) && IN(10)) xcd_barrier(bar); }
    if (IN(10)) {
        build_tilebase(F);
        const LAS int* tb = (const LAS int*)(F.lds + TB_OFF);
        pg8::Gemm g{(const bf16*)(ws + WS_XN), (const bf16*)(ws + WS_W13), M, NE * 1024, D / 2};
        MoeOrder S{tb, F.G, F.vcu, tb[NE] * 4, 1, (const LAS int*)(F.lds + TOKL_OFF)};
        fill_tokl(F, S);
        EpiUp E{ws + WS_HDN};
        pg8::gemm_phase<EpiUp, MoeOrder, true, true, true, true>(F.lds, g, S, E, F.wave);
        SEAM(10);
    }
    if (IN(11)) {
        build_tilebase(F);
        const LAS int* tb = (const LAS int*)(F.lds + TB_OFF);
        pg8::Gemm g{(const bf16*)(ws + WS_HDN), (const bf16*)(ws + WS_W2), 49152, NE * 1024, DFF / 2};
        MoeOrder S{tb, F.G, F.vcu, tb[NE] * 4, 1, nullptr};
        EpiDown E{ws + WS_YEXP};
        pg8::gemm_phase<EpiDown, MoeOrder, true, true, true>(F.lds, g, S, E, F.wave);
        SEAM(11);
    }
    if (IN(12)) { build_tilebase(F); ph12_final(F, args, REPS(12)); }
#undef IN
#undef SEAM
}

extern "C" void kernel_launch(void* const* d_in, const int* in_sizes, int n_in, void* d_out, int out_size, void* d_ws, size_t ws_size, hipStream_t stream) {
    static int grid = 0;
    if (grid == 0) {
        if (n_in != N_IN || in_sizes[0] != M * D || out_size != M * D || ws_size < WS_END) {
            fprintf(stderr, "kernel_launch: unexpected shapes: n_in %d in0 %d out %d ws %zu (need %zu)\n", n_in, n_in > 0 ? in_sizes[0] : -1, out_size, ws_size, (size_t)WS_END); grid = -1; return; }
        int dev = 0, cus = 0, per_cu = 0;
        if (hipGetDevice(&dev) != hipSuccess || hipDeviceGetAttribute(&cus, hipDeviceAttributeMultiprocessorCount, dev) != hipSuccess) { fprintf(stderr, "kernel_launch: device query failed\n"); grid = -1; return; }
        if (hipFuncSetAttribute((const void*)fwd_kernel, hipFuncAttributeMaxDynamicSharedMemorySize, LDS_BYTES) != hipSuccess) { fprintf(stderr, "kernel_launch: hipFuncSetAttribute failed\n"); grid = -1; return; }
        if (hipOccupancyMaxActiveBlocksPerMultiprocessor(&per_cu, (const void*)fwd_kernel, NTHREADS, LDS_BYTES) != hipSuccess || per_cu < 1) {
            fprintf(stderr, "kernel_launch: the occupancy query admits no workgroup of this kernel per CU (%d); nothing launched\n", per_cu); (void)hipGetLastError(); grid = -1; return; }
        grid = cus;
        if (cus < 192 || (cus & 7)) { fprintf(stderr, "kernel_launch: built for a 256-CU device (the MoE unit table holds 4 units per workgroup); %d CUs: nothing launched\n", cus); grid = -1; return; }
        fprintf(stderr, "kernel_launch: grid %d (cus %d, per_cu %d)\n", grid, cus, per_cu);
    }
    if (grid < 0) return;
    (void)hipMemsetAsync((char*)d_ws + WS_CTL, 0, CTL_ZERO_BYTES, stream);
    Args a{};
    for (int i = 0; i < N_IN; ++i) a.in[i] = (const float*)d_in[i];
    a.out = (float*)d_out; a.ws = (unsigned char*)d_ws;
#if MK_ONE_LAUNCH
    a.ph_lo = 0; a.ph_hi = N_PHASES;
    void* kargs[] = {&a};
    hipError_t e = hipLaunchCooperativeKernel((const void*)fwd_kernel, dim3(grid), dim3(NTHREADS), kargs, LDS_BYTES, stream);
    if (e != hipSuccess) fprintf(stderr, "kernel_launch: cooperative launch failed: %s\n", hipGetErrorString(e));
#else
    for (int ph = 0; ph < N_PHASES; ++ph) {
        a.ph_lo = ph; a.ph_hi = ph + 1;
        hipLaunchKernelGGL(fwd_kernel, dim3(grid), dim3(NTHREADS), LDS_BYTES, stream, a);
    }
#endif
}
```

```cpp
#include <hip/hip_runtime.h>
#include <hip/hip_cooperative_groups.h>
#include <cstdio>
#include <cstdint>
namespace pg8 {
#define PG8_LAS __attribute__((address_space(3)))
typedef unsigned short bf16_t;
typedef short bf16x8 __attribute__((ext_vector_type(8)));
typedef float f32x4 __attribute__((ext_vector_type(4)));
typedef unsigned u32x4 __attribute__((ext_vector_type(4)));
typedef int v4i_ __attribute__((ext_vector_type(4)));
typedef int v8i_ __attribute__((ext_vector_type(8)));
constexpr int BM = 256, BK = 64, HALF = 128, HTB = HALF * BK * 2  , STAGE_BYTES = 8 * HTB, NXCD = 8, WGM = 8;

__host__ __device__ __forceinline__ int lds_byte(int r, int c) { const int st = (r >> 4) * 2 + (c >> 5), rr = r & 15, cc = c & 31, ob = rr * 64 + cc * 2; return st * 1024 + (ob ^ (((ob >> 9) & 1) << 5)); }
__host__ __device__ __forceinline__ void stage_rc(int b, int& R, int& C) { const int st = b / 1024, sb = b % 1024, swz = sb ^ (((sb >> 9) & 1) << 5); R = (st >> 1) * 16 + swz / 64; C = (st & 1) * 32 + (swz % 64) / 2; }
__host__ __device__ __forceinline__ int perm32(int rho) { const int n = rho >> 4, i = rho & 15; return 8 * (i >> 2) + 4 * n + (i & 3); }

struct Unit { int pm, pn; };
struct Gemm { const bf16_t* A; const bf16_t* Bt; int M, N, K; };

struct StaticOrder {
    int nM, nN, nwg, G, c;
    __host__ __device__ void init(int M, int N, int G_, int c_) { nM = M / BM; nN = N / BM; nwg = nM * nN; G = G_; c = c_; }
    __host__ __device__ bool next(int i, Unit& u) const {
        const long L = (long)i * G + c; if (L >= nwg) return false;
        int wgid = (int)L; { const int q = nwg / NXCD, r = nwg % NXCD, xcd = wgid % NXCD, off = wgid / NXCD; wgid = (xcd < r ? xcd * (q + 1) : r * (q + 1) + (xcd - r) * q) + off; }
        const int nig = WGM * nN, gid = wgid / nig, fm = gid * WGM, gsz = (nM - fm) < WGM ? (nM - fm) : WGM;
        u.pm = fm + ((wgid % nig) % gsz); u.pn = (wgid % nig) / gsz; return true;
    }
    __device__ __forceinline__ void a_ready(const Unit&) const {}
    __device__ __forceinline__ void done(const Unit&) const {}
};

__device__ __forceinline__ unsigned cvt_pk_bf16(float lo, float hi) { unsigned r; asm volatile("v_cvt_pk_bf16_f32 %0, %1, %2" : "=v"(r) : "v"(lo), "v"(hi)); return r; }
typedef float f32x2 __attribute__((ext_vector_type(2)));
template <class Epi, class Sched, bool ALIGN_EPI = false, bool SP2 = false, bool FP8 = false, bool GATHER = false, bool I8 = false>
__device__ __forceinline__ void gemm_phase(PG8_LAS unsigned char* lds, const Gemm g, const Sched& S, const Epi& E, const int wave_in) {
    const int lane = (int)__builtin_amdgcn_mbcnt_hi(~0u, __builtin_amdgcn_mbcnt_lo(~0u, 0u)), wid = wave_in, tid = wid * 64 + lane, wr = wid >> 2, wc = wid & 3, fr = lane & 15, fq = lane >> 4;
    const int K = g.K, nt = K / BK;
    unsigned voffA[2], voffB[2];
#pragma unroll
    for (int i = 0; i < 2; ++i) { int R, C; stage_rc(tid * 16 + i * 8192, R, C); const int Rb = Epi::PERM ? ((R & ~31) + perm32(R & 31)) : R;
        voffA[i] = (unsigned)(R * K + C) * 2u; voffB[i] = (unsigned)(Rb * K + C) * 2u; }
    static_assert(!GATHER || SP2, "GATHER is implemented in the SP2 loop");
    unsigned gA[2][2], ngA[2][2]; int RA[2]; unsigned CA2[2];
#pragma unroll
    for (int i = 0; i < 2; ++i) { int R, C; stage_rc(tid * 16 + i * 8192, R, C); RA[i] = R; CA2[i] = (unsigned)C * 2u; }
    auto load_g = [&](int ui_, unsigned (&dst)[2][2]) {
        if constexpr (GATHER) {
#pragma unroll
            for (int h = 0; h < 2; ++h)
#pragma unroll
                for (int i = 0; i < 2; ++i) dst[h][i] = (unsigned)S.tokl[ui_ * 256 + 128 * h + RA[i]] * (unsigned)(K * 2) + CA2[i];
        }
    };
    const size_t kstep = (size_t)(BK * 2);
    const size_t hstep = (size_t)HALF * K * 2;
    const size_t tstep = 2 * hstep;
    const size_t hstepA = GATHER ? (size_t)0 : hstep, tstepA = GATHER ? (size_t)0 : 2 * hstep;
    const unsigned ldsw = (unsigned)wid * 1024u;
    const int aoff = lds_byte(wr * 64 + fr, fq * 8), boff = lds_byte(wc * 32 + fr, fq * 8);
#define PG8_SA(b, h) (((b) * 2 + (h)) * HTB)
#define PG8_SB(b, h) ((4 + (b) * 2 + (h)) * HTB)
#define PG8_STAGE(bufoff, gbase, voff) do { _Pragma("unroll") for (int _i = 0; _i < 2; ++_i) \
        __builtin_amdgcn_global_load_lds((const unsigned*)((const char*)(gbase) + (voff)[_i]), (PG8_LAS unsigned*)(lds + (bufoff) + ldsw + _i * 8192), 16, 0, 0); } while (0)
#define PG8_STAGE_A(bufoff, gbase, gvoff) do { if constexpr (GATHER) { PG8_STAGE(bufoff, gbase, gvoff); } else { PG8_STAGE(bufoff, gbase, voffA); } } while (0)
#define PG8_LDA(dst, b, h) do { if constexpr (FP8) { _Pragma("unroll") for (int m = 0; m < 4; ++m) dst##8[m] = __builtin_shufflevector(*(const PG8_LAS v4i_*)(lds + PG8_SA(b, h) + aoff + m * 2048), *(const PG8_LAS v4i_*)(lds + PG8_SA(b, h) + aoff + m * 2048 + 1024), 0, 1, 2, 3, 4, 5, 6, 7); } \
        else { _Pragma("unroll") for (int m = 0; m < 4; ++m) _Pragma("unroll") for (int k = 0; k < 2; ++k) dst[m][k] = *(const PG8_LAS bf16x8*)(lds + PG8_SA(b, h) + aoff + m * 2048 + k * 1024); } } while (0)
#define PG8_LDB(dst, b, h) do { if constexpr (FP8) { _Pragma("unroll") for (int n = 0; n < 2; ++n) dst##8[n] = __builtin_shufflevector(*(const PG8_LAS v4i_*)(lds + PG8_SB(b, h) + boff + n * 2048), *(const PG8_LAS v4i_*)(lds + PG8_SB(b, h) + boff + n * 2048 + 1024), 0, 1, 2, 3, 4, 5, 6, 7); } \
        else { _Pragma("unroll") for (int n = 0; n < 2; ++n) _Pragma("unroll") for (int k = 0; k < 2; ++k) dst[n][k] = *(const PG8_LAS bf16x8*)(lds + PG8_SB(b, h) + boff + n * 2048 + k * 1024); } } while (0)
#define PG8_MMA(ai, bj, At, Bt) do { __builtin_amdgcn_s_setprio(1); \
        if constexpr (FP8) {   \
              \
            _Pragma("unroll") for (int m = 0; m < 4; ++m) _Pragma("unroll") for (int n = 0; n < 2; ++n) \
                asm volatile("v_mfma_scale_f32_16x16x128_f8f6f4 %0, %1, %2, %0, %3, %4 op_sel_hi:[0,0,0]" : "+v"(acc[ai][bj][m][n]) : "v"(Bt##8[n]), "v"(At##8[m]), "v"(scale_w), "v"(scale_x)); \
        } else { \
        _Pragma("unroll") for (int m = 0; m < 4; ++m) _Pragma("unroll") for (int n = 0; n < 2; ++n) _Pragma("unroll") for (int k = 0; k < 2; ++k) { \
        if constexpr (I8) acc[ai][bj][m][n] = __builtin_bit_cast(f32x4, __builtin_amdgcn_mfma_i32_16x16x64_i8(__builtin_bit_cast(v4i_, Bt[n][k]), __builtin_bit_cast(v4i_, At[m][k]), __builtin_bit_cast(v4i_, acc[ai][bj][m][n]), 0, 0, 0)); \
        else acc[ai][bj][m][n] = __builtin_amdgcn_mfma_f32_16x16x32_bf16(Bt[n][k], At[m][k], acc[ai][bj][m][n], 0, 0, 0); } } __builtin_amdgcn_s_setprio(0); } while (0)
#define PG8_WAIT_V(n) asm volatile("s_waitcnt vmcnt(" #n ")" ::: "memory")
#define PG8_WAIT_L(n) asm volatile("s_waitcnt lgkmcnt(" #n ")" ::: "memory")
#define PG8_BAR __builtin_amdgcn_s_barrier()
#define PG8_SCHED __builtin_amdgcn_sched_barrier(0)
    Unit cur, nxt; int ui = 0;
    if (!S.next(0, cur)) return;
    f32x4 acc[2][2][4][2];
#pragma unroll
    for (int a = 0; a < 2; ++a)
#pragma unroll
        for (int b = 0; b < 2; ++b)
#pragma unroll
            for (int m = 0; m < 4; ++m)
#pragma unroll
                for (int n = 0; n < 2; ++n) acc[a][b][m][n] = (f32x4){0.f, 0.f, 0.f, 0.f};
    auto xdl_settle = [&]() {
        asm volatile("s_nop 15\n\ts_nop 15" : "+v"(acc[0][0][0][0]), "+v"(acc[0][0][0][1]), "+v"(acc[0][0][1][0]), "+v"(acc[0][0][1][1]), "+v"(acc[0][0][2][0]), "+v"(acc[0][0][2][1]), "+v"(acc[0][0][3][0]), "+v"(acc[0][0][3][1]), "+v"(acc[0][1][0][0]), "+v"(acc[0][1][0][1]), "+v"(acc[0][1][1][0]), "+v"(acc[0][1][1][1]), "+v"(acc[0][1][2][0]), "+v"(acc[0][1][2][1]), "+v"(acc[0][1][3][0]), "+v"(acc[0][1][3][1]));
        asm volatile("s_nop 0" : "+v"(acc[1][0][0][0]), "+v"(acc[1][0][0][1]), "+v"(acc[1][0][1][0]), "+v"(acc[1][0][1][1]), "+v"(acc[1][0][2][0]), "+v"(acc[1][0][2][1]), "+v"(acc[1][0][3][0]), "+v"(acc[1][0][3][1]), "+v"(acc[1][1][0][0]), "+v"(acc[1][1][0][1]), "+v"(acc[1][1][1][0]), "+v"(acc[1][1][1][1]), "+v"(acc[1][1][2][0]), "+v"(acc[1][1][2][1]), "+v"(acc[1][1][3][0]), "+v"(acc[1][1][3][1]));
    };
    const int scale_w = 0x79797979, scale_x = 0x7f7f7f7f;
    bf16x8 At[4][2], B0[2][2], B1[2][2]; v8i_ At8[4], B08[2], B18[2];
    const char* cA = (const char*)g.A + (size_t)cur.pm * tstepA; const char* cB = (const char*)g.Bt + (size_t)cur.pn * tstep;
    load_g(0, gA);
    S.a_ready(cur);
    if constexpr (SP2) {
        PG8_STAGE(PG8_SB(0, 0), cB, voffB); PG8_STAGE(PG8_SB(0, 1), cB + hstep, voffB); PG8_STAGE_A(PG8_SA(0, 0), cA, gA[0]); PG8_STAGE_A(PG8_SA(0, 1), cA + hstepA, gA[1]);
        if (wr == 1) PG8_BAR;
        PG8_WAIT_V(2); PG8_BAR;
        PG8_STAGE(PG8_SB(1, 0), cB + kstep, voffB); PG8_STAGE_A(PG8_SA(1, 0), cA + kstep, gA[0]); PG8_STAGE(PG8_SB(1, 1), cB + hstep + kstep, voffB);
        PG8_WAIT_V(6); PG8_BAR;
    } else {
        PG8_STAGE(PG8_SB(0, 0), cB, voffB); PG8_STAGE(PG8_SA(0, 0), cA, voffA); PG8_STAGE(PG8_SB(0, 1), cB + hstep, voffB); PG8_STAGE(PG8_SA(0, 1), cA + hstep, voffA);
        if (wr == 1) PG8_BAR;
        PG8_WAIT_V(4); PG8_BAR;
        PG8_STAGE(PG8_SB(1, 0), cB + kstep, voffB); PG8_STAGE(PG8_SA(1, 0), cA + kstep, voffA); PG8_STAGE(PG8_SB(1, 1), cB + hstep + kstep, voffB);
        PG8_WAIT_V(6); PG8_BAR;
    }
    for (;;) {
        const bool has_next = S.next(ui + 1, nxt);
        const char* nA = has_next ? (const char*)g.A + (size_t)nxt.pm * tstepA : cA; const char* nB = has_next ? (const char*)g.Bt + (size_t)nxt.pn * tstep : cB;
        if constexpr (GATHER) { if (has_next) load_g(ui + 1, ngA); else {
#pragma unroll
            for (int h = 0; h < 2; ++h)
#pragma unroll
                for (int i = 0; i < 2; ++i) ngA[h][i] = gA[h][i]; } }
        for (int t = 0; t < nt; t += 2) {
            const bool last = (t == nt - 2);
            const char* a1 = cA + (size_t)(t + 1) * kstep;
            const char* a2 = last ? nA : cA + (size_t)(t + 2) * kstep; const char* b2 = last ? nB : cB + (size_t)(t + 2) * kstep;
            const char* a3 = a2 + kstep; const char* b3 = b2 + kstep;
            if (last && has_next) S.a_ready(nxt);
            unsigned sN[2][2];
#pragma unroll
            for (int h = 0; h < 2; ++h)
#pragma unroll
                for (int i = 0; i < 2; ++i) sN[h][i] = last ? ngA[h][i] : gA[h][i];
            if constexpr (SP2) {
            PG8_LDB(B0, 0, 0); PG8_LDB(B1, 0, 1); PG8_SCHED; PG8_LDA(At, 0, 0); PG8_STAGE_A(PG8_SA(1, 1), a1 + hstepA, gA[1]);
            PG8_WAIT_V(8); PG8_WAIT_L(0); PG8_BAR; PG8_MMA(0, 0, At, B0); PG8_MMA(0, 1, At, B1); PG8_BAR; PG8_SCHED;
            PG8_LDA(At, 0, 1); PG8_STAGE(PG8_SB(0, 0), b2, voffB); PG8_STAGE(PG8_SB(0, 1), b2 + hstep, voffB); PG8_STAGE_A(PG8_SA(0, 0), a2, sN[0]);
            PG8_WAIT_V(8); PG8_WAIT_L(0); PG8_BAR; PG8_MMA(1, 0, At, B0); PG8_MMA(1, 1, At, B1); PG8_BAR; PG8_SCHED;
            PG8_LDB(B0, 1, 0); PG8_LDB(B1, 1, 1); PG8_SCHED; PG8_LDA(At, 1, 0); PG8_STAGE_A(PG8_SA(0, 1), a2 + hstepA, sN[1]);
            PG8_WAIT_V(8); PG8_WAIT_L(0); PG8_BAR; PG8_MMA(0, 0, At, B0); PG8_MMA(0, 1, At, B1); PG8_BAR; PG8_SCHED;
            PG8_LDA(At, 1, 1); PG8_STAGE(PG8_SB(1, 0), b3, voffB); PG8_STAGE(PG8_SB(1, 1), b3 + hstep, voffB); PG8_STAGE_A(PG8_SA(1, 0), a3, sN[0]);
            PG8_WAIT_V(8); PG8_WAIT_L(0); PG8_BAR; PG8_MMA(1, 0, At, B0); PG8_MMA(1, 1, At, B1); PG8_BAR; PG8_SCHED;
            } else {
            PG8_LDB(B0, 0, 0); PG8_SCHED; PG8_LDA(At, 0, 0); PG8_STAGE(PG8_SA(1, 1), a1 + hstep, voffA);
            PG8_WAIT_L(8); PG8_BAR; PG8_WAIT_L(0); PG8_MMA(0, 0, At, B0); PG8_BAR; PG8_SCHED;
            PG8_LDB(B1, 0, 1); PG8_STAGE(PG8_SB(0, 0), b2, voffB);
            PG8_BAR; PG8_WAIT_L(0); PG8_MMA(0, 1, At, B1); PG8_BAR;
            PG8_LDA(At, 0, 1); PG8_STAGE(PG8_SA(0, 0), a2, voffA);
            PG8_BAR; PG8_WAIT_L(0); PG8_MMA(1, 0, At, B0); PG8_BAR; PG8_SCHED;
            PG8_STAGE(PG8_SB(0, 1), b2 + hstep, voffB);
            PG8_WAIT_V(6); PG8_BAR; PG8_MMA(1, 1, At, B1); PG8_BAR;
            PG8_LDB(B0, 1, 0); PG8_SCHED; PG8_LDA(At, 1, 0); PG8_STAGE(PG8_SA(0, 1), a2 + hstep, voffA);
            PG8_WAIT_L(8); PG8_BAR; PG8_WAIT_L(0); PG8_MMA(0, 0, At, B0); PG8_BAR; PG8_SCHED;
            PG8_LDB(B1, 1, 1); PG8_STAGE(PG8_SB(1, 0), b3, voffB);
            PG8_BAR; PG8_WAIT_L(0); PG8_MMA(0, 1, At, B1); PG8_BAR;
            PG8_LDA(At, 1, 1); PG8_STAGE(PG8_SA(1, 0), a3, voffA);
            PG8_BAR; PG8_WAIT_L(0); PG8_MMA(1, 0, At, B0); PG8_BAR; PG8_SCHED;
            PG8_STAGE(PG8_SB(1, 1), b3 + hstep, voffB);
            PG8_WAIT_V(6); PG8_BAR; PG8_MMA(1, 1, At, B1); PG8_BAR;
            }
            if constexpr (Epi::KHOOK) { constexpr int HK = FP8 ? 4 : 8, HS = FP8 ? 2 : 3;
                if ((((t + 2) & (HK - 1)) == 0) && (t + 2 < nt)) { if constexpr (FP8) xdl_settle(); E.khook(acc, ((t + 2) >> HS) - 1, wr, fr); if constexpr (FP8) xdl_settle(); } }
        }
        if constexpr (ALIGN_EPI) { if (wr == 0) PG8_BAR; }
        if constexpr (FP8) {
            xdl_settle();
        }
        if constexpr (!Epi::AFTER_DRAIN) { E(acc, cur, wr, wc, fr, fq); S.done(cur); }
        if (!has_next) break;
#pragma unroll
        for (int a = 0; a < 2; ++a)
#pragma unroll
            for (int b = 0; b < 2; ++b)
#pragma unroll
                for (int m = 0; m < 4; ++m)
#pragma unroll
                    for (int n = 0; n < 2; ++n) acc[a][b][m][n] = (f32x4){0.f, 0.f, 0.f, 0.f};
        cur = nxt; cA = nA; cB = nB; ++ui;
        if constexpr (GATHER) {
#pragma unroll
            for (int h = 0; h < 2; ++h)
#pragma unroll
                for (int i = 0; i < 2; ++i) gA[h][i] = ngA[h][i]; }
        if constexpr (ALIGN_EPI) { if (wr == 1) PG8_BAR; }
    }
    PG8_WAIT_V(0);
    if constexpr (!ALIGN_EPI) { if (wr == 0) PG8_BAR; }
    PG8_BAR;
    if constexpr (Epi::AFTER_DRAIN) { E.fused(acc, cur, wr, wc, fr, fq, lds, wid, lane); S.done(cur); }
#undef PG8_SA
#undef PG8_SB
#undef PG8_STAGE
#undef PG8_STAGE_A
#undef PG8_LDA
#undef PG8_LDB
#undef PG8_MMA
#undef PG8_WAIT_V
#undef PG8_WAIT_L
#undef PG8_BAR
#undef PG8_SCHED
}
}

#define DI __device__ __forceinline__
#define GAS __attribute__((address_space(1)))
#define LAS __attribute__((address_space(3)))
typedef unsigned short bf16;
typedef unsigned v4u __attribute__((ext_vector_type(4)));
typedef unsigned v2u __attribute__((ext_vector_type(2)));
typedef float f32x4 __attribute__((ext_vector_type(4)));
typedef float f32x16 __attribute__((ext_vector_type(16)));
typedef short bf16x8 __attribute__((ext_vector_type(8)));
typedef __bf16 bf2v __attribute__((ext_vector_type(2)));
typedef float f2v __attribute__((ext_vector_type(2)));
typedef GAS unsigned gu32;

constexpr int NWAVES = 8, NTHREADS = 512;
constexpr int M = 16384, D = 1024, DIN = 2048, NH = 32, HD = 64, NGRP = 4, NST = 128, XBCW = 3072;
constexpr int NPROJ = 9216, WIN_LD = 9248;
constexpr int LCH = 128, NCH = M / LCH;
constexpr int NE = 64, DFF = 512;
constexpr float EPS = 1e-6f;
constexpr float LOG2E = 1.4426950408889634f;

constexpr size_t MiB = 1u << 20;
constexpr size_t WS_CTL = 0, CTL_ZERO_BYTES = 262144;
constexpr size_t WS_WIN = 1 * MiB, WS_WDT = 19 * MiB, WS_WCV = 20 * MiB, WS_WMIX = 22 * MiB, WS_WSSM = 24 * MiB;
constexpr size_t WS_RSTD = 31 * MiB + 524288;
constexpr size_t WS_DT = 28 * MiB, WS_CD = 30 * MiB, WS_WRH = 30 * MiB + 65536, WS_WRL = WS_WRH + 262144, WS_ROUTE = 31 * MiB;
constexpr size_t WS_ST = 32 * MiB, WS_YS = 96 * MiB, WS_TMP = 160 * MiB, WS_MG = 192 * MiB;
constexpr size_t WS_W13 = 32 * MiB, WS_W2 = 160 * MiB, WS_H16 = 96 * MiB;
constexpr size_t WS_XN8 = 32 * MiB, WS_W8IN = 48 * MiB, WS_SA = 60 * MiB, WS_SW = 61 * MiB;
constexpr size_t WS_XN = 224 * MiB;
constexpr size_t WS_U = 256 * MiB, WS_ZS = 288 * MiB, WS_XBC = 352 * MiB, WS_GATE = 448 * MiB;
constexpr size_t WS_LIST = 256 * MiB, WS_HDN = 352 * MiB, WS_YEXP = 400 * MiB;
constexpr size_t WS_END = 512 * MiB;
constexpr int CW_BAR = 4096;
constexpr int CW_CNT = 8192;
constexpr int CW_MODC = 40960;
constexpr int CW_WMAX = 49152;
constexpr int CW_MOD = 16384;

constexpr int RING_BYTES = 131072;
constexpr int LDSCTL_OFF = 147456;
constexpr int TB_OFF = LDSCTL_OFF + 256;
constexpr int CNTL_OFF = TB_OFF + 320;
constexpr int TOKL_OFF = LDSCTL_OFF + 1024;
constexpr int RT_OFF = 148480;
constexpr int LDS_BYTES = 152576;

#define LDS_WAIT() asm volatile("s_waitcnt lgkmcnt(0)" ::: "memory")
#define VM_WAIT() asm volatile("s_waitcnt vmcnt(0)" ::: "memory")

DI unsigned pk2(float lo, float hi) { f2v v = {lo, hi}; return __builtin_bit_cast(unsigned, __builtin_convertvector(v, bf2v)); }
DI unsigned pk4_fp8(float a, float b, float c, float d) {
    a = __builtin_fminf(__builtin_fmaxf(a, -448.f), 448.f); b = __builtin_fminf(__builtin_fmaxf(b, -448.f), 448.f);
    c = __builtin_fminf(__builtin_fmaxf(c, -448.f), 448.f); d = __builtin_fminf(__builtin_fmaxf(d, -448.f), 448.f);
    unsigned w = 0u; w = __builtin_amdgcn_cvt_pk_fp8_f32(a, b, w, false); w = __builtin_amdgcn_cvt_pk_fp8_f32(c, d, w, true); return w; }
DI unsigned pk4_fp8_nc(float a, float b, float c, float d) { unsigned w = 0u; w = __builtin_amdgcn_cvt_pk_fp8_f32(a, b, w, false); w = __builtin_amdgcn_cvt_pk_fp8_f32(c, d, w, true); return w; }
DI unsigned pk4_i8(float a, float b, float c, float d) {
    const int ia = (int)__builtin_rintf(a), ib = (int)__builtin_rintf(b), ic = (int)__builtin_rintf(c), id = (int)__builtin_rintf(d);
    return ((unsigned)ia & 255u) | (((unsigned)ib & 255u) << 8) | (((unsigned)ic & 255u) << 16) | ((unsigned)id << 24); }
DI float bflo(unsigned u) { return __uint_as_float(u << 16); }
DI float bfhi(unsigned u) { return __uint_as_float(u & 0xffff0000u); }
DI float sigmoidf_(float x) { return __builtin_amdgcn_rcpf(1.f + __builtin_amdgcn_exp2f(x * -LOG2E)); }
DI float siluf_(float x) { return x * __builtin_amdgcn_rcpf(1.f + __builtin_amdgcn_exp2f(x * -LOG2E)); }
DI float wave_sum(float v) {
#pragma unroll
    for (int o = 1; o < 64; o <<= 1) v += __shfl_xor(v, o);
    return v;
}
DI f32x4 mod4(const float* modp, int k) { return (*(const f32x4*)(modp + k) + *(const f32x4*)(modp + 6144 + k)) + (*(const f32x4*)(modp + 2 * 6144 + k) + *(const f32x4*)(modp + 3 * 6144 + k)); }
DI int crow(int reg, int hh) { return (reg & 3) + 8 * (reg >> 2) + 4 * hh; }
DI int swz(int row, int chunk) { return chunk ^ ((row ^ (row >> 3)) & 15); }
#define MFMA32(a, b, c) __builtin_amdgcn_mfma_f32_32x32x16_bf16((a), (b), (c), 0, 0, 0)

DI int lane_id() { return (int)__builtin_amdgcn_mbcnt_hi(~0u, __builtin_amdgcn_mbcnt_lo(~0u, 0u)); }
#define XB_TMO      128
#define XB_XCNT(j)  (256  + 64 * (j))
#define XB_XSUB(j)  (1280 + 64 * (j))
#define XB_XGEN(j)  (2304 + 64 * (j))
#define XB_TOP      3328
#define XB_TOPGEN   3392
#define XCD_BAR_WORDS 3456
#define XB_SPIN_CAP (1u << 18)
DI unsigned xb_ld(unsigned* p)              { return __hip_atomic_load(p, __ATOMIC_RELAXED, __HIP_MEMORY_SCOPE_AGENT); }
DI unsigned xb_add(unsigned* p, unsigned v) { return __hip_atomic_fetch_add(p, v, __ATOMIC_RELAXED, __HIP_MEMORY_SCOPE_AGENT); }
DI unsigned xb_xcc_id() { return (unsigned)__builtin_amdgcn_s_getreg((3 << 11) | 20) & 0xFu; }
#define XB_SPIN(cond, bar) do { unsigned _sp = 0; while (cond) { __builtin_amdgcn_s_sleep(1); \
    if ((++_sp & 255u) == 0u) { if (xb_ld(&(bar)[XB_TMO])) break; if (_sp > XB_SPIN_CAP) { atomicAdd(&(bar)[XB_TMO], 1u); break; } } } } while (0)
struct XcdBarrier { unsigned* bar; unsigned x; volatile LAS unsigned* st; int wave; };
DI XcdBarrier xcd_barrier_post(unsigned* bar, volatile LAS unsigned* st) {
    XcdBarrier b; b.bar = bar; b.x = xb_xcc_id(); b.st = st; b.wave = 0;
    if (threadIdx.x == 0) (void)xb_add(&bar[XB_XCNT(b.x)], 1u);
    return b;
}
DI void xcd_barrier_complete(unsigned* bar, unsigned x, unsigned& nloc, unsigned& nx) {
    const unsigned G = gridDim.x * gridDim.y * gridDim.z;
    unsigned sum, cnt, mine, sp = 0u;
    for (;;) {
        sum = 0u; cnt = 0u; mine = 0u;
#pragma unroll
        for (unsigned j = 0; j < 16; ++j) { const unsigned c = xb_ld(&bar[XB_XCNT(j)]); sum += c; cnt += (c > 0u) ? 1u : 0u; mine = (j == x) ? c : mine; }
        if (sum == G) break;
        __builtin_amdgcn_s_sleep(1);
        if ((++sp & 255u) == 0u) { if (xb_ld(&bar[XB_TMO])) break; if (sp > XB_SPIN_CAP) { atomicAdd(&bar[XB_TMO], 1u); break; } }
    }
    nloc = mine > 0u ? mine : 1u; nx = cnt > 0u ? cnt : 1u;
}
DI void xcd_barrier(const XcdBarrier& b) {
    asm volatile("s_waitcnt vmcnt(0)" ::: "memory");
    __syncthreads();
    if (b.wave == 0 && lane_id() == 0) {
        unsigned* bar = b.bar;
        __builtin_amdgcn_s_waitcnt(0);
        unsigned nloc = b.st[0], nx = b.st[1];
        if (nloc == 0u) { xcd_barrier_complete(bar, b.x, nloc, nx); b.st[0] = nloc; b.st[1] = nx; }
        const unsigned old = xb_add(&bar[XB_XSUB(b.x)], 1u);
        const unsigned gen = old / nloc;
        if (old + 1u == (gen + 1u) * nloc) {
            __builtin_amdgcn_fence(__ATOMIC_RELEASE, "agent");
            asm volatile("s_waitcnt vmcnt(0)" ::: "memory");
            const unsigned og = xb_add(&bar[XB_TOP], 1u);
            const unsigned tg = og / nx;
            if (og + 1u == (tg + 1u) * nx) xb_add(&bar[XB_TOPGEN], 1u);
            else XB_SPIN(xb_ld(&bar[XB_TOPGEN]) == tg, bar);
            __builtin_amdgcn_fence(__ATOMIC_ACQUIRE, "agent");
            xb_add(&bar[XB_XGEN(b.x)], 1u);
            asm volatile("s_waitcnt vmcnt(0)" ::: "memory");
        } else {
            XB_SPIN(xb_ld(&bar[XB_XGEN(b.x)]) == gen, bar);
            __builtin_amdgcn_fence(__ATOMIC_ACQUIRE, "agent");
            asm volatile("s_waitcnt vmcnt(0)" ::: "memory");
        }
    }
    __syncthreads();
}

enum { I_X = 0, I_C, I_WADA, I_BADA, I_N1G, I_WIN, I_CVW, I_CVB, I_LNG, I_LNB, I_WCV, I_SCW, I_SCB, I_DTB, I_ALOG, I_DSKIP, I_SNG, I_WSSM, I_WMIX,
       I_N2G, I_WGRP, I_BGRP, I_WER, I_BER, I_W1, I_W3, I_W2, I_FG, N_IN };
struct Args { const float* in[N_IN]; float* out; unsigned char* ws; int ph_lo, ph_hi; };

template <int I> DI const float* argp() {
    auto kp = __builtin_amdgcn_kernarg_segment_ptr();
    unsigned long long v;
    asm volatile("s_load_dwordx2 %0, %1, %2\n\ts_waitcnt lgkmcnt(0)" : "=s"(v) : "s"(kp), "i"(I * 8));
    return (const float*)(const GAS float*)v;
}
#define ARG(i) argp<i>()
struct Ctx {
    LAS unsigned char* lds;
    int wave, vcu, G, xcd, xj;
    unsigned char* ws;
};

DI int xcd_unit(int x, int j, int gx, int i, int N) { const int u = i * gx + j; return (u < (N >> 3)) ? x * (N >> 3) + u : -1; }
DI int inproj_tile(int p) { return p < 8 ? p + 8 : (p < 16 ? p + 20 : (p < 24 ? p - 16 : p - 8)); }
DI int win_col(int npp) { const int np = inproj_tile(npp >> 8) * 256 + (npp & 255);
    if (np < 2048) { const int q = np >> 3, rr = np & 7; return (rr >> 2) * 1024 + 4 * q + (rr & 3); } return np < 7168 ? np : np + 32; }
struct EpiInProj {
    static constexpr bool PERM = true, AFTER_DRAIN = false, KHOOK = false; static constexpr int NPF = 0;
    unsigned char* ws;
    DI static pg8::f32x4 cvt(const pg8::f32x4& a, float sr, const f32x4& sc) { const pg8::v4i_ q = __builtin_bit_cast(pg8::v4i_, a);
        return (pg8::f32x4){(float)q[0] * (sr * sc.x), (float)q[1] * (sr * sc.y), (float)q[2] * (sr * sc.z), (float)q[3] * (sr * sc.w)}; }
    DI void operator()(const pg8::f32x4 (&acc)[2][2][4][2], const pg8::Unit& u, int wr, int wc, int fr, int fq) const {
        const int pn = inproj_tile(u.pn), row0 = u.pm * 256 + wr * 64 + fr;
        const float* SA = (const float*)(ws + WS_SA); const float* SW = (const float*)(ws + WS_SW) + u.pn * 256 + wc * 32 + fq * 8;
        f32x4 sc[2][2];
#pragma unroll
        for (int bj = 0; bj < 2; ++bj) { sc[bj][0] = *(const f32x4*)(SW + bj * 128); sc[bj][1] = *(const f32x4*)(SW + bj * 128 + 4); }
        float sr[2][4];
#pragma unroll
        for (int ai = 0; ai < 2; ++ai)
#pragma unroll
            for (int m = 0; m < 4; ++m) sr[ai][m] = SA[row0 + ai * 128 + m * 16];
        if (pn < 8) {
            bf16* U = (bf16*)(ws + WS_U);
#pragma unroll
            for (int ai = 0; ai < 2; ++ai)
#pragma unroll
                for (int m = 0; m < 4; ++m) {
                    bf16* rowp = U + (size_t)(row0 + ai * 128 + m * 16) * D + pn * 128 + wc * 16 + fq * 4;
#pragma unroll
                    for (int bj = 0; bj < 2; ++bj) { const pg8::f32x4 a = cvt(acc[ai][bj][m][0], sr[ai][m], sc[bj][0]), b = cvt(acc[ai][bj][m][1], sr[ai][m], sc[bj][1]);
                        v2u w; w.x = pk2(a[0] * sigmoidf_(b[0]), a[1] * sigmoidf_(b[1])); w.y = pk2(a[2] * sigmoidf_(b[2]), a[3] * sigmoidf_(b[3]));
                        *(v2u*)(rowp + bj * 64) = w; } }
        } else {
            const bool isz = pn < 16, isx = (pn >= 16) && (pn < 28);
            const size_t boff = isz ? WS_ZS : (isx ? WS_XBC : WS_GATE);
            const int ldc = isx ? XBCW : DIN;
            const int colt = (pn - (isz ? 8 : (isx ? 16 : 28))) * 256;
            bf16* base = (bf16*)(ws + boff);
            const int col0 = colt + wc * 32 + fq * 8;
#pragma unroll
            for (int ai = 0; ai < 2; ++ai)
#pragma unroll
                for (int m = 0; m < 4; ++m) {
                    bf16* rowp = base + (size_t)(row0 + ai * 128 + m * 16) * ldc + col0;
#pragma unroll
                    for (int bj = 0; bj < 2; ++bj) { pg8::f32x4 v0 = cvt(acc[ai][bj][m][0], sr[ai][m], sc[bj][0]), v1 = cvt(acc[ai][bj][m][1], sr[ai][m], sc[bj][1]);
                        if (isz) {
#pragma unroll
                            for (int i = 0; i < 4; ++i) { v0[i] = v0[i] * sigmoidf_(v0[i]); v1[i] = v1[i] * sigmoidf_(v1[i]); }
                        }
                        v4u w; w.x = pk2(v0[0], v0[1]); w.y = pk2(v0[2], v0[3]); w.z = pk2(v1[0], v1[1]); w.w = pk2(v1[2], v1[3]);
                        *(v4u*)(rowp + bj * 128) = w; } }
        }
    }
};
template <bool NORM> struct EpiGate {
    static constexpr bool PERM = true, AFTER_DRAIN = false, KHOOK = NORM;
    bf16* O; const bf16* P; const bf16* GATE; int gcol; const LAS float* rt;
    DI void khook(pg8::f32x4 (&acc)[2][2][4][2], int b, int wr, int fr) const {
#pragma unroll
        for (int ai = 0; ai < 2; ++ai)
#pragma unroll
            for (int m = 0; m < 4; ++m) { const float f = rt[(ai * 128 + wr * 64 + m * 16 + fr) * 4 + b];
#pragma unroll
                for (int bj = 0; bj < 2; ++bj)
#pragma unroll
                    for (int n = 0; n < 2; ++n) acc[ai][bj][m][n] = acc[ai][bj][m][n] * f; }
    }
    DI void operator()(const pg8::f32x4 (&acc)[2][2][4][2], const pg8::Unit& u, int wr, int wc, int fr, int fq) const {
        const int row0 = u.pm * 256 + wr * 64 + fr, col0 = u.pn * 256 + wc * 32 + fq * 8;
        v4u g[4], p[4], wA[4], wB[4];
        auto loadq = [&](int bj, int ai) {
#pragma unroll
            for (int m = 0; m < 4; ++m) { const size_t r = (size_t)(row0 + ai * 128 + m * 16); const int c = col0 + bj * 128;
                g[m] = *(const v4u*)(GATE + r * (2 * D) + gcol + c); if (NORM) p[m] = *(const v4u*)(P + r * D + c); }
        };
        auto calcq = [&](int bj, int ai, v4u (&w)[4]) {
#pragma unroll
            for (int m = 0; m < 4; ++m) {
                float f = 1.0f; if (NORM) f = rt[(ai * 128 + wr * 64 + m * 16 + fr) * 4 + 3];
                const v4u gg = g[m];
                pg8::f32x4 v0 = acc[ai][bj][m][0] * f, v1 = acc[ai][bj][m][1] * f;
                float o[8] = {v0[0] * sigmoidf_(bflo(gg.x)), v0[1] * sigmoidf_(bfhi(gg.x)), v0[2] * sigmoidf_(bflo(gg.y)), v0[3] * sigmoidf_(bfhi(gg.y)), v1[0] * sigmoidf_(bflo(gg.z)), v1[1] * sigmoidf_(bfhi(gg.z)), v1[2] * sigmoidf_(bflo(gg.w)), v1[3] * sigmoidf_(bfhi(gg.w))};
                if (NORM) { const v4u pp = p[m];
                    o[0] += bflo(pp.x); o[1] += bfhi(pp.x); o[2] += bflo(pp.y); o[3] += bfhi(pp.y); o[4] += bflo(pp.z); o[5] += bfhi(pp.z); o[6] += bflo(pp.w); o[7] += bfhi(pp.w); }
                w[m].x = pk2(o[0], o[1]); w[m].y = pk2(o[2], o[3]); w[m].z = pk2(o[4], o[5]); w[m].w = pk2(o[6], o[7]); }
        };
        auto storeq = [&](int bj, int ai, const v4u (&w)[4]) {
#pragma unroll
            for (int m = 0; m < 4; ++m) *(v4u*)(O + (size_t)(row0 + ai * 128 + m * 16) * D + col0 + bj * 128) = w[m];
        };
        loadq(0, 0); calcq(0, 0, wA); loadq(0, 1); storeq(0, 0, wA); calcq(0, 1, wB); loadq(1, 0); storeq(0, 1, wB); calcq(1, 0, wA); loadq(1, 1); storeq(1, 0, wA); calcq(1, 1, wB); storeq(1, 1, wB);
    }
};
struct EpiMix {
    static constexpr bool PERM = true, AFTER_DRAIN = false, KHOOK = false;
    bf16* H; const float* X; const float* g1;
    DI void operator()(const pg8::f32x4 (&acc)[2][2][4][2], const pg8::Unit& u, int wr, int wc, int fr, int fq) const {
        const int row0 = u.pm * 256 + wr * 64 + fr, col0 = u.pn * 256 + wc * 32 + fq * 8;
        f32x4 xa[4], xb[4]; v4u wA[4], wB[4];
        auto loadq = [&](int bj, int ai) {
#pragma unroll
            for (int m = 0; m < 4; ++m) { const size_t off = (size_t)(row0 + ai * 128 + m * 16) * D + col0 + bj * 128;
                xa[m] = __builtin_nontemporal_load((const f32x4*)(X + off)); xb[m] = __builtin_nontemporal_load((const f32x4*)(X + off + 4)); }
        };
        auto calcq = [&](int bj, int ai, v4u (&w)[4]) { const int c = col0 + bj * 128;
            const f32x4 ga = *(const f32x4*)(g1 + c), gb = *(const f32x4*)(g1 + c + 4);
#pragma unroll
            for (int m = 0; m < 4; ++m) { const f32x4 ha = xa[m] + ga * acc[ai][bj][m][0], hb = xb[m] + gb * acc[ai][bj][m][1];
                w[m].x = pk2(ha.x, ha.y); w[m].y = pk2(ha.z, ha.w); w[m].z = pk2(hb.x, hb.y); w[m].w = pk2(hb.z, hb.w); }
        };
        auto storeq = [&](int bj, int ai, const v4u (&w)[4]) {
#pragma unroll
            for (int m = 0; m < 4; ++m) *(v4u*)(H + (size_t)(row0 + ai * 128 + m * 16) * D + col0 + bj * 128) = w[m];
        };
        loadq(0, 0); calcq(0, 0, wA); loadq(0, 1); storeq(0, 0, wA); calcq(0, 1, wB); loadq(1, 0); storeq(0, 1, wB); calcq(1, 0, wA); loadq(1, 1); storeq(1, 0, wA); calcq(1, 1, wB); storeq(1, 1, wB);
    }
};
struct EpiUp {
    static constexpr bool PERM = true, AFTER_DRAIN = false, KHOOK = false;
    unsigned char* HDN;
    DI void operator()(const pg8::f32x4 (&acc)[2][2][4][2], const pg8::Unit& u, int wr, int wc, int fr, int fq) const {
        const int j = u.pn & 3, row0 = u.pm * 256 + wr * 64 + fr, col0 = j * 128 + wc * 16 + fq * 4;
#pragma unroll
        for (int ai = 0; ai < 2; ++ai)
#pragma unroll
            for (int m = 0; m < 4; ++m) { unsigned char* rowp = HDN + (size_t)(row0 + ai * 128 + m * 16) * DFF + col0;
#pragma unroll
                for (int bj = 0; bj < 2; ++bj) { const pg8::f32x4 a = acc[ai][bj][m][0], b = acc[ai][bj][m][1];
                    *(unsigned*)(rowp + bj * 64) = pk4_fp8(siluf_(a[0]) * b[0], siluf_(a[1]) * b[1], siluf_(a[2]) * b[2], siluf_(a[3]) * b[3]); } }
    }
};
struct EpiDown {
    static constexpr bool PERM = true, AFTER_DRAIN = false, KHOOK = false;
    unsigned char* Y;
    DI void operator()(const pg8::f32x4 (&acc)[2][2][4][2], const pg8::Unit& u, int wr, int wc, int fr, int fq) const {
        const int j = u.pn & 3, row0 = u.pm * 256 + wr * 64 + fr, col0 = j * 256 + wc * 32 + fq * 8;
#pragma unroll
        for (int ai = 0; ai < 2; ++ai)
#pragma unroll
            for (int m = 0; m < 4; ++m) { unsigned char* rowp = Y + (size_t)(row0 + ai * 128 + m * 16) * D + col0;
#pragma unroll
                for (int bj = 0; bj < 2; ++bj) { const pg8::f32x4 v0 = acc[ai][bj][m][0] * 16.0f, v1 = acc[ai][bj][m][1] * 16.0f;
                    v2u w; w.x = pk4_fp8(v0[0], v0[1], v0[2], v0[3]); w.y = pk4_fp8(v1[0], v1[1], v1[2], v1[3]);
                    *(v2u*)(rowp + bj * 128) = w; } }
    }
};
struct MoeOrder {
    const LAS int* tb; int G, c, total, reps; const LAS int* tokl;
    DI bool next(int i0, pg8::Unit& u) const {
        const int n = (total - c + G - 1) / G; if (n <= 0 || i0 >= n * reps) return false;
        const int i = i0 % n; const int uu = i * G + c;
        const int T = uu >> 2; int e = 0;
        while (e < NE - 1 && tb[e + 1] <= T) ++e;
        u.pm = T; u.pn = 4 * e + (uu & 3); return true;
    }
    DI void a_ready(const pg8::Unit&) const {}
    DI void done(const pg8::Unit&) const {}
};

struct OneUnit { pg8::Unit u;
    DI bool next(int i, pg8::Unit& o) const { if (i != 0) return false; o = u; return true; }
    DI void a_ready(const pg8::Unit&) const {}
    DI void done(const pg8::Unit&) const {} };

template <class SrcF>
DI void transpose_item(SrcF src, int K, bf16* WT, LAS float* scr, int kb, int n0, int lane) {
    const int k0 = 64 * kb;
#pragma unroll 8
    for (int i = 0; i < 32; ++i) { const int kk = 2 * i + (lane >> 5); scr[kk * 33 + (lane & 31)] = src(k0 + kk, n0 + (lane & 31)); }
    LDS_WAIT(); asm volatile("" ::: "memory");
    const int c = lane & 7;
#pragma unroll
    for (int j = 0; j < 4; ++j) { const int n = (lane >> 3) + 8 * j; const LAS float* s = scr + (8 * c) * 33 + n;
        v4u o; o.x = pk2(s[0 * 33], s[1 * 33]); o.y = pk2(s[2 * 33], s[3 * 33]); o.z = pk2(s[4 * 33], s[5 * 33]); o.w = pk2(s[6 * 33], s[7 * 33]);
        *(v4u*)(WT + (size_t)(n0 + n) * K + k0 + 8 * c) = o; }
    LDS_WAIT(); asm volatile("" ::: "memory");
}

template <class SrcF>
DI void transpose_item8(SrcF src, int K, unsigned char* WT, LAS float* scr, int kb, int n0, int lane) {
    const int k0 = 64 * kb;
#pragma unroll 8
    for (int i = 0; i < 32; ++i) { const int kk = 2 * i + (lane >> 5); scr[kk * 33 + (lane & 31)] = src(k0 + kk, n0 + (lane & 31)) * 64.0f; }
    LDS_WAIT(); asm volatile("" ::: "memory");
#pragma unroll
    for (int i = 0; i < 2; ++i) { const int p = lane + 64 * i, n = p >> 2, c = p & 3; const LAS float* s = scr + (16 * c) * 33 + n;
        v4u o; o.x = pk4_fp8(s[0 * 33], s[1 * 33], s[2 * 33], s[3 * 33]); o.y = pk4_fp8(s[4 * 33], s[5 * 33], s[6 * 33], s[7 * 33]);
        o.z = pk4_fp8(s[8 * 33], s[9 * 33], s[10 * 33], s[11 * 33]); o.w = pk4_fp8(s[12 * 33], s[13 * 33], s[14 * 33], s[15 * 33]);
        *(v4u*)(WT + (size_t)(n0 + n) * K + k0 + 16 * c) = o; }
    LDS_WAIT(); asm volatile("" ::: "memory");
}

template <class SrcF>
DI void transpose_item_i8(SrcF src, float inv, int K, unsigned char* WT, LAS float* scr, int kb, int n0, int lane) {
    const int k0 = 64 * kb;
#pragma unroll 8
    for (int i = 0; i < 32; ++i) { const int kk = 2 * i + (lane >> 5); scr[kk * 33 + (lane & 31)] = src(k0 + kk, n0 + (lane & 31)) * inv; }
    LDS_WAIT(); asm volatile("" ::: "memory");
#pragma unroll
    for (int i = 0; i < 2; ++i) { const int p = lane + 64 * i, n = p >> 2, c = p & 3; const LAS float* s = scr + (16 * c) * 33 + n;
        v4u o; o.x = pk4_i8(s[0 * 33], s[1 * 33], s[2 * 33], s[3 * 33]); o.y = pk4_i8(s[4 * 33], s[5 * 33], s[6 * 33], s[7 * 33]);
        o.z = pk4_i8(s[8 * 33], s[9 * 33], s[10 * 33], s[11 * 33]); o.w = pk4_i8(s[12 * 33], s[13 * 33], s[14 * 33], s[15 * 33]);
        *(v4u*)(WT + (size_t)(n0 + n) * K + k0 + 16 * c) = o; }
    LDS_WAIT(); asm volatile("" ::: "memory");
}

DI void ph0_prologue(const Ctx& F, const Args& a, int reps) {
    const int gw = F.vcu * NWAVES + F.wave, NGW = F.G * NWAVES, lane = lane_id();
    float* mod = (float*)(F.ws + WS_CTL) + CW_MOD;
    {
        const float* cvec = ARG(I_C); const float* wada = ARG(I_WADA); const float* bada = ARG(I_BADA);
        const int r8 = lane >> 3, c4 = lane & 7;
        for (int item0 = gw; item0 < 768 * reps; item0 += NGW) {
            const int item = item0 % 768; const int cc = item % 192, kq = item / 192;
            f32x4 acc = {0.f, 0.f, 0.f, 0.f};
#pragma unroll 8
            for (int i = 0; i < 32; ++i) { const int k = kq * 256 + i * 8 + r8; const float cv = cvec[k]; const float s = siluf_(cv);
                const f32x4 w = *(const f32x4*)(wada + (size_t)k * (6 * D) + cc * 32 + c4 * 4); acc += s * w; }
#pragma unroll
            for (int j = 0; j < 4; ++j) { float v = acc[j]; v += __shfl_xor(v, 8); v += __shfl_xor(v, 16); v += __shfl_xor(v, 32); acc[j] = v; }
            if (lane < 8) {
#pragma unroll
                for (int j = 0; j < 4; ++j) { float v = acc[j]; if (kq == 0) v += bada[cc * 32 + c4 * 4 + j]; mod[kq * 6144 + cc * 32 + c4 * 4 + j] = v; }
            }
        }
    }
    LAS float* scr = (LAS float*)(F.lds + F.wave * 16384);
    const float* win = ARG(I_WIN); const float* wcv = ARG(I_WCV); const float* wmix = ARG(I_WMIX); const float* wssm = ARG(I_WSSM);
    bf16* Win_t = (bf16*)(F.ws + WS_WIN); bf16* Wdt_t = (bf16*)(F.ws + WS_WDT); bf16* Wcv_t = (bf16*)(F.ws + WS_WCV);
    bf16* Wmix_t = (bf16*)(F.ws + WS_WMIX); bf16* Wssm_t = (bf16*)(F.ws + WS_WSSM);
    constexpr int I_IN = 16 * 288, I_DT = 16, I_CV = 16 * 32, I_MX = 16 * 32, I_SS = 32 * 32, I_RT = 16 * 3 * 2;
    constexpr int NITEMS = I_IN + I_DT + I_CV + I_MX + I_SS + I_RT;
    const float* wer = ARG(I_WER); const float* wgrp = ARG(I_WGRP); const float* sng0 = ARG(I_SNG);
    for (int it0 = gw; it0 < NITEMS * reps; it0 += NGW) {
        int r = it0 % NITEMS;
        if (r < I_IN) { const int kb = r / 288, nb = r % 288;
            const int npp = nb * 32 + (lane & 31), col = win_col(npp);
            float mx = 0.f;
#pragma unroll 8
            for (int i = 0; i < 32; ++i) mx = __builtin_fmaxf(mx, __builtin_fabsf(win[(size_t)(64 * kb + 2 * i + (lane >> 5)) * WIN_LD + col]));
            mx = __builtin_fmaxf(mx, __shfl_xor(mx, 32));
            if (lane < 32) atomicMax((unsigned*)(F.ws + WS_CTL) + CW_WMAX + npp, __float_as_uint(mx));
            continue; } r -= I_IN;
        if (r < I_DT) { transpose_item([&](int k, int np) -> float { return win[(size_t)k * WIN_LD + 7168 + np]; }, D, Wdt_t, scr, r, 0, lane); continue; } r -= I_DT;
        if (r < I_CV) { transpose_item([&](int k, int np) -> float { return wcv[(size_t)k * D + np]; }, D, Wcv_t, scr, r / 32, (r % 32) * 32, lane); continue; } r -= I_CV;
        if (r < I_MX) { transpose_item([&](int k, int np) -> float { return wmix[(size_t)k * D + np]; }, D, Wmix_t, scr, r / 32, (r % 32) * 32, lane); continue; } r -= I_MX;
        if (r < I_SS) { transpose_item8([&](int k, int np) -> float { return wssm[(size_t)k * D + np] * sng0[k]; }, DIN, (unsigned char*)Wssm_t, scr, r / 32, (r % 32) * 32, lane); continue; } r -= I_SS;
        {
            const int lo = r / 48, rr = r % 48, kb = rr / 3, nb = rr % 3;
            auto wsrc = [&](int k, int np) -> float { float w = 0.f; if (np < 64) w = wer[(size_t)k * NE + np]; else if (np < 72) w = wgrp[(size_t)k * 8 + (np - 64)];
                const float hi = bflo(pk2(w, 0.f)); return lo ? (w - hi) : hi; };
            transpose_item(wsrc, D, (bf16*)(F.ws + (lo ? WS_WRL : WS_WRH)), scr, kb, nb * 32, lane);
        }
    }
}

DI void convert_experts(const Ctx& F, const Args& a) {
    const int gw = F.vcu * NWAVES + F.wave, NGW = F.G * NWAVES, lane = lane_id();
    LAS float* scr = (LAS float*)(F.lds + F.wave * 17408);
    const float* w1 = ARG(I_W1); const float* w3 = ARG(I_W3); const float* w2 = ARG(I_W2);
    unsigned char* W13_t = F.ws + WS_W13; unsigned char* W2_t = F.ws + WS_W2;
    constexpr int I_13 = NE * 4 * 16, I_2 = NE * 2 * 16, NIT = I_13 + I_2;
    const int ch = lane & 15, kq = lane >> 4;
    for (int it = gw; it < NIT; it += NGW) {
        const float* src; size_t ld; unsigned char* dst;
        if (it < I_13) { const int e = it >> 6, r = it & 63, kb = r >> 4, cb = r & 15;
            src = ((ch & 1) ? w3 : w1) + (size_t)e * D * DFF + (size_t)(256 * kb + kq) * DFF + 32 * cb + 4 * (ch >> 1); ld = DFF;
            dst = W13_t + (size_t)e * D * D + (size_t)(64 * cb + lane) * D + 256 * kb;
        } else { const int r0 = it - I_13, e = r0 >> 5, r = r0 & 31, kb = r >> 4, nb = r & 15;
            src = w2 + (size_t)e * DFF * D + (size_t)(256 * kb + kq) * D + 64 * nb + 4 * ch; ld = D;
            dst = W2_t + (size_t)e * D * DFF + (size_t)(64 * nb + lane) * DFF + 256 * kb;
        }
        f32x4 va[16], vb[16]; v4u o[16];
#pragma unroll
        for (int i = 0; i < 16; ++i) va[i] = __builtin_nontemporal_load((const f32x4*)(src + (size_t)(4 * i) * ld));
#pragma unroll
        for (int sub = 0; sub < 4; ++sub) {
            f32x4 (&cur)[16] = (sub & 1) ? vb : va; f32x4 (&nxt)[16] = (sub & 1) ? va : vb;
            if (sub < 3) {
#pragma unroll
                for (int i = 0; i < 16; ++i) nxt[i] = __builtin_nontemporal_load((const f32x4*)(src + (size_t)(64 * (sub + 1) + 4 * i) * ld));
            }
#pragma unroll
            for (int i = 0; i < 16; ++i) *(LAS f32x4*)(scr + (4 * i + kq) * 68 + 4 * ch) = cur[i] * 64.0f;
            LDS_WAIT(); asm volatile("" ::: "memory");
#pragma unroll
            for (int j = 0; j < 4; ++j) {
                unsigned w[4];
#pragma unroll
                for (int q = 0; q < 4; ++q) { const LAS float* sp = scr + (16 * j + 4 * q) * 68 + lane; w[q] = pk4_fp8(sp[0], sp[68], sp[136], sp[204]); }
                o[4 * sub + j].x = w[0]; o[4 * sub + j].y = w[1]; o[4 * sub + j].z = w[2]; o[4 * sub + j].w = w[3];
            }
            LDS_WAIT(); asm volatile("" ::: "memory");
        }
#pragma unroll
        for (int j = 0; j < 16; ++j) *(v4u*)(dst + 16 * j) = o[j];
    }
}

DI void ph1_norm_dt(const Ctx& F, const Args& a) {
    const float* mod = (const float*)(F.ws + WS_CTL) + CW_MOD;
    const float* x = ARG(I_X); const float* n1g = ARG(I_N1G); const float* dtb = ARG(I_DTB);
    bf16* XN = (bf16*)(F.ws + WS_XN); const bf16* Wdt_t = (const bf16*)(F.ws + WS_WDT); float* DT = (float*)(F.ws + WS_DT);
    const int lane = lane_id(), wave = F.wave;
    f32x4 gm[4], ga[4];
#pragma unroll
    for (int j = 0; j < 4; ++j) { const int k = 256 * j + 4 * lane; const f32x4 g = *(const f32x4*)(n1g + k), sc = mod4(mod, 1024 + k);
        gm[j] = g * (sc + 1.0f); ga[j] = mod4(mod, k); }
    if (F.vcu == 0) { float* modc = (float*)(F.ws + WS_CTL) + CW_MODC; for (int k = (F.wave * 64 + lane_id()) * 4; k < 6 * D; k += NTHREADS * 4) *(f32x4*)(modc + k) = mod4(mod, k); }
    for (int unit = F.vcu; unit < M / 64; unit += F.G) {
        const int row0 = unit * 64;
#pragma unroll 1
        for (int rh = 0; rh < 2; ++rh) {
            f32x4 v[4][4];
#pragma unroll
            for (int rr = 0; rr < 4; ++rr)
#pragma unroll
                for (int j = 0; j < 4; ++j) v[rr][j] = __builtin_nontemporal_load((const f32x4*)(x + (size_t)(row0 + wave * 8 + rh * 4 + rr) * D + 256 * j + 4 * lane));
#pragma unroll
            for (int rr = 0; rr < 4; ++rr) {
                const int rl = wave * 8 + rh * 4 + rr, row = row0 + rl; float ss = 0.f;
#pragma unroll
                for (int j = 0; j < 4; ++j) ss += (v[rr][j].x * v[rr][j].x + v[rr][j].y * v[rr][j].y) + (v[rr][j].z * v[rr][j].z + v[rr][j].w * v[rr][j].w);
                const float rstd = 1.0f / sqrtf(wave_sum(ss) * (1.0f / D) + EPS);
                float am = 0.f;
#pragma unroll
                for (int j = 0; j < 4; ++j) { const f32x4 n = v[rr][j] * rstd * gm[j] + ga[j]; v[rr][j] = n;
                    am = __builtin_fmaxf(__builtin_fmaxf(am, __builtin_fmaxf(__builtin_fabsf(n.x), __builtin_fabsf(n.y))), __builtin_fmaxf(__builtin_fabsf(n.z), __builtin_fabsf(n.w)));
                    v2u w; w.x = pk2(n.x, n.y); w.y = pk2(n.z, n.w);
                    const int chunk = (32 * j + (lane >> 1)) ^ (rl & 15);
                    *(LAS v2u*)(F.lds + rl * 2048 + chunk * 16 + 8 * (lane & 1)) = w; }
#pragma unroll
                for (int o = 1; o < 64; o <<= 1) am = __builtin_fmaxf(am, __shfl_xor(am, o));
                const float inv = am > 0.f ? 127.0f / am : 0.f;
#pragma unroll
                for (int j = 0; j < 4; ++j) *(unsigned*)(F.ws + WS_XN8 + (size_t)row * D + 256 * j + 4 * lane) = pk4_i8(v[rr][j].x * inv, v[rr][j].y * inv, v[rr][j].z * inv, v[rr][j].w * inv);
                if (lane == 0) ((float*)(F.ws + WS_SA))[row] = am * (1.0f / 127.0f);
            }
        }
        __syncthreads();
        {
            const int rt = wave & 3, ct = wave >> 2, fr = lane & 15, fq = lane >> 4;
            pg8::f32x4 acc = {0.f, 0.f, 0.f, 0.f};
            const bf16* wrow = Wdt_t + (size_t)(16 * ct + fr) * D + 8 * fq;
#pragma unroll 4
            for (int ks = 0; ks < 32; ++ks) {
                const bf16x8 av = *(const LAS bf16x8*)(F.lds + (16 * rt + fr) * 2048 + (((4 * ks + fq) ^ fr) * 16));
                const bf16x8 bv = *(const bf16x8*)(wrow + 32 * ks);
                acc = __builtin_amdgcn_mfma_f32_16x16x32_bf16(av, bv, acc, 0, 0, 0);
            }
            const float bias = dtb[16 * ct + fr];
#pragma unroll
            for (int r = 0; r < 4; ++r) { const float v = acc[r] + bias; const float sp = v > 20.f ? v : log1pf(__expf(v));
                DT[(size_t)(row0 + 16 * rt + 4 * fq + r) * NH + 16 * ct + fr] = sp; }
        }
        __syncthreads();
    }
    {
        const float* win = ARG(I_WIN); const unsigned* wmax = (const unsigned*)(F.ws + WS_CTL) + CW_WMAX;
        const int gw = F.vcu * NWAVES + F.wave, NGW = F.G * NWAVES;
        LAS float* scr = (LAS float*)(F.lds + F.wave * 16384);
        for (int r = gw; r < 16 * 288; r += NGW) { const int kb = r / 288, nb = r % 288;
            const int npp = nb * 32 + (lane & 31), col = win_col(npp);
            const float mx = __uint_as_float(wmax[npp]); const float inv = mx > 0.f ? 127.0f / mx : 0.f;
            if (kb == 0 && lane < 32) ((float*)(F.ws + WS_SW))[npp] = mx * (1.0f / 127.0f);
            transpose_item_i8([&](int k, int) -> float { return win[(size_t)k * WIN_LD + col]; }, inv, D, F.ws + WS_W8IN, scr, kb, nb * 32, lane);
        }
    }
}

DI void ph3_convbranch(const Ctx& F, const Args& a, int reps) {
    const bf16* U = (const bf16*)(F.ws + WS_U); bf16* UC = (bf16*)(F.ws + WS_XN);
    const float* cw = ARG(I_CVW); const float* cb = ARG(I_CVB); const float* lg = ARG(I_LNG); const float* lb = ARG(I_LNB);
    const int tid = F.wave * 64 + lane_id(), lane = lane_id(), wave = F.wave;
    LAS unsigned char* tile = F.lds;
    LAS float* red = (LAS float*)(F.lds + 62 * 2048);
    LAS float* stat = red + 32 * 8 * 2;
    f2v w[31];
#pragma unroll
    for (int j = 0; j < 31; ++j) w[j] = *(const f2v*)(cw + j * D + 2 * tid);
    const f2v bias = *(const f2v*)(cb + 2 * tid), gam = *(const f2v*)(lg + 2 * tid), bet = *(const f2v*)(lb + 2 * tid);
    const int RU = (M / 32 + F.G - 1) / F.G;
    for (int it = 0; it < RU * reps; ++it) {
        const int unit = xcd_unit(F.xcd, F.xj, F.G >> 3, (it >= RU ? it - RU : it), M / 32); if (unit < 0) break; const int t0 = unit * 32;
        for (int piece = tid; piece < 62 * 128; piece += NTHREADS) { const int r = piece >> 7, cch = piece & 127, t = t0 - 30 + r;
            v4u v = {0u, 0u, 0u, 0u}; if (t >= 0) v = *(const v4u*)(U + (size_t)t * D + cch * 8);
            *(LAS v4u*)(tile + r * 2048 + cch * 16) = v; }
        __syncthreads();
        f2v o[32];
#pragma unroll
        for (int tg = 0; tg < 8; ++tg) {
            f2v acc[4];
#pragma unroll
            for (int i = 0; i < 4; ++i) acc[i] = bias;
#pragma unroll
            for (int j = 0; j < 34; ++j) {
                const unsigned uu = *(const LAS unsigned*)(tile + (4 * tg + j) * 2048 + tid * 4);
                const f2v u2 = {bflo(uu), bfhi(uu)};
#pragma unroll
                for (int i = 0; i < 4; ++i) { const int jj = j - i; if (jj >= 0 && jj <= 30) acc[i] = __builtin_elementwise_fma(w[jj], u2, acc[i]); }
            }
#pragma unroll
            for (int i = 0; i < 4; ++i) o[4 * tg + i] = acc[i];
        }
        {
            float r5[64];
#pragma unroll
            for (int tk = 0; tk < 32; ++tk) { r5[2 * tk] = o[tk].x + o[tk].y; r5[2 * tk + 1] = o[tk].x * o[tk].x + o[tk].y * o[tk].y; }
            float r4[32], r3[16], r2[8], r1[4], r0[2];
            { const bool up = (lane & 32) != 0;
#pragma unroll
              for (int i = 0; i < 32; ++i) { const float keep = up ? r5[i + 32] : r5[i], send = up ? r5[i] : r5[i + 32]; r4[i] = keep + __shfl_xor(send, 32); } }
            { const bool up = (lane & 16) != 0;
#pragma unroll
              for (int i = 0; i < 16; ++i) { const float keep = up ? r4[i + 16] : r4[i], send = up ? r4[i] : r4[i + 16]; r3[i] = keep + __shfl_xor(send, 16); } }
            { const bool up = (lane & 8) != 0;
#pragma unroll
              for (int i = 0; i < 8; ++i) { const float keep = up ? r3[i + 8] : r3[i], send = up ? r3[i] : r3[i + 8]; r2[i] = keep + __shfl_xor(send, 8); } }
            { const bool up = (lane & 4) != 0;
#pragma unroll
              for (int i = 0; i < 4; ++i) { const float keep = up ? r2[i + 4] : r2[i], send = up ? r2[i] : r2[i + 4]; r1[i] = keep + __shfl_xor(send, 4); } }
            { const bool up = (lane & 2) != 0;
#pragma unroll
              for (int i = 0; i < 2; ++i) { const float keep = up ? r1[i + 2] : r1[i], send = up ? r1[i] : r1[i + 2]; r0[i] = keep + __shfl_xor(send, 2); } }
            const bool up0 = (lane & 1) != 0;
            const float tot = (up0 ? r0[1] : r0[0]) + __shfl_xor(up0 ? r0[0] : r0[1], 1);
            red[((lane >> 1) * 8 + wave) * 2 + (lane & 1)] = tot;
        }
        __syncthreads();
        if (tid < 32) { float s = 0.f, q = 0.f;
#pragma unroll
            for (int wv = 0; wv < 8; ++wv) { s += red[(tid * 8 + wv) * 2]; q += red[(tid * 8 + wv) * 2 + 1]; }
            const float mean = s * (1.0f / D); const float var = fmaxf(q * (1.0f / D) - mean * mean, 0.f);
            stat[tid * 2] = mean; stat[tid * 2 + 1] = 1.0f / sqrtf(var + EPS); }
        __syncthreads();
#pragma unroll
        for (int tk = 0; tk < 32; ++tk) { const float mean = stat[tk * 2], rstd = stat[tk * 2 + 1];
            const float y0 = (o[tk].x - mean) * rstd * gam.x + bet.x, y1 = (o[tk].y - mean) * rstd * gam.y + bet.y;
            *(unsigned*)(UC + (size_t)(t0 + tk) * D + 2 * tid) = pk2(siluf_(y0), siluf_(y1)); }
        __syncthreads();
    }
}

DI void conv_block(const bf16* XBC, const float* cw, const float* cb, int t_first, int col, float (&o)[8][8]) {
    v4u raw[11];
#pragma unroll
    for (int r = 0; r < 11; ++r) { const int t = t_first - 3 + r; const int tc = t < 0 ? 0 : t; v4u v = *(const v4u*)(XBC + (size_t)tc * XBCW + col);
        const unsigned msk = t < 0 ? 0u : 0xffffffffu; v.x &= msk; v.y &= msk; v.z &= msk; v.w &= msk; raw[r] = v; }
    float w[4][8], b[8];
#pragma unroll
    for (int j = 0; j < 4; ++j) { const f32x4 lo = *(const f32x4*)(cw + j * XBCW + col), hi = *(const f32x4*)(cw + j * XBCW + col + 4);
        w[j][0] = lo.x; w[j][1] = lo.y; w[j][2] = lo.z; w[j][3] = lo.w; w[j][4] = hi.x; w[j][5] = hi.y; w[j][6] = hi.z; w[j][7] = hi.w; }
    { const f32x4 lo = *(const f32x4*)(cb + col), hi = *(const f32x4*)(cb + col + 4); b[0] = lo.x; b[1] = lo.y; b[2] = lo.z; b[3] = lo.w; b[4] = hi.x; b[5] = hi.y; b[6] = hi.z; b[7] = hi.w; }
#pragma unroll
    for (int tk = 0; tk < 8; ++tk)
#pragma unroll
        for (int ch = 0; ch < 8; ++ch) {
            float acc = b[ch];
#pragma unroll
            for (int j = 0; j < 4; ++j) { const unsigned wd = raw[tk + j][ch >> 1]; const float xv = (ch & 1) ? bfhi(wd) : bflo(wd); acc += w[j][ch] * xv; }
            o[tk][ch] = siluf_(acc);
        }
}
DI float head_scan(const float* DT, const float* alog, int t0, int h, int lane, LAS float* acs_h, LAS float* dtv_h, float& d0o, float& d1o, float& c0o, float& c1o) {
    const float d0 = DT[(size_t)(t0 + 2 * lane) * NH + h], d1 = DT[(size_t)(t0 + 2 * lane + 1) * NH + h];
    const float A2 = -__expf(alog[h]) * LOG2E;
    const float a0 = d0 * A2, a1 = d1 * A2; float inc = a0 + a1;
#pragma unroll
    for (int o = 1; o < 64; o <<= 1) { const float t = __shfl_up(inc, o); if (lane >= o) inc += t; }
    acs_h[2 * lane] = inc - a1; acs_h[2 * lane + 1] = inc; dtv_h[2 * lane] = d0; dtv_h[2 * lane + 1] = d1;
    d0o = d0; d1o = d1; c0o = inc - a1; c1o = inc;
    return __shfl(inc, 63);
}

constexpr int S_CN = 0, S_BN = 32768, S_XT = 65536, S_ACS = 131072, S_DTV = 135168, S_SSQ = 139264, S_FS = 139776;

DI void ph3_chunk_states(const Ctx& F, const Args& a, int reps) {
    const bf16* XBC = (const bf16*)(F.ws + WS_XBC); const float* DT = (const float*)(F.ws + WS_DT);
    bf16* ST = (bf16*)(F.ws + WS_ST); float* CD = (float*)(F.ws + WS_CD);
    const float* scw = ARG(I_SCW); const float* scb = ARG(I_SCB); const float* alog = ARG(I_ALOG);
    const int tid = F.wave * 64 + lane_id(), lane = lane_id(), wave = F.wave, hh = lane >> 5;
    LAS unsigned char* lds = F.lds;
    LAS float* acs = (LAS float*)(lds + S_ACS); LAS float* wsc = (LAS float*)(lds + S_DTV);
    const int RU = (NCH * NGRP + F.G - 1) / F.G;
    for (int it = 0; it < RU * reps; ++it) {
        const int unit = xcd_unit(F.xcd, F.xj, F.G >> 3, (it >= RU ? it - RU : it), NCH * NGRP); if (unit < 0) break; const int c = unit >> 2, g = unit & 3, t0 = c * LCH;
        {
            const int h = 8 * g + wave; float d0, d1, c0, c1;
            const float total = head_scan(DT, alog, t0, h, lane, acs + wave * 128, wsc + wave * 128, d0, d1, c0, c1);
            wsc[wave * 128 + 2 * lane] = d0 * __builtin_amdgcn_exp2f(total - c0); wsc[wave * 128 + 2 * lane + 1] = d1 * __builtin_amdgcn_exp2f(total - c1);
            if (lane == 0) CD[c * NH + h] = __builtin_amdgcn_exp2f(total);
        }
        __syncthreads();
        if (tid < 256) { const int co = tid & 15, to = tid >> 4; float o[8][8];
            conv_block(XBC, scw, scb, t0 + 8 * to, 2048 + 128 * g + 8 * co, o);
#pragma unroll
            for (int ch = 0; ch < 8; ++ch) { const int row = 8 * co + ch;
                v4u w; w.x = pk2(o[0][ch], o[1][ch]); w.y = pk2(o[2][ch], o[3][ch]); w.z = pk2(o[4][ch], o[5][ch]); w.w = pk2(o[6][ch], o[7][ch]);
                *(LAS v4u*)(lds + S_BN + row * 256 + swz(row, to) * 16) = w; } }
        for (int ps = 0; ps < 2; ++ps) {
            {
                const int co = tid & 31, to = tid >> 5, hd = co >> 3, p0 = (co & 7) * 8; float o[8][8];
                conv_block(XBC, scw, scb, t0 + 8 * to, 512 * g + 64 * (4 * ps + hd) + p0, o);
                float sc[8];
#pragma unroll
                for (int tk = 0; tk < 8; ++tk) sc[tk] = wsc[(4 * ps + hd) * 128 + 8 * to + tk];
#pragma unroll
                for (int ch = 0; ch < 8; ++ch) { const int row = hd * 64 + p0 + ch;
                    v4u w; w.x = pk2(o[0][ch] * sc[0], o[1][ch] * sc[1]); w.y = pk2(o[2][ch] * sc[2], o[3][ch] * sc[3]);
                    w.z = pk2(o[4][ch] * sc[4], o[5][ch] * sc[5]); w.w = pk2(o[6][ch] * sc[6], o[7][ch] * sc[7]);
                    *(LAS v4u*)(lds + S_XT + row * 256 + swz(row, to) * 16) = w; }
            }
            __syncthreads();
            {
                const int hd = wave & 3, ph = wave >> 2, h = 8 * g + 4 * ps + hd;
                f32x16 acc[4];
#pragma unroll
                for (int nt = 0; nt < 4; ++nt)
#pragma unroll
                    for (int i = 0; i < 16; ++i) acc[nt][i] = 0.f;
                const int arow = hd * 64 + 32 * ph + (lane & 31);
#pragma unroll
                for (int ks = 0; ks < 8; ++ks) {
                    const bf16x8 av = *(const LAS bf16x8*)(lds + S_XT + arow * 256 + swz(arow, 2 * ks + hh) * 16);
#pragma unroll
                    for (int nt = 0; nt < 4; ++nt) { const int brow = 32 * nt + (lane & 31);
                        const bf16x8 bv = *(const LAS bf16x8*)(lds + S_BN + brow * 256 + swz(brow, 2 * ks + hh) * 16);
                        acc[nt] = MFMA32(av, bv, acc[nt]); }
                }
                bf16* dst = ST + ((size_t)(c * NH + h) * HD) * NST;
#pragma unroll
                for (int nt = 0; nt < 4; ++nt)
#pragma unroll
                    for (int i = 0; i < 16; i += 2) { const int p = 32 * ph + crow(i, hh); const unsigned pk = pk2(acc[nt][i], acc[nt][i + 1]);
                        dst[(size_t)p * NST + 32 * nt + (lane & 31)] = (bf16)(pk & 0xffffu); dst[(size_t)(p + 1) * NST + 32 * nt + (lane & 31)] = (bf16)(pk >> 16); }
            }
            __syncthreads();
        }
    }
}

DI void ph4_scan(const Ctx& F, size_t dst_off) {
    unsigned* ST32 = (unsigned*)(F.ws + WS_ST); unsigned* DST32 = (unsigned*)(F.ws + dst_off); const float* CD = (const float*)(F.ws + WS_CD);
    constexpr int NPAIR = NH * HD * NST / 2;
    for (int e = F.vcu * NTHREADS + (F.wave * 64 + lane_id()); e < NPAIR; e += F.G * NTHREADS) {
        const int h = e >> 12; float c0 = 0.f, c1 = 0.f;
#pragma unroll 1
        for (int cb = 0; cb < NCH; cb += 32) {
            unsigned v[32]; float dec[32];
#pragma unroll
            for (int i = 0; i < 32; ++i) { v[i] = __builtin_nontemporal_load(ST32 + (size_t)(cb + i) * NPAIR + e); dec[i] = CD[(cb + i) * NH + h]; }
#pragma unroll
            for (int i = 0; i < 32; ++i) { DST32[(size_t)(cb + i) * NPAIR + e] = pk2(c0, c1); c0 = c0 * dec[i] + bflo(v[i]); c1 = c1 * dec[i] + bfhi(v[i]); }
        }
    }
}

DI void ph5_ssd_out(const Ctx& F, const Args& a, int reps) {
    const bf16* XBC = (const bf16*)(F.ws + WS_XBC); const float* DT = (const float*)(F.ws + WS_DT);
    const bf16* ST = (const bf16*)(F.ws + WS_ST); const bf16* ZS = (const bf16*)(F.ws + WS_ZS); bf16* YS = (bf16*)(F.ws + WS_YS);
    const float* scw = ARG(I_SCW); const float* scb = ARG(I_SCB); const float* alog = ARG(I_ALOG); const float* dskip = ARG(I_DSKIP);
    const int tid = F.wave * 64 + lane_id(), lane = lane_id(), wave = F.wave, hh = lane >> 5, l31 = lane & 31;
    LAS unsigned char* lds = F.lds;
    LAS float* acs = (LAS float*)(lds + S_ACS); LAS float* dtv = (LAS float*)(lds + S_DTV); LAS float* ssq = (LAS float*)(lds + S_SSQ);
    const int RU = (NCH * NGRP + F.G - 1) / F.G;
    for (int it = 0; it < RU * reps; ++it) {
        const int unit = xcd_unit(F.xcd, F.xj, F.G >> 3, (it >= RU ? it - RU : it), NCH * NGRP); if (unit < 0) break; const int c = unit >> 2, g = unit & 3, t0 = c * LCH;
        { const int h = 8 * g + wave; float d0, d1, c0, c1; (void)head_scan(DT, alog, t0, h, lane, acs + wave * 128, dtv + wave * 128, d0, d1, c0, c1);
          const float cend = __shfl(c1, (lane & 48) | 15);
          LAS float* fsw = (LAS float*)(lds + S_FS) + wave * 128;
          fsw[2 * lane] = d0 * __builtin_amdgcn_exp2f(cend - c0); fsw[2 * lane + 1] = d1 * __builtin_amdgcn_exp2f(cend - c1); }
        if (tid < 128) ssq[tid] = 0.f;
        { const int which = tid >> 8, t8 = tid & 255, co = t8 & 15; int to = t8 >> 4; asm volatile("" : "+v"(to)); float o[8][8];
            conv_block(XBC, scw, scb, t0 + 8 * to, (which ? 2560 : 2048) + 128 * g + 8 * co, o);
            const int base = which ? S_CN : S_BN;
#pragma unroll
            for (int tk = 0; tk < 8; ++tk) { const int row = 8 * to + tk;
                v4u w; w.x = pk2(o[tk][0], o[tk][1]); w.y = pk2(o[tk][2], o[tk][3]); w.z = pk2(o[tk][4], o[tk][5]); w.w = pk2(o[tk][6], o[tk][7]);
                *(LAS v4u*)(lds + base + row * 256 + swz(row, co) * 16) = w; } }
#pragma unroll 1
        for (int ps = 0; ps < 2; ++ps) {
            {
                const int co = tid & 31; int to = tid >> 5; asm volatile("" : "+v"(to));
                const int hd = co >> 3, p0 = (co & 7) * 8; float o[8][8];
                conv_block(XBC, scw, scb, t0 + 8 * to, 512 * g + 64 * (4 * ps + hd) + p0, o);
#pragma unroll
                for (int ch = 0; ch < 8; ++ch) { const int row = hd * 64 + p0 + ch;
                    v4u w; w.x = pk2(o[0][ch], o[1][ch]); w.y = pk2(o[2][ch], o[3][ch]); w.z = pk2(o[4][ch], o[5][ch]); w.w = pk2(o[6][ch], o[7][ch]);
                    *(LAS v4u*)(lds + S_XT + row * 256 + swz(row, to) * 16) = w; }
            }
            __syncthreads();
            const int hd = wave & 3, lp = wave >> 2, hl = 4 * ps + hd, h = 8 * g + hl;
            const float Dh = dskip[h];
            const LAS float* acs_h = acs + hl * 128; const LAS float* dt_h = dtv + hl * 128; const LAS float* fs_h = (const LAS float*)(lds + S_FS) + hl * 128;
            const bf16* prev = ST + ((size_t)(c * NH + h) * HD) * NST;
            const int erow = lane >> 1, ehalf = lane & 1;
            f32x16 acc[2][2];
            {
#pragma unroll
                for (int which = 0; which < 2; ++which)
#pragma unroll
                    for (int pt = 0; pt < 2; ++pt)
#pragma unroll
                        for (int i = 0; i < 16; ++i) acc[which][pt][i] = 0.f;
                const int rowA = 32 * lp + l31, rowB = 32 * (3 - lp) + l31;
#pragma unroll
                for (int ks = 0; ks < 8; ++ks) {
                    const bf16x8 b0 = *(const bf16x8*)(prev + (size_t)l31 * NST + 16 * ks + 8 * hh), b1 = *(const bf16x8*)(prev + (size_t)(32 + l31) * NST + 16 * ks + 8 * hh);
                    const bf16x8 a0 = *(const LAS bf16x8*)(lds + S_CN + rowA * 256 + swz(rowA, 2 * ks + hh) * 16);
                    const bf16x8 a1 = *(const LAS bf16x8*)(lds + S_CN + rowB * 256 + swz(rowB, 2 * ks + hh) * 16);
                    acc[0][0] = MFMA32(a0, b0, acc[0][0]); acc[0][1] = MFMA32(a0, b1, acc[0][1]);
                    acc[1][0] = MFMA32(a1, b0, acc[1][0]); acc[1][1] = MFMA32(a1, b1, acc[1][1]);
                }
#pragma unroll
                for (int which = 0; which < 2; ++which) { const int li = which == 0 ? lp : 3 - lp;
#pragma unroll
                    for (int i = 0; i < 16; ++i) { const float e = __builtin_amdgcn_exp2f(acs_h[32 * li + crow(i, hh)]); acc[which][0][i] *= e; acc[which][1][i] *= e; } }
            }
            {
                const int liA = lp, liB = 3 - lp;
                const int rowA = 32 * liA + l31, rowB = 32 * liB + l31;
                const float alA = acs_h[rowA], alB = acs_h[rowB];
#pragma unroll 1
                for (int sj = 0; sj <= liB; ++sj) {
                    const bool doA = sj <= liA;
                    f32x16 GA, GB;
#pragma unroll
                    for (int i = 0; i < 16; ++i) { GA[i] = 0.f; GB[i] = 0.f; }
                    const int brow = 32 * sj + l31;
                    if (doA) {
#pragma unroll 2
                        for (int ks = 0; ks < 8; ++ks) {
                            const bf16x8 av = *(const LAS bf16x8*)(lds + S_BN + brow * 256 + swz(brow, 2 * ks + hh) * 16);
                            const bf16x8 ca = *(const LAS bf16x8*)(lds + S_CN + rowA * 256 + swz(rowA, 2 * ks + hh) * 16);
                            const bf16x8 cb = *(const LAS bf16x8*)(lds + S_CN + rowB * 256 + swz(rowB, 2 * ks + hh) * 16);
                            GA = MFMA32(av, ca, GA); GB = MFMA32(av, cb, GB);
                        }
                    } else {
#pragma unroll 2
                        for (int ks = 0; ks < 8; ++ks) {
                            const bf16x8 av = *(const LAS bf16x8*)(lds + S_BN + brow * 256 + swz(brow, 2 * ks + hh) * 16);
                            const bf16x8 cb = *(const LAS bf16x8*)(lds + S_CN + rowB * 256 + swz(rowB, 2 * ks + hh) * 16);
                            GB = MFMA32(av, cb, GB);
                        }
                    }
                    auto mask = [&](f32x16& G, int li, int row_l, float al) {
                        if (sj < li) {
                            const float fl = __builtin_amdgcn_exp2f(al - acs_h[32 * sj + 31]);
#pragma unroll
                            for (int i = 0; i < 16; ++i) G[i] = G[i] * (fs_h[32 * sj + crow(i, hh)] * fl);
                        } else {
#pragma unroll
                            for (int i = 0; i < 16; ++i) { const int s = 32 * sj + crow(i, hh);
                                float v = G[i] * __builtin_amdgcn_exp2f(fminf(al - acs_h[s], 0.f)) * dt_h[s];
                                v = (s > row_l) ? 0.f : v; v = (s == row_l) ? v + Dh : v; G[i] = v; }
                        }
                    };
                    auto pv = [&](const f32x16& G, f32x16 (&ac)[2]) {
#pragma unroll
                        for (int s2 = 0; s2 < 2; ++s2) {
                            v4u fa; fa.x = pk2(G[8 * s2 + 0], G[8 * s2 + 1]); fa.y = pk2(G[8 * s2 + 2], G[8 * s2 + 3]); fa.z = pk2(G[8 * s2 + 4], G[8 * s2 + 5]); fa.w = pk2(G[8 * s2 + 6], G[8 * s2 + 7]);
#pragma unroll
                            for (int pt = 0; pt < 2; ++pt) { const int xrow = hd * 64 + 32 * pt + l31; const int sc0 = 32 * sj + 16 * s2;
                                const v2u lo = *(const LAS v2u*)(lds + S_XT + xrow * 256 + swz(xrow, (sc0 >> 3)) * 16 + 8 * hh);
                                const v2u hi = *(const LAS v2u*)(lds + S_XT + xrow * 256 + swz(xrow, (sc0 >> 3) + 1) * 16 + 8 * hh);
                                v4u bfr; bfr.x = lo.x; bfr.y = lo.y; bfr.z = hi.x; bfr.w = hi.y;
                                ac[pt] = MFMA32(__builtin_bit_cast(bf16x8, fa), __builtin_bit_cast(bf16x8, bfr), ac[pt]); }
                        }
                    };
                    if (doA) { mask(GA, liA, rowA, alA); pv(GA, acc[0]); }
                    mask(GB, liB, rowB, alB); pv(GB, acc[1]);
                }
            }
            asm volatile("" ::: "memory");
            v4u zs[2][4];
#pragma unroll
            for (int which = 0; which < 2; ++which) { const int li = which == 0 ? lp : 3 - lp; const size_t t = (size_t)(t0 + 32 * li + erow);
#pragma unroll
                for (int j = 0; j < 4; ++j) zs[which][j] = *(const v4u*)(ZS + t * DIN + 64 * h + 32 * ehalf + 8 * j); }
            __syncthreads();
            {
                LAS unsigned char* stg = lds + S_XT + wave * 8192;
#pragma unroll
                for (int which = 0; which < 2; ++which)
#pragma unroll
                    for (int pt = 0; pt < 2; ++pt)
#pragma unroll
                        for (int i = 0; i < 16; ++i) *(LAS bf16*)(stg + ((which * 32 + crow(i, hh)) * 64 + 32 * pt + l31) * 2) = (bf16)(pk2(acc[which][pt][i], 0.f) & 0xffffu);
                LDS_WAIT(); asm volatile("" ::: "memory");
#pragma unroll
                for (int which = 0; which < 2; ++which) { const int li = which == 0 ? lp : 3 - lp; const int l = 32 * li + erow; const size_t t = (size_t)(t0 + l);
                    float q = 0.f; unsigned w8[8];
#pragma unroll
                    for (int j = 0; j < 4; ++j) { const v4u yv = *(const LAS v4u*)(stg + ((which * 32 + erow) * 64 + 32 * ehalf + 8 * j) * 2); const v4u zv = zs[which][j];
                        float y[8] = {bflo(yv.x) * bflo(zv.x), bfhi(yv.x) * bfhi(zv.x), bflo(yv.y) * bflo(zv.y), bfhi(yv.y) * bfhi(zv.y), bflo(yv.z) * bflo(zv.z), bfhi(yv.z) * bfhi(zv.z), bflo(yv.w) * bflo(zv.w), bfhi(yv.w) * bfhi(zv.w)};
#pragma unroll
                        for (int k = 0; k < 8; ++k) q += y[k] * y[k];
                        w8[2 * j] = pk4_fp8(y[0], y[1], y[2], y[3]); w8[2 * j + 1] = pk4_fp8(y[4], y[5], y[6], y[7]); }
                    { unsigned char* yp = (unsigned char*)YS + t * DIN + 64 * h + 32 * ehalf;
                      *(v4u*)yp = (v4u){w8[0], w8[1], w8[2], w8[3]}; *(v4u*)(yp + 16) = (v4u){w8[4], w8[5], w8[6], w8[7]}; }
                    q += __shfl_xor(q, 1);
                    if (ehalf == 0) __hip_atomic_fetch_add(ssq + l, q, __ATOMIC_RELAXED, __HIP_MEMORY_SCOPE_WORKGROUP);
                }
            }
            __syncthreads();
        }
        if (tid < 128) ((float*)(F.ws + WS_RSTD))[(size_t)(t0 + tid) * 4 + g] = 1.0f / sqrtf(ssq[tid] * (1.0f / 512.f) + EPS);
        __syncthreads();
    }
}

constexpr int RT_LD = 1028;
DI void ph8_router(const Ctx& F, const Args& a, int reps) {
    const float* mod = (const float*)(F.ws + WS_CTL) + CW_MODC;
    const bf16* H = (const bf16*)(F.ws + WS_H16); const float* n2g = ARG(I_N2G); const float* bgrp = ARG(I_BGRP); const float* ber = ARG(I_BER);
    unsigned char* XN2 = F.ws + WS_XN; int* cnt0 = (int*)(F.ws + WS_CTL) + CW_CNT;
    int* RE = (int*)(F.ws + WS_ROUTE); int* RP = RE + 2 * M; float* RW = (float*)(RP + 2 * M); int* LIST = (int*)(F.ws + WS_LIST);
    const int lane = lane_id(), wave = F.wave;
    LAS float* tile = (LAS float*)F.lds;
    LAS float* pe = (LAS float*)F.lds;
    f32x4 gm[4], ga[4];
#pragma unroll
    for (int j = 0; j < 4; ++j) { const int k = 256 * j + 4 * lane; const f32x4 g = *(const f32x4*)(n2g + k), sc = *(const f32x4*)(mod + 4096 + k);
        gm[j] = g * (sc + 1.0f); ga[j] = *(const f32x4*)(mod + 3072 + k); }
    const int RU = (M / 32 + F.G - 1) / F.G;
    for (int it = 0; it < RU * reps; ++it) {
        const int unit = xcd_unit(F.xcd, F.xj, F.G >> 3, (it >= RU ? it - RU : it), M / 32); if (unit < 0) break; int* cnt = cnt0 + ((it >= RU * (reps - 1)) ? 0 : 4096);
        const int row0 = unit * 32;
        {
            f32x4 v[4][4];
#pragma unroll
            for (int rr = 0; rr < 4; ++rr)
#pragma unroll
                for (int j = 0; j < 4; ++j) { const v2u hw = *(const v2u*)(H + (size_t)(row0 + wave * 4 + rr) * D + 256 * j + 4 * lane); v[rr][j] = (f32x4){bflo(hw.x), bfhi(hw.x), bflo(hw.y), bfhi(hw.y)}; }
#pragma unroll
            for (int rr = 0; rr < 4; ++rr) { const int rl = wave * 4 + rr, row = row0 + rl; float ss = 0.f;
#pragma unroll
                for (int j = 0; j < 4; ++j) ss += (v[rr][j].x * v[rr][j].x + v[rr][j].y * v[rr][j].y) + (v[rr][j].z * v[rr][j].z + v[rr][j].w * v[rr][j].w);
                const float rstd = 1.0f / sqrtf(wave_sum(ss) * (1.0f / D) + EPS);
#pragma unroll
                for (int j = 0; j < 4; ++j) { const f32x4 n = v[rr][j] * rstd * gm[j] + ga[j];
                    *(LAS f32x4*)(tile + rl * RT_LD + 256 * j + 4 * lane) = n;
                    *(unsigned*)(XN2 + (size_t)row * D + 256 * j + 4 * lane) = pk4_fp8(n.x, n.y, n.z, n.w); }
            }
        }
        __syncthreads();
        pg8::f32x4 acc[2][5];
#pragma unroll
        for (int rt = 0; rt < 2; ++rt)
#pragma unroll
            for (int ct = 0; ct < 5; ++ct) acc[rt][ct] = (pg8::f32x4){0.f, 0.f, 0.f, 0.f};
        const int kb = wave * 128, fr = lane & 15, kq = lane >> 4;
        const bf16* WRH = (const bf16*)(F.ws + WS_WRH); const bf16* WRL = (const bf16*)(F.ws + WS_WRL);
#pragma unroll 2
        for (int ks = 0; ks < 4; ++ks) {
            const int k0 = kb + 32 * ks + 8 * kq;
            bf16x8 bh[5], bl[5];
#pragma unroll
            for (int ct = 0; ct < 5; ++ct) { bh[ct] = *(const bf16x8*)(WRH + (size_t)(16 * ct + fr) * D + k0); bl[ct] = *(const bf16x8*)(WRL + (size_t)(16 * ct + fr) * D + k0); }
#pragma unroll
            for (int rt = 0; rt < 2; ++rt) {
                const f32x4 x0 = *(const LAS f32x4*)(tile + (16 * rt + fr) * RT_LD + k0), x1 = *(const LAS f32x4*)(tile + (16 * rt + fr) * RT_LD + k0 + 4);
                v4u hv, lv;
                hv.x = pk2(x0.x, x0.y); hv.y = pk2(x0.z, x0.w); hv.z = pk2(x1.x, x1.y); hv.w = pk2(x1.z, x1.w);
                lv.x = pk2(x0.x - bflo(hv.x), x0.y - bfhi(hv.x)); lv.y = pk2(x0.z - bflo(hv.y), x0.w - bfhi(hv.y));
                lv.z = pk2(x1.x - bflo(hv.z), x1.y - bfhi(hv.z)); lv.w = pk2(x1.z - bflo(hv.w), x1.w - bfhi(hv.w));
                const bf16x8 ah = __builtin_bit_cast(bf16x8, hv), al = __builtin_bit_cast(bf16x8, lv);
#pragma unroll
                for (int ct = 0; ct < 5; ++ct) {
                    acc[rt][ct] = __builtin_amdgcn_mfma_f32_16x16x32_bf16(ah, bh[ct], acc[rt][ct], 0, 0, 0);
                    acc[rt][ct] = __builtin_amdgcn_mfma_f32_16x16x32_bf16(ah, bl[ct], acc[rt][ct], 0, 0, 0);
                    acc[rt][ct] = __builtin_amdgcn_mfma_f32_16x16x32_bf16(al, bh[ct], acc[rt][ct], 0, 0, 0); }
            }
        }
        __syncthreads();
#pragma unroll
        for (int rt = 0; rt < 2; ++rt)
#pragma unroll
            for (int ct = 0; ct < 5; ++ct)
#pragma unroll
                for (int r = 0; r < 4; ++r) pe[(wave * 32 + 16 * rt + 4 * kq + r) * 80 + 16 * ct + fr] = acc[rt][ct][r];
        __syncthreads();
        int e0s[4], e1s[4]; float w0s[4], w1s[4];
#pragma unroll
        for (int rr = 0; rr < 4; ++rr) { const int rl = wave * 4 + rr;
            float le = ber[lane], lgv = (lane < 8) ? bgrp[lane] : 0.f;
#pragma unroll
            for (int wv = 0; wv < 8; ++wv) { le += pe[(wv * 32 + rl) * 80 + lane]; if (lane < 8) lgv += pe[(wv * 32 + rl) * 80 + 64 + lane]; }
            float gl[8];
#pragma unroll
            for (int i = 0; i < 8; ++i) gl[i] = __shfl(lgv, i);
            int gi = 0; float gmax = gl[0];
#pragma unroll
            for (int i = 1; i < 8; ++i) if (gl[i] > gmax) { gmax = gl[i]; gi = i; }
            float den = 0.f;
#pragma unroll
            for (int i = 0; i < 8; ++i) den += __expf(gl[i] - gmax);
            const float gp = 1.0f / den;
            float el[8];
#pragma unroll
            for (int i = 0; i < 8; ++i) el[i] = __shfl(le, gi * 8 + i);
            int i0 = 0; float m0 = el[0];
#pragma unroll
            for (int i = 1; i < 8; ++i) if (el[i] > m0) { m0 = el[i]; i0 = i; }
            int i1 = -1; float m1 = -INFINITY;
#pragma unroll
            for (int i = 0; i < 8; ++i) if (i != i0 && el[i] > m1) { m1 = el[i]; i1 = i; }
            const float dd = __expf(m1 - m0);
            w0s[rr] = gp / (1.0f + dd); w1s[rr] = gp * dd / (1.0f + dd); e0s[rr] = gi * 8 + i0; e1s[rr] = gi * 8 + i1;
        }
        if (lane == 0) {
            int p0[4], p1[4];
#pragma unroll
            for (int rr = 0; rr < 4; ++rr) { p0[rr] = atomicAdd(cnt + 64 * e0s[rr], 1); p1[rr] = atomicAdd(cnt + 64 * e1s[rr], 1); }
#pragma unroll
            for (int rr = 0; rr < 4; ++rr) { const int row = row0 + wave * 4 + rr;
                RE[2 * row] = e0s[rr]; RE[2 * row + 1] = e1s[rr]; RP[2 * row] = p0[rr]; RP[2 * row + 1] = p1[rr]; RW[2 * row] = w0s[rr]; RW[2 * row + 1] = w1s[rr];
                LIST[e0s[rr] * 16384 + p0[rr]] = row; LIST[e1s[rr] * 16384 + p1[rr]] = row; }
        }
        __syncthreads();
    }
}

DI void build_tilebase(const Ctx& F) {
    const int* cnt = (const int*)(F.ws + WS_CTL) + CW_CNT; LAS int* tb = (LAS int*)(F.lds + TB_OFF);
    if (F.wave == 0) {
        const int lane = lane_id(); const int tiles = (cnt[64 * lane] + 255) >> 8; int inc = tiles;
#pragma unroll
        for (int o = 1; o < 64; o <<= 1) { const int t = __shfl_up(inc, o); if (lane >= o) inc += t; }
        tb[lane] = inc - tiles; if (lane == 63) tb[NE] = inc; ((LAS int*)(F.lds + CNTL_OFF))[lane] = cnt[64 * lane];
    }
    __syncthreads();
}
DI void fill_tokl(const Ctx& F, const MoeOrder& S) {
    const LAS int* tb = (const LAS int*)(F.lds + TB_OFF); const LAS int* cntl = (const LAS int*)(F.lds + CNTL_OFF); LAS int* tokl = (LAS int*)(F.lds + TOKL_OFF);
    const int* LIST = (const int*)(F.ws + WS_LIST); const int tid = F.wave * 64 + lane_id();
    for (int i = 0; i < 4; ++i) { pg8::Unit u; if (!S.next(i, u)) break;
        const int e = u.pn >> 2, r = 256 * (u.pm - tb[e]) + tid;
        if (tid < 256) tokl[256 * i + tid] = (r < cntl[e]) ? LIST[e * 16384 + r] : 0; }
    asm volatile("s_waitcnt vmcnt(0) lgkmcnt(0)" ::: "memory"); __syncthreads();
}
DI void ph12_final(const Ctx& F, const Args& a, int reps) {
    const float* mod = (const float*)(F.ws + WS_CTL) + CW_MODC; float* H = (float*)argp<N_IN>(); const bf16* H16 = (const bf16*)(F.ws + WS_H16); const float* fg = ARG(I_FG);
    const unsigned char* YE = F.ws + WS_YEXP; const int* RE = (const int*)(F.ws + WS_ROUTE); const int* RP = RE + 2 * M; const float* RW = (const float*)(F.ws + WS_ROUTE) + 4 * M;
    const LAS int* tb = (const LAS int*)(F.lds + TB_OFF);
    float* OUT2 = (float*)(F.ws + WS_U);
    const int gw = F.vcu * NWAVES + F.wave, NGW = F.G * NWAVES, lane = lane_id();
    f32x4 g2[4], fgv[4];
#pragma unroll
    for (int j = 0; j < 4; ++j) { g2[j] = *(const f32x4*)(mod + 5 * 1024 + 256 * j + 4 * lane); fgv[j] = *(const f32x4*)(fg + 256 * j + 4 * lane); }
    const int RT = (M / 2 + NGW - 1) / NGW;
    for (int it = 0; it < RT * reps; ++it) {
        const int t0 = 2 * xcd_unit(F.xcd, F.xj * NWAVES + F.wave, NGW >> 3, (it >= RT ? it - RT : it), M / 2); if (t0 < 0) break;
        float* O = (it >= RT * (reps - 1)) ? H : OUT2;
        int tt[2], d0[2], d1[2]; float w0[2], w1[2];
#pragma unroll
        for (int u = 0; u < 2; ++u) { tt[u] = (t0 + u) % M; d0[u] = 256 * tb[RE[2 * tt[u]]] + RP[2 * tt[u]]; d1[u] = 256 * tb[RE[2 * tt[u] + 1]] + RP[2 * tt[u] + 1]; w0[u] = RW[2 * tt[u]]; w1[u] = RW[2 * tt[u] + 1]; }
        f32x4 hv[2][4]; unsigned ya[2][4], yb[2][4];
#pragma unroll
        for (int u = 0; u < 2; ++u)
#pragma unroll
            for (int j = 0; j < 4; ++j) { const v2u hw = *(const v2u*)(H16 + (size_t)tt[u] * D + 256 * j + 4 * lane); hv[u][j] = (f32x4){bflo(hw.x), bfhi(hw.x), bflo(hw.y), bfhi(hw.y)};
                ya[u][j] = *(const unsigned*)(YE + (size_t)d0[u] * D + 256 * j + 4 * lane); yb[u][j] = *(const unsigned*)(YE + (size_t)d1[u] * D + 256 * j + 4 * lane); }
#pragma unroll
        for (int u = 0; u < 2; ++u) {
            f32x4 v[4]; float ss = 0.f;
#pragma unroll
            for (int j = 0; j < 4; ++j) { const unsigned a4 = ya[u][j], b4 = yb[u][j];
                const f2v a01 = __builtin_amdgcn_cvt_pk_f32_fp8(a4, false), a23 = __builtin_amdgcn_cvt_pk_f32_fp8(a4, true), b01 = __builtin_amdgcn_cvt_pk_f32_fp8(b4, false), b23 = __builtin_amdgcn_cvt_pk_f32_fp8(b4, true);
                f32x4 mo; mo.x = w0[u] * a01.x + w1[u] * b01.x; mo.y = w0[u] * a01.y + w1[u] * b01.y; mo.z = w0[u] * a23.x + w1[u] * b23.x; mo.w = w0[u] * a23.y + w1[u] * b23.y;
                mo = mo * 0.0625f;
                v[j] = hv[u][j] + g2[j] * mo; ss += (v[j].x * v[j].x + v[j].y * v[j].y) + (v[j].z * v[j].z + v[j].w * v[j].w); }
            const float rstd = 1.0f / sqrtf(wave_sum(ss) * (1.0f / D) + EPS);
#pragma unroll
            for (int j = 0; j < 4; ++j) *(f32x4*)(O + (size_t)tt[u] * D + 256 * j + 4 * lane) = v[j] * rstd * fgv[j];
        }
    }
}

constexpr int N_PHASES = 13;
#ifndef REP_MASK
#define REP_MASK 0
#endif
#define REPS(k) (((REP_MASK >> (k)) & 1) ? 2 : 1)
#ifndef MK_ONE_LAUNCH
#define MK_ONE_LAUNCH 1
#endif

struct RepOrder { pg8::StaticOrder s; int n, reps;
    DI bool next(int i, pg8::Unit& u) const { if (i >= n * reps) return false; return s.next(i % n, u); }
    DI void a_ready(const pg8::Unit&) const {}
    DI void done(const pg8::Unit&) const {} };

__global__ void __launch_bounds__(NTHREADS, 2) fwd_kernel(Args args) {
    extern __shared__ __attribute__((aligned(16))) unsigned char lds_raw[];
    Ctx F;
    F.lds = (LAS unsigned char*)lds_raw;
    F.wave = __builtin_amdgcn_readfirstlane((int)threadIdx.x >> 6);
    F.G = gridDim.x; { const int bx = blockIdx.x; F.xcd = bx & 7; F.xj = bx >> 3; F.vcu = F.xcd * (F.G >> 3) + F.xj; }
    F.ws = (unsigned char*)argp<N_IN + 1>();
    volatile LAS unsigned* MISC = (volatile LAS unsigned*)(F.lds + LDSCTL_OFF);
    for (int u = threadIdx.x; u < (LDS_BYTES - LDSCTL_OFF) / 4; u += NTHREADS) ((LAS unsigned*)(F.lds + LDSCTL_OFF))[u] = 0u;
    __syncthreads();
    const int lo = args.ph_lo, hi = args.ph_hi;
    unsigned* barw = (unsigned*)(F.ws + WS_CTL) + CW_BAR;
    XcdBarrier bar; bar.bar = barw; bar.x = 0; bar.st = nullptr;
    if (hi - lo > 1) bar = xcd_barrier_post(barw, MISC + 8);
    bar.wave = F.wave;
#define IN(k) (lo <= (k) && (k) < hi)
#define SEAM(k) do { if (IN(k) && IN((k) + 1)) { xcd_barrier(bar); if (REPS(14) > 1) xcd_barrier(bar); } } while (0)
    unsigned char* ws = F.ws;
    bf16* XN = (bf16*)(ws + WS_XN);
    const float* mod = (const float*)(ws + WS_CTL) + CW_MOD;

    if (IN(0)) { ph0_prologue(F, args, REPS(0)); SEAM(0); }
    if (IN(1)) { for (int rep = 0; rep < REPS(1); ++rep) { ph1_norm_dt(F, args); __syncthreads(); } SEAM(1); }
    if (IN(2)) {
        pg8::Gemm g{(const bf16*)(ws + WS_XN8), (const bf16*)(ws + WS_W8IN), M, NPROJ, D / 2}; pg8::StaticOrder S; S.init(M, NPROJ, F.G, (int)blockIdx.x);
        EpiInProj E{ws};
        RepOrder R{S, (S.nwg - S.c + S.G - 1) / S.G, REPS(2)};
        pg8::gemm_phase<EpiInProj, RepOrder, true, true, false, false, true>(F.lds, g, R, E, F.wave);
        SEAM(2);
    }
    if (IN(3)) { ph3_chunk_states(F, args, REPS(13)); __syncthreads(); ph3_convbranch(F, args, REPS(3)); __syncthreads(); SEAM(3); }
    if (IN(4)) {
        if (REPS(4) > 1) ph4_scan(F, WS_YS);
        ph4_scan(F, WS_ST);
        pg8::Gemm g{XN, (const bf16*)(ws + WS_WCV), M, D, D}; pg8::StaticOrder S; S.init(M, D, F.G, (int)blockIdx.x);
        EpiGate<false> E{(bf16*)(ws + WS_TMP), nullptr, (const bf16*)(ws + WS_GATE), 0, nullptr};
        RepOrder R{S, (S.nwg - S.c + S.G - 1) / S.G, REPS(15)};
        pg8::gemm_phase<EpiGate<false>, RepOrder, false, true>(F.lds, g, R, E, F.wave);
        SEAM(4);
    }
    if (IN(5)) { ph5_ssd_out(F, args, REPS(5)); SEAM(5); }
    if (IN(6)) {
        pg8::Gemm g{(const bf16*)(ws + WS_YS), (const bf16*)(ws + WS_WSSM), M, D, DIN / 2}; pg8::StaticOrder S; S.init(M, D, F.G, (int)blockIdx.x);
        LAS float* rt = (LAS float*)(F.lds + RT_OFF);
        EpiGate<true> E{(bf16*)(ws + WS_MG), (const bf16*)(ws + WS_TMP), (const bf16*)(ws + WS_GATE), 1024, rt};
        for (int i = 0;; ++i) {
            OneUnit S1; if (!S.next(i, S1.u)) break;
            if (F.wave < 4) { const int tid = F.wave * 64 + lane_id(); const f32x4 r = *(const f32x4*)((const float*)(ws + WS_RSTD) + (size_t)(S1.u.pm * 256 + tid) * 4);
                *(LAS f32x4*)(rt + tid * 4) = (f32x4){r.x / r.y, r.y / r.z, r.z / r.w, r.w}; }
            asm volatile("s_waitcnt vmcnt(0) lgkmcnt(0)" ::: "memory"); __syncthreads();
            pg8::gemm_phase<EpiGate<true>, OneUnit, false, true, true>(F.lds, g, S1, E, F.wave);
            __syncthreads();
        }
        SEAM(6);
    }
    if (IN(7)) {
        pg8::Gemm g{(const bf16*)(ws + WS_MG), (const bf16*)(ws + WS_WMIX), M, D, D}; pg8::StaticOrder S; S.init(M, D, F.G, (int)blockIdx.x);
        EpiMix E{(bf16*)(ws + WS_H16), ARG(I_X), (const float*)(ws + WS_CTL) + CW_MODC + 2 * 1024};
        RepOrder R{S, (S.nwg - S.c + S.G - 1) / S.G, REPS(7)};
        pg8::gemm_phase<EpiMix, RepOrder, false, true>(F.lds, g, R, E, F.wave);
        SEAM(7);
    }
    if (IN(8)) { for (int rep = 0; rep < REPS(8); ++rep) { convert_experts(F, args); __syncthreads(); } ph8_router(F, args, REPS(9)); if (IN(8) && IN(10)) xcd_barrier(bar); }
    if (IN(10)) {
        build_tilebase(F);
        const LAS int* tb = (const LAS int*)(F.lds + TB_OFF);
        pg8::Gemm g{(const bf16*)(ws + WS_XN), (const bf16*)(ws + WS_W13), M, NE * 1024, D / 2};
        MoeOrder S{tb, F.G, F.vcu, tb[NE] * 4, 1, (const LAS int*)(F.lds + TOKL_OFF)};
        fill_tokl(F, S);
        EpiUp E{ws + WS_HDN};
        pg8::gemm_phase<EpiUp, MoeOrder, true, true, true, true>(F.lds, g, S, E, F.wave);
        SEAM(10);
    }
    if (IN(11)) {
        build_tilebase(F);
        const LAS int* tb = (const LAS int*)(F.lds + TB_OFF);
        pg8::Gemm g{(const bf16*)(ws + WS_HDN), (const bf16*)(ws + WS_W2), 49152, NE * 1024, DFF / 2};
        MoeOrder S{tb, F.G, F.vcu, tb[NE] * 4, 1, nullptr};
        EpiDown E{ws + WS_YEXP};
        pg8::gemm_phase<EpiDown, MoeOrder, true, true, true>(F.lds, g, S, E, F.wave);
        SEAM(11);
    }
    if (IN(12)) { build_tilebase(F); ph12_final(F, args, REPS(12)); }
#undef IN
#undef SEAM
}

extern "C" void kernel_launch(void* const* d_in, const int* in_sizes, int n_in, void* d_out, int out_size, void* d_ws, size_t ws_size, hipStream_t stream) {
    static int grid = 0;
    if (grid == 0) {
        if (n_in != N_IN || in_sizes[0] != M * D || out_size != M * D || ws_size < WS_END) {
            fprintf(stderr, "kernel_launch: unexpected shapes: n_in %d in0 %d out %d ws %zu (need %zu)\n", n_in, n_in > 0 ? in_sizes[0] : -1, out_size, ws_size, (size_t)WS_END); grid = -1; return; }
        int dev = 0, cus = 0, per_cu = 0;
        if (hipGetDevice(&dev) != hipSuccess || hipDeviceGetAttribute(&cus, hipDeviceAttributeMultiprocessorCount, dev) != hipSuccess) { fprintf(stderr, "kernel_launch: device query failed\n"); grid = -1; return; }
        if (hipFuncSetAttribute((const void*)fwd_kernel, hipFuncAttributeMaxDynamicSharedMemorySize, LDS_BYTES) != hipSuccess) { fprintf(stderr, "kernel_launch: hipFuncSetAttribute failed\n"); grid = -1; return; }
        if (hipOccupancyMaxActiveBlocksPerMultiprocessor(&per_cu, (const void*)fwd_kernel, NTHREADS, LDS_BYTES) != hipSuccess || per_cu < 1) {
            fprintf(stderr, "kernel_launch: the occupancy query admits no workgroup of this kernel per CU (%d); nothing launched\n", per_cu); (void)hipGetLastError(); grid = -1; return; }
        grid = cus;
        if (cus < 192 || (cus & 7)) { fprintf(stderr, "kernel_launch: built for a 256-CU device (the MoE unit table holds 4 units per workgroup); %d CUs: nothing launched\n", cus); grid = -1; return; }
        fprintf(stderr, "kernel_launch: grid %d (cus %d, per_cu %d)\n", grid, cus, per_cu);
    }
    if (grid < 0) return;
    (void)hipMemsetAsync((char*)d_ws + WS_CTL, 0, CTL_ZERO_BYTES, stream);
    Args a{};
    for (int i = 0; i < N_IN; ++i) a.in[i] = (const float*)d_in[i];
    a.out = (float*)d_out; a.ws = (unsigned char*)d_ws;
#if MK_ONE_LAUNCH
    a.ph_lo = 0; a.ph_hi = N_PHASES;
    void* kargs[] = {&a};
    hipError_t e = hipLaunchCooperativeKernel((const void*)fwd_kernel, dim3(grid), dim3(NTHREADS), kargs, LDS_BYTES, stream);
    if (e != hipSuccess) fprintf(stderr, "kernel_launch: cooperative launch failed: %s\n", hipGetErrorString(e));
#else
    for (int ph = 0; ph < N_PHASES; ++ph) {
        a.ph_lo = ph; a.ph_hi = ph + 1;
        hipLaunchKernelGGL(fwd_kernel, dim3(grid), dim3(NTHREADS), LDS_BYTES, stream, a);
    }
#endif
}
```

```cpp
#include <hip/hip_runtime.h>
#include <hip/hip_cooperative_groups.h>
#include <cstdio>
#include <cstdint>
namespace pg8 {
#define PG8_LAS __attribute__((address_space(3)))
typedef unsigned short bf16_t;
typedef short bf16x8 __attribute__((ext_vector_type(8)));
typedef float f32x4 __attribute__((ext_vector_type(4)));
typedef unsigned u32x4 __attribute__((ext_vector_type(4)));
typedef int v4i_ __attribute__((ext_vector_type(4)));
typedef int v8i_ __attribute__((ext_vector_type(8)));
constexpr int BM = 256, BK = 64, HALF = 128, HTB = HALF * BK * 2  , STAGE_BYTES = 8 * HTB, NXCD = 8, WGM = 8;

__host__ __device__ __forceinline__ int lds_byte(int r, int c) { const int st = (r >> 4) * 2 + (c >> 5), rr = r & 15, cc = c & 31, ob = rr * 64 + cc * 2; return st * 1024 + (ob ^ (((ob >> 9) & 1) << 5)); }
__host__ __device__ __forceinline__ void stage_rc(int b, int& R, int& C) { const int st = b / 1024, sb = b % 1024, swz = sb ^ (((sb >> 9) & 1) << 5); R = (st >> 1) * 16 + swz / 64; C = (st & 1) * 32 + (swz % 64) / 2; }
__host__ __device__ __forceinline__ int perm32(int rho) { const int n = rho >> 4, i = rho & 15; return 8 * (i >> 2) + 4 * n + (i & 3); }

struct Unit { int pm, pn; };
struct Gemm { const bf16_t* A; const bf16_t* Bt; int M, N, K; };

struct StaticOrder {
    int nM, nN, nwg, G, c;
    __host__ __device__ void init(int M, int N, int G_, int c_) { nM = M / BM; nN = N / BM; nwg = nM * nN; G = G_; c = c_; }
    __host__ __device__ bool next(int i, Unit& u) const {
        const long L = (long)i * G + c; if (L >= nwg) return false;
        int wgid = (int)L; { const int q = nwg / NXCD, r = nwg % NXCD, xcd = wgid % NXCD, off = wgid / NXCD; wgid = (xcd < r ? xcd * (q + 1) : r * (q + 1) + (xcd - r) * q) + off; }
        const int nig = WGM * nN, gid = wgid / nig, fm = gid * WGM, gsz = (nM - fm) < WGM ? (nM - fm) : WGM;
        u.pm = fm + ((wgid % nig) % gsz); u.pn = (wgid % nig) / gsz; return true;
    }
    __device__ __forceinline__ void a_ready(const Unit&) const {}
    __device__ __forceinline__ void done(const Unit&) const {}
};

__device__ __forceinline__ unsigned cvt_pk_bf16(float lo, float hi) { unsigned r; asm volatile("v_cvt_pk_bf16_f32 %0, %1, %2" : "=v"(r) : "v"(lo), "v"(hi)); return r; }
typedef float f32x2 __attribute__((ext_vector_type(2)));
template <class Epi, class Sched, bool ALIGN_EPI = false, bool SP2 = false, bool FP8 = false, bool GATHER = false, bool I8 = false>
__device__ __forceinline__ void gemm_phase(PG8_LAS unsigned char* lds, const Gemm g, const Sched& S, const Epi& E, const int wave_in) {
    const int lane = (int)__builtin_amdgcn_mbcnt_hi(~0u, __builtin_amdgcn_mbcnt_lo(~0u, 0u)), wid = wave_in, tid = wid * 64 + lane, wr = wid >> 2, wc = wid & 3, fr = lane & 15, fq = lane >> 4;
    const int K = g.K, nt = K / BK;
    unsigned voffA[2], voffB[2];
#pragma unroll
    for (int i = 0; i < 2; ++i) { int R, C; stage_rc(tid * 16 + i * 8192, R, C); const int Rb = Epi::PERM ? ((R & ~31) + perm32(R & 31)) : R;
        voffA[i] = (unsigned)(R * K + C) * 2u; voffB[i] = (unsigned)(Rb * K + C) * 2u; }
    static_assert(!GATHER || SP2, "GATHER is implemented in the SP2 loop");
    unsigned gA[2][2], ngA[2][2]; int RA[2]; unsigned CA2[2];
#pragma unroll
    for (int i = 0; i < 2; ++i) { int R, C; stage_rc(tid * 16 + i * 8192, R, C); RA[i] = R; CA2[i] = (unsigned)C * 2u; }
    auto load_g = [&](int ui_, unsigned (&dst)[2][2]) {
        if constexpr (GATHER) {
#pragma unroll
            for (int h = 0; h < 2; ++h)
#pragma unroll
                for (int i = 0; i < 2; ++i) dst[h][i] = (unsigned)S.tokl[ui_ * 256 + 128 * h + RA[i]] * (unsigned)(K * 2) + CA2[i];
        }
    };
    const size_t kstep = (size_t)(BK * 2);
    const size_t hstep = (size_t)HALF * K * 2;
    const size_t tstep = 2 * hstep;
    const size_t hstepA = GATHER ? (size_t)0 : hstep, tstepA = GATHER ? (size_t)0 : 2 * hstep;
    const unsigned ldsw = (unsigned)wid * 1024u;
    const int aoff = lds_byte(wr * 64 + fr, fq * 8), boff = lds_byte(wc * 32 + fr, fq * 8);
#define PG8_SA(b, h) (((b) * 2 + (h)) * HTB)
#define PG8_SB(b, h) ((4 + (b) * 2 + (h)) * HTB)
#define PG8_STAGE(bufoff, gbase, voff) do { _Pragma("unroll") for (int _i = 0; _i < 2; ++_i) \
        __builtin_amdgcn_global_load_lds((const unsigned*)((const char*)(gbase) + (voff)[_i]), (PG8_LAS unsigned*)(lds + (bufoff) + ldsw + _i * 8192), 16, 0, 0); } while (0)
#define PG8_STAGE_A(bufoff, gbase, gvoff) do { if constexpr (GATHER) { PG8_STAGE(bufoff, gbase, gvoff); } else { PG8_STAGE(bufoff, gbase, voffA); } } while (0)
#define PG8_LDA(dst, b, h) do { if constexpr (FP8) { _Pragma("unroll") for (int m = 0; m < 4; ++m) dst##8[m] = __builtin_shufflevector(*(const PG8_LAS v4i_*)(lds + PG8_SA(b, h) + aoff + m * 2048), *(const PG8_LAS v4i_*)(lds + PG8_SA(b, h) + aoff + m * 2048 + 1024), 0, 1, 2, 3, 4, 5, 6, 7); } \
        else { _Pragma("unroll") for (int m = 0; m < 4; ++m) _Pragma("unroll") for (int k = 0; k < 2; ++k) dst[m][k] = *(const PG8_LAS bf16x8*)(lds + PG8_SA(b, h) + aoff + m * 2048 + k * 1024); } } while (0)
#define PG8_LDB(dst, b, h) do { if constexpr (FP8) { _Pragma("unroll") for (int n = 0; n < 2; ++n) dst##8[n] = __builtin_shufflevector(*(const PG8_LAS v4i_*)(lds + PG8_SB(b, h) + boff + n * 2048), *(const PG8_LAS v4i_*)(lds + PG8_SB(b, h) + boff + n * 2048 + 1024), 0, 1, 2, 3, 4, 5, 6, 7); } \
        else { _Pragma("unroll") for (int n = 0; n < 2; ++n) _Pragma("unroll") for (int k = 0; k < 2; ++k) dst[n][k] = *(const PG8_LAS bf16x8*)(lds + PG8_SB(b, h) + boff + n * 2048 + k * 1024); } } while (0)
#define PG8_MMA(ai, bj, At, Bt) do { __builtin_amdgcn_s_setprio(1); \
        if constexpr (FP8) {   \
              \
            _Pragma("unroll") for (int m = 0; m < 4; ++m) _Pragma("unroll") for (int n = 0; n < 2; ++n) \
                asm volatile("v_mfma_scale_f32_16x16x128_f8f6f4 %0, %1, %2, %0, %3, %4 op_sel_hi:[0,0,0]" : "+v"(acc[ai][bj][m][n]) : "v"(Bt##8[n]), "v"(At##8[m]), "v"(scale_w), "v"(scale_x)); \
        } else { \
        _Pragma("unroll") for (int m = 0; m < 4; ++m) _Pragma("unroll") for (int n = 0; n < 2; ++n) _Pragma("unroll") for (int k = 0; k < 2; ++k) { \
        if constexpr (I8) acc[ai][bj][m][n] = __builtin_bit_cast(f32x4, __builtin_amdgcn_mfma_i32_16x16x64_i8(__builtin_bit_cast(v4i_, Bt[n][k]), __builtin_bit_cast(v4i_, At[m][k]), __builtin_bit_cast(v4i_, acc[ai][bj][m][n]), 0, 0, 0)); \
        else acc[ai][bj][m][n] = __builtin_amdgcn_mfma_f32_16x16x32_bf16(Bt[n][k], At[m][k], acc[ai][bj][m][n], 0, 0, 0); } } __builtin_amdgcn_s_setprio(0); } while (0)
#define PG8_WAIT_V(n) asm volatile("s_waitcnt vmcnt(" #n ")" ::: "memory")
#define PG8_WAIT_L(n) asm volatile("s_waitcnt lgkmcnt(" #n ")" ::: "memory")
#define PG8_BAR __builtin_amdgcn_s_barrier()
#define PG8_SCHED __builtin_amdgcn_sched_barrier(0)
    Unit cur, nxt; int ui = 0;
    if (!S.next(0, cur)) return;
    f32x4 acc[2][2][4][2];
#pragma unroll
    for (int a = 0; a < 2; ++a)
#pragma unroll
        for (int b = 0; b < 2; ++b)
#pragma unroll
            for (int m = 0; m < 4; ++m)
#pragma unroll
                for (int n = 0; n < 2; ++n) acc[a][b][m][n] = (f32x4){0.f, 0.f, 0.f, 0.f};
    auto xdl_settle = [&]() {
        asm volatile("s_nop 15\n\ts_nop 15" : "+v"(acc[0][0][0][0]), "+v"(acc[0][0][0][1]), "+v"(acc[0][0][1][0]), "+v"(acc[0][0][1][1]), "+v"(acc[0][0][2][0]), "+v"(acc[0][0][2][1]), "+v"(acc[0][0][3][0]), "+v"(acc[0][0][3][1]), "+v"(acc[0][1][0][0]), "+v"(acc[0][1][0][1]), "+v"(acc[0][1][1][0]), "+v"(acc[0][1][1][1]), "+v"(acc[0][1][2][0]), "+v"(acc[0][1][2][1]), "+v"(acc[0][1][3][0]), "+v"(acc[0][1][3][1]));
        asm volatile("s_nop 0" : "+v"(acc[1][0][0][0]), "+v"(acc[1][0][0][1]), "+v"(acc[1][0][1][0]), "+v"(acc[1][0][1][1]), "+v"(acc[1][0][2][0]), "+v"(acc[1][0][2][1]), "+v"(acc[1][0][3][0]), "+v"(acc[1][0][3][1]), "+v"(acc[1][1][0][0]), "+v"(acc[1][1][0][1]), "+v"(acc[1][1][1][0]), "+v"(acc[1][1][1][1]), "+v"(acc[1][1][2][0]), "+v"(acc[1][1][2][1]), "+v"(acc[1][1][3][0]), "+v"(acc[1][1][3][1]));
    };
    const int scale_w = 0x79797979, scale_x = 0x7f7f7f7f;
    bf16x8 At[4][2], B0[2][2], B1[2][2]; v8i_ At8[4], B08[2], B18[2];
    const char* cA = (const char*)g.A + (size_t)cur.pm * tstepA; const char* cB = (const char*)g.Bt + (size_t)cur.pn * tstep;
    load_g(0, gA);
    S.a_ready(cur);
    if constexpr (SP2) {
        PG8_STAGE(PG8_SB(0, 0), cB, voffB); PG8_STAGE(PG8_SB(0, 1), cB + hstep, voffB); PG8_STAGE_A(PG8_SA(0, 0), cA, gA[0]); PG8_STAGE_A(PG8_SA(0, 1), cA + hstepA, gA[1]);
        if (wr == 1) PG8_BAR;
        PG8_WAIT_V(2); PG8_BAR;
        PG8_STAGE(PG8_SB(1, 0), cB + kstep, voffB); PG8_STAGE_A(PG8_SA(1, 0), cA + kstep, gA[0]); PG8_STAGE(PG8_SB(1, 1), cB + hstep + kstep, voffB);
        PG8_WAIT_V(6); PG8_BAR;
    } else {
        PG8_STAGE(PG8_SB(0, 0), cB, voffB); PG8_STAGE(PG8_SA(0, 0), cA, voffA); PG8_STAGE(PG8_SB(0, 1), cB + hstep, voffB); PG8_STAGE(PG8_SA(0, 1), cA + hstep, voffA);
        if (wr == 1) PG8_BAR;
        PG8_WAIT_V(4); PG8_BAR;
        PG8_STAGE(PG8_SB(1, 0), cB + kstep, voffB); PG8_STAGE(PG8_SA(1, 0), cA + kstep, voffA); PG8_STAGE(PG8_SB(1, 1), cB + hstep + kstep, voffB);
        PG8_WAIT_V(6); PG8_BAR;
    }
    for (;;) {
        const bool has_next = S.next(ui + 1, nxt);
        const char* nA = has_next ? (const char*)g.A + (size_t)nxt.pm * tstepA : cA; const char* nB = has_next ? (const char*)g.Bt + (size_t)nxt.pn * tstep : cB;
        if constexpr (GATHER) { if (has_next) load_g(ui + 1, ngA); else {
#pragma unroll
            for (int h = 0; h < 2; ++h)
#pragma unroll
                for (int i = 0; i < 2; ++i) ngA[h][i] = gA[h][i]; } }
        for (int t = 0; t < nt; t += 2) {
            const bool last = (t == nt - 2);
            const char* a1 = cA + (size_t)(t + 1) * kstep;
            const char* a2 = last ? nA : cA + (size_t)(t + 2) * kstep; const char* b2 = last ? nB : cB + (size_t)(t + 2) * kstep;
            const char* a3 = a2 + kstep; const char* b3 = b2 + kstep;
            if (last && has_next) S.a_ready(nxt);
            unsigned sN[2][2];
#pragma unroll
            for (int h = 0; h < 2; ++h)
#pragma unroll
                for (int i = 0; i < 2; ++i) sN[h][i] = last ? ngA[h][i] : gA[h][i];
            if constexpr (SP2) {
            PG8_LDB(B0, 0, 0); PG8_LDB(B1, 0, 1); PG8_SCHED; PG8_LDA(At, 0, 0); PG8_STAGE_A(PG8_SA(1, 1), a1 + hstepA, gA[1]);
            PG8_WAIT_V(8); PG8_WAIT_L(0); PG8_BAR; PG8_MMA(0, 0, At, B0); PG8_MMA(0, 1, At, B1); PG8_BAR; PG8_SCHED;
            PG8_LDA(At, 0, 1); PG8_STAGE(PG8_SB(0, 0), b2, voffB); PG8_STAGE(PG8_SB(0, 1), b2 + hstep, voffB); PG8_STAGE_A(PG8_SA(0, 0), a2, sN[0]);
            PG8_WAIT_V(8); PG8_WAIT_L(0); PG8_BAR; PG8_MMA(1, 0, At, B0); PG8_MMA(1, 1, At, B1); PG8_BAR; PG8_SCHED;
            PG8_LDB(B0, 1, 0); PG8_LDB(B1, 1, 1); PG8_SCHED; PG8_LDA(At, 1, 0); PG8_STAGE_A(PG8_SA(0, 1), a2 + hstepA, sN[1]);
            PG8_WAIT_V(8); PG8_WAIT_L(0); PG8_BAR; PG8_MMA(0, 0, At, B0); PG8_MMA(0, 1, At, B1); PG8_BAR; PG8_SCHED;
            PG8_LDA(At, 1, 1); PG8_STAGE(PG8_SB(1, 0), b3, voffB); PG8_STAGE(PG8_SB(1, 1), b3 + hstep, voffB); PG8_STAGE_A(PG8_SA(1, 0), a3, sN[0]);
            PG8_WAIT_V(8); PG8_WAIT_L(0); PG8_BAR; PG8_MMA(1, 0, At, B0); PG8_MMA(1, 1, At, B1); PG8_BAR; PG8_SCHED;
            } else {
            PG8_LDB(B0, 0, 0); PG8_SCHED; PG8_LDA(At, 0, 0); PG8_STAGE(PG8_SA(1, 1), a1 + hstep, voffA);
            PG8_WAIT_L(8); PG8_BAR; PG8_WAIT_L(0); PG8_MMA(0, 0, At, B0); PG8_BAR; PG8_SCHED;
            PG8_LDB(B1, 0, 1); PG8_STAGE(PG8_SB(0, 0), b2, voffB);
            PG8_BAR; PG8_WAIT_L(0); PG8_MMA(0, 1, At, B1); PG8_BAR;
            PG8_LDA(At, 0, 1); PG8_STAGE(PG8_SA(0, 0), a2, voffA);
            PG8_BAR; PG8_WAIT_L(0); PG8_MMA(1, 0, At, B0); PG8_BAR; PG8_SCHED;
            PG8_STAGE(PG8_SB(0, 1), b2 + hstep, voffB);
            PG8_WAIT_V(6); PG8_BAR; PG8_MMA(1, 1, At, B1); PG8_BAR;
            PG8_LDB(B0, 1, 0); PG8_SCHED; PG8_LDA(At, 1, 0); PG8_STAGE(PG8_SA(0, 1), a2 + hstep, voffA);
            PG8_WAIT_L(8); PG8_BAR; PG8_WAIT_L(0); PG8_MMA(0, 0, At, B0); PG8_BAR; PG8_SCHED;
            PG8_LDB(B1, 1, 1); PG8_STAGE(PG8_SB(1, 0), b3, voffB);
            PG8_BAR; PG8_WAIT_L(0); PG8_MMA(0, 1, At, B1); PG8_BAR;
            PG8_LDA(At, 1, 1); PG8_STAGE(PG8_SA(1, 0), a3, voffA);
            PG8_BAR; PG8_WAIT_L(0); PG8_MMA(1, 0, At, B0); PG8_BAR; PG8_SCHED;
            PG8_STAGE(PG8_SB(1, 1), b3 + hstep, voffB);
            PG8_WAIT_V(6); PG8_BAR; PG8_MMA(1, 1, At, B1); PG8_BAR;
            }
            if constexpr (Epi::KHOOK) { constexpr int HK = FP8 ? 4 : 8, HS = FP8 ? 2 : 3;
                if ((((t + 2) & (HK - 1)) == 0) && (t + 2 < nt)) { if constexpr (FP8) xdl_settle(); E.khook(acc, ((t + 2) >> HS) - 1, wr, fr); if constexpr (FP8) xdl_settle(); } }
        }
        if constexpr (ALIGN_EPI) { if (wr == 0) PG8_BAR; }
        if constexpr (FP8) {
            xdl_settle();
        }
        if constexpr (!Epi::AFTER_DRAIN) { E(acc, cur, wr, wc, fr, fq); S.done(cur); }
        if (!has_next) break;
#pragma unroll
        for (int a = 0; a < 2; ++a)
#pragma unroll
            for (int b = 0; b < 2; ++b)
#pragma unroll
                for (int m = 0; m < 4; ++m)
#pragma unroll
                    for (int n = 0; n < 2; ++n) acc[a][b][m][n] = (f32x4){0.f, 0.f, 0.f, 0.f};
        cur = nxt; cA = nA; cB = nB; ++ui;
        if constexpr (GATHER) {
#pragma unroll
            for (int h = 0; h < 2; ++h)
#pragma unroll
                for (int i = 0; i < 2; ++i) gA[h][i] = ngA[h][i]; }
        if constexpr (ALIGN_EPI) { if (wr == 1) PG8_BAR; }
    }
    PG8_WAIT_V(0);
    if constexpr (!ALIGN_EPI) { if (wr == 0) PG8_BAR; }
    PG8_BAR;
    if constexpr (Epi::AFTER_DRAIN) { E.fused(acc, cur, wr, wc, fr, fq, lds, wid, lane); S.done(cur); }
#undef PG8_SA
#undef PG8_SB
#undef PG8_STAGE
#undef PG8_STAGE_A
#undef PG8_LDA
#undef PG8_LDB
#undef PG8_MMA
#undef PG8_WAIT_V
#undef PG8_WAIT_L
#undef PG8_BAR
#undef PG8_SCHED
}
}

#define DI __device__ __forceinline__
#define GAS __attribute__((address_space(1)))
#define LAS __attribute__((address_space(3)))
typedef unsigned short bf16;
typedef unsigned v4u __attribute__((ext_vector_type(4)));
typedef unsigned v2u __attribute__((ext_vector_type(2)));
typedef float f32x4 __attribute__((ext_vector_type(4)));
typedef float f32x16 __attribute__((ext_vector_type(16)));
typedef short bf16x8 __attribute__((ext_vector_type(8)));
typedef __bf16 bf2v __attribute__((ext_vector_type(2)));
typedef float f2v __attribute__((ext_vector_type(2)));
typedef GAS unsigned gu32;

constexpr int NWAVES = 8, NTHREADS = 512;
constexpr int M = 16384, D = 1024, DIN = 2048, NH = 32, HD = 64, NGRP = 4, NST = 128, XBCW = 3072;
constexpr int NPROJ = 9216, WIN_LD = 9248;
constexpr int LCH = 128, NCH = M / LCH;
constexpr int NE = 64, DFF = 512;
constexpr float EPS = 1e-6f;
constexpr float LOG2E = 1.4426950408889634f;

constexpr size_t MiB = 1u << 20;
constexpr size_t WS_CTL = 0, CTL_ZERO_BYTES = 262144;
constexpr size_t WS_WIN = 1 * MiB, WS_WDT = 19 * MiB, WS_WCV = 20 * MiB, WS_WMIX = 22 * MiB, WS_WSSM = 24 * MiB;
constexpr size_t WS_RSTD = 31 * MiB + 524288;
constexpr size_t WS_DT = 28 * MiB, WS_CD = 30 * MiB, WS_WRH = 30 * MiB + 65536, WS_WRL = WS_WRH + 262144, WS_ROUTE = 31 * MiB;
constexpr size_t WS_ST = 32 * MiB, WS_YS = 96 * MiB, WS_TMP = 160 * MiB, WS_MG = 192 * MiB;
constexpr size_t WS_W13 = 32 * MiB, WS_W2 = 160 * MiB, WS_H16 = 96 * MiB;
constexpr size_t WS_XN8 = 32 * MiB, WS_W8IN = 48 * MiB, WS_SA = 60 * MiB, WS_SW = 61 * MiB;
constexpr size_t WS_XN = 224 * MiB;
constexpr size_t WS_U = 256 * MiB, WS_ZS = 288 * MiB, WS_XBC = 352 * MiB, WS_GATE = 448 * MiB;
constexpr size_t WS_LIST = 256 * MiB, WS_HDN = 352 * MiB, WS_YEXP = 400 * MiB;
constexpr size_t WS_END = 512 * MiB;
constexpr int CW_BAR = 4096;
constexpr int CW_CNT = 8192;
constexpr int CW_MODC = 40960;
constexpr int CW_WMAX = 49152;
constexpr int CW_MOD = 16384;

constexpr int RING_BYTES = 131072;
constexpr int LDSCTL_OFF = 147456;
constexpr int TB_OFF = LDSCTL_OFF + 256;
constexpr int CNTL_OFF = TB_OFF + 320;
constexpr int TOKL_OFF = LDSCTL_OFF + 1024;
constexpr int RT_OFF = 148480;
constexpr int LDS_BYTES = 152576;

#define LDS_WAIT() asm volatile("s_waitcnt lgkmcnt(0)" ::: "memory")
#define VM_WAIT() asm volatile("s_waitcnt vmcnt(0)" ::: "memory")

DI unsigned pk2(float lo, float hi) { f2v v = {lo, hi}; return __builtin_bit_cast(unsigned, __builtin_convertvector(v, bf2v)); }
DI unsigned pk4_fp8(float a, float b, float c, float d) {
    a = __builtin_fminf(__builtin_fmaxf(a, -448.f), 448.f); b = __builtin_fminf(__builtin_fmaxf(b, -448.f), 448.f);
    c = __builtin_fminf(__builtin_fmaxf(c, -448.f), 448.f); d = __builtin_fminf(__builtin_fmaxf(d, -448.f), 448.f);
    unsigned w = 0u; w = __builtin_amdgcn_cvt_pk_fp8_f32(a, b, w, false); w = __builtin_amdgcn_cvt_pk_fp8_f32(c, d, w, true); return w; }
DI unsigned pk4_fp8_nc(float a, float b, float c, float d) { unsigned w = 0u; w = __builtin_amdgcn_cvt_pk_fp8_f32(a, b, w, false); w = __builtin_amdgcn_cvt_pk_fp8_f32(c, d, w, true); return w; }
DI unsigned pk4_i8(float a, float b, float c, float d) {
    const int ia = (int)__builtin_rintf(a), ib = (int)__builtin_rintf(b), ic = (int)__builtin_rintf(c), id = (int)__builtin_rintf(d);
    return ((unsigned)ia & 255u) | (((unsigned)ib & 255u) << 8) | (((unsigned)ic & 255u) << 16) | ((unsigned)id << 24); }
DI float bflo(unsigned u) { return __uint_as_float(u << 16); }
DI float bfhi(unsigned u) { return __uint_as_float(u & 0xffff0000u); }
DI float sigmoidf_(float x) { return __builtin_amdgcn_rcpf(1.f + __builtin_amdgcn_exp2f(x * -LOG2E)); }
DI float siluf_(float x) { return x * __builtin_amdgcn_rcpf(1.f + __builtin_amdgcn_exp2f(x * -LOG2E)); }
DI float wave_sum(float v) {
#pragma unroll
    for (int o = 1; o < 64; o <<= 1) v += __shfl_xor(v, o);
    return v;
}
DI f32x4 mod4(const float* modp, int k) { return (*(const f32x4*)(modp + k) + *(const f32x4*)(modp + 6144 + k)) + (*(const f32x4*)(modp + 2 * 6144 + k) + *(const f32x4*)(modp + 3 * 6144 + k)); }
DI int crow(int reg, int hh) { return (reg & 3) + 8 * (reg >> 2) + 4 * hh; }
DI int swz(int row, int chunk) { return chunk ^ ((row ^ (row >> 3)) & 15); }
#define MFMA32(a, b, c) __builtin_amdgcn_mfma_f32_32x32x16_bf16((a), (b), (c), 0, 0, 0)

DI int lane_id() { return (int)__builtin_amdgcn_mbcnt_hi(~0u, __builtin_amdgcn_mbcnt_lo(~0u, 0u)); }
#define XB_TMO      128
#define XB_XCNT(j)  (256  + 64 * (j))
#define XB_XSUB(j)  (1280 + 64 * (j))
#define XB_XGEN(j)  (2304 + 64 * (j))
#define XB_TOP      3328
#define XB_TOPGEN   3392
#define XCD_BAR_WORDS 3456
#define XB_SPIN_CAP (1u << 18)
DI unsigned xb_ld(unsigned* p)              { return __hip_atomic_load(p, __ATOMIC_RELAXED, __HIP_MEMORY_SCOPE_AGENT); }
DI unsigned xb_add(unsigned* p, unsigned v) { return __hip_atomic_fetch_add(p, v, __ATOMIC_RELAXED, __HIP_MEMORY_SCOPE_AGENT); }
DI unsigned xb_xcc_id() { return (unsigned)__builtin_amdgcn_s_getreg((3 << 11) | 20) & 0xFu; }
#define XB_SPIN(cond, bar) do { unsigned _sp = 0; while (cond) { __builtin_amdgcn_s_sleep(1); \
    if ((++_sp & 255u) == 0u) { if (xb_ld(&(bar)[XB_TMO])) break; if (_sp > XB_SPIN_CAP) { atomicAdd(&(bar)[XB_TMO], 1u); break; } } } } while (0)
struct XcdBarrier { unsigned* bar; unsigned x; volatile LAS unsigned* st; int wave; };
DI XcdBarrier xcd_barrier_post(unsigned* bar, volatile LAS unsigned* st) {
    XcdBarrier b; b.bar = bar; b.x = xb_xcc_id(); b.st = st; b.wave = 0;
    if (threadIdx.x == 0) (void)xb_add(&bar[XB_XCNT(b.x)], 1u);
    return b;
}
DI void xcd_barrier_complete(unsigned* bar, unsigned x, unsigned& nloc, unsigned& nx) {
    const unsigned G = gridDim.x * gridDim.y * gridDim.z;
    unsigned sum, cnt, mine, sp = 0u;
    for (;;) {
        sum = 0u; cnt = 0u; mine = 0u;
#pragma unroll
        for (unsigned j = 0; j < 16; ++j) { const unsigned c = xb_ld(&bar[XB_XCNT(j)]); sum += c; cnt += (c > 0u) ? 1u : 0u; mine = (j == x) ? c : mine; }
        if (sum == G) break;
        __builtin_amdgcn_s_sleep(1);
        if ((++sp & 255u) == 0u) { if (xb_ld(&bar[XB_TMO])) break; if (sp > XB_SPIN_CAP) { atomicAdd(&bar[XB_TMO], 1u); break; } }
    }
    nloc = mine > 0u ? mine : 1u; nx = cnt > 0u ? cnt : 1u;
}
DI void xcd_barrier(const XcdBarrier& b) {
    asm volatile("s_waitcnt vmcnt(0)" ::: "memory");
    __syncthreads();
    if (b.wave == 0 && lane_id() == 0) {
        unsigned* bar = b.bar;
        __builtin_amdgcn_s_waitcnt(0);
        unsigned nloc = b.st[0], nx = b.st[1];
        if (nloc == 0u) { xcd_barrier_complete(bar, b.x, nloc, nx); b.st[0] = nloc; b.st[1] = nx; }
        const unsigned old = xb_add(&bar[XB_XSUB(b.x)], 1u);
        const unsigned gen = old / nloc;
        if (old + 1u == (gen + 1u) * nloc) {
            __builtin_amdgcn_fence(__ATOMIC_RELEASE, "agent");
            asm volatile("s_waitcnt vmcnt(0)" ::: "memory");
            const unsigned og = xb_add(&bar[XB_TOP], 1u);
            const unsigned tg = og / nx;
            if (og + 1u == (tg + 1u) * nx) xb_add(&bar[XB_TOPGEN], 1u);
            else XB_SPIN(xb_ld(&bar[XB_TOPGEN]) == tg, bar);
            __builtin_amdgcn_fence(__ATOMIC_ACQUIRE, "agent");
            xb_add(&bar[XB_XGEN(b.x)], 1u);
            asm volatile("s_waitcnt vmcnt(0)" ::: "memory");
        } else {
            XB_SPIN(xb_ld(&bar[XB_XGEN(b.x)]) == gen, bar);
            __builtin_amdgcn_fence(__ATOMIC_ACQUIRE, "agent");
            asm volatile("s_waitcnt vmcnt(0)" ::: "memory");
        }
    }
    __syncthreads();
}

enum { I_X = 0, I_C, I_WADA, I_BADA, I_N1G, I_WIN, I_CVW, I_CVB, I_LNG, I_LNB, I_WCV, I_SCW, I_SCB, I_DTB, I_ALOG, I_DSKIP, I_SNG, I_WSSM, I_WMIX,
       I_N2G, I_WGRP, I_BGRP, I_WER, I_BER, I_W1, I_W3, I_W2, I_FG, N_IN };
struct Args { const float* in[N_IN]; float* out; unsigned char* ws; int ph_lo, ph_hi; };

template <int I> DI const float* argp() {
    auto kp = __builtin_amdgcn_kernarg_segment_ptr();
    unsigned long long v;
    asm volatile("s_load_dwordx2 %0, %1, %2\n\ts_waitcnt lgkmcnt(0)" : "=s"(v) : "s"(kp), "i"(I * 8));
    return (const float*)(const GAS float*)v;
}
#define ARG(i) argp<i>()
struct Ctx {
    LAS unsigned char* lds;
    int wave, vcu, G, xcd, xj;
    unsigned char* ws;
};

DI int xcd_unit(int x, int j, int gx, int i, int N) { const int u = i * gx + j; return (u < (N >> 3)) ? x * (N >> 3) + u : -1; }
DI int inproj_tile(int p) { return p < 8 ? p + 8 : (p < 16 ? p + 20 : (p < 24 ? p - 16 : p - 8)); }
DI int win_col(int npp) { const int np = inproj_tile(npp >> 8) * 256 + (npp & 255);
    if (np < 2048) { const int q = np >> 3, rr = np & 7; return (rr >> 2) * 1024 + 4 * q + (rr & 3); } return np < 7168 ? np : np + 32; }
struct EpiInProj {
    static constexpr bool PERM = true, AFTER_DRAIN = false, KHOOK = false; static constexpr int NPF = 0;
    unsigned char* ws;
    DI static pg8::f32x4 cvt(const pg8::f32x4& a, float sr, const f32x4& sc) { const pg8::v4i_ q = __builtin_bit_cast(pg8::v4i_, a);
        return (pg8::f32x4){(float)q[0] * (sr * sc.x), (float)q[1] * (sr * sc.y), (float)q[2] * (sr * sc.z), (float)q[3] * (sr * sc.w)}; }
    DI void operator()(const pg8::f32x4 (&acc)[2][2][4][2], const pg8::Unit& u, int wr, int wc, int fr, int fq) const {
        const int pn = inproj_tile(u.pn), row0 = u.pm * 256 + wr * 64 + fr;
        const float* SA = (const float*)(ws + WS_SA); const float* SW = (const float*)(ws + WS_SW) + u.pn * 256 + wc * 32 + fq * 8;
        f32x4 sc[2][2];
#pragma unroll
        for (int bj = 0; bj < 2; ++bj) { sc[bj][0] = *(const f32x4*)(SW + bj * 128); sc[bj][1] = *(const f32x4*)(SW + bj * 128 + 4); }
        float sr[2][4];
#pragma unroll
        for (int ai = 0; ai < 2; ++ai)
#pragma unroll
            for (int m = 0; m < 4; ++m) sr[ai][m] = SA[row0 + ai * 128 + m * 16];
        if (pn < 8) {
            bf16* U = (bf16*)(ws + WS_U);
#pragma unroll
            for (int ai = 0; ai < 2; ++ai)
#pragma unroll
                for (int m = 0; m < 4; ++m) {
                    bf16* rowp = U + (size_t)(row0 + ai * 128 + m * 16) * D + pn * 128 + wc * 16 + fq * 4;
#pragma unroll
                    for (int bj = 0; bj < 2; ++bj) { const pg8::f32x4 a = cvt(acc[ai][bj][m][0], sr[ai][m], sc[bj][0]), b = cvt(acc[ai][bj][m][1], sr[ai][m], sc[bj][1]);
                        v2u w; w.x = pk2(a[0] * sigmoidf_(b[0]), a[1] * sigmoidf_(b[1])); w.y = pk2(a[2] * sigmoidf_(b[2]), a[3] * sigmoidf_(b[3]));
                        *(v2u*)(rowp + bj * 64) = w; } }
        } else {
            const bool isz = pn < 16, isx = (pn >= 16) && (pn < 28);
            const size_t boff = isz ? WS_ZS : (isx ? WS_XBC : WS_GATE);
            const int ldc = isx ? XBCW : DIN;
            const int colt = (pn - (isz ? 8 : (isx ? 16 : 28))) * 256;
            bf16* base = (bf16*)(ws + boff);
            const int col0 = colt + wc * 32 + fq * 8;
#pragma unroll
            for (int ai = 0; ai < 2; ++ai)
#pragma unroll
                for (int m = 0; m < 4; ++m) {
                    bf16* rowp = base + (size_t)(row0 + ai * 128 + m * 16) * ldc + col0;
#pragma unroll
                    for (int bj = 0; bj < 2; ++bj) { pg8::f32x4 v0 = cvt(acc[ai][bj][m][0], sr[ai][m], sc[bj][0]), v1 = cvt(acc[ai][bj][m][1], sr[ai][m], sc[bj][1]);
                        if (isz) {
#pragma unroll
                            for (int i = 0; i < 4; ++i) { v0[i] = v0[i] * sigmoidf_(v0[i]); v1[i] = v1[i] * sigmoidf_(v1[i]); }
                        }
                        v4u w; w.x = pk2(v0[0], v0[1]); w.y = pk2(v0[2], v0[3]); w.z = pk2(v1[0], v1[1]); w.w = pk2(v1[2], v1[3]);
                        *(v4u*)(rowp + bj * 128) = w; } }
        }
    }
};
template <bool NORM> struct EpiGate {
    static constexpr bool PERM = true, AFTER_DRAIN = false, KHOOK = NORM;
    bf16* O; const bf16* P; const bf16* GATE; int gcol; const LAS float* rt;
    DI void khook(pg8::f32x4 (&acc)[2][2][4][2], int b, int wr, int fr) const {
#pragma unroll
        for (int ai = 0; ai < 2; ++ai)
#pragma unroll
            for (int m = 0; m < 4; ++m) { const float f = rt[(ai * 128 + wr * 64 + m * 16 + fr) * 4 + b];
#pragma unroll
                for (int bj = 0; bj < 2; ++bj)
#pragma unroll
                    for (int n = 0; n < 2; ++n) acc[ai][bj][m][n] = acc[ai][bj][m][n] * f; }
    }
    DI void operator()(const pg8::f32x4 (&acc)[2][2][4][2], const pg8::Unit& u, int wr, int wc, int fr, int fq) const {
        const int row0 = u.pm * 256 + wr * 64 + fr, col0 = u.pn * 256 + wc * 32 + fq * 8;
        v4u g[4], p[4], wA[4], wB[4];
        auto loadq = [&](int bj, int ai) {
#pragma unroll
            for (int m = 0; m < 4; ++m) { const size_t r = (size_t)(row0 + ai * 128 + m * 16); const int c = col0 + bj * 128;
                g[m] = *(const v4u*)(GATE + r * (2 * D) + gcol + c); if (NORM) p[m] = *(const v4u*)(P + r * D + c); }
        };
        auto calcq = [&](int bj, int ai, v4u (&w)[4]) {
#pragma unroll
            for (int m = 0; m < 4; ++m) {
                float f = 1.0f; if (NORM) f = rt[(ai * 128 + wr * 64 + m * 16 + fr) * 4 + 3];
                const v4u gg = g[m];
                pg8::f32x4 v0 = acc[ai][bj][m][0] * f, v1 = acc[ai][bj][m][1] * f;
                float o[8] = {v0[0] * sigmoidf_(bflo(gg.x)), v0[1] * sigmoidf_(bfhi(gg.x)), v0[2] * sigmoidf_(bflo(gg.y)), v0[3] * sigmoidf_(bfhi(gg.y)), v1[0] * sigmoidf_(bflo(gg.z)), v1[1] * sigmoidf_(bfhi(gg.z)), v1[2] * sigmoidf_(bflo(gg.w)), v1[3] * sigmoidf_(bfhi(gg.w))};
                if (NORM) { const v4u pp = p[m];
                    o[0] += bflo(pp.x); o[1] += bfhi(pp.x); o[2] += bflo(pp.y); o[3] += bfhi(pp.y); o[4] += bflo(pp.z); o[5] += bfhi(pp.z); o[6] += bflo(pp.w); o[7] += bfhi(pp.w); }
                w[m].x = pk2(o[0], o[1]); w[m].y = pk2(o[2], o[3]); w[m].z = pk2(o[4], o[5]); w[m].w = pk2(o[6], o[7]); }
        };
        auto storeq = [&](int bj, int ai, const v4u (&w)[4]) {
#pragma unroll
            for (int m = 0; m < 4; ++m) *(v4u*)(O + (size_t)(row0 + ai * 128 + m * 16) * D + col0 + bj * 128) = w[m];
        };
        loadq(0, 0); calcq(0, 0, wA); loadq(0, 1); storeq(0, 0, wA); calcq(0, 1, wB); loadq(1, 0); storeq(0, 1, wB); calcq(1, 0, wA); loadq(1, 1); storeq(1, 0, wA); calcq(1, 1, wB); storeq(1, 1, wB);
    }
};
struct EpiMix {
    static constexpr bool PERM = true, AFTER_DRAIN = false, KHOOK = false;
    bf16* H; const float* X; const float* g1;
    DI void operator()(const pg8::f32x4 (&acc)[2][2][4][2], const pg8::Unit& u, int wr, int wc, int fr, int fq) const {
        const int row0 = u.pm * 256 + wr * 64 + fr, col0 = u.pn * 256 + wc * 32 + fq * 8;
        f32x4 xa[4], xb[4]; v4u wA[4], wB[4];
        auto loadq = [&](int bj, int ai) {
#pragma unroll
            for (int m = 0; m < 4; ++m) { const size_t off = (size_t)(row0 + ai * 128 + m * 16) * D + col0 + bj * 128;
                xa[m] = __builtin_nontemporal_load((const f32x4*)(X + off)); xb[m] = __builtin_nontemporal_load((const f32x4*)(X + off + 4)); }
        };
        auto calcq = [&](int bj, int ai, v4u (&w)[4]) { const int c = col0 + bj * 128;
            const f32x4 ga = *(const f32x4*)(g1 + c), gb = *(const f32x4*)(g1 + c + 4);
#pragma unroll
            for (int m = 0; m < 4; ++m) { const f32x4 ha = xa[m] + ga * acc[ai][bj][m][0], hb = xb[m] + gb * acc[ai][bj][m][1];
                w[m].x = pk2(ha.x, ha.y); w[m].y = pk2(ha.z, ha.w); w[m].z = pk2(hb.x, hb.y); w[m].w = pk2(hb.z, hb.w); }
        };
        auto storeq = [&](int bj, int ai, const v4u (&w)[4]) {
#pragma unroll
            for (int m = 0; m < 4; ++m) *(v4u*)(H + (size_t)(row0 + ai * 128 + m * 16) * D + col0 + bj * 128) = w[m];
        };
        loadq(0, 0); calcq(0, 0, wA); loadq(0, 1); storeq(0, 0, wA); calcq(0, 1, wB); loadq(1, 0); storeq(0, 1, wB); calcq(1, 0, wA); loadq(1, 1); storeq(1, 0, wA); calcq(1, 1, wB); storeq(1, 1, wB);
    }
};
struct EpiUp {
    static constexpr bool PERM = true, AFTER_DRAIN = false, KHOOK = false;
    unsigned char* HDN;
    DI void operator()(const pg8::f32x4 (&acc)[2][2][4][2], const pg8::Unit& u, int wr, int wc, int fr, int fq) const {
        const int j = u.pn & 3, row0 = u.pm * 256 + wr * 64 + fr, col0 = j * 128 + wc * 16 + fq * 4;
#pragma unroll
        for (int ai = 0; ai < 2; ++ai)
#pragma unroll
            for (int m = 0; m < 4; ++m) { unsigned char* rowp = HDN + (size_t)(row0 + ai * 128 + m * 16) * DFF + col0;
#pragma unroll
                for (int bj = 0; bj < 2; ++bj) { const pg8::f32x4 a = acc[ai][bj][m][0], b = acc[ai][bj][m][1];
                    *(unsigned*)(rowp + bj * 64) = pk4_fp8(siluf_(a[0]) * b[0], siluf_(a[1]) * b[1], siluf_(a[2]) * b[2], siluf_(a[3]) * b[3]); } }
    }
};
struct EpiDown {
    static constexpr bool PERM = true, AFTER_DRAIN = false, KHOOK = false;
    unsigned char* Y;
    DI void operator()(const pg8::f32x4 (&acc)[2][2][4][2], const pg8::Unit& u, int wr, int wc, int fr, int fq) const {
        const int j = u.pn & 3, row0 = u.pm * 256 + wr * 64 + fr, col0 = j * 256 + wc * 32 + fq * 8;
#pragma unroll
        for (int ai = 0; ai < 2; ++ai)
#pragma unroll
            for (int m = 0; m < 4; ++m) { unsigned char* rowp = Y + (size_t)(row0 + ai * 128 + m * 16) * D + col0;
#pragma unroll
                for (int bj = 0; bj < 2; ++bj) { const pg8::f32x4 v0 = acc[ai][bj][m][0] * 16.0f, v1 = acc[ai][bj][m][1] * 16.0f;
                    v2u w; w.x = pk4_fp8(v0[0], v0[1], v0[2], v0[3]); w.y = pk4_fp8(v1[0], v1[1], v1[2], v1[3]);
                    *(v2u*)(rowp + bj * 128) = w; } }
    }
};
struct MoeOrder {
    const LAS int* tb; int G, c, total, reps; const LAS int* tokl;
    DI bool next(int i0, pg8::Unit& u) const {
        const int n = (total - c + G - 1) / G; if (n <= 0 || i0 >= n * reps) return false;
        const int i = i0 % n; const int uu = i * G + c;
        const int T = uu >> 2; int e = 0;
        while (e < NE - 1 && tb[e + 1] <= T) ++e;
        u.pm = T; u.pn = 4 * e + (uu & 3); return true;
    }
    DI void a_ready(const pg8::Unit&) const {}
    DI void done(const pg8::Unit&) const {}
};

struct OneUnit { pg8::Unit u;
    DI bool next(int i, pg8::Unit& o) const { if (i != 0) return false; o = u; return true; }
    DI void a_ready(const pg8::Unit&) const {}
    DI void done(const pg8::Unit&) const {} };

template <class SrcF>
DI void transpose_item(SrcF src, int K, bf16* WT, LAS float* scr, int kb, int n0, int lane) {
    const int k0 = 64 * kb;
#pragma unroll 8
    for (int i = 0; i < 32; ++i) { const int kk = 2 * i + (lane >> 5); scr[kk * 33 + (lane & 31)] = src(k0 + kk, n0 + (lane & 31)); }
    LDS_WAIT(); asm volatile("" ::: "memory");
    const int c = lane & 7;
#pragma unroll
    for (int j = 0; j < 4; ++j) { const int n = (lane >> 3) + 8 * j; const LAS float* s = scr + (8 * c) * 33 + n;
        v4u o; o.x = pk2(s[0 * 33], s[1 * 33]); o.y = pk2(s[2 * 33], s[3 * 33]); o.z = pk2(s[4 * 33], s[5 * 33]); o.w = pk2(s[6 * 33], s[7 * 33]);
        *(v4u*)(WT + (size_t)(n0 + n) * K + k0 + 8 * c) = o; }
    LDS_WAIT(); asm volatile("" ::: "memory");
}

template <class SrcF>
DI void transpose_item8(SrcF src, int K, unsigned char* WT, LAS float* scr, int kb, int n0, int lane) {
    const int k0 = 64 * kb;
#pragma unroll 8
    for (int i = 0; i < 32; ++i) { const int kk = 2 * i + (lane >> 5); scr[kk * 33 + (lane & 31)] = src(k0 + kk, n0 + (lane & 31)) * 64.0f; }
    LDS_WAIT(); asm volatile("" ::: "memory");
#pragma unroll
    for (int i = 0; i < 2; ++i) { const int p = lane + 64 * i, n = p >> 2, c = p & 3; const LAS float* s = scr + (16 * c) * 33 + n;
        v4u o; o.x = pk4_fp8(s[0 * 33], s[1 * 33], s[2 * 33], s[3 * 33]); o.y = pk4_fp8(s[4 * 33], s[5 * 33], s[6 * 33], s[7 * 33]);
        o.z = pk4_fp8(s[8 * 33], s[9 * 33], s[10 * 33], s[11 * 33]); o.w = pk4_fp8(s[12 * 33], s[13 * 33], s[14 * 33], s[15 * 33]);
        *(v4u*)(WT + (size_t)(n0 + n) * K + k0 + 16 * c) = o; }
    LDS_WAIT(); asm volatile("" ::: "memory");
}

template <class SrcF>
DI void transpose_item_i8(SrcF src, float inv, int K, unsigned char* WT, LAS float* scr, int kb, int n0, int lane) {
    const int k0 = 64 * kb;
#pragma unroll 8
    for (int i = 0; i < 32; ++i) { const int kk = 2 * i + (lane >> 5); scr[kk * 33 + (lane & 31)] = src(k0 + kk, n0 + (lane & 31)) * inv; }
    LDS_WAIT(); asm volatile("" ::: "memory");
#pragma unroll
    for (int i = 0; i < 2; ++i) { const int p = lane + 64 * i, n = p >> 2, c = p & 3; const LAS float* s = scr + (16 * c) * 33 + n;
        v4u o; o.x = pk4_i8(s[0 * 33], s[1 * 33], s[2 * 33], s[3 * 33]); o.y = pk4_i8(s[4 * 33], s[5 * 33], s[6 * 33], s[7 * 33]);
        o.z = pk4_i8(s[8 * 33], s[9 * 33], s[10 * 33], s[11 * 33]); o.w = pk4_i8(s[12 * 33], s[13 * 33], s[14 * 33], s[15 * 33]);
        *(v4u*)(WT + (size_t)(n0 + n) * K + k0 + 16 * c) = o; }
    LDS_WAIT(); asm volatile("" ::: "memory");
}

DI void ph0_prologue(const Ctx& F, const Args& a, int reps) {
    const int gw = F.vcu * NWAVES + F.wave, NGW = F.G * NWAVES, lane = lane_id();
    float* mod = (float*)(F.ws + WS_CTL) + CW_MOD;
    {
        const float* cvec = ARG(I_C); const float* wada = ARG(I_WADA); const float* bada = ARG(I_BADA);
        const int r8 = lane >> 3, c4 = lane & 7;
        for (int item0 = gw; item0 < 768 * reps; item0 += NGW) {
            const int item = item0 % 768; const int cc = item % 192, kq = item / 192;
            f32x4 acc = {0.f, 0.f, 0.f, 0.f};
#pragma unroll 8
            for (int i = 0; i < 32; ++i) { const int k = kq * 256 + i * 8 + r8; const float cv = cvec[k]; const float s = siluf_(cv);
                const f32x4 w = *(const f32x4*)(wada + (size_t)k * (6 * D) + cc * 32 + c4 * 4); acc += s * w; }
#pragma unroll
            for (int j = 0; j < 4; ++j) { float v = acc[j]; v += __shfl_xor(v, 8); v += __shfl_xor(v, 16); v += __shfl_xor(v, 32); acc[j] = v; }
            if (lane < 8) {
#pragma unroll
                for (int j = 0; j < 4; ++j) { float v = acc[j]; if (kq == 0) v += bada[cc * 32 + c4 * 4 + j]; mod[kq * 6144 + cc * 32 + c4 * 4 + j] = v; }
            }
        }
    }
    LAS float* scr = (LAS float*)(F.lds + F.wave * 16384);
    const float* win = ARG(I_WIN); const float* wcv = ARG(I_WCV); const float* wmix = ARG(I_WMIX); const float* wssm = ARG(I_WSSM);
    bf16* Win_t = (bf16*)(F.ws + WS_WIN); bf16* Wdt_t = (bf16*)(F.ws + WS_WDT); bf16* Wcv_t = (bf16*)(F.ws + WS_WCV);
    bf16* Wmix_t = (bf16*)(F.ws + WS_WMIX); bf16* Wssm_t = (bf16*)(F.ws + WS_WSSM);
    constexpr int I_IN = 16 * 288, I_DT = 16, I_CV = 16 * 32, I_MX = 16 * 32, I_SS = 32 * 32, I_RT = 16 * 3 * 2;
    constexpr int NITEMS = I_IN + I_DT + I_CV + I_MX + I_SS + I_RT;
    const float* wer = ARG(I_WER); const float* wgrp = ARG(I_WGRP); const float* sng0 = ARG(I_SNG);
    for (int it0 = gw; it0 < NITEMS * reps; it0 += NGW) {
        int r = it0 % NITEMS;
        if (r < I_IN) { const int kb = r / 288, nb = r % 288;
            const int npp = nb * 32 + (lane & 31), col = win_col(npp);
            float mx = 0.f;
#pragma unroll 8
            for (int i = 0; i < 32; ++i) mx = __builtin_fmaxf(mx, __builtin_fabsf(win[(size_t)(64 * kb + 2 * i + (lane >> 5)) * WIN_LD + col]));
            mx = __builtin_fmaxf(mx, __shfl_xor(mx, 32));
            if (lane < 32) atomicMax((unsigned*)(F.ws + WS_CTL) + CW_WMAX + npp, __float_as_uint(mx));
            continue; } r -= I_IN;
        if (r < I_DT) { transpose_item([&](int k, int np) -> float { return win[(size_t)k * WIN_LD + 7168 + np]; }, D, Wdt_t, scr, r, 0, lane); continue; } r -= I_DT;
        if (r < I_CV) { transpose_item([&](int k, int np) -> float { return wcv[(size_t)k * D + np]; }, D, Wcv_t, scr, r / 32, (r % 32) * 32, lane); continue; } r -= I_CV;
        if (r < I_MX) { transpose_item([&](int k, int np) -> float { return wmix[(size_t)k * D + np]; }, D, Wmix_t, scr, r / 32, (r % 32) * 32, lane); continue; } r -= I_MX;
        if (r < I_SS) { transpose_item8([&](int k, int np) -> float { return wssm[(size_t)k * D + np] * sng0[k]; }, DIN, (unsigned char*)Wssm_t, scr, r / 32, (r % 32) * 32, lane); continue; } r -= I_SS;
        {
            const int lo = r / 48, rr = r % 48, kb = rr / 3, nb = rr % 3;
            auto wsrc = [&](int k, int np) -> float { float w = 0.f; if (np < 64) w = wer[(size_t)k * NE + np]; else if (np < 72) w = wgrp[(size_t)k * 8 + (np - 64)];
                const float hi = bflo(pk2(w, 0.f)); return lo ? (w - hi) : hi; };
            transpose_item(wsrc, D, (bf16*)(F.ws + (lo ? WS_WRL : WS_WRH)), scr, kb, nb * 32, lane);
        }
    }
}

DI void convert_experts(const Ctx& F, const Args& a) {
    const int gw = F.vcu * NWAVES + F.wave, NGW = F.G * NWAVES, lane = lane_id();
    LAS float* scr = (LAS float*)(F.lds + F.wave * 17408);
    const float* w1 = ARG(I_W1); const float* w3 = ARG(I_W3); const float* w2 = ARG(I_W2);
    unsigned char* W13_t = F.ws + WS_W13; unsigned char* W2_t = F.ws + WS_W2;
    constexpr int I_13 = NE * 4 * 16, I_2 = NE * 2 * 16, NIT = I_13 + I_2;
    const int ch = lane & 15, kq = lane >> 4;
    for (int it = gw; it < NIT; it += NGW) {
        const float* src; size_t ld; unsigned char* dst;
        if (it < I_13) { const int e = it >> 6, r = it & 63, kb = r >> 4, cb = r & 15;
            src = ((ch & 1) ? w3 : w1) + (size_t)e * D * DFF + (size_t)(256 * kb + kq) * DFF + 32 * cb + 4 * (ch >> 1); ld = DFF;
            dst = W13_t + (size_t)e * D * D + (size_t)(64 * cb + lane) * D + 256 * kb;
        } else { const int r0 = it - I_13, e = r0 >> 5, r = r0 & 31, kb = r >> 4, nb = r & 15;
            src = w2 + (size_t)e * DFF * D + (size_t)(256 * kb + kq) * D + 64 * nb + 4 * ch; ld = D;
            dst = W2_t + (size_t)e * D * DFF + (size_t)(64 * nb + lane) * DFF + 256 * kb;
        }
        f32x4 va[16], vb[16]; v4u o[16];
#pragma unroll
        for (int i = 0; i < 16; ++i) va[i] = __builtin_nontemporal_load((const f32x4*)(src + (size_t)(4 * i) * ld));
#pragma unroll
        for (int sub = 0; sub < 4; ++sub) {
            f32x4 (&cur)[16] = (sub & 1) ? vb : va; f32x4 (&nxt)[16] = (sub & 1) ? va : vb;
            if (sub < 3) {
#pragma unroll
                for (int i = 0; i < 16; ++i) nxt[i] = __builtin_nontemporal_load((const f32x4*)(src + (size_t)(64 * (sub + 1) + 4 * i) * ld));
            }
#pragma unroll
            for (int i = 0; i < 16; ++i) *(LAS f32x4*)(scr + (4 * i + kq) * 68 + 4 * ch) = cur[i] * 64.0f;
            LDS_WAIT(); asm volatile("" ::: "memory");
#pragma unroll
            for (int j = 0; j < 4; ++j) {
                unsigned w[4];
#pragma unroll
                for (int q = 0; q < 4; ++q) { const LAS float* sp = scr + (16 * j + 4 * q) * 68 + lane; w[q] = pk4_fp8(sp[0], sp[68], sp[136], sp[204]); }
                o[4 * sub + j].x = w[0]; o[4 * sub + j].y = w[1]; o[4 * sub + j].z = w[2]; o[4 * sub + j].w = w[3];
            }
            LDS_WAIT(); asm volatile("" ::: "memory");
        }
#pragma unroll
        for (int j = 0; j < 16; ++j) *(v4u*)(dst + 16 * j) = o[j];
    }
}

DI void ph1_norm_dt(const Ctx& F, const Args& a) {
    const float* mod = (const float*)(F.ws + WS_CTL) + CW_MOD;
    const float* x = ARG(I_X); const float* n1g = ARG(I_N1G); const float* dtb = ARG(I_DTB);
    bf16* XN = (bf16*)(F.ws + WS_XN); const bf16* Wdt_t = (const bf16*)(F.ws + WS_WDT); float* DT = (float*)(F.ws + WS_DT);
    const int lane = lane_id(), wave = F.wave;
    f32x4 gm[4], ga[4];
#pragma unroll
    for (int j = 0; j < 4; ++j) { const int k = 256 * j + 4 * lane; const f32x4 g = *(const f32x4*)(n1g + k), sc = mod4(mod, 1024 + k);
        gm[j] = g * (sc + 1.0f); ga[j] = mod4(mod, k); }
    if (F.vcu == 0) { float* modc = (float*)(F.ws + WS_CTL) + CW_MODC; for (int k = (F.wave * 64 + lane_id()) * 4; k < 6 * D; k += NTHREADS * 4) *(f32x4*)(modc + k) = mod4(mod, k); }
    for (int unit = F.vcu; unit < M / 64; unit += F.G) {
        const int row0 = unit * 64;
#pragma unroll 1
        for (int rh = 0; rh < 2; ++rh) {
            f32x4 v[4][4];
#pragma unroll
            for (int rr = 0; rr < 4; ++rr)
#pragma unroll
                for (int j = 0; j < 4; ++j) v[rr][j] = __builtin_nontemporal_load((const f32x4*)(x + (size_t)(row0 + wave * 8 + rh * 4 + rr) * D + 256 * j + 4 * lane));
#pragma unroll
            for (int rr = 0; rr < 4; ++rr) {
                const int rl = wave * 8 + rh * 4 + rr, row = row0 + rl; float ss = 0.f;
#pragma unroll
                for (int j = 0; j < 4; ++j) ss += (v[rr][j].x * v[rr][j].x + v[rr][j].y * v[rr][j].y) + (v[rr][j].z * v[rr][j].z + v[rr][j].w * v[rr][j].w);
                const float rstd = 1.0f / sqrtf(wave_sum(ss) * (1.0f / D) + EPS);
                float am = 0.f;
#pragma unroll
                for (int j = 0; j < 4; ++j) { const f32x4 n = v[rr][j] * rstd * gm[j] + ga[j]; v[rr][j] = n;
                    am = __builtin_fmaxf(__builtin_fmaxf(am, __builtin_fmaxf(__builtin_fabsf(n.x), __builtin_fabsf(n.y))), __builtin_fmaxf(__builtin_fabsf(n.z), __builtin_fabsf(n.w)));
                    v2u w; w.x = pk2(n.x, n.y); w.y = pk2(n.z, n.w);
                    const int chunk = (32 * j + (lane >> 1)) ^ (rl & 15);
                    *(LAS v2u*)(F.lds + rl * 2048 + chunk * 16 + 8 * (lane & 1)) = w; }
#pragma unroll
                for (int o = 1; o < 64; o <<= 1) am = __builtin_fmaxf(am, __shfl_xor(am, o));
                const float inv = am > 0.f ? 127.0f / am : 0.f;
#pragma unroll
                for (int j = 0; j < 4; ++j) *(unsigned*)(F.ws + WS_XN8 + (size_t)row * D + 256 * j + 4 * lane) = pk4_i8(v[rr][j].x * inv, v[rr][j].y * inv, v[rr][j].z * inv, v[rr][j].w * inv);
                if (lane == 0) ((float*)(F.ws + WS_SA))[row] = am * (1.0f / 127.0f);
            }
        }
        __syncthreads();
        {
            const int rt = wave & 3, ct = wave >> 2, fr = lane & 15, fq = lane >> 4;
            pg8::f32x4 acc = {0.f, 0.f, 0.f, 0.f};
            const bf16* wrow = Wdt_t + (size_t)(16 * ct + fr) * D + 8 * fq;
#pragma unroll 4
            for (int ks = 0; ks < 32; ++ks) {
                const bf16x8 av = *(const LAS bf16x8*)(F.lds + (16 * rt + fr) * 2048 + (((4 * ks + fq) ^ fr) * 16));
                const bf16x8 bv = *(const bf16x8*)(wrow + 32 * ks);
                acc = __builtin_amdgcn_mfma_f32_16x16x32_bf16(av, bv, acc, 0, 0, 0);
            }
            const float bias = dtb[16 * ct + fr];
#pragma unroll
            for (int r = 0; r < 4; ++r) { const float v = acc[r] + bias; const float sp = v > 20.f ? v : log1pf(__expf(v));
                DT[(size_t)(row0 + 16 * rt + 4 * fq + r) * NH + 16 * ct + fr] = sp; }
        }
        __syncthreads();
    }
    {
        const float* win = ARG(I_WIN); const unsigned* wmax = (const unsigned*)(F.ws + WS_CTL) + CW_WMAX;
        const int gw = F.vcu * NWAVES + F.wave, NGW = F.G * NWAVES;
        LAS float* scr = (LAS float*)(F.lds + F.wave * 16384);
        for (int r = gw; r < 16 * 288; r += NGW) { const int kb = r / 288, nb = r % 288;
            const int npp = nb * 32 + (lane & 31), col = win_col(npp);
            const float mx = __uint_as_float(wmax[npp]); const float inv = mx > 0.f ? 127.0f / mx : 0.f;
            if (kb == 0 && lane < 32) ((float*)(F.ws + WS_SW))[npp] = mx * (1.0f / 127.0f);
            transpose_item_i8([&](int k, int) -> float { return win[(size_t)k * WIN_LD + col]; }, inv, D, F.ws + WS_W8IN, scr, kb, nb * 32, lane);
        }
    }
}

DI void ph3_convbranch(const Ctx& F, const Args& a, int reps) {
    const bf16* U = (const bf16*)(F.ws + WS_U); bf16* UC = (bf16*)(F.ws + WS_XN);
    const float* cw = ARG(I_CVW); const float* cb = ARG(I_CVB); const float* lg = ARG(I_LNG); const float* lb = ARG(I_LNB);
    const int tid = F.wave * 64 + lane_id(), lane = lane_id(), wave = F.wave;
    LAS unsigned char* tile = F.lds;
    LAS float* red = (LAS float*)(F.lds + 62 * 2048);
    LAS float* stat = red + 32 * 8 * 2;
    f2v w[31];
#pragma unroll
    for (int j = 0; j < 31; ++j) w[j] = *(const f2v*)(cw + j * D + 2 * tid);
    const f2v bias = *(const f2v*)(cb + 2 * tid), gam = *(const f2v*)(lg + 2 * tid), bet = *(const f2v*)(lb + 2 * tid);
    const int RU = (M / 32 + F.G - 1) / F.G;
    for (int it = 0; it < RU * reps; ++it) {
        const int unit = xcd_unit(F.xcd, F.xj, F.G >> 3, (it >= RU ? it - RU : it), M / 32); if (unit < 0) break; const int t0 = unit * 32;
        for (int piece = tid; piece < 62 * 128; piece += NTHREADS) { const int r = piece >> 7, cch = piece & 127, t = t0 - 30 + r;
            v4u v = {0u, 0u, 0u, 0u}; if (t >= 0) v = *(const v4u*)(U + (size_t)t * D + cch * 8);
            *(LAS v4u*)(tile + r * 2048 + cch * 16) = v; }
        __syncthreads();
        f2v o[32];
#pragma unroll
        for (int tg = 0; tg < 8; ++tg) {
            f2v acc[4];
#pragma unroll
            for (int i = 0; i < 4; ++i) acc[i] = bias;
#pragma unroll
            for (int j = 0; j < 34; ++j) {
                const unsigned uu = *(const LAS unsigned*)(tile + (4 * tg + j) * 2048 + tid * 4);
                const f2v u2 = {bflo(uu), bfhi(uu)};
#pragma unroll
                for (int i = 0; i < 4; ++i) { const int jj = j - i; if (jj >= 0 && jj <= 30) acc[i] = __builtin_elementwise_fma(w[jj], u2, acc[i]); }
            }
#pragma unroll
            for (int i = 0; i < 4; ++i) o[4 * tg + i] = acc[i];
        }
        {
            float r5[64];
#pragma unroll
            for (int tk = 0; tk < 32; ++tk) { r5[2 * tk] = o[tk].x + o[tk].y; r5[2 * tk + 1] = o[tk].x * o[tk].x + o[tk].y * o[tk].y; }
            float r4[32], r3[16], r2[8], r1[4], r0[2];
            { const bool up = (lane & 32) != 0;
#pragma unroll
              for (int i = 0; i < 32; ++i) { const float keep = up ? r5[i + 32] : r5[i], send = up ? r5[i] : r5[i + 32]; r4[i] = keep + __shfl_xor(send, 32); } }
            { const bool up = (lane & 16) != 0;
#pragma unroll
              for (int i = 0; i < 16; ++i) { const float keep = up ? r4[i + 16] : r4[i], send = up ? r4[i] : r4[i + 16]; r3[i] = keep + __shfl_xor(send, 16); } }
            { const bool up = (lane & 8) != 0;
#pragma unroll
              for (int i = 0; i < 8; ++i) { const float keep = up ? r3[i + 8] : r3[i], send = up ? r3[i] : r3[i + 8]; r2[i] = keep + __shfl_xor(send, 8); } }
            { const bool up = (lane & 4) != 0;
#pragma unroll
              for (int i = 0; i < 4; ++i) { const float keep = up ? r2[i + 4] : r2[i], send = up ? r2[i] : r2[i + 4]; r1[i] = keep + __shfl_xor(send, 4); } }
            { const bool up = (lane & 2) != 0;
#pragma unroll
              for (int i = 0; i < 2; ++i) { const float keep = up ? r1[i + 2] : r1[i], send = up ? r1[i] : r1[i + 2]; r0[i] = keep + __shfl_xor(send, 2); } }
            const bool up0 = (lane & 1) != 0;
            const float tot = (up0 ? r0[1] : r0[0]) + __shfl_xor(up0 ? r0[0] : r0[1], 1);
            red[((lane >> 1) * 8 + wave) * 2 + (lane & 1)] = tot;
        }
        __syncthreads();
        if (tid < 32) { float s = 0.f, q = 0.f;
#pragma unroll
            for (int wv = 0; wv < 8; ++wv) { s += red[(tid * 8 + wv) * 2]; q += red[(tid * 8 + wv) * 2 + 1]; }
            const float mean = s * (1.0f / D); const float var = fmaxf(q * (1.0f / D) - mean * mean, 0.f);
            stat[tid * 2] = mean; stat[tid * 2 + 1] = 1.0f / sqrtf(var + EPS); }
        __syncthreads();
#pragma unroll
        for (int tk = 0; tk < 32; ++tk) { const float mean = stat[tk * 2], rstd = stat[tk * 2 + 1];
            const float y0 = (o[tk].x - mean) * rstd * gam.x + bet.x, y1 = (o[tk].y - mean) * rstd * gam.y + bet.y;
            *(unsigned*)(UC + (size_t)(t0 + tk) * D + 2 * tid) = pk2(siluf_(y0), siluf_(y1)); }
        __syncthreads();
    }
}

DI void conv_block(const bf16* XBC, const float* cw, const float* cb, int t_first, int col, float (&o)[8][8]) {
    v4u raw[11];
#pragma unroll
    for (int r = 0; r < 11; ++r) { const int t = t_first - 3 + r; const int tc = t < 0 ? 0 : t; v4u v = *(const v4u*)(XBC + (size_t)tc * XBCW + col);
        const unsigned msk = t < 0 ? 0u : 0xffffffffu; v.x &= msk; v.y &= msk; v.z &= msk; v.w &= msk; raw[r] = v; }
    float w[4][8], b[8];
#pragma unroll
    for (int j = 0; j < 4; ++j) { const f32x4 lo = *(const f32x4*)(cw + j * XBCW + col), hi = *(const f32x4*)(cw + j * XBCW + col + 4);
        w[j][0] = lo.x; w[j][1] = lo.y; w[j][2] = lo.z; w[j][3] = lo.w; w[j][4] = hi.x; w[j][5] = hi.y; w[j][6] = hi.z; w[j][7] = hi.w; }
    { const f32x4 lo = *(const f32x4*)(cb + col), hi = *(const f32x4*)(cb + col + 4); b[0] = lo.x; b[1] = lo.y; b[2] = lo.z; b[3] = lo.w; b[4] = hi.x; b[5] = hi.y; b[6] = hi.z; b[7] = hi.w; }
#pragma unroll
    for (int tk = 0; tk < 8; ++tk)
#pragma unroll
        for (int ch = 0; ch < 8; ++ch) {
            float acc = b[ch];
#pragma unroll
            for (int j = 0; j < 4; ++j) { const unsigned wd = raw[tk + j][ch >> 1]; const float xv = (ch & 1) ? bfhi(wd) : bflo(wd); acc += w[j][ch] * xv; }
            o[tk][ch] = siluf_(acc);
        }
}
DI float head_scan(const float* DT, const float* alog, int t0, int h, int lane, LAS float* acs_h, LAS float* dtv_h, float& d0o, float& d1o, float& c0o, float& c1o) {
    const float d0 = DT[(size_t)(t0 + 2 * lane) * NH + h], d1 = DT[(size_t)(t0 + 2 * lane + 1) * NH + h];
    const float A2 = -__expf(alog[h]) * LOG2E;
    const float a0 = d0 * A2, a1 = d1 * A2; float inc = a0 + a1;
#pragma unroll
    for (int o = 1; o < 64; o <<= 1) { const float t = __shfl_up(inc, o); if (lane >= o) inc += t; }
    acs_h[2 * lane] = inc - a1; acs_h[2 * lane + 1] = inc; dtv_h[2 * lane] = d0; dtv_h[2 * lane + 1] = d1;
    d0o = d0; d1o = d1; c0o = inc - a1; c1o = inc;
    return __shfl(inc, 63);
}

constexpr int S_CN = 0, S_BN = 32768, S_XT = 65536, S_ACS = 131072, S_DTV = 135168, S_SSQ = 139264, S_FS = 139776;

DI void ph3_chunk_states(const Ctx& F, const Args& a, int reps) {
    const bf16* XBC = (const bf16*)(F.ws + WS_XBC); const float* DT = (const float*)(F.ws + WS_DT);
    bf16* ST = (bf16*)(F.ws + WS_ST); float* CD = (float*)(F.ws + WS_CD);
    const float* scw = ARG(I_SCW); const float* scb = ARG(I_SCB); const float* alog = ARG(I_ALOG);
    const int tid = F.wave * 64 + lane_id(), lane = lane_id(), wave = F.wave, hh = lane >> 5;
    LAS unsigned char* lds = F.lds;
    LAS float* acs = (LAS float*)(lds + S_ACS); LAS float* wsc = (LAS float*)(lds + S_DTV);
    const int RU = (NCH * NGRP + F.G - 1) / F.G;
    for (int it = 0; it < RU * reps; ++it) {
        const int unit = xcd_unit(F.xcd, F.xj, F.G >> 3, (it >= RU ? it - RU : it), NCH * NGRP); if (unit < 0) break; const int c = unit >> 2, g = unit & 3, t0 = c * LCH;
        {
            const int h = 8 * g + wave; float d0, d1, c0, c1;
            const float total = head_scan(DT, alog, t0, h, lane, acs + wave * 128, wsc + wave * 128, d0, d1, c0, c1);
            wsc[wave * 128 + 2 * lane] = d0 * __builtin_amdgcn_exp2f(total - c0); wsc[wave * 128 + 2 * lane + 1] = d1 * __builtin_amdgcn_exp2f(total - c1);
            if (lane == 0) CD[c * NH + h] = __builtin_amdgcn_exp2f(total);
        }
        __syncthreads();
        if (tid < 256) { const int co = tid & 15, to = tid >> 4; float o[8][8];
            conv_block(XBC, scw, scb, t0 + 8 * to, 2048 + 128 * g + 8 * co, o);
#pragma unroll
            for (int ch = 0; ch < 8; ++ch) { const int row = 8 * co + ch;
                v4u w; w.x = pk2(o[0][ch], o[1][ch]); w.y = pk2(o[2][ch], o[3][ch]); w.z = pk2(o[4][ch], o[5][ch]); w.w = pk2(o[6][ch], o[7][ch]);
                *(LAS v4u*)(lds + S_BN + row * 256 + swz(row, to) * 16) = w; } }
        for (int ps = 0; ps < 2; ++ps) {
            {
                const int co = tid & 31, to = tid >> 5, hd = co >> 3, p0 = (co & 7) * 8; float o[8][8];
                conv_block(XBC, scw, scb, t0 + 8 * to, 512 * g + 64 * (4 * ps + hd) + p0, o);
                float sc[8];
#pragma unroll
                for (int tk = 0; tk < 8; ++tk) sc[tk] = wsc[(4 * ps + hd) * 128 + 8 * to + tk];
#pragma unroll
                for (int ch = 0; ch < 8; ++ch) { const int row = hd * 64 + p0 + ch;
                    v4u w; w.x = pk2(o[0][ch] * sc[0], o[1][ch] * sc[1]); w.y = pk2(o[2][ch] * sc[2], o[3][ch] * sc[3]);
                    w.z = pk2(o[4][ch] * sc[4], o[5][ch] * sc[5]); w.w = pk2(o[6][ch] * sc[6], o[7][ch] * sc[7]);
                    *(LAS v4u*)(lds + S_XT + row * 256 + swz(row, to) * 16) = w; }
            }
            __syncthreads();
            {
                const int hd = wave & 3, ph = wave >> 2, h = 8 * g + 4 * ps + hd;
                f32x16 acc[4];
#pragma unroll
                for (int nt = 0; nt < 4; ++nt)
#pragma unroll
                    for (int i = 0; i < 16; ++i) acc[nt][i] = 0.f;
                const int arow = hd * 64 + 32 * ph + (lane & 31);
#pragma unroll
                for (int ks = 0; ks < 8; ++ks) {
                    const bf16x8 av = *(const LAS bf16x8*)(lds + S_XT + arow * 256 + swz(arow, 2 * ks + hh) * 16);
#pragma unroll
                    for (int nt = 0; nt < 4; ++nt) { const int brow = 32 * nt + (lane & 31);
                        const bf16x8 bv = *(const LAS bf16x8*)(lds + S_BN + brow * 256 + swz(brow, 2 * ks + hh) * 16);
                        acc[nt] = MFMA32(av, bv, acc[nt]); }
                }
                bf16* dst = ST + ((size_t)(c * NH + h) * HD) * NST;
#pragma unroll
                for (int nt = 0; nt < 4; ++nt)
#pragma unroll
                    for (int i = 0; i < 16; i += 2) { const int p = 32 * ph + crow(i, hh); const unsigned pk = pk2(acc[nt][i], acc[nt][i + 1]);
                        dst[(size_t)p * NST + 32 * nt + (lane & 31)] = (bf16)(pk & 0xffffu); dst[(size_t)(p + 1) * NST + 32 * nt + (lane & 31)] = (bf16)(pk >> 16); }
            }
            __syncthreads();
        }
    }
}

DI void ph4_scan(const Ctx& F, size_t dst_off) {
    unsigned* ST32 = (unsigned*)(F.ws + WS_ST); unsigned* DST32 = (unsigned*)(F.ws + dst_off); const float* CD = (const float*)(F.ws + WS_CD);
    constexpr int NPAIR = NH * HD * NST / 2;
    for (int e = F.vcu * NTHREADS + (F.wave * 64 + lane_id()); e < NPAIR; e += F.G * NTHREADS) {
        const int h = e >> 12; float c0 = 0.f, c1 = 0.f;
#pragma unroll 1
        for (int cb = 0; cb < NCH; cb += 32) {
            unsigned v[32]; float dec[32];
#pragma unroll
            for (int i = 0; i < 32; ++i) { v[i] = __builtin_nontemporal_load(ST32 + (size_t)(cb + i) * NPAIR + e); dec[i] = CD[(cb + i) * NH + h]; }
#pragma unroll
            for (int i = 0; i < 32; ++i) { DST32[(size_t)(cb + i) * NPAIR + e] = pk2(c0, c1); c0 = c0 * dec[i] + bflo(v[i]); c1 = c1 * dec[i] + bfhi(v[i]); }
        }
    }
}

DI void ph5_ssd_out(const Ctx& F, const Args& a, int reps) {
    const bf16* XBC = (const bf16*)(F.ws + WS_XBC); const float* DT = (const float*)(F.ws + WS_DT);
    const bf16* ST = (const bf16*)(F.ws + WS_ST); const bf16* ZS = (const bf16*)(F.ws + WS_ZS); bf16* YS = (bf16*)(F.ws + WS_YS);
    const float* scw = ARG(I_SCW); const float* scb = ARG(I_SCB); const float* alog = ARG(I_ALOG); const float* dskip = ARG(I_DSKIP);
    const int tid = F.wave * 64 + lane_id(), lane = lane_id(), wave = F.wave, hh = lane >> 5, l31 = lane & 31;
    LAS unsigned char* lds = F.lds;
    LAS float* acs = (LAS float*)(lds + S_ACS); LAS float* dtv = (LAS float*)(lds + S_DTV); LAS float* ssq = (LAS float*)(lds + S_SSQ);
    const int RU = (NCH * NGRP + F.G - 1) / F.G;
    for (int it = 0; it < RU * reps; ++it) {
        const int unit = xcd_unit(F.xcd, F.xj, F.G >> 3, (it >= RU ? it - RU : it), NCH * NGRP); if (unit < 0) break; const int c = unit >> 2, g = unit & 3, t0 = c * LCH;
        { const int h = 8 * g + wave; float d0, d1, c0, c1; (void)head_scan(DT, alog, t0, h, lane, acs + wave * 128, dtv + wave * 128, d0, d1, c0, c1);
          const float cend = __shfl(c1, (lane & 48) | 15);
          LAS float* fsw = (LAS float*)(lds + S_FS) + wave * 128;
          fsw[2 * lane] = d0 * __builtin_amdgcn_exp2f(cend - c0); fsw[2 * lane + 1] = d1 * __builtin_amdgcn_exp2f(cend - c1); }
        if (tid < 128) ssq[tid] = 0.f;
        { const int which = tid >> 8, t8 = tid & 255, co = t8 & 15; int to = t8 >> 4; asm volatile("" : "+v"(to)); float o[8][8];
            conv_block(XBC, scw, scb, t0 + 8 * to, (which ? 2560 : 2048) + 128 * g + 8 * co, o);
            const int base = which ? S_CN : S_BN;
#pragma unroll
            for (int tk = 0; tk < 8; ++tk) { const int row = 8 * to + tk;
                v4u w; w.x = pk2(o[tk][0], o[tk][1]); w.y = pk2(o[tk][2], o[tk][3]); w.z = pk2(o[tk][4], o[tk][5]); w.w = pk2(o[tk][6], o[tk][7]);
                *(LAS v4u*)(lds + base + row * 256 + swz(row, co) * 16) = w; } }
#pragma unroll 1
        for (int ps = 0; ps < 2; ++ps) {
            {
                const int co = tid & 31; int to = tid >> 5; asm volatile("" : "+v"(to));
                const int hd = co >> 3, p0 = (co & 7) * 8; float o[8][8];
                conv_block(XBC, scw, scb, t0 + 8 * to, 512 * g + 64 * (4 * ps + hd) + p0, o);
#pragma unroll
                for (int ch = 0; ch < 8; ++ch) { const int row = hd * 64 + p0 + ch;
                    v4u w; w.x = pk2(o[0][ch], o[1][ch]); w.y = pk2(o[2][ch], o[3][ch]); w.z = pk2(o[4][ch], o[5][ch]); w.w = pk2(o[6][ch], o[7][ch]);
                    *(LAS v4u*)(lds + S_XT + row * 256 + swz(row, to) * 16) = w; }
            }
            __syncthreads();
            const int hd = wave & 3, lp = wave >> 2, hl = 4 * ps + hd, h = 8 * g + hl;
            const float Dh = dskip[h];
            const LAS float* acs_h = acs + hl * 128; const LAS float* dt_h = dtv + hl * 128; const LAS float* fs_h = (const LAS float*)(lds + S_FS) + hl * 128;
            const bf16* prev = ST + ((size_t)(c * NH + h) * HD) * NST;
            const int erow = lane >> 1, ehalf = lane & 1;
            f32x16 acc[2][2];
            {
#pragma unroll
                for (int which = 0; which < 2; ++which)
#pragma unroll
                    for (int pt = 0; pt < 2; ++pt)
#pragma unroll
                        for (int i = 0; i < 16; ++i) acc[which][pt][i] = 0.f;
                const int rowA = 32 * lp + l31, rowB = 32 * (3 - lp) + l31;
#pragma unroll
                for (int ks = 0; ks < 8; ++ks) {
                    const bf16x8 b0 = *(const bf16x8*)(prev + (size_t)l31 * NST + 16 * ks + 8 * hh), b1 = *(const bf16x8*)(prev + (size_t)(32 + l31) * NST + 16 * ks + 8 * hh);
                    const bf16x8 a0 = *(const LAS bf16x8*)(lds + S_CN + rowA * 256 + swz(rowA, 2 * ks + hh) * 16);
                    const bf16x8 a1 = *(const LAS bf16x8*)(lds + S_CN + rowB * 256 + swz(rowB, 2 * ks + hh) * 16);
                    acc[0][0] = MFMA32(a0, b0, acc[0][0]); acc[0][1] = MFMA32(a0, b1, acc[0][1]);
                    acc[1][0] = MFMA32(a1, b0, acc[1][0]); acc[1][1] = MFMA32(a1, b1, acc[1][1]);
                }
#pragma unroll
                for (int which = 0; which < 2; ++which) { const int li = which == 0 ? lp : 3 - lp;
#pragma unroll
                    for (int i = 0; i < 16; ++i) { const float e = __builtin_amdgcn_exp2f(acs_h[32 * li + crow(i, hh)]); acc[which][0][i] *= e; acc[which][1][i] *= e; } }
            }
            {
                const int liA = lp, liB = 3 - lp;
                const int rowA = 32 * liA + l31, rowB = 32 * liB + l31;
                const float alA = acs_h[rowA], alB = acs_h[rowB];
#pragma unroll 1
                for (int sj = 0; sj <= liB; ++sj) {
                    const bool doA = sj <= liA;
                    f32x16 GA, GB;
#pragma unroll
                    for (int i = 0; i < 16; ++i) { GA[i] = 0.f; GB[i] = 0.f; }
                    const int brow = 32 * sj + l31;
                    if (doA) {
#pragma unroll 2
                        for (int ks = 0; ks < 8; ++ks) {
                            const bf16x8 av = *(const LAS bf16x8*)(lds + S_BN + brow * 256 + swz(brow, 2 * ks + hh) * 16);
                            const bf16x8 ca = *(const LAS bf16x8*)(lds + S_CN + rowA * 256 + swz(rowA, 2 * ks + hh) * 16);
                            const bf16x8 cb = *(const LAS bf16x8*)(lds + S_CN + rowB * 256 + swz(rowB, 2 * ks + hh) * 16);
                            GA = MFMA32(av, ca, GA); GB = MFMA32(av, cb, GB);
                        }
                    } else {
#pragma unroll 2
                        for (int ks = 0; ks < 8; ++ks) {
                            const bf16x8 av = *(const LAS bf16x8*)(lds + S_BN + brow * 256 + swz(brow, 2 * ks + hh) * 16);
                            const bf16x8 cb = *(const LAS bf16x8*)(lds + S_CN + rowB * 256 + swz(rowB, 2 * ks + hh) * 16);
                            GB = MFMA32(av, cb, GB);
                        }
                    }
                    auto mask = [&](f32x16& G, int li, int row_l, float al) {
                        if (sj < li) {
                            const float fl = __builtin_amdgcn_exp2f(al - acs_h[32 * sj + 31]);
#pragma unroll
                            for (int i = 0; i < 16; ++i) G[i] = G[i] * (fs_h[32 * sj + crow(i, hh)] * fl);
                        } else {
#pragma unroll
                            for (int i = 0; i < 16; ++i) { const int s = 32 * sj + crow(i, hh);
                                float v = G[i] * __builtin_amdgcn_exp2f(fminf(al - acs_h[s], 0.f)) * dt_h[s];
                                v = (s > row_l) ? 0.f : v; v = (s == row_l) ? v + Dh : v; G[i] = v; }
                        }
                    };
                    auto pv = [&](const f32x16& G, f32x16 (&ac)[2]) {
#pragma unroll
                        for (int s2 = 0; s2 < 2; ++s2) {
                            v4u fa; fa.x = pk2(G[8 * s2 + 0], G[8 * s2 + 1]); fa.y = pk2(G[8 * s2 + 2], G[8 * s2 + 3]); fa.z = pk2(G[8 * s2 + 4], G[8 * s2 + 5]); fa.w = pk2(G[8 * s2 + 6], G[8 * s2 + 7]);
#pragma unroll
                            for (int pt = 0; pt < 2; ++pt) { const int xrow = hd * 64 + 32 * pt + l31; const int sc0 = 32 * sj + 16 * s2;
                                const v2u lo = *(const LAS v2u*)(lds + S_XT + xrow * 256 + swz(xrow, (sc0 >> 3)) * 16 + 8 * hh);
                                const v2u hi = *(const LAS v2u*)(lds + S_XT + xrow * 256 + swz(xrow, (sc0 >> 3) + 1) * 16 + 8 * hh);
                                v4u bfr; bfr.x = lo.x; bfr.y = lo.y; bfr.z = hi.x; bfr.w = hi.y;
                                ac[pt] = MFMA32(__builtin_bit_cast(bf16x8, fa), __builtin_bit_cast(bf16x8, bfr), ac[pt]); }
                        }
                    };
                    if (doA) { mask(GA, liA, rowA, alA); pv(GA, acc[0]); }
                    mask(GB, liB, rowB, alB); pv(GB, acc[1]);
                }
            }
            asm volatile("" ::: "memory");
            v4u zs[2][4];
#pragma unroll
            for (int which = 0; which < 2; ++which) { const int li = which == 0 ? lp : 3 - lp; const size_t t = (size_t)(t0 + 32 * li + erow);
#pragma unroll
                for (int j = 0; j < 4; ++j) zs[which][j] = *(const v4u*)(ZS + t * DIN + 64 * h + 32 * ehalf + 8 * j); }
            __syncthreads();
            {
                LAS unsigned char* stg = lds + S_XT + wave * 8192;
#pragma unroll
                for (int which = 0; which < 2; ++which)
#pragma unroll
                    for (int pt = 0; pt < 2; ++pt)
#pragma unroll
                        for (int i = 0; i < 16; ++i) *(LAS bf16*)(stg + ((which * 32 + crow(i, hh)) * 64 + 32 * pt + l31) * 2) = (bf16)(pk2(acc[which][pt][i], 0.f) & 0xffffu);
                LDS_WAIT(); asm volatile("" ::: "memory");
#pragma unroll
                for (int which = 0; which < 2; ++which) { const int li = which == 0 ? lp : 3 - lp; const int l = 32 * li + erow; const size_t t = (size_t)(t0 + l);
                    float q = 0.f; unsigned w8[8];
#pragma unroll
                    for (int j = 0; j < 4; ++j) { const v4u yv = *(const LAS v4u*)(stg + ((which * 32 + erow) * 64 + 32 * ehalf + 8 * j) * 2); const v4u zv = zs[which][j];
                        float y[8] = {bflo(yv.x) * bflo(zv.x), bfhi(yv.x) * bfhi(zv.x), bflo(yv.y) * bflo(zv.y), bfhi(yv.y) * bfhi(zv.y), bflo(yv.z) * bflo(zv.z), bfhi(yv.z) * bfhi(zv.z), bflo(yv.w) * bflo(zv.w), bfhi(yv.w) * bfhi(zv.w)};
#pragma unroll
                        for (int k = 0; k < 8; ++k) q += y[k] * y[k];
                        w8[2 * j] = pk4_fp8(y[0], y[1], y[2], y[3]); w8[2 * j + 1] = pk4_fp8(y[4], y[5], y[6], y[7]); }
                    { unsigned char* yp = (unsigned char*)YS + t * DIN + 64 * h + 32 * ehalf;
                      *(v4u*)yp = (v4u){w8[0], w8[1], w8[2], w8[3]}; *(v4u*)(yp + 16) = (v4u){w8[4], w8[5], w8[6], w8[7]}; }
                    q += __shfl_xor(q, 1);
                    if (ehalf == 0) __hip_atomic_fetch_add(ssq + l, q, __ATOMIC_RELAXED, __HIP_MEMORY_SCOPE_WORKGROUP);
                }
            }
            __syncthreads();
        }
        if (tid < 128) ((float*)(F.ws + WS_RSTD))[(size_t)(t0 + tid) * 4 + g] = 1.0f / sqrtf(ssq[tid] * (1.0f / 512.f) + EPS);
        __syncthreads();
    }
}

constexpr int RT_LD = 1028;
DI void ph8_router(const Ctx& F, const Args& a, int reps) {
    const float* mod = (const float*)(F.ws + WS_CTL) + CW_MODC;
    const bf16* H = (const bf16*)(F.ws + WS_H16); const float* n2g = ARG(I_N2G); const float* bgrp = ARG(I_BGRP); const float* ber = ARG(I_BER);
    unsigned char* XN2 = F.ws + WS_XN; int* cnt0 = (int*)(F.ws + WS_CTL) + CW_CNT;
    int* RE = (int*)(F.ws + WS_ROUTE); int* RP = RE + 2 * M; float* RW = (float*)(RP + 2 * M); int* LIST = (int*)(F.ws + WS_LIST);
    const int lane = lane_id(), wave = F.wave;
    LAS float* tile = (LAS float*)F.lds;
    LAS float* pe = (LAS float*)F.lds;
    f32x4 gm[4], ga[4];
#pragma unroll
    for (int j = 0; j < 4; ++j) { const int k = 256 * j + 4 * lane; const f32x4 g = *(const f32x4*)(n2g + k), sc = *(const f32x4*)(mod + 4096 + k);
        gm[j] = g * (sc + 1.0f); ga[j] = *(const f32x4*)(mod + 3072 + k); }
    const int RU = (M / 32 + F.G - 1) / F.G;
    for (int it = 0; it < RU * reps; ++it) {
        const int unit = xcd_unit(F.xcd, F.xj, F.G >> 3, (it >= RU ? it - RU : it), M / 32); if (unit < 0) break; int* cnt = cnt0 + ((it >= RU * (reps - 1)) ? 0 : 4096);
        const int row0 = unit * 32;
        {
            f32x4 v[4][4];
#pragma unroll
            for (int rr = 0; rr < 4; ++rr)
#pragma unroll
                for (int j = 0; j < 4; ++j) { const v2u hw = *(const v2u*)(H + (size_t)(row0 + wave * 4 + rr) * D + 256 * j + 4 * lane); v[rr][j] = (f32x4){bflo(hw.x), bfhi(hw.x), bflo(hw.y), bfhi(hw.y)}; }
#pragma unroll
            for (int rr = 0; rr < 4; ++rr) { const int rl = wave * 4 + rr, row = row0 + rl; float ss = 0.f;
#pragma unroll
                for (int j = 0; j < 4; ++j) ss += (v[rr][j].x * v[rr][j].x + v[rr][j].y * v[rr][j].y) + (v[rr][j].z * v[rr][j].z + v[rr][j].w * v[rr][j].w);
                const float rstd = 1.0f / sqrtf(wave_sum(ss) * (1.0f / D) + EPS);
#pragma unroll
                for (int j = 0; j < 4; ++j) { const f32x4 n = v[rr][j] * rstd * gm[j] + ga[j];
                    *(LAS f32x4*)(tile + rl * RT_LD + 256 * j + 4 * lane) = n;
                    *(unsigned*)(XN2 + (size_t)row * D + 256 * j + 4 * lane) = pk4_fp8(n.x, n.y, n.z, n.w); }
            }
        }
        __syncthreads();
        pg8::f32x4 acc[2][5];
#pragma unroll
        for (int rt = 0; rt < 2; ++rt)
#pragma unroll
            for (int ct = 0; ct < 5; ++ct) acc[rt][ct] = (pg8::f32x4){0.f, 0.f, 0.f, 0.f};
        const int kb = wave * 128, fr = lane & 15, kq = lane >> 4;
        const bf16* WRH = (const bf16*)(F.ws + WS_WRH); const bf16* WRL = (const bf16*)(F.ws + WS_WRL);
#pragma unroll 2
        for (int ks = 0; ks < 4; ++ks) {
            const int k0 = kb + 32 * ks + 8 * kq;
            bf16x8 bh[5], bl[5];
#pragma unroll
            for (int ct = 0; ct < 5; ++ct) { bh[ct] = *(const bf16x8*)(WRH + (size_t)(16 * ct + fr) * D + k0); bl[ct] = *(const bf16x8*)(WRL + (size_t)(16 * ct + fr) * D + k0); }
#pragma unroll
            for (int rt = 0; rt < 2; ++rt) {
                const f32x4 x0 = *(const LAS f32x4*)(tile + (16 * rt + fr) * RT_LD + k0), x1 = *(const LAS f32x4*)(tile + (16 * rt + fr) * RT_LD + k0 + 4);
                v4u hv, lv;
                hv.x = pk2(x0.x, x0.y); hv.y = pk2(x0.z, x0.w); hv.z = pk2(x1.x, x1.y); hv.w = pk2(x1.z, x1.w);
                lv.x = pk2(x0.x - bflo(hv.x), x0.y - bfhi(hv.x)); lv.y = pk2(x0.z - bflo(hv.y), x0.w - bfhi(hv.y));
                lv.z = pk2(x1.x - bflo(hv.z), x1.y - bfhi(hv.z)); lv.w = pk2(x1.z - bflo(hv.w), x1.w - bfhi(hv.w));
                const bf16x8 ah = __builtin_bit_cast(bf16x8, hv), al = __builtin_bit_cast(bf16x8, lv);
#pragma unroll
                for (int ct = 0; ct < 5; ++ct) {
                    acc[rt][ct] = __builtin_amdgcn_mfma_f32_16x16x32_bf16(ah, bh[ct], acc[rt][ct], 0, 0, 0);
                    acc[rt][ct] = __builtin_amdgcn_mfma_f32_16x16x32_bf16(ah, bl[ct], acc[rt][ct], 0, 0, 0);
                    acc[rt][ct] = __builtin_amdgcn_mfma_f32_16x16x32_bf16(al, bh[ct], acc[rt][ct], 0, 0, 0); }
            }
        }
        __syncthreads();
#pragma unroll
        for (int rt = 0; rt < 2; ++rt)
#pragma unroll
            for (int ct = 0; ct < 5; ++ct)
#pragma unroll
                for (int r = 0; r < 4; ++r) pe[(wave * 32 + 16 * rt + 4 * kq + r) * 80 + 16 * ct + fr] = acc[rt][ct][r];
        __syncthreads();
        int e0s[4], e1s[4]; float w0s[4], w1s[4];
#pragma unroll
        for (int rr = 0; rr < 4; ++rr) { const int rl = wave * 4 + rr;
            float le = ber[lane], lgv = (lane < 8) ? bgrp[lane] : 0.f;
#pragma unroll
            for (int wv = 0; wv < 8; ++wv) { le += pe[(wv * 32 + rl) * 80 + lane]; if (lane < 8) lgv += pe[(wv * 32 + rl) * 80 + 64 + lane]; }
            float gl[8];
#pragma unroll
            for (int i = 0; i < 8; ++i) gl[i] = __shfl(lgv, i);
            int gi = 0; float gmax = gl[0];
#pragma unroll
            for (int i = 1; i < 8; ++i) if (gl[i] > gmax) { gmax = gl[i]; gi = i; }
            float den = 0.f;
#pragma unroll
            for (int i = 0; i < 8; ++i) den += __expf(gl[i] - gmax);
            const float gp = 1.0f / den;
            float el[8];
#pragma unroll
            for (int i = 0; i < 8; ++i) el[i] = __shfl(le, gi * 8 + i);
            int i0 = 0; float m0 = el[0];
#pragma unroll
            for (int i = 1; i < 8; ++i) if (el[i] > m0) { m0 = el[i]; i0 = i; }
            int i1 = -1; float m1 = -INFINITY;
#pragma unroll
            for (int i = 0; i < 8; ++i) if (i != i0 && el[i] > m1) { m1 = el[i]; i1 = i; }
            const float dd = __expf(m1 - m0);
            w0s[rr] = gp / (1.0f + dd); w1s[rr] = gp * dd / (1.0f + dd); e0s[rr] = gi * 8 + i0; e1s[rr] = gi * 8 + i1;
        }
        if (lane == 0) {
            int p0[4], p1[4];
#pragma unroll
            for (int rr = 0; rr < 4; ++rr) { p0[rr] = atomicAdd(cnt + 64 * e0s[rr], 1); p1[rr] = atomicAdd(cnt + 64 * e1s[rr], 1); }
#pragma unroll
            for (int rr = 0; rr < 4; ++rr) { const int row = row0 + wave * 4 + rr;
                RE[2 * row] = e0s[rr]; RE[2 * row + 1] = e1s[rr]; RP[2 * row] = p0[rr]; RP[2 * row + 1] = p1[rr]; RW[2 * row] = w0s[rr]; RW[2 * row + 1] = w1s[rr];
                LIST[e0s[rr] * 16384 + p0[rr]] = row; LIST[e1s[rr] * 16384 + p1[rr]] = row; }
        }
        __syncthreads();
    }
}

DI void build_tilebase(const Ctx& F) {
    const int* cnt = (const int*)(F.ws + WS_CTL) + CW_CNT; LAS int* tb = (LAS int*)(F.lds + TB_OFF);
    if (F.wave == 0) {
        const int lane = lane_id(); const int tiles = (cnt[64 * lane] + 255) >> 8; int inc = tiles;
#pragma unroll
        for (int o = 1; o < 64; o <<= 1) { const int t = __shfl_up(inc, o); if (lane >= o) inc += t; }
        tb[lane] = inc - tiles; if (lane == 63) tb[NE] = inc; ((LAS int*)(F.lds + CNTL_OFF))[lane] = cnt[64 * lane];
    }
    __syncthreads();
}
DI void fill_tokl(const Ctx& F, const MoeOrder& S) {
    const LAS int* tb = (const LAS int*)(F.lds + TB_OFF); const LAS int* cntl = (const LAS int*)(F.lds + CNTL_OFF); LAS int* tokl = (LAS int*)(F.lds + TOKL_OFF);
    const int* LIST = (const int*)(F.ws + WS_LIST); const int tid = F.wave * 64 + lane_id();
    for (int i = 0; i < 4; ++i) { pg8::Unit u; if (!S.next(i, u)) break;
        const int e = u.pn >> 2, r = 256 * (u.pm - tb[e]) + tid;
        if (tid < 256) tokl[256 * i + tid] = (r < cntl[e]) ? LIST[e * 16384 + r] : 0; }
    asm volatile("s_waitcnt vmcnt(0) lgkmcnt(0)" ::: "memory"); __syncthreads();
}
DI void ph12_final(const Ctx& F, const Args& a, int reps) {
    const float* mod = (const float*)(F.ws + WS_CTL) + CW_MODC; float* H = (float*)argp<N_IN>(); const bf16* H16 = (const bf16*)(F.ws + WS_H16); const float* fg = ARG(I_FG);
    const unsigned char* YE = F.ws + WS_YEXP; const int* RE = (const int*)(F.ws + WS_ROUTE); const int* RP = RE + 2 * M; const float* RW = (const float*)(F.ws + WS_ROUTE) + 4 * M;
    const LAS int* tb = (const LAS int*)(F.lds + TB_OFF);
    float* OUT2 = (float*)(F.ws + WS_U);
    const int gw = F.vcu * NWAVES + F.wave, NGW = F.G * NWAVES, lane = lane_id();
    f32x4 g2[4], fgv[4];
#pragma unroll
    for (int j = 0; j < 4; ++j) { g2[j] = *(const f32x4*)(mod + 5 * 1024 + 256 * j + 4 * lane); fgv[j] = *(const f32x4*)(fg + 256 * j + 4 * lane); }
    const int RT = (M / 2 + NGW - 1) / NGW;
    for (int it = 0; it < RT * reps; ++it) {
        const int t0 = 2 * xcd_unit(F.xcd, F.xj * NWAVES + F.wave, NGW >> 3, (it >= RT ? it - RT : it), M / 2); if (t0 < 0) break;
        float* O = (it >= RT * (reps - 1)) ? H : OUT2;
        int tt[2], d0[2], d1[2]; float w0[2], w1[2];
#pragma unroll
        for (int u = 0; u < 2; ++u) { tt[u] = (t0 + u) % M; d0[u] = 256 * tb[RE[2 * tt[u]]] + RP[2 * tt[u]]; d1[u] = 256 * tb[RE[2 * tt[u] + 1]] + RP[2 * tt[u] + 1]; w0[u] = RW[2 * tt[u]]; w1[u] = RW[2 * tt[u] + 1]; }
        f32x4 hv[2][4]; unsigned ya[2][4], yb[2][4];
#pragma unroll
        for (int u = 0; u < 2; ++u)
#pragma unroll
            for (int j = 0; j < 4; ++j) { const v2u hw = *(const v2u*)(H16 + (size_t)tt[u] * D + 256 * j + 4 * lane); hv[u][j] = (f32x4){bflo(hw.x), bfhi(hw.x), bflo(hw.y), bfhi(hw.y)};
                ya[u][j] = *(const unsigned*)(YE + (size_t)d0[u] * D + 256 * j + 4 * lane); yb[u][j] = *(const unsigned*)(YE + (size_t)d1[u] * D + 256 * j + 4 * lane); }
#pragma unroll
        for (int u = 0; u < 2; ++u) {
            f32x4 v[4]; float ss = 0.f;
#pragma unroll
            for (int j = 0; j < 4; ++j) { const unsigned a4 = ya[u][j], b4 = yb[u][j];
                const f2v a01 = __builtin_amdgcn_cvt_pk_f32_fp8(a4, false), a23 = __builtin_amdgcn_cvt_pk_f32_fp8(a4, true), b01 = __builtin_amdgcn_cvt_pk_f32_fp8(b4, false), b23 = __builtin_amdgcn_cvt_pk_f32_fp8(b4, true);
                f32x4 mo; mo.x = w0[u] * a01.x + w1[u] * b01.x; mo.y = w0[u] * a01.y + w1[u] * b01.y; mo.z = w0[u] * a23.x + w1[u] * b23.x; mo.w = w0[u] * a23.y + w1[u] * b23.y;
                mo = mo * 0.0625f;
                v[j] = hv[u][j] + g2[j] * mo; ss += (v[j].x * v[j].x + v[j].y * v[j].y) + (v[j].z * v[j].z + v[j].w * v[j].w); }
            const float rstd = 1.0f / sqrtf(wave_sum(ss) * (1.0f / D) + EPS);
#pragma unroll
            for (int j = 0; j < 4; ++j) *(f32x4*)(O + (size_t)tt[u] * D + 256 * j + 4 * lane) = v[j] * rstd * fgv[j];
        }
    }
}

constexpr int N_PHASES = 13;
#ifndef REP_MASK
#define REP_MASK 0
#endif
#define REPS(k) (((REP_MASK >> (k)) & 1) ? 2 : 1)
#ifndef MK_ONE_LAUNCH
#define MK_ONE_LAUNCH 1
#endif

struct RepOrder { pg8::StaticOrder s; int n, reps;
    DI bool next(int i, pg8::Unit& u) const { if (i >= n * reps) return false; return s.next(i % n, u); }
    DI void a_ready(const pg8::Unit&) const {}
    DI void done(const pg8::Unit&) const {} };

__global__ void __launch_bounds__(NTHREADS, 2) fwd_kernel(Args args) {
    extern __shared__ __attribute__((aligned(16))) unsigned char lds_raw[];
    Ctx F;
    F.lds = (LAS unsigned char*)lds_raw;
    F.wave = __builtin_amdgcn_readfirstlane((int)threadIdx.x >> 6);
    F.G = gridDim.x; { const int bx = blockIdx.x; F.xcd = bx & 7; F.xj = bx >> 3; F.vcu = F.xcd * (F.G >> 3) + F.xj; }
    F.ws = (unsigned char*)argp<N_IN + 1>();
    volatile LAS unsigned* MISC = (volatile LAS unsigned*)(F.lds + LDSCTL_OFF);
    for (int u = threadIdx.x; u < (LDS_BYTES - LDSCTL_OFF) / 4; u += NTHREADS) ((LAS unsigned*)(F.lds + LDSCTL_OFF))[u] = 0u;
    __syncthreads();
    const int lo = args.ph_lo, hi = args.ph_hi;
    unsigned* barw = (unsigned*)(F.ws + WS_CTL) + CW_BAR;
    XcdBarrier bar; bar.bar = barw; bar.x = 0; bar.st = nullptr;
    if (hi - lo > 1) bar = xcd_barrier_post(barw, MISC + 8);
    bar.wave = F.wave;
#define IN(k) (lo <= (k) && (k) < hi)
#define SEAM(k) do { if (IN(k) && IN((k) + 1)) { xcd_barrier(bar); if (REPS(14) > 1) xcd_barrier(bar); } } while (0)
    unsigned char* ws = F.ws;
    bf16* XN = (bf16*)(ws + WS_XN);
    const float* mod = (const float*)(ws + WS_CTL) + CW_MOD;

    if (IN(0)) { ph0_prologue(F, args, REPS(0)); SEAM(0); }
    if (IN(1)) { for (int rep = 0; rep < REPS(1); ++rep) { ph1_norm_dt(F, args); __syncthreads(); } SEAM(1); }
    if (IN(2)) {
        pg8::Gemm g{(const bf16*)(ws + WS_XN8), (const bf16*)(ws + WS_W8IN), M, NPROJ, D / 2}; pg8::StaticOrder S; S.init(M, NPROJ, F.G, (int)blockIdx.x);
        EpiInProj E{ws};
        RepOrder R{S, (S.nwg - S.c + S.G - 1) / S.G, REPS(2)};
        pg8::gemm_phase<EpiInProj, RepOrder, true, true, false, false, true>(F.lds, g, R, E, F.wave);
        SEAM(2);
    }
    if (IN(3)) { ph3_convbranch(F, args, REPS(3)); __syncthreads(); ph3_chunk_states(F, args, REPS(13)); __syncthreads(); SEAM(3); }
    if (IN(4)) {
        if (REPS(4) > 1) ph4_scan(F, WS_YS);
        ph4_scan(F, WS_ST);
        pg8::Gemm g{XN, (const bf16*)(ws + WS_WCV), M, D, D}; pg8::StaticOrder S; S.init(M, D, F.G, (int)blockIdx.x);
        EpiGate<false> E{(bf16*)(ws + WS_TMP), nullptr, (const bf16*)(ws + WS_GATE), 0, nullptr};
        RepOrder R{S, (S.nwg - S.c + S.G - 1) / S.G, REPS(15)};
        pg8::gemm_phase<EpiGate<false>, RepOrder, false, true>(F.lds, g, R, E, F.wave);
        SEAM(4);
    }
    if (IN(5)) { ph5_ssd_out(F, args, REPS(5)); SEAM(5); }
    if (IN(6)) {
        pg8::Gemm g{(const bf16*)(ws + WS_YS), (const bf16*)(ws + WS_WSSM), M, D, DIN / 2}; pg8::StaticOrder S; S.init(M, D, F.G, (int)blockIdx.x);
        LAS float* rt = (LAS float*)(F.lds + RT_OFF);
        EpiGate<true> E{(bf16*)(ws + WS_MG), (const bf16*)(ws + WS_TMP), (const bf16*)(ws + WS_GATE), 1024, rt};
        for (int i = 0;; ++i) {
            OneUnit S1; if (!S.next(i, S1.u)) break;
            if (F.wave < 4) { const int tid = F.wave * 64 + lane_id(); const f32x4 r = *(const f32x4*)((const float*)(ws + WS_RSTD) + (size_t)(S1.u.pm * 256 + tid) * 4);
                *(LAS f32x4*)(rt + tid * 4) = (f32x4){r.x / r.y, r.y / r.z, r.z / r.w, r.w}; }
            asm volatile("s_waitcnt vmcnt(0) lgkmcnt(0)" ::: "memory"); __syncthreads();
            pg8::gemm_phase<EpiGate<true>, OneUnit, false, true, true>(F.lds, g, S1, E, F.wave);
            __syncthreads();
        }
        SEAM(6);
    }
    if (IN(7)) {
        pg8::Gemm g{(const bf16*)(ws + WS_MG), (const bf16*)(ws + WS_WMIX), M, D, D}; pg8::StaticOrder S; S.init(M, D, F.G, (int)blockIdx.x);
        EpiMix E{(bf16*)(ws + WS_H16), ARG(I_X), (const float*)(ws + WS_CTL) + CW_MODC + 2 * 1024};
        RepOrder R{S, (S.nwg - S.c + S.G - 1) / S.G, REPS(7)};
        pg8::gemm_phase<EpiMix, RepOrder, false, true>(F.lds, g, R, E, F.wave);
        SEAM(7);
    }
    if (IN(8)) { for (int rep = 0; rep < REPS(8); ++rep) { convert_experts(F, args); __syncthreads(); } ph8_router(F, args, REPS(9)); if (IN(8) && IN(10)) xcd_barrier(bar); }
    if (IN(10)) {
        build_tilebase(F);
        const LAS int* tb = (const LAS int*)(F.lds + TB_OFF);
        pg8::Gemm g{(const bf16*)(ws + WS_XN), (const bf16*)(ws + WS_W13), M, NE * 1024, D / 2};
        MoeOrder S{tb, F.G, F.vcu, tb[NE] * 4, 1, (const LAS int*)(F.lds + TOKL_OFF)};
        fill_tokl(F, S);
        EpiUp E{ws + WS_HDN};
        pg8::gemm_phase<EpiUp, MoeOrder, true, true, true, true>(F.lds, g, S, E, F.wave);
        SEAM(10);
    }
    if (IN(11)) {
        build_tilebase(F);
        const LAS int* tb = (const LAS int*)(F.lds + TB_OFF);
        pg8::Gemm g{(const bf16*)(ws + WS_HDN), (const bf16*)(ws + WS_W2), 49152, NE * 1024, DFF / 2};
        MoeOrder S{tb, F.G, F.vcu, tb[NE] * 4, 1, nullptr};
        EpiDown E{ws + WS_YEXP};
        pg8::gemm_phase<EpiDown, MoeOrder, true, true, true>(F.lds, g, S, E, F.wave);
        SEAM(11);
    }
    if (IN(12)) { build_tilebase(F); ph12_final(F, args, REPS(12)); }
#undef IN
#undef SEAM
}

extern "C" void kernel_launch(void* const* d_in, const int* in_sizes, int n_in, void* d_out, int out_size, void* d_ws, size_t ws_size, hipStream_t stream) {
    static int grid = 0;
    if (grid == 0) {
        if (n_in != N_IN || in_sizes[0] != M * D || out_size != M * D || ws_size < WS_END) {
            fprintf(stderr, "kernel_launch: unexpected shapes: n_in %d in0 %d out %d ws %zu (need %zu)\n", n_in, n_in > 0 ? in_sizes[0] : -1, out_size, ws_size, (size_t)WS_END); grid = -1; return; }
        int dev = 0, cus = 0, per_cu = 0;
        if (hipGetDevice(&dev) != hipSuccess || hipDeviceGetAttribute(&cus, hipDeviceAttributeMultiprocessorCount, dev) != hipSuccess) { fprintf(stderr, "kernel_launch: device query failed\n"); grid = -1; return; }
        if (hipFuncSetAttribute((const void*)fwd_kernel, hipFuncAttributeMaxDynamicSharedMemorySize, LDS_BYTES) != hipSuccess) { fprintf(stderr, "kernel_launch: hipFuncSetAttribute failed\n"); grid = -1; return; }
        if (hipOccupancyMaxActiveBlocksPerMultiprocessor(&per_cu, (const void*)fwd_kernel, NTHREADS, LDS_BYTES) != hipSuccess || per_cu < 1) {
            fprintf(stderr, "kernel_launch: the occupancy query admits no workgroup of this kernel per CU (%d); nothing launched\n", per_cu); (void)hipGetLastError(); grid = -1; return; }
        grid = cus;
        if (cus < 192 || (cus & 7)) { fprintf(stderr, "kernel_launch: built for a 256-CU device (the MoE unit table holds 4 units per workgroup); %d CUs: nothing launched\n", cus); grid = -1; return; }
        fprintf(stderr, "kernel_launch: grid %d (cus %d, per_cu %d)\n", grid, cus, per_cu);
    }
    if (grid < 0) return;
    (void)hipMemsetAsync((char*)d_ws + WS_CTL, 0, CTL_ZERO_BYTES, stream);
    Args a{};
    for (int i = 0; i < N_IN; ++i) a.in[i] = (const float*)d_in[i];
    a.out = (float*)d_out; a.ws = (unsigned char*)d_ws;
#if MK_ONE_LAUNCH
    a.ph_lo = 0; a.ph_hi = N_PHASES;
    void* kargs[] = {&a};
    hipError_t e = hipLaunchCooperativeKernel((const void*)fwd_kernel, dim3(grid), dim3(NTHREADS), kargs, LDS_BYTES, stream);
    if (e != hipSuccess) fprintf(stderr, "kernel_launch: cooperative launch failed: %s\n", hipGetErrorString(e));
#else
    for (int ph = 0; ph < N_PHASES; ++ph) {
        a.ph_lo = ph; a.ph_hi = ph + 1;
        hipLaunchKernelGGL(fwd_kernel, dim3(grid), dim3(NTHREADS), LDS_BYTES, stream, a);
    }
#endif
}
```

```cpp
#include <hip/hip_runtime.h>
#include <hip/hip_cooperative_groups.h>
#include <cstdio>
#include <cstdint>
namespace pg8 {
#define PG8_LAS __attribute__((address_space(3)))
typedef unsigned short bf16_t;
typedef short bf16x8 __attribute__((ext_vector_type(8)));
typedef float f32x4 __attribute__((ext_vector_type(4)));
typedef unsigned u32x4 __attribute__((ext_vector_type(4)));
typedef int v4i_ __attribute__((ext_vector_type(4)));
typedef int v8i_ __attribute__((ext_vector_type(8)));
constexpr int BM = 256, BK = 64, HALF = 128, HTB = HALF * BK * 2  , STAGE_BYTES = 8 * HTB, NXCD = 8, WGM = 8;

__host__ __device__ __forceinline__ int lds_byte(int r, int c) { const int st = (r >> 4) * 2 + (c >> 5), rr = r & 15, cc = c & 31, ob = rr * 64 + cc * 2; return st * 1024 + (ob ^ (((ob >> 9) & 1) << 5)); }
__host__ __device__ __forceinline__ void stage_rc(int b, int& R, int& C) { const int st = b / 1024, sb = b % 1024, swz = sb ^ (((sb >> 9) & 1) << 5); R = (st >> 1) * 16 + swz / 64; C = (st & 1) * 32 + (swz % 64) / 2; }
__host__ __device__ __forceinline__ int perm32(int rho) { const int n = rho >> 4, i = rho & 15; return 8 * (i >> 2) + 4 * n + (i & 3); }

struct Unit { int pm, pn; };
struct Gemm { const bf16_t* A; const bf16_t* Bt; int M, N, K; };

struct StaticOrder {
    int nM, nN, nwg, G, c;
    __host__ __device__ void init(int M, int N, int G_, int c_) { nM = M / BM; nN = N / BM; nwg = nM * nN; G = G_; c = c_; }
    __host__ __device__ bool next(int i, Unit& u) const {
        const long L = (long)i * G + c; if (L >= nwg) return false;
        int wgid = (int)L; { const int q = nwg / NXCD, r = nwg % NXCD, xcd = wgid % NXCD, off = wgid / NXCD; wgid = (xcd < r ? xcd * (q + 1) : r * (q + 1) + (xcd - r) * q) + off; }
        const int nig = WGM * nN, gid = wgid / nig, fm = gid * WGM, gsz = (nM - fm) < WGM ? (nM - fm) : WGM;
        u.pm = fm + ((wgid % nig) % gsz); u.pn = (wgid % nig) / gsz; return true;
    }
    __device__ __forceinline__ void a_ready(const Unit&) const {}
    __device__ __forceinline__ void done(const Unit&) const {}
};

__device__ __forceinline__ unsigned cvt_pk_bf16(float lo, float hi) { unsigned r; asm volatile("v_cvt_pk_bf16_f32 %0, %1, %2" : "=v"(r) : "v"(lo), "v"(hi)); return r; }
typedef float f32x2 __attribute__((ext_vector_type(2)));
template <class Epi, class Sched, bool ALIGN_EPI = false, bool SP2 = false, bool FP8 = false, bool GATHER = false, bool I8 = false>
__device__ __forceinline__ void gemm_phase(PG8_LAS unsigned char* lds, const Gemm g, const Sched& S, const Epi& E, const int wave_in) {
    const int lane = (int)__builtin_amdgcn_mbcnt_hi(~0u, __builtin_amdgcn_mbcnt_lo(~0u, 0u)), wid = wave_in, tid = wid * 64 + lane, wr = wid >> 2, wc = wid & 3, fr = lane & 15, fq = lane >> 4;
    const int K = g.K, nt = K / BK;
    unsigned voffA[2], voffB[2];
#pragma unroll
    for (int i = 0; i < 2; ++i) { int R, C; stage_rc(tid * 16 + i * 8192, R, C); const int Rb = Epi::PERM ? ((R & ~31) + perm32(R & 31)) : R;
        voffA[i] = (unsigned)(R * K + C) * 2u; voffB[i] = (unsigned)(Rb * K + C) * 2u; }
    static_assert(!GATHER || SP2, "GATHER is implemented in the SP2 loop");
    unsigned gA[2][2], ngA[2][2]; int RA[2]; unsigned CA2[2];
#pragma unroll
    for (int i = 0; i < 2; ++i) { int R, C; stage_rc(tid * 16 + i * 8192, R, C); RA[i] = R; CA2[i] = (unsigned)C * 2u; }
    auto load_g = [&](int ui_, unsigned (&dst)[2][2]) {
        if constexpr (GATHER) {
#pragma unroll
            for (int h = 0; h < 2; ++h)
#pragma unroll
                for (int i = 0; i < 2; ++i) dst[h][i] = (unsigned)S.tokl[ui_ * 256 + 128 * h + RA[i]] * (unsigned)(K * 2) + CA2[i];
        }
    };
    const size_t kstep = (size_t)(BK * 2);
    const size_t hstep = (size_t)HALF * K * 2;
    const size_t tstep = 2 * hstep;
    const size_t hstepA = GATHER ? (size_t)0 : hstep, tstepA = GATHER ? (size_t)0 : 2 * hstep;
    const unsigned ldsw = (unsigned)wid * 1024u;
    const int aoff = lds_byte(wr * 64 + fr, fq * 8), boff = lds_byte(wc * 32 + fr, fq * 8);
#define PG8_SA(b, h) (((b) * 2 + (h)) * HTB)
#define PG8_SB(b, h) ((4 + (b) * 2 + (h)) * HTB)
#define PG8_STAGE(bufoff, gbase, voff) do { _Pragma("unroll") for (int _i = 0; _i < 2; ++_i) \
        __builtin_amdgcn_global_load_lds((const unsigned*)((const char*)(gbase) + (voff)[_i]), (PG8_LAS unsigned*)(lds + (bufoff) + ldsw + _i * 8192), 16, 0, 0); } while (0)
#define PG8_STAGE_A(bufoff, gbase, gvoff) do { if constexpr (GATHER) { PG8_STAGE(bufoff, gbase, gvoff); } else { PG8_STAGE(bufoff, gbase, voffA); } } while (0)
#define PG8_LDA(dst, b, h) do { if constexpr (FP8) { _Pragma("unroll") for (int m = 0; m < 4; ++m) dst##8[m] = __builtin_shufflevector(*(const PG8_LAS v4i_*)(lds + PG8_SA(b, h) + aoff + m * 2048), *(const PG8_LAS v4i_*)(lds + PG8_SA(b, h) + aoff + m * 2048 + 1024), 0, 1, 2, 3, 4, 5, 6, 7); } \
        else { _Pragma("unroll") for (int m = 0; m < 4; ++m) _Pragma("unroll") for (int k = 0; k < 2; ++k) dst[m][k] = *(const PG8_LAS bf16x8*)(lds + PG8_SA(b, h) + aoff + m * 2048 + k * 1024); } } while (0)
#define PG8_LDB(dst, b, h) do { if constexpr (FP8) { _Pragma("unroll") for (int n = 0; n < 2; ++n) dst##8[n] = __builtin_shufflevector(*(const PG8_LAS v4i_*)(lds + PG8_SB(b, h) + boff + n * 2048), *(const PG8_LAS v4i_*)(lds + PG8_SB(b, h) + boff + n * 2048 + 1024), 0, 1, 2, 3, 4, 5, 6, 7); } \
        else { _Pragma("unroll") for (int n = 0; n < 2; ++n) _Pragma("unroll") for (int k = 0; k < 2; ++k) dst[n][k] = *(const PG8_LAS bf16x8*)(lds + PG8_SB(b, h) + boff + n * 2048 + k * 1024); } } while (0)
#define PG8_MMA(ai, bj, At, Bt) do { __builtin_amdgcn_s_setprio(1); \
        if constexpr (FP8) {   \
              \
            _Pragma("unroll") for (int m = 0; m < 4; ++m) _Pragma("unroll") for (int n = 0; n < 2; ++n) \
                asm volatile("v_mfma_scale_f32_16x16x128_f8f6f4 %0, %1, %2, %0, %3, %4 op_sel_hi:[0,0,0]" : "+v"(acc[ai][bj][m][n]) : "v"(Bt##8[n]), "v"(At##8[m]), "v"(scale_w), "v"(scale_x)); \
        } else { \
        _Pragma("unroll") for (int m = 0; m < 4; ++m) _Pragma("unroll") for (int n = 0; n < 2; ++n) _Pragma("unroll") for (int k = 0; k < 2; ++k) { \
        if constexpr (I8) acc[ai][bj][m][n] = __builtin_bit_cast(f32x4, __builtin_amdgcn_mfma_i32_16x16x64_i8(__builtin_bit_cast(v4i_, Bt[n][k]), __builtin_bit_cast(v4i_, At[m][k]), __builtin_bit_cast(v4i_, acc[ai][bj][m][n]), 0, 0, 0)); \
        else acc[ai][bj][m][n] = __builtin_amdgcn_mfma_f32_16x16x32_bf16(Bt[n][k], At[m][k], acc[ai][bj][m][n], 0, 0, 0); } } __builtin_amdgcn_s_setprio(0); } while (0)
#define PG8_WAIT_V(n) asm volatile("s_waitcnt vmcnt(" #n ")" ::: "memory")
#define PG8_WAIT_L(n) asm volatile("s_waitcnt lgkmcnt(" #n ")" ::: "memory")
#define PG8_BAR __builtin_amdgcn_s_barrier()
#define PG8_SCHED __builtin_amdgcn_sched_barrier(0)
    Unit cur, nxt; int ui = 0;
    if (!S.next(0, cur)) return;
    f32x4 acc[2][2][4][2];
#pragma unroll
    for (int a = 0; a < 2; ++a)
#pragma unroll
        for (int b = 0; b < 2; ++b)
#pragma unroll
            for (int m = 0; m < 4; ++m)
#pragma unroll
                for (int n = 0; n < 2; ++n) acc[a][b][m][n] = (f32x4){0.f, 0.f, 0.f, 0.f};
    auto xdl_settle = [&]() {
        asm volatile("s_nop 15\n\ts_nop 15" : "+v"(acc[0][0][0][0]), "+v"(acc[0][0][0][1]), "+v"(acc[0][0][1][0]), "+v"(acc[0][0][1][1]), "+v"(acc[0][0][2][0]), "+v"(acc[0][0][2][1]), "+v"(acc[0][0][3][0]), "+v"(acc[0][0][3][1]), "+v"(acc[0][1][0][0]), "+v"(acc[0][1][0][1]), "+v"(acc[0][1][1][0]), "+v"(acc[0][1][1][1]), "+v"(acc[0][1][2][0]), "+v"(acc[0][1][2][1]), "+v"(acc[0][1][3][0]), "+v"(acc[0][1][3][1]));
        asm volatile("s_nop 0" : "+v"(acc[1][0][0][0]), "+v"(acc[1][0][0][1]), "+v"(acc[1][0][1][0]), "+v"(acc[1][0][1][1]), "+v"(acc[1][0][2][0]), "+v"(acc[1][0][2][1]), "+v"(acc[1][0][3][0]), "+v"(acc[1][0][3][1]), "+v"(acc[1][1][0][0]), "+v"(acc[1][1][0][1]), "+v"(acc[1][1][1][0]), "+v"(acc[1][1][1][1]), "+v"(acc[1][1][2][0]), "+v"(acc[1][1][2][1]), "+v"(acc[1][1][3][0]), "+v"(acc[1][1][3][1]));
    };
    const int scale_w = 0x79797979, scale_x = 0x7f7f7f7f;
    bf16x8 At[4][2], B0[2][2], B1[2][2]; v8i_ At8[4], B08[2], B18[2];
    const char* cA = (const char*)g.A + (size_t)cur.pm * tstepA; const char* cB = (const char*)g.Bt + (size_t)cur.pn * tstep;
    load_g(0, gA);
    S.a_ready(cur);
    if constexpr (SP2) {
        PG8_STAGE(PG8_SB(0, 0), cB, voffB); PG8_STAGE(PG8_SB(0, 1), cB + hstep, voffB); PG8_STAGE_A(PG8_SA(0, 0), cA, gA[0]); PG8_STAGE_A(PG8_SA(0, 1), cA + hstepA, gA[1]);
        if (wr == 1) PG8_BAR;
        PG8_WAIT_V(2); PG8_BAR;
        PG8_STAGE(PG8_SB(1, 0), cB + kstep, voffB); PG8_STAGE_A(PG8_SA(1, 0), cA + kstep, gA[0]); PG8_STAGE(PG8_SB(1, 1), cB + hstep + kstep, voffB);
        PG8_WAIT_V(6); PG8_BAR;
    } else {
        PG8_STAGE(PG8_SB(0, 0), cB, voffB); PG8_STAGE(PG8_SA(0, 0), cA, voffA); PG8_STAGE(PG8_SB(0, 1), cB + hstep, voffB); PG8_STAGE(PG8_SA(0, 1), cA + hstep, voffA);
        if (wr == 1) PG8_BAR;
        PG8_WAIT_V(4); PG8_BAR;
        PG8_STAGE(PG8_SB(1, 0), cB + kstep, voffB); PG8_STAGE(PG8_SA(1, 0), cA + kstep, voffA); PG8_STAGE(PG8_SB(1, 1), cB + hstep + kstep, voffB);
        PG8_WAIT_V(6); PG8_BAR;
    }
    for (;;) {
        const bool has_next = S.next(ui + 1, nxt);
        const char* nA = has_next ? (const char*)g.A + (size_t)nxt.pm * tstepA : cA; const char* nB = has_next ? (const char*)g.Bt + (size_t)nxt.pn * tstep : cB;
        if constexpr (GATHER) { if (has_next) load_g(ui + 1, ngA); else {
#pragma unroll
            for (int h = 0; h < 2; ++h)
#pragma unroll
                for (int i = 0; i < 2; ++i) ngA[h][i] = gA[h][i]; } }
        for (int t = 0; t < nt; t += 2) {
            const bool last = (t == nt - 2);
            const char* a1 = cA + (size_t)(t + 1) * kstep;
            const char* a2 = last ? nA : cA + (size_t)(t + 2) * kstep; const char* b2 = last ? nB : cB + (size_t)(t + 2) * kstep;
            const char* a3 = a2 + kstep; const char* b3 = b2 + kstep;
            if (last && has_next) S.a_ready(nxt);
            unsigned sN[2][2];
#pragma unroll
            for (int h = 0; h < 2; ++h)
#pragma unroll
                for (int i = 0; i < 2; ++i) sN[h][i] = last ? ngA[h][i] : gA[h][i];
            if constexpr (SP2) {
            PG8_LDB(B0, 0, 0); PG8_LDB(B1, 0, 1); PG8_SCHED; PG8_LDA(At, 0, 0); PG8_STAGE_A(PG8_SA(1, 1), a1 + hstepA, gA[1]);
            PG8_WAIT_V(8); PG8_WAIT_L(0); PG8_BAR; PG8_MMA(0, 0, At, B0); PG8_MMA(0, 1, At, B1); PG8_BAR; PG8_SCHED;
            PG8_LDA(At, 0, 1); PG8_STAGE(PG8_SB(0, 0), b2, voffB); PG8_STAGE(PG8_SB(0, 1), b2 + hstep, voffB); PG8_STAGE_A(PG8_SA(0, 0), a2, sN[0]);
            PG8_WAIT_V(8); PG8_WAIT_L(0); PG8_BAR; PG8_MMA(1, 0, At, B0); PG8_MMA(1, 1, At, B1); PG8_BAR; PG8_SCHED;
            PG8_LDB(B0, 1, 0); PG8_LDB(B1, 1, 1); PG8_SCHED; PG8_LDA(At, 1, 0); PG8_STAGE_A(PG8_SA(0, 1), a2 + hstepA, sN[1]);
            PG8_WAIT_V(8); PG8_WAIT_L(0); PG8_BAR; PG8_MMA(0, 0, At, B0); PG8_MMA(0, 1, At, B1); PG8_BAR; PG8_SCHED;
            PG8_LDA(At, 1, 1); PG8_STAGE(PG8_SB(1, 0), b3, voffB); PG8_STAGE(PG8_SB(1, 1), b3 + hstep, voffB); PG8_STAGE_A(PG8_SA(1, 0), a3, sN[0]);
            PG8_WAIT_V(8); PG8_WAIT_L(0); PG8_BAR; PG8_MMA(1, 0, At, B0); PG8_MMA(1, 1, At, B1); PG8_BAR; PG8_SCHED;
            } else {
            PG8_LDB(B0, 0, 0); PG8_SCHED; PG8_LDA(At, 0, 0); PG8_STAGE(PG8_SA(1, 1), a1 + hstep, voffA);
            PG8_WAIT_L(8); PG8_BAR; PG8_WAIT_L(0); PG8_MMA(0, 0, At, B0); PG8_BAR; PG8_SCHED;
            PG8_LDB(B1, 0, 1); PG8_STAGE(PG8_SB(0, 0), b2, voffB);
            PG8_BAR; PG8_WAIT_L(0); PG8_MMA(0, 1, At, B1); PG8_BAR;
            PG8_LDA(At, 0, 1); PG8_STAGE(PG8_SA(0, 0), a2, voffA);
            PG8_BAR; PG8_WAIT_L(0); PG8_MMA(1, 0, At, B0); PG8_BAR; PG8_SCHED;
            PG8_STAGE(PG8_SB(0, 1), b2 + hstep, voffB);
            PG8_WAIT_V(6); PG8_BAR; PG8_MMA(1, 1, At, B1); PG8_BAR;
            PG8_LDB(B0, 1, 0); PG8_SCHED; PG8_LDA(At, 1, 0); PG8_STAGE(PG8_SA(0, 1), a2 + hstep, voffA);
            PG8_WAIT_L(8); PG8_BAR; PG8_WAIT_L(0); PG8_MMA(0, 0, At, B0); PG8_BAR; PG8_SCHED;
            PG8_LDB(B1, 1, 1); PG8_STAGE(PG8_SB(1, 0), b3, voffB);
            PG8_BAR; PG8_WAIT_L(0); PG8_MMA(0, 1, At, B1); PG8_BAR;
            PG8_LDA(At, 1, 1); PG8_STAGE(PG8_SA(1, 0), a3, voffA);
            PG8_BAR; PG8_WAIT_L(0); PG8_MMA(1, 0, At, B0); PG8_BAR; PG8_SCHED;
            PG8_STAGE(PG8_SB(1, 1), b3 + hstep, voffB);
            PG8_WAIT_V(6); PG8_BAR; PG8_MMA(1, 1, At, B1); PG8_BAR;
            }
            if constexpr (Epi::KHOOK) { constexpr int HK = FP8 ? 4 : 8, HS = FP8 ? 2 : 3;
                if ((((t + 2) & (HK - 1)) == 0) && (t + 2 < nt)) { if constexpr (FP8) xdl_settle(); E.khook(acc, ((t + 2) >> HS) - 1, wr, fr); if constexpr (FP8) xdl_settle(); } }
        }
        if constexpr (ALIGN_EPI) { if (wr == 0) PG8_BAR; }
        if constexpr (FP8) {
            xdl_settle();
        }
        if constexpr (!Epi::AFTER_DRAIN) { E(acc, cur, wr, wc, fr, fq); S.done(cur); }
        if (!has_next) break;
#pragma unroll
        for (int a = 0; a < 2; ++a)
#pragma unroll
            for (int b = 0; b < 2; ++b)
#pragma unroll
                for (int m = 0; m < 4; ++m)
#pragma unroll
                    for (int n = 0; n < 2; ++n) acc[a][b][m][n] = (f32x4){0.f, 0.f, 0.f, 0.f};
        cur = nxt; cA = nA; cB = nB; ++ui;
        if constexpr (GATHER) {
#pragma unroll
            for (int h = 0; h < 2; ++h)
#pragma unroll
                for (int i = 0; i < 2; ++i) gA[h][i] = ngA[h][i]; }
        if constexpr (ALIGN_EPI) { if (wr == 1) PG8_BAR; }
    }
    PG8_WAIT_V(0);
    if constexpr (!ALIGN_EPI) { if (wr == 0) PG8_BAR; }
    PG8_BAR;
    if constexpr (Epi::AFTER_DRAIN) { E.fused(acc, cur, wr, wc, fr, fq, lds, wid, lane); S.done(cur); }
#undef PG8_SA
#undef PG8_SB
#undef PG8_STAGE
#undef PG8_STAGE_A
#undef PG8_LDA
#undef PG8_LDB
#undef PG8_MMA
#undef PG8_WAIT_V
#undef PG8_WAIT_L
#undef PG8_BAR
#undef PG8_SCHED
}
}

#define DI __device__ __forceinline__
#define GAS __attribute__((address_space(1)))
#define LAS __attribute__((address_space(3)))
typedef unsigned short bf16;
typedef unsigned v4u __attribute__((ext_vector_type(4)));
typedef unsigned v2u __attribute__((ext_vector_type(2)));
typedef float f32x4 __attribute__((ext_vector_type(4)));
typedef float f32x16 __attribute__((ext_vector_type(16)));
typedef short bf16x8 __attribute__((ext_vector_type(8)));
typedef __bf16 bf2v __attribute__((ext_vector_type(2)));
typedef float f2v __attribute__((ext_vector_type(2)));
typedef GAS unsigned gu32;

constexpr int NWAVES = 8, NTHREADS = 512;
constexpr int M = 16384, D = 1024, DIN = 2048, NH = 32, HD = 64, NGRP = 4, NST = 128, XBCW = 3072;
constexpr int NPROJ = 9216, WIN_LD = 9248;
constexpr int LCH = 128, NCH = M / LCH;
constexpr int NE = 64, DFF = 512;
constexpr float EPS = 1e-6f;
constexpr float LOG2E = 1.4426950408889634f;

constexpr size_t MiB = 1u << 20;
constexpr size_t WS_CTL = 0, CTL_ZERO_BYTES = 262144;
constexpr size_t WS_WIN = 1 * MiB, WS_WDT = 19 * MiB, WS_WCV = 20 * MiB, WS_WMIX = 22 * MiB, WS_WSSM = 24 * MiB;
constexpr size_t WS_RSTD = 31 * MiB + 524288;
constexpr size_t WS_DT = 28 * MiB, WS_CD = 30 * MiB, WS_WRH = 30 * MiB + 65536, WS_WRL = WS_WRH + 262144, WS_ROUTE = 31 * MiB;
constexpr size_t WS_ST = 32 * MiB, WS_YS = 96 * MiB, WS_TMP = 160 * MiB, WS_MG = 192 * MiB;
constexpr size_t WS_W13 = 32 * MiB, WS_W2 = 160 * MiB, WS_H16 = 96 * MiB;
constexpr size_t WS_XN8 = 32 * MiB, WS_W8IN = 48 * MiB, WS_SA = 60 * MiB, WS_SW = 61 * MiB;
constexpr size_t WS_XN = 224 * MiB;
constexpr size_t WS_U = 256 * MiB, WS_ZS = 288 * MiB, WS_XBC = 352 * MiB, WS_GATE = 448 * MiB;
constexpr size_t WS_LIST = 256 * MiB, WS_HDN = 352 * MiB, WS_YEXP = 400 * MiB;
constexpr size_t WS_END = 512 * MiB;
constexpr int CW_BAR = 4096;
constexpr int CW_CNT = 8192;
constexpr int CW_MODC = 40960;
constexpr int CW_WMAX = 49152;
constexpr int CW_MOD = 16384;

constexpr int RING_BYTES = 131072;
constexpr int LDSCTL_OFF = 147456;
constexpr int TB_OFF = LDSCTL_OFF + 256;
constexpr int CNTL_OFF = TB_OFF + 320;
constexpr int TOKL_OFF = LDSCTL_OFF + 1024;
constexpr int RT_OFF = 148480;
constexpr int LDS_BYTES = 152576;

#define LDS_WAIT() asm volatile("s_waitcnt lgkmcnt(0)" ::: "memory")
#define VM_WAIT() asm volatile("s_waitcnt vmcnt(0)" ::: "memory")

DI unsigned pk2(float lo, float hi) { f2v v = {lo, hi}; return __builtin_bit_cast(unsigned, __builtin_convertvector(v, bf2v)); }
DI unsigned pk4_fp8(float a, float b, float c, float d) {
    a = __builtin_fminf(__builtin_fmaxf(a, -448.f), 448.f); b = __builtin_fminf(__builtin_fmaxf(b, -448.f), 448.f);
    c = __builtin_fminf(__builtin_fmaxf(c, -448.f), 448.f); d = __builtin_fminf(__builtin_fmaxf(d, -448.f), 448.f);
    unsigned w = 0u; w = __builtin_amdgcn_cvt_pk_fp8_f32(a, b, w, false); w = __builtin_amdgcn_cvt_pk_fp8_f32(c, d, w, true); return w; }
DI unsigned pk4_fp8_nc(float a, float b, float c, float d) { unsigned w = 0u; w = __builtin_amdgcn_cvt_pk_fp8_f32(a, b, w, false); w = __builtin_amdgcn_cvt_pk_fp8_f32(c, d, w, true); return w; }
DI unsigned pk4_i8(float a, float b, float c, float d) {
    const int ia = (int)__builtin_rintf(a), ib = (int)__builtin_rintf(b), ic = (int)__builtin_rintf(c), id = (int)__builtin_rintf(d);
    return ((unsigned)ia & 255u) | (((unsigned)ib & 255u) << 8) | (((unsigned)ic & 255u) << 16) | ((unsigned)id << 24); }
DI float bflo(unsigned u) { return __uint_as_float(u << 16); }
DI float bfhi(unsigned u) { return __uint_as_float(u & 0xffff0000u); }
DI float sigmoidf_(float x) { return __builtin_amdgcn_rcpf(1.f + __builtin_amdgcn_exp2f(x * -LOG2E)); }
DI float siluf_(float x) { return x * __builtin_amdgcn_rcpf(1.f + __builtin_amdgcn_exp2f(x * -LOG2E)); }
DI float wave_sum(float v) {
#pragma unroll
    for (int o = 1; o < 64; o <<= 1) v += __shfl_xor(v, o);
    return v;
}
DI f32x4 mod4(const float* modp, int k) { return (*(const f32x4*)(modp + k) + *(const f32x4*)(modp + 6144 + k)) + (*(const f32x4*)(modp + 2 * 6144 + k) + *(const f32x4*)(modp + 3 * 6144 + k)); }
DI int crow(int reg, int hh) { return (reg & 3) + 8 * (reg >> 2) + 4 * hh; }
DI int swz(int row, int chunk) { return chunk ^ ((row ^ (row >> 3)) & 15); }
#define MFMA32(a, b, c) __builtin_amdgcn_mfma_f32_32x32x16_bf16((a), (b), (c), 0, 0, 0)

DI int lane_id() { return (int)__builtin_amdgcn_mbcnt_hi(~0u, __builtin_amdgcn_mbcnt_lo(~0u, 0u)); }
#define XB_TMO      128
#define XB_XCNT(j)  (256  + 64 * (j))
#define XB_XSUB(j)  (1280 + 64 * (j))
#define XB_XGEN(j)  (2304 + 64 * (j))
#define XB_TOP      3328
#define XB_TOPGEN   3392
#define XCD_BAR_WORDS 3456
#define XB_SPIN_CAP (1u << 18)
DI unsigned xb_ld(unsigned* p)              { return __hip_atomic_load(p, __ATOMIC_RELAXED, __HIP_MEMORY_SCOPE_AGENT); }
DI unsigned xb_add(unsigned* p, unsigned v) { return __hip_atomic_fetch_add(p, v, __ATOMIC_RELAXED, __HIP_MEMORY_SCOPE_AGENT); }
DI unsigned xb_xcc_id() { return (unsigned)__builtin_amdgcn_s_getreg((3 << 11) | 20) & 0xFu; }
#define XB_SPIN(cond, bar) do { unsigned _sp = 0; while (cond) { __builtin_amdgcn_s_sleep(1); \
    if ((++_sp & 255u) == 0u) { if (xb_ld(&(bar)[XB_TMO])) break; if (_sp > XB_SPIN_CAP) { atomicAdd(&(bar)[XB_TMO], 1u); break; } } } } while (0)
struct XcdBarrier { unsigned* bar; unsigned x; volatile LAS unsigned* st; int wave; };
DI XcdBarrier xcd_barrier_post(unsigned* bar, volatile LAS unsigned* st) {
    XcdBarrier b; b.bar = bar; b.x = xb_xcc_id(); b.st = st; b.wave = 0;
    if (threadIdx.x == 0) (void)xb_add(&bar[XB_XCNT(b.x)], 1u);
    return b;
}
DI void xcd_barrier_complete(unsigned* bar, unsigned x, unsigned& nloc, unsigned& nx) {
    const unsigned G = gridDim.x * gridDim.y * gridDim.z;
    unsigned sum, cnt, mine, sp = 0u;
    for (;;) {
        sum = 0u; cnt = 0u; mine = 0u;
#pragma unroll
        for (unsigned j = 0; j < 16; ++j) { const unsigned c = xb_ld(&bar[XB_XCNT(j)]); sum += c; cnt += (c > 0u) ? 1u : 0u; mine = (j == x) ? c : mine; }
        if (sum == G) break;
        __builtin_amdgcn_s_sleep(1);
        if ((++sp & 255u) == 0u) { if (xb_ld(&bar[XB_TMO])) break; if (sp > XB_SPIN_CAP) { atomicAdd(&bar[XB_TMO], 1u); break; } }
    }
    nloc = mine > 0u ? mine : 1u; nx = cnt > 0u ? cnt : 1u;
}
DI void xcd_barrier(const XcdBarrier& b) {
    asm volatile("s_waitcnt vmcnt(0)" ::: "memory");
    __syncthreads();
    if (b.wave == 0 && lane_id() == 0) {
        unsigned* bar = b.bar;
        __builtin_amdgcn_s_waitcnt(0);
        unsigned nloc = b.st[0], nx = b.st[1];
        if (nloc == 0u) { xcd_barrier_complete(bar, b.x, nloc, nx); b.st[0] = nloc; b.st[1] = nx; }
        const unsigned old = xb_add(&bar[XB_XSUB(b.x)], 1u);
        const unsigned gen = old / nloc;
        if (old + 1u == (gen + 1u) * nloc) {
            __builtin_amdgcn_fence(__ATOMIC_RELEASE, "agent");
            asm volatile("s_waitcnt vmcnt(0)" ::: "memory");
            const unsigned og = xb_add(&bar[XB_TOP], 1u);
            const unsigned tg = og / nx;
            if (og + 1u == (tg + 1u) * nx) xb_add(&bar[XB_TOPGEN], 1u);
            else XB_SPIN(xb_ld(&bar[XB_TOPGEN]) == tg, bar);
            __builtin_amdgcn_fence(__ATOMIC_ACQUIRE, "agent");
            xb_add(&bar[XB_XGEN(b.x)], 1u);
            asm volatile("s_waitcnt vmcnt(0)" ::: "memory");
        } else {
            XB_SPIN(xb_ld(&bar[XB_XGEN(b.x)]) == gen, bar);
            __builtin_amdgcn_fence(__ATOMIC_ACQUIRE, "agent");
            asm volatile("s_waitcnt vmcnt(0)" ::: "memory");
        }
    }
    __syncthreads();
}

enum { I_X = 0, I_C, I_WADA, I_BADA, I_N1G, I_WIN, I_CVW, I_CVB, I_LNG, I_LNB, I_WCV, I_SCW, I_SCB, I_DTB, I_ALOG, I_DSKIP, I_SNG, I_WSSM, I_WMIX,
       I_N2G, I_WGRP, I_BGRP, I_WER, I_BER, I_W1, I_W3, I_W2, I_FG, N_IN };
struct Args { const float* in[N_IN]; float* out; unsigned char* ws; int ph_lo, ph_hi; };

template <int I> DI const float* argp() {
    auto kp = __builtin_amdgcn_kernarg_segment_ptr();
    unsigned long long v;
    asm volatile("s_load_dwordx2 %0, %1, %2\n\ts_waitcnt lgkmcnt(0)" : "=s"(v) : "s"(kp), "i"(I * 8));
    return (const float*)(const GAS float*)v;
}
#define ARG(i) argp<i>()
struct Ctx {
    LAS unsigned char* lds;
    int wave, vcu, G, xcd, xj;
    unsigned char* ws;
};

DI int xcd_unit(int x, int j, int gx, int i, int N) { const int u = i * gx + j; return (u < (N >> 3)) ? x * (N >> 3) + u : -1; }
DI int inproj_tile(int p) { return p < 8 ? p + 8 : (p < 16 ? p + 20 : (p < 24 ? p - 16 : p - 8)); }
DI int win_col(int npp) { const int np = inproj_tile(npp >> 8) * 256 + (npp & 255);
    if (np < 2048) { const int q = np >> 3, rr = np & 7; return (rr >> 2) * 1024 + 4 * q + (rr & 3); } return np < 7168 ? np : np + 32; }
struct EpiInProj {
    static constexpr bool PERM = true, AFTER_DRAIN = false, KHOOK = false; static constexpr int NPF = 0;
    unsigned char* ws;
    DI static pg8::f32x4 cvt(const pg8::f32x4& a, float sr, const f32x4& sc) { const pg8::v4i_ q = __builtin_bit_cast(pg8::v4i_, a);
        return (pg8::f32x4){(float)q[0] * (sr * sc.x), (float)q[1] * (sr * sc.y), (float)q[2] * (sr * sc.z), (float)q[3] * (sr * sc.w)}; }
    DI void operator()(const pg8::f32x4 (&acc)[2][2][4][2], const pg8::Unit& u, int wr, int wc, int fr, int fq) const {
        const int pn = inproj_tile(u.pn), row0 = u.pm * 256 + wr * 64 + fr;
        const float* SA = (const float*)(ws + WS_SA); const float* SW = (const float*)(ws + WS_SW) + u.pn * 256 + wc * 32 + fq * 8;
        f32x4 sc[2][2];
#pragma unroll
        for (int bj = 0; bj < 2; ++bj) { sc[bj][0] = *(const f32x4*)(SW + bj * 128); sc[bj][1] = *(const f32x4*)(SW + bj * 128 + 4); }
        float sr[2][4];
#pragma unroll
        for (int ai = 0; ai < 2; ++ai)
#pragma unroll
            for (int m = 0; m < 4; ++m) sr[ai][m] = SA[row0 + ai * 128 + m * 16];
        if (pn < 8) {
            bf16* U = (bf16*)(ws + WS_U);
#pragma unroll
            for (int ai = 0; ai < 2; ++ai)
#pragma unroll
                for (int m = 0; m < 4; ++m) {
                    bf16* rowp = U + (size_t)(row0 + ai * 128 + m * 16) * D + pn * 128 + wc * 16 + fq * 4;
#pragma unroll
                    for (int bj = 0; bj < 2; ++bj) { const pg8::f32x4 a = cvt(acc[ai][bj][m][0], sr[ai][m], sc[bj][0]), b = cvt(acc[ai][bj][m][1], sr[ai][m], sc[bj][1]);
                        v2u w; w.x = pk2(a[0] * sigmoidf_(b[0]), a[1] * sigmoidf_(b[1])); w.y = pk2(a[2] * sigmoidf_(b[2]), a[3] * sigmoidf_(b[3]));
                        *(v2u*)(rowp + bj * 64) = w; } }
        } else {
            const bool isz = pn < 16, isx = (pn >= 16) && (pn < 28);
            const size_t boff = isz ? WS_ZS : (isx ? WS_XBC : WS_GATE);
            const int ldc = isx ? XBCW : DIN;
            const int colt = (pn - (isz ? 8 : (isx ? 16 : 28))) * 256;
            bf16* base = (bf16*)(ws + boff);
            const int col0 = colt + wc * 32 + fq * 8;
#pragma unroll
            for (int ai = 0; ai < 2; ++ai)
#pragma unroll
                for (int m = 0; m < 4; ++m) {
                    bf16* rowp = base + (size_t)(row0 + ai * 128 + m * 16) * ldc + col0;
#pragma unroll
                    for (int bj = 0; bj < 2; ++bj) { pg8::f32x4 v0 = cvt(acc[ai][bj][m][0], sr[ai][m], sc[bj][0]), v1 = cvt(acc[ai][bj][m][1], sr[ai][m], sc[bj][1]);
                        if (isz) {
#pragma unroll
                            for (int i = 0; i < 4; ++i) { v0[i] = v0[i] * sigmoidf_(v0[i]); v1[i] = v1[i] * sigmoidf_(v1[i]); }
                        }
                        v4u w; w.x = pk2(v0[0], v0[1]); w.y = pk2(v0[2], v0[3]); w.z = pk2(v1[0], v1[1]); w.w = pk2(v1[2], v1[3]);
                        *(v4u*)(rowp + bj * 128) = w; } }
        }
    }
};
template <bool NORM> struct EpiGate {
    static constexpr bool PERM = true, AFTER_DRAIN = false, KHOOK = NORM;
    bf16* O; const bf16* P; const bf16* GATE; int gcol; const LAS float* rt;
    DI void khook(pg8::f32x4 (&acc)[2][2][4][2], int b, int wr, int fr) const {
#pragma unroll
        for (int ai = 0; ai < 2; ++ai)
#pragma unroll
            for (int m = 0; m < 4; ++m) { const float f = rt[(ai * 128 + wr * 64 + m * 16 + fr) * 4 + b];
#pragma unroll
                for (int bj = 0; bj < 2; ++bj)
#pragma unroll
                    for (int n = 0; n < 2; ++n) acc[ai][bj][m][n] = acc[ai][bj][m][n] * f; }
    }
    DI void operator()(const pg8::f32x4 (&acc)[2][2][4][2], const pg8::Unit& u, int wr, int wc, int fr, int fq) const {
        const int row0 = u.pm * 256 + wr * 64 + fr, col0 = u.pn * 256 + wc * 32 + fq * 8;
        v4u g[4], p[4], wA[4], wB[4];
        auto loadq = [&](int bj, int ai) {
#pragma unroll
            for (int m = 0; m < 4; ++m) { const size_t r = (size_t)(row0 + ai * 128 + m * 16); const int c = col0 + bj * 128;
                g[m] = *(const v4u*)(GATE + r * (2 * D) + gcol + c); if (NORM) p[m] = *(const v4u*)(P + r * D + c); }
        };
        auto calcq = [&](int bj, int ai, v4u (&w)[4]) {
#pragma unroll
            for (int m = 0; m < 4; ++m) {
                float f = 1.0f; if (NORM) f = rt[(ai * 128 + wr * 64 + m * 16 + fr) * 4 + 3];
                const v4u gg = g[m];
                pg8::f32x4 v0 = acc[ai][bj][m][0] * f, v1 = acc[ai][bj][m][1] * f;
                float o[8] = {v0[0] * sigmoidf_(bflo(gg.x)), v0[1] * sigmoidf_(bfhi(gg.x)), v0[2] * sigmoidf_(bflo(gg.y)), v0[3] * sigmoidf_(bfhi(gg.y)), v1[0] * sigmoidf_(bflo(gg.z)), v1[1] * sigmoidf_(bfhi(gg.z)), v1[2] * sigmoidf_(bflo(gg.w)), v1[3] * sigmoidf_(bfhi(gg.w))};
                if (NORM) { const v4u pp = p[m];
                    o[0] += bflo(pp.x); o[1] += bfhi(pp.x); o[2] += bflo(pp.y); o[3] += bfhi(pp.y); o[4] += bflo(pp.z); o[5] += bfhi(pp.z); o[6] += bflo(pp.w); o[7] += bfhi(pp.w); }
                w[m].x = pk2(o[0], o[1]); w[m].y = pk2(o[2], o[3]); w[m].z = pk2(o[4], o[5]); w[m].w = pk2(o[6], o[7]); }
        };
        auto storeq = [&](int bj, int ai, const v4u (&w)[4]) {
#pragma unroll
            for (int m = 0; m < 4; ++m) *(v4u*)(O + (size_t)(row0 + ai * 128 + m * 16) * D + col0 + bj * 128) = w[m];
        };
        loadq(0, 0); calcq(0, 0, wA); loadq(0, 1); storeq(0, 0, wA); calcq(0, 1, wB); loadq(1, 0); storeq(0, 1, wB); calcq(1, 0, wA); loadq(1, 1); storeq(1, 0, wA); calcq(1, 1, wB); storeq(1, 1, wB);
    }
};
struct EpiMix {
    static constexpr bool PERM = true, AFTER_DRAIN = false, KHOOK = false;
    bf16* H; const float* X; const float* g1;
    DI void operator()(const pg8::f32x4 (&acc)[2][2][4][2], const pg8::Unit& u, int wr, int wc, int fr, int fq) const {
        const int row0 = u.pm * 256 + wr * 64 + fr, col0 = u.pn * 256 + wc * 32 + fq * 8;
        f32x4 xa[4], xb[4]; v4u wA[4], wB[4];
        auto loadq = [&](int bj, int ai) {
#pragma unroll
            for (int m = 0; m < 4; ++m) { const size_t off = (size_t)(row0 + ai * 128 + m * 16) * D + col0 + bj * 128;
                xa[m] = __builtin_nontemporal_load((const f32x4*)(X + off)); xb[m] = __builtin_nontemporal_load((const f32x4*)(X + off + 4)); }
        };
        auto calcq = [&](int bj, int ai, v4u (&w)[4]) { const int c = col0 + bj * 128;
            const f32x4 ga = *(const f32x4*)(g1 + c), gb = *(const f32x4*)(g1 + c + 4);
#pragma unroll
            for (int m = 0; m < 4; ++m) { const f32x4 ha = xa[m] + ga * acc[ai][bj][m][0], hb = xb[m] + gb * acc[ai][bj][m][1];
                w[m].x = pk2(ha.x, ha.y); w[m].y = pk2(ha.z, ha.w); w[m].z = pk2(hb.x, hb.y); w[m].w = pk2(hb.z, hb.w); }
        };
        auto storeq = [&](int bj, int ai, const v4u (&w)[4]) {
#pragma unroll
            for (int m = 0; m < 4; ++m) *(v4u*)(H + (size_t)(row0 + ai * 128 + m * 16) * D + col0 + bj * 128) = w[m];
        };
        loadq(0, 0); calcq(0, 0, wA); loadq(0, 1); storeq(0, 0, wA); calcq(0, 1, wB); loadq(1, 0); storeq(0, 1, wB); calcq(1, 0, wA); loadq(1, 1); storeq(1, 0, wA); calcq(1, 1, wB); storeq(1, 1, wB);
    }
};
struct EpiUp {
    static constexpr bool PERM = true, AFTER_DRAIN = false, KHOOK = false;
    unsigned char* HDN;
    DI void operator()(const pg8::f32x4 (&acc)[2][2][4][2], const pg8::Unit& u, int wr, int wc, int fr, int fq) const {
        const int j = u.pn & 3, row0 = u.pm * 256 + wr * 64 + fr, col0 = j * 128 + wc * 16 + fq * 4;
#pragma unroll
        for (int ai = 0; ai < 2; ++ai)
#pragma unroll
            for (int m = 0; m < 4; ++m) { unsigned char* rowp = HDN + (size_t)(row0 + ai * 128 + m * 16) * DFF + col0;
#pragma unroll
                for (int bj = 0; bj < 2; ++bj) { const pg8::f32x4 a = acc[ai][bj][m][0], b = acc[ai][bj][m][1];
                    *(unsigned*)(rowp + bj * 64) = pk4_fp8(siluf_(a[0]) * b[0], siluf_(a[1]) * b[1], siluf_(a[2]) * b[2], siluf_(a[3]) * b[3]); } }
    }
};
struct EpiDown {
    static constexpr bool PERM = true, AFTER_DRAIN = false, KHOOK = false;
    unsigned char* Y;
    DI void operator()(const pg8::f32x4 (&acc)[2][2][4][2], const pg8::Unit& u, int wr, int wc, int fr, int fq) const {
        const int j = u.pn & 3, row0 = u.pm * 256 + wr * 64 + fr, col0 = j * 256 + wc * 32 + fq * 8;
#pragma unroll
        for (int ai = 0; ai < 2; ++ai)
#pragma unroll
            for (int m = 0; m < 4; ++m) { unsigned char* rowp = Y + (size_t)(row0 + ai * 128 + m * 16) * D + col0;
#pragma unroll
                for (int bj = 0; bj < 2; ++bj) { const pg8::f32x4 v0 = acc[ai][bj][m][0] * 16.0f, v1 = acc[ai][bj][m][1] * 16.0f;
                    v2u w; w.x = pk4_fp8(v0[0], v0[1], v0[2], v0[3]); w.y = pk4_fp8(v1[0], v1[1], v1[2], v1[3]);
                    *(v2u*)(rowp + bj * 128) = w; } }
    }
};
struct MoeOrder {
    const LAS int* tb; int G, c, total, reps; const LAS int* tokl;
    DI bool next(int i0, pg8::Unit& u) const {
        const int n = (total - c + G - 1) / G; if (n <= 0 || i0 >= n * reps) return false;
        const int i = i0 % n; const int uu = i * G + c;
        const int T = uu >> 2; int e = 0;
        while (e < NE - 1 && tb[e + 1] <= T) ++e;
        u.pm = T; u.pn = 4 * e + (uu & 3); return true;
    }
    DI void a_ready(const pg8::Unit&) const {}
    DI void done(const pg8::Unit&) const {}
};

struct OneUnit { pg8::Unit u;
    DI bool next(int i, pg8::Unit& o) const { if (i != 0) return false; o = u; return true; }
    DI void a_ready(const pg8::Unit&) const {}
    DI void done(const pg8::Unit&) const {} };

template <class SrcF>
DI void transpose_item(SrcF src, int K, bf16* WT, LAS float* scr, int kb, int n0, int lane) {
    const int k0 = 64 * kb;
#pragma unroll 8
    for (int i = 0; i < 32; ++i) { const int kk = 2 * i + (lane >> 5); scr[kk * 33 + (lane & 31)] = src(k0 + kk, n0 + (lane & 31)); }
    LDS_WAIT(); asm volatile("" ::: "memory");
    const int c = lane & 7;
#pragma unroll
    for (int j = 0; j < 4; ++j) { const int n = (lane >> 3) + 8 * j; const LAS float* s = scr + (8 * c) * 33 + n;
        v4u o; o.x = pk2(s[0 * 33], s[1 * 33]); o.y = pk2(s[2 * 33], s[3 * 33]); o.z = pk2(s[4 * 33], s[5 * 33]); o.w = pk2(s[6 * 33], s[7 * 33]);
        *(v4u*)(WT + (size_t)(n0 + n) * K + k0 + 8 * c) = o; }
    LDS_WAIT(); asm volatile("" ::: "memory");
}

template <class SrcF>
DI void transpose_item8(SrcF src, int K, unsigned char* WT, LAS float* scr, int kb, int n0, int lane) {
    const int k0 = 64 * kb;
#pragma unroll 8
    for (int i = 0; i < 32; ++i) { const int kk = 2 * i + (lane >> 5); scr[kk * 33 + (lane & 31)] = src(k0 + kk, n0 + (lane & 31)) * 64.0f; }
    LDS_WAIT(); asm volatile("" ::: "memory");
#pragma unroll
    for (int i = 0; i < 2; ++i) { const int p = lane + 64 * i, n = p >> 2, c = p & 3; const LAS float* s = scr + (16 * c) * 33 + n;
        v4u o; o.x = pk4_fp8(s[0 * 33], s[1 * 33], s[2 * 33], s[3 * 33]); o.y = pk4_fp8(s[4 * 33], s[5 * 33], s[6 * 33], s[7 * 33]);
        o.z = pk4_fp8(s[8 * 33], s[9 * 33], s[10 * 33], s[11 * 33]); o.w = pk4_fp8(s[12 * 33], s[13 * 33], s[14 * 33], s[15 * 33]);
        *(v4u*)(WT + (size_t)(n0 + n) * K + k0 + 16 * c) = o; }
    LDS_WAIT(); asm volatile("" ::: "memory");
}

template <class SrcF>
DI void transpose_item_i8(SrcF src, float inv, int K, unsigned char* WT, LAS float* scr, int kb, int n0, int lane) {
    const int k0 = 64 * kb;
#pragma unroll 8
    for (int i = 0; i < 32; ++i) { const int kk = 2 * i + (lane >> 5); scr[kk * 33 + (lane & 31)] = src(k0 + kk, n0 + (lane & 31)) * inv; }
    LDS_WAIT(); asm volatile("" ::: "memory");
#pragma unroll
    for (int i = 0; i < 2; ++i) { const int p = lane + 64 * i, n = p >> 2, c = p & 3; const LAS float* s = scr + (16 * c) * 33 + n;
        v4u o; o.x = pk4_i8(s[0 * 33], s[1 * 33], s[2 * 33], s[3 * 33]); o.y = pk4_i8(s[4 * 33], s[5 * 33], s[6 * 33], s[7 * 33]);
        o.z = pk4_i8(s[8 * 33], s[9 * 33], s[10 * 33], s[11 * 33]); o.w = pk4_i8(s[12 * 33], s[13 * 33], s[14 * 33], s[15 * 33]);
        *(v4u*)(WT + (size_t)(n0 + n) * K + k0 + 16 * c) = o; }
    LDS_WAIT(); asm volatile("" ::: "memory");
}

DI void ph0_prologue(const Ctx& F, const Args& a, int reps) {
    const int gw = F.vcu * NWAVES + F.wave, NGW = F.G * NWAVES, lane = lane_id();
    float* mod = (float*)(F.ws + WS_CTL) + CW_MOD;
    {
        const float* cvec = ARG(I_C); const float* wada = ARG(I_WADA); const float* bada = ARG(I_BADA);
        const int r8 = lane >> 3, c4 = lane & 7;
        for (int item0 = gw; item0 < 768 * reps; item0 += NGW) {
            const int item = item0 % 768; const int cc = item % 192, kq = item / 192;
            f32x4 acc = {0.f, 0.f, 0.f, 0.f};
#pragma unroll 8
            for (int i = 0; i < 32; ++i) { const int k = kq * 256 + i * 8 + r8; const float cv = cvec[k]; const float s = siluf_(cv);
                const f32x4 w = *(const f32x4*)(wada + (size_t)k * (6 * D) + cc * 32 + c4 * 4); acc += s * w; }
#pragma unroll
            for (int j = 0; j < 4; ++j) { float v = acc[j]; v += __shfl_xor(v, 8); v += __shfl_xor(v, 16); v += __shfl_xor(v, 32); acc[j] = v; }
            if (lane < 8) {
#pragma unroll
                for (int j = 0; j < 4; ++j) { float v = acc[j]; if (kq == 0) v += bada[cc * 32 + c4 * 4 + j]; mod[kq * 6144 + cc * 32 + c4 * 4 + j] = v; }
            }
        }
    }
    LAS float* scr = (LAS float*)(F.lds + F.wave * 16384);
    const float* win = ARG(I_WIN); const float* wcv = ARG(I_WCV); const float* wmix = ARG(I_WMIX); const float* wssm = ARG(I_WSSM);
    bf16* Win_t = (bf16*)(F.ws + WS_WIN); bf16* Wdt_t = (bf16*)(F.ws + WS_WDT); bf16* Wcv_t = (bf16*)(F.ws + WS_WCV);
    bf16* Wmix_t = (bf16*)(F.ws + WS_WMIX); bf16* Wssm_t = (bf16*)(F.ws + WS_WSSM);
    constexpr int I_IN = 16 * 288, I_DT = 16, I_CV = 16 * 32, I_MX = 16 * 32, I_SS = 32 * 32, I_RT = 16 * 3 * 2;
    constexpr int NITEMS = I_IN + I_DT + I_CV + I_MX + I_SS + I_RT;
    const float* wer = ARG(I_WER); const float* wgrp = ARG(I_WGRP); const float* sng0 = ARG(I_SNG);
    for (int it0 = gw; it0 < NITEMS * reps; it0 += NGW) {
        int r = it0 % NITEMS;
        if (r < I_IN) { const int kb = r / 288, nb = r % 288;
            const int npp = nb * 32 + (lane & 31), col = win_col(npp);
            float mx = 0.f;
#pragma unroll 8
            for (int i = 0; i < 32; ++i) mx = __builtin_fmaxf(mx, __builtin_fabsf(win[(size_t)(64 * kb + 2 * i + (lane >> 5)) * WIN_LD + col]));
            mx = __builtin_fmaxf(mx, __shfl_xor(mx, 32));
            if (lane < 32) atomicMax((unsigned*)(F.ws + WS_CTL) + CW_WMAX + npp, __float_as_uint(mx));
            continue; } r -= I_IN;
        if (r < I_DT) { transpose_item([&](int k, int np) -> float { return win[(size_t)k * WIN_LD + 7168 + np]; }, D, Wdt_t, scr, r, 0, lane); continue; } r -= I_DT;
        if (r < I_CV) { transpose_item([&](int k, int np) -> float { return wcv[(size_t)k * D + np]; }, D, Wcv_t, scr, r / 32, (r % 32) * 32, lane); continue; } r -= I_CV;
        if (r < I_MX) { transpose_item([&](int k, int np) -> float { return wmix[(size_t)k * D + np]; }, D, Wmix_t, scr, r / 32, (r % 32) * 32, lane); continue; } r -= I_MX;
        if (r < I_SS) { transpose_item8([&](int k, int np) -> float { return wssm[(size_t)k * D + np] * sng0[k]; }, DIN, (unsigned char*)Wssm_t, scr, r / 32, (r % 32) * 32, lane); continue; } r -= I_SS;
        {
            const int lo = r / 48, rr = r % 48, kb = rr / 3, nb = rr % 3;
            auto wsrc = [&](int k, int np) -> float { float w = 0.f; if (np < 64) w = wer[(size_t)k * NE + np]; else if (np < 72) w = wgrp[(size_t)k * 8 + (np - 64)];
                const float hi = bflo(pk2(w, 0.f)); return lo ? (w - hi) : hi; };
            transpose_item(wsrc, D, (bf16*)(F.ws + (lo ? WS_WRL : WS_WRH)), scr, kb, nb * 32, lane);
        }
    }
}

DI void convert_experts(const Ctx& F, const Args& a) {
    const int gw = F.vcu * NWAVES + F.wave, NGW = F.G * NWAVES, lane = lane_id();
    LAS float* scr = (LAS float*)(F.lds + F.wave * 17408);
    const float* w1 = ARG(I_W1); const float* w3 = ARG(I_W3); const float* w2 = ARG(I_W2);
    unsigned char* W13_t = F.ws + WS_W13; unsigned char* W2_t = F.ws + WS_W2;
    constexpr int I_13 = NE * 4 * 16, I_2 = NE * 2 * 16, NIT = I_13 + I_2;
    const int ch = lane & 15, kq = lane >> 4;
    for (int it = gw; it < NIT; it += NGW) {
        const float* src; size_t ld; unsigned char* dst;
        if (it < I_13) { const int e = it >> 6, r = it & 63, kb = r >> 4, cb = r & 15;
            src = ((ch & 1) ? w3 : w1) + (size_t)e * D * DFF + (size_t)(256 * kb + kq) * DFF + 32 * cb + 4 * (ch >> 1); ld = DFF;
            dst = W13_t + (size_t)e * D * D + (size_t)(64 * cb + lane) * D + 256 * kb;
        } else { const int r0 = it - I_13, e = r0 >> 5, r = r0 & 31, kb = r >> 4, nb = r & 15;
            src = w2 + (size_t)e * DFF * D + (size_t)(256 * kb + kq) * D + 64 * nb + 4 * ch; ld = D;
            dst = W2_t + (size_t)e * D * DFF + (size_t)(64 * nb + lane) * DFF + 256 * kb;
        }
        f32x4 va[16], vb[16]; v4u o[16];
#pragma unroll
        for (int i = 0; i < 16; ++i) va[i] = __builtin_nontemporal_load((const f32x4*)(src + (size_t)(4 * i) * ld));
#pragma unroll
        for (int sub = 0; sub < 4; ++sub) {
            f32x4 (&cur)[16] = (sub & 1) ? vb : va; f32x4 (&nxt)[16] = (sub & 1) ? va : vb;
            if (sub < 3) {
#pragma unroll
                for (int i = 0; i < 16; ++i) nxt[i] = __builtin_nontemporal_load((const f32x4*)(src + (size_t)(64 * (sub + 1) + 4 * i) * ld));
            }
#pragma unroll
            for (int i = 0; i < 16; ++i) *(LAS f32x4*)(scr + (4 * i + kq) * 68 + 4 * ch) = cur[i] * 64.0f;
            LDS_WAIT(); asm volatile("" ::: "memory");
#pragma unroll
            for (int j = 0; j < 4; ++j) {
                unsigned w[4];
#pragma unroll
                for (int q = 0; q < 4; ++q) { const LAS float* sp = scr + (16 * j + 4 * q) * 68 + lane; w[q] = pk4_fp8(sp[0], sp[68], sp[136], sp[204]); }
                o[4 * sub + j].x = w[0]; o[4 * sub + j].y = w[1]; o[4 * sub + j].z = w[2]; o[4 * sub + j].w = w[3];
            }
            LDS_WAIT(); asm volatile("" ::: "memory");
        }
#pragma unroll
        for (int j = 0; j < 16; ++j) *(v4u*)(dst + 16 * j) = o[j];
    }
}

DI void ph1_norm_dt(const Ctx& F, const Args& a) {
    const float* mod = (const float*)(F.ws + WS_CTL) + CW_MOD;
    const float* x = ARG(I_X); const float* n1g = ARG(I_N1G); const float* dtb = ARG(I_DTB);
    bf16* XN = (bf16*)(F.ws + WS_XN); const bf16* Wdt_t = (const bf16*)(F.ws + WS_WDT); float* DT = (float*)(F.ws + WS_DT);
    const int lane = lane_id(), wave = F.wave;
    f32x4 gm[4], ga[4];
#pragma unroll
    for (int j = 0; j < 4; ++j) { const int k = 256 * j + 4 * lane; const f32x4 g = *(const f32x4*)(n1g + k), sc = mod4(mod, 1024 + k);
        gm[j] = g * (sc + 1.0f); ga[j] = mod4(mod, k); }
    if (F.vcu == 0) { float* modc = (float*)(F.ws + WS_CTL) + CW_MODC; for (int k = (F.wave * 64 + lane_id()) * 4; k < 6 * D; k += NTHREADS * 4) *(f32x4*)(modc + k) = mod4(mod, k); }
    for (int unit = F.vcu; unit < M / 64; unit += F.G) {
        const int row0 = unit * 64;
#pragma unroll 1
        for (int rh = 0; rh < 2; ++rh) {
            f32x4 v[4][4];
#pragma unroll
            for (int rr = 0; rr < 4; ++rr)
#pragma unroll
                for (int j = 0; j < 4; ++j) v[rr][j] = __builtin_nontemporal_load((const f32x4*)(x + (size_t)(row0 + wave * 8 + rh * 4 + rr) * D + 256 * j + 4 * lane));
#pragma unroll
            for (int rr = 0; rr < 4; ++rr) {
                const int rl = wave * 8 + rh * 4 + rr, row = row0 + rl; float ss = 0.f;
#pragma unroll
                for (int j = 0; j < 4; ++j) ss += (v[rr][j].x * v[rr][j].x + v[rr][j].y * v[rr][j].y) + (v[rr][j].z * v[rr][j].z + v[rr][j].w * v[rr][j].w);
                const float rstd = 1.0f / sqrtf(wave_sum(ss) * (1.0f / D) + EPS);
                float am = 0.f;
#pragma unroll
                for (int j = 0; j < 4; ++j) { const f32x4 n = v[rr][j] * rstd * gm[j] + ga[j]; v[rr][j] = n;
                    am = __builtin_fmaxf(__builtin_fmaxf(am, __builtin_fmaxf(__builtin_fabsf(n.x), __builtin_fabsf(n.y))), __builtin_fmaxf(__builtin_fabsf(n.z), __builtin_fabsf(n.w)));
                    v2u w; w.x = pk2(n.x, n.y); w.y = pk2(n.z, n.w);
                    const int chunk = (32 * j + (lane >> 1)) ^ (rl & 15);
                    *(LAS v2u*)(F.lds + rl * 2048 + chunk * 16 + 8 * (lane & 1)) = w; }
#pragma unroll
                for (int o = 1; o < 64; o <<= 1) am = __builtin_fmaxf(am, __shfl_xor(am, o));
                const float inv = am > 0.f ? 127.0f / am : 0.f;
#pragma unroll
                for (int j = 0; j < 4; ++j) *(unsigned*)(F.ws + WS_XN8 + (size_t)row * D + 256 * j + 4 * lane) = pk4_i8(v[rr][j].x * inv, v[rr][j].y * inv, v[rr][j].z * inv, v[rr][j].w * inv);
                if (lane == 0) ((float*)(F.ws + WS_SA))[row] = am * (1.0f / 127.0f);
            }
        }
        __syncthreads();
        {
            const int rt = wave & 3, ct = wave >> 2, fr = lane & 15, fq = lane >> 4;
            pg8::f32x4 acc = {0.f, 0.f, 0.f, 0.f};
            const bf16* wrow = Wdt_t + (size_t)(16 * ct + fr) * D + 8 * fq;
#pragma unroll 4
            for (int ks = 0; ks < 32; ++ks) {
                const bf16x8 av = *(const LAS bf16x8*)(F.lds + (16 * rt + fr) * 2048 + (((4 * ks + fq) ^ fr) * 16));
                const bf16x8 bv = *(const bf16x8*)(wrow + 32 * ks);
                acc = __builtin_amdgcn_mfma_f32_16x16x32_bf16(av, bv, acc, 0, 0, 0);
            }
            const float bias = dtb[16 * ct + fr];
#pragma unroll
            for (int r = 0; r < 4; ++r) { const float v = acc[r] + bias; const float sp = v > 20.f ? v : log1pf(__expf(v));
                DT[(size_t)(row0 + 16 * rt + 4 * fq + r) * NH + 16 * ct + fr] = sp; }
        }
        __syncthreads();
    }
    {
        const float* win = ARG(I_WIN); const unsigned* wmax = (const unsigned*)(F.ws + WS_CTL) + CW_WMAX;
        const int gw = F.vcu * NWAVES + F.wave, NGW = F.G * NWAVES;
        LAS float* scr = (LAS float*)(F.lds + F.wave * 16384);
        for (int r = gw; r < 16 * 288; r += NGW) { const int kb = r / 288, nb = r % 288;
            const int npp = nb * 32 + (lane & 31), col = win_col(npp);
            const float mx = __uint_as_float(wmax[npp]); const float inv = mx > 0.f ? 127.0f / mx : 0.f;
            if (kb == 0 && lane < 32) ((float*)(F.ws + WS_SW))[npp] = mx * (1.0f / 127.0f);
            transpose_item_i8([&](int k, int) -> float { return win[(size_t)k * WIN_LD + col]; }, inv, D, F.ws + WS_W8IN, scr, kb, nb * 32, lane);
        }
    }
}

DI void ph3_convbranch(const Ctx& F, const Args& a, int reps) {
    const bf16* U = (const bf16*)(F.ws + WS_U); bf16* UC = (bf16*)(F.ws + WS_XN);
    const float* cw = ARG(I_CVW); const float* cb = ARG(I_CVB); const float* lg = ARG(I_LNG); const float* lb = ARG(I_LNB);
    const int tid = F.wave * 64 + lane_id(), lane = lane_id(), wave = F.wave;
    LAS unsigned char* tile = F.lds;
    LAS float* red = (LAS float*)(F.lds + 62 * 2048);
    LAS float* stat = red + 32 * 8 * 2;
    f2v w[31];
#pragma unroll
    for (int j = 0; j < 31; ++j) w[j] = *(const f2v*)(cw + j * D + 2 * tid);
    const f2v bias = *(const f2v*)(cb + 2 * tid), gam = *(const f2v*)(lg + 2 * tid), bet = *(const f2v*)(lb + 2 * tid);
    const int RU = (M / 32 + F.G - 1) / F.G;
    for (int it = 0; it < RU * reps; ++it) {
        const int unit = xcd_unit(F.xcd, F.xj, F.G >> 3, (it >= RU ? it - RU : it), M / 32); if (unit < 0) break; const int t0 = unit * 32;
        {
            v4u v[16];
#pragma unroll
            for (int i = 0; i < 16; ++i) { const int piece = tid + i * NTHREADS, r = piece >> 7, cch = piece & 127, t = t0 - 30 + r;
                v[i] = (v4u){0u, 0u, 0u, 0u}; if (piece < 62 * 128 && t >= 0) v[i] = *(const v4u*)(U + (size_t)t * D + cch * 8); }
#pragma unroll
            for (int i = 0; i < 16; ++i) { const int piece = tid + i * NTHREADS, r = piece >> 7, cch = piece & 127;
                if (piece < 62 * 128) *(LAS v4u*)(tile + r * 2048 + cch * 16) = v[i]; }
        }
        __syncthreads();
        f2v o[32];
#pragma unroll
        for (int tg = 0; tg < 8; ++tg) {
            f2v acc[4];
#pragma unroll
            for (int i = 0; i < 4; ++i) acc[i] = bias;
#pragma unroll
            for (int j = 0; j < 34; ++j) {
                const unsigned uu = *(const LAS unsigned*)(tile + (4 * tg + j) * 2048 + tid * 4);
                const f2v u2 = {bflo(uu), bfhi(uu)};
#pragma unroll
                for (int i = 0; i < 4; ++i) { const int jj = j - i; if (jj >= 0 && jj <= 30) acc[i] = __builtin_elementwise_fma(w[jj], u2, acc[i]); }
            }
#pragma unroll
            for (int i = 0; i < 4; ++i) o[4 * tg + i] = acc[i];
        }
        {
            float r5[64];
#pragma unroll
            for (int tk = 0; tk < 32; ++tk) { r5[2 * tk] = o[tk].x + o[tk].y; r5[2 * tk + 1] = o[tk].x * o[tk].x + o[tk].y * o[tk].y; }
            float r4[32], r3[16], r2[8], r1[4], r0[2];
            { const bool up = (lane & 32) != 0;
#pragma unroll
              for (int i = 0; i < 32; ++i) { const float keep = up ? r5[i + 32] : r5[i], send = up ? r5[i] : r5[i + 32]; r4[i] = keep + __shfl_xor(send, 32); } }
            { const bool up = (lane & 16) != 0;
#pragma unroll
              for (int i = 0; i < 16; ++i) { const float keep = up ? r4[i + 16] : r4[i], send = up ? r4[i] : r4[i + 16]; r3[i] = keep + __shfl_xor(send, 16); } }
            { const bool up = (lane & 8) != 0;
#pragma unroll
              for (int i = 0; i < 8; ++i) { const float keep = up ? r3[i + 8] : r3[i], send = up ? r3[i] : r3[i + 8]; r2[i] = keep + __shfl_xor(send, 8); } }
            { const bool up = (lane & 4) != 0;
#pragma unroll
              for (int i = 0; i < 4; ++i) { const float keep = up ? r2[i + 4] : r2[i], send = up ? r2[i] : r2[i + 4]; r1[i] = keep + __shfl_xor(send, 4); } }
            { const bool up = (lane & 2) != 0;
#pragma unroll
              for (int i = 0; i < 2; ++i) { const float keep = up ? r1[i + 2] : r1[i], send = up ? r1[i] : r1[i + 2]; r0[i] = keep + __shfl_xor(send, 2); } }
            const bool up0 = (lane & 1) != 0;
            const float tot = (up0 ? r0[1] : r0[0]) + __shfl_xor(up0 ? r0[0] : r0[1], 1);
            red[((lane >> 1) * 8 + wave) * 2 + (lane & 1)] = tot;
        }
        __syncthreads();
        if (tid < 32) { float s = 0.f, q = 0.f;
#pragma unroll
            for (int wv = 0; wv < 8; ++wv) { s += red[(tid * 8 + wv) * 2]; q += red[(tid * 8 + wv) * 2 + 1]; }
            const float mean = s * (1.0f / D); const float var = fmaxf(q * (1.0f / D) - mean * mean, 0.f);
            stat[tid * 2] = mean; stat[tid * 2 + 1] = 1.0f / sqrtf(var + EPS); }
        __syncthreads();
#pragma unroll
        for (int tk = 0; tk < 32; ++tk) { const float mean = stat[tk * 2], rstd = stat[tk * 2 + 1];
            const float y0 = (o[tk].x - mean) * rstd * gam.x + bet.x, y1 = (o[tk].y - mean) * rstd * gam.y + bet.y;
            *(unsigned*)(UC + (size_t)(t0 + tk) * D + 2 * tid) = pk2(siluf_(y0), siluf_(y1)); }
        __syncthreads();
    }
}

DI void conv_block(const bf16* XBC, const float* cw, const float* cb, int t_first, int col, float (&o)[8][8]) {
    v4u raw[11];
#pragma unroll
    for (int r = 0; r < 11; ++r) { const int t = t_first - 3 + r; const int tc = t < 0 ? 0 : t; v4u v = *(const v4u*)(XBC + (size_t)tc * XBCW + col);
        const unsigned msk = t < 0 ? 0u : 0xffffffffu; v.x &= msk; v.y &= msk; v.z &= msk; v.w &= msk; raw[r] = v; }
    float w[4][8], b[8];
#pragma unroll
    for (int j = 0; j < 4; ++j) { const f32x4 lo = *(const f32x4*)(cw + j * XBCW + col), hi = *(const f32x4*)(cw + j * XBCW + col + 4);
        w[j][0] = lo.x; w[j][1] = lo.y; w[j][2] = lo.z; w[j][3] = lo.w; w[j][4] = hi.x; w[j][5] = hi.y; w[j][6] = hi.z; w[j][7] = hi.w; }
    { const f32x4 lo = *(const f32x4*)(cb + col), hi = *(const f32x4*)(cb + col + 4); b[0] = lo.x; b[1] = lo.y; b[2] = lo.z; b[3] = lo.w; b[4] = hi.x; b[5] = hi.y; b[6] = hi.z; b[7] = hi.w; }
#pragma unroll
    for (int tk = 0; tk < 8; ++tk)
#pragma unroll
        for (int ch = 0; ch < 8; ++ch) {
            float acc = b[ch];
#pragma unroll
            for (int j = 0; j < 4; ++j) { const unsigned wd = raw[tk + j][ch >> 1]; const float xv = (ch & 1) ? bfhi(wd) : bflo(wd); acc += w[j][ch] * xv; }
            o[tk][ch] = siluf_(acc);
        }
}
DI float head_scan(const float* DT, const float* alog, int t0, int h, int lane, LAS float* acs_h, LAS float* dtv_h, float& d0o, float& d1o, float& c0o, float& c1o) {
    const float d0 = DT[(size_t)(t0 + 2 * lane) * NH + h], d1 = DT[(size_t)(t0 + 2 * lane + 1) * NH + h];
    const float A2 = -__expf(alog[h]) * LOG2E;
    const float a0 = d0 * A2, a1 = d1 * A2; float inc = a0 + a1;
#pragma unroll
    for (int o = 1; o < 64; o <<= 1) { const float t = __shfl_up(inc, o); if (lane >= o) inc += t; }
    acs_h[2 * lane] = inc - a1; acs_h[2 * lane + 1] = inc; dtv_h[2 * lane] = d0; dtv_h[2 * lane + 1] = d1;
    d0o = d0; d1o = d1; c0o = inc - a1; c1o = inc;
    return __shfl(inc, 63);
}

constexpr int S_CN = 0, S_BN = 32768, S_XT = 65536, S_ACS = 131072, S_DTV = 135168, S_SSQ = 139264, S_FS = 139776;

DI void ph3_chunk_states(const Ctx& F, const Args& a, int reps) {
    const bf16* XBC = (const bf16*)(F.ws + WS_XBC); const float* DT = (const float*)(F.ws + WS_DT);
    bf16* ST = (bf16*)(F.ws + WS_ST); float* CD = (float*)(F.ws + WS_CD);
    const float* scw = ARG(I_SCW); const float* scb = ARG(I_SCB); const float* alog = ARG(I_ALOG);
    const int tid = F.wave * 64 + lane_id(), lane = lane_id(), wave = F.wave, hh = lane >> 5;
    LAS unsigned char* lds = F.lds;
    LAS float* acs = (LAS float*)(lds + S_ACS); LAS float* wsc = (LAS float*)(lds + S_DTV);
    const int RU = (NCH * NGRP + F.G - 1) / F.G;
    for (int it = 0; it < RU * reps; ++it) {
        const int unit = xcd_unit(F.xcd, F.xj, F.G >> 3, (it >= RU ? it - RU : it), NCH * NGRP); if (unit < 0) break; const int c = unit >> 2, g = unit & 3, t0 = c * LCH;
        {
            const int h = 8 * g + wave; float d0, d1, c0, c1;
            const float total = head_scan(DT, alog, t0, h, lane, acs + wave * 128, wsc + wave * 128, d0, d1, c0, c1);
            wsc[wave * 128 + 2 * lane] = d0 * __builtin_amdgcn_exp2f(total - c0); wsc[wave * 128 + 2 * lane + 1] = d1 * __builtin_amdgcn_exp2f(total - c1);
            if (lane == 0) CD[c * NH + h] = __builtin_amdgcn_exp2f(total);
        }
        __syncthreads();
        if (tid < 256) { const int co = tid & 15, to = tid >> 4; float o[8][8];
            conv_block(XBC, scw, scb, t0 + 8 * to, 2048 + 128 * g + 8 * co, o);
#pragma unroll
            for (int ch = 0; ch < 8; ++ch) { const int row = 8 * co + ch;
                v4u w; w.x = pk2(o[0][ch], o[1][ch]); w.y = pk2(o[2][ch], o[3][ch]); w.z = pk2(o[4][ch], o[5][ch]); w.w = pk2(o[6][ch], o[7][ch]);
                *(LAS v4u*)(lds + S_BN + row * 256 + swz(row, to) * 16) = w; } }
        for (int ps = 0; ps < 2; ++ps) {
            {
                const int co = tid & 31, to = tid >> 5, hd = co >> 3, p0 = (co & 7) * 8; float o[8][8];
                conv_block(XBC, scw, scb, t0 + 8 * to, 512 * g + 64 * (4 * ps + hd) + p0, o);
                float sc[8];
#pragma unroll
                for (int tk = 0; tk < 8; ++tk) sc[tk] = wsc[(4 * ps + hd) * 128 + 8 * to + tk];
#pragma unroll
                for (int ch = 0; ch < 8; ++ch) { const int row = hd * 64 + p0 + ch;
                    v4u w; w.x = pk2(o[0][ch] * sc[0], o[1][ch] * sc[1]); w.y = pk2(o[2][ch] * sc[2], o[3][ch] * sc[3]);
                    w.z = pk2(o[4][ch] * sc[4], o[5][ch] * sc[5]); w.w = pk2(o[6][ch] * sc[6], o[7][ch] * sc[7]);
                    *(LAS v4u*)(lds + S_XT + row * 256 + swz(row, to) * 16) = w; }
            }
            __syncthreads();
            {
                const int hd = wave & 3, ph = wave >> 2, h = 8 * g + 4 * ps + hd;
                f32x16 acc[4];
#pragma unroll
                for (int nt = 0; nt < 4; ++nt)
#pragma unroll
                    for (int i = 0; i < 16; ++i) acc[nt][i] = 0.f;
                const int arow = hd * 64 + 32 * ph + (lane & 31);
#pragma unroll
                for (int ks = 0; ks < 8; ++ks) {
                    const bf16x8 av = *(const LAS bf16x8*)(lds + S_XT + arow * 256 + swz(arow, 2 * ks + hh) * 16);
#pragma unroll
                    for (int nt = 0; nt < 4; ++nt) { const int brow = 32 * nt + (lane & 31);
                        const bf16x8 bv = *(const LAS bf16x8*)(lds + S_BN + brow * 256 + swz(brow, 2 * ks + hh) * 16);
                        acc[nt] = MFMA32(av, bv, acc[nt]); }
                }
                bf16* dst = ST + ((size_t)(c * NH + h) * HD) * NST;
#pragma unroll
                for (int nt = 0; nt < 4; ++nt)
#pragma unroll
                    for (int i = 0; i < 16; i += 2) { const int p = 32 * ph + crow(i, hh); const unsigned pk = pk2(acc[nt][i], acc[nt][i + 1]);
                        dst[(size_t)p * NST + 32 * nt + (lane & 31)] = (bf16)(pk & 0xffffu); dst[(size_t)(p + 1) * NST + 32 * nt + (lane & 31)] = (bf16)(pk >> 16); }
            }
            __syncthreads();
        }
    }
}

DI void ph4_scan(const Ctx& F, size_t dst_off) {
    unsigned* ST32 = (unsigned*)(F.ws + WS_ST); unsigned* DST32 = (unsigned*)(F.ws + dst_off); const float* CD = (const float*)(F.ws + WS_CD);
    constexpr int NPAIR = NH * HD * NST / 2;
    for (int e = F.vcu * NTHREADS + (F.wave * 64 + lane_id()); e < NPAIR; e += F.G * NTHREADS) {
        const int h = e >> 12; float c0 = 0.f, c1 = 0.f;
#pragma unroll 1
        for (int cb = 0; cb < NCH; cb += 32) {
            unsigned v[32]; float dec[32];
#pragma unroll
            for (int i = 0; i < 32; ++i) { v[i] = __builtin_nontemporal_load(ST32 + (size_t)(cb + i) * NPAIR + e); dec[i] = CD[(cb + i) * NH + h]; }
#pragma unroll
            for (int i = 0; i < 32; ++i) { DST32[(size_t)(cb + i) * NPAIR + e] = pk2(c0, c1); c0 = c0 * dec[i] + bflo(v[i]); c1 = c1 * dec[i] + bfhi(v[i]); }
        }
    }
}

DI void ph5_ssd_out(const Ctx& F, const Args& a, int reps) {
    const bf16* XBC = (const bf16*)(F.ws + WS_XBC); const float* DT = (const float*)(F.ws + WS_DT);
    const bf16* ST = (const bf16*)(F.ws + WS_ST); const bf16* ZS = (const bf16*)(F.ws + WS_ZS); bf16* YS = (bf16*)(F.ws + WS_YS);
    const float* scw = ARG(I_SCW); const float* scb = ARG(I_SCB); const float* alog = ARG(I_ALOG); const float* dskip = ARG(I_DSKIP);
    const int tid = F.wave * 64 + lane_id(), lane = lane_id(), wave = F.wave, hh = lane >> 5, l31 = lane & 31;
    LAS unsigned char* lds = F.lds;
    LAS float* acs = (LAS float*)(lds + S_ACS); LAS float* dtv = (LAS float*)(lds + S_DTV); LAS float* ssq = (LAS float*)(lds + S_SSQ);
    const int RU = (NCH * NGRP + F.G - 1) / F.G;
    for (int it = 0; it < RU * reps; ++it) {
        const int unit = xcd_unit(F.xcd, F.xj, F.G >> 3, (it >= RU ? it - RU : it), NCH * NGRP); if (unit < 0) break; const int c = unit >> 2, g = unit & 3, t0 = c * LCH;
        { const int h = 8 * g + wave; float d0, d1, c0, c1; (void)head_scan(DT, alog, t0, h, lane, acs + wave * 128, dtv + wave * 128, d0, d1, c0, c1);
          const float cend = __shfl(c1, (lane & 48) | 15);
          LAS float* fsw = (LAS float*)(lds + S_FS) + wave * 128;
          fsw[2 * lane] = d0 * __builtin_amdgcn_exp2f(cend - c0); fsw[2 * lane + 1] = d1 * __builtin_amdgcn_exp2f(cend - c1); }
        if (tid < 128) ssq[tid] = 0.f;
        { const int which = tid >> 8, t8 = tid & 255, co = t8 & 15; int to = t8 >> 4; asm volatile("" : "+v"(to)); float o[8][8];
            conv_block(XBC, scw, scb, t0 + 8 * to, (which ? 2560 : 2048) + 128 * g + 8 * co, o);
            const int base = which ? S_CN : S_BN;
#pragma unroll
            for (int tk = 0; tk < 8; ++tk) { const int row = 8 * to + tk;
                v4u w; w.x = pk2(o[tk][0], o[tk][1]); w.y = pk2(o[tk][2], o[tk][3]); w.z = pk2(o[tk][4], o[tk][5]); w.w = pk2(o[tk][6], o[tk][7]);
                *(LAS v4u*)(lds + base + row * 256 + swz(row, co) * 16) = w; } }
#pragma unroll 1
        for (int ps = 0; ps < 2; ++ps) {
            {
                const int co = tid & 31; int to = tid >> 5; asm volatile("" : "+v"(to));
                const int hd = co >> 3, p0 = (co & 7) * 8; float o[8][8];
                conv_block(XBC, scw, scb, t0 + 8 * to, 512 * g + 64 * (4 * ps + hd) + p0, o);
#pragma unroll
                for (int ch = 0; ch < 8; ++ch) { const int row = hd * 64 + p0 + ch;
                    v4u w; w.x = pk2(o[0][ch], o[1][ch]); w.y = pk2(o[2][ch], o[3][ch]); w.z = pk2(o[4][ch], o[5][ch]); w.w = pk2(o[6][ch], o[7][ch]);
                    *(LAS v4u*)(lds + S_XT + row * 256 + swz(row, to) * 16) = w; }
            }
            __syncthreads();
            const int hd = wave & 3, lp = wave >> 2, hl = 4 * ps + hd, h = 8 * g + hl;
            const float Dh = dskip[h];
            const LAS float* acs_h = acs + hl * 128; const LAS float* dt_h = dtv + hl * 128; const LAS float* fs_h = (const LAS float*)(lds + S_FS) + hl * 128;
            const bf16* prev = ST + ((size_t)(c * NH + h) * HD) * NST;
            const int erow = lane >> 1, ehalf = lane & 1;
            f32x16 acc[2][2];
            {
#pragma unroll
                for (int which = 0; which < 2; ++which)
#pragma unroll
                    for (int pt = 0; pt < 2; ++pt)
#pragma unroll
                        for (int i = 0; i < 16; ++i) acc[which][pt][i] = 0.f;
                const int rowA = 32 * lp + l31, rowB = 32 * (3 - lp) + l31;
#pragma unroll
                for (int ks = 0; ks < 8; ++ks) {
                    const bf16x8 b0 = *(const bf16x8*)(prev + (size_t)l31 * NST + 16 * ks + 8 * hh), b1 = *(const bf16x8*)(prev + (size_t)(32 + l31) * NST + 16 * ks + 8 * hh);
                    const bf16x8 a0 = *(const LAS bf16x8*)(lds + S_CN + rowA * 256 + swz(rowA, 2 * ks + hh) * 16);
                    const bf16x8 a1 = *(const LAS bf16x8*)(lds + S_CN + rowB * 256 + swz(rowB, 2 * ks + hh) * 16);
                    acc[0][0] = MFMA32(a0, b0, acc[0][0]); acc[0][1] = MFMA32(a0, b1, acc[0][1]);
                    acc[1][0] = MFMA32(a1, b0, acc[1][0]); acc[1][1] = MFMA32(a1, b1, acc[1][1]);
                }
#pragma unroll
                for (int which = 0; which < 2; ++which) { const int li = which == 0 ? lp : 3 - lp;
#pragma unroll
                    for (int i = 0; i < 16; ++i) { const float e = __builtin_amdgcn_exp2f(acs_h[32 * li + crow(i, hh)]); acc[which][0][i] *= e; acc[which][1][i] *= e; } }
            }
            {
                const int liA = lp, liB = 3 - lp;
                const int rowA = 32 * liA + l31, rowB = 32 * liB + l31;
                const float alA = acs_h[rowA], alB = acs_h[rowB];
#pragma unroll 1
                for (int sj = 0; sj <= liB; ++sj) {
                    const bool doA = sj <= liA;
                    f32x16 GA, GB;
#pragma unroll
                    for (int i = 0; i < 16; ++i) { GA[i] = 0.f; GB[i] = 0.f; }
                    const int brow = 32 * sj + l31;
                    if (doA) {
#pragma unroll 2
                        for (int ks = 0; ks < 8; ++ks) {
                            const bf16x8 av = *(const LAS bf16x8*)(lds + S_BN + brow * 256 + swz(brow, 2 * ks + hh) * 16);
                            const bf16x8 ca = *(const LAS bf16x8*)(lds + S_CN + rowA * 256 + swz(rowA, 2 * ks + hh) * 16);
                            const bf16x8 cb = *(const LAS bf16x8*)(lds + S_CN + rowB * 256 + swz(rowB, 2 * ks + hh) * 16);
                            GA = MFMA32(av, ca, GA); GB = MFMA32(av, cb, GB);
                        }
                    } else {
#pragma unroll 2
                        for (int ks = 0; ks < 8; ++ks) {
                            const bf16x8 av = *(const LAS bf16x8*)(lds + S_BN + brow * 256 + swz(brow, 2 * ks + hh) * 16);
                            const bf16x8 cb = *(const LAS bf16x8*)(lds + S_CN + rowB * 256 + swz(rowB, 2 * ks + hh) * 16);
                            GB = MFMA32(av, cb, GB);
                        }
                    }
                    auto mask = [&](f32x16& G, int li, int row_l, float al) {
                        if (sj < li) {
                            const float fl = __builtin_amdgcn_exp2f(al - acs_h[32 * sj + 31]);
#pragma unroll
                            for (int i = 0; i < 16; ++i) G[i] = G[i] * (fs_h[32 * sj + crow(i, hh)] * fl);
                        } else {
#pragma unroll
                            for (int i = 0; i < 16; ++i) { const int s = 32 * sj + crow(i, hh);
                                float v = G[i] * __builtin_amdgcn_exp2f(fminf(al - acs_h[s], 0.f)) * dt_h[s];
                                v = (s > row_l) ? 0.f : v; v = (s == row_l) ? v + Dh : v; G[i] = v; }
                        }
                    };
                    auto pv = [&](const f32x16& G, f32x16 (&ac)[2]) {
#pragma unroll
                        for (int s2 = 0; s2 < 2; ++s2) {
                            v4u fa; fa.x = pk2(G[8 * s2 + 0], G[8 * s2 + 1]); fa.y = pk2(G[8 * s2 + 2], G[8 * s2 + 3]); fa.z = pk2(G[8 * s2 + 4], G[8 * s2 + 5]); fa.w = pk2(G[8 * s2 + 6], G[8 * s2 + 7]);
#pragma unroll
                            for (int pt = 0; pt < 2; ++pt) { const int xrow = hd * 64 + 32 * pt + l31; const int sc0 = 32 * sj + 16 * s2;
                                const v2u lo = *(const LAS v2u*)(lds + S_XT + xrow * 256 + swz(xrow, (sc0 >> 3)) * 16 + 8 * hh);
                                const v2u hi = *(const LAS v2u*)(lds + S_XT + xrow * 256 + swz(xrow, (sc0 >> 3) + 1) * 16 + 8 * hh);
                                v4u bfr; bfr.x = lo.x; bfr.y = lo.y; bfr.z = hi.x; bfr.w = hi.y;
                                ac[pt] = MFMA32(__builtin_bit_cast(bf16x8, fa), __builtin_bit_cast(bf16x8, bfr), ac[pt]); }
                        }
                    };
                    if (doA) { mask(GA, liA, rowA, alA); pv(GA, acc[0]); }
                    mask(GB, liB, rowB, alB); pv(GB, acc[1]);
                }
            }
            asm volatile("" ::: "memory");
            v4u zs[2][4];
#pragma unroll
            for (int which = 0; which < 2; ++which) { const int li = which == 0 ? lp : 3 - lp; const size_t t = (size_t)(t0 + 32 * li + erow);
#pragma unroll
                for (int j = 0; j < 4; ++j) zs[which][j] = *(const v4u*)(ZS + t * DIN + 64 * h + 32 * ehalf + 8 * j); }
            __syncthreads();
            {
                LAS unsigned char* stg = lds + S_XT + wave * 8192;
#pragma unroll
                for (int which = 0; which < 2; ++which)
#pragma unroll
                    for (int pt = 0; pt < 2; ++pt)
#pragma unroll
                        for (int i = 0; i < 16; ++i) *(LAS bf16*)(stg + ((which * 32 + crow(i, hh)) * 64 + 32 * pt + l31) * 2) = (bf16)(pk2(acc[which][pt][i], 0.f) & 0xffffu);
                LDS_WAIT(); asm volatile("" ::: "memory");
#pragma unroll
                for (int which = 0; which < 2; ++which) { const int li = which == 0 ? lp : 3 - lp; const int l = 32 * li + erow; const size_t t = (size_t)(t0 + l);
                    float q = 0.f; unsigned w8[8];
#pragma unroll
                    for (int j = 0; j < 4; ++j) { const v4u yv = *(const LAS v4u*)(stg + ((which * 32 + erow) * 64 + 32 * ehalf + 8 * j) * 2); const v4u zv = zs[which][j];
                        float y[8] = {bflo(yv.x) * bflo(zv.x), bfhi(yv.x) * bfhi(zv.x), bflo(yv.y) * bflo(zv.y), bfhi(yv.y) * bfhi(zv.y), bflo(yv.z) * bflo(zv.z), bfhi(yv.z) * bfhi(zv.z), bflo(yv.w) * bflo(zv.w), bfhi(yv.w) * bfhi(zv.w)};
#pragma unroll
                        for (int k = 0; k < 8; ++k) q += y[k] * y[k];
                        w8[2 * j] = pk4_fp8(y[0], y[1], y[2], y[3]); w8[2 * j + 1] = pk4_fp8(y[4], y[5], y[6], y[7]); }
                    { unsigned char* yp = (unsigned char*)YS + t * DIN + 64 * h + 32 * ehalf;
                      *(v4u*)yp = (v4u){w8[0], w8[1], w8[2], w8[3]}; *(v4u*)(yp + 16) = (v4u){w8[4], w8[5], w8[6], w8[7]}; }
                    q += __shfl_xor(q, 1);
                    if (ehalf == 0) __hip_atomic_fetch_add(ssq + l, q, __ATOMIC_RELAXED, __HIP_MEMORY_SCOPE_WORKGROUP);
                }
            }
            __syncthreads();
        }
        if (tid < 128) ((float*)(F.ws + WS_RSTD))[(size_t)(t0 + tid) * 4 + g] = 1.0f / sqrtf(ssq[tid] * (1.0f / 512.f) + EPS);
        __syncthreads();
    }
}

constexpr int RT_LD = 1028;
DI void ph8_router(const Ctx& F, const Args& a, int reps) {
    const float* mod = (const float*)(F.ws + WS_CTL) + CW_MODC;
    const bf16* H = (const bf16*)(F.ws + WS_H16); const float* n2g = ARG(I_N2G); const float* bgrp = ARG(I_BGRP); const float* ber = ARG(I_BER);
    unsigned char* XN2 = F.ws + WS_XN; int* cnt0 = (int*)(F.ws + WS_CTL) + CW_CNT;
    int* RE = (int*)(F.ws + WS_ROUTE); int* RP = RE + 2 * M; float* RW = (float*)(RP + 2 * M); int* LIST = (int*)(F.ws + WS_LIST);
    const int lane = lane_id(), wave = F.wave;
    LAS float* tile = (LAS float*)F.lds;
    LAS float* pe = (LAS float*)F.lds;
    f32x4 gm[4], ga[4];
#pragma unroll
    for (int j = 0; j < 4; ++j) { const int k = 256 * j + 4 * lane; const f32x4 g = *(const f32x4*)(n2g + k), sc = *(const f32x4*)(mod + 4096 + k);
        gm[j] = g * (sc + 1.0f); ga[j] = *(const f32x4*)(mod + 3072 + k); }
    const int RU = (M / 32 + F.G - 1) / F.G;
    for (int it = 0; it < RU * reps; ++it) {
        const int unit = xcd_unit(F.xcd, F.xj, F.G >> 3, (it >= RU ? it - RU : it), M / 32); if (unit < 0) break; int* cnt = cnt0 + ((it >= RU * (reps - 1)) ? 0 : 4096);
        const int row0 = unit * 32;
        {
            f32x4 v[4][4];
#pragma unroll
            for (int rr = 0; rr < 4; ++rr)
#pragma unroll
                for (int j = 0; j < 4; ++j) { const v2u hw = *(const v2u*)(H + (size_t)(row0 + wave * 4 + rr) * D + 256 * j + 4 * lane); v[rr][j] = (f32x4){bflo(hw.x), bfhi(hw.x), bflo(hw.y), bfhi(hw.y)}; }
#pragma unroll
            for (int rr = 0; rr < 4; ++rr) { const int rl = wave * 4 + rr, row = row0 + rl; float ss = 0.f;
#pragma unroll
                for (int j = 0; j < 4; ++j) ss += (v[rr][j].x * v[rr][j].x + v[rr][j].y * v[rr][j].y) + (v[rr][j].z * v[rr][j].z + v[rr][j].w * v[rr][j].w);
                const float rstd = 1.0f / sqrtf(wave_sum(ss) * (1.0f / D) + EPS);
#pragma unroll
                for (int j = 0; j < 4; ++j) { const f32x4 n = v[rr][j] * rstd * gm[j] + ga[j];
                    *(LAS f32x4*)(tile + rl * RT_LD + 256 * j + 4 * lane) = n;
                    *(unsigned*)(XN2 + (size_t)row * D + 256 * j + 4 * lane) = pk4_fp8(n.x, n.y, n.z, n.w); }
            }
        }
        __syncthreads();
        pg8::f32x4 acc[2][5];
#pragma unroll
        for (int rt = 0; rt < 2; ++rt)
#pragma unroll
            for (int ct = 0; ct < 5; ++ct) acc[rt][ct] = (pg8::f32x4){0.f, 0.f, 0.f, 0.f};
        const int kb = wave * 128, fr = lane & 15, kq = lane >> 4;
        const bf16* WRH = (const bf16*)(F.ws + WS_WRH); const bf16* WRL = (const bf16*)(F.ws + WS_WRL);
#pragma unroll 2
        for (int ks = 0; ks < 4; ++ks) {
            const int k0 = kb + 32 * ks + 8 * kq;
            bf16x8 bh[5], bl[5];
#pragma unroll
            for (int ct = 0; ct < 5; ++ct) { bh[ct] = *(const bf16x8*)(WRH + (size_t)(16 * ct + fr) * D + k0); bl[ct] = *(const bf16x8*)(WRL + (size_t)(16 * ct + fr) * D + k0); }
#pragma unroll
            for (int rt = 0; rt < 2; ++rt) {
                const f32x4 x0 = *(const LAS f32x4*)(tile + (16 * rt + fr) * RT_LD + k0), x1 = *(const LAS f32x4*)(tile + (16 * rt + fr) * RT_LD + k0 + 4);
                v4u hv, lv;
                hv.x = pk2(x0.x, x0.y); hv.y = pk2(x0.z, x0.w); hv.z = pk2(x1.x, x1.y); hv.w = pk2(x1.z, x1.w);
                lv.x = pk2(x0.x - bflo(hv.x), x0.y - bfhi(hv.x)); lv.y = pk2(x0.z - bflo(hv.y), x0.w - bfhi(hv.y));
                lv.z = pk2(x1.x - bflo(hv.z), x1.y - bfhi(hv.z)); lv.w = pk2(x1.z - bflo(hv.w), x1.w - bfhi(hv.w));
                const bf16x8 ah = __builtin_bit_cast(bf16x8, hv), al = __builtin_bit_cast(bf16x8, lv);
#pragma unroll
                for (int ct = 0; ct < 5; ++ct) {
                    acc[rt][ct] = __builtin_amdgcn_mfma_f32_16x16x32_bf16(ah, bh[ct], acc[rt][ct], 0, 0, 0);
                    acc[rt][ct] = __builtin_amdgcn_mfma_f32_16x16x32_bf16(ah, bl[ct], acc[rt][ct], 0, 0, 0);
                    acc[rt][ct] = __builtin_amdgcn_mfma_f32_16x16x32_bf16(al, bh[ct], acc[rt][ct], 0, 0, 0); }
            }
        }
        __syncthreads();
#pragma unroll
        for (int rt = 0; rt < 2; ++rt)
#pragma unroll
            for (int ct = 0; ct < 5; ++ct)
#pragma unroll
                for (int r = 0; r < 4; ++r) pe[(wave * 32 + 16 * rt + 4 * kq + r) * 80 + 16 * ct + fr] = acc[rt][ct][r];
        __syncthreads();
        int e0s[4], e1s[4]; float w0s[4], w1s[4];
#pragma unroll
        for (int rr = 0; rr < 4; ++rr) { const int rl = wave * 4 + rr;
            float le = ber[lane], lgv = (lane < 8) ? bgrp[lane] : 0.f;
#pragma unroll
            for (int wv = 0; wv < 8; ++wv) { le += pe[(wv * 32 + rl) * 80 + lane]; if (lane < 8) lgv += pe[(wv * 32 + rl) * 80 + 64 + lane]; }
            float gl[8];
#pragma unroll
            for (int i = 0; i < 8; ++i) gl[i] = __shfl(lgv, i);
            int gi = 0; float gmax = gl[0];
#pragma unroll
            for (int i = 1; i < 8; ++i) if (gl[i] > gmax) { gmax = gl[i]; gi = i; }
            float den = 0.f;
#pragma unroll
            for (int i = 0; i < 8; ++i) den += __expf(gl[i] - gmax);
            const float gp = 1.0f / den;
            float el[8];
#pragma unroll
            for (int i = 0; i < 8; ++i) el[i] = __shfl(le, gi * 8 + i);
            int i0 = 0; float m0 = el[0];
#pragma unroll
            for (int i = 1; i < 8; ++i) if (el[i] > m0) { m0 = el[i]; i0 = i; }
            int i1 = -1; float m1 = -INFINITY;
#pragma unroll
            for (int i = 0; i < 8; ++i) if (i != i0 && el[i] > m1) { m1 = el[i]; i1 = i; }
            const float dd = __expf(m1 - m0);
            w0s[rr] = gp / (1.0f + dd); w1s[rr] = gp * dd / (1.0f + dd); e0s[rr] = gi * 8 + i0; e1s[rr] = gi * 8 + i1;
        }
        if (lane == 0) {
            int p0[4], p1[4];
#pragma unroll
            for (int rr = 0; rr < 4; ++rr) { p0[rr] = atomicAdd(cnt + 64 * e0s[rr], 1); p1[rr] = atomicAdd(cnt + 64 * e1s[rr], 1); }
#pragma unroll
            for (int rr = 0; rr < 4; ++rr) { const int row = row0 + wave * 4 + rr;
                RE[2 * row] = e0s[rr]; RE[2 * row + 1] = e1s[rr]; RP[2 * row] = p0[rr]; RP[2 * row + 1] = p1[rr]; RW[2 * row] = w0s[rr]; RW[2 * row + 1] = w1s[rr];
                LIST[e0s[rr] * 16384 + p0[rr]] = row; LIST[e1s[rr] * 16384 + p1[rr]] = row; }
        }
        __syncthreads();
    }
}

DI void build_tilebase(const Ctx& F) {
    const int* cnt = (const int*)(F.ws + WS_CTL) + CW_CNT; LAS int* tb = (LAS int*)(F.lds + TB_OFF);
    if (F.wave == 0) {
        const int lane = lane_id(); const int tiles = (cnt[64 * lane] + 255) >> 8; int inc = tiles;
#pragma unroll
        for (int o = 1; o < 64; o <<= 1) { const int t = __shfl_up(inc, o); if (lane >= o) inc += t; }
        tb[lane] = inc - tiles; if (lane == 63) tb[NE] = inc; ((LAS int*)(F.lds + CNTL_OFF))[lane] = cnt[64 * lane];
    }
    __syncthreads();
}
DI void fill_tokl(const Ctx& F, const MoeOrder& S) {
    const LAS int* tb = (const LAS int*)(F.lds + TB_OFF); const LAS int* cntl = (const LAS int*)(F.lds + CNTL_OFF); LAS int* tokl = (LAS int*)(F.lds + TOKL_OFF);
    const int* LIST = (const int*)(F.ws + WS_LIST); const int tid = F.wave * 64 + lane_id();
    for (int i = 0; i < 4; ++i) { pg8::Unit u; if (!S.next(i, u)) break;
        const int e = u.pn >> 2, r = 256 * (u.pm - tb[e]) + tid;
        if (tid < 256) tokl[256 * i + tid] = (r < cntl[e]) ? LIST[e * 16384 + r] : 0; }
    asm volatile("s_waitcnt vmcnt(0) lgkmcnt(0)" ::: "memory"); __syncthreads();
}
DI void ph12_final(const Ctx& F, const Args& a, int reps) {
    const float* mod = (const float*)(F.ws + WS_CTL) + CW_MODC; float* H = (float*)argp<N_IN>(); const bf16* H16 = (const bf16*)(F.ws + WS_H16); const float* fg = ARG(I_FG);
    const unsigned char* YE = F.ws + WS_YEXP; const int* RE = (const int*)(F.ws + WS_ROUTE); const int* RP = RE + 2 * M; const float* RW = (const float*)(F.ws + WS_ROUTE) + 4 * M;
    const LAS int* tb = (const LAS int*)(F.lds + TB_OFF);
    float* OUT2 = (float*)(F.ws + WS_U);
    const int gw = F.vcu * NWAVES + F.wave, NGW = F.G * NWAVES, lane = lane_id();
    f32x4 g2[4], fgv[4];
#pragma unroll
    for (int j = 0; j < 4; ++j) { g2[j] = *(const f32x4*)(mod + 5 * 1024 + 256 * j + 4 * lane); fgv[j] = *(const f32x4*)(fg + 256 * j + 4 * lane); }
    const int RT = (M / 2 + NGW - 1) / NGW;
    for (int it = 0; it < RT * reps; ++it) {
        const int t0 = 2 * xcd_unit(F.xcd, F.xj * NWAVES + F.wave, NGW >> 3, (it >= RT ? it - RT : it), M / 2); if (t0 < 0) break;
        float* O = (it >= RT * (reps - 1)) ? H : OUT2;
        int tt[2], d0[2], d1[2]; float w0[2], w1[2];
#pragma unroll
        for (int u = 0; u < 2; ++u) { tt[u] = (t0 + u) % M; d0[u] = 256 * tb[RE[2 * tt[u]]] + RP[2 * tt[u]]; d1[u] = 256 * tb[RE[2 * tt[u] + 1]] + RP[2 * tt[u] + 1]; w0[u] = RW[2 * tt[u]]; w1[u] = RW[2 * tt[u] + 1]; }
        f32x4 hv[2][4]; unsigned ya[2][4], yb[2][4];
#pragma unroll
        for (int u = 0; u < 2; ++u)
#pragma unroll
            for (int j = 0; j < 4; ++j) { const v2u hw = *(const v2u*)(H16 + (size_t)tt[u] * D + 256 * j + 4 * lane); hv[u][j] = (f32x4){bflo(hw.x), bfhi(hw.x), bflo(hw.y), bfhi(hw.y)};
                ya[u][j] = *(const unsigned*)(YE + (size_t)d0[u] * D + 256 * j + 4 * lane); yb[u][j] = *(const unsigned*)(YE + (size_t)d1[u] * D + 256 * j + 4 * lane); }
#pragma unroll
        for (int u = 0; u < 2; ++u) {
            f32x4 v[4]; float ss = 0.f;
#pragma unroll
            for (int j = 0; j < 4; ++j) { const unsigned a4 = ya[u][j], b4 = yb[u][j];
                const f2v a01 = __builtin_amdgcn_cvt_pk_f32_fp8(a4, false), a23 = __builtin_amdgcn_cvt_pk_f32_fp8(a4, true), b01 = __builtin_amdgcn_cvt_pk_f32_fp8(b4, false), b23 = __builtin_amdgcn_cvt_pk_f32_fp8(b4, true);
                f32x4 mo; mo.x = w0[u] * a01.x + w1[u] * b01.x; mo.y = w0[u] * a01.y + w1[u] * b01.y; mo.z = w0[u] * a23.x + w1[u] * b23.x; mo.w = w0[u] * a23.y + w1[u] * b23.y;
                mo = mo * 0.0625f;
                v[j] = hv[u][j] + g2[j] * mo; ss += (v[j].x * v[j].x + v[j].y * v[j].y) + (v[j].z * v[j].z + v[j].w * v[j].w); }
            const float rstd = 1.0f / sqrtf(wave_sum(ss) * (1.0f / D) + EPS);
#pragma unroll
            for (int j = 0; j < 4; ++j) *(f32x4*)(O + (size_t)tt[u] * D + 256 * j + 4 * lane) = v[j] * rstd * fgv[j];
        }
    }
}

constexpr int N_PHASES = 13;
#ifndef REP_MASK
#define REP_MASK 0
#endif
#define REPS(k) (((REP_MASK >> (k)) & 1) ? 2 : 1)
#ifndef MK_ONE_LAUNCH
#define MK_ONE_LAUNCH 1
#endif

struct RepOrder { pg8::StaticOrder s; int n, reps;
    DI bool next(int i, pg8::Unit& u) const { if (i >= n * reps) return false; return s.next(i % n, u); }
    DI void a_ready(const pg8::Unit&) const {}
    DI void done(const pg8::Unit&) const {} };

__global__ void __launch_bounds__(NTHREADS, 2) fwd_kernel(Args args) {
    extern __shared__ __attribute__((aligned(16))) unsigned char lds_raw[];
    Ctx F;
    F.lds = (LAS unsigned char*)lds_raw;
    F.wave = __builtin_amdgcn_readfirstlane((int)threadIdx.x >> 6);
    F.G = gridDim.x; { const int bx = blockIdx.x; F.xcd = bx & 7; F.xj = bx >> 3; F.vcu = F.xcd * (F.G >> 3) + F.xj; }
    F.ws = (unsigned char*)argp<N_IN + 1>();
    volatile LAS unsigned* MISC = (volatile LAS unsigned*)(F.lds + LDSCTL_OFF);
    for (int u = threadIdx.x; u < (LDS_BYTES - LDSCTL_OFF) / 4; u += NTHREADS) ((LAS unsigned*)(F.lds + LDSCTL_OFF))[u] = 0u;
    __syncthreads();
    const int lo = args.ph_lo, hi = args.ph_hi;
    unsigned* barw = (unsigned*)(F.ws + WS_CTL) + CW_BAR;
    XcdBarrier bar; bar.bar = barw; bar.x = 0; bar.st = nullptr;
    if (hi - lo > 1) bar = xcd_barrier_post(barw, MISC + 8);
    bar.wave = F.wave;
#define IN(k) (lo <= (k) && (k) < hi)
#define SEAM(k) do { if (IN(k) && IN((k) + 1)) { xcd_barrier(bar); if (REPS(14) > 1) xcd_barrier(bar); } } while (0)
    unsigned char* ws = F.ws;
    bf16* XN = (bf16*)(ws + WS_XN);
    const float* mod = (const float*)(ws + WS_CTL) + CW_MOD;

    if (IN(0)) { ph0_prologue(F, args, REPS(0)); SEAM(0); }
    if (IN(1)) { for (int rep = 0; rep < REPS(1); ++rep) { ph1_norm_dt(F, args); __syncthreads(); } SEAM(1); }
    if (IN(2)) {
        pg8::Gemm g{(const bf16*)(ws + WS_XN8), (const bf16*)(ws + WS_W8IN), M, NPROJ, D / 2}; pg8::StaticOrder S; S.init(M, NPROJ, F.G, (int)blockIdx.x);
        EpiInProj E{ws};
        RepOrder R{S, (S.nwg - S.c + S.G - 1) / S.G, REPS(2)};
        pg8::gemm_phase<EpiInProj, RepOrder, true, true, false, false, true>(F.lds, g, R, E, F.wave);
        SEAM(2);
    }
    if (IN(3)) { ph3_convbranch(F, args, REPS(3)); __syncthreads(); ph3_chunk_states(F, args, REPS(13)); __syncthreads(); SEAM(3); }
    if (IN(4)) {
        if (REPS(4) > 1) ph4_scan(F, WS_YS);
        ph4_scan(F, WS_ST);
        pg8::Gemm g{XN, (const bf16*)(ws + WS_WCV), M, D, D}; pg8::StaticOrder S; S.init(M, D, F.G, (int)blockIdx.x);
        EpiGate<false> E{(bf16*)(ws + WS_TMP), nullptr, (const bf16*)(ws + WS_GATE), 0, nullptr};
        RepOrder R{S, (S.nwg - S.c + S.G - 1) / S.G, REPS(15)};
        pg8::gemm_phase<EpiGate<false>, RepOrder, false, true>(F.lds, g, R, E, F.wave);
        SEAM(4);
    }
    if (IN(5)) { ph5_ssd_out(F, args, REPS(5)); SEAM(5); }
    if (IN(6)) {
        pg8::Gemm g{(const bf16*)(ws + WS_YS), (const bf16*)(ws + WS_WSSM), M, D, DIN / 2}; pg8::StaticOrder S; S.init(M, D, F.G, (int)blockIdx.x);
        LAS float* rt = (LAS float*)(F.lds + RT_OFF);
        EpiGate<true> E{(bf16*)(ws + WS_MG), (const bf16*)(ws + WS_TMP), (const bf16*)(ws + WS_GATE), 1024, rt};
        for (int i = 0;; ++i) {
            OneUnit S1; if (!S.next(i, S1.u)) break;
            if (F.wave < 4) { const int tid = F.wave * 64 + lane_id(); const f32x4 r = *(const f32x4*)((const float*)(ws + WS_RSTD) + (size_t)(S1.u.pm * 256 + tid) * 4);
                *(LAS f32x4*)(rt + tid * 4) = (f32x4){r.x / r.y, r.y / r.z, r.z / r.w, r.w}; }
            asm volatile("s_waitcnt vmcnt(0) lgkmcnt(0)" ::: "memory"); __syncthreads();
            pg8::gemm_phase<EpiGate<true>, OneUnit, false, true, true>(F.lds, g, S1, E, F.wave);
            __syncthreads();
        }
        SEAM(6);
    }
    if (IN(7)) {
        pg8::Gemm g{(const bf16*)(ws + WS_MG), (const bf16*)(ws + WS_WMIX), M, D, D}; pg8::StaticOrder S; S.init(M, D, F.G, (int)blockIdx.x);
        EpiMix E{(bf16*)(ws + WS_H16), ARG(I_X), (const float*)(ws + WS_CTL) + CW_MODC + 2 * 1024};
        RepOrder R{S, (S.nwg - S.c + S.G - 1) / S.G, REPS(7)};
        pg8::gemm_phase<EpiMix, RepOrder, false, true>(F.lds, g, R, E, F.wave);
        SEAM(7);
    }
    if (IN(8)) { for (int rep = 0; rep < REPS(8); ++rep) { convert_experts(F, args); __syncthreads(); } ph8_router(F, args, REPS(9)); if (IN(8) && IN(10)) xcd_barrier(bar); }
    if (IN(10)) {
        build_tilebase(F);
        const LAS int* tb = (const LAS int*)(F.lds + TB_OFF);
        pg8::Gemm g{(const bf16*)(ws + WS_XN), (const bf16*)(ws + WS_W13), M, NE * 1024, D / 2};
        MoeOrder S{tb, F.G, F.vcu, tb[NE] * 4, 1, (const LAS int*)(F.lds + TOKL_OFF)};
        fill_tokl(F, S);
        EpiUp E{ws + WS_HDN};
        pg8::gemm_phase<EpiUp, MoeOrder, true, true, true, true>(F.lds, g, S, E, F.wave);
        SEAM(10);
    }
    if (IN(11)) {
        build_tilebase(F);
        const LAS int* tb = (const LAS int*)(F.lds + TB_OFF);
        pg8::Gemm g{(const bf16*)(ws + WS_HDN), (const bf16*)(ws + WS_W2), 49152, NE * 1024, DFF / 2};
        MoeOrder S{tb, F.G, F.vcu, tb[NE] * 4, 1, nullptr};
        EpiDown E{ws + WS_YEXP};
        pg8::gemm_phase<EpiDown, MoeOrder, true, true, true>(F.lds, g, S, E, F.wave);
        SEAM(11);
    }
    if (IN(12)) { build_tilebase(F); ph12_final(F, args, REPS(12)); }
#undef IN
#undef SEAM
}

extern "C" void kernel_launch(void* const* d_in, const int* in_sizes, int n_in, void* d_out, int out_size, void* d_ws, size_t ws_size, hipStream_t stream) {
    static int grid = 0;
    if (grid == 0) {
        if (n_in != N_IN || in_sizes[0] != M * D || out_size != M * D || ws_size < WS_END) {
            fprintf(stderr, "kernel_launch: unexpected shapes: n_in %d in0 %d out %d ws %zu (need %zu)\n", n_in, n_in > 0 ? in_sizes[0] : -1, out_size, ws_size, (size_t)WS_END); grid = -1; return; }
        int dev = 0, cus = 0, per_cu = 0;
        if (hipGetDevice(&dev) != hipSuccess || hipDeviceGetAttribute(&cus, hipDeviceAttributeMultiprocessorCount, dev) != hipSuccess) { fprintf(stderr, "kernel_launch: device query failed\n"); grid = -1; return; }
        if (hipFuncSetAttribute((const void*)fwd_kernel, hipFuncAttributeMaxDynamicSharedMemorySize, LDS_BYTES) != hipSuccess) { fprintf(stderr, "kernel_launch: hipFuncSetAttribute failed\n"); grid = -1; return; }
        if (hipOccupancyMaxActiveBlocksPerMultiprocessor(&per_cu, (const void*)fwd_kernel, NTHREADS, LDS_BYTES) != hipSuccess || per_cu < 1) {
            fprintf(stderr, "kernel_launch: the occupancy query admits no workgroup of this kernel per CU (%d); nothing launched\n", per_cu); (void)hipGetLastError(); grid = -1; return; }
        grid = cus;
        if (cus < 192 || (cus & 7)) { fprintf(stderr, "kernel_launch: built for a 256-CU device (the MoE unit table holds 4 units per workgroup); %d CUs: nothing launched\n", cus); grid = -1; return; }
        fprintf(stderr, "kernel_launch: grid %d (cus %d, per_cu %d)\n", grid, cus, per_cu);
    }
    if (grid < 0) return;
    (void)hipMemsetAsync((char*)d_ws + WS_CTL, 0, CTL_ZERO_BYTES, stream);
    Args a{};
    for (int i = 0; i < N_IN; ++i) a.in[i] = (const float*)d_in[i];
    a.out = (float*)d_out; a.ws = (unsigned char*)d_ws;
#if MK_ONE_LAUNCH
    a.ph_lo = 0; a.ph_hi = N_PHASES;
    void* kargs[] = {&a};
    hipError_t e = hipLaunchCooperativeKernel((const void*)fwd_kernel, dim3(grid), dim3(NTHREADS), kargs, LDS_BYTES, stream);
    if (e != hipSuccess) fprintf(stderr, "kernel_launch: cooperative launch failed: %s\n", hipGetErrorString(e));
#else
    for (int ph = 0; ph < N_PHASES; ++ph) {
        a.ph_lo = ph; a.ph_hi = ph + 1;
        hipLaunchKernelGGL(fwd_kernel, dim3(grid), dim3(NTHREADS), LDS_BYTES, stream, a);
    }
#endif
}
```

```cpp
#include <hip/hip_runtime.h>
#include <hip/hip_cooperative_groups.h>
#include <cstdio>
#include <cstdint>
namespace pg8 {
#define PG8_LAS __attribute__((address_space(3)))
typedef unsigned short bf16_t;
typedef short bf16x8 __attribute__((ext_vector_type(8)));
typedef float f32x4 __attribute__((ext_vector_type(4)));
typedef unsigned u32x4 __attribute__((ext_vector_type(4)));
typedef int v4i_ __attribute__((ext_vector_type(4)));
typedef int v8i_ __attribute__((ext_vector_type(8)));
constexpr int BM = 256, BK = 64, HALF = 128, HTB = HALF * BK * 2  , STAGE_BYTES = 8 * HTB, NXCD = 8, WGM = 8;

__host__ __device__ __forceinline__ int lds_byte(int r, int c) { const int st = (r >> 4) * 2 + (c >> 5), rr = r & 15, cc = c & 31, ob = rr * 64 + cc * 2; return st * 1024 + (ob ^ (((ob >> 9) & 1) << 5)); }
__host__ __device__ __forceinline__ void stage_rc(int b, int& R, int& C) { const int st = b / 1024, sb = b % 1024, swz = sb ^ (((sb >> 9) & 1) << 5); R = (st >> 1) * 16 + swz / 64; C = (st & 1) * 32 + (swz % 64) / 2; }
__host__ __device__ __forceinline__ int perm32(int rho) { const int n = rho >> 4, i = rho & 15; return 8 * (i >> 2) + 4 * n + (i & 3); }

struct Unit { int pm, pn; };
struct Gemm { const bf16_t* A; const bf16_t* Bt; int M, N, K; };

struct StaticOrder {
    int nM, nN, nwg, G, c;
    __host__ __device__ void init(int M, int N, int G_, int c_) { nM = M / BM; nN = N / BM; nwg = nM * nN; G = G_; c = c_; }
    __host__ __device__ bool next(int i, Unit& u) const {
        const long L = (long)i * G + c; if (L >= nwg) return false;
        int wgid = (int)L; { const int q = nwg / NXCD, r = nwg % NXCD, xcd = wgid % NXCD, off = wgid / NXCD; wgid = (xcd < r ? xcd * (q + 1) : r * (q + 1) + (xcd - r) * q) + off; }
        const int nig = WGM * nN, gid = wgid / nig, fm = gid * WGM, gsz = (nM - fm) < WGM ? (nM - fm) : WGM;
        u.pm = fm + ((wgid % nig) % gsz); u.pn = (wgid % nig) / gsz; return true;
    }
    __device__ __forceinline__ void a_ready(const Unit&) const {}
    __device__ __forceinline__ void done(const Unit&) const {}
};

__device__ __forceinline__ unsigned cvt_pk_bf16(float lo, float hi) { unsigned r; asm volatile("v_cvt_pk_bf16_f32 %0, %1, %2" : "=v"(r) : "v"(lo), "v"(hi)); return r; }
typedef float f32x2 __attribute__((ext_vector_type(2)));
template <class Epi, class Sched, bool ALIGN_EPI = false, bool SP2 = false, bool FP8 = false, bool GATHER = false, bool I8 = false>
__device__ __forceinline__ void gemm_phase(PG8_LAS unsigned char* lds, const Gemm g, const Sched& S, const Epi& E, const int wave_in) {
    const int lane = (int)__builtin_amdgcn_mbcnt_hi(~0u, __builtin_amdgcn_mbcnt_lo(~0u, 0u)), wid = wave_in, tid = wid * 64 + lane, wr = wid >> 2, wc = wid & 3, fr = lane & 15, fq = lane >> 4;
    const int K = g.K, nt = K / BK;
    unsigned voffA[2], voffB[2];
#pragma unroll
    for (int i = 0; i < 2; ++i) { int R, C; stage_rc(tid * 16 + i * 8192, R, C); const int Rb = Epi::PERM ? ((R & ~31) + perm32(R & 31)) : R;
        voffA[i] = (unsigned)(R * K + C) * 2u; voffB[i] = (unsigned)(Rb * K + C) * 2u; }
    static_assert(!GATHER || SP2, "GATHER is implemented in the SP2 loop");
    unsigned gA[2][2], ngA[2][2]; int RA[2]; unsigned CA2[2];
#pragma unroll
    for (int i = 0; i < 2; ++i) { int R, C; stage_rc(tid * 16 + i * 8192, R, C); RA[i] = R; CA2[i] = (unsigned)C * 2u; }
    auto load_g = [&](int ui_, unsigned (&dst)[2][2]) {
        if constexpr (GATHER) {
#pragma unroll
            for (int h = 0; h < 2; ++h)
#pragma unroll
                for (int i = 0; i < 2; ++i) dst[h][i] = (unsigned)S.tokl[ui_ * 256 + 128 * h + RA[i]] * (unsigned)(K * 2) + CA2[i];
        }
    };
    const size_t kstep = (size_t)(BK * 2);
    const size_t hstep = (size_t)HALF * K * 2;
    const size_t tstep = 2 * hstep;
    const size_t hstepA = GATHER ? (size_t)0 : hstep, tstepA = GATHER ? (size_t)0 : 2 * hstep;
    const unsigned ldsw = (unsigned)wid * 1024u;
    const int aoff = lds_byte(wr * 64 + fr, fq * 8), boff = lds_byte(wc * 32 + fr, fq * 8);
#define PG8_SA(b, h) (((b) * 2 + (h)) * HTB)
#define PG8_SB(b, h) ((4 + (b) * 2 + (h)) * HTB)
#define PG8_STAGE(bufoff, gbase, voff) do { _Pragma("unroll") for (int _i = 0; _i < 2; ++_i) \
        __builtin_amdgcn_global_load_lds((const unsigned*)((const char*)(gbase) + (voff)[_i]), (PG8_LAS unsigned*)(lds + (bufoff) + ldsw + _i * 8192), 16, 0, 0); } while (0)
#define PG8_STAGE_A(bufoff, gbase, gvoff) do { if constexpr (GATHER) { PG8_STAGE(bufoff, gbase, gvoff); } else { PG8_STAGE(bufoff, gbase, voffA); } } while (0)
#define PG8_LDA(dst, b, h) do { if constexpr (FP8) { _Pragma("unroll") for (int m = 0; m < 4; ++m) dst##8[m] = __builtin_shufflevector(*(const PG8_LAS v4i_*)(lds + PG8_SA(b, h) + aoff + m * 2048), *(const PG8_LAS v4i_*)(lds + PG8_SA(b, h) + aoff + m * 2048 + 1024), 0, 1, 2, 3, 4, 5, 6, 7); } \
        else { _Pragma("unroll") for (int m = 0; m < 4; ++m) _Pragma("unroll") for (int k = 0; k < 2; ++k) dst[m][k] = *(const PG8_LAS bf16x8*)(lds + PG8_SA(b, h) + aoff + m * 2048 + k * 1024); } } while (0)
#define PG8_LDB(dst, b, h) do { if constexpr (FP8) { _Pragma("unroll") for (int n = 0; n < 2; ++n) dst##8[n] = __builtin_shufflevector(*(const PG8_LAS v4i_*)(lds + PG8_SB(b, h) + boff + n * 2048), *(const PG8_LAS v4i_*)(lds + PG8_SB(b, h) + boff + n * 2048 + 1024), 0, 1, 2, 3, 4, 5, 6, 7); } \
        else { _Pragma("unroll") for (int n = 0; n < 2; ++n) _Pragma("unroll") for (int k = 0; k < 2; ++k) dst[n][k] = *(const PG8_LAS bf16x8*)(lds + PG8_SB(b, h) + boff + n * 2048 + k * 1024); } } while (0)
#define PG8_MMA(ai, bj, At, Bt) do { __builtin_amdgcn_s_setprio(1); \
        if constexpr (FP8) {   \
              \
            _Pragma("unroll") for (int m = 0; m < 4; ++m) _Pragma("unroll") for (int n = 0; n < 2; ++n) \
                asm volatile("v_mfma_scale_f32_16x16x128_f8f6f4 %0, %1, %2, %0, %3, %4 op_sel_hi:[0,0,0]" : "+v"(acc[ai][bj][m][n]) : "v"(Bt##8[n]), "v"(At##8[m]), "v"(scale_w), "v"(scale_x)); \
        } else { \
        _Pragma("unroll") for (int m = 0; m < 4; ++m) _Pragma("unroll") for (int n = 0; n < 2; ++n) _Pragma("unroll") for (int k = 0; k < 2; ++k) { \
        if constexpr (I8) acc[ai][bj][m][n] = __builtin_bit_cast(f32x4, __builtin_amdgcn_mfma_i32_16x16x64_i8(__builtin_bit_cast(v4i_, Bt[n][k]), __builtin_bit_cast(v4i_, At[m][k]), __builtin_bit_cast(v4i_, acc[ai][bj][m][n]), 0, 0, 0)); \
        else acc[ai][bj][m][n] = __builtin_amdgcn_mfma_f32_16x16x32_bf16(Bt[n][k], At[m][k], acc[ai][bj][m][n], 0, 0, 0); } } __builtin_amdgcn_s_setprio(0); } while (0)
#define PG8_WAIT_V(n) asm volatile("s_waitcnt vmcnt(" #n ")" ::: "memory")
#define PG8_WAIT_L(n) asm volatile("s_waitcnt lgkmcnt(" #n ")" ::: "memory")
#define PG8_BAR __builtin_amdgcn_s_barrier()
#define PG8_SCHED __builtin_amdgcn_sched_barrier(0)
    Unit cur, nxt; int ui = 0;
    if (!S.next(0, cur)) return;
    f32x4 acc[2][2][4][2];
#pragma unroll
    for (int a = 0; a < 2; ++a)
#pragma unroll
        for (int b = 0; b < 2; ++b)
#pragma unroll
            for (int m = 0; m < 4; ++m)
#pragma unroll
                for (int n = 0; n < 2; ++n) acc[a][b][m][n] = (f32x4){0.f, 0.f, 0.f, 0.f};
    auto xdl_settle = [&]() {
        asm volatile("s_nop 15\n\ts_nop 15" : "+v"(acc[0][0][0][0]), "+v"(acc[0][0][0][1]), "+v"(acc[0][0][1][0]), "+v"(acc[0][0][1][1]), "+v"(acc[0][0][2][0]), "+v"(acc[0][0][2][1]), "+v"(acc[0][0][3][0]), "+v"(acc[0][0][3][1]), "+v"(acc[0][1][0][0]), "+v"(acc[0][1][0][1]), "+v"(acc[0][1][1][0]), "+v"(acc[0][1][1][1]), "+v"(acc[0][1][2][0]), "+v"(acc[0][1][2][1]), "+v"(acc[0][1][3][0]), "+v"(acc[0][1][3][1]));
        asm volatile("s_nop 0" : "+v"(acc[1][0][0][0]), "+v"(acc[1][0][0][1]), "+v"(acc[1][0][1][0]), "+v"(acc[1][0][1][1]), "+v"(acc[1][0][2][0]), "+v"(acc[1][0][2][1]), "+v"(acc[1][0][3][0]), "+v"(acc[1][0][3][1]), "+v"(acc[1][1][0][0]), "+v"(acc[1][1][0][1]), "+v"(acc[1][1][1][0]), "+v"(acc[1][1][1][1]), "+v"(acc[1][1][2][0]), "+v"(acc[1][1][2][1]), "+v"(acc[1][1][3][0]), "+v"(acc[1][1][3][1]));
    };
    const int scale_w = 0x79797979, scale_x = 0x7f7f7f7f;
    bf16x8 At[4][2], B0[2][2], B1[2][2]; v8i_ At8[4], B08[2], B18[2];
    const char* cA = (const char*)g.A + (size_t)cur.pm * tstepA; const char* cB = (const char*)g.Bt + (size_t)cur.pn * tstep;
    load_g(0, gA);
    S.a_ready(cur);
    if constexpr (SP2) {
        PG8_STAGE(PG8_SB(0, 0), cB, voffB); PG8_STAGE(PG8_SB(0, 1), cB + hstep, voffB); PG8_STAGE_A(PG8_SA(0, 0), cA, gA[0]); PG8_STAGE_A(PG8_SA(0, 1), cA + hstepA, gA[1]);
        if (wr == 1) PG8_BAR;
        PG8_WAIT_V(2); PG8_BAR;
        PG8_STAGE(PG8_SB(1, 0), cB + kstep, voffB); PG8_STAGE_A(PG8_SA(1, 0), cA + kstep, gA[0]); PG8_STAGE(PG8_SB(1, 1), cB + hstep + kstep, voffB);
        PG8_WAIT_V(6); PG8_BAR;
    } else {
        PG8_STAGE(PG8_SB(0, 0), cB, voffB); PG8_STAGE(PG8_SA(0, 0), cA, voffA); PG8_STAGE(PG8_SB(0, 1), cB + hstep, voffB); PG8_STAGE(PG8_SA(0, 1), cA + hstep, voffA);
        if (wr == 1) PG8_BAR;
        PG8_WAIT_V(4); PG8_BAR;
        PG8_STAGE(PG8_SB(1, 0), cB + kstep, voffB); PG8_STAGE(PG8_SA(1, 0), cA + kstep, voffA); PG8_STAGE(PG8_SB(1, 1), cB + hstep + kstep, voffB);
        PG8_WAIT_V(6); PG8_BAR;
    }
    for (;;) {
        const bool has_next = S.next(ui + 1, nxt);
        const char* nA = has_next ? (const char*)g.A + (size_t)nxt.pm * tstepA : cA; const char* nB = has_next ? (const char*)g.Bt + (size_t)nxt.pn * tstep : cB;
        if constexpr (GATHER) { if (has_next) load_g(ui + 1, ngA); else {
#pragma unroll
            for (int h = 0; h < 2; ++h)
#pragma unroll
                for (int i = 0; i < 2; ++i) ngA[h][i] = gA[h][i]; } }
        for (int t = 0; t < nt; t += 2) {
            const bool last = (t == nt - 2);
            const char* a1 = cA + (size_t)(t + 1) * kstep;
            const char* a2 = last ? nA : cA + (size_t)(t + 2) * kstep; const char* b2 = last ? nB : cB + (size_t)(t + 2) * kstep;
            const char* a3 = a2 + kstep; const char* b3 = b2 + kstep;
            if (last && has_next) S.a_ready(nxt);
            unsigned sN[2][2];
#pragma unroll
            for (int h = 0; h < 2; ++h)
#pragma unroll
                for (int i = 0; i < 2; ++i) sN[h][i] = last ? ngA[h][i] : gA[h][i];
            if constexpr (SP2) {
            PG8_LDB(B0, 0, 0); PG8_LDB(B1, 0, 1); PG8_SCHED; PG8_LDA(At, 0, 0); PG8_STAGE_A(PG8_SA(1, 1), a1 + hstepA, gA[1]);
            PG8_WAIT_V(8); PG8_WAIT_L(0); PG8_BAR; PG8_MMA(0, 0, At, B0); PG8_MMA(0, 1, At, B1); PG8_BAR; PG8_SCHED;
            PG8_LDA(At, 0, 1); PG8_STAGE(PG8_SB(0, 0), b2, voffB); PG8_STAGE(PG8_SB(0, 1), b2 + hstep, voffB); PG8_STAGE_A(PG8_SA(0, 0), a2, sN[0]);
            PG8_WAIT_V(8); PG8_WAIT_L(0); PG8_BAR; PG8_MMA(1, 0, At, B0); PG8_MMA(1, 1, At, B1); PG8_BAR; PG8_SCHED;
            PG8_LDB(B0, 1, 0); PG8_LDB(B1, 1, 1); PG8_SCHED; PG8_LDA(At, 1, 0); PG8_STAGE_A(PG8_SA(0, 1), a2 + hstepA, sN[1]);
            PG8_WAIT_V(8); PG8_WAIT_L(0); PG8_BAR; PG8_MMA(0, 0, At, B0); PG8_MMA(0, 1, At, B1); PG8_BAR; PG8_SCHED;
            PG8_LDA(At, 1, 1); PG8_STAGE(PG8_SB(1, 0), b3, voffB); PG8_STAGE(PG8_SB(1, 1), b3 + hstep, voffB); PG8_STAGE_A(PG8_SA(1, 0), a3, sN[0]);
            PG8_WAIT_V(8); PG8_WAIT_L(0); PG8_BAR; PG8_MMA(1, 0, At, B0); PG8_MMA(1, 1, At, B1); PG8_BAR; PG8_SCHED;
            } else {
            PG8_LDB(B0, 0, 0); PG8_SCHED; PG8_LDA(At, 0, 0); PG8_STAGE(PG8_SA(1, 1), a1 + hstep, voffA);
            PG8_WAIT_L(8); PG8_BAR; PG8_WAIT_L(0); PG8_MMA(0, 0, At, B0); PG8_BAR; PG8_SCHED;
            PG8_LDB(B1, 0, 1); PG8_STAGE(PG8_SB(0, 0), b2, voffB);
            PG8_BAR; PG8_WAIT_L(0); PG8_MMA(0, 1, At, B1); PG8_BAR;
            PG8_LDA(At, 0, 1); PG8_STAGE(PG8_SA(0, 0), a2, voffA);
            PG8_BAR; PG8_WAIT_L(0); PG8_MMA(1, 0, At, B0); PG8_BAR; PG8_SCHED;
            PG8_STAGE(PG8_SB(0, 1), b2 + hstep, voffB);
            PG8_WAIT_V(6); PG8_BAR; PG8_MMA(1, 1, At, B1); PG8_BAR;
            PG8_LDB(B0, 1, 0); PG8_SCHED; PG8_LDA(At, 1, 0); PG8_STAGE(PG8_SA(0, 1), a2 + hstep, voffA);
            PG8_WAIT_L(8); PG8_BAR; PG8_WAIT_L(0); PG8_MMA(0, 0, At, B0); PG8_BAR; PG8_SCHED;
            PG8_LDB(B1, 1, 1); PG8_STAGE(PG8_SB(1, 0), b3, voffB);
            PG8_BAR; PG8_WAIT_L(0); PG8_MMA(0, 1, At, B1); PG8_BAR;
            PG8_LDA(At, 1, 1); PG8_STAGE(PG8_SA(1, 0), a3, voffA);
            PG8_BAR; PG8_WAIT_L(0); PG8_MMA(1, 0, At, B0); PG8_BAR; PG8_SCHED;
            PG8_STAGE(PG8_SB(1, 1), b3 + hstep, voffB);
            PG8_WAIT_V(6); PG8_BAR; PG8_MMA(1, 1, At, B1); PG8_BAR;
            }
            if constexpr (Epi::KHOOK) { constexpr int HK = FP8 ? 4 : 8, HS = FP8 ? 2 : 3;
                if ((((t + 2) & (HK - 1)) == 0) && (t + 2 < nt)) { if constexpr (FP8) xdl_settle(); E.khook(acc, ((t + 2) >> HS) - 1, wr, fr); if constexpr (FP8) xdl_settle(); } }
        }
        if constexpr (ALIGN_EPI) { if (wr == 0) PG8_BAR; }
        if constexpr (FP8) {
            xdl_settle();
        }
        if constexpr (!Epi::AFTER_DRAIN) { E(acc, cur, wr, wc, fr, fq); S.done(cur); }
        if (!has_next) break;
#pragma unroll
        for (int a = 0; a < 2; ++a)
#pragma unroll
            for (int b = 0; b < 2; ++b)
#pragma unroll
                for (int m = 0; m < 4; ++m)
#pragma unroll
                    for (int n = 0; n < 2; ++n) acc[a][b][m][n] = (f32x4){0.f, 0.f, 0.f, 0.f};
        cur = nxt; cA = nA; cB = nB; ++ui;
        if constexpr (GATHER) {
#pragma unroll
            for (int h = 0; h < 2; ++h)
#pragma unroll
                for (int i = 0; i < 2; ++i) gA[h][i] = ngA[h][i]; }
        if constexpr (ALIGN_EPI) { if (wr == 1) PG8_BAR; }
    }
    PG8_WAIT_V(0);
    if constexpr (!ALIGN_EPI) { if (wr == 0) PG8_BAR; }
    PG8_BAR;
    if constexpr (Epi::AFTER_DRAIN) { E.fused(acc, cur, wr, wc, fr, fq, lds, wid, lane); S.done(cur); }
#undef PG8_SA
#undef PG8_SB
#undef PG8_STAGE
#undef PG8_STAGE_A
#undef PG8_LDA
#undef PG8_LDB
#undef PG8_MMA
#undef PG8_WAIT_V
#undef PG8_WAIT_L
#undef PG8_BAR
#undef PG8_SCHED
}
}

#define DI __device__ __forceinline__
#define GAS __attribute__((address_space(1)))
#define LAS __attribute__((address_space(3)))
typedef unsigned short bf16;
typedef unsigned v4u __attribute__((ext_vector_type(4)));
typedef unsigned v2u __attribute__((ext_vector_type(2)));
typedef float f32x4 __attribute__((ext_vector_type(4)));
typedef float f32x16 __attribute__((ext_vector_type(16)));
typedef short bf16x8 __attribute__((ext_vector_type(8)));
typedef __bf16 bf2v __attribute__((ext_vector_type(2)));
typedef float f2v __attribute__((ext_vector_type(2)));
typedef GAS unsigned gu32;

constexpr int NWAVES = 8, NTHREADS = 512;
constexpr int M = 16384, D = 1024, DIN = 2048, NH = 32, HD = 64, NGRP = 4, NST = 128, XBCW = 3072;
constexpr int NPROJ = 9216, WIN_LD = 9248;
constexpr int LCH = 128, NCH = M / LCH;
constexpr int NE = 64, DFF = 512;
constexpr float EPS = 1e-6f;
constexpr float LOG2E = 1.4426950408889634f;

constexpr size_t MiB = 1u << 20;
constexpr size_t WS_CTL = 0, CTL_ZERO_BYTES = 262144;
constexpr size_t WS_WIN = 1 * MiB, WS_WDT = 19 * MiB, WS_WCV = 20 * MiB, WS_WMIX = 22 * MiB, WS_WSSM = 24 * MiB;
constexpr size_t WS_RSTD = 31 * MiB + 524288;
constexpr size_t WS_DT = 28 * MiB, WS_CD = 30 * MiB, WS_WRH = 30 * MiB + 65536, WS_WRL = WS_WRH + 262144, WS_ROUTE = 31 * MiB;
constexpr size_t WS_ST = 32 * MiB, WS_YS = 96 * MiB, WS_TMP = 160 * MiB, WS_MG = 192 * MiB;
constexpr size_t WS_W13 = 32 * MiB, WS_W2 = 160 * MiB, WS_H16 = 96 * MiB;
constexpr size_t WS_XN8 = 32 * MiB, WS_W8IN = 48 * MiB, WS_SA = 60 * MiB, WS_SW = 61 * MiB;
constexpr size_t WS_XN = 224 * MiB;
constexpr size_t WS_U = 256 * MiB, WS_ZS = 288 * MiB, WS_XBC = 352 * MiB, WS_GATE = 448 * MiB;
constexpr size_t WS_LIST = 256 * MiB, WS_HDN = 352 * MiB, WS_YEXP = 400 * MiB;
constexpr size_t WS_END = 512 * MiB;
constexpr int CW_BAR = 4096;
constexpr int CW_CNT = 8192;
constexpr int CW_MODC = 40960;
constexpr int CW_WMAX = 49152;
constexpr int CW_MOD = 16384;

constexpr int RING_BYTES = 131072;
constexpr int LDSCTL_OFF = 147456;
constexpr int TB_OFF = LDSCTL_OFF + 256;
constexpr int CNTL_OFF = TB_OFF + 320;
constexpr int TOKL_OFF = LDSCTL_OFF + 1024;
constexpr int RT_OFF = 148480;
constexpr int LDS_BYTES = 152576;

#define LDS_WAIT() asm volatile("s_waitcnt lgkmcnt(0)" ::: "memory")
#define VM_WAIT() asm volatile("s_waitcnt vmcnt(0)" ::: "memory")

DI unsigned pk2(float lo, float hi) { f2v v = {lo, hi}; return __builtin_bit_cast(unsigned, __builtin_convertvector(v, bf2v)); }
DI unsigned pk4_fp8(float a, float b, float c, float d) {
    a = __builtin_fminf(__builtin_fmaxf(a, -448.f), 448.f); b = __builtin_fminf(__builtin_fmaxf(b, -448.f), 448.f);
    c = __builtin_fminf(__builtin_fmaxf(c, -448.f), 448.f); d = __builtin_fminf(__builtin_fmaxf(d, -448.f), 448.f);
    unsigned w = 0u; w = __builtin_amdgcn_cvt_pk_fp8_f32(a, b, w, false); w = __builtin_amdgcn_cvt_pk_fp8_f32(c, d, w, true); return w; }
DI unsigned pk4_fp8_nc(float a, float b, float c, float d) { unsigned w = 0u; w = __builtin_amdgcn_cvt_pk_fp8_f32(a, b, w, false); w = __builtin_amdgcn_cvt_pk_fp8_f32(c, d, w, true); return w; }
DI unsigned pk4_i8(float a, float b, float c, float d) {
    const int ia = (int)__builtin_rintf(a), ib = (int)__builtin_rintf(b), ic = (int)__builtin_rintf(c), id = (int)__builtin_rintf(d);
    return ((unsigned)ia & 255u) | (((unsigned)ib & 255u) << 8) | (((unsigned)ic & 255u) << 16) | ((unsigned)id << 24); }
DI float bflo(unsigned u) { return __uint_as_float(u << 16); }
DI float bfhi(unsigned u) { return __uint_as_float(u & 0xffff0000u); }
DI float sigmoidf_(float x) { return __builtin_amdgcn_rcpf(1.f + __builtin_amdgcn_exp2f(x * -LOG2E)); }
DI float siluf_(float x) { return x * __builtin_amdgcn_rcpf(1.f + __builtin_amdgcn_exp2f(x * -LOG2E)); }
DI float wave_sum(float v) {
#pragma unroll
    for (int o = 1; o < 64; o <<= 1) v += __shfl_xor(v, o);
    return v;
}
DI f32x4 mod4(const float* modp, int k) { return (*(const f32x4*)(modp + k) + *(const f32x4*)(modp + 6144 + k)) + (*(const f32x4*)(modp + 2 * 6144 + k) + *(const f32x4*)(modp + 3 * 6144 + k)); }
DI int crow(int reg, int hh) { return (reg & 3) + 8 * (reg >> 2) + 4 * hh; }
DI int swz(int row, int chunk) { return chunk ^ ((row ^ (row >> 3)) & 15); }
#define MFMA32(a, b, c) __builtin_amdgcn_mfma_f32_32x32x16_bf16((a), (b), (c), 0, 0, 0)

DI int lane_id() { return (int)__builtin_amdgcn_mbcnt_hi(~0u, __builtin_amdgcn_mbcnt_lo(~0u, 0u)); }
#define XB_TMO      128
#define XB_XCNT(j)  (256  + 64 * (j))
#define XB_XSUB(j)  (1280 + 64 * (j))
#define XB_XGEN(j)  (2304 + 64 * (j))
#define XB_TOP      3328
#define XB_TOPGEN   3392
#define XCD_BAR_WORDS 3456
#define XB_SPIN_CAP (1u << 18)
DI unsigned xb_ld(unsigned* p)              { return __hip_atomic_load(p, __ATOMIC_RELAXED, __HIP_MEMORY_SCOPE_AGENT); }
DI unsigned xb_add(unsigned* p, unsigned v) { return __hip_atomic_fetch_add(p, v, __ATOMIC_RELAXED, __HIP_MEMORY_SCOPE_AGENT); }
DI unsigned xb_xcc_id() { return (unsigned)__builtin_amdgcn_s_getreg((3 << 11) | 20) & 0xFu; }
#define XB_SPIN(cond, bar) do { unsigned _sp = 0; while (cond) { __builtin_amdgcn_s_sleep(1); \
    if ((++_sp & 255u) == 0u) { if (xb_ld(&(bar)[XB_TMO])) break; if (_sp > XB_SPIN_CAP) { atomicAdd(&(bar)[XB_TMO], 1u); break; } } } } while (0)
struct XcdBarrier { unsigned* bar; unsigned x; volatile LAS unsigned* st; int wave; };
DI XcdBarrier xcd_barrier_post(unsigned* bar, volatile LAS unsigned* st) {
    XcdBarrier b; b.bar = bar; b.x = xb_xcc_id(); b.st = st; b.wave = 0;
    if (threadIdx.x == 0) (void)xb_add(&bar[XB_XCNT(b.x)], 1u);
    return b;
}
DI void xcd_barrier_complete(unsigned* bar, unsigned x, unsigned& nloc, unsigned& nx) {
    const unsigned G = gridDim.x * gridDim.y * gridDim.z;
    unsigned sum, cnt, mine, sp = 0u;
    for (;;) {
        sum = 0u; cnt = 0u; mine = 0u;
#pragma unroll
        for (unsigned j = 0; j < 16; ++j) { const unsigned c = xb_ld(&bar[XB_XCNT(j)]); sum += c; cnt += (c > 0u) ? 1u : 0u; mine = (j == x) ? c : mine; }
        if (sum == G) break;
        __builtin_amdgcn_s_sleep(1);
        if ((++sp & 255u) == 0u) { if (xb_ld(&bar[XB_TMO])) break; if (sp > XB_SPIN_CAP) { atomicAdd(&bar[XB_TMO], 1u); break; } }
    }
    nloc = mine > 0u ? mine : 1u; nx = cnt > 0u ? cnt : 1u;
}
DI void xcd_barrier(const XcdBarrier& b) {
    asm volatile("s_waitcnt vmcnt(0)" ::: "memory");
    __syncthreads();
    if (b.wave == 0 && lane_id() == 0) {
        unsigned* bar = b.bar;
        __builtin_amdgcn_s_waitcnt(0);
        unsigned nloc = b.st[0], nx = b.st[1];
        if (nloc == 0u) { xcd_barrier_complete(bar, b.x, nloc, nx); b.st[0] = nloc; b.st[1] = nx; }
        const unsigned old = xb_add(&bar[XB_XSUB(b.x)], 1u);
        const unsigned gen = old / nloc;
        if (old + 1u == (gen + 1u) * nloc) {
            __builtin_amdgcn_fence(__ATOMIC_RELEASE, "agent");
            asm volatile("s_waitcnt vmcnt(0)" ::: "memory");
            const unsigned og = xb_add(&bar[XB_TOP], 1u);
            const unsigned tg = og / nx;
            if (og + 1u == (tg + 1u) * nx) xb_add(&bar[XB_TOPGEN], 1u);
            else XB_SPIN(xb_ld(&bar[XB_TOPGEN]) == tg, bar);
            __builtin_amdgcn_fence(__ATOMIC_ACQUIRE, "agent");
            xb_add(&bar[XB_XGEN(b.x)], 1u);
            asm volatile("s_waitcnt vmcnt(0)" ::: "memory");
        } else {
            XB_SPIN(xb_ld(&bar[XB_XGEN(b.x)]) == gen, bar);
            __builtin_amdgcn_fence(__ATOMIC_ACQUIRE, "agent");
            asm volatile("s_waitcnt vmcnt(0)" ::: "memory");
        }
    }
    __syncthreads();
}

enum { I_X = 0, I_C, I_WADA, I_BADA, I_N1G, I_WIN, I_CVW, I_CVB, I_LNG, I_LNB, I_WCV, I_SCW, I_SCB, I_DTB, I_ALOG, I_DSKIP, I_SNG, I_WSSM, I_WMIX,
       I_N2G, I_WGRP, I_BGRP, I_WER, I_BER, I_W1, I_W3, I_W2, I_FG, N_IN };
struct Args { const float* in[N_IN]; float* out; unsigned char* ws; int ph_lo, ph_hi; };

template <int I> DI const float* argp() {
    auto kp = __builtin_amdgcn_kernarg_segment_ptr();
    unsigned long long v;
    asm volatile("s_load_dwordx2 %0, %1, %2\n\ts_waitcnt lgkmcnt(0)" : "=s"(v) : "s"(kp), "i"(I * 8));
    return (const float*)(const GAS float*)v;
}
#define ARG(i) argp<i>()
struct Ctx {
    LAS unsigned char* lds;
    int wave, vcu, G, xcd, xj;
    unsigned char* ws;
};

DI int xcd_unit(int x, int j, int gx, int i, int N) { const int u = i * gx + j; return (u < (N >> 3)) ? x * (N >> 3) + u : -1; }
DI int inproj_tile(int p) { return p < 8 ? p + 8 : (p < 16 ? p + 20 : (p < 24 ? p - 16 : p - 8)); }
DI int win_col(int npp) { const int np = inproj_tile(npp >> 8) * 256 + (npp & 255);
    if (np < 2048) { const int q = np >> 3, rr = np & 7; return (rr >> 2) * 1024 + 4 * q + (rr & 3); } return np < 7168 ? np : np + 32; }
struct EpiInProj {
    static constexpr bool PERM = true, AFTER_DRAIN = false, KHOOK = false; static constexpr int NPF = 0;
    unsigned char* ws;
    DI static pg8::f32x4 cvt(const pg8::f32x4& a, float sr, const f32x4& sc) { const pg8::v4i_ q = __builtin_bit_cast(pg8::v4i_, a);
        return (pg8::f32x4){(float)q[0] * (sr * sc.x), (float)q[1] * (sr * sc.y), (float)q[2] * (sr * sc.z), (float)q[3] * (sr * sc.w)}; }
    DI void operator()(const pg8::f32x4 (&acc)[2][2][4][2], const pg8::Unit& u, int wr, int wc, int fr, int fq) const {
        const int pn = inproj_tile(u.pn), row0 = u.pm * 256 + wr * 64 + fr;
        const float* SA = (const float*)(ws + WS_SA); const float* SW = (const float*)(ws + WS_SW) + u.pn * 256 + wc * 32 + fq * 8;
        f32x4 sc[2][2];
#pragma unroll
        for (int bj = 0; bj < 2; ++bj) { sc[bj][0] = *(const f32x4*)(SW + bj * 128); sc[bj][1] = *(const f32x4*)(SW + bj * 128 + 4); }
        float sr[2][4];
#pragma unroll
        for (int ai = 0; ai < 2; ++ai)
#pragma unroll
            for (int m = 0; m < 4; ++m) sr[ai][m] = SA[row0 + ai * 128 + m * 16];
        if (pn < 8) {
            bf16* U = (bf16*)(ws + WS_U);
#pragma unroll
            for (int ai = 0; ai < 2; ++ai)
#pragma unroll
                for (int m = 0; m < 4; ++m) {
                    bf16* rowp = U + (size_t)(row0 + ai * 128 + m * 16) * D + pn * 128 + wc * 16 + fq * 4;
#pragma unroll
                    for (int bj = 0; bj < 2; ++bj) { const pg8::f32x4 a = cvt(acc[ai][bj][m][0], sr[ai][m], sc[bj][0]), b = cvt(acc[ai][bj][m][1], sr[ai][m], sc[bj][1]);
                        v2u w; w.x = pk2(a[0] * sigmoidf_(b[0]), a[1] * sigmoidf_(b[1])); w.y = pk2(a[2] * sigmoidf_(b[2]), a[3] * sigmoidf_(b[3]));
                        *(v2u*)(rowp + bj * 64) = w; } }
        } else {
            const bool isz = pn < 16, isx = (pn >= 16) && (pn < 28);
            const size_t boff = isz ? WS_ZS : (isx ? WS_XBC : WS_GATE);
            const int ldc = isx ? XBCW : DIN;
            const int colt = (pn - (isz ? 8 : (isx ? 16 : 28))) * 256;
            bf16* base = (bf16*)(ws + boff);
            const int col0 = colt + wc * 32 + fq * 8;
#pragma unroll
            for (int ai = 0; ai < 2; ++ai)
#pragma unroll
                for (int m = 0; m < 4; ++m) {
                    bf16* rowp = base + (size_t)(row0 + ai * 128 + m * 16) * ldc + col0;
#pragma unroll
                    for (int bj = 0; bj < 2; ++bj) { pg8::f32x4 v0 = cvt(acc[ai][bj][m][0], sr[ai][m], sc[bj][0]), v1 = cvt(acc[ai][bj][m][1], sr[ai][m], sc[bj][1]);
                        if (isz) {
#pragma unroll
                            for (int i = 0; i < 4; ++i) { v0[i] = v0[i] * sigmoidf_(v0[i]); v1[i] = v1[i] * sigmoidf_(v1[i]); }
                        }
                        if (!isz && !isx) {
                            v2u w8; w8.x = pk4_fp8(v0[0], v0[1], v0[2], v0[3]); w8.y = pk4_fp8(v1[0], v1[1], v1[2], v1[3]);
                            *(v2u*)((unsigned char*)base + (size_t)(row0 + ai * 128 + m * 16) * ldc + col0 + bj * 128) = w8;
                        } else {
                        v4u w; w.x = pk2(v0[0], v0[1]); w.y = pk2(v0[2], v0[3]); w.z = pk2(v1[0], v1[1]); w.w = pk2(v1[2], v1[3]);
                        *(v4u*)(rowp + bj * 128) = w; } } }
        }
    }
};
template <bool NORM> struct EpiGate {
    static constexpr bool PERM = true, AFTER_DRAIN = false, KHOOK = NORM;
    bf16* O; const bf16* P; const bf16* GATE; int gcol; const LAS float* rt;
    DI void khook(pg8::f32x4 (&acc)[2][2][4][2], int b, int wr, int fr) const {
#pragma unroll
        for (int ai = 0; ai < 2; ++ai)
#pragma unroll
            for (int m = 0; m < 4; ++m) { const float f = rt[(ai * 128 + wr * 64 + m * 16 + fr) * 4 + b];
#pragma unroll
                for (int bj = 0; bj < 2; ++bj)
#pragma unroll
                    for (int n = 0; n < 2; ++n) acc[ai][bj][m][n] = acc[ai][bj][m][n] * f; }
    }
    DI void operator()(const pg8::f32x4 (&acc)[2][2][4][2], const pg8::Unit& u, int wr, int wc, int fr, int fq) const {
        const int row0 = u.pm * 256 + wr * 64 + fr, col0 = u.pn * 256 + wc * 32 + fq * 8;
        v2u g[4]; v4u p[4], wA[4], wB[4];
        auto loadq = [&](int bj, int ai) {
#pragma unroll
            for (int m = 0; m < 4; ++m) { const size_t r = (size_t)(row0 + ai * 128 + m * 16); const int c = col0 + bj * 128;
                g[m] = *(const v2u*)((const unsigned char*)GATE + r * (2 * D) + gcol + c); if (NORM) p[m] = *(const v4u*)(P + r * D + c); }
        };
        auto calcq = [&](int bj, int ai, v4u (&w)[4]) {
#pragma unroll
            for (int m = 0; m < 4; ++m) {
                float f = 1.0f; if (NORM) f = rt[(ai * 128 + wr * 64 + m * 16 + fr) * 4 + 3];
                const v2u gg = g[m];
                pg8::f32x4 v0 = acc[ai][bj][m][0] * f, v1 = acc[ai][bj][m][1] * f;
                float o[8] = {v0[0] * sigmoidf_(__builtin_amdgcn_cvt_f32_fp8(gg.x, 0)), v0[1] * sigmoidf_(__builtin_amdgcn_cvt_f32_fp8(gg.x, 1)), v0[2] * sigmoidf_(__builtin_amdgcn_cvt_f32_fp8(gg.x, 2)), v0[3] * sigmoidf_(__builtin_amdgcn_cvt_f32_fp8(gg.x, 3)),
                              v1[0] * sigmoidf_(__builtin_amdgcn_cvt_f32_fp8(gg.y, 0)), v1[1] * sigmoidf_(__builtin_amdgcn_cvt_f32_fp8(gg.y, 1)), v1[2] * sigmoidf_(__builtin_amdgcn_cvt_f32_fp8(gg.y, 2)), v1[3] * sigmoidf_(__builtin_amdgcn_cvt_f32_fp8(gg.y, 3))};
                if (NORM) { const v4u pp = p[m];
                    o[0] += bflo(pp.x); o[1] += bfhi(pp.x); o[2] += bflo(pp.y); o[3] += bfhi(pp.y); o[4] += bflo(pp.z); o[5] += bfhi(pp.z); o[6] += bflo(pp.w); o[7] += bfhi(pp.w); }
                w[m].x = pk2(o[0], o[1]); w[m].y = pk2(o[2], o[3]); w[m].z = pk2(o[4], o[5]); w[m].w = pk2(o[6], o[7]); }
        };
        auto storeq = [&](int bj, int ai, const v4u (&w)[4]) {
#pragma unroll
            for (int m = 0; m < 4; ++m) *(v4u*)(O + (size_t)(row0 + ai * 128 + m * 16) * D + col0 + bj * 128) = w[m];
        };
        loadq(0, 0); calcq(0, 0, wA); loadq(0, 1); storeq(0, 0, wA); calcq(0, 1, wB); loadq(1, 0); storeq(0, 1, wB); calcq(1, 0, wA); loadq(1, 1); storeq(1, 0, wA); calcq(1, 1, wB); storeq(1, 1, wB);
    }
};
struct EpiMix {
    static constexpr bool PERM = true, AFTER_DRAIN = false, KHOOK = false;
    bf16* H; const float* X; const float* g1;
    DI void operator()(const pg8::f32x4 (&acc)[2][2][4][2], const pg8::Unit& u, int wr, int wc, int fr, int fq) const {
        const int row0 = u.pm * 256 + wr * 64 + fr, col0 = u.pn * 256 + wc * 32 + fq * 8;
        f32x4 xa[4], xb[4]; v4u wA[4], wB[4];
        auto loadq = [&](int bj, int ai) {
#pragma unroll
            for (int m = 0; m < 4; ++m) { const size_t off = (size_t)(row0 + ai * 128 + m * 16) * D + col0 + bj * 128;
                xa[m] = __builtin_nontemporal_load((const f32x4*)(X + off)); xb[m] = __builtin_nontemporal_load((const f32x4*)(X + off + 4)); }
        };
        auto calcq = [&](int bj, int ai, v4u (&w)[4]) { const int c = col0 + bj * 128;
            const f32x4 ga = *(const f32x4*)(g1 + c), gb = *(const f32x4*)(g1 + c + 4);
#pragma unroll
            for (int m = 0; m < 4; ++m) { const f32x4 ha = xa[m] + ga * acc[ai][bj][m][0], hb = xb[m] + gb * acc[ai][bj][m][1];
                w[m].x = pk2(ha.x, ha.y); w[m].y = pk2(ha.z, ha.w); w[m].z = pk2(hb.x, hb.y); w[m].w = pk2(hb.z, hb.w); }
        };
        auto storeq = [&](int bj, int ai, const v4u (&w)[4]) {
#pragma unroll
            for (int m = 0; m < 4; ++m) *(v4u*)(H + (size_t)(row0 + ai * 128 + m * 16) * D + col0 + bj * 128) = w[m];
        };
        loadq(0, 0); calcq(0, 0, wA); loadq(0, 1); storeq(0, 0, wA); calcq(0, 1, wB); loadq(1, 0); storeq(0, 1, wB); calcq(1, 0, wA); loadq(1, 1); storeq(1, 0, wA); calcq(1, 1, wB); storeq(1, 1, wB);
    }
};
struct EpiUp {
    static constexpr bool PERM = true, AFTER_DRAIN = false, KHOOK = false;
    unsigned char* HDN;
    DI void operator()(const pg8::f32x4 (&acc)[2][2][4][2], const pg8::Unit& u, int wr, int wc, int fr, int fq) const {
        const int j = u.pn & 3, row0 = u.pm * 256 + wr * 64 + fr, col0 = j * 128 + wc * 16 + fq * 4;
#pragma unroll
        for (int ai = 0; ai < 2; ++ai)
#pragma unroll
            for (int m = 0; m < 4; ++m) { unsigned char* rowp = HDN + (size_t)(row0 + ai * 128 + m * 16) * DFF + col0;
#pragma unroll
                for (int bj = 0; bj < 2; ++bj) { const pg8::f32x4 a = acc[ai][bj][m][0], b = acc[ai][bj][m][1];
                    *(unsigned*)(rowp + bj * 64) = pk4_fp8(siluf_(a[0]) * b[0], siluf_(a[1]) * b[1], siluf_(a[2]) * b[2], siluf_(a[3]) * b[3]); } }
    }
};
struct EpiDown {
    static constexpr bool PERM = true, AFTER_DRAIN = false, KHOOK = false;
    unsigned char* Y;
    DI void operator()(const pg8::f32x4 (&acc)[2][2][4][2], const pg8::Unit& u, int wr, int wc, int fr, int fq) const {
        const int j = u.pn & 3, row0 = u.pm * 256 + wr * 64 + fr, col0 = j * 256 + wc * 32 + fq * 8;
#pragma unroll
        for (int ai = 0; ai < 2; ++ai)
#pragma unroll
            for (int m = 0; m < 4; ++m) { unsigned char* rowp = Y + (size_t)(row0 + ai * 128 + m * 16) * D + col0;
#pragma unroll
                for (int bj = 0; bj < 2; ++bj) { const pg8::f32x4 v0 = acc[ai][bj][m][0] * 16.0f, v1 = acc[ai][bj][m][1] * 16.0f;
                    v2u w; w.x = pk4_fp8(v0[0], v0[1], v0[2], v0[3]); w.y = pk4_fp8(v1[0], v1[1], v1[2], v1[3]);
                    *(v2u*)(rowp + bj * 128) = w; } }
    }
};
struct MoeOrder {
    const LAS int* tb; int G, c, total, reps; const LAS int* tokl;
    DI bool next(int i0, pg8::Unit& u) const {
        const int n = (total - c + G - 1) / G; if (n <= 0 || i0 >= n * reps) return false;
        const int i = i0 % n; const int uu = i * G + c;
        const int T = uu >> 2; int e = 0;
        while (e < NE - 1 && tb[e + 1] <= T) ++e;
        u.pm = T; u.pn = 4 * e + (uu & 3); return true;
    }
    DI void a_ready(const pg8::Unit&) const {}
    DI void done(const pg8::Unit&) const {}
};

struct OneUnit { pg8::Unit u;
    DI bool next(int i, pg8::Unit& o) const { if (i != 0) return false; o = u; return true; }
    DI void a_ready(const pg8::Unit&) const {}
    DI void done(const pg8::Unit&) const {} };

template <class SrcF>
DI void transpose_item(SrcF src, int K, bf16* WT, LAS float* scr, int kb, int n0, int lane) {
    const int k0 = 64 * kb;
#pragma unroll 8
    for (int i = 0; i < 32; ++i) { const int kk = 2 * i + (lane >> 5); scr[kk * 33 + (lane & 31)] = src(k0 + kk, n0 + (lane & 31)); }
    LDS_WAIT(); asm volatile("" ::: "memory");
    const int c = lane & 7;
#pragma unroll
    for (int j = 0; j < 4; ++j) { const int n = (lane >> 3) + 8 * j; const LAS float* s = scr + (8 * c) * 33 + n;
        v4u o; o.x = pk2(s[0 * 33], s[1 * 33]); o.y = pk2(s[2 * 33], s[3 * 33]); o.z = pk2(s[4 * 33], s[5 * 33]); o.w = pk2(s[6 * 33], s[7 * 33]);
        *(v4u*)(WT + (size_t)(n0 + n) * K + k0 + 8 * c) = o; }
    LDS_WAIT(); asm volatile("" ::: "memory");
}

template <class SrcF>
DI void transpose_item8(SrcF src, int K, unsigned char* WT, LAS float* scr, int kb, int n0, int lane) {
    const int k0 = 64 * kb;
#pragma unroll 8
    for (int i = 0; i < 32; ++i) { const int kk = 2 * i + (lane >> 5); scr[kk * 33 + (lane & 31)] = src(k0 + kk, n0 + (lane & 31)) * 64.0f; }
    LDS_WAIT(); asm volatile("" ::: "memory");
#pragma unroll
    for (int i = 0; i < 2; ++i) { const int p = lane + 64 * i, n = p >> 2, c = p & 3; const LAS float* s = scr + (16 * c) * 33 + n;
        v4u o; o.x = pk4_fp8(s[0 * 33], s[1 * 33], s[2 * 33], s[3 * 33]); o.y = pk4_fp8(s[4 * 33], s[5 * 33], s[6 * 33], s[7 * 33]);
        o.z = pk4_fp8(s[8 * 33], s[9 * 33], s[10 * 33], s[11 * 33]); o.w = pk4_fp8(s[12 * 33], s[13 * 33], s[14 * 33], s[15 * 33]);
        *(v4u*)(WT + (size_t)(n0 + n) * K + k0 + 16 * c) = o; }
    LDS_WAIT(); asm volatile("" ::: "memory");
}

template <class SrcF>
DI void transpose_item_i8(SrcF src, float inv, int K, unsigned char* WT, LAS float* scr, int kb, int n0, int lane) {
    const int k0 = 64 * kb;
#pragma unroll 8
    for (int i = 0; i < 32; ++i) { const int kk = 2 * i + (lane >> 5); scr[kk * 33 + (lane & 31)] = src(k0 + kk, n0 + (lane & 31)) * inv; }
    LDS_WAIT(); asm volatile("" ::: "memory");
#pragma unroll
    for (int i = 0; i < 2; ++i) { const int p = lane + 64 * i, n = p >> 2, c = p & 3; const LAS float* s = scr + (16 * c) * 33 + n;
        v4u o; o.x = pk4_i8(s[0 * 33], s[1 * 33], s[2 * 33], s[3 * 33]); o.y = pk4_i8(s[4 * 33], s[5 * 33], s[6 * 33], s[7 * 33]);
        o.z = pk4_i8(s[8 * 33], s[9 * 33], s[10 * 33], s[11 * 33]); o.w = pk4_i8(s[12 * 33], s[13 * 33], s[14 * 33], s[15 * 33]);
        *(v4u*)(WT + (size_t)(n0 + n) * K + k0 + 16 * c) = o; }
    LDS_WAIT(); asm volatile("" ::: "memory");
}

DI void ph0_prologue(const Ctx& F, const Args& a, int reps) {
    const int gw = F.vcu * NWAVES + F.wave, NGW = F.G * NWAVES, lane = lane_id();
    float* mod = (float*)(F.ws + WS_CTL) + CW_MOD;
    {
        const float* cvec = ARG(I_C); const float* wada = ARG(I_WADA); const float* bada = ARG(I_BADA);
        const int r8 = lane >> 3, c4 = lane & 7;
        for (int item0 = gw; item0 < 768 * reps; item0 += NGW) {
            const int item = item0 % 768; const int cc = item % 192, kq = item / 192;
            f32x4 acc = {0.f, 0.f, 0.f, 0.f};
#pragma unroll 8
            for (int i = 0; i < 32; ++i) { const int k = kq * 256 + i * 8 + r8; const float cv = cvec[k]; const float s = siluf_(cv);
                const f32x4 w = *(const f32x4*)(wada + (size_t)k * (6 * D) + cc * 32 + c4 * 4); acc += s * w; }
#pragma unroll
            for (int j = 0; j < 4; ++j) { float v = acc[j]; v += __shfl_xor(v, 8); v += __shfl_xor(v, 16); v += __shfl_xor(v, 32); acc[j] = v; }
            if (lane < 8) {
#pragma unroll
                for (int j = 0; j < 4; ++j) { float v = acc[j]; if (kq == 0) v += bada[cc * 32 + c4 * 4 + j]; mod[kq * 6144 + cc * 32 + c4 * 4 + j] = v; }
            }
        }
    }
    LAS float* scr = (LAS float*)(F.lds + F.wave * 16384);
    const float* win = ARG(I_WIN); const float* wcv = ARG(I_WCV); const float* wmix = ARG(I_WMIX); const float* wssm = ARG(I_WSSM);
    bf16* Win_t = (bf16*)(F.ws + WS_WIN); bf16* Wdt_t = (bf16*)(F.ws + WS_WDT); bf16* Wcv_t = (bf16*)(F.ws + WS_WCV);
    bf16* Wmix_t = (bf16*)(F.ws + WS_WMIX); bf16* Wssm_t = (bf16*)(F.ws + WS_WSSM);
    constexpr int I_IN = 16 * 288, I_DT = 16, I_CV = 16 * 32, I_MX = 16 * 32, I_SS = 32 * 32, I_RT = 16 * 3 * 2;
    constexpr int NITEMS = I_IN + I_DT + I_CV + I_MX + I_SS + I_RT;
    const float* wer = ARG(I_WER); const float* wgrp = ARG(I_WGRP); const float* sng0 = ARG(I_SNG);
    for (int it0 = gw; it0 < NITEMS * reps; it0 += NGW) {
        int r = it0 % NITEMS;
        if (r < I_IN) { const int kb = r / 288, nb = r % 288;
            const int npp = nb * 32 + (lane & 31), col = win_col(npp);
            float mx = 0.f;
#pragma unroll 8
            for (int i = 0; i < 32; ++i) mx = __builtin_fmaxf(mx, __builtin_fabsf(win[(size_t)(64 * kb + 2 * i + (lane >> 5)) * WIN_LD + col]));
            mx = __builtin_fmaxf(mx, __shfl_xor(mx, 32));
            if (lane < 32) atomicMax((unsigned*)(F.ws + WS_CTL) + CW_WMAX + npp, __float_as_uint(mx));
            continue; } r -= I_IN;
        if (r < I_DT) { transpose_item([&](int k, int np) -> float { return win[(size_t)k * WIN_LD + 7168 + np]; }, D, Wdt_t, scr, r, 0, lane); continue; } r -= I_DT;
        if (r < I_CV) { transpose_item([&](int k, int np) -> float { return wcv[(size_t)k * D + np]; }, D, Wcv_t, scr, r / 32, (r % 32) * 32, lane); continue; } r -= I_CV;
        if (r < I_MX) { transpose_item([&](int k, int np) -> float { return wmix[(size_t)k * D + np]; }, D, Wmix_t, scr, r / 32, (r % 32) * 32, lane); continue; } r -= I_MX;
        if (r < I_SS) { transpose_item8([&](int k, int np) -> float { return wssm[(size_t)k * D + np] * sng0[k]; }, DIN, (unsigned char*)Wssm_t, scr, r / 32, (r % 32) * 32, lane); continue; } r -= I_SS;
        {
            const int lo = r / 48, rr = r % 48, kb = rr / 3, nb = rr % 3;
            auto wsrc = [&](int k, int np) -> float { float w = 0.f; if (np < 64) w = wer[(size_t)k * NE + np]; else if (np < 72) w = wgrp[(size_t)k * 8 + (np - 64)];
                const float hi = bflo(pk2(w, 0.f)); return lo ? (w - hi) : hi; };
            transpose_item(wsrc, D, (bf16*)(F.ws + (lo ? WS_WRL : WS_WRH)), scr, kb, nb * 32, lane);
        }
    }
}

DI void convert_experts(const Ctx& F, const Args& a) {
    const int gw = F.vcu * NWAVES + F.wave, NGW = F.G * NWAVES, lane = lane_id();
    LAS float* scr = (LAS float*)(F.lds + F.wave * 17408);
    const float* w1 = ARG(I_W1); const float* w3 = ARG(I_W3); const float* w2 = ARG(I_W2);
    unsigned char* W13_t = F.ws + WS_W13; unsigned char* W2_t = F.ws + WS_W2;
    constexpr int I_13 = NE * 4 * 16, I_2 = NE * 2 * 16, NIT = I_13 + I_2;
    const int ch = lane & 15, kq = lane >> 4;
    for (int it = gw; it < NIT; it += NGW) {
        const float* src; size_t ld; unsigned char* dst;
        if (it < I_13) { const int e = it >> 6, r = it & 63, kb = r >> 4, cb = r & 15;
            src = ((ch & 1) ? w3 : w1) + (size_t)e * D * DFF + (size_t)(256 * kb + kq) * DFF + 32 * cb + 4 * (ch >> 1); ld = DFF;
            dst = W13_t + (size_t)e * D * D + (size_t)(64 * cb + lane) * D + 256 * kb;
        } else { const int r0 = it - I_13, e = r0 >> 5, r = r0 & 31, kb = r >> 4, nb = r & 15;
            src = w2 + (size_t)e * DFF * D + (size_t)(256 * kb + kq) * D + 64 * nb + 4 * ch; ld = D;
            dst = W2_t + (size_t)e * D * DFF + (size_t)(64 * nb + lane) * DFF + 256 * kb;
        }
        f32x4 va[16], vb[16]; v4u o[16];
#pragma unroll
        for (int i = 0; i < 16; ++i) va[i] = __builtin_nontemporal_load((const f32x4*)(src + (size_t)(4 * i) * ld));
#pragma unroll
        for (int sub = 0; sub < 4; ++sub) {
            f32x4 (&cur)[16] = (sub & 1) ? vb : va; f32x4 (&nxt)[16] = (sub & 1) ? va : vb;
            if (sub < 3) {
#pragma unroll
                for (int i = 0; i < 16; ++i) nxt[i] = __builtin_nontemporal_load((const f32x4*)(src + (size_t)(64 * (sub + 1) + 4 * i) * ld));
            }
#pragma unroll
            for (int i = 0; i < 16; ++i) *(LAS f32x4*)(scr + (4 * i + kq) * 68 + 4 * ch) = cur[i] * 64.0f;
            LDS_WAIT(); asm volatile("" ::: "memory");
#pragma unroll
            for (int j = 0; j < 4; ++j) {
                unsigned w[4];
#pragma unroll
                for (int q = 0; q < 4; ++q) { const LAS float* sp = scr + (16 * j + 4 * q) * 68 + lane; w[q] = pk4_fp8(sp[0], sp[68], sp[136], sp[204]); }
                o[4 * sub + j].x = w[0]; o[4 * sub + j].y = w[1]; o[4 * sub + j].z = w[2]; o[4 * sub + j].w = w[3];
            }
            LDS_WAIT(); asm volatile("" ::: "memory");
        }
#pragma unroll
        for (int j = 0; j < 16; ++j) *(v4u*)(dst + 16 * j) = o[j];
    }
}

DI void ph1_norm_dt(const Ctx& F, const Args& a) {
    const float* mod = (const float*)(F.ws + WS_CTL) + CW_MOD;
    const float* x = ARG(I_X); const float* n1g = ARG(I_N1G); const float* dtb = ARG(I_DTB);
    bf16* XN = (bf16*)(F.ws + WS_XN); const bf16* Wdt_t = (const bf16*)(F.ws + WS_WDT); float* DT = (float*)(F.ws + WS_DT);
    const int lane = lane_id(), wave = F.wave;
    f32x4 gm[4], ga[4];
#pragma unroll
    for (int j = 0; j < 4; ++j) { const int k = 256 * j + 4 * lane; const f32x4 g = *(const f32x4*)(n1g + k), sc = mod4(mod, 1024 + k);
        gm[j] = g * (sc + 1.0f); ga[j] = mod4(mod, k); }
    if (F.vcu == 0) { float* modc = (float*)(F.ws + WS_CTL) + CW_MODC; for (int k = (F.wave * 64 + lane_id()) * 4; k < 6 * D; k += NTHREADS * 4) *(f32x4*)(modc + k) = mod4(mod, k); }
    for (int unit = F.vcu; unit < M / 64; unit += F.G) {
        const int row0 = unit * 64;
#pragma unroll 1
        for (int rh = 0; rh < 2; ++rh) {
            f32x4 v[4][4];
#pragma unroll
            for (int rr = 0; rr < 4; ++rr)
#pragma unroll
                for (int j = 0; j < 4; ++j) v[rr][j] = __builtin_nontemporal_load((const f32x4*)(x + (size_t)(row0 + wave * 8 + rh * 4 + rr) * D + 256 * j + 4 * lane));
#pragma unroll
            for (int rr = 0; rr < 4; ++rr) {
                const int rl = wave * 8 + rh * 4 + rr, row = row0 + rl; float ss = 0.f;
#pragma unroll
                for (int j = 0; j < 4; ++j) ss += (v[rr][j].x * v[rr][j].x + v[rr][j].y * v[rr][j].y) + (v[rr][j].z * v[rr][j].z + v[rr][j].w * v[rr][j].w);
                const float rstd = 1.0f / sqrtf(wave_sum(ss) * (1.0f / D) + EPS);
                float am = 0.f;
#pragma unroll
                for (int j = 0; j < 4; ++j) { const f32x4 n = v[rr][j] * rstd * gm[j] + ga[j]; v[rr][j] = n;
                    am = __builtin_fmaxf(__builtin_fmaxf(am, __builtin_fmaxf(__builtin_fabsf(n.x), __builtin_fabsf(n.y))), __builtin_fmaxf(__builtin_fabsf(n.z), __builtin_fabsf(n.w)));
                    v2u w; w.x = pk2(n.x, n.y); w.y = pk2(n.z, n.w);
                    const int chunk = (32 * j + (lane >> 1)) ^ (rl & 15);
                    *(LAS v2u*)(F.lds + rl * 2048 + chunk * 16 + 8 * (lane & 1)) = w; }
#pragma unroll
                for (int o = 1; o < 64; o <<= 1) am = __builtin_fmaxf(am, __shfl_xor(am, o));
                const float inv = am > 0.f ? 127.0f / am : 0.f;
#pragma unroll
                for (int j = 0; j < 4; ++j) *(unsigned*)(F.ws + WS_XN8 + (size_t)row * D + 256 * j + 4 * lane) = pk4_i8(v[rr][j].x * inv, v[rr][j].y * inv, v[rr][j].z * inv, v[rr][j].w * inv);
                if (lane == 0) ((float*)(F.ws + WS_SA))[row] = am * (1.0f / 127.0f);
            }
        }
        __syncthreads();
        {
            const int rt = wave & 3, ct = wave >> 2, fr = lane & 15, fq = lane >> 4;
            pg8::f32x4 acc = {0.f, 0.f, 0.f, 0.f};
            const bf16* wrow = Wdt_t + (size_t)(16 * ct + fr) * D + 8 * fq;
#pragma unroll 4
            for (int ks = 0; ks < 32; ++ks) {
                const bf16x8 av = *(const LAS bf16x8*)(F.lds + (16 * rt + fr) * 2048 + (((4 * ks + fq) ^ fr) * 16));
                const bf16x8 bv = *(const bf16x8*)(wrow + 32 * ks);
                acc = __builtin_amdgcn_mfma_f32_16x16x32_bf16(av, bv, acc, 0, 0, 0);
            }
            const float bias = dtb[16 * ct + fr];
#pragma unroll
            for (int r = 0; r < 4; ++r) { const float v = acc[r] + bias; const float sp = v > 20.f ? v : log1pf(__expf(v));
                DT[(size_t)(row0 + 16 * rt + 4 * fq + r) * NH + 16 * ct + fr] = sp; }
        }
        __syncthreads();
    }
    {
        const float* win = ARG(I_WIN); const unsigned* wmax = (const unsigned*)(F.ws + WS_CTL) + CW_WMAX;
        const int gw = F.vcu * NWAVES + F.wave, NGW = F.G * NWAVES;
        LAS float* scr = (LAS float*)(F.lds + F.wave * 16384);
        for (int r = gw; r < 16 * 288; r += NGW) { const int kb = r / 288, nb = r % 288;
            const int npp = nb * 32 + (lane & 31), col = win_col(npp);
            const float mx = __uint_as_float(wmax[npp]); const float inv = mx > 0.f ? 127.0f / mx : 0.f;
            if (kb == 0 && lane < 32) ((float*)(F.ws + WS_SW))[npp] = mx * (1.0f / 127.0f);
            transpose_item_i8([&](int k, int) -> float { return win[(size_t)k * WIN_LD + col]; }, inv, D, F.ws + WS_W8IN, scr, kb, nb * 32, lane);
        }
    }
}

DI void ph3_convbranch(const Ctx& F, const Args& a, int reps) {
    const bf16* U = (const bf16*)(F.ws + WS_U); bf16* UC = (bf16*)(F.ws + WS_XN);
    const float* cw = ARG(I_CVW); const float* cb = ARG(I_CVB); const float* lg = ARG(I_LNG); const float* lb = ARG(I_LNB);
    const int tid = F.wave * 64 + lane_id(), lane = lane_id(), wave = F.wave;
    LAS unsigned char* tile = F.lds;
    LAS float* red = (LAS float*)(F.lds + 62 * 2048);
    LAS float* stat = red + 32 * 8 * 2;
    f2v w[31];
#pragma unroll
    for (int j = 0; j < 31; ++j) w[j] = *(const f2v*)(cw + j * D + 2 * tid);
    const f2v bias = *(const f2v*)(cb + 2 * tid), gam = *(const f2v*)(lg + 2 * tid), bet = *(const f2v*)(lb + 2 * tid);
    const int RU = (M / 32 + F.G - 1) / F.G;
    for (int it = 0; it < RU * reps; ++it) {
        const int unit = xcd_unit(F.xcd, F.xj, F.G >> 3, (it >= RU ? it - RU : it), M / 32); if (unit < 0) break; const int t0 = unit * 32;
        {
            v4u v[16];
#pragma unroll
            for (int i = 0; i < 16; ++i) { const int piece = tid + i * NTHREADS, r = piece >> 7, cch = piece & 127, t = t0 - 30 + r;
                v[i] = (v4u){0u, 0u, 0u, 0u}; if (piece < 62 * 128 && t >= 0) v[i] = *(const v4u*)(U + (size_t)t * D + cch * 8); }
#pragma unroll
            for (int i = 0; i < 16; ++i) { const int piece = tid + i * NTHREADS, r = piece >> 7, cch = piece & 127;
                if (piece < 62 * 128) *(LAS v4u*)(tile + r * 2048 + cch * 16) = v[i]; }
        }
        __syncthreads();
        f2v o[32];
#pragma unroll
        for (int tg = 0; tg < 8; ++tg) {
            f2v acc[4];
#pragma unroll
            for (int i = 0; i < 4; ++i) acc[i] = bias;
#pragma unroll
            for (int j = 0; j < 34; ++j) {
                const unsigned uu = *(const LAS unsigned*)(tile + (4 * tg + j) * 2048 + tid * 4);
                const f2v u2 = {bflo(uu), bfhi(uu)};
#pragma unroll
                for (int i = 0; i < 4; ++i) { const int jj = j - i; if (jj >= 0 && jj <= 30) acc[i] = __builtin_elementwise_fma(w[jj], u2, acc[i]); }
            }
#pragma unroll
            for (int i = 0; i < 4; ++i) o[4 * tg + i] = acc[i];
        }
        {
            float r5[64];
#pragma unroll
            for (int tk = 0; tk < 32; ++tk) { r5[2 * tk] = o[tk].x + o[tk].y; r5[2 * tk + 1] = o[tk].x * o[tk].x + o[tk].y * o[tk].y; }
            float r4[32], r3[16], r2[8], r1[4], r0[2];
            { const bool up = (lane & 32) != 0;
#pragma unroll
              for (int i = 0; i < 32; ++i) { const float keep = up ? r5[i + 32] : r5[i], send = up ? r5[i] : r5[i + 32]; r4[i] = keep + __shfl_xor(send, 32); } }
            { const bool up = (lane & 16) != 0;
#pragma unroll
              for (int i = 0; i < 16; ++i) { const float keep = up ? r4[i + 16] : r4[i], send = up ? r4[i] : r4[i + 16]; r3[i] = keep + __shfl_xor(send, 16); } }
            { const bool up = (lane & 8) != 0;
#pragma unroll
              for (int i = 0; i < 8; ++i) { const float keep = up ? r3[i + 8] : r3[i], send = up ? r3[i] : r3[i + 8]; r2[i] = keep + __shfl_xor(send, 8); } }
            { const bool up = (lane & 4) != 0;
#pragma unroll
              for (int i = 0; i < 4; ++i) { const float keep = up ? r2[i + 4] : r2[i], send = up ? r2[i] : r2[i + 4]; r1[i] = keep + __shfl_xor(send, 4); } }
            { const bool up = (lane & 2) != 0;
#pragma unroll
              for (int i = 0; i < 2; ++i) { const float keep = up ? r1[i + 2] : r1[i], send = up ? r1[i] : r1[i + 2]; r0[i] = keep + __shfl_xor(send, 2); } }
            const bool up0 = (lane & 1) != 0;
            const float tot = (up0 ? r0[1] : r0[0]) + __shfl_xor(up0 ? r0[0] : r0[1], 1);
            red[((lane >> 1) * 8 + wave) * 2 + (lane & 1)] = tot;
        }
        __syncthreads();
        if (tid < 32) { float s = 0.f, q = 0.f;
#pragma unroll
            for (int wv = 0; wv < 8; ++wv) { s += red[(tid * 8 + wv) * 2]; q += red[(tid * 8 + wv) * 2 + 1]; }
            const float mean = s * (1.0f / D); const float var = fmaxf(q * (1.0f / D) - mean * mean, 0.f);
            stat[tid * 2] = mean; stat[tid * 2 + 1] = 1.0f / sqrtf(var + EPS); }
        __syncthreads();
#pragma unroll
        for (int tk = 0; tk < 32; ++tk) { const float mean = stat[tk * 2], rstd = stat[tk * 2 + 1];
            const float y0 = (o[tk].x - mean) * rstd * gam.x + bet.x, y1 = (o[tk].y - mean) * rstd * gam.y + bet.y;
            *(unsigned*)(UC + (size_t)(t0 + tk) * D + 2 * tid) = pk2(siluf_(y0), siluf_(y1)); }
        __syncthreads();
    }
}

DI void conv_block(const bf16* XBC, const float* cw, const float* cb, int t_first, int col, float (&o)[8][8]) {
    v4u raw[11];
#pragma unroll
    for (int r = 0; r < 11; ++r) { const int t = t_first - 3 + r; const int tc = t < 0 ? 0 : t; v4u v = *(const v4u*)(XBC + (size_t)tc * XBCW + col);
        const unsigned msk = t < 0 ? 0u : 0xffffffffu; v.x &= msk; v.y &= msk; v.z &= msk; v.w &= msk; raw[r] = v; }
    float w[4][8], b[8];
#pragma unroll
    for (int j = 0; j < 4; ++j) { const f32x4 lo = *(const f32x4*)(cw + j * XBCW + col), hi = *(const f32x4*)(cw + j * XBCW + col + 4);
        w[j][0] = lo.x; w[j][1] = lo.y; w[j][2] = lo.z; w[j][3] = lo.w; w[j][4] = hi.x; w[j][5] = hi.y; w[j][6] = hi.z; w[j][7] = hi.w; }
    { const f32x4 lo = *(const f32x4*)(cb + col), hi = *(const f32x4*)(cb + col + 4); b[0] = lo.x; b[1] = lo.y; b[2] = lo.z; b[3] = lo.w; b[4] = hi.x; b[5] = hi.y; b[6] = hi.z; b[7] = hi.w; }
#pragma unroll
    for (int tk = 0; tk < 8; ++tk)
#pragma unroll
        for (int ch = 0; ch < 8; ++ch) {
            float acc = b[ch];
#pragma unroll
            for (int j = 0; j < 4; ++j) { const unsigned wd = raw[tk + j][ch >> 1]; const float xv = (ch & 1) ? bfhi(wd) : bflo(wd); acc += w[j][ch] * xv; }
            o[tk][ch] = siluf_(acc);
        }
}
DI float head_scan(const float* DT, const float* alog, int t0, int h, int lane, LAS float* acs_h, LAS float* dtv_h, float& d0o, float& d1o, float& c0o, float& c1o) {
    const float d0 = DT[(size_t)(t0 + 2 * lane) * NH + h], d1 = DT[(size_t)(t0 + 2 * lane + 1) * NH + h];
    const float A2 = -__expf(alog[h]) * LOG2E;
    const float a0 = d0 * A2, a1 = d1 * A2; float inc = a0 + a1;
#pragma unroll
    for (int o = 1; o < 64; o <<= 1) { const float t = __shfl_up(inc, o); if (lane >= o) inc += t; }
    acs_h[2 * lane] = inc - a1; acs_h[2 * lane + 1] = inc; dtv_h[2 * lane] = d0; dtv_h[2 * lane + 1] = d1;
    d0o = d0; d1o = d1; c0o = inc - a1; c1o = inc;
    return __shfl(inc, 63);
}

constexpr int S_CN = 0, S_BN = 32768, S_XT = 65536, S_ACS = 131072, S_DTV = 135168, S_SSQ = 139264, S_FS = 139776;

DI void ph3_chunk_states(const Ctx& F, const Args& a, int reps) {
    const bf16* XBC = (const bf16*)(F.ws + WS_XBC); const float* DT = (const float*)(F.ws + WS_DT);
    bf16* ST = (bf16*)(F.ws + WS_ST); float* CD = (float*)(F.ws + WS_CD);
    const float* scw = ARG(I_SCW); const float* scb = ARG(I_SCB); const float* alog = ARG(I_ALOG);
    const int tid = F.wave * 64 + lane_id(), lane = lane_id(), wave = F.wave, hh = lane >> 5;
    LAS unsigned char* lds = F.lds;
    LAS float* acs = (LAS float*)(lds + S_ACS); LAS float* wsc = (LAS float*)(lds + S_DTV);
    const int RU = (NCH * NGRP + F.G - 1) / F.G;
    for (int it = 0; it < RU * reps; ++it) {
        const int unit = xcd_unit(F.xcd, F.xj, F.G >> 3, (it >= RU ? it - RU : it), NCH * NGRP); if (unit < 0) break; const int c = unit >> 2, g = unit & 3, t0 = c * LCH;
        {
            const int h = 8 * g + wave; float d0, d1, c0, c1;
            const float total = head_scan(DT, alog, t0, h, lane, acs + wave * 128, wsc + wave * 128, d0, d1, c0, c1);
            wsc[wave * 128 + 2 * lane] = d0 * __builtin_amdgcn_exp2f(total - c0); wsc[wave * 128 + 2 * lane + 1] = d1 * __builtin_amdgcn_exp2f(total - c1);
            if (lane == 0) CD[c * NH + h] = __builtin_amdgcn_exp2f(total);
        }
        __syncthreads();
        if (tid < 256) { const int co = tid & 15, to = tid >> 4; float o[8][8];
            conv_block(XBC, scw, scb, t0 + 8 * to, 2048 + 128 * g + 8 * co, o);
#pragma unroll
            for (int ch = 0; ch < 8; ++ch) { const int row = 8 * co + ch;
                v4u w; w.x = pk2(o[0][ch], o[1][ch]); w.y = pk2(o[2][ch], o[3][ch]); w.z = pk2(o[4][ch], o[5][ch]); w.w = pk2(o[6][ch], o[7][ch]);
                *(LAS v4u*)(lds + S_BN + row * 256 + swz(row, to) * 16) = w; } }
        for (int ps = 0; ps < 2; ++ps) {
            {
                const int co = tid & 31, to = tid >> 5, hd = co >> 3, p0 = (co & 7) * 8; float o[8][8];
                conv_block(XBC, scw, scb, t0 + 8 * to, 512 * g + 64 * (4 * ps + hd) + p0, o);
                float sc[8];
#pragma unroll
                for (int tk = 0; tk < 8; ++tk) sc[tk] = wsc[(4 * ps + hd) * 128 + 8 * to + tk];
#pragma unroll
                for (int ch = 0; ch < 8; ++ch) { const int row = hd * 64 + p0 + ch;
                    v4u w; w.x = pk2(o[0][ch] * sc[0], o[1][ch] * sc[1]); w.y = pk2(o[2][ch] * sc[2], o[3][ch] * sc[3]);
                    w.z = pk2(o[4][ch] * sc[4], o[5][ch] * sc[5]); w.w = pk2(o[6][ch] * sc[6], o[7][ch] * sc[7]);
                    *(LAS v4u*)(lds + S_XT + row * 256 + swz(row, to) * 16) = w; }
            }
            __syncthreads();
            {
                const int hd = wave & 3, ph = wave >> 2, h = 8 * g + 4 * ps + hd;
                f32x16 acc[4];
#pragma unroll
                for (int nt = 0; nt < 4; ++nt)
#pragma unroll
                    for (int i = 0; i < 16; ++i) acc[nt][i] = 0.f;
                const int arow = hd * 64 + 32 * ph + (lane & 31);
#pragma unroll
                for (int ks = 0; ks < 8; ++ks) {
                    const bf16x8 av = *(const LAS bf16x8*)(lds + S_XT + arow * 256 + swz(arow, 2 * ks + hh) * 16);
#pragma unroll
                    for (int nt = 0; nt < 4; ++nt) { const int brow = 32 * nt + (lane & 31);
                        const bf16x8 bv = *(const LAS bf16x8*)(lds + S_BN + brow * 256 + swz(brow, 2 * ks + hh) * 16);
                        acc[nt] = MFMA32(av, bv, acc[nt]); }
                }
                bf16* dst = ST + ((size_t)(c * NH + h) * HD) * NST;
#pragma unroll
                for (int nt = 0; nt < 4; ++nt)
#pragma unroll
                    for (int i = 0; i < 16; i += 2) { const int p = 32 * ph + crow(i, hh); const unsigned pk = pk2(acc[nt][i], acc[nt][i + 1]);
                        dst[(size_t)p * NST + 32 * nt + (lane & 31)] = (bf16)(pk & 0xffffu); dst[(size_t)(p + 1) * NST + 32 * nt + (lane & 31)] = (bf16)(pk >> 16); }
            }
            __syncthreads();
        }
    }
}

DI void ph4_scan(const Ctx& F, size_t dst_off) {
    unsigned* ST32 = (unsigned*)(F.ws + WS_ST); unsigned* DST32 = (unsigned*)(F.ws + dst_off); const float* CD = (const float*)(F.ws + WS_CD);
    constexpr int NPAIR = NH * HD * NST / 2;
    for (int e = F.vcu * NTHREADS + (F.wave * 64 + lane_id()); e < NPAIR; e += F.G * NTHREADS) {
        const int h = e >> 12; float c0 = 0.f, c1 = 0.f;
#pragma unroll 1
        for (int cb = 0; cb < NCH; cb += 32) {
            unsigned v[32]; float dec[32];
#pragma unroll
            for (int i = 0; i < 32; ++i) { v[i] = __builtin_nontemporal_load(ST32 + (size_t)(cb + i) * NPAIR + e); dec[i] = CD[(cb + i) * NH + h]; }
#pragma unroll
            for (int i = 0; i < 32; ++i) { DST32[(size_t)(cb + i) * NPAIR + e] = pk2(c0, c1); c0 = c0 * dec[i] + bflo(v[i]); c1 = c1 * dec[i] + bfhi(v[i]); }
        }
    }
}

DI void ph5_ssd_out(const Ctx& F, const Args& a, int reps) {
    const bf16* XBC = (const bf16*)(F.ws + WS_XBC); const float* DT = (const float*)(F.ws + WS_DT);
    const bf16* ST = (const bf16*)(F.ws + WS_ST); const bf16* ZS = (const bf16*)(F.ws + WS_ZS); bf16* YS = (bf16*)(F.ws + WS_YS);
    const float* scw = ARG(I_SCW); const float* scb = ARG(I_SCB); const float* alog = ARG(I_ALOG); const float* dskip = ARG(I_DSKIP);
    const int tid = F.wave * 64 + lane_id(), lane = lane_id(), wave = F.wave, hh = lane >> 5, l31 = lane & 31;
    LAS unsigned char* lds = F.lds;
    LAS float* acs = (LAS float*)(lds + S_ACS); LAS float* dtv = (LAS float*)(lds + S_DTV); LAS float* ssq = (LAS float*)(lds + S_SSQ);
    const int RU = (NCH * NGRP + F.G - 1) / F.G;
    for (int it = 0; it < RU * reps; ++it) {
        const int unit = xcd_unit(F.xcd, F.xj, F.G >> 3, (it >= RU ? it - RU : it), NCH * NGRP); if (unit < 0) break; const int c = unit >> 2, g = unit & 3, t0 = c * LCH;
        { const int h = 8 * g + wave; float d0, d1, c0, c1; (void)head_scan(DT, alog, t0, h, lane, acs + wave * 128, dtv + wave * 128, d0, d1, c0, c1);
          const float cend = __shfl(c1, (lane & 48) | 15);
          LAS float* fsw = (LAS float*)(lds + S_FS) + wave * 128;
          fsw[2 * lane] = d0 * __builtin_amdgcn_exp2f(cend - c0); fsw[2 * lane + 1] = d1 * __builtin_amdgcn_exp2f(cend - c1); }
        if (tid < 128) ssq[tid] = 0.f;
        { const int which = tid >> 8, t8 = tid & 255, co = t8 & 15; int to = t8 >> 4; asm volatile("" : "+v"(to)); float o[8][8];
            conv_block(XBC, scw, scb, t0 + 8 * to, (which ? 2560 : 2048) + 128 * g + 8 * co, o);
            const int base = which ? S_CN : S_BN;
#pragma unroll
            for (int tk = 0; tk < 8; ++tk) { const int row = 8 * to + tk;
                v4u w; w.x = pk2(o[tk][0], o[tk][1]); w.y = pk2(o[tk][2], o[tk][3]); w.z = pk2(o[tk][4], o[tk][5]); w.w = pk2(o[tk][6], o[tk][7]);
                *(LAS v4u*)(lds + base + row * 256 + swz(row, co) * 16) = w; } }
#pragma unroll 1
        for (int ps = 0; ps < 2; ++ps) {
            {
                const int co = tid & 31; int to = tid >> 5; asm volatile("" : "+v"(to));
                const int hd = co >> 3, p0 = (co & 7) * 8; float o[8][8];
                conv_block(XBC, scw, scb, t0 + 8 * to, 512 * g + 64 * (4 * ps + hd) + p0, o);
#pragma unroll
                for (int ch = 0; ch < 8; ++ch) { const int row = hd * 64 + p0 + ch;
                    v4u w; w.x = pk2(o[0][ch], o[1][ch]); w.y = pk2(o[2][ch], o[3][ch]); w.z = pk2(o[4][ch], o[5][ch]); w.w = pk2(o[6][ch], o[7][ch]);
                    *(LAS v4u*)(lds + S_XT + row * 256 + swz(row, to) * 16) = w; }
            }
            __syncthreads();
            const int hd = wave & 3, lp = wave >> 2, hl = 4 * ps + hd, h = 8 * g + hl;
            const float Dh = dskip[h];
            const LAS float* acs_h = acs + hl * 128; const LAS float* dt_h = dtv + hl * 128; const LAS float* fs_h = (const LAS float*)(lds + S_FS) + hl * 128;
            const bf16* prev = ST + ((size_t)(c * NH + h) * HD) * NST;
            const int erow = lane >> 1, ehalf = lane & 1;
            f32x16 acc[2][2];
            {
#pragma unroll
                for (int which = 0; which < 2; ++which)
#pragma unroll
                    for (int pt = 0; pt < 2; ++pt)
#pragma unroll
                        for (int i = 0; i < 16; ++i) acc[which][pt][i] = 0.f;
                const int rowA = 32 * lp + l31, rowB = 32 * (3 - lp) + l31;
#pragma unroll
                for (int ks = 0; ks < 8; ++ks) {
                    const bf16x8 b0 = *(const bf16x8*)(prev + (size_t)l31 * NST + 16 * ks + 8 * hh), b1 = *(const bf16x8*)(prev + (size_t)(32 + l31) * NST + 16 * ks + 8 * hh);
                    const bf16x8 a0 = *(const LAS bf16x8*)(lds + S_CN + rowA * 256 + swz(rowA, 2 * ks + hh) * 16);
                    const bf16x8 a1 = *(const LAS bf16x8*)(lds + S_CN + rowB * 256 + swz(rowB, 2 * ks + hh) * 16);
                    acc[0][0] = MFMA32(a0, b0, acc[0][0]); acc[0][1] = MFMA32(a0, b1, acc[0][1]);
                    acc[1][0] = MFMA32(a1, b0, acc[1][0]); acc[1][1] = MFMA32(a1, b1, acc[1][1]);
                }
#pragma unroll
                for (int which = 0; which < 2; ++which) { const int li = which == 0 ? lp : 3 - lp;
#pragma unroll
                    for (int i = 0; i < 16; ++i) { const float e = __builtin_amdgcn_exp2f(acs_h[32 * li + crow(i, hh)]); acc[which][0][i] *= e; acc[which][1][i] *= e; } }
            }
            {
                const int liA = lp, liB = 3 - lp;
                const int rowA = 32 * liA + l31, rowB = 32 * liB + l31;
                const float alA = acs_h[rowA], alB = acs_h[rowB];
#pragma unroll 1
                for (int sj = 0; sj <= liB; ++sj) {
                    const bool doA = sj <= liA;
                    f32x16 GA, GB;
#pragma unroll
                    for (int i = 0; i < 16; ++i) { GA[i] = 0.f; GB[i] = 0.f; }
                    const int brow = 32 * sj + l31;
                    if (doA) {
#pragma unroll 2
                        for (int ks = 0; ks < 8; ++ks) {
                            const bf16x8 av = *(const LAS bf16x8*)(lds + S_BN + brow * 256 + swz(brow, 2 * ks + hh) * 16);
                            const bf16x8 ca = *(const LAS bf16x8*)(lds + S_CN + rowA * 256 + swz(rowA, 2 * ks + hh) * 16);
                            const bf16x8 cb = *(const LAS bf16x8*)(lds + S_CN + rowB * 256 + swz(rowB, 2 * ks + hh) * 16);
                            GA = MFMA32(av, ca, GA); GB = MFMA32(av, cb, GB);
                        }
                    } else {
#pragma unroll 2
                        for (int ks = 0; ks < 8; ++ks) {
                            const bf16x8 av = *(const LAS bf16x8*)(lds + S_BN + brow * 256 + swz(brow, 2 * ks + hh) * 16);
                            const bf16x8 cb = *(const LAS bf16x8*)(lds + S_CN + rowB * 256 + swz(rowB, 2 * ks + hh) * 16);
                            GB = MFMA32(av, cb, GB);
                        }
                    }
                    auto mask = [&](f32x16& G, int li, int row_l, float al) {
                        if (sj < li) {
                            const float fl = __builtin_amdgcn_exp2f(al - acs_h[32 * sj + 31]);
#pragma unroll
                            for (int i = 0; i < 16; ++i) G[i] = G[i] * (fs_h[32 * sj + crow(i, hh)] * fl);
                        } else {
#pragma unroll
                            for (int i = 0; i < 16; ++i) { const int s = 32 * sj + crow(i, hh);
                                float v = G[i] * __builtin_amdgcn_exp2f(fminf(al - acs_h[s], 0.f)) * dt_h[s];
                                v = (s > row_l) ? 0.f : v; v = (s == row_l) ? v + Dh : v; G[i] = v; }
                        }
                    };
                    auto pv = [&](const f32x16& G, f32x16 (&ac)[2]) {
#pragma unroll
                        for (int s2 = 0; s2 < 2; ++s2) {
                            v4u fa; fa.x = pk2(G[8 * s2 + 0], G[8 * s2 + 1]); fa.y = pk2(G[8 * s2 + 2], G[8 * s2 + 3]); fa.z = pk2(G[8 * s2 + 4], G[8 * s2 + 5]); fa.w = pk2(G[8 * s2 + 6], G[8 * s2 + 7]);
#pragma unroll
                            for (int pt = 0; pt < 2; ++pt) { const int xrow = hd * 64 + 32 * pt + l31; const int sc0 = 32 * sj + 16 * s2;
                                const v2u lo = *(const LAS v2u*)(lds + S_XT + xrow * 256 + swz(xrow, (sc0 >> 3)) * 16 + 8 * hh);
                                const v2u hi = *(const LAS v2u*)(lds + S_XT + xrow * 256 + swz(xrow, (sc0 >> 3) + 1) * 16 + 8 * hh);
                                v4u bfr; bfr.x = lo.x; bfr.y = lo.y; bfr.z = hi.x; bfr.w = hi.y;
                                ac[pt] = MFMA32(__builtin_bit_cast(bf16x8, fa), __builtin_bit_cast(bf16x8, bfr), ac[pt]); }
                        }
                    };
                    if (doA) { mask(GA, liA, rowA, alA); pv(GA, acc[0]); }
                    mask(GB, liB, rowB, alB); pv(GB, acc[1]);
                }
            }
            asm volatile("" ::: "memory");
            v4u zs[2][4];
#pragma unroll
            for (int which = 0; which < 2; ++which) { const int li = which == 0 ? lp : 3 - lp; const size_t t = (size_t)(t0 + 32 * li + erow);
#pragma unroll
                for (int j = 0; j < 4; ++j) zs[which][j] = *(const v4u*)(ZS + t * DIN + 64 * h + 32 * ehalf + 8 * j); }
            __syncthreads();
            {
                LAS unsigned char* stg = lds + S_XT + wave * 8192;
#pragma unroll
                for (int which = 0; which < 2; ++which)
#pragma unroll
                    for (int pt = 0; pt < 2; ++pt)
#pragma unroll
                        for (int i = 0; i < 16; ++i) *(LAS bf16*)(stg + ((which * 32 + crow(i, hh)) * 64 + 32 * pt + l31) * 2) = (bf16)(pk2(acc[which][pt][i], 0.f) & 0xffffu);
                LDS_WAIT(); asm volatile("" ::: "memory");
#pragma unroll
                for (int which = 0; which < 2; ++which) { const int li = which == 0 ? lp : 3 - lp; const int l = 32 * li + erow; const size_t t = (size_t)(t0 + l);
                    float q = 0.f; unsigned w8[8];
#pragma unroll
                    for (int j = 0; j < 4; ++j) { const v4u yv = *(const LAS v4u*)(stg + ((which * 32 + erow) * 64 + 32 * ehalf + 8 * j) * 2); const v4u zv = zs[which][j];
                        float y[8] = {bflo(yv.x) * bflo(zv.x), bfhi(yv.x) * bfhi(zv.x), bflo(yv.y) * bflo(zv.y), bfhi(yv.y) * bfhi(zv.y), bflo(yv.z) * bflo(zv.z), bfhi(yv.z) * bfhi(zv.z), bflo(yv.w) * bflo(zv.w), bfhi(yv.w) * bfhi(zv.w)};
#pragma unroll
                        for (int k = 0; k < 8; ++k) q += y[k] * y[k];
                        w8[2 * j] = pk4_fp8(y[0], y[1], y[2], y[3]); w8[2 * j + 1] = pk4_fp8(y[4], y[5], y[6], y[7]); }
                    { unsigned char* yp = (unsigned char*)YS + t * DIN + 64 * h + 32 * ehalf;
                      *(v4u*)yp = (v4u){w8[0], w8[1], w8[2], w8[3]}; *(v4u*)(yp + 16) = (v4u){w8[4], w8[5], w8[6], w8[7]}; }
                    q += __shfl_xor(q, 1);
                    if (ehalf == 0) __hip_atomic_fetch_add(ssq + l, q, __ATOMIC_RELAXED, __HIP_MEMORY_SCOPE_WORKGROUP);
                }
            }
            __syncthreads();
        }
        if (tid < 128) ((float*)(F.ws + WS_RSTD))[(size_t)(t0 + tid) * 4 + g] = 1.0f / sqrtf(ssq[tid] * (1.0f / 512.f) + EPS);
        __syncthreads();
    }
}

constexpr int RT_LD = 1028;
DI void ph8_router(const Ctx& F, const Args& a, int reps) {
    const float* mod = (const float*)(F.ws + WS_CTL) + CW_MODC;
    const bf16* H = (const bf16*)(F.ws + WS_H16); const float* n2g = ARG(I_N2G); const float* bgrp = ARG(I_BGRP); const float* ber = ARG(I_BER);
    unsigned char* XN2 = F.ws + WS_XN; int* cnt0 = (int*)(F.ws + WS_CTL) + CW_CNT;
    int* RE = (int*)(F.ws + WS_ROUTE); int* RP = RE + 2 * M; float* RW = (float*)(RP + 2 * M); int* LIST = (int*)(F.ws + WS_LIST);
    const int lane = lane_id(), wave = F.wave;
    LAS float* tile = (LAS float*)F.lds;
    LAS float* pe = (LAS float*)F.lds;
    f32x4 gm[4], ga[4];
#pragma unroll
    for (int j = 0; j < 4; ++j) { const int k = 256 * j + 4 * lane; const f32x4 g = *(const f32x4*)(n2g + k), sc = *(const f32x4*)(mod + 4096 + k);
        gm[j] = g * (sc + 1.0f); ga[j] = *(const f32x4*)(mod + 3072 + k); }
    const int RU = (M / 32 + F.G - 1) / F.G;
    for (int it = 0; it < RU * reps; ++it) {
        const int unit = xcd_unit(F.xcd, F.xj, F.G >> 3, (it >= RU ? it - RU : it), M / 32); if (unit < 0) break; int* cnt = cnt0 + ((it >= RU * (reps - 1)) ? 0 : 4096);
        const int row0 = unit * 32;
        {
            f32x4 v[4][4];
#pragma unroll
            for (int rr = 0; rr < 4; ++rr)
#pragma unroll
                for (int j = 0; j < 4; ++j) { const v2u hw = *(const v2u*)(H + (size_t)(row0 + wave * 4 + rr) * D + 256 * j + 4 * lane); v[rr][j] = (f32x4){bflo(hw.x), bfhi(hw.x), bflo(hw.y), bfhi(hw.y)}; }
#pragma unroll
            for (int rr = 0; rr < 4; ++rr) { const int rl = wave * 4 + rr, row = row0 + rl; float ss = 0.f;
#pragma unroll
                for (int j = 0; j < 4; ++j) ss += (v[rr][j].x * v[rr][j].x + v[rr][j].y * v[rr][j].y) + (v[rr][j].z * v[rr][j].z + v[rr][j].w * v[rr][j].w);
                const float rstd = 1.0f / sqrtf(wave_sum(ss) * (1.0f / D) + EPS);
#pragma unroll
                for (int j = 0; j < 4; ++j) { const f32x4 n = v[rr][j] * rstd * gm[j] + ga[j];
                    *(LAS f32x4*)(tile + rl * RT_LD + 256 * j + 4 * lane) = n;
                    *(unsigned*)(XN2 + (size_t)row * D + 256 * j + 4 * lane) = pk4_fp8(n.x, n.y, n.z, n.w); }
            }
        }
        __syncthreads();
        pg8::f32x4 acc[2][5];
#pragma unroll
        for (int rt = 0; rt < 2; ++rt)
#pragma unroll
            for (int ct = 0; ct < 5; ++ct) acc[rt][ct] = (pg8::f32x4){0.f, 0.f, 0.f, 0.f};
        const int kb = wave * 128, fr = lane & 15, kq = lane >> 4;
        const bf16* WRH = (const bf16*)(F.ws + WS_WRH); const bf16* WRL = (const bf16*)(F.ws + WS_WRL);
#pragma unroll 2
        for (int ks = 0; ks < 4; ++ks) {
            const int k0 = kb + 32 * ks + 8 * kq;
            bf16x8 bh[5], bl[5];
#pragma unroll
            for (int ct = 0; ct < 5; ++ct) { bh[ct] = *(const bf16x8*)(WRH + (size_t)(16 * ct + fr) * D + k0); bl[ct] = *(const bf16x8*)(WRL + (size_t)(16 * ct + fr) * D + k0); }
#pragma unroll
            for (int rt = 0; rt < 2; ++rt) {
                const f32x4 x0 = *(const LAS f32x4*)(tile + (16 * rt + fr) * RT_LD + k0), x1 = *(const LAS f32x4*)(tile + (16 * rt + fr) * RT_LD + k0 + 4);
                v4u hv, lv;
                hv.x = pk2(x0.x, x0.y); hv.y = pk2(x0.z, x0.w); hv.z = pk2(x1.x, x1.y); hv.w = pk2(x1.z, x1.w);
                lv.x = pk2(x0.x - bflo(hv.x), x0.y - bfhi(hv.x)); lv.y = pk2(x0.z - bflo(hv.y), x0.w - bfhi(hv.y));
                lv.z = pk2(x1.x - bflo(hv.z), x1.y - bfhi(hv.z)); lv.w = pk2(x1.z - bflo(hv.w), x1.w - bfhi(hv.w));
                const bf16x8 ah = __builtin_bit_cast(bf16x8, hv), al = __builtin_bit_cast(bf16x8, lv);
#pragma unroll
                for (int ct = 0; ct < 5; ++ct) {
                    acc[rt][ct] = __builtin_amdgcn_mfma_f32_16x16x32_bf16(ah, bh[ct], acc[rt][ct], 0, 0, 0);
                    acc[rt][ct] = __builtin_amdgcn_mfma_f32_16x16x32_bf16(ah, bl[ct], acc[rt][ct], 0, 0, 0);
                    acc[rt][ct] = __builtin_amdgcn_mfma_f32_16x16x32_bf16(al, bh[ct], acc[rt][ct], 0, 0, 0); }
            }
        }
        __syncthreads();
#pragma unroll
        for (int rt = 0; rt < 2; ++rt)
#pragma unroll
            for (int ct = 0; ct < 5; ++ct)
#pragma unroll
                for (int r = 0; r < 4; ++r) pe[(wave * 32 + 16 * rt + 4 * kq + r) * 80 + 16 * ct + fr] = acc[rt][ct][r];
        __syncthreads();
        int e0s[4], e1s[4]; float w0s[4], w1s[4];
#pragma unroll
        for (int rr = 0; rr < 4; ++rr) { const int rl = wave * 4 + rr;
            float le = ber[lane], lgv = (lane < 8) ? bgrp[lane] : 0.f;
#pragma unroll
            for (int wv = 0; wv < 8; ++wv) { le += pe[(wv * 32 + rl) * 80 + lane]; if (lane < 8) lgv += pe[(wv * 32 + rl) * 80 + 64 + lane]; }
            float gl[8];
#pragma unroll
            for (int i = 0; i < 8; ++i) gl[i] = __shfl(lgv, i);
            int gi = 0; float gmax = gl[0];
#pragma unroll
            for (int i = 1; i < 8; ++i) if (gl[i] > gmax) { gmax = gl[i]; gi = i; }
            float den = 0.f;
#pragma unroll
            for (int i = 0; i < 8; ++i) den += __expf(gl[i] - gmax);
            const float gp = 1.0f / den;
            float el[8];
#pragma unroll
            for (int i = 0; i < 8; ++i) el[i] = __shfl(le, gi * 8 + i);
            int i0 = 0; float m0 = el[0];
#pragma unroll
            for (int i = 1; i < 8; ++i) if (el[i] > m0) { m0 = el[i]; i0 = i; }
            int i1 = -1; float m1 = -INFINITY;
#pragma unroll
            for (int i = 0; i < 8; ++i) if (i != i0 && el[i] > m1) { m1 = el[i]; i1 = i; }
            const float dd = __expf(m1 - m0);
            w0s[rr] = gp / (1.0f + dd); w1s[rr] = gp * dd / (1.0f + dd); e0s[rr] = gi * 8 + i0; e1s[rr] = gi * 8 + i1;
        }
        if (lane == 0) {
            int p0[4], p1[4];
#pragma unroll
            for (int rr = 0; rr < 4; ++rr) { p0[rr] = atomicAdd(cnt + 64 * e0s[rr], 1); p1[rr] = atomicAdd(cnt + 64 * e1s[rr], 1); }
#pragma unroll
            for (int rr = 0; rr < 4; ++rr) { const int row = row0 + wave * 4 + rr;
                RE[2 * row] = e0s[rr]; RE[2 * row + 1] = e1s[rr]; RP[2 * row] = p0[rr]; RP[2 * row + 1] = p1[rr]; RW[2 * row] = w0s[rr]; RW[2 * row + 1] = w1s[rr];
                LIST[e0s[rr] * 16384 + p0[rr]] = row; LIST[e1s[rr] * 16384 + p1[rr]] = row; }
        }
        __syncthreads();
    }
}

DI void build_tilebase(const Ctx& F) {
    const int* cnt = (const int*)(F.ws + WS_CTL) + CW_CNT; LAS int* tb = (LAS int*)(F.lds + TB_OFF);
    if (F.wave == 0) {
        const int lane = lane_id(); const int tiles = (cnt[64 * lane] + 255) >> 8; int inc = tiles;
#pragma unroll
        for (int o = 1; o < 64; o <<= 1) { const int t = __shfl_up(inc, o); if (lane >= o) inc += t; }
        tb[lane] = inc - tiles; if (lane == 63) tb[NE] = inc; ((LAS int*)(F.lds + CNTL_OFF))[lane] = cnt[64 * lane];
    }
    __syncthreads();
}
DI void fill_tokl(const Ctx& F, const MoeOrder& S) {
    const LAS int* tb = (const LAS int*)(F.lds + TB_OFF); const LAS int* cntl = (const LAS int*)(F.lds + CNTL_OFF); LAS int* tokl = (LAS int*)(F.lds + TOKL_OFF);
    const int* LIST = (const int*)(F.ws + WS_LIST); const int tid = F.wave * 64 + lane_id();
    for (int i = 0; i < 4; ++i) { pg8::Unit u; if (!S.next(i, u)) break;
        const int e = u.pn >> 2, r = 256 * (u.pm - tb[e]) + tid;
        if (tid < 256) tokl[256 * i + tid] = (r < cntl[e]) ? LIST[e * 16384 + r] : 0; }
    asm volatile("s_waitcnt vmcnt(0) lgkmcnt(0)" ::: "memory"); __syncthreads();
}
DI void ph12_final(const Ctx& F, const Args& a, int reps) {
    const float* mod = (const float*)(F.ws + WS_CTL) + CW_MODC; float* H = (float*)argp<N_IN>(); const bf16* H16 = (const bf16*)(F.ws + WS_H16); const float* fg = ARG(I_FG);
    const unsigned char* YE = F.ws + WS_YEXP; const int* RE = (const int*)(F.ws + WS_ROUTE); const int* RP = RE + 2 * M; const float* RW = (const float*)(F.ws + WS_ROUTE) + 4 * M;
    const LAS int* tb = (const LAS int*)(F.lds + TB_OFF);
    float* OUT2 = (float*)(F.ws + WS_U);
    const int gw = F.vcu * NWAVES + F.wave, NGW = F.G * NWAVES, lane = lane_id();
    f32x4 g2[4], fgv[4];
#pragma unroll
    for (int j = 0; j < 4; ++j) { g2[j] = *(const f32x4*)(mod + 5 * 1024 + 256 * j + 4 * lane); fgv[j] = *(const f32x4*)(fg + 256 * j + 4 * lane); }
    const int RT = (M / 2 + NGW - 1) / NGW;
    for (int it = 0; it < RT * reps; ++it) {
        const int t0 = 2 * xcd_unit(F.xcd, F.xj * NWAVES + F.wave, NGW >> 3, (it >= RT ? it - RT : it), M / 2); if (t0 < 0) break;
        float* O = (it >= RT * (reps - 1)) ? H : OUT2;
        int tt[2], d0[2], d1[2]; float w0[2], w1[2];
#pragma unroll
        for (int u = 0; u < 2; ++u) { tt[u] = (t0 + u) % M; d0[u] = 256 * tb[RE[2 * tt[u]]] + RP[2 * tt[u]]; d1[u] = 256 * tb[RE[2 * tt[u] + 1]] + RP[2 * tt[u] + 1]; w0[u] = RW[2 * tt[u]]; w1[u] = RW[2 * tt[u] + 1]; }
        f32x4 hv[2][4]; unsigned ya[2][4], yb[2][4];
#pragma unroll
        for (int u = 0; u < 2; ++u)
#pragma unroll
            for (int j = 0; j < 4; ++j) { const v2u hw = *(const v2u*)(H16 + (size_t)tt[u] * D + 256 * j + 4 * lane); hv[u][j] = (f32x4){bflo(hw.x), bfhi(hw.x), bflo(hw.y), bfhi(hw.y)};
                ya[u][j] = *(const unsigned*)(YE + (size_t)d0[u] * D + 256 * j + 4 * lane); yb[u][j] = *(const unsigned*)(YE + (size_t)d1[u] * D + 256 * j + 4 * lane); }
#pragma unroll
        for (int u = 0; u < 2; ++u) {
            f32x4 v[4]; float ss = 0.f;
#pragma unroll
            for (int j = 0; j < 4; ++j) { const unsigned a4 = ya[u][j], b4 = yb[u][j];
                const f2v a01 = __builtin_amdgcn_cvt_pk_f32_fp8(a4, false), a23 = __builtin_amdgcn_cvt_pk_f32_fp8(a4, true), b01 = __builtin_amdgcn_cvt_pk_f32_fp8(b4, false), b23 = __builtin_amdgcn_cvt_pk_f32_fp8(b4, true);
                f32x4 mo; mo.x = w0[u] * a01.x + w1[u] * b01.x; mo.y = w0[u] * a01.y + w1[u] * b01.y; mo.z = w0[u] * a23.x + w1[u] * b23.x; mo.w = w0[u] * a23.y + w1[u] * b23.y;
                mo = mo * 0.0625f;
                v[j] = hv[u][j] + g2[j] * mo; ss += (v[j].x * v[j].x + v[j].y * v[j].y) + (v[j].z * v[j].z + v[j].w * v[j].w); }
            const float rstd = 1.0f / sqrtf(wave_sum(ss) * (1.0f / D) + EPS);
#pragma unroll
            for (int j = 0; j < 4; ++j) *(f32x4*)(O + (size_t)tt[u] * D + 256 * j + 4 * lane) = v[j] * rstd * fgv[j];
        }
    }
}

constexpr int N_PHASES = 13;
#ifndef REP_MASK
#define REP_MASK 0
#endif
#define REPS(k) (((REP_MASK >> (k)) & 1) ? 2 : 1)
#ifndef MK_ONE_LAUNCH
#define MK_ONE_LAUNCH 1
#endif

struct RepOrder { pg8::StaticOrder s; int n, reps;
    DI bool next(int i, pg8::Unit& u) const { if (i >= n * reps) return false; return s.next(i % n, u); }
    DI void a_ready(const pg8::Unit&) const {}
    DI void done(const pg8::Unit&) const {} };

__global__ void __launch_bounds__(NTHREADS, 2) fwd_kernel(Args args) {
    extern __shared__ __attribute__((aligned(16))) unsigned char lds_raw[];
    Ctx F;
    F.lds = (LAS unsigned char*)lds_raw;
    F.wave = __builtin_amdgcn_readfirstlane((int)threadIdx.x >> 6);
    F.G = gridDim.x; { const int bx = blockIdx.x; F.xcd = bx & 7; F.xj = bx >> 3; F.vcu = F.xcd * (F.G >> 3) + F.xj; }
    F.ws = (unsigned char*)argp<N_IN + 1>();
    volatile LAS unsigned* MISC = (volatile LAS unsigned*)(F.lds + LDSCTL_OFF);
    for (int u = threadIdx.x; u < (LDS_BYTES - LDSCTL_OFF) / 4; u += NTHREADS) ((LAS unsigned*)(F.lds + LDSCTL_OFF))[u] = 0u;
    __syncthreads();
    const int lo = args.ph_lo, hi = args.ph_hi;
    unsigned* barw = (unsigned*)(F.ws + WS_CTL) + CW_BAR;
    XcdBarrier bar; bar.bar = barw; bar.x = 0; bar.st = nullptr;
    if (hi - lo > 1) bar = xcd_barrier_post(barw, MISC + 8);
    bar.wave = F.wave;
#define IN(k) (lo <= (k) && (k) < hi)
#define SEAM(k) do { if (IN(k) && IN((k) + 1)) { xcd_barrier(bar); if (REPS(14) > 1) xcd_barrier(bar); } } while (0)
    unsigned char* ws = F.ws;
    bf16* XN = (bf16*)(ws + WS_XN);
    const float* mod = (const float*)(ws + WS_CTL) + CW_MOD;

    if (IN(0)) { ph0_prologue(F, args, REPS(0)); SEAM(0); }
    if (IN(1)) { for (int rep = 0; rep < REPS(1); ++rep) { ph1_norm_dt(F, args); __syncthreads(); } SEAM(1); }
    if (IN(2)) {
        pg8::Gemm g{(const bf16*)(ws + WS_XN8), (const bf16*)(ws + WS_W8IN), M, NPROJ, D / 2}; pg8::StaticOrder S; S.init(M, NPROJ, F.G, (int)blockIdx.x);
        EpiInProj E{ws};
        RepOrder R{S, (S.nwg - S.c + S.G - 1) / S.G, REPS(2)};
        pg8::gemm_phase<EpiInProj, RepOrder, true, true, false, false, true>(F.lds, g, R, E, F.wave);
        SEAM(2);
    }
    if (IN(3)) { ph3_convbranch(F, args, REPS(3)); __syncthreads(); ph3_chunk_states(F, args, REPS(13)); __syncthreads(); SEAM(3); }
    if (IN(4)) {
        if (REPS(4) > 1) ph4_scan(F, WS_YS);
        ph4_scan(F, WS_ST);
        pg8::Gemm g{XN, (const bf16*)(ws + WS_WCV), M, D, D}; pg8::StaticOrder S; S.init(M, D, F.G, (int)blockIdx.x);
        EpiGate<false> E{(bf16*)(ws + WS_TMP), nullptr, (const bf16*)(ws + WS_GATE), 0, nullptr};
        RepOrder R{S, (S.nwg - S.c + S.G - 1) / S.G, REPS(15)};
        pg8::gemm_phase<EpiGate<false>, RepOrder, false, true>(F.lds, g, R, E, F.wave);
        SEAM(4);
    }
    if (IN(5)) { ph5_ssd_out(F, args, REPS(5)); SEAM(5); }
    if (IN(6)) {
        pg8::Gemm g{(const bf16*)(ws + WS_YS), (const bf16*)(ws + WS_WSSM), M, D, DIN / 2}; pg8::StaticOrder S; S.init(M, D, F.G, (int)blockIdx.x);
        LAS float* rt = (LAS float*)(F.lds + RT_OFF);
        EpiGate<true> E{(bf16*)(ws + WS_MG), (const bf16*)(ws + WS_TMP), (const bf16*)(ws + WS_GATE), 1024, rt};
        for (int i = 0;; ++i) {
            OneUnit S1; if (!S.next(i, S1.u)) break;
            if (F.wave < 4) { const int tid = F.wave * 64 + lane_id(); const f32x4 r = *(const f32x4*)((const float*)(ws + WS_RSTD) + (size_t)(S1.u.pm * 256 + tid) * 4);
                *(LAS f32x4*)(rt + tid * 4) = (f32x4){r.x / r.y, r.y / r.z, r.z / r.w, r.w}; }
            asm volatile("s_waitcnt vmcnt(0) lgkmcnt(0)" ::: "memory"); __syncthreads();
            pg8::gemm_phase<EpiGate<true>, OneUnit, false, true, true>(F.lds, g, S1, E, F.wave);
            __syncthreads();
        }
        SEAM(6);
    }
    if (IN(7)) {
        pg8::Gemm g{(const bf16*)(ws + WS_MG), (const bf16*)(ws + WS_WMIX), M, D, D}; pg8::StaticOrder S; S.init(M, D, F.G, (int)blockIdx.x);
        EpiMix E{(bf16*)(ws + WS_H16), ARG(I_X), (const float*)(ws + WS_CTL) + CW_MODC + 2 * 1024};
        RepOrder R{S, (S.nwg - S.c + S.G - 1) / S.G, REPS(7)};
        pg8::gemm_phase<EpiMix, RepOrder, false, true>(F.lds, g, R, E, F.wave);
        SEAM(7);
    }
    if (IN(8)) { for (int rep = 0; rep < REPS(8); ++rep) { convert_experts(F, args); __syncthreads(); } ph8_router(F, args, REPS(9)); if (IN(8) && IN(10)) xcd_barrier(bar); }
    if (IN(10)) {
        build_tilebase(F);
        const LAS int* tb = (const LAS int*)(F.lds + TB_OFF);
        pg8::Gemm g{(const bf16*)(ws + WS_XN), (const bf16*)(ws + WS_W13), M, NE * 1024, D / 2};
        MoeOrder S{tb, F.G, F.vcu, tb[NE] * 4, 1, (const LAS int*)(F.lds + TOKL_OFF)};
        fill_tokl(F, S);
        EpiUp E{ws + WS_HDN};
        pg8::gemm_phase<EpiUp, MoeOrder, true, true, true, true>(F.lds, g, S, E, F.wave);
        SEAM(10);
    }
    if (IN(11)) {
        build_tilebase(F);
        const LAS int* tb = (const LAS int*)(F.lds + TB_OFF);
        pg8::Gemm g{(const bf16*)(ws + WS_HDN), (const bf16*)(ws + WS_W2), 49152, NE * 1024, DFF / 2};
        MoeOrder S{tb, F.G, F.vcu, tb[NE] * 4, 1, nullptr};
        EpiDown E{ws + WS_YEXP};
        pg8::gemm_phase<EpiDown, MoeOrder, true, true, true>(F.lds, g, S, E, F.wave);
        SEAM(11);
    }
    if (IN(12)) { build_tilebase(F); ph12_final(F, args, REPS(12)); }
#undef IN
#undef SEAM
}

extern "C" void kernel_launch(void* const* d_in, const int* in_sizes, int n_in, void* d_out, int out_size, void* d_ws, size_t ws_size, hipStream_t stream) {
    static int grid = 0;
    if (grid == 0) {
        if (n_in != N_IN || in_sizes[0] != M * D || out_size != M * D || ws_size < WS_END) {
            fprintf(stderr, "kernel_launch: unexpected shapes: n_in %d in0 %d out %d ws %zu (need %zu)\n", n_in, n_in > 0 ? in_sizes[0] : -1, out_size, ws_size, (size_t)WS_END); grid = -1; return; }
        int dev = 0, cus = 0, per_cu = 0;
        if (hipGetDevice(&dev) != hipSuccess || hipDeviceGetAttribute(&cus, hipDeviceAttributeMultiprocessorCount, dev) != hipSuccess) { fprintf(stderr, "kernel_launch: device query failed\n"); grid = -1; return; }
        if (hipFuncSetAttribute((const void*)fwd_kernel, hipFuncAttributeMaxDynamicSharedMemorySize, LDS_BYTES) != hipSuccess) { fprintf(stderr, "kernel_launch: hipFuncSetAttribute failed\n"); grid = -1; return; }
        if (hipOccupancyMaxActiveBlocksPerMultiprocessor(&per_cu, (const void*)fwd_kernel, NTHREADS, LDS_BYTES) != hipSuccess || per_cu < 1) {
            fprintf(stderr, "kernel_launch: the occupancy query admits no workgroup of this kernel per CU (%d); nothing launched\n", per_cu); (void)hipGetLastError(); grid = -1; return; }
        grid = cus;
        if (cus < 192 || (cus & 7)) { fprintf(stderr, "kernel_launch: built for a 256-CU device (the MoE unit table holds 4 units per workgroup); %d CUs: nothing launched\n", cus); grid = -1; return; }
        fprintf(stderr, "kernel_launch: grid %d (cus %d, per_cu %d)\n", grid, cus, per_cu);
    }
    if (grid < 0) return;
    (void)hipMemsetAsync((char*)d_ws + WS_CTL, 0, CTL_ZERO_BYTES, stream);
    Args a{};
    for (int i = 0; i < N_IN; ++i) a.in[i] = (const float*)d_in[i];
    a.out = (float*)d_out; a.ws = (unsigned char*)d_ws;
#if MK_ONE_LAUNCH
    a.ph_lo = 0; a.ph_hi = N_PHASES;
    void* kargs[] = {&a};
    hipError_t e = hipLaunchCooperativeKernel((const void*)fwd_kernel, dim3(grid), dim3(NTHREADS), kargs, LDS_BYTES, stream);
    if (e != hipSuccess) fprintf(stderr, "kernel_launch: cooperative launch failed: %s\n", hipGetErrorString(e));
#else
    for (int ph = 0; ph < N_PHASES; ++ph) {
        a.ph_lo = ph; a.ph_hi = ph + 1;
        hipLaunchKernelGGL(fwd_kernel, dim3(grid), dim3(NTHREADS), LDS_BYTES, stream, a);
    }
#endif
}
```

```cpp
#include <hip/hip_runtime.h>
#include <hip/hip_cooperative_groups.h>
#include <cstdio>
#include <cstdint>
namespace pg8 {
#define PG8_LAS __attribute__((address_space(3)))
typedef unsigned short bf16_t;
typedef short bf16x8 __attribute__((ext_vector_type(8)));
typedef float f32x4 __attribute__((ext_vector_type(4)));
typedef unsigned u32x4 __attribute__((ext_vector_type(4)));
typedef int v4i_ __attribute__((ext_vector_type(4)));
typedef int v8i_ __attribute__((ext_vector_type(8)));
constexpr int BM = 256, BK = 64, HALF = 128, HTB = HALF * BK * 2  , STAGE_BYTES = 8 * HTB, NXCD = 8, WGM = 8;

__host__ __device__ __forceinline__ int lds_byte(int r, int c) { const int st = (r >> 4) * 2 + (c >> 5), rr = r & 15, cc = c & 31, ob = rr * 64 + cc * 2; return st * 1024 + (ob ^ (((ob >> 9) & 1) << 5)); }
__host__ __device__ __forceinline__ void stage_rc(int b, int& R, int& C) { const int st = b / 1024, sb = b % 1024, swz = sb ^ (((sb >> 9) & 1) << 5); R = (st >> 1) * 16 + swz / 64; C = (st & 1) * 32 + (swz % 64) / 2; }
__host__ __device__ __forceinline__ int perm32(int rho) { const int n = rho >> 4, i = rho & 15; return 8 * (i >> 2) + 4 * n + (i & 3); }

struct Unit { int pm, pn; };
struct Gemm { const bf16_t* A; const bf16_t* Bt; int M, N, K; };

struct StaticOrder {
    int nM, nN, nwg, G, c;
    __host__ __device__ void init(int M, int N, int G_, int c_) { nM = M / BM; nN = N / BM; nwg = nM * nN; G = G_; c = c_; }
    __host__ __device__ bool next(int i, Unit& u) const {
        const long L = (long)i * G + c; if (L >= nwg) return false;
        int wgid = (int)L; { const int q = nwg / NXCD, r = nwg % NXCD, xcd = wgid % NXCD, off = wgid / NXCD; wgid = (xcd < r ? xcd * (q + 1) : r * (q + 1) + (xcd - r) * q) + off; }
        const int nig = WGM * nN, gid = wgid / nig, fm = gid * WGM, gsz = (nM - fm) < WGM ? (nM - fm) : WGM;
        u.pm = fm + ((wgid % nig) % gsz); u.pn = (wgid % nig) / gsz; return true;
    }
    __device__ __forceinline__ void a_ready(const Unit&) const {}
    __device__ __forceinline__ void done(const Unit&) const {}
};

__device__ __forceinline__ unsigned cvt_pk_bf16(float lo, float hi) { unsigned r; asm volatile("v_cvt_pk_bf16_f32 %0, %1, %2" : "=v"(r) : "v"(lo), "v"(hi)); return r; }
typedef float f32x2 __attribute__((ext_vector_type(2)));
template <class Epi, class Sched, bool ALIGN_EPI = false, bool SP2 = false, bool FP8 = false, bool GATHER = false, bool I8 = false>
__device__ __forceinline__ void gemm_phase(PG8_LAS unsigned char* lds, const Gemm g, const Sched& S, const Epi& E, const int wave_in) {
    const int lane = (int)__builtin_amdgcn_mbcnt_hi(~0u, __builtin_amdgcn_mbcnt_lo(~0u, 0u)), wid = wave_in, tid = wid * 64 + lane, wr = wid >> 2, wc = wid & 3, fr = lane & 15, fq = lane >> 4;
    const int K = g.K, nt = K / BK;
    unsigned voffA[2], voffB[2];
#pragma unroll
    for (int i = 0; i < 2; ++i) { int R, C; stage_rc(tid * 16 + i * 8192, R, C); const int Rb = Epi::PERM ? ((R & ~31) + perm32(R & 31)) : R;
        voffA[i] = (unsigned)(R * K + C) * 2u; voffB[i] = (unsigned)(Rb * K + C) * 2u; }
    static_assert(!GATHER || SP2, "GATHER is implemented in the SP2 loop");
    unsigned gA[2][2], ngA[2][2]; int RA[2]; unsigned CA2[2];
#pragma unroll
    for (int i = 0; i < 2; ++i) { int R, C; stage_rc(tid * 16 + i * 8192, R, C); RA[i] = R; CA2[i] = (unsigned)C * 2u; }
    auto load_g = [&](int ui_, unsigned (&dst)[2][2]) {
        if constexpr (GATHER) {
#pragma unroll
            for (int h = 0; h < 2; ++h)
#pragma unroll
                for (int i = 0; i < 2; ++i) dst[h][i] = (unsigned)S.tokl[ui_ * 256 + 128 * h + RA[i]] * (unsigned)(K * 2) + CA2[i];
        }
    };
    const size_t kstep = (size_t)(BK * 2);
    const size_t hstep = (size_t)HALF * K * 2;
    const size_t tstep = 2 * hstep;
    const size_t hstepA = GATHER ? (size_t)0 : hstep, tstepA = GATHER ? (size_t)0 : 2 * hstep;
    const unsigned ldsw = (unsigned)wid * 1024u;
    const int aoff = lds_byte(wr * 64 + fr, fq * 8), boff = lds_byte(wc * 32 + fr, fq * 8);
#define PG8_SA(b, h) (((b) * 2 + (h)) * HTB)
#define PG8_SB(b, h) ((4 + (b) * 2 + (h)) * HTB)
#define PG8_STAGE(bufoff, gbase, voff) do { _Pragma("unroll") for (int _i = 0; _i < 2; ++_i) \
        __builtin_amdgcn_global_load_lds((const unsigned*)((const char*)(gbase) + (voff)[_i]), (PG8_LAS unsigned*)(lds + (bufoff) + ldsw + _i * 8192), 16, 0, 0); } while (0)
#define PG8_STAGE_A(bufoff, gbase, gvoff) do { if constexpr (GATHER) { PG8_STAGE(bufoff, gbase, gvoff); } else { PG8_STAGE(bufoff, gbase, voffA); } } while (0)
#define PG8_LDA(dst, b, h) do { if constexpr (FP8) { _Pragma("unroll") for (int m = 0; m < 4; ++m) dst##8[m] = __builtin_shufflevector(*(const PG8_LAS v4i_*)(lds + PG8_SA(b, h) + aoff + m * 2048), *(const PG8_LAS v4i_*)(lds + PG8_SA(b, h) + aoff + m * 2048 + 1024), 0, 1, 2, 3, 4, 5, 6, 7); } \
        else { _Pragma("unroll") for (int m = 0; m < 4; ++m) _Pragma("unroll") for (int k = 0; k < 2; ++k) dst[m][k] = *(const PG8_LAS bf16x8*)(lds + PG8_SA(b, h) + aoff + m * 2048 + k * 1024); } } while (0)
#define PG8_LDB(dst, b, h) do { if constexpr (FP8) { _Pragma("unroll") for (int n = 0; n < 2; ++n) dst##8[n] = __builtin_shufflevector(*(const PG8_LAS v4i_*)(lds + PG8_SB(b, h) + boff + n * 2048), *(const PG8_LAS v4i_*)(lds + PG8_SB(b, h) + boff + n * 2048 + 1024), 0, 1, 2, 3, 4, 5, 6, 7); } \
        else { _Pragma("unroll") for (int n = 0; n < 2; ++n) _Pragma("unroll") for (int k = 0; k < 2; ++k) dst[n][k] = *(const PG8_LAS bf16x8*)(lds + PG8_SB(b, h) + boff + n * 2048 + k * 1024); } } while (0)
#define PG8_MMA(ai, bj, At, Bt) do { __builtin_amdgcn_s_setprio(1); \
        if constexpr (FP8) {   \
              \
            _Pragma("unroll") for (int m = 0; m < 4; ++m) _Pragma("unroll") for (int n = 0; n < 2; ++n) \
                asm volatile("v_mfma_scale_f32_16x16x128_f8f6f4 %0, %1, %2, %0, %3, %4 op_sel_hi:[0,0,0]" : "+v"(acc[ai][bj][m][n]) : "v"(Bt##8[n]), "v"(At##8[m]), "v"(scale_w), "v"(scale_x)); \
        } else { \
        _Pragma("unroll") for (int m = 0; m < 4; ++m) _Pragma("unroll") for (int n = 0; n < 2; ++n) _Pragma("unroll") for (int k = 0; k < 2; ++k) { \
        if constexpr (I8) acc[ai][bj][m][n] = __builtin_bit_cast(f32x4, __builtin_amdgcn_mfma_i32_16x16x64_i8(__builtin_bit_cast(v4i_, Bt[n][k]), __builtin_bit_cast(v4i_, At[m][k]), __builtin_bit_cast(v4i_, acc[ai][bj][m][n]), 0, 0, 0)); \
        else acc[ai][bj][m][n] = __builtin_amdgcn_mfma_f32_16x16x32_bf16(Bt[n][k], At[m][k], acc[ai][bj][m][n], 0, 0, 0); } } __builtin_amdgcn_s_setprio(0); } while (0)
#define PG8_WAIT_V(n) asm volatile("s_waitcnt vmcnt(" #n ")" ::: "memory")
#define PG8_WAIT_L(n) asm volatile("s_waitcnt lgkmcnt(" #n ")" ::: "memory")
#define PG8_BAR __builtin_amdgcn_s_barrier()
#define PG8_SCHED __builtin_amdgcn_sched_barrier(0)
    Unit cur, nxt; int ui = 0;
    if (!S.next(0, cur)) return;
    f32x4 acc[2][2][4][2];
#pragma unroll
    for (int a = 0; a < 2; ++a)
#pragma unroll
        for (int b = 0; b < 2; ++b)
#pragma unroll
            for (int m = 0; m < 4; ++m)
#pragma unroll
                for (int n = 0; n < 2; ++n) acc[a][b][m][n] = (f32x4){0.f, 0.f, 0.f, 0.f};
    auto xdl_settle = [&]() {
        asm volatile("s_nop 15\n\ts_nop 15" : "+v"(acc[0][0][0][0]), "+v"(acc[0][0][0][1]), "+v"(acc[0][0][1][0]), "+v"(acc[0][0][1][1]), "+v"(acc[0][0][2][0]), "+v"(acc[0][0][2][1]), "+v"(acc[0][0][3][0]), "+v"(acc[0][0][3][1]), "+v"(acc[0][1][0][0]), "+v"(acc[0][1][0][1]), "+v"(acc[0][1][1][0]), "+v"(acc[0][1][1][1]), "+v"(acc[0][1][2][0]), "+v"(acc[0][1][2][1]), "+v"(acc[0][1][3][0]), "+v"(acc[0][1][3][1]));
        asm volatile("s_nop 0" : "+v"(acc[1][0][0][0]), "+v"(acc[1][0][0][1]), "+v"(acc[1][0][1][0]), "+v"(acc[1][0][1][1]), "+v"(acc[1][0][2][0]), "+v"(acc[1][0][2][1]), "+v"(acc[1][0][3][0]), "+v"(acc[1][0][3][1]), "+v"(acc[1][1][0][0]), "+v"(acc[1][1][0][1]), "+v"(acc[1][1][1][0]), "+v"(acc[1][1][1][1]), "+v"(acc[1][1][2][0]), "+v"(acc[1][1][2][1]), "+v"(acc[1][1][3][0]), "+v"(acc[1][1][3][1]));
    };
    const int scale_w = 0x79797979, scale_x = 0x7f7f7f7f;
    bf16x8 At[4][2], B0[2][2], B1[2][2]; v8i_ At8[4], B08[2], B18[2];
    const char* cA = (const char*)g.A + (size_t)cur.pm * tstepA; const char* cB = (const char*)g.Bt + (size_t)cur.pn * tstep;
    load_g(0, gA);
    S.a_ready(cur);
    if constexpr (SP2) {
        PG8_STAGE(PG8_SB(0, 0), cB, voffB); PG8_STAGE(PG8_SB(0, 1), cB + hstep, voffB); PG8_STAGE_A(PG8_SA(0, 0), cA, gA[0]); PG8_STAGE_A(PG8_SA(0, 1), cA + hstepA, gA[1]);
        if (wr == 1) PG8_BAR;
        PG8_WAIT_V(2); PG8_BAR;
        PG8_STAGE(PG8_SB(1, 0), cB + kstep, voffB); PG8_STAGE_A(PG8_SA(1, 0), cA + kstep, gA[0]); PG8_STAGE(PG8_SB(1, 1), cB + hstep + kstep, voffB);
        PG8_WAIT_V(6); PG8_BAR;
    } else {
        PG8_STAGE(PG8_SB(0, 0), cB, voffB); PG8_STAGE(PG8_SA(0, 0), cA, voffA); PG8_STAGE(PG8_SB(0, 1), cB + hstep, voffB); PG8_STAGE(PG8_SA(0, 1), cA + hstep, voffA);
        if (wr == 1) PG8_BAR;
        PG8_WAIT_V(4); PG8_BAR;
        PG8_STAGE(PG8_SB(1, 0), cB + kstep, voffB); PG8_STAGE(PG8_SA(1, 0), cA + kstep, voffA); PG8_STAGE(PG8_SB(1, 1), cB + hstep + kstep, voffB);
        PG8_WAIT_V(6); PG8_BAR;
    }
    for (;;) {
        const bool has_next = S.next(ui + 1, nxt);
        const char* nA = has_next ? (const char*)g.A + (size_t)nxt.pm * tstepA : cA; const char* nB = has_next ? (const char*)g.Bt + (size_t)nxt.pn * tstep : cB;
        if constexpr (GATHER) { if (has_next) load_g(ui + 1, ngA); else {
#pragma unroll
            for (int h = 0; h < 2; ++h)
#pragma unroll
                for (int i = 0; i < 2; ++i) ngA[h][i] = gA[h][i]; } }
        for (int t = 0; t < nt; t += 2) {
            const bool last = (t == nt - 2);
            const char* a1 = cA + (size_t)(t + 1) * kstep;
            const char* a2 = last ? nA : cA + (size_t)(t + 2) * kstep; const char* b2 = last ? nB : cB + (size_t)(t + 2) * kstep;
            const char* a3 = a2 + kstep; const char* b3 = b2 + kstep;
            if (last && has_next) S.a_ready(nxt);
            unsigned sN[2][2];
#pragma unroll
            for (int h = 0; h < 2; ++h)
#pragma unroll
                for (int i = 0; i < 2; ++i) sN[h][i] = last ? ngA[h][i] : gA[h][i];
            if constexpr (SP2) {
            PG8_LDB(B0, 0, 0); PG8_LDB(B1, 0, 1); PG8_SCHED; PG8_LDA(At, 0, 0); PG8_STAGE_A(PG8_SA(1, 1), a1 + hstepA, gA[1]);
            PG8_WAIT_V(8); PG8_WAIT_L(0); PG8_BAR; PG8_MMA(0, 0, At, B0); PG8_MMA(0, 1, At, B1); PG8_BAR; PG8_SCHED;
            PG8_LDA(At, 0, 1); PG8_STAGE(PG8_SB(0, 0), b2, voffB); PG8_STAGE(PG8_SB(0, 1), b2 + hstep, voffB); PG8_STAGE_A(PG8_SA(0, 0), a2, sN[0]);
            PG8_WAIT_V(8); PG8_WAIT_L(0); PG8_BAR; PG8_MMA(1, 0, At, B0); PG8_MMA(1, 1, At, B1); PG8_BAR; PG8_SCHED;
            PG8_LDB(B0, 1, 0); PG8_LDB(B1, 1, 1); PG8_SCHED; PG8_LDA(At, 1, 0); PG8_STAGE_A(PG8_SA(0, 1), a2 + hstepA, sN[1]);
            PG8_WAIT_V(8); PG8_WAIT_L(0); PG8_BAR; PG8_MMA(0, 0, At, B0); PG8_MMA(0, 1, At, B1); PG8_BAR; PG8_SCHED;
            PG8_LDA(At, 1, 1); PG8_STAGE(PG8_SB(1, 0), b3, voffB); PG8_STAGE(PG8_SB(1, 1), b3 + hstep, voffB); PG8_STAGE_A(PG8_SA(1, 0), a3, sN[0]);
            PG8_WAIT_V(8); PG8_WAIT_L(0); PG8_BAR; PG8_MMA(1, 0, At, B0); PG8_MMA(1, 1, At, B1); PG8_BAR; PG8_SCHED;
            } else {
            PG8_LDB(B0, 0, 0); PG8_SCHED; PG8_LDA(At, 0, 0); PG8_STAGE(PG8_SA(1, 1), a1 + hstep, voffA);
            PG8_WAIT_L(8); PG8_BAR; PG8_WAIT_L(0); PG8_MMA(0, 0, At, B0); PG8_BAR; PG8_SCHED;
            PG8_LDB(B1, 0, 1); PG8_STAGE(PG8_SB(0, 0), b2, voffB);
            PG8_BAR; PG8_WAIT_L(0); PG8_MMA(0, 1, At, B1); PG8_BAR;
            PG8_LDA(At, 0, 1); PG8_STAGE(PG8_SA(0, 0), a2, voffA);
            PG8_BAR; PG8_WAIT_L(0); PG8_MMA(1, 0, At, B0); PG8_BAR; PG8_SCHED;
            PG8_STAGE(PG8_SB(0, 1), b2 + hstep, voffB);
            PG8_WAIT_V(6); PG8_BAR; PG8_MMA(1, 1, At, B1); PG8_BAR;
            PG8_LDB(B0, 1, 0); PG8_SCHED; PG8_LDA(At, 1, 0); PG8_STAGE(PG8_SA(0, 1), a2 + hstep, voffA);
            PG8_WAIT_L(8); PG8_BAR; PG8_WAIT_L(0); PG8_MMA(0, 0, At, B0); PG8_BAR; PG8_SCHED;
            PG8_LDB(B1, 1, 1); PG8_STAGE(PG8_SB(1, 0), b3, voffB);
            PG8_BAR; PG8_WAIT_L(0); PG8_MMA(0, 1, At, B1); PG8_BAR;
            PG8_LDA(At, 1, 1); PG8_STAGE(PG8_SA(1, 0), a3, voffA);
            PG8_BAR; PG8_WAIT_L(0); PG8_MMA(1, 0, At, B0); PG8_BAR; PG8_SCHED;
            PG8_STAGE(PG8_SB(1, 1), b3 + hstep, voffB);
            PG8_WAIT_V(6); PG8_BAR; PG8_MMA(1, 1, At, B1); PG8_BAR;
            }
            if constexpr (Epi::KHOOK) { constexpr int HK = FP8 ? 4 : 8, HS = FP8 ? 2 : 3;
                if ((((t + 2) & (HK - 1)) == 0) && (t + 2 < nt)) { if constexpr (FP8) xdl_settle(); E.khook(acc, ((t + 2) >> HS) - 1, wr, fr); if constexpr (FP8) xdl_settle(); } }
        }
        if constexpr (ALIGN_EPI) { if (wr == 0) PG8_BAR; }
        if constexpr (FP8) {
            xdl_settle();
        }
        if constexpr (!Epi::AFTER_DRAIN) { E(acc, cur, wr, wc, fr, fq); S.done(cur); }
        if (!has_next) break;
#pragma unroll
        for (int a = 0; a < 2; ++a)
#pragma unroll
            for (int b = 0; b < 2; ++b)
#pragma unroll
                for (int m = 0; m < 4; ++m)
#pragma unroll
                    for (int n = 0; n < 2; ++n) acc[a][b][m][n] = (f32x4){0.f, 0.f, 0.f, 0.f};
        cur = nxt; cA = nA; cB = nB; ++ui;
        if constexpr (GATHER) {
#pragma unroll
            for (int h = 0; h < 2; ++h)
#pragma unroll
                for (int i = 0; i < 2; ++i) gA[h][i] = ngA[h][i]; }
        if constexpr (ALIGN_EPI) { if (wr == 1) PG8_BAR; }
    }
    PG8_WAIT_V(0);
    if constexpr (!ALIGN_EPI) { if (wr == 0) PG8_BAR; }
    PG8_BAR;
    if constexpr (Epi::AFTER_DRAIN) { E.fused(acc, cur, wr, wc, fr, fq, lds, wid, lane); S.done(cur); }
#undef PG8_SA
#undef PG8_SB
#undef PG8_STAGE
#undef PG8_STAGE_A
#undef PG8_LDA
#undef PG8_LDB
#undef PG8_MMA
#undef PG8_WAIT_V
#undef PG8_WAIT_L
#undef PG8_BAR
#undef PG8_SCHED
}
}

#define DI __device__ __forceinline__
#define GAS __attribute__((address_space(1)))
#define LAS __attribute__((address_space(3)))
typedef unsigned short bf16;
typedef unsigned v4u __attribute__((ext_vector_type(4)));
typedef unsigned v2u __attribute__((ext_vector_type(2)));
typedef float f32x4 __attribute__((ext_vector_type(4)));
typedef float f32x16 __attribute__((ext_vector_type(16)));
typedef short bf16x8 __attribute__((ext_vector_type(8)));
typedef __bf16 bf2v __attribute__((ext_vector_type(2)));
typedef float f2v __attribute__((ext_vector_type(2)));
typedef GAS unsigned gu32;

constexpr int NWAVES = 8, NTHREADS = 512;
constexpr int M = 16384, D = 1024, DIN = 2048, NH = 32, HD = 64, NGRP = 4, NST = 128, XBCW = 3072;
constexpr int NPROJ = 9216, WIN_LD = 9248;
constexpr int LCH = 128, NCH = M / LCH;
constexpr int NE = 64, DFF = 512;
constexpr float EPS = 1e-6f;
constexpr float LOG2E = 1.4426950408889634f;

constexpr size_t MiB = 1u << 20;
constexpr size_t WS_CTL = 0, CTL_ZERO_BYTES = 262144;
constexpr size_t WS_WIN = 1 * MiB, WS_WDT = 19 * MiB, WS_WCV = 20 * MiB, WS_WMIX = 22 * MiB, WS_WSSM = 24 * MiB;
constexpr size_t WS_RSTD = 31 * MiB + 524288;
constexpr size_t WS_DT = 28 * MiB, WS_CD = 30 * MiB, WS_WRH = 30 * MiB + 65536, WS_WRL = WS_WRH + 262144, WS_ROUTE = 31 * MiB;
constexpr size_t WS_ST = 32 * MiB, WS_YS = 96 * MiB, WS_TMP = 160 * MiB, WS_MG = 192 * MiB;
constexpr size_t WS_W13 = 32 * MiB, WS_W2 = 160 * MiB, WS_H16 = 96 * MiB;
constexpr size_t WS_XN8 = 32 * MiB, WS_W8IN = 48 * MiB, WS_SA = 60 * MiB, WS_SW = 61 * MiB;
constexpr size_t WS_XN = 224 * MiB;
constexpr size_t WS_U = 256 * MiB, WS_ZS = 288 * MiB, WS_XBC = 352 * MiB, WS_GATE = 448 * MiB;
constexpr size_t WS_LIST = 256 * MiB, WS_HDN = 352 * MiB, WS_YEXP = 400 * MiB;
constexpr size_t WS_END = 512 * MiB;
constexpr int CW_BAR = 4096;
constexpr int CW_CNT = 8192;
constexpr int CW_MODC = 40960;
constexpr int CW_WMAX = 49152;
constexpr int CW_MOD = 16384;

constexpr int RING_BYTES = 131072;
constexpr int LDSCTL_OFF = 147456;
constexpr int TB_OFF = LDSCTL_OFF + 256;
constexpr int CNTL_OFF = TB_OFF + 320;
constexpr int TOKL_OFF = LDSCTL_OFF + 1024;
constexpr int RT_OFF = 148480;
constexpr int LDS_BYTES = 152576;

#define LDS_WAIT() asm volatile("s_waitcnt lgkmcnt(0)" ::: "memory")
#define VM_WAIT() asm volatile("s_waitcnt vmcnt(0)" ::: "memory")

DI unsigned pk2(float lo, float hi) { f2v v = {lo, hi}; return __builtin_bit_cast(unsigned, __builtin_convertvector(v, bf2v)); }
DI unsigned pk4_fp8(float a, float b, float c, float d) {
    a = __builtin_fminf(__builtin_fmaxf(a, -448.f), 448.f); b = __builtin_fminf(__builtin_fmaxf(b, -448.f), 448.f);
    c = __builtin_fminf(__builtin_fmaxf(c, -448.f), 448.f); d = __builtin_fminf(__builtin_fmaxf(d, -448.f), 448.f);
    unsigned w = 0u; w = __builtin_amdgcn_cvt_pk_fp8_f32(a, b, w, false); w = __builtin_amdgcn_cvt_pk_fp8_f32(c, d, w, true); return w; }
DI unsigned pk4_fp8_nc(float a, float b, float c, float d) { unsigned w = 0u; w = __builtin_amdgcn_cvt_pk_fp8_f32(a, b, w, false); w = __builtin_amdgcn_cvt_pk_fp8_f32(c, d, w, true); return w; }
DI unsigned pk4_i8(float a, float b, float c, float d) {
    const int ia = (int)__builtin_rintf(a), ib = (int)__builtin_rintf(b), ic = (int)__builtin_rintf(c), id = (int)__builtin_rintf(d);
    return ((unsigned)ia & 255u) | (((unsigned)ib & 255u) << 8) | (((unsigned)ic & 255u) << 16) | ((unsigned)id << 24); }
DI unsigned pk2_fp8(float a, float b) {
    a = __builtin_fminf(__builtin_fmaxf(a, -448.f), 448.f); b = __builtin_fminf(__builtin_fmaxf(b, -448.f), 448.f);
    return __builtin_amdgcn_cvt_pk_fp8_f32(a, b, 0u, false) & 0xffffu; }
DI bf16x8 fp8x8_to_bf16(v2u w) {
    v4u o; o.x = pk2(__builtin_amdgcn_cvt_f32_fp8(w.x, 0), __builtin_amdgcn_cvt_f32_fp8(w.x, 1)); o.y = pk2(__builtin_amdgcn_cvt_f32_fp8(w.x, 2), __builtin_amdgcn_cvt_f32_fp8(w.x, 3));
    o.z = pk2(__builtin_amdgcn_cvt_f32_fp8(w.y, 0), __builtin_amdgcn_cvt_f32_fp8(w.y, 1)); o.w = pk2(__builtin_amdgcn_cvt_f32_fp8(w.y, 2), __builtin_amdgcn_cvt_f32_fp8(w.y, 3));
    return __builtin_bit_cast(bf16x8, o); }
DI float bflo(unsigned u) { return __uint_as_float(u << 16); }
DI float bfhi(unsigned u) { return __uint_as_float(u & 0xffff0000u); }
DI float sigmoidf_(float x) { return __builtin_amdgcn_rcpf(1.f + __builtin_amdgcn_exp2f(x * -LOG2E)); }
DI float siluf_(float x) { return x * __builtin_amdgcn_rcpf(1.f + __builtin_amdgcn_exp2f(x * -LOG2E)); }
DI float wave_sum(float v) {
#pragma unroll
    for (int o = 1; o < 64; o <<= 1) v += __shfl_xor(v, o);
    return v;
}
DI f32x4 mod4(const float* modp, int k) { return (*(const f32x4*)(modp + k) + *(const f32x4*)(modp + 6144 + k)) + (*(const f32x4*)(modp + 2 * 6144 + k) + *(const f32x4*)(modp + 3 * 6144 + k)); }
DI int crow(int reg, int hh) { return (reg & 3) + 8 * (reg >> 2) + 4 * hh; }
DI int swz(int row, int chunk) { return chunk ^ ((row ^ (row >> 3)) & 15); }
#define MFMA32(a, b, c) __builtin_amdgcn_mfma_f32_32x32x16_bf16((a), (b), (c), 0, 0, 0)

DI int lane_id() { return (int)__builtin_amdgcn_mbcnt_hi(~0u, __builtin_amdgcn_mbcnt_lo(~0u, 0u)); }
#define XB_TMO      128
#define XB_XCNT(j)  (256  + 64 * (j))
#define XB_XSUB(j)  (1280 + 64 * (j))
#define XB_XGEN(j)  (2304 + 64 * (j))
#define XB_TOP      3328
#define XB_TOPGEN   3392
#define XCD_BAR_WORDS 3456
#define XB_SPIN_CAP (1u << 18)
DI unsigned xb_ld(unsigned* p)              { return __hip_atomic_load(p, __ATOMIC_RELAXED, __HIP_MEMORY_SCOPE_AGENT); }
DI unsigned xb_add(unsigned* p, unsigned v) { return __hip_atomic_fetch_add(p, v, __ATOMIC_RELAXED, __HIP_MEMORY_SCOPE_AGENT); }
DI unsigned xb_xcc_id() { return (unsigned)__builtin_amdgcn_s_getreg((3 << 11) | 20) & 0xFu; }
#define XB_SPIN(cond, bar) do { unsigned _sp = 0; while (cond) { __builtin_amdgcn_s_sleep(1); \
    if ((++_sp & 255u) == 0u) { if (xb_ld(&(bar)[XB_TMO])) break; if (_sp > XB_SPIN_CAP) { atomicAdd(&(bar)[XB_TMO], 1u); break; } } } } while (0)
struct XcdBarrier { unsigned* bar; unsigned x; volatile LAS unsigned* st; int wave; };
DI XcdBarrier xcd_barrier_post(unsigned* bar, volatile LAS unsigned* st) {
    XcdBarrier b; b.bar = bar; b.x = xb_xcc_id(); b.st = st; b.wave = 0;
    if (threadIdx.x == 0) (void)xb_add(&bar[XB_XCNT(b.x)], 1u);
    return b;
}
DI void xcd_barrier_complete(unsigned* bar, unsigned x, unsigned& nloc, unsigned& nx) {
    const unsigned G = gridDim.x * gridDim.y * gridDim.z;
    unsigned sum, cnt, mine, sp = 0u;
    for (;;) {
        sum = 0u; cnt = 0u; mine = 0u;
#pragma unroll
        for (unsigned j = 0; j < 16; ++j) { const unsigned c = xb_ld(&bar[XB_XCNT(j)]); sum += c; cnt += (c > 0u) ? 1u : 0u; mine = (j == x) ? c : mine; }
        if (sum == G) break;
        __builtin_amdgcn_s_sleep(1);
        if ((++sp & 255u) == 0u) { if (xb_ld(&bar[XB_TMO])) break; if (sp > XB_SPIN_CAP) { atomicAdd(&bar[XB_TMO], 1u); break; } }
    }
    nloc = mine > 0u ? mine : 1u; nx = cnt > 0u ? cnt : 1u;
}
DI void xcd_barrier(const XcdBarrier& b) {
    asm volatile("s_waitcnt vmcnt(0)" ::: "memory");
    __syncthreads();
    if (b.wave == 0 && lane_id() == 0) {
        unsigned* bar = b.bar;
        __builtin_amdgcn_s_waitcnt(0);
        unsigned nloc = b.st[0], nx = b.st[1];
        if (nloc == 0u) { xcd_barrier_complete(bar, b.x, nloc, nx); b.st[0] = nloc; b.st[1] = nx; }
        const unsigned old = xb_add(&bar[XB_XSUB(b.x)], 1u);
        const unsigned gen = old / nloc;
        if (old + 1u == (gen + 1u) * nloc) {
            __builtin_amdgcn_fence(__ATOMIC_RELEASE, "agent");
            asm volatile("s_waitcnt vmcnt(0)" ::: "memory");
            const unsigned og = xb_add(&bar[XB_TOP], 1u);
            const unsigned tg = og / nx;
            if (og + 1u == (tg + 1u) * nx) xb_add(&bar[XB_TOPGEN], 1u);
            else XB_SPIN(xb_ld(&bar[XB_TOPGEN]) == tg, bar);
            __builtin_amdgcn_fence(__ATOMIC_ACQUIRE, "agent");
            xb_add(&bar[XB_XGEN(b.x)], 1u);
            asm volatile("s_waitcnt vmcnt(0)" ::: "memory");
        } else {
            XB_SPIN(xb_ld(&bar[XB_XGEN(b.x)]) == gen, bar);
            __builtin_amdgcn_fence(__ATOMIC_ACQUIRE, "agent");
            asm volatile("s_waitcnt vmcnt(0)" ::: "memory");
        }
    }
    __syncthreads();
}

enum { I_X = 0, I_C, I_WADA, I_BADA, I_N1G, I_WIN, I_CVW, I_CVB, I_LNG, I_LNB, I_WCV, I_SCW, I_SCB, I_DTB, I_ALOG, I_DSKIP, I_SNG, I_WSSM, I_WMIX,
       I_N2G, I_WGRP, I_BGRP, I_WER, I_BER, I_W1, I_W3, I_W2, I_FG, N_IN };
struct Args { const float* in[N_IN]; float* out; unsigned char* ws; int ph_lo, ph_hi; };

template <int I> DI const float* argp() {
    auto kp = __builtin_amdgcn_kernarg_segment_ptr();
    unsigned long long v;
    asm volatile("s_load_dwordx2 %0, %1, %2\n\ts_waitcnt lgkmcnt(0)" : "=s"(v) : "s"(kp), "i"(I * 8));
    return (const float*)(const GAS float*)v;
}
#define ARG(i) argp<i>()
struct Ctx {
    LAS unsigned char* lds;
    int wave, vcu, G, xcd, xj;
    unsigned char* ws;
};

DI int xcd_unit(int x, int j, int gx, int i, int N) { const int u = i * gx + j; return (u < (N >> 3)) ? x * (N >> 3) + u : -1; }
DI int inproj_tile(int p) { return p < 8 ? p + 8 : (p < 16 ? p + 20 : (p < 24 ? p - 16 : p - 8)); }
DI int win_col(int npp) { const int np = inproj_tile(npp >> 8) * 256 + (npp & 255);
    if (np < 2048) { const int q = np >> 3, rr = np & 7; return (rr >> 2) * 1024 + 4 * q + (rr & 3); } return np < 7168 ? np : np + 32; }
struct EpiInProj {
    static constexpr bool PERM = true, AFTER_DRAIN = false, KHOOK = false; static constexpr int NPF = 0;
    unsigned char* ws;
    DI static pg8::f32x4 cvt(const pg8::f32x4& a, float sr, const f32x4& sc) { const pg8::v4i_ q = __builtin_bit_cast(pg8::v4i_, a);
        return (pg8::f32x4){(float)q[0] * (sr * sc.x), (float)q[1] * (sr * sc.y), (float)q[2] * (sr * sc.z), (float)q[3] * (sr * sc.w)}; }
    DI void operator()(const pg8::f32x4 (&acc)[2][2][4][2], const pg8::Unit& u, int wr, int wc, int fr, int fq) const {
        const int pn = inproj_tile(u.pn), row0 = u.pm * 256 + wr * 64 + fr;
        const float* SA = (const float*)(ws + WS_SA); const float* SW = (const float*)(ws + WS_SW) + u.pn * 256 + wc * 32 + fq * 8;
        f32x4 sc[2][2];
#pragma unroll
        for (int bj = 0; bj < 2; ++bj) { sc[bj][0] = *(const f32x4*)(SW + bj * 128); sc[bj][1] = *(const f32x4*)(SW + bj * 128 + 4); }
        float sr[2][4];
#pragma unroll
        for (int ai = 0; ai < 2; ++ai)
#pragma unroll
            for (int m = 0; m < 4; ++m) sr[ai][m] = SA[row0 + ai * 128 + m * 16];
        if (pn < 8) {
            bf16* U = (bf16*)(ws + WS_U);
#pragma unroll
            for (int ai = 0; ai < 2; ++ai)
#pragma unroll
                for (int m = 0; m < 4; ++m) {
                    bf16* rowp = U + (size_t)(row0 + ai * 128 + m * 16) * D + pn * 128 + wc * 16 + fq * 4;
#pragma unroll
                    for (int bj = 0; bj < 2; ++bj) { const pg8::f32x4 a = cvt(acc[ai][bj][m][0], sr[ai][m], sc[bj][0]), b = cvt(acc[ai][bj][m][1], sr[ai][m], sc[bj][1]);
                        v2u w; w.x = pk2(a[0] * sigmoidf_(b[0]), a[1] * sigmoidf_(b[1])); w.y = pk2(a[2] * sigmoidf_(b[2]), a[3] * sigmoidf_(b[3]));
                        *(v2u*)(rowp + bj * 64) = w; } }
        } else {
            const bool isz = pn < 16, isx = (pn >= 16) && (pn < 28);
            const size_t boff = isz ? WS_ZS : (isx ? WS_XBC : WS_GATE);
            const int ldc = isx ? XBCW : DIN;
            const int colt = (pn - (isz ? 8 : (isx ? 16 : 28))) * 256;
            bf16* base = (bf16*)(ws + boff);
            const int col0 = colt + wc * 32 + fq * 8;
#pragma unroll
            for (int ai = 0; ai < 2; ++ai)
#pragma unroll
                for (int m = 0; m < 4; ++m) {
                    bf16* rowp = base + (size_t)(row0 + ai * 128 + m * 16) * ldc + col0;
#pragma unroll
                    for (int bj = 0; bj < 2; ++bj) { pg8::f32x4 v0 = cvt(acc[ai][bj][m][0], sr[ai][m], sc[bj][0]), v1 = cvt(acc[ai][bj][m][1], sr[ai][m], sc[bj][1]);
                        if (isz) {
#pragma unroll
                            for (int i = 0; i < 4; ++i) { v0[i] = v0[i] * sigmoidf_(v0[i]); v1[i] = v1[i] * sigmoidf_(v1[i]); }
                        }
                        if (!isz && !isx) {
                            v2u w8; w8.x = pk4_fp8(v0[0], v0[1], v0[2], v0[3]); w8.y = pk4_fp8(v1[0], v1[1], v1[2], v1[3]);
                            *(v2u*)((unsigned char*)base + (size_t)(row0 + ai * 128 + m * 16) * ldc + col0 + bj * 128) = w8;
                        } else {
                        v4u w; w.x = pk2(v0[0], v0[1]); w.y = pk2(v0[2], v0[3]); w.z = pk2(v1[0], v1[1]); w.w = pk2(v1[2], v1[3]);
                        *(v4u*)(rowp + bj * 128) = w; } } }
        }
    }
};
template <bool NORM> struct EpiGate {
    static constexpr bool PERM = true, AFTER_DRAIN = false, KHOOK = NORM;
    bf16* O; const bf16* P; const bf16* GATE; int gcol; const LAS float* rt;
    DI void khook(pg8::f32x4 (&acc)[2][2][4][2], int b, int wr, int fr) const {
#pragma unroll
        for (int ai = 0; ai < 2; ++ai)
#pragma unroll
            for (int m = 0; m < 4; ++m) { const float f = rt[(ai * 128 + wr * 64 + m * 16 + fr) * 4 + b];
#pragma unroll
                for (int bj = 0; bj < 2; ++bj)
#pragma unroll
                    for (int n = 0; n < 2; ++n) acc[ai][bj][m][n] = acc[ai][bj][m][n] * f; }
    }
    DI void operator()(const pg8::f32x4 (&acc)[2][2][4][2], const pg8::Unit& u, int wr, int wc, int fr, int fq) const {
        const int row0 = u.pm * 256 + wr * 64 + fr, col0 = u.pn * 256 + wc * 32 + fq * 8;
        v2u g[4]; v4u p[4], wA[4], wB[4];
        auto loadq = [&](int bj, int ai) {
#pragma unroll
            for (int m = 0; m < 4; ++m) { const size_t r = (size_t)(row0 + ai * 128 + m * 16); const int c = col0 + bj * 128;
                g[m] = *(const v2u*)((const unsigned char*)GATE + r * (2 * D) + gcol + c); if (NORM) p[m] = *(const v4u*)(P + r * D + c); }
        };
        auto calcq = [&](int bj, int ai, v4u (&w)[4]) {
#pragma unroll
            for (int m = 0; m < 4; ++m) {
                float f = 1.0f; if (NORM) f = rt[(ai * 128 + wr * 64 + m * 16 + fr) * 4 + 3];
                const v2u gg = g[m];
                pg8::f32x4 v0 = acc[ai][bj][m][0] * f, v1 = acc[ai][bj][m][1] * f;
                float o[8] = {v0[0] * sigmoidf_(__builtin_amdgcn_cvt_f32_fp8(gg.x, 0)), v0[1] * sigmoidf_(__builtin_amdgcn_cvt_f32_fp8(gg.x, 1)), v0[2] * sigmoidf_(__builtin_amdgcn_cvt_f32_fp8(gg.x, 2)), v0[3] * sigmoidf_(__builtin_amdgcn_cvt_f32_fp8(gg.x, 3)),
                              v1[0] * sigmoidf_(__builtin_amdgcn_cvt_f32_fp8(gg.y, 0)), v1[1] * sigmoidf_(__builtin_amdgcn_cvt_f32_fp8(gg.y, 1)), v1[2] * sigmoidf_(__builtin_amdgcn_cvt_f32_fp8(gg.y, 2)), v1[3] * sigmoidf_(__builtin_amdgcn_cvt_f32_fp8(gg.y, 3))};
                if (NORM) { const v4u pp = p[m];
                    o[0] += bflo(pp.x); o[1] += bfhi(pp.x); o[2] += bflo(pp.y); o[3] += bfhi(pp.y); o[4] += bflo(pp.z); o[5] += bfhi(pp.z); o[6] += bflo(pp.w); o[7] += bfhi(pp.w); }
                w[m].x = pk2(o[0], o[1]); w[m].y = pk2(o[2], o[3]); w[m].z = pk2(o[4], o[5]); w[m].w = pk2(o[6], o[7]); }
        };
        auto storeq = [&](int bj, int ai, const v4u (&w)[4]) {
#pragma unroll
            for (int m = 0; m < 4; ++m) *(v4u*)(O + (size_t)(row0 + ai * 128 + m * 16) * D + col0 + bj * 128) = w[m];
        };
        loadq(0, 0); calcq(0, 0, wA); loadq(0, 1); storeq(0, 0, wA); calcq(0, 1, wB); loadq(1, 0); storeq(0, 1, wB); calcq(1, 0, wA); loadq(1, 1); storeq(1, 0, wA); calcq(1, 1, wB); storeq(1, 1, wB);
    }
};
struct EpiMix {
    static constexpr bool PERM = true, AFTER_DRAIN = false, KHOOK = false;
    bf16* H; const float* X; const float* g1;
    DI void operator()(const pg8::f32x4 (&acc)[2][2][4][2], const pg8::Unit& u, int wr, int wc, int fr, int fq) const {
        const int row0 = u.pm * 256 + wr * 64 + fr, col0 = u.pn * 256 + wc * 32 + fq * 8;
        f32x4 xa[4], xb[4]; v4u wA[4], wB[4];
        auto loadq = [&](int bj, int ai) {
#pragma unroll
            for (int m = 0; m < 4; ++m) { const size_t off = (size_t)(row0 + ai * 128 + m * 16) * D + col0 + bj * 128;
                xa[m] = __builtin_nontemporal_load((const f32x4*)(X + off)); xb[m] = __builtin_nontemporal_load((const f32x4*)(X + off + 4)); }
        };
        auto calcq = [&](int bj, int ai, v4u (&w)[4]) { const int c = col0 + bj * 128;
            const f32x4 ga = *(const f32x4*)(g1 + c), gb = *(const f32x4*)(g1 + c + 4);
#pragma unroll
            for (int m = 0; m < 4; ++m) { const f32x4 ha = xa[m] + ga * acc[ai][bj][m][0], hb = xb[m] + gb * acc[ai][bj][m][1];
                w[m].x = pk2(ha.x, ha.y); w[m].y = pk2(ha.z, ha.w); w[m].z = pk2(hb.x, hb.y); w[m].w = pk2(hb.z, hb.w); }
        };
        auto storeq = [&](int bj, int ai, const v4u (&w)[4]) {
#pragma unroll
            for (int m = 0; m < 4; ++m) *(v4u*)(H + (size_t)(row0 + ai * 128 + m * 16) * D + col0 + bj * 128) = w[m];
        };
        loadq(0, 0); calcq(0, 0, wA); loadq(0, 1); storeq(0, 0, wA); calcq(0, 1, wB); loadq(1, 0); storeq(0, 1, wB); calcq(1, 0, wA); loadq(1, 1); storeq(1, 0, wA); calcq(1, 1, wB); storeq(1, 1, wB);
    }
};
struct EpiUp {
    static constexpr bool PERM = true, AFTER_DRAIN = false, KHOOK = false;
    unsigned char* HDN;
    DI void operator()(const pg8::f32x4 (&acc)[2][2][4][2], const pg8::Unit& u, int wr, int wc, int fr, int fq) const {
        const int j = u.pn & 3, row0 = u.pm * 256 + wr * 64 + fr, col0 = j * 128 + wc * 16 + fq * 4;
#pragma unroll
        for (int ai = 0; ai < 2; ++ai)
#pragma unroll
            for (int m = 0; m < 4; ++m) { unsigned char* rowp = HDN + (size_t)(row0 + ai * 128 + m * 16) * DFF + col0;
#pragma unroll
                for (int bj = 0; bj < 2; ++bj) { const pg8::f32x4 a = acc[ai][bj][m][0], b = acc[ai][bj][m][1];
                    *(unsigned*)(rowp + bj * 64) = pk4_fp8(siluf_(a[0]) * b[0], siluf_(a[1]) * b[1], siluf_(a[2]) * b[2], siluf_(a[3]) * b[3]); } }
    }
};
struct EpiDown {
    static constexpr bool PERM = true, AFTER_DRAIN = false, KHOOK = false;
    unsigned char* Y;
    DI void operator()(const pg8::f32x4 (&acc)[2][2][4][2], const pg8::Unit& u, int wr, int wc, int fr, int fq) const {
        const int j = u.pn & 3, row0 = u.pm * 256 + wr * 64 + fr, col0 = j * 256 + wc * 32 + fq * 8;
#pragma unroll
        for (int ai = 0; ai < 2; ++ai)
#pragma unroll
            for (int m = 0; m < 4; ++m) { unsigned char* rowp = Y + (size_t)(row0 + ai * 128 + m * 16) * D + col0;
#pragma unroll
                for (int bj = 0; bj < 2; ++bj) { const pg8::f32x4 v0 = acc[ai][bj][m][0] * 16.0f, v1 = acc[ai][bj][m][1] * 16.0f;
                    v2u w; w.x = pk4_fp8(v0[0], v0[1], v0[2], v0[3]); w.y = pk4_fp8(v1[0], v1[1], v1[2], v1[3]);
                    *(v2u*)(rowp + bj * 128) = w; } }
    }
};
struct MoeOrder {
    const LAS int* tb; int G, c, total, reps; const LAS int* tokl;
    DI bool next(int i0, pg8::Unit& u) const {
        const int n = (total - c + G - 1) / G; if (n <= 0 || i0 >= n * reps) return false;
        const int i = i0 % n; const int uu = i * G + c;
        const int T = uu >> 2; int e = 0;
        while (e < NE - 1 && tb[e + 1] <= T) ++e;
        u.pm = T; u.pn = 4 * e + (uu & 3); return true;
    }
    DI void a_ready(const pg8::Unit&) const {}
    DI void done(const pg8::Unit&) const {}
};

struct OneUnit { pg8::Unit u;
    DI bool next(int i, pg8::Unit& o) const { if (i != 0) return false; o = u; return true; }
    DI void a_ready(const pg8::Unit&) const {}
    DI void done(const pg8::Unit&) const {} };

template <class SrcF>
DI void transpose_item(SrcF src, int K, bf16* WT, LAS float* scr, int kb, int n0, int lane) {
    const int k0 = 64 * kb;
#pragma unroll 8
    for (int i = 0; i < 32; ++i) { const int kk = 2 * i + (lane >> 5); scr[kk * 33 + (lane & 31)] = src(k0 + kk, n0 + (lane & 31)); }
    LDS_WAIT(); asm volatile("" ::: "memory");
    const int c = lane & 7;
#pragma unroll
    for (int j = 0; j < 4; ++j) { const int n = (lane >> 3) + 8 * j; const LAS float* s = scr + (8 * c) * 33 + n;
        v4u o; o.x = pk2(s[0 * 33], s[1 * 33]); o.y = pk2(s[2 * 33], s[3 * 33]); o.z = pk2(s[4 * 33], s[5 * 33]); o.w = pk2(s[6 * 33], s[7 * 33]);
        *(v4u*)(WT + (size_t)(n0 + n) * K + k0 + 8 * c) = o; }
    LDS_WAIT(); asm volatile("" ::: "memory");
}

template <class SrcF>
DI void transpose_item8(SrcF src, int K, unsigned char* WT, LAS float* scr, int kb, int n0, int lane) {
    const int k0 = 64 * kb;
#pragma unroll 8
    for (int i = 0; i < 32; ++i) { const int kk = 2 * i + (lane >> 5); scr[kk * 33 + (lane & 31)] = src(k0 + kk, n0 + (lane & 31)) * 64.0f; }
    LDS_WAIT(); asm volatile("" ::: "memory");
#pragma unroll
    for (int i = 0; i < 2; ++i) { const int p = lane + 64 * i, n = p >> 2, c = p & 3; const LAS float* s = scr + (16 * c) * 33 + n;
        v4u o; o.x = pk4_fp8(s[0 * 33], s[1 * 33], s[2 * 33], s[3 * 33]); o.y = pk4_fp8(s[4 * 33], s[5 * 33], s[6 * 33], s[7 * 33]);
        o.z = pk4_fp8(s[8 * 33], s[9 * 33], s[10 * 33], s[11 * 33]); o.w = pk4_fp8(s[12 * 33], s[13 * 33], s[14 * 33], s[15 * 33]);
        *(v4u*)(WT + (size_t)(n0 + n) * K + k0 + 16 * c) = o; }
    LDS_WAIT(); asm volatile("" ::: "memory");
}

template <class SrcF>
DI void transpose_item_i8(SrcF src, float inv, int K, unsigned char* WT, LAS float* scr, int kb, int n0, int lane) {
    const int k0 = 64 * kb;
#pragma unroll 8
    for (int i = 0; i < 32; ++i) { const int kk = 2 * i + (lane >> 5); scr[kk * 33 + (lane & 31)] = src(k0 + kk, n0 + (lane & 31)) * inv; }
    LDS_WAIT(); asm volatile("" ::: "memory");
#pragma unroll
    for (int i = 0; i < 2; ++i) { const int p = lane + 64 * i, n = p >> 2, c = p & 3; const LAS float* s = scr + (16 * c) * 33 + n;
        v4u o; o.x = pk4_i8(s[0 * 33], s[1 * 33], s[2 * 33], s[3 * 33]); o.y = pk4_i8(s[4 * 33], s[5 * 33], s[6 * 33], s[7 * 33]);
        o.z = pk4_i8(s[8 * 33], s[9 * 33], s[10 * 33], s[11 * 33]); o.w = pk4_i8(s[12 * 33], s[13 * 33], s[14 * 33], s[15 * 33]);
        *(v4u*)(WT + (size_t)(n0 + n) * K + k0 + 16 * c) = o; }
    LDS_WAIT(); asm volatile("" ::: "memory");
}

DI void ph0_prologue(const Ctx& F, const Args& a, int reps) {
    const int gw = F.vcu * NWAVES + F.wave, NGW = F.G * NWAVES, lane = lane_id();
    float* mod = (float*)(F.ws + WS_CTL) + CW_MOD;
    {
        const float* cvec = ARG(I_C); const float* wada = ARG(I_WADA); const float* bada = ARG(I_BADA);
        const int r8 = lane >> 3, c4 = lane & 7;
        for (int item0 = gw; item0 < 768 * reps; item0 += NGW) {
            const int item = item0 % 768; const int cc = item % 192, kq = item / 192;
            f32x4 acc = {0.f, 0.f, 0.f, 0.f};
#pragma unroll 8
            for (int i = 0; i < 32; ++i) { const int k = kq * 256 + i * 8 + r8; const float cv = cvec[k]; const float s = siluf_(cv);
                const f32x4 w = *(const f32x4*)(wada + (size_t)k * (6 * D) + cc * 32 + c4 * 4); acc += s * w; }
#pragma unroll
            for (int j = 0; j < 4; ++j) { float v = acc[j]; v += __shfl_xor(v, 8); v += __shfl_xor(v, 16); v += __shfl_xor(v, 32); acc[j] = v; }
            if (lane < 8) {
#pragma unroll
                for (int j = 0; j < 4; ++j) { float v = acc[j]; if (kq == 0) v += bada[cc * 32 + c4 * 4 + j]; mod[kq * 6144 + cc * 32 + c4 * 4 + j] = v; }
            }
        }
    }
    LAS float* scr = (LAS float*)(F.lds + F.wave * 16384);
    const float* win = ARG(I_WIN); const float* wcv = ARG(I_WCV); const float* wmix = ARG(I_WMIX); const float* wssm = ARG(I_WSSM);
    bf16* Win_t = (bf16*)(F.ws + WS_WIN); bf16* Wdt_t = (bf16*)(F.ws + WS_WDT); bf16* Wcv_t = (bf16*)(F.ws + WS_WCV);
    bf16* Wmix_t = (bf16*)(F.ws + WS_WMIX); bf16* Wssm_t = (bf16*)(F.ws + WS_WSSM);
    constexpr int I_IN = 16 * 288, I_DT = 16, I_CV = 16 * 32, I_MX = 16 * 32, I_SS = 32 * 32, I_RT = 16 * 3 * 2;
    constexpr int NITEMS = I_IN + I_DT + I_CV + I_MX + I_SS + I_RT;
    const float* wer = ARG(I_WER); const float* wgrp = ARG(I_WGRP); const float* sng0 = ARG(I_SNG);
    for (int it0 = gw; it0 < NITEMS * reps; it0 += NGW) {
        int r = it0 % NITEMS;
        if (r < I_IN) { const int kb = r / 288, nb = r % 288;
            const int npp = nb * 32 + (lane & 31), col = win_col(npp);
            float mx = 0.f;
#pragma unroll 8
            for (int i = 0; i < 32; ++i) mx = __builtin_fmaxf(mx, __builtin_fabsf(win[(size_t)(64 * kb + 2 * i + (lane >> 5)) * WIN_LD + col]));
            mx = __builtin_fmaxf(mx, __shfl_xor(mx, 32));
            if (lane < 32) atomicMax((unsigned*)(F.ws + WS_CTL) + CW_WMAX + npp, __float_as_uint(mx));
            continue; } r -= I_IN;
        if (r < I_DT) { transpose_item([&](int k, int np) -> float { return win[(size_t)k * WIN_LD + 7168 + np]; }, D, Wdt_t, scr, r, 0, lane); continue; } r -= I_DT;
        if (r < I_CV) { transpose_item([&](int k, int np) -> float { return wcv[(size_t)k * D + np]; }, D, Wcv_t, scr, r / 32, (r % 32) * 32, lane); continue; } r -= I_CV;
        if (r < I_MX) { transpose_item([&](int k, int np) -> float { return wmix[(size_t)k * D + np]; }, D, Wmix_t, scr, r / 32, (r % 32) * 32, lane); continue; } r -= I_MX;
        if (r < I_SS) { transpose_item8([&](int k, int np) -> float { return wssm[(size_t)k * D + np] * sng0[k]; }, DIN, (unsigned char*)Wssm_t, scr, r / 32, (r % 32) * 32, lane); continue; } r -= I_SS;
        {
            const int lo = r / 48, rr = r % 48, kb = rr / 3, nb = rr % 3;
            auto wsrc = [&](int k, int np) -> float { float w = 0.f; if (np < 64) w = wer[(size_t)k * NE + np]; else if (np < 72) w = wgrp[(size_t)k * 8 + (np - 64)];
                const float hi = bflo(pk2(w, 0.f)); return lo ? (w - hi) : hi; };
            transpose_item(wsrc, D, (bf16*)(F.ws + (lo ? WS_WRL : WS_WRH)), scr, kb, nb * 32, lane);
        }
    }
}

DI void convert_experts(const Ctx& F, const Args& a) {
    const int gw = F.vcu * NWAVES + F.wave, NGW = F.G * NWAVES, lane = lane_id();
    LAS float* scr = (LAS float*)(F.lds + F.wave * 17408);
    const float* w1 = ARG(I_W1); const float* w3 = ARG(I_W3); const float* w2 = ARG(I_W2);
    unsigned char* W13_t = F.ws + WS_W13; unsigned char* W2_t = F.ws + WS_W2;
    constexpr int I_13 = NE * 4 * 16, I_2 = NE * 2 * 16, NIT = I_13 + I_2;
    const int ch = lane & 15, kq = lane >> 4;
    for (int it = gw; it < NIT; it += NGW) {
        const float* src; size_t ld; unsigned char* dst;
        if (it < I_13) { const int e = it >> 6, r = it & 63, kb = r >> 4, cb = r & 15;
            src = ((ch & 1) ? w3 : w1) + (size_t)e * D * DFF + (size_t)(256 * kb + kq) * DFF + 32 * cb + 4 * (ch >> 1); ld = DFF;
            dst = W13_t + (size_t)e * D * D + (size_t)(64 * cb + lane) * D + 256 * kb;
        } else { const int r0 = it - I_13, e = r0 >> 5, r = r0 & 31, kb = r >> 4, nb = r & 15;
            src = w2 + (size_t)e * DFF * D + (size_t)(256 * kb + kq) * D + 64 * nb + 4 * ch; ld = D;
            dst = W2_t + (size_t)e * D * DFF + (size_t)(64 * nb + lane) * DFF + 256 * kb;
        }
        f32x4 va[16], vb[16]; v4u o[16];
#pragma unroll
        for (int i = 0; i < 16; ++i) va[i] = __builtin_nontemporal_load((const f32x4*)(src + (size_t)(4 * i) * ld));
#pragma unroll
        for (int sub = 0; sub < 4; ++sub) {
            f32x4 (&cur)[16] = (sub & 1) ? vb : va; f32x4 (&nxt)[16] = (sub & 1) ? va : vb;
            if (sub < 3) {
#pragma unroll
                for (int i = 0; i < 16; ++i) nxt[i] = __builtin_nontemporal_load((const f32x4*)(src + (size_t)(64 * (sub + 1) + 4 * i) * ld));
            }
#pragma unroll
            for (int i = 0; i < 16; ++i) *(LAS f32x4*)(scr + (4 * i + kq) * 68 + 4 * ch) = cur[i] * 64.0f;
            LDS_WAIT(); asm volatile("" ::: "memory");
#pragma unroll
            for (int j = 0; j < 4; ++j) {
                unsigned w[4];
#pragma unroll
                for (int q = 0; q < 4; ++q) { const LAS float* sp = scr + (16 * j + 4 * q) * 68 + lane; w[q] = pk4_fp8(sp[0], sp[68], sp[136], sp[204]); }
                o[4 * sub + j].x = w[0]; o[4 * sub + j].y = w[1]; o[4 * sub + j].z = w[2]; o[4 * sub + j].w = w[3];
            }
            LDS_WAIT(); asm volatile("" ::: "memory");
        }
#pragma unroll
        for (int j = 0; j < 16; ++j) *(v4u*)(dst + 16 * j) = o[j];
    }
}

DI void ph1_norm_dt(const Ctx& F, const Args& a) {
    const float* mod = (const float*)(F.ws + WS_CTL) + CW_MOD;
    const float* x = ARG(I_X); const float* n1g = ARG(I_N1G); const float* dtb = ARG(I_DTB);
    bf16* XN = (bf16*)(F.ws + WS_XN); const bf16* Wdt_t = (const bf16*)(F.ws + WS_WDT); float* DT = (float*)(F.ws + WS_DT);
    const int lane = lane_id(), wave = F.wave;
    f32x4 gm[4], ga[4];
#pragma unroll
    for (int j = 0; j < 4; ++j) { const int k = 256 * j + 4 * lane; const f32x4 g = *(const f32x4*)(n1g + k), sc = mod4(mod, 1024 + k);
        gm[j] = g * (sc + 1.0f); ga[j] = mod4(mod, k); }
    if (F.vcu == 0) { float* modc = (float*)(F.ws + WS_CTL) + CW_MODC; for (int k = (F.wave * 64 + lane_id()) * 4; k < 6 * D; k += NTHREADS * 4) *(f32x4*)(modc + k) = mod4(mod, k); }
    for (int unit = F.vcu; unit < M / 64; unit += F.G) {
        const int row0 = unit * 64;
#pragma unroll 1
        for (int rh = 0; rh < 2; ++rh) {
            f32x4 v[4][4];
#pragma unroll
            for (int rr = 0; rr < 4; ++rr)
#pragma unroll
                for (int j = 0; j < 4; ++j) v[rr][j] = __builtin_nontemporal_load((const f32x4*)(x + (size_t)(row0 + wave * 8 + rh * 4 + rr) * D + 256 * j + 4 * lane));
#pragma unroll
            for (int rr = 0; rr < 4; ++rr) {
                const int rl = wave * 8 + rh * 4 + rr, row = row0 + rl; float ss = 0.f;
#pragma unroll
                for (int j = 0; j < 4; ++j) ss += (v[rr][j].x * v[rr][j].x + v[rr][j].y * v[rr][j].y) + (v[rr][j].z * v[rr][j].z + v[rr][j].w * v[rr][j].w);
                const float rstd = 1.0f / sqrtf(wave_sum(ss) * (1.0f / D) + EPS);
                float am = 0.f;
#pragma unroll
                for (int j = 0; j < 4; ++j) { const f32x4 n = v[rr][j] * rstd * gm[j] + ga[j]; v[rr][j] = n;
                    am = __builtin_fmaxf(__builtin_fmaxf(am, __builtin_fmaxf(__builtin_fabsf(n.x), __builtin_fabsf(n.y))), __builtin_fmaxf(__builtin_fabsf(n.z), __builtin_fabsf(n.w)));
                    v2u w; w.x = pk2(n.x, n.y); w.y = pk2(n.z, n.w);
                    const int chunk = (32 * j + (lane >> 1)) ^ (rl & 15);
                    *(LAS v2u*)(F.lds + rl * 2048 + chunk * 16 + 8 * (lane & 1)) = w; }
#pragma unroll
                for (int o = 1; o < 64; o <<= 1) am = __builtin_fmaxf(am, __shfl_xor(am, o));
                const float inv = am > 0.f ? 127.0f / am : 0.f;
#pragma unroll
                for (int j = 0; j < 4; ++j) *(unsigned*)(F.ws + WS_XN8 + (size_t)row * D + 256 * j + 4 * lane) = pk4_i8(v[rr][j].x * inv, v[rr][j].y * inv, v[rr][j].z * inv, v[rr][j].w * inv);
                if (lane == 0) ((float*)(F.ws + WS_SA))[row] = am * (1.0f / 127.0f);
            }
        }
        __syncthreads();
        {
            const int rt = wave & 3, ct = wave >> 2, fr = lane & 15, fq = lane >> 4;
            pg8::f32x4 acc = {0.f, 0.f, 0.f, 0.f};
            const bf16* wrow = Wdt_t + (size_t)(16 * ct + fr) * D + 8 * fq;
#pragma unroll 4
            for (int ks = 0; ks < 32; ++ks) {
                const bf16x8 av = *(const LAS bf16x8*)(F.lds + (16 * rt + fr) * 2048 + (((4 * ks + fq) ^ fr) * 16));
                const bf16x8 bv = *(const bf16x8*)(wrow + 32 * ks);
                acc = __builtin_amdgcn_mfma_f32_16x16x32_bf16(av, bv, acc, 0, 0, 0);
            }
            const float bias = dtb[16 * ct + fr];
#pragma unroll
            for (int r = 0; r < 4; ++r) { const float v = acc[r] + bias; const float sp = v > 20.f ? v : log1pf(__expf(v));
                DT[(size_t)(row0 + 16 * rt + 4 * fq + r) * NH + 16 * ct + fr] = sp; }
        }
        __syncthreads();
    }
    {
        const float* win = ARG(I_WIN); const unsigned* wmax = (const unsigned*)(F.ws + WS_CTL) + CW_WMAX;
        const int gw = F.vcu * NWAVES + F.wave, NGW = F.G * NWAVES;
        LAS float* scr = (LAS float*)(F.lds + F.wave * 16384);
        for (int r = gw; r < 16 * 288; r += NGW) { const int kb = r / 288, nb = r % 288;
            const int npp = nb * 32 + (lane & 31), col = win_col(npp);
            const float mx = __uint_as_float(wmax[npp]); const float inv = mx > 0.f ? 127.0f / mx : 0.f;
            if (kb == 0 && lane < 32) ((float*)(F.ws + WS_SW))[npp] = mx * (1.0f / 127.0f);
            transpose_item_i8([&](int k, int) -> float { return win[(size_t)k * WIN_LD + col]; }, inv, D, F.ws + WS_W8IN, scr, kb, nb * 32, lane);
        }
    }
}

DI void ph3_convbranch(const Ctx& F, const Args& a, int reps) {
    const bf16* U = (const bf16*)(F.ws + WS_U); bf16* UC = (bf16*)(F.ws + WS_XN);
    const float* cw = ARG(I_CVW); const float* cb = ARG(I_CVB); const float* lg = ARG(I_LNG); const float* lb = ARG(I_LNB);
    const int tid = F.wave * 64 + lane_id(), lane = lane_id(), wave = F.wave;
    LAS unsigned char* tile = F.lds;
    LAS float* red = (LAS float*)(F.lds + 62 * 2048);
    LAS float* stat = red + 32 * 8 * 2;
    f2v w[31];
#pragma unroll
    for (int j = 0; j < 31; ++j) w[j] = *(const f2v*)(cw + j * D + 2 * tid);
    const f2v bias = *(const f2v*)(cb + 2 * tid), gam = *(const f2v*)(lg + 2 * tid), bet = *(const f2v*)(lb + 2 * tid);
    const int RU = (M / 32 + F.G - 1) / F.G;
    for (int it = 0; it < RU * reps; ++it) {
        const int unit = xcd_unit(F.xcd, F.xj, F.G >> 3, (it >= RU ? it - RU : it), M / 32); if (unit < 0) break; const int t0 = unit * 32;
        {
            v4u v[16];
#pragma unroll
            for (int i = 0; i < 16; ++i) { const int piece = tid + i * NTHREADS, r = piece >> 7, cch = piece & 127, t = t0 - 30 + r;
                v[i] = (v4u){0u, 0u, 0u, 0u}; if (piece < 62 * 128 && t >= 0) v[i] = *(const v4u*)(U + (size_t)t * D + cch * 8); }
#pragma unroll
            for (int i = 0; i < 16; ++i) { const int piece = tid + i * NTHREADS, r = piece >> 7, cch = piece & 127;
                if (piece < 62 * 128) *(LAS v4u*)(tile + r * 2048 + cch * 16) = v[i]; }
        }
        __syncthreads();
        f2v o[32];
#pragma unroll
        for (int tg = 0; tg < 8; ++tg) {
            f2v acc[4];
#pragma unroll
            for (int i = 0; i < 4; ++i) acc[i] = bias;
#pragma unroll
            for (int j = 0; j < 34; ++j) {
                const unsigned uu = *(const LAS unsigned*)(tile + (4 * tg + j) * 2048 + tid * 4);
                const f2v u2 = {bflo(uu), bfhi(uu)};
#pragma unroll
                for (int i = 0; i < 4; ++i) { const int jj = j - i; if (jj >= 0 && jj <= 30) acc[i] = __builtin_elementwise_fma(w[jj], u2, acc[i]); }
            }
#pragma unroll
            for (int i = 0; i < 4; ++i) o[4 * tg + i] = acc[i];
        }
        {
            float r5[64];
#pragma unroll
            for (int tk = 0; tk < 32; ++tk) { r5[2 * tk] = o[tk].x + o[tk].y; r5[2 * tk + 1] = o[tk].x * o[tk].x + o[tk].y * o[tk].y; }
            float r4[32], r3[16], r2[8], r1[4], r0[2];
            { const bool up = (lane & 32) != 0;
#pragma unroll
              for (int i = 0; i < 32; ++i) { const float keep = up ? r5[i + 32] : r5[i], send = up ? r5[i] : r5[i + 32]; r4[i] = keep + __shfl_xor(send, 32); } }
            { const bool up = (lane & 16) != 0;
#pragma unroll
              for (int i = 0; i < 16; ++i) { const float keep = up ? r4[i + 16] : r4[i], send = up ? r4[i] : r4[i + 16]; r3[i] = keep + __shfl_xor(send, 16); } }
            { const bool up = (lane & 8) != 0;
#pragma unroll
              for (int i = 0; i < 8; ++i) { const float keep = up ? r3[i + 8] : r3[i], send = up ? r3[i] : r3[i + 8]; r2[i] = keep + __shfl_xor(send, 8); } }
            { const bool up = (lane & 4) != 0;
#pragma unroll
              for (int i = 0; i < 4; ++i) { const float keep = up ? r2[i + 4] : r2[i], send = up ? r2[i] : r2[i + 4]; r1[i] = keep + __shfl_xor(send, 4); } }
            { const bool up = (lane & 2) != 0;
#pragma unroll
              for (int i = 0; i < 2; ++i) { const float keep = up ? r1[i + 2] : r1[i], send = up ? r1[i] : r1[i + 2]; r0[i] = keep + __shfl_xor(send, 2); } }
            const bool up0 = (lane & 1) != 0;
            const float tot = (up0 ? r0[1] : r0[0]) + __shfl_xor(up0 ? r0[0] : r0[1], 1);
            red[((lane >> 1) * 8 + wave) * 2 + (lane & 1)] = tot;
        }
        __syncthreads();
        if (tid < 32) { float s = 0.f, q = 0.f;
#pragma unroll
            for (int wv = 0; wv < 8; ++wv) { s += red[(tid * 8 + wv) * 2]; q += red[(tid * 8 + wv) * 2 + 1]; }
            const float mean = s * (1.0f / D); const float var = fmaxf(q * (1.0f / D) - mean * mean, 0.f);
            stat[tid * 2] = mean; stat[tid * 2 + 1] = 1.0f / sqrtf(var + EPS); }
        __syncthreads();
#pragma unroll
        for (int tk = 0; tk < 32; ++tk) { const float mean = stat[tk * 2], rstd = stat[tk * 2 + 1];
            const float y0 = (o[tk].x - mean) * rstd * gam.x + bet.x, y1 = (o[tk].y - mean) * rstd * gam.y + bet.y;
            *(unsigned*)(UC + (size_t)(t0 + tk) * D + 2 * tid) = pk2(siluf_(y0), siluf_(y1)); }
        __syncthreads();
    }
}

DI void conv_block(const bf16* XBC, const float* cw, const float* cb, int t_first, int col, float (&o)[8][8]) {
    v4u raw[11];
#pragma unroll
    for (int r = 0; r < 11; ++r) { const int t = t_first - 3 + r; const int tc = t < 0 ? 0 : t; v4u v = *(const v4u*)(XBC + (size_t)tc * XBCW + col);
        const unsigned msk = t < 0 ? 0u : 0xffffffffu; v.x &= msk; v.y &= msk; v.z &= msk; v.w &= msk; raw[r] = v; }
    float w[4][8], b[8];
#pragma unroll
    for (int j = 0; j < 4; ++j) { const f32x4 lo = *(const f32x4*)(cw + j * XBCW + col), hi = *(const f32x4*)(cw + j * XBCW + col + 4);
        w[j][0] = lo.x; w[j][1] = lo.y; w[j][2] = lo.z; w[j][3] = lo.w; w[j][4] = hi.x; w[j][5] = hi.y; w[j][6] = hi.z; w[j][7] = hi.w; }
    { const f32x4 lo = *(const f32x4*)(cb + col), hi = *(const f32x4*)(cb + col + 4); b[0] = lo.x; b[1] = lo.y; b[2] = lo.z; b[3] = lo.w; b[4] = hi.x; b[5] = hi.y; b[6] = hi.z; b[7] = hi.w; }
#pragma unroll
    for (int tk = 0; tk < 8; ++tk)
#pragma unroll
        for (int ch = 0; ch < 8; ++ch) {
            float acc = b[ch];
#pragma unroll
            for (int j = 0; j < 4; ++j) { const unsigned wd = raw[tk + j][ch >> 1]; const float xv = (ch & 1) ? bfhi(wd) : bflo(wd); acc += w[j][ch] * xv; }
            o[tk][ch] = siluf_(acc);
        }
}
DI float head_scan(const float* DT, const float* alog, int t0, int h, int lane, LAS float* acs_h, LAS float* dtv_h, float& d0o, float& d1o, float& c0o, float& c1o) {
    const float d0 = DT[(size_t)(t0 + 2 * lane) * NH + h], d1 = DT[(size_t)(t0 + 2 * lane + 1) * NH + h];
    const float A2 = -__expf(alog[h]) * LOG2E;
    const float a0 = d0 * A2, a1 = d1 * A2; float inc = a0 + a1;
#pragma unroll
    for (int o = 1; o < 64; o <<= 1) { const float t = __shfl_up(inc, o); if (lane >= o) inc += t; }
    acs_h[2 * lane] = inc - a1; acs_h[2 * lane + 1] = inc; dtv_h[2 * lane] = d0; dtv_h[2 * lane + 1] = d1;
    d0o = d0; d1o = d1; c0o = inc - a1; c1o = inc;
    return __shfl(inc, 63);
}

constexpr int S_CN = 0, S_BN = 32768, S_XT = 65536, S_ACS = 131072, S_DTV = 135168, S_SSQ = 139264, S_FS = 139776;

DI void ph3_chunk_states(const Ctx& F, const Args& a, int reps) {
    const bf16* XBC = (const bf16*)(F.ws + WS_XBC); const float* DT = (const float*)(F.ws + WS_DT);
    bf16* ST = (bf16*)(F.ws + WS_ST); float* CD = (float*)(F.ws + WS_CD);
    const float* scw = ARG(I_SCW); const float* scb = ARG(I_SCB); const float* alog = ARG(I_ALOG);
    const int tid = F.wave * 64 + lane_id(), lane = lane_id(), wave = F.wave, hh = lane >> 5;
    LAS unsigned char* lds = F.lds;
    LAS float* acs = (LAS float*)(lds + S_ACS); LAS float* wsc = (LAS float*)(lds + S_DTV);
    const int RU = (NCH * NGRP + F.G - 1) / F.G;
    for (int it = 0; it < RU * reps; ++it) {
        const int unit = xcd_unit(F.xcd, F.xj, F.G >> 3, (it >= RU ? it - RU : it), NCH * NGRP); if (unit < 0) break; const int c = unit >> 2, g = unit & 3, t0 = c * LCH;
        {
            const int h = 8 * g + wave; float d0, d1, c0, c1;
            const float total = head_scan(DT, alog, t0, h, lane, acs + wave * 128, wsc + wave * 128, d0, d1, c0, c1);
            wsc[wave * 128 + 2 * lane] = d0 * __builtin_amdgcn_exp2f(total - c0); wsc[wave * 128 + 2 * lane + 1] = d1 * __builtin_amdgcn_exp2f(total - c1);
            if (lane == 0) CD[c * NH + h] = __builtin_amdgcn_exp2f(total);
        }
        __syncthreads();
        if (tid < 256) { const int co = tid & 15, to = tid >> 4; float o[8][8];
            conv_block(XBC, scw, scb, t0 + 8 * to, 2048 + 128 * g + 8 * co, o);
#pragma unroll
            for (int ch = 0; ch < 8; ++ch) { const int row = 8 * co + ch;
                v4u w; w.x = pk2(o[0][ch], o[1][ch]); w.y = pk2(o[2][ch], o[3][ch]); w.z = pk2(o[4][ch], o[5][ch]); w.w = pk2(o[6][ch], o[7][ch]);
                *(LAS v4u*)(lds + S_BN + row * 256 + swz(row, to) * 16) = w; } }
        for (int ps = 0; ps < 2; ++ps) {
            {
                const int co = tid & 31, to = tid >> 5, hd = co >> 3, p0 = (co & 7) * 8; float o[8][8];
                conv_block(XBC, scw, scb, t0 + 8 * to, 512 * g + 64 * (4 * ps + hd) + p0, o);
                float sc[8];
#pragma unroll
                for (int tk = 0; tk < 8; ++tk) sc[tk] = wsc[(4 * ps + hd) * 128 + 8 * to + tk];
#pragma unroll
                for (int ch = 0; ch < 8; ++ch) { const int row = hd * 64 + p0 + ch;
                    v4u w; w.x = pk2(o[0][ch] * sc[0], o[1][ch] * sc[1]); w.y = pk2(o[2][ch] * sc[2], o[3][ch] * sc[3]);
                    w.z = pk2(o[4][ch] * sc[4], o[5][ch] * sc[5]); w.w = pk2(o[6][ch] * sc[6], o[7][ch] * sc[7]);
                    *(LAS v4u*)(lds + S_XT + row * 256 + swz(row, to) * 16) = w; }
            }
            __syncthreads();
            {
                const int hd = wave & 3, ph = wave >> 2, h = 8 * g + 4 * ps + hd;
                f32x16 acc[4];
#pragma unroll
                for (int nt = 0; nt < 4; ++nt)
#pragma unroll
                    for (int i = 0; i < 16; ++i) acc[nt][i] = 0.f;
                const int arow = hd * 64 + 32 * ph + (lane & 31);
#pragma unroll
                for (int ks = 0; ks < 8; ++ks) {
                    const bf16x8 av = *(const LAS bf16x8*)(lds + S_XT + arow * 256 + swz(arow, 2 * ks + hh) * 16);
#pragma unroll
                    for (int nt = 0; nt < 4; ++nt) { const int brow = 32 * nt + (lane & 31);
                        const bf16x8 bv = *(const LAS bf16x8*)(lds + S_BN + brow * 256 + swz(brow, 2 * ks + hh) * 16);
                        acc[nt] = MFMA32(av, bv, acc[nt]); }
                }
                unsigned char* dst = (unsigned char*)ST + ((size_t)(c * NH + h) * HD) * NST;
#pragma unroll
                for (int nt = 0; nt < 4; ++nt)
#pragma unroll
                    for (int i = 0; i < 16; i += 2) { const int p = 32 * ph + crow(i, hh); const unsigned pk = pk2_fp8(acc[nt][i], acc[nt][i + 1]);
                        dst[(size_t)p * NST + 32 * nt + (lane & 31)] = (unsigned char)(pk & 0xffu); dst[(size_t)(p + 1) * NST + 32 * nt + (lane & 31)] = (unsigned char)(pk >> 8); }
            }
            __syncthreads();
        }
    }
}

DI void ph4_scan(const Ctx& F, size_t dst_off) {
    unsigned short* ST16 = (unsigned short*)(F.ws + WS_ST); unsigned short* DST16 = (unsigned short*)(F.ws + dst_off); const float* CD = (const float*)(F.ws + WS_CD);
    constexpr int NPAIR = NH * HD * NST / 2;
    for (int e = F.vcu * NTHREADS + (F.wave * 64 + lane_id()); e < NPAIR; e += F.G * NTHREADS) {
        const int h = e >> 12; float c0 = 0.f, c1 = 0.f;
#pragma unroll 1
        for (int cb = 0; cb < NCH; cb += 32) {
            unsigned v[32]; float dec[32];
#pragma unroll
            for (int i = 0; i < 32; ++i) { v[i] = __builtin_nontemporal_load(ST16 + (size_t)(cb + i) * NPAIR + e); dec[i] = CD[(cb + i) * NH + h]; }
#pragma unroll
            for (int i = 0; i < 32; ++i) { DST16[(size_t)(cb + i) * NPAIR + e] = (unsigned short)pk2_fp8(c0, c1);
                c0 = c0 * dec[i] + __builtin_amdgcn_cvt_f32_fp8(v[i], 0); c1 = c1 * dec[i] + __builtin_amdgcn_cvt_f32_fp8(v[i], 1); }
        }
    }
}

DI void ph5_ssd_out(const Ctx& F, const Args& a, int reps) {
    const bf16* XBC = (const bf16*)(F.ws + WS_XBC); const float* DT = (const float*)(F.ws + WS_DT);
    const bf16* ST = (const bf16*)(F.ws + WS_ST); const bf16* ZS = (const bf16*)(F.ws + WS_ZS); bf16* YS = (bf16*)(F.ws + WS_YS);
    const float* scw = ARG(I_SCW); const float* scb = ARG(I_SCB); const float* alog = ARG(I_ALOG); const float* dskip = ARG(I_DSKIP);
    const int tid = F.wave * 64 + lane_id(), lane = lane_id(), wave = F.wave, hh = lane >> 5, l31 = lane & 31;
    LAS unsigned char* lds = F.lds;
    LAS float* acs = (LAS float*)(lds + S_ACS); LAS float* dtv = (LAS float*)(lds + S_DTV); LAS float* ssq = (LAS float*)(lds + S_SSQ);
    const int RU = (NCH * NGRP + F.G - 1) / F.G;
    for (int it = 0; it < RU * reps; ++it) {
        const int unit = xcd_unit(F.xcd, F.xj, F.G >> 3, (it >= RU ? it - RU : it), NCH * NGRP); if (unit < 0) break; const int c = unit >> 2, g = unit & 3, t0 = c * LCH;
        { const int h = 8 * g + wave; float d0, d1, c0, c1; (void)head_scan(DT, alog, t0, h, lane, acs + wave * 128, dtv + wave * 128, d0, d1, c0, c1);
          const float cend = __shfl(c1, (lane & 48) | 15);
          LAS float* fsw = (LAS float*)(lds + S_FS) + wave * 128;
          fsw[2 * lane] = d0 * __builtin_amdgcn_exp2f(cend - c0); fsw[2 * lane + 1] = d1 * __builtin_amdgcn_exp2f(cend - c1); }
        if (tid < 128) ssq[tid] = 0.f;
        { const int which = tid >> 8, t8 = tid & 255, co = t8 & 15; int to = t8 >> 4; asm volatile("" : "+v"(to)); float o[8][8];
            conv_block(XBC, scw, scb, t0 + 8 * to, (which ? 2560 : 2048) + 128 * g + 8 * co, o);
            const int base = which ? S_CN : S_BN;
#pragma unroll
            for (int tk = 0; tk < 8; ++tk) { const int row = 8 * to + tk;
                v4u w; w.x = pk2(o[tk][0], o[tk][1]); w.y = pk2(o[tk][2], o[tk][3]); w.z = pk2(o[tk][4], o[tk][5]); w.w = pk2(o[tk][6], o[tk][7]);
                *(LAS v4u*)(lds + base + row * 256 + swz(row, co) * 16) = w; } }
#pragma unroll 1
        for (int ps = 0; ps < 2; ++ps) {
            {
                const int co = tid & 31; int to = tid >> 5; asm volatile("" : "+v"(to));
                const int hd = co >> 3, p0 = (co & 7) * 8; float o[8][8];
                conv_block(XBC, scw, scb, t0 + 8 * to, 512 * g + 64 * (4 * ps + hd) + p0, o);
#pragma unroll
                for (int ch = 0; ch < 8; ++ch) { const int row = hd * 64 + p0 + ch;
                    v4u w; w.x = pk2(o[0][ch], o[1][ch]); w.y = pk2(o[2][ch], o[3][ch]); w.z = pk2(o[4][ch], o[5][ch]); w.w = pk2(o[6][ch], o[7][ch]);
                    *(LAS v4u*)(lds + S_XT + row * 256 + swz(row, to) * 16) = w; }
            }
            __syncthreads();
            const int hd = wave & 3, lp = wave >> 2, hl = 4 * ps + hd, h = 8 * g + hl;
            const float Dh = dskip[h];
            const LAS float* acs_h = acs + hl * 128; const LAS float* dt_h = dtv + hl * 128; const LAS float* fs_h = (const LAS float*)(lds + S_FS) + hl * 128;
            const unsigned char* prev = (const unsigned char*)ST + ((size_t)(c * NH + h) * HD) * NST;
            const int erow = lane >> 1, ehalf = lane & 1;
            f32x16 acc[2][2];
            {
#pragma unroll
                for (int which = 0; which < 2; ++which)
#pragma unroll
                    for (int pt = 0; pt < 2; ++pt)
#pragma unroll
                        for (int i = 0; i < 16; ++i) acc[which][pt][i] = 0.f;
                const int rowA = 32 * lp + l31, rowB = 32 * (3 - lp) + l31;
#pragma unroll
                for (int ks = 0; ks < 8; ++ks) {
                    const bf16x8 b0 = fp8x8_to_bf16(*(const v2u*)(prev + (size_t)l31 * NST + 16 * ks + 8 * hh)), b1 = fp8x8_to_bf16(*(const v2u*)(prev + (size_t)(32 + l31) * NST + 16 * ks + 8 * hh));
                    const bf16x8 a0 = *(const LAS bf16x8*)(lds + S_CN + rowA * 256 + swz(rowA, 2 * ks + hh) * 16);
                    const bf16x8 a1 = *(const LAS bf16x8*)(lds + S_CN + rowB * 256 + swz(rowB, 2 * ks + hh) * 16);
                    acc[0][0] = MFMA32(a0, b0, acc[0][0]); acc[0][1] = MFMA32(a0, b1, acc[0][1]);
                    acc[1][0] = MFMA32(a1, b0, acc[1][0]); acc[1][1] = MFMA32(a1, b1, acc[1][1]);
                }
#pragma unroll
                for (int which = 0; which < 2; ++which) { const int li = which == 0 ? lp : 3 - lp;
#pragma unroll
                    for (int i = 0; i < 16; ++i) { const float e = __builtin_amdgcn_exp2f(acs_h[32 * li + crow(i, hh)]); acc[which][0][i] *= e; acc[which][1][i] *= e; } }
            }
            {
                const int liA = lp, liB = 3 - lp;
                const int rowA = 32 * liA + l31, rowB = 32 * liB + l31;
                const float alA = acs_h[rowA], alB = acs_h[rowB];
#pragma unroll 1
                for (int sj = 0; sj <= liB; ++sj) {
                    const bool doA = sj <= liA;
                    f32x16 GA, GB;
#pragma unroll
                    for (int i = 0; i < 16; ++i) { GA[i] = 0.f; GB[i] = 0.f; }
                    const int brow = 32 * sj + l31;
                    if (doA) {
#pragma unroll 2
                        for (int ks = 0; ks < 8; ++ks) {
                            const bf16x8 av = *(const LAS bf16x8*)(lds + S_BN + brow * 256 + swz(brow, 2 * ks + hh) * 16);
                            const bf16x8 ca = *(const LAS bf16x8*)(lds + S_CN + rowA * 256 + swz(rowA, 2 * ks + hh) * 16);
                            const bf16x8 cb = *(const LAS bf16x8*)(lds + S_CN + rowB * 256 + swz(rowB, 2 * ks + hh) * 16);
                            GA = MFMA32(av, ca, GA); GB = MFMA32(av, cb, GB);
                        }
                    } else {
#pragma unroll 2
                        for (int ks = 0; ks < 8; ++ks) {
                            const bf16x8 av = *(const LAS bf16x8*)(lds + S_BN + brow * 256 + swz(brow, 2 * ks + hh) * 16);
                            const bf16x8 cb = *(const LAS bf16x8*)(lds + S_CN + rowB * 256 + swz(rowB, 2 * ks + hh) * 16);
                            GB = MFMA32(av, cb, GB);
                        }
                    }
                    auto mask = [&](f32x16& G, int li, int row_l, float al) {
                        if (sj < li) {
                            const float fl = __builtin_amdgcn_exp2f(al - acs_h[32 * sj + 31]);
#pragma unroll
                            for (int i = 0; i < 16; ++i) G[i] = G[i] * (fs_h[32 * sj + crow(i, hh)] * fl);
                        } else {
#pragma unroll
                            for (int i = 0; i < 16; ++i) { const int s = 32 * sj + crow(i, hh);
                                float v = G[i] * __builtin_amdgcn_exp2f(fminf(al - acs_h[s], 0.f)) * dt_h[s];
                                v = (s > row_l) ? 0.f : v; v = (s == row_l) ? v + Dh : v; G[i] = v; }
                        }
                    };
                    auto pv = [&](const f32x16& G, f32x16 (&ac)[2]) {
#pragma unroll
                        for (int s2 = 0; s2 < 2; ++s2) {
                            v4u fa; fa.x = pk2(G[8 * s2 + 0], G[8 * s2 + 1]); fa.y = pk2(G[8 * s2 + 2], G[8 * s2 + 3]); fa.z = pk2(G[8 * s2 + 4], G[8 * s2 + 5]); fa.w = pk2(G[8 * s2 + 6], G[8 * s2 + 7]);
#pragma unroll
                            for (int pt = 0; pt < 2; ++pt) { const int xrow = hd * 64 + 32 * pt + l31; const int sc0 = 32 * sj + 16 * s2;
                                const v2u lo = *(const LAS v2u*)(lds + S_XT + xrow * 256 + swz(xrow, (sc0 >> 3)) * 16 + 8 * hh);
                                const v2u hi = *(const LAS v2u*)(lds + S_XT + xrow * 256 + swz(xrow, (sc0 >> 3) + 1) * 16 + 8 * hh);
                                v4u bfr; bfr.x = lo.x; bfr.y = lo.y; bfr.z = hi.x; bfr.w = hi.y;
                                ac[pt] = MFMA32(__builtin_bit_cast(bf16x8, fa), __builtin_bit_cast(bf16x8, bfr), ac[pt]); }
                        }
                    };
                    if (doA) { mask(GA, liA, rowA, alA); pv(GA, acc[0]); }
                    mask(GB, liB, rowB, alB); pv(GB, acc[1]);
                }
            }
            asm volatile("" ::: "memory");
            v4u zs[2][4];
#pragma unroll
            for (int which = 0; which < 2; ++which) { const int li = which == 0 ? lp : 3 - lp; const size_t t = (size_t)(t0 + 32 * li + erow);
#pragma unroll
                for (int j = 0; j < 4; ++j) zs[which][j] = *(const v4u*)(ZS + t * DIN + 64 * h + 32 * ehalf + 8 * j); }
            __syncthreads();
            {
                LAS unsigned char* stg = lds + S_XT + wave * 8192;
#pragma unroll
                for (int which = 0; which < 2; ++which)
#pragma unroll
                    for (int pt = 0; pt < 2; ++pt)
#pragma unroll
                        for (int i = 0; i < 16; ++i) *(LAS bf16*)(stg + ((which * 32 + crow(i, hh)) * 64 + 32 * pt + l31) * 2) = (bf16)(pk2(acc[which][pt][i], 0.f) & 0xffffu);
                LDS_WAIT(); asm volatile("" ::: "memory");
#pragma unroll
                for (int which = 0; which < 2; ++which) { const int li = which == 0 ? lp : 3 - lp; const int l = 32 * li + erow; const size_t t = (size_t)(t0 + l);
                    float q = 0.f; unsigned w8[8];
#pragma unroll
                    for (int j = 0; j < 4; ++j) { const v4u yv = *(const LAS v4u*)(stg + ((which * 32 + erow) * 64 + 32 * ehalf + 8 * j) * 2); const v4u zv = zs[which][j];
                        float y[8] = {bflo(yv.x) * bflo(zv.x), bfhi(yv.x) * bfhi(zv.x), bflo(yv.y) * bflo(zv.y), bfhi(yv.y) * bfhi(zv.y), bflo(yv.z) * bflo(zv.z), bfhi(yv.z) * bfhi(zv.z), bflo(yv.w) * bflo(zv.w), bfhi(yv.w) * bfhi(zv.w)};
#pragma unroll
                        for (int k = 0; k < 8; ++k) q += y[k] * y[k];
                        w8[2 * j] = pk4_fp8(y[0], y[1], y[2], y[3]); w8[2 * j + 1] = pk4_fp8(y[4], y[5], y[6], y[7]); }
                    { unsigned char* yp = (unsigned char*)YS + t * DIN + 64 * h + 32 * ehalf;
                      *(v4u*)yp = (v4u){w8[0], w8[1], w8[2], w8[3]}; *(v4u*)(yp + 16) = (v4u){w8[4], w8[5], w8[6], w8[7]}; }
                    q += __shfl_xor(q, 1);
                    if (ehalf == 0) __hip_atomic_fetch_add(ssq + l, q, __ATOMIC_RELAXED, __HIP_MEMORY_SCOPE_WORKGROUP);
                }
            }
            __syncthreads();
        }
        if (tid < 128) ((float*)(F.ws + WS_RSTD))[(size_t)(t0 + tid) * 4 + g] = 1.0f / sqrtf(ssq[tid] * (1.0f / 512.f) + EPS);
        __syncthreads();
    }
}

constexpr int RT_LD = 1028;
DI void ph8_router(const Ctx& F, const Args& a, int reps) {
    const float* mod = (const float*)(F.ws + WS_CTL) + CW_MODC;
    const bf16* H = (const bf16*)(F.ws + WS_H16); const float* n2g = ARG(I_N2G); const float* bgrp = ARG(I_BGRP); const float* ber = ARG(I_BER);
    unsigned char* XN2 = F.ws + WS_XN; int* cnt0 = (int*)(F.ws + WS_CTL) + CW_CNT;
    int* RE = (int*)(F.ws + WS_ROUTE); int* RP = RE + 2 * M; float* RW = (float*)(RP + 2 * M); int* LIST = (int*)(F.ws + WS_LIST);
    const int lane = lane_id(), wave = F.wave;
    LAS float* tile = (LAS float*)F.lds;
    LAS float* pe = (LAS float*)F.lds;
    f32x4 gm[4], ga[4];
#pragma unroll
    for (int j = 0; j < 4; ++j) { const int k = 256 * j + 4 * lane; const f32x4 g = *(const f32x4*)(n2g + k), sc = *(const f32x4*)(mod + 4096 + k);
        gm[j] = g * (sc + 1.0f); ga[j] = *(const f32x4*)(mod + 3072 + k); }
    const int RU = (M / 32 + F.G - 1) / F.G;
    for (int it = 0; it < RU * reps; ++it) {
        const int unit = xcd_unit(F.xcd, F.xj, F.G >> 3, (it >= RU ? it - RU : it), M / 32); if (unit < 0) break; int* cnt = cnt0 + ((it >= RU * (reps - 1)) ? 0 : 4096);
        const int row0 = unit * 32;
        {
            f32x4 v[4][4];
#pragma unroll
            for (int rr = 0; rr < 4; ++rr)
#pragma unroll
                for (int j = 0; j < 4; ++j) { const v2u hw = *(const v2u*)(H + (size_t)(row0 + wave * 4 + rr) * D + 256 * j + 4 * lane); v[rr][j] = (f32x4){bflo(hw.x), bfhi(hw.x), bflo(hw.y), bfhi(hw.y)}; }
#pragma unroll
            for (int rr = 0; rr < 4; ++rr) { const int rl = wave * 4 + rr, row = row0 + rl; float ss = 0.f;
#pragma unroll
                for (int j = 0; j < 4; ++j) ss += (v[rr][j].x * v[rr][j].x + v[rr][j].y * v[rr][j].y) + (v[rr][j].z * v[rr][j].z + v[rr][j].w * v[rr][j].w);
                const float rstd = 1.0f / sqrtf(wave_sum(ss) * (1.0f / D) + EPS);
#pragma unroll
                for (int j = 0; j < 4; ++j) { const f32x4 n = v[rr][j] * rstd * gm[j] + ga[j];
                    *(LAS f32x4*)(tile + rl * RT_LD + 256 * j + 4 * lane) = n;
                    *(unsigned*)(XN2 + (size_t)row * D + 256 * j + 4 * lane) = pk4_fp8(n.x, n.y, n.z, n.w); }
            }
        }
        __syncthreads();
        pg8::f32x4 acc[2][5];
#pragma unroll
        for (int rt = 0; rt < 2; ++rt)
#pragma unroll
            for (int ct = 0; ct < 5; ++ct) acc[rt][ct] = (pg8::f32x4){0.f, 0.f, 0.f, 0.f};
        const int kb = wave * 128, fr = lane & 15, kq = lane >> 4;
        const bf16* WRH = (const bf16*)(F.ws + WS_WRH); const bf16* WRL = (const bf16*)(F.ws + WS_WRL);
#pragma unroll 2
        for (int ks = 0; ks < 4; ++ks) {
            const int k0 = kb + 32 * ks + 8 * kq;
            bf16x8 bh[5], bl[5];
#pragma unroll
            for (int ct = 0; ct < 5; ++ct) { bh[ct] = *(const bf16x8*)(WRH + (size_t)(16 * ct + fr) * D + k0); bl[ct] = *(const bf16x8*)(WRL + (size_t)(16 * ct + fr) * D + k0); }
#pragma unroll
            for (int rt = 0; rt < 2; ++rt) {
                const f32x4 x0 = *(const LAS f32x4*)(tile + (16 * rt + fr) * RT_LD + k0), x1 = *(const LAS f32x4*)(tile + (16 * rt + fr) * RT_LD + k0 + 4);
                v4u hv, lv;
                hv.x = pk2(x0.x, x0.y); hv.y = pk2(x0.z, x0.w); hv.z = pk2(x1.x, x1.y); hv.w = pk2(x1.z, x1.w);
                lv.x = pk2(x0.x - bflo(hv.x), x0.y - bfhi(hv.x)); lv.y = pk2(x0.z - bflo(hv.y), x0.w - bfhi(hv.y));
                lv.z = pk2(x1.x - bflo(hv.z), x1.y - bfhi(hv.z)); lv.w = pk2(x1.z - bflo(hv.w), x1.w - bfhi(hv.w));
                const bf16x8 ah = __builtin_bit_cast(bf16x8, hv), al = __builtin_bit_cast(bf16x8, lv);
#pragma unroll
                for (int ct = 0; ct < 5; ++ct) {
                    acc[rt][ct] = __builtin_amdgcn_mfma_f32_16x16x32_bf16(ah, bh[ct], acc[rt][ct], 0, 0, 0);
                    acc[rt][ct] = __builtin_amdgcn_mfma_f32_16x16x32_bf16(ah, bl[ct], acc[rt][ct], 0, 0, 0);
                    acc[rt][ct] = __builtin_amdgcn_mfma_f32_16x16x32_bf16(al, bh[ct], acc[rt][ct], 0, 0, 0); }
            }
        }
        __syncthreads();
#pragma unroll
        for (int rt = 0; rt < 2; ++rt)
#pragma unroll
            for (int ct = 0; ct < 5; ++ct)
#pragma unroll
                for (int r = 0; r < 4; ++r) pe[(wave * 32 + 16 * rt + 4 * kq + r) * 80 + 16 * ct + fr] = acc[rt][ct][r];
        __syncthreads();
        int e0s[4], e1s[4]; float w0s[4], w1s[4];
#pragma unroll
        for (int rr = 0; rr < 4; ++rr) { const int rl = wave * 4 + rr;
            float le = ber[lane], lgv = (lane < 8) ? bgrp[lane] : 0.f;
#pragma unroll
            for (int wv = 0; wv < 8; ++wv) { le += pe[(wv * 32 + rl) * 80 + lane]; if (lane < 8) lgv += pe[(wv * 32 + rl) * 80 + 64 + lane]; }
            float gl[8];
#pragma unroll
            for (int i = 0; i < 8; ++i) gl[i] = __shfl(lgv, i);
            int gi = 0; float gmax = gl[0];
#pragma unroll
            for (int i = 1; i < 8; ++i) if (gl[i] > gmax) { gmax = gl[i]; gi = i; }
            float den = 0.f;
#pragma unroll
            for (int i = 0; i < 8; ++i) den += __expf(gl[i] - gmax);
            const float gp = 1.0f / den;
            float el[8];
#pragma unroll
            for (int i = 0; i < 8; ++i) el[i] = __shfl(le, gi * 8 + i);
            int i0 = 0; float m0 = el[0];
#pragma unroll
            for (int i = 1; i < 8; ++i) if (el[i] > m0) { m0 = el[i]; i0 = i; }
            int i1 = -1; float m1 = -INFINITY;
#pragma unroll
            for (int i = 0; i < 8; ++i) if (i != i0 && el[i] > m1) { m1 = el[i]; i1 = i; }
            const float dd = __expf(m1 - m0);
            w0s[rr] = gp / (1.0f + dd); w1s[rr] = gp * dd / (1.0f + dd); e0s[rr] = gi * 8 + i0; e1s[rr] = gi * 8 + i1;
        }
        if (lane == 0) {
            int p0[4], p1[4];
#pragma unroll
            for (int rr = 0; rr < 4; ++rr) { p0[rr] = atomicAdd(cnt + 64 * e0s[rr], 1); p1[rr] = atomicAdd(cnt + 64 * e1s[rr], 1); }
#pragma unroll
            for (int rr = 0; rr < 4; ++rr) { const int row = row0 + wave * 4 + rr;
                RE[2 * row] = e0s[rr]; RE[2 * row + 1] = e1s[rr]; RP[2 * row] = p0[rr]; RP[2 * row + 1] = p1[rr]; RW[2 * row] = w0s[rr]; RW[2 * row + 1] = w1s[rr];
                LIST[e0s[rr] * 16384 + p0[rr]] = row; LIST[e1s[rr] * 16384 + p1[rr]] = row; }
        }
        __syncthreads();
    }
}

DI void build_tilebase(const Ctx& F) {
    const int* cnt = (const int*)(F.ws + WS_CTL) + CW_CNT; LAS int* tb = (LAS int*)(F.lds + TB_OFF);
    if (F.wave == 0) {
        const int lane = lane_id(); const int tiles = (cnt[64 * lane] + 255) >> 8; int inc = tiles;
#pragma unroll
        for (int o = 1; o < 64; o <<= 1) { const int t = __shfl_up(inc, o); if (lane >= o) inc += t; }
        tb[lane] = inc - tiles; if (lane == 63) tb[NE] = inc; ((LAS int*)(F.lds + CNTL_OFF))[lane] = cnt[64 * lane];
    }
    __syncthreads();
}
DI void fill_tokl(const Ctx& F, const MoeOrder& S) {
    const LAS int* tb = (const LAS int*)(F.lds + TB_OFF); const LAS int* cntl = (const LAS int*)(F.lds + CNTL_OFF); LAS int* tokl = (LAS int*)(F.lds + TOKL_OFF);
    const int* LIST = (const int*)(F.ws + WS_LIST); const int tid = F.wave * 64 + lane_id();
    for (int i = 0; i < 4; ++i) { pg8::Unit u; if (!S.next(i, u)) break;
        const int e = u.pn >> 2, r = 256 * (u.pm - tb[e]) + tid;
        if (tid < 256) tokl[256 * i + tid] = (r < cntl[e]) ? LIST[e * 16384 + r] : 0; }
    asm volatile("s_waitcnt vmcnt(0) lgkmcnt(0)" ::: "memory"); __syncthreads();
}
DI void ph12_final(const Ctx& F, const Args& a, int reps) {
    const float* mod = (const float*)(F.ws + WS_CTL) + CW_MODC; float* H = (float*)argp<N_IN>(); const bf16* H16 = (const bf16*)(F.ws + WS_H16); const float* fg = ARG(I_FG);
    const unsigned char* YE = F.ws + WS_YEXP; const int* RE = (const int*)(F.ws + WS_ROUTE); const int* RP = RE + 2 * M; const float* RW = (const float*)(F.ws + WS_ROUTE) + 4 * M;
    const LAS int* tb = (const LAS int*)(F.lds + TB_OFF);
    float* OUT2 = (float*)(F.ws + WS_U);
    const int gw = F.vcu * NWAVES + F.wave, NGW = F.G * NWAVES, lane = lane_id();
    f32x4 g2[4], fgv[4];
#pragma unroll
    for (int j = 0; j < 4; ++j) { g2[j] = *(const f32x4*)(mod + 5 * 1024 + 256 * j + 4 * lane); fgv[j] = *(const f32x4*)(fg + 256 * j + 4 * lane); }
    const int RT = (M / 2 + NGW - 1) / NGW;
    for (int it = 0; it < RT * reps; ++it) {
        const int t0 = 2 * xcd_unit(F.xcd, F.xj * NWAVES + F.wave, NGW >> 3, (it >= RT ? it - RT : it), M / 2); if (t0 < 0) break;
        float* O = (it >= RT * (reps - 1)) ? H : OUT2;
        int tt[2], d0[2], d1[2]; float w0[2], w1[2];
#pragma unroll
        for (int u = 0; u < 2; ++u) { tt[u] = (t0 + u) % M; d0[u] = 256 * tb[RE[2 * tt[u]]] + RP[2 * tt[u]]; d1[u] = 256 * tb[RE[2 * tt[u] + 1]] + RP[2 * tt[u] + 1]; w0[u] = RW[2 * tt[u]]; w1[u] = RW[2 * tt[u] + 1]; }
        f32x4 hv[2][4]; unsigned ya[2][4], yb[2][4];
#pragma unroll
        for (int u = 0; u < 2; ++u)
#pragma unroll
            for (int j = 0; j < 4; ++j) { const v2u hw = *(const v2u*)(H16 + (size_t)tt[u] * D + 256 * j + 4 * lane); hv[u][j] = (f32x4){bflo(hw.x), bfhi(hw.x), bflo(hw.y), bfhi(hw.y)};
                ya[u][j] = *(const unsigned*)(YE + (size_t)d0[u] * D + 256 * j + 4 * lane); yb[u][j] = *(const unsigned*)(YE + (size_t)d1[u] * D + 256 * j + 4 * lane); }
#pragma unroll
        for (int u = 0; u < 2; ++u) {
            f32x4 v[4]; float ss = 0.f;
#pragma unroll
            for (int j = 0; j < 4; ++j) { const unsigned a4 = ya[u][j], b4 = yb[u][j];
                const f2v a01 = __builtin_amdgcn_cvt_pk_f32_fp8(a4, false), a23 = __builtin_amdgcn_cvt_pk_f32_fp8(a4, true), b01 = __builtin_amdgcn_cvt_pk_f32_fp8(b4, false), b23 = __builtin_amdgcn_cvt_pk_f32_fp8(b4, true);
                f32x4 mo; mo.x = w0[u] * a01.x + w1[u] * b01.x; mo.y = w0[u] * a01.y + w1[u] * b01.y; mo.z = w0[u] * a23.x + w1[u] * b23.x; mo.w = w0[u] * a23.y + w1[u] * b23.y;
                mo = mo * 0.0625f;
                v[j] = hv[u][j] + g2[j] * mo; ss += (v[j].x * v[j].x + v[j].y * v[j].y) + (v[j].z * v[j].z + v[j].w * v[j].w); }
            const float rstd = 1.0f / sqrtf(wave_sum(ss) * (1.0f / D) + EPS);
#pragma unroll
            for (int j = 0; j < 4; ++j) *(f32x4*)(O + (size_t)tt[u] * D + 256 * j + 4 * lane) = v[j] * rstd * fgv[j];
        }
    }
}

constexpr int N_PHASES = 13;
#ifndef REP_MASK
#define REP_MASK 0
#endif
#define REPS(k) (((REP_MASK >> (k)) & 1) ? 2 : 1)
#ifndef MK_ONE_LAUNCH
#define MK_ONE_LAUNCH 1
#endif

struct RepOrder { pg8::StaticOrder s; int n, reps;
    DI bool next(int i, pg8::Unit& u) const { if (i >= n * reps) return false; return s.next(i % n, u); }
    DI void a_ready(const pg8::Unit&) const {}
    DI void done(const pg8::Unit&) const {} };

__global__ void __launch_bounds__(NTHREADS, 2) fwd_kernel(Args args) {
    extern __shared__ __attribute__((aligned(16))) unsigned char lds_raw[];
    Ctx F;
    F.lds = (LAS unsigned char*)lds_raw;
    F.wave = __builtin_amdgcn_readfirstlane((int)threadIdx.x >> 6);
    F.G = gridDim.x; { const int bx = blockIdx.x; F.xcd = bx & 7; F.xj = bx >> 3; F.vcu = F.xcd * (F.G >> 3) + F.xj; }
    F.ws = (unsigned char*)argp<N_IN + 1>();
    volatile LAS unsigned* MISC = (volatile LAS unsigned*)(F.lds + LDSCTL_OFF);
    for (int u = threadIdx.x; u < (LDS_BYTES - LDSCTL_OFF) / 4; u += NTHREADS) ((LAS unsigned*)(F.lds + LDSCTL_OFF))[u] = 0u;
    __syncthreads();
    const int lo = args.ph_lo, hi = args.ph_hi;
    unsigned* barw = (unsigned*)(F.ws + WS_CTL) + CW_BAR;
    XcdBarrier bar; bar.bar = barw; bar.x = 0; bar.st = nullptr;
    if (hi - lo > 1) bar = xcd_barrier_post(barw, MISC + 8);
    bar.wave = F.wave;
#define IN(k) (lo <= (k) && (k) < hi)
#define SEAM(k) do { if (IN(k) && IN((k) + 1)) { xcd_barrier(bar); if (REPS(14) > 1) xcd_barrier(bar); } } while (0)
    unsigned char* ws = F.ws;
    bf16* XN = (bf16*)(ws + WS_XN);
    const float* mod = (const float*)(ws + WS_CTL) + CW_MOD;

    if (IN(0)) { ph0_prologue(F, args, REPS(0)); SEAM(0); }
    if (IN(1)) { for (int rep = 0; rep < REPS(1); ++rep) { ph1_norm_dt(F, args); __syncthreads(); } SEAM(1); }
    if (IN(2)) {
        pg8::Gemm g{(const bf16*)(ws + WS_XN8), (const bf16*)(ws + WS_W8IN), M, NPROJ, D / 2}; pg8::StaticOrder S; S.init(M, NPROJ, F.G, (int)blockIdx.x);
        EpiInProj E{ws};
        RepOrder R{S, (S.nwg - S.c + S.G - 1) / S.G, REPS(2)};
        pg8::gemm_phase<EpiInProj, RepOrder, true, true, false, false, true>(F.lds, g, R, E, F.wave);
        SEAM(2);
    }
    if (IN(3)) { ph3_convbranch(F, args, REPS(3)); __syncthreads(); ph3_chunk_states(F, args, REPS(13)); __syncthreads(); SEAM(3); }
    if (IN(4)) {
        if (REPS(4) > 1) ph4_scan(F, WS_YS);
        ph4_scan(F, WS_ST);
        pg8::Gemm g{XN, (const bf16*)(ws + WS_WCV), M, D, D}; pg8::StaticOrder S; S.init(M, D, F.G, (int)blockIdx.x);
        EpiGate<false> E{(bf16*)(ws + WS_TMP), nullptr, (const bf16*)(ws + WS_GATE), 0, nullptr};
        RepOrder R{S, (S.nwg - S.c + S.G - 1) / S.G, REPS(15)};
        pg8::gemm_phase<EpiGate<false>, RepOrder, false, true>(F.lds, g, R, E, F.wave);
        SEAM(4);
    }
    if (IN(5)) { ph5_ssd_out(F, args, REPS(5)); SEAM(5); }
    if (IN(6)) {
        pg8::Gemm g{(const bf16*)(ws + WS_YS), (const bf16*)(ws + WS_WSSM), M, D, DIN / 2}; pg8::StaticOrder S; S.init(M, D, F.G, (int)blockIdx.x);
        LAS float* rt = (LAS float*)(F.lds + RT_OFF);
        EpiGate<true> E{(bf16*)(ws + WS_MG), (const bf16*)(ws + WS_TMP), (const bf16*)(ws + WS_GATE), 1024, rt};
        for (int i = 0;; ++i) {
            OneUnit S1; if (!S.next(i, S1.u)) break;
            if (F.wave < 4) { const int tid = F.wave * 64 + lane_id(); const f32x4 r = *(const f32x4*)((const float*)(ws + WS_RSTD) + (size_t)(S1.u.pm * 256 + tid) * 4);
                *(LAS f32x4*)(rt + tid * 4) = (f32x4){r.x / r.y, r.y / r.z, r.z / r.w, r.w}; }
            asm volatile("s_waitcnt vmcnt(0) lgkmcnt(0)" ::: "memory"); __syncthreads();
            pg8::gemm_phase<EpiGate<true>, OneUnit, false, true, true>(F.lds, g, S1, E, F.wave);
            __syncthreads();
        }
        SEAM(6);
    }
    if (IN(7)) {
        pg8::Gemm g{(const bf16*)(ws + WS_MG), (const bf16*)(ws + WS_WMIX), M, D, D}; pg8::StaticOrder S; S.init(M, D, F.G, (int)blockIdx.x);
        EpiMix E{(bf16*)(ws + WS_H16), ARG(I_X), (const float*)(ws + WS_CTL) + CW_MODC + 2 * 1024};
        RepOrder R{S, (S.nwg - S.c + S.G - 1) / S.G, REPS(7)};
        pg8::gemm_phase<EpiMix, RepOrder, false, true>(F.lds, g, R, E, F.wave);
        SEAM(7);
    }
    if (IN(8)) { for (int rep = 0; rep < REPS(8); ++rep) { convert_experts(F, args); __syncthreads(); } ph8_router(F, args, REPS(9)); if (IN(8) && IN(10)) xcd_barrier(bar); }
    if (IN(10)) {
        build_tilebase(F);
        const LAS int* tb = (const LAS int*)(F.lds + TB_OFF);
        pg8::Gemm g{(const bf16*)(ws + WS_XN), (const bf16*)(ws + WS_W13), M, NE * 1024, D / 2};
        MoeOrder S{tb, F.G, F.vcu, tb[NE] * 4, 1, (const LAS int*)(F.lds + TOKL_OFF)};
        fill_tokl(F, S);
        EpiUp E{ws + WS_HDN};
        pg8::gemm_phase<EpiUp, MoeOrder, true, true, true, true>(F.lds, g, S, E, F.wave);
        SEAM(10);
    }
    if (IN(11)) {
        build_tilebase(F);
        const LAS int* tb = (const LAS int*)(F.lds + TB_OFF);
        pg8::Gemm g{(const bf16*)(ws + WS_HDN), (const bf16*)(ws + WS_W2), 49152, NE * 1024, DFF / 2};
        MoeOrder S{tb, F.G, F.vcu, tb[NE] * 4, 1, nullptr};
        EpiDown E{ws + WS_YEXP};
        pg8::gemm_phase<EpiDown, MoeOrder, true, true, true>(F.lds, g, S, E, F.wave);
        SEAM(11);
    }
    if (IN(12)) { build_tilebase(F); ph12_final(F, args, REPS(12)); }
#undef IN
#undef SEAM
}

extern "C" void kernel_launch(void* const* d_in, const int* in_sizes, int n_in, void* d_out, int out_size, void* d_ws, size_t ws_size, hipStream_t stream) {
    static int grid = 0;
    if (grid == 0) {
        if (n_in != N_IN || in_sizes[0] != M * D || out_size != M * D || ws_size < WS_END) {
            fprintf(stderr, "kernel_launch: unexpected shapes: n_in %d in0 %d out %d ws %zu (need %zu)\n", n_in, n_in > 0 ? in_sizes[0] : -1, out_size, ws_size, (size_t)WS_END); grid = -1; return; }
        int dev = 0, cus = 0, per_cu = 0;
        if (hipGetDevice(&dev) != hipSuccess || hipDeviceGetAttribute(&cus, hipDeviceAttributeMultiprocessorCount, dev) != hipSuccess) { fprintf(stderr, "kernel_launch: device query failed\n"); grid = -1; return; }
        if (hipFuncSetAttribute((const void*)fwd_kernel, hipFuncAttributeMaxDynamicSharedMemorySize, LDS_BYTES) != hipSuccess) { fprintf(stderr, "kernel_launch: hipFuncSetAttribute failed\n"); grid = -1; return; }
        if (hipOccupancyMaxActiveBlocksPerMultiprocessor(&per_cu, (const void*)fwd_kernel, NTHREADS, LDS_BYTES) != hipSuccess || per_cu < 1) {
            fprintf(stderr, "kernel_launch: the occupancy query admits no workgroup of this kernel per CU (%d); nothing launched\n", per_cu); (void)hipGetLastError(); grid = -1; return; }
        grid = cus;
        if (cus < 192 || (cus & 7)) { fprintf(stderr, "kernel_launch: built for a 256-CU device (the MoE unit table holds 4 units per workgroup); %d CUs: nothing launched\n", cus); grid = -1; return; }
        fprintf(stderr, "kernel_launch: grid %d (cus %d, per_cu %d)\n", grid, cus, per_cu);
    }
    if (grid < 0) return;
    (void)hipMemsetAsync((char*)d_ws + WS_CTL, 0, CTL_ZERO_BYTES, stream);
    Args a{};
    for (int i = 0; i < N_IN; ++i) a.in[i] = (const float*)d_in[i];
    a.out = (float*)d_out; a.ws = (unsigned char*)d_ws;
#if MK_ONE_LAUNCH
    a.ph_lo = 0; a.ph_hi = N_PHASES;
    void* kargs[] = {&a};
    hipError_t e = hipLaunchCooperativeKernel((const void*)fwd_kernel, dim3(grid), dim3(NTHREADS), kargs, LDS_BYTES, stream);
    if (e != hipSuccess) fprintf(stderr, "kernel_launch: cooperative launch failed: %s\n", hipGetErrorString(e));
#else
    for (int ph = 0; ph < N_PHASES; ++ph) {
        a.ph_lo = ph; a.ph_hi = ph + 1;
        hipLaunchKernelGGL(fwd_kernel, dim3(grid), dim3(NTHREADS), LDS_BYTES, stream, a);
    }
#endif
}
```

```cpp
#include <hip/hip_runtime.h>
#include <hip/hip_cooperative_groups.h>
#include <cstdio>
#include <cstdint>
namespace pg8 {
#define PG8_LAS __attribute__((address_space(3)))
typedef unsigned short bf16_t;
typedef short bf16x8 __attribute__((ext_vector_type(8)));
typedef float f32x4 __attribute__((ext_vector_type(4)));
typedef unsigned u32x4 __attribute__((ext_vector_type(4)));
typedef int v4i_ __attribute__((ext_vector_type(4)));
typedef int v8i_ __attribute__((ext_vector_type(8)));
constexpr int BM = 256, BK = 64, HALF = 128, HTB = HALF * BK * 2  , STAGE_BYTES = 8 * HTB, NXCD = 8, WGM = 8;

__host__ __device__ __forceinline__ int lds_byte(int r, int c) { const int st = (r >> 4) * 2 + (c >> 5), rr = r & 15, cc = c & 31, ob = rr * 64 + cc * 2; return st * 1024 + (ob ^ (((ob >> 9) & 1) << 5)); }
__host__ __device__ __forceinline__ void stage_rc(int b, int& R, int& C) { const int st = b / 1024, sb = b % 1024, swz = sb ^ (((sb >> 9) & 1) << 5); R = (st >> 1) * 16 + swz / 64; C = (st & 1) * 32 + (swz % 64) / 2; }
__host__ __device__ __forceinline__ int perm32(int rho) { const int n = rho >> 4, i = rho & 15; return 8 * (i >> 2) + 4 * n + (i & 3); }

struct Unit { int pm, pn, aux; };
struct Gemm { const bf16_t* A; const bf16_t* Bt; int M, N, K; };

struct StaticOrder {
    int nM, nN, nwg, G, c;
    __host__ __device__ void init(int M, int N, int G_, int c_) { nM = M / BM; nN = N / BM; nwg = nM * nN; G = G_; c = c_; }
    __host__ __device__ bool next(int i, Unit& u) const {
        const long L = (long)i * G + c; if (L >= nwg) return false;
        int wgid = (int)L; { const int q = nwg / NXCD, r = nwg % NXCD, xcd = wgid % NXCD, off = wgid / NXCD; wgid = (xcd < r ? xcd * (q + 1) : r * (q + 1) + (xcd - r) * q) + off; }
        const int nig = WGM * nN, gid = wgid / nig, fm = gid * WGM, gsz = (nM - fm) < WGM ? (nM - fm) : WGM;
        u.pm = fm + ((wgid % nig) % gsz); u.pn = (wgid % nig) / gsz; return true;
    }
    __device__ __forceinline__ void a_ready(const Unit&) const {}
    __device__ __forceinline__ void done(const Unit&) const {}
};

__device__ __forceinline__ unsigned cvt_pk_bf16(float lo, float hi) { unsigned r; asm volatile("v_cvt_pk_bf16_f32 %0, %1, %2" : "=v"(r) : "v"(lo), "v"(hi)); return r; }
typedef float f32x2 __attribute__((ext_vector_type(2)));
template <class Epi, class Sched, bool ALIGN_EPI = false, bool SP2 = false, bool FP8 = false, bool GATHER = false, bool I8 = false>
__device__ __forceinline__ void gemm_phase(PG8_LAS unsigned char* lds, const Gemm g, const Sched& S, const Epi& E, const int wave_in) {
    const int lane = (int)__builtin_amdgcn_mbcnt_hi(~0u, __builtin_amdgcn_mbcnt_lo(~0u, 0u)), wid = wave_in, tid = wid * 64 + lane, wr = wid >> 2, wc = wid & 3, fr = lane & 15, fq = lane >> 4;
    const int K = g.K, nt = K / BK;
    unsigned voffA[2], voffB[2];
#pragma unroll
    for (int i = 0; i < 2; ++i) { int R, C; stage_rc(tid * 16 + i * 8192, R, C); const int Rb = Epi::PERM ? ((R & ~31) + perm32(R & 31)) : R;
        voffA[i] = (unsigned)(R * K + C) * 2u; voffB[i] = (unsigned)(Rb * K + C) * 2u; }
    static_assert(!GATHER || SP2, "GATHER is implemented in the SP2 loop");
    unsigned gA[2][2], ngA[2][2]; int RA[2]; unsigned CA2[2];
#pragma unroll
    for (int i = 0; i < 2; ++i) { int R, C; stage_rc(tid * 16 + i * 8192, R, C); RA[i] = R; CA2[i] = (unsigned)C * 2u; }
    auto load_g = [&](int ui_, unsigned (&dst)[2][2]) {
        if constexpr (GATHER) {
#pragma unroll
            for (int h = 0; h < 2; ++h)
#pragma unroll
                for (int i = 0; i < 2; ++i) dst[h][i] = (unsigned)S.tokl[ui_ * 256 + 128 * h + RA[i]] * (unsigned)(K * 2) + CA2[i];
        }
    };
    const size_t kstep = (size_t)(BK * 2);
    const size_t hstep = (size_t)HALF * K * 2;
    const size_t tstep = 2 * hstep;
    const size_t hstepA = GATHER ? (size_t)0 : hstep, tstepA = GATHER ? (size_t)0 : 2 * hstep;
    const unsigned ldsw = (unsigned)wid * 1024u;
    const int aoff = lds_byte(wr * 64 + fr, fq * 8), boff = lds_byte(wc * 32 + fr, fq * 8);
#define PG8_SA(b, h) (((b) * 2 + (h)) * HTB)
#define PG8_SB(b, h) ((4 + (b) * 2 + (h)) * HTB)
#define PG8_STAGE(bufoff, gbase, voff) do { _Pragma("unroll") for (int _i = 0; _i < 2; ++_i) \
        __builtin_amdgcn_global_load_lds((const unsigned*)((const char*)(gbase) + (voff)[_i]), (PG8_LAS unsigned*)(lds + (bufoff) + ldsw + _i * 8192), 16, 0, 0); } while (0)
#define PG8_STAGE_A(bufoff, gbase, gvoff) do { if constexpr (GATHER) { PG8_STAGE(bufoff, gbase, gvoff); } else { PG8_STAGE(bufoff, gbase, voffA); } } while (0)
#define PG8_LDA(dst, b, h) do { if constexpr (FP8) { _Pragma("unroll") for (int m = 0; m < 4; ++m) dst##8[m] = __builtin_shufflevector(*(const PG8_LAS v4i_*)(lds + PG8_SA(b, h) + aoff + m * 2048), *(const PG8_LAS v4i_*)(lds + PG8_SA(b, h) + aoff + m * 2048 + 1024), 0, 1, 2, 3, 4, 5, 6, 7); } \
        else { _Pragma("unroll") for (int m = 0; m < 4; ++m) _Pragma("unroll") for (int k = 0; k < 2; ++k) dst[m][k] = *(const PG8_LAS bf16x8*)(lds + PG8_SA(b, h) + aoff + m * 2048 + k * 1024); } } while (0)
#define PG8_LDB(dst, b, h) do { if constexpr (FP8) { _Pragma("unroll") for (int n = 0; n < 2; ++n) dst##8[n] = __builtin_shufflevector(*(const PG8_LAS v4i_*)(lds + PG8_SB(b, h) + boff + n * 2048), *(const PG8_LAS v4i_*)(lds + PG8_SB(b, h) + boff + n * 2048 + 1024), 0, 1, 2, 3, 4, 5, 6, 7); } \
        else { _Pragma("unroll") for (int n = 0; n < 2; ++n) _Pragma("unroll") for (int k = 0; k < 2; ++k) dst[n][k] = *(const PG8_LAS bf16x8*)(lds + PG8_SB(b, h) + boff + n * 2048 + k * 1024); } } while (0)
#define PG8_MMA(ai, bj, At, Bt) do { __builtin_amdgcn_s_setprio(1); \
        if constexpr (FP8) {   \
              \
            _Pragma("unroll") for (int m = 0; m < 4; ++m) _Pragma("unroll") for (int n = 0; n < 2; ++n) \
                asm volatile("v_mfma_scale_f32_16x16x128_f8f6f4 %0, %1, %2, %0, %3, %4 op_sel_hi:[0,0,0]" : "+v"(acc[ai][bj][m][n]) : "v"(Bt##8[n]), "v"(At##8[m]), "v"(scale_w), "v"(scale_x)); \
        } else { \
        _Pragma("unroll") for (int m = 0; m < 4; ++m) _Pragma("unroll") for (int n = 0; n < 2; ++n) _Pragma("unroll") for (int k = 0; k < 2; ++k) { \
        if constexpr (I8) acc[ai][bj][m][n] = __builtin_bit_cast(f32x4, __builtin_amdgcn_mfma_i32_16x16x64_i8(__builtin_bit_cast(v4i_, Bt[n][k]), __builtin_bit_cast(v4i_, At[m][k]), __builtin_bit_cast(v4i_, acc[ai][bj][m][n]), 0, 0, 0)); \
        else acc[ai][bj][m][n] = __builtin_amdgcn_mfma_f32_16x16x32_bf16(Bt[n][k], At[m][k], acc[ai][bj][m][n], 0, 0, 0); } } __builtin_amdgcn_s_setprio(0); } while (0)
#define PG8_WAIT_V(n) asm volatile("s_waitcnt vmcnt(" #n ")" ::: "memory")
#define PG8_WAIT_L(n) asm volatile("s_waitcnt lgkmcnt(" #n ")" ::: "memory")
#define PG8_BAR __builtin_amdgcn_s_barrier()
#define PG8_SCHED __builtin_amdgcn_sched_barrier(0)
    Unit cur, nxt; int ui = 0;
    if (!S.next(0, cur)) return;
    f32x4 acc[2][2][4][2];
#pragma unroll
    for (int a = 0; a < 2; ++a)
#pragma unroll
        for (int b = 0; b < 2; ++b)
#pragma unroll
            for (int m = 0; m < 4; ++m)
#pragma unroll
                for (int n = 0; n < 2; ++n) acc[a][b][m][n] = (f32x4){0.f, 0.f, 0.f, 0.f};
    auto xdl_settle = [&]() {
        asm volatile("s_nop 15\n\ts_nop 15" : "+v"(acc[0][0][0][0]), "+v"(acc[0][0][0][1]), "+v"(acc[0][0][1][0]), "+v"(acc[0][0][1][1]), "+v"(acc[0][0][2][0]), "+v"(acc[0][0][2][1]), "+v"(acc[0][0][3][0]), "+v"(acc[0][0][3][1]), "+v"(acc[0][1][0][0]), "+v"(acc[0][1][0][1]), "+v"(acc[0][1][1][0]), "+v"(acc[0][1][1][1]), "+v"(acc[0][1][2][0]), "+v"(acc[0][1][2][1]), "+v"(acc[0][1][3][0]), "+v"(acc[0][1][3][1]));
        asm volatile("s_nop 0" : "+v"(acc[1][0][0][0]), "+v"(acc[1][0][0][1]), "+v"(acc[1][0][1][0]), "+v"(acc[1][0][1][1]), "+v"(acc[1][0][2][0]), "+v"(acc[1][0][2][1]), "+v"(acc[1][0][3][0]), "+v"(acc[1][0][3][1]), "+v"(acc[1][1][0][0]), "+v"(acc[1][1][0][1]), "+v"(acc[1][1][1][0]), "+v"(acc[1][1][1][1]), "+v"(acc[1][1][2][0]), "+v"(acc[1][1][2][1]), "+v"(acc[1][1][3][0]), "+v"(acc[1][1][3][1]));
    };
    const int scale_w = 0x79797979, scale_x = 0x7f7f7f7f;
    bf16x8 At[4][2], B0[2][2], B1[2][2]; v8i_ At8[4], B08[2], B18[2];
    const char* cA = (const char*)g.A + (size_t)cur.pm * tstepA; const char* cB = (const char*)g.Bt + (size_t)cur.pn * tstep;
    load_g(0, gA);
    S.a_ready(cur);
    if constexpr (SP2) {
        PG8_STAGE(PG8_SB(0, 0), cB, voffB); PG8_STAGE(PG8_SB(0, 1), cB + hstep, voffB); PG8_STAGE_A(PG8_SA(0, 0), cA, gA[0]); PG8_STAGE_A(PG8_SA(0, 1), cA + hstepA, gA[1]);
        if (wr == 1) PG8_BAR;
        PG8_WAIT_V(2); PG8_BAR;
        PG8_STAGE(PG8_SB(1, 0), cB + kstep, voffB); PG8_STAGE_A(PG8_SA(1, 0), cA + kstep, gA[0]); PG8_STAGE(PG8_SB(1, 1), cB + hstep + kstep, voffB);
        PG8_WAIT_V(6); PG8_BAR;
    } else {
        PG8_STAGE(PG8_SB(0, 0), cB, voffB); PG8_STAGE(PG8_SA(0, 0), cA, voffA); PG8_STAGE(PG8_SB(0, 1), cB + hstep, voffB); PG8_STAGE(PG8_SA(0, 1), cA + hstep, voffA);
        if (wr == 1) PG8_BAR;
        PG8_WAIT_V(4); PG8_BAR;
        PG8_STAGE(PG8_SB(1, 0), cB + kstep, voffB); PG8_STAGE(PG8_SA(1, 0), cA + kstep, voffA); PG8_STAGE(PG8_SB(1, 1), cB + hstep + kstep, voffB);
        PG8_WAIT_V(6); PG8_BAR;
    }
    for (;;) {
        const bool has_next = S.next(ui + 1, nxt);
        const char* nA = has_next ? (const char*)g.A + (size_t)nxt.pm * tstepA : cA; const char* nB = has_next ? (const char*)g.Bt + (size_t)nxt.pn * tstep : cB;
        if constexpr (GATHER) { if (has_next) load_g(ui + 1, ngA); else {
#pragma unroll
            for (int h = 0; h < 2; ++h)
#pragma unroll
                for (int i = 0; i < 2; ++i) ngA[h][i] = gA[h][i]; } }
        for (int t = 0; t < nt; t += 2) {
            const bool last = (t == nt - 2);
            const char* a1 = cA + (size_t)(t + 1) * kstep;
            const char* a2 = last ? nA : cA + (size_t)(t + 2) * kstep; const char* b2 = last ? nB : cB + (size_t)(t + 2) * kstep;
            const char* a3 = a2 + kstep; const char* b3 = b2 + kstep;
            if (last && has_next) S.a_ready(nxt);
            unsigned sN[2][2];
#pragma unroll
            for (int h = 0; h < 2; ++h)
#pragma unroll
                for (int i = 0; i < 2; ++i) sN[h][i] = last ? ngA[h][i] : gA[h][i];
            if constexpr (SP2) {
            PG8_LDB(B0, 0, 0); PG8_LDB(B1, 0, 1); PG8_SCHED; PG8_LDA(At, 0, 0); PG8_STAGE_A(PG8_SA(1, 1), a1 + hstepA, gA[1]);
            PG8_WAIT_V(8); PG8_WAIT_L(0); PG8_BAR; PG8_MMA(0, 0, At, B0); PG8_MMA(0, 1, At, B1); PG8_BAR; PG8_SCHED;
            PG8_LDA(At, 0, 1); PG8_STAGE(PG8_SB(0, 0), b2, voffB); PG8_STAGE(PG8_SB(0, 1), b2 + hstep, voffB); PG8_STAGE_A(PG8_SA(0, 0), a2, sN[0]);
            PG8_WAIT_V(8); PG8_WAIT_L(0); PG8_BAR; PG8_MMA(1, 0, At, B0); PG8_MMA(1, 1, At, B1); PG8_BAR; PG8_SCHED;
            PG8_LDB(B0, 1, 0); PG8_LDB(B1, 1, 1); PG8_SCHED; PG8_LDA(At, 1, 0); PG8_STAGE_A(PG8_SA(0, 1), a2 + hstepA, sN[1]);
            PG8_WAIT_V(8); PG8_WAIT_L(0); PG8_BAR; PG8_MMA(0, 0, At, B0); PG8_MMA(0, 1, At, B1); PG8_BAR; PG8_SCHED;
            PG8_LDA(At, 1, 1); PG8_STAGE(PG8_SB(1, 0), b3, voffB); PG8_STAGE(PG8_SB(1, 1), b3 + hstep, voffB); PG8_STAGE_A(PG8_SA(1, 0), a3, sN[0]);
            PG8_WAIT_V(8); PG8_WAIT_L(0); PG8_BAR; PG8_MMA(1, 0, At, B0); PG8_MMA(1, 1, At, B1); PG8_BAR; PG8_SCHED;
            } else {
            PG8_LDB(B0, 0, 0); PG8_SCHED; PG8_LDA(At, 0, 0); PG8_STAGE(PG8_SA(1, 1), a1 + hstep, voffA);
            PG8_WAIT_L(8); PG8_BAR; PG8_WAIT_L(0); PG8_MMA(0, 0, At, B0); PG8_BAR; PG8_SCHED;
            PG8_LDB(B1, 0, 1); PG8_STAGE(PG8_SB(0, 0), b2, voffB);
            PG8_BAR; PG8_WAIT_L(0); PG8_MMA(0, 1, At, B1); PG8_BAR;
            PG8_LDA(At, 0, 1); PG8_STAGE(PG8_SA(0, 0), a2, voffA);
            PG8_BAR; PG8_WAIT_L(0); PG8_MMA(1, 0, At, B0); PG8_BAR; PG8_SCHED;
            PG8_STAGE(PG8_SB(0, 1), b2 + hstep, voffB);
            PG8_WAIT_V(6); PG8_BAR; PG8_MMA(1, 1, At, B1); PG8_BAR;
            PG8_LDB(B0, 1, 0); PG8_SCHED; PG8_LDA(At, 1, 0); PG8_STAGE(PG8_SA(0, 1), a2 + hstep, voffA);
            PG8_WAIT_L(8); PG8_BAR; PG8_WAIT_L(0); PG8_MMA(0, 0, At, B0); PG8_BAR; PG8_SCHED;
            PG8_LDB(B1, 1, 1); PG8_STAGE(PG8_SB(1, 0), b3, voffB);
            PG8_BAR; PG8_WAIT_L(0); PG8_MMA(0, 1, At, B1); PG8_BAR;
            PG8_LDA(At, 1, 1); PG8_STAGE(PG8_SA(1, 0), a3, voffA);
            PG8_BAR; PG8_WAIT_L(0); PG8_MMA(1, 0, At, B0); PG8_BAR; PG8_SCHED;
            PG8_STAGE(PG8_SB(1, 1), b3 + hstep, voffB);
            PG8_WAIT_V(6); PG8_BAR; PG8_MMA(1, 1, At, B1); PG8_BAR;
            }
            if constexpr (Epi::KHOOK) { constexpr int HK = FP8 ? 4 : 8, HS = FP8 ? 2 : 3;
                if ((((t + 2) & (HK - 1)) == 0) && (t + 2 < nt)) { if constexpr (FP8) xdl_settle(); E.khook(acc, ((t + 2) >> HS) - 1, wr, fr); if constexpr (FP8) xdl_settle(); } }
        }
        if constexpr (ALIGN_EPI) { if (wr == 0) PG8_BAR; }
        if constexpr (FP8) {
            xdl_settle();
        }
        if constexpr (!Epi::AFTER_DRAIN) { E(acc, cur, wr, wc, fr, fq); S.done(cur); }
        if (!has_next) break;
#pragma unroll
        for (int a = 0; a < 2; ++a)
#pragma unroll
            for (int b = 0; b < 2; ++b)
#pragma unroll
                for (int m = 0; m < 4; ++m)
#pragma unroll
                    for (int n = 0; n < 2; ++n) acc[a][b][m][n] = (f32x4){0.f, 0.f, 0.f, 0.f};
        cur = nxt; cA = nA; cB = nB; ++ui;
        if constexpr (GATHER) {
#pragma unroll
            for (int h = 0; h < 2; ++h)
#pragma unroll
                for (int i = 0; i < 2; ++i) gA[h][i] = ngA[h][i]; }
        if constexpr (ALIGN_EPI) { if (wr == 1) PG8_BAR; }
    }
    PG8_WAIT_V(0);
    if constexpr (!ALIGN_EPI) { if (wr == 0) PG8_BAR; }
    PG8_BAR;
    if constexpr (Epi::AFTER_DRAIN) { E.fused(acc, cur, wr, wc, fr, fq, lds, wid, lane); S.done(cur); }
#undef PG8_SA
#undef PG8_SB
#undef PG8_STAGE
#undef PG8_STAGE_A
#undef PG8_LDA
#undef PG8_LDB
#undef PG8_MMA
#undef PG8_WAIT_V
#undef PG8_WAIT_L
#undef PG8_BAR
#undef PG8_SCHED
}
}

#define DI __device__ __forceinline__
#define GAS __attribute__((address_space(1)))
#define LAS __attribute__((address_space(3)))
typedef unsigned short bf16;
typedef unsigned v4u __attribute__((ext_vector_type(4)));
typedef unsigned v2u __attribute__((ext_vector_type(2)));
typedef float f32x4 __attribute__((ext_vector_type(4)));
typedef float f32x16 __attribute__((ext_vector_type(16)));
typedef short bf16x8 __attribute__((ext_vector_type(8)));
typedef __bf16 bf2v __attribute__((ext_vector_type(2)));
typedef float f2v __attribute__((ext_vector_type(2)));
typedef GAS unsigned gu32;

constexpr int NWAVES = 8, NTHREADS = 512;
constexpr int M = 16384, D = 1024, DIN = 2048, NH = 32, HD = 64, NGRP = 4, NST = 128, XBCW = 3072;
constexpr int NPROJ = 9216, WIN_LD = 9248;
constexpr int LCH = 128, NCH = M / LCH;
constexpr int NE = 64, DFF = 512;
constexpr float EPS = 1e-6f;
constexpr float LOG2E = 1.4426950408889634f;

constexpr size_t MiB = 1u << 20;
constexpr size_t WS_CTL = 0, CTL_ZERO_BYTES = 262144;
constexpr size_t WS_WIN = 1 * MiB, WS_WDT = 19 * MiB, WS_WCV = 20 * MiB, WS_WMIX = 22 * MiB, WS_WSSM = 24 * MiB;
constexpr size_t WS_RSTD = 31 * MiB + 524288;
constexpr size_t WS_DT = 28 * MiB, WS_CD = 30 * MiB, WS_WRH = 30 * MiB + 65536, WS_WRL = WS_WRH + 262144, WS_ROUTE = 31 * MiB;
constexpr size_t WS_ST = 32 * MiB, WS_YS = 96 * MiB, WS_TMP = 160 * MiB, WS_MG = 192 * MiB;
constexpr size_t WS_W13 = 32 * MiB, WS_W2 = 160 * MiB, WS_H16 = 96 * MiB;
constexpr size_t WS_XN8 = 32 * MiB, WS_W8IN = 48 * MiB, WS_SA = 60 * MiB, WS_SW = 61 * MiB;
constexpr size_t WS_XN = 224 * MiB;
constexpr size_t WS_U = 256 * MiB, WS_ZS = 288 * MiB, WS_XBC = 352 * MiB, WS_GATE = 448 * MiB;
constexpr size_t WS_LIST = 256 * MiB, WS_HDN = 352 * MiB, WS_YEXP = 400 * MiB;
constexpr size_t WS_END = 512 * MiB;
constexpr int CW_BAR = 4096;
constexpr int CW_CNT = 8192;
constexpr int CW_MODC = 40960;
constexpr int CW_WMAX = 49152;
constexpr int CW_MOD = 16384;

constexpr int RING_BYTES = 131072;
constexpr int LDSCTL_OFF = 147456;
constexpr int TB_OFF = LDSCTL_OFF + 256;
constexpr int CNTL_OFF = TB_OFF + 320;
constexpr int TOKL_OFF = LDSCTL_OFF + 1024;
constexpr int RT_OFF = 148480;
constexpr int SCL_OFF = 131072;
constexpr int LDS_BYTES = 152576;

#define LDS_WAIT() asm volatile("s_waitcnt lgkmcnt(0)" ::: "memory")
#define VM_WAIT() asm volatile("s_waitcnt vmcnt(0)" ::: "memory")

DI unsigned pk2(float lo, float hi) { f2v v = {lo, hi}; return __builtin_bit_cast(unsigned, __builtin_convertvector(v, bf2v)); }
DI unsigned pk4_fp8(float a, float b, float c, float d) {
    a = __builtin_fminf(__builtin_fmaxf(a, -448.f), 448.f); b = __builtin_fminf(__builtin_fmaxf(b, -448.f), 448.f);
    c = __builtin_fminf(__builtin_fmaxf(c, -448.f), 448.f); d = __builtin_fminf(__builtin_fmaxf(d, -448.f), 448.f);
    unsigned w = 0u; w = __builtin_amdgcn_cvt_pk_fp8_f32(a, b, w, false); w = __builtin_amdgcn_cvt_pk_fp8_f32(c, d, w, true); return w; }
DI unsigned pk4_fp8_nc(float a, float b, float c, float d) { unsigned w = 0u; w = __builtin_amdgcn_cvt_pk_fp8_f32(a, b, w, false); w = __builtin_amdgcn_cvt_pk_fp8_f32(c, d, w, true); return w; }
DI unsigned pk4_i8(float a, float b, float c, float d) {
    const int ia = (int)__builtin_rintf(a), ib = (int)__builtin_rintf(b), ic = (int)__builtin_rintf(c), id = (int)__builtin_rintf(d);
    return ((unsigned)ia & 255u) | (((unsigned)ib & 255u) << 8) | (((unsigned)ic & 255u) << 16) | ((unsigned)id << 24); }
DI unsigned pk2_fp8(float a, float b) {
    a = __builtin_fminf(__builtin_fmaxf(a, -448.f), 448.f); b = __builtin_fminf(__builtin_fmaxf(b, -448.f), 448.f);
    return __builtin_amdgcn_cvt_pk_fp8_f32(a, b, 0u, false) & 0xffffu; }
DI bf16x8 fp8x8_to_bf16(v2u w) {
    v4u o; o.x = pk2(__builtin_amdgcn_cvt_f32_fp8(w.x, 0), __builtin_amdgcn_cvt_f32_fp8(w.x, 1)); o.y = pk2(__builtin_amdgcn_cvt_f32_fp8(w.x, 2), __builtin_amdgcn_cvt_f32_fp8(w.x, 3));
    o.z = pk2(__builtin_amdgcn_cvt_f32_fp8(w.y, 0), __builtin_amdgcn_cvt_f32_fp8(w.y, 1)); o.w = pk2(__builtin_amdgcn_cvt_f32_fp8(w.y, 2), __builtin_amdgcn_cvt_f32_fp8(w.y, 3));
    return __builtin_bit_cast(bf16x8, o); }
DI float bflo(unsigned u) { return __uint_as_float(u << 16); }
DI float bfhi(unsigned u) { return __uint_as_float(u & 0xffff0000u); }
DI float sigmoidf_(float x) { return __builtin_amdgcn_rcpf(1.f + __builtin_amdgcn_exp2f(x * -LOG2E)); }
DI float siluf_(float x) { return x * __builtin_amdgcn_rcpf(1.f + __builtin_amdgcn_exp2f(x * -LOG2E)); }
DI float wave_sum(float v) {
#pragma unroll
    for (int o = 1; o < 64; o <<= 1) v += __shfl_xor(v, o);
    return v;
}
DI f32x4 mod4(const float* modp, int k) { return (*(const f32x4*)(modp + k) + *(const f32x4*)(modp + 6144 + k)) + (*(const f32x4*)(modp + 2 * 6144 + k) + *(const f32x4*)(modp + 3 * 6144 + k)); }
DI int crow(int reg, int hh) { return (reg & 3) + 8 * (reg >> 2) + 4 * hh; }
DI int swz(int row, int chunk) { return chunk ^ ((row ^ (row >> 3)) & 15); }
#define MFMA32(a, b, c) __builtin_amdgcn_mfma_f32_32x32x16_bf16((a), (b), (c), 0, 0, 0)

DI int lane_id() { return (int)__builtin_amdgcn_mbcnt_hi(~0u, __builtin_amdgcn_mbcnt_lo(~0u, 0u)); }
#define XB_TMO      128
#define XB_XCNT(j)  (256  + 64 * (j))
#define XB_XSUB(j)  (1280 + 64 * (j))
#define XB_XGEN(j)  (2304 + 64 * (j))
#define XB_TOP      3328
#define XB_TOPGEN   3392
#define XCD_BAR_WORDS 3456
#define XB_SPIN_CAP (1u << 18)
DI unsigned xb_ld(unsigned* p)              { return __hip_atomic_load(p, __ATOMIC_RELAXED, __HIP_MEMORY_SCOPE_AGENT); }
DI unsigned xb_add(unsigned* p, unsigned v) { return __hip_atomic_fetch_add(p, v, __ATOMIC_RELAXED, __HIP_MEMORY_SCOPE_AGENT); }
DI unsigned xb_xcc_id() { return (unsigned)__builtin_amdgcn_s_getreg((3 << 11) | 20) & 0xFu; }
#define XB_SPIN(cond, bar) do { unsigned _sp = 0; while (cond) { __builtin_amdgcn_s_sleep(1); \
    if ((++_sp & 255u) == 0u) { if (xb_ld(&(bar)[XB_TMO])) break; if (_sp > XB_SPIN_CAP) { atomicAdd(&(bar)[XB_TMO], 1u); break; } } } } while (0)
struct XcdBarrier { unsigned* bar; unsigned x; volatile LAS unsigned* st; int wave; };
DI XcdBarrier xcd_barrier_post(unsigned* bar, volatile LAS unsigned* st) {
    XcdBarrier b; b.bar = bar; b.x = xb_xcc_id(); b.st = st; b.wave = 0;
    if (threadIdx.x == 0) (void)xb_add(&bar[XB_XCNT(b.x)], 1u);
    return b;
}
DI void xcd_barrier_complete(unsigned* bar, unsigned x, unsigned& nloc, unsigned& nx) {
    const unsigned G = gridDim.x * gridDim.y * gridDim.z;
    unsigned sum, cnt, mine, sp = 0u;
    for (;;) {
        sum = 0u; cnt = 0u; mine = 0u;
#pragma unroll
        for (unsigned j = 0; j < 16; ++j) { const unsigned c = xb_ld(&bar[XB_XCNT(j)]); sum += c; cnt += (c > 0u) ? 1u : 0u; mine = (j == x) ? c : mine; }
        if (sum == G) break;
        __builtin_amdgcn_s_sleep(1);
        if ((++sp & 255u) == 0u) { if (xb_ld(&bar[XB_TMO])) break; if (sp > XB_SPIN_CAP) { atomicAdd(&bar[XB_TMO], 1u); break; } }
    }
    nloc = mine > 0u ? mine : 1u; nx = cnt > 0u ? cnt : 1u;
}
DI void xcd_barrier(const XcdBarrier& b) {
    asm volatile("s_waitcnt vmcnt(0)" ::: "memory");
    __syncthreads();
    if (b.wave == 0 && lane_id() == 0) {
        unsigned* bar = b.bar;
        __builtin_amdgcn_s_waitcnt(0);
        unsigned nloc = b.st[0], nx = b.st[1];
        if (nloc == 0u) { xcd_barrier_complete(bar, b.x, nloc, nx); b.st[0] = nloc; b.st[1] = nx; }
        const unsigned old = xb_add(&bar[XB_XSUB(b.x)], 1u);
        const unsigned gen = old / nloc;
        if (old + 1u == (gen + 1u) * nloc) {
            __builtin_amdgcn_fence(__ATOMIC_RELEASE, "agent");
            asm volatile("s_waitcnt vmcnt(0)" ::: "memory");
            const unsigned og = xb_add(&bar[XB_TOP], 1u);
            const unsigned tg = og / nx;
            if (og + 1u == (tg + 1u) * nx) xb_add(&bar[XB_TOPGEN], 1u);
            else XB_SPIN(xb_ld(&bar[XB_TOPGEN]) == tg, bar);
            __builtin_amdgcn_fence(__ATOMIC_ACQUIRE, "agent");
            xb_add(&bar[XB_XGEN(b.x)], 1u);
            asm volatile("s_waitcnt vmcnt(0)" ::: "memory");
        } else {
            XB_SPIN(xb_ld(&bar[XB_XGEN(b.x)]) == gen, bar);
            __builtin_amdgcn_fence(__ATOMIC_ACQUIRE, "agent");
            asm volatile("s_waitcnt vmcnt(0)" ::: "memory");
        }
    }
    __syncthreads();
}

enum { I_X = 0, I_C, I_WADA, I_BADA, I_N1G, I_WIN, I_CVW, I_CVB, I_LNG, I_LNB, I_WCV, I_SCW, I_SCB, I_DTB, I_ALOG, I_DSKIP, I_SNG, I_WSSM, I_WMIX,
       I_N2G, I_WGRP, I_BGRP, I_WER, I_BER, I_W1, I_W3, I_W2, I_FG, N_IN };
struct Args { const float* in[N_IN]; float* out; unsigned char* ws; int ph_lo, ph_hi; };

template <int I> DI const float* argp() {
    auto kp = __builtin_amdgcn_kernarg_segment_ptr();
    unsigned long long v;
    asm volatile("s_load_dwordx2 %0, %1, %2\n\ts_waitcnt lgkmcnt(0)" : "=s"(v) : "s"(kp), "i"(I * 8));
    return (const float*)(const GAS float*)v;
}
#define ARG(i) argp<i>()
struct Ctx {
    LAS unsigned char* lds;
    int wave, vcu, G, xcd, xj;
    unsigned char* ws;
};

DI int xcd_unit(int x, int j, int gx, int i, int N) { const int u = i * gx + j; return (u < (N >> 3)) ? x * (N >> 3) + u : -1; }
DI int inproj_tile(int p) { return p < 8 ? p + 8 : (p < 16 ? p + 20 : (p < 24 ? p - 16 : p - 8)); }
DI int win_col(int npp) { const int np = inproj_tile(npp >> 8) * 256 + (npp & 255);
    if (np < 2048) { const int q = np >> 3, rr = np & 7; return (rr >> 2) * 1024 + 4 * q + (rr & 3); } return np < 7168 ? np : np + 32; }
struct EpiInProj {
    static constexpr bool PERM = true, AFTER_DRAIN = false, KHOOK = false; static constexpr int NPF = 0;
    unsigned char* ws; LAS unsigned char* lds;
    DI static pg8::f32x4 cvt(const pg8::f32x4& a, float sr, const f32x4& sc) { const pg8::v4i_ q = __builtin_bit_cast(pg8::v4i_, a);
        return (pg8::f32x4){(float)q[0] * (sr * sc.x), (float)q[1] * (sr * sc.y), (float)q[2] * (sr * sc.z), (float)q[3] * (sr * sc.w)}; }
    DI void operator()(const pg8::f32x4 (&acc)[2][2][4][2], const pg8::Unit& u, int wr, int wc, int fr, int fq) const {
        const int pn = inproj_tile(u.pn), row0 = u.pm * 256 + wr * 64 + fr;
        const LAS float* SAl = (const LAS float*)(lds + SCL_OFF + (u.aux & 1) * 2048); const LAS float* SWl = SAl + 256 + wc * 32 + fq * 8;
        f32x4 sc[2][2];
#pragma unroll
        for (int bj = 0; bj < 2; ++bj) { sc[bj][0] = *(const LAS f32x4*)(SWl + bj * 128); sc[bj][1] = *(const LAS f32x4*)(SWl + bj * 128 + 4); }
        float sr[2][4];
#pragma unroll
        for (int ai = 0; ai < 2; ++ai)
#pragma unroll
            for (int m = 0; m < 4; ++m) sr[ai][m] = SAl[wr * 64 + fr + ai * 128 + m * 16];
        if (pn < 8) {
            bf16* U = (bf16*)(ws + WS_U);
#pragma unroll
            for (int ai = 0; ai < 2; ++ai)
#pragma unroll
                for (int m = 0; m < 4; ++m) {
                    bf16* rowp = U + (size_t)(row0 + ai * 128 + m * 16) * D + pn * 128 + wc * 16 + fq * 4;
#pragma unroll
                    for (int bj = 0; bj < 2; ++bj) { const pg8::f32x4 a = cvt(acc[ai][bj][m][0], sr[ai][m], sc[bj][0]), b = cvt(acc[ai][bj][m][1], sr[ai][m], sc[bj][1]);
                        v2u w; w.x = pk2(a[0] * sigmoidf_(b[0]), a[1] * sigmoidf_(b[1])); w.y = pk2(a[2] * sigmoidf_(b[2]), a[3] * sigmoidf_(b[3]));
                        *(v2u*)(rowp + bj * 64) = w; } }
        } else {
            const bool isz = pn < 16, isx = (pn >= 16) && (pn < 28);
            const size_t boff = isz ? WS_ZS : (isx ? WS_XBC : WS_GATE);
            const int ldc = isx ? XBCW : DIN;
            const int colt = (pn - (isz ? 8 : (isx ? 16 : 28))) * 256;
            bf16* base = (bf16*)(ws + boff);
            const int col0 = colt + wc * 32 + fq * 8;
#pragma unroll
            for (int ai = 0; ai < 2; ++ai)
#pragma unroll
                for (int m = 0; m < 4; ++m) {
                    bf16* rowp = base + (size_t)(row0 + ai * 128 + m * 16) * ldc + col0;
#pragma unroll
                    for (int bj = 0; bj < 2; ++bj) { pg8::f32x4 v0 = cvt(acc[ai][bj][m][0], sr[ai][m], sc[bj][0]), v1 = cvt(acc[ai][bj][m][1], sr[ai][m], sc[bj][1]);
                        if (isz) {
#pragma unroll
                            for (int i = 0; i < 4; ++i) { v0[i] = v0[i] * sigmoidf_(v0[i]); v1[i] = v1[i] * sigmoidf_(v1[i]); }
                        }
                        if (!isz && !isx) {
                            v2u w8; w8.x = pk4_fp8(v0[0], v0[1], v0[2], v0[3]); w8.y = pk4_fp8(v1[0], v1[1], v1[2], v1[3]);
                            *(v2u*)((unsigned char*)base + (size_t)(row0 + ai * 128 + m * 16) * ldc + col0 + bj * 128) = w8;
                        } else {
                        v4u w; w.x = pk2(v0[0], v0[1]); w.y = pk2(v0[2], v0[3]); w.z = pk2(v1[0], v1[1]); w.w = pk2(v1[2], v1[3]);
                        *(v4u*)(rowp + bj * 128) = w; } } }
        }
    }
};
template <bool NORM> struct EpiGate {
    static constexpr bool PERM = true, AFTER_DRAIN = false, KHOOK = NORM;
    bf16* O; const bf16* P; const bf16* GATE; int gcol; const LAS float* rt;
    DI void khook(pg8::f32x4 (&acc)[2][2][4][2], int b, int wr, int fr) const {
#pragma unroll
        for (int ai = 0; ai < 2; ++ai)
#pragma unroll
            for (int m = 0; m < 4; ++m) { const float f = rt[(ai * 128 + wr * 64 + m * 16 + fr) * 4 + b];
#pragma unroll
                for (int bj = 0; bj < 2; ++bj)
#pragma unroll
                    for (int n = 0; n < 2; ++n) acc[ai][bj][m][n] = acc[ai][bj][m][n] * f; }
    }
    DI void operator()(const pg8::f32x4 (&acc)[2][2][4][2], const pg8::Unit& u, int wr, int wc, int fr, int fq) const {
        const int row0 = u.pm * 256 + wr * 64 + fr, col0 = u.pn * 256 + wc * 32 + fq * 8;
        v2u g[4]; v4u p[4], wA[4], wB[4];
        auto loadq = [&](int bj, int ai) {
#pragma unroll
            for (int m = 0; m < 4; ++m) { const size_t r = (size_t)(row0 + ai * 128 + m * 16); const int c = col0 + bj * 128;
                g[m] = *(const v2u*)((const unsigned char*)GATE + r * (2 * D) + gcol + c); if (NORM) p[m] = *(const v4u*)(P + r * D + c); }
        };
        auto calcq = [&](int bj, int ai, v4u (&w)[4]) {
#pragma unroll
            for (int m = 0; m < 4; ++m) {
                float f = 1.0f; if (NORM) f = rt[(ai * 128 + wr * 64 + m * 16 + fr) * 4 + 3];
                const v2u gg = g[m];
                pg8::f32x4 v0 = acc[ai][bj][m][0] * f, v1 = acc[ai][bj][m][1] * f;
                float o[8] = {v0[0] * sigmoidf_(__builtin_amdgcn_cvt_f32_fp8(gg.x, 0)), v0[1] * sigmoidf_(__builtin_amdgcn_cvt_f32_fp8(gg.x, 1)), v0[2] * sigmoidf_(__builtin_amdgcn_cvt_f32_fp8(gg.x, 2)), v0[3] * sigmoidf_(__builtin_amdgcn_cvt_f32_fp8(gg.x, 3)),
                              v1[0] * sigmoidf_(__builtin_amdgcn_cvt_f32_fp8(gg.y, 0)), v1[1] * sigmoidf_(__builtin_amdgcn_cvt_f32_fp8(gg.y, 1)), v1[2] * sigmoidf_(__builtin_amdgcn_cvt_f32_fp8(gg.y, 2)), v1[3] * sigmoidf_(__builtin_amdgcn_cvt_f32_fp8(gg.y, 3))};
                if (NORM) { const v4u pp = p[m];
                    o[0] += bflo(pp.x); o[1] += bfhi(pp.x); o[2] += bflo(pp.y); o[3] += bfhi(pp.y); o[4] += bflo(pp.z); o[5] += bfhi(pp.z); o[6] += bflo(pp.w); o[7] += bfhi(pp.w); }
                w[m].x = pk2(o[0], o[1]); w[m].y = pk2(o[2], o[3]); w[m].z = pk2(o[4], o[5]); w[m].w = pk2(o[6], o[7]); }
        };
        auto storeq = [&](int bj, int ai, const v4u (&w)[4]) {
#pragma unroll
            for (int m = 0; m < 4; ++m) *(v4u*)(O + (size_t)(row0 + ai * 128 + m * 16) * D + col0 + bj * 128) = w[m];
        };
        loadq(0, 0); calcq(0, 0, wA); loadq(0, 1); storeq(0, 0, wA); calcq(0, 1, wB); loadq(1, 0); storeq(0, 1, wB); calcq(1, 0, wA); loadq(1, 1); storeq(1, 0, wA); calcq(1, 1, wB); storeq(1, 1, wB);
    }
};
struct EpiMix {
    static constexpr bool PERM = true, AFTER_DRAIN = false, KHOOK = false;
    bf16* H; const float* X; const float* g1;
    DI void operator()(const pg8::f32x4 (&acc)[2][2][4][2], const pg8::Unit& u, int wr, int wc, int fr, int fq) const {
        const int row0 = u.pm * 256 + wr * 64 + fr, col0 = u.pn * 256 + wc * 32 + fq * 8;
        f32x4 xa[4], xb[4]; v4u wA[4], wB[4];
        auto loadq = [&](int bj, int ai) {
#pragma unroll
            for (int m = 0; m < 4; ++m) { const size_t off = (size_t)(row0 + ai * 128 + m * 16) * D + col0 + bj * 128;
                xa[m] = __builtin_nontemporal_load((const f32x4*)(X + off)); xb[m] = __builtin_nontemporal_load((const f32x4*)(X + off + 4)); }
        };
        auto calcq = [&](int bj, int ai, v4u (&w)[4]) { const int c = col0 + bj * 128;
            const f32x4 ga = *(const f32x4*)(g1 + c), gb = *(const f32x4*)(g1 + c + 4);
#pragma unroll
            for (int m = 0; m < 4; ++m) { const f32x4 ha = xa[m] + ga * acc[ai][bj][m][0], hb = xb[m] + gb * acc[ai][bj][m][1];
                w[m].x = pk2(ha.x, ha.y); w[m].y = pk2(ha.z, ha.w); w[m].z = pk2(hb.x, hb.y); w[m].w = pk2(hb.z, hb.w); }
        };
        auto storeq = [&](int bj, int ai, const v4u (&w)[4]) {
#pragma unroll
            for (int m = 0; m < 4; ++m) *(v4u*)(H + (size_t)(row0 + ai * 128 + m * 16) * D + col0 + bj * 128) = w[m];
        };
        loadq(0, 0); calcq(0, 0, wA); loadq(0, 1); storeq(0, 0, wA); calcq(0, 1, wB); loadq(1, 0); storeq(0, 1, wB); calcq(1, 0, wA); loadq(1, 1); storeq(1, 0, wA); calcq(1, 1, wB); storeq(1, 1, wB);
    }
};
struct EpiUp {
    static constexpr bool PERM = true, AFTER_DRAIN = false, KHOOK = false;
    unsigned char* HDN;
    DI void operator()(const pg8::f32x4 (&acc)[2][2][4][2], const pg8::Unit& u, int wr, int wc, int fr, int fq) const {
        const int j = u.pn & 3, row0 = u.pm * 256 + wr * 64 + fr, col0 = j * 128 + wc * 16 + fq * 4;
#pragma unroll
        for (int ai = 0; ai < 2; ++ai)
#pragma unroll
            for (int m = 0; m < 4; ++m) { unsigned char* rowp = HDN + (size_t)(row0 + ai * 128 + m * 16) * DFF + col0;
#pragma unroll
                for (int bj = 0; bj < 2; ++bj) { const pg8::f32x4 a = acc[ai][bj][m][0], b = acc[ai][bj][m][1];
                    *(unsigned*)(rowp + bj * 64) = pk4_fp8(siluf_(a[0]) * b[0], siluf_(a[1]) * b[1], siluf_(a[2]) * b[2], siluf_(a[3]) * b[3]); } }
    }
};
struct EpiDown {
    static constexpr bool PERM = true, AFTER_DRAIN = false, KHOOK = false;
    unsigned char* Y;
    DI void operator()(const pg8::f32x4 (&acc)[2][2][4][2], const pg8::Unit& u, int wr, int wc, int fr, int fq) const {
        const int j = u.pn & 3, row0 = u.pm * 256 + wr * 64 + fr, col0 = j * 256 + wc * 32 + fq * 8;
#pragma unroll
        for (int ai = 0; ai < 2; ++ai)
#pragma unroll
            for (int m = 0; m < 4; ++m) { unsigned char* rowp = Y + (size_t)(row0 + ai * 128 + m * 16) * D + col0;
#pragma unroll
                for (int bj = 0; bj < 2; ++bj) { const pg8::f32x4 v0 = acc[ai][bj][m][0] * 16.0f, v1 = acc[ai][bj][m][1] * 16.0f;
                    v2u w; w.x = pk4_fp8(v0[0], v0[1], v0[2], v0[3]); w.y = pk4_fp8(v1[0], v1[1], v1[2], v1[3]);
                    *(v2u*)(rowp + bj * 128) = w; } }
    }
};
struct MoeOrder {
    const LAS int* tb; int G, c, total, reps; const LAS int* tokl;
    DI bool next(int i0, pg8::Unit& u) const {
        const int n = (total - c + G - 1) / G; if (n <= 0 || i0 >= n * reps) return false;
        const int i = i0 % n; const int uu = i * G + c;
        const int T = uu >> 2; int e = 0;
        while (e < NE - 1 && tb[e + 1] <= T) ++e;
        u.pm = T; u.pn = 4 * e + (uu & 3); return true;
    }
    DI void a_ready(const pg8::Unit&) const {}
    DI void done(const pg8::Unit&) const {}
};

struct OneUnit { pg8::Unit u;
    DI bool next(int i, pg8::Unit& o) const { if (i != 0) return false; o = u; return true; }
    DI void a_ready(const pg8::Unit&) const {}
    DI void done(const pg8::Unit&) const {} };

template <class SrcF>
DI void transpose_item(SrcF src, int K, bf16* WT, LAS float* scr, int kb, int n0, int lane) {
    const int k0 = 64 * kb;
#pragma unroll 8
    for (int i = 0; i < 32; ++i) { const int kk = 2 * i + (lane >> 5); scr[kk * 33 + (lane & 31)] = src(k0 + kk, n0 + (lane & 31)); }
    LDS_WAIT(); asm volatile("" ::: "memory");
    const int c = lane & 7;
#pragma unroll
    for (int j = 0; j < 4; ++j) { const int n = (lane >> 3) + 8 * j; const LAS float* s = scr + (8 * c) * 33 + n;
        v4u o; o.x = pk2(s[0 * 33], s[1 * 33]); o.y = pk2(s[2 * 33], s[3 * 33]); o.z = pk2(s[4 * 33], s[5 * 33]); o.w = pk2(s[6 * 33], s[7 * 33]);
        *(v4u*)(WT + (size_t)(n0 + n) * K + k0 + 8 * c) = o; }
    LDS_WAIT(); asm volatile("" ::: "memory");
}

template <class SrcF>
DI void transpose_item8(SrcF src, int K, unsigned char* WT, LAS float* scr, int kb, int n0, int lane) {
    const int k0 = 64 * kb;
#pragma unroll 8
    for (int i = 0; i < 32; ++i) { const int kk = 2 * i + (lane >> 5); scr[kk * 33 + (lane & 31)] = src(k0 + kk, n0 + (lane & 31)) * 64.0f; }
    LDS_WAIT(); asm volatile("" ::: "memory");
#pragma unroll
    for (int i = 0; i < 2; ++i) { const int p = lane + 64 * i, n = p >> 2, c = p & 3; const LAS float* s = scr + (16 * c) * 33 + n;
        v4u o; o.x = pk4_fp8(s[0 * 33], s[1 * 33], s[2 * 33], s[3 * 33]); o.y = pk4_fp8(s[4 * 33], s[5 * 33], s[6 * 33], s[7 * 33]);
        o.z = pk4_fp8(s[8 * 33], s[9 * 33], s[10 * 33], s[11 * 33]); o.w = pk4_fp8(s[12 * 33], s[13 * 33], s[14 * 33], s[15 * 33]);
        *(v4u*)(WT + (size_t)(n0 + n) * K + k0 + 16 * c) = o; }
    LDS_WAIT(); asm volatile("" ::: "memory");
}

template <class SrcF>
DI void transpose_item_i8(SrcF src, float inv, int K, unsigned char* WT, LAS float* scr, int kb, int n0, int lane) {
    const int k0 = 64 * kb;
#pragma unroll 8
    for (int i = 0; i < 32; ++i) { const int kk = 2 * i + (lane >> 5); scr[kk * 33 + (lane & 31)] = src(k0 + kk, n0 + (lane & 31)) * inv; }
    LDS_WAIT(); asm volatile("" ::: "memory");
#pragma unroll
    for (int i = 0; i < 2; ++i) { const int p = lane + 64 * i, n = p >> 2, c = p & 3; const LAS float* s = scr + (16 * c) * 33 + n;
        v4u o; o.x = pk4_i8(s[0 * 33], s[1 * 33], s[2 * 33], s[3 * 33]); o.y = pk4_i8(s[4 * 33], s[5 * 33], s[6 * 33], s[7 * 33]);
        o.z = pk4_i8(s[8 * 33], s[9 * 33], s[10 * 33], s[11 * 33]); o.w = pk4_i8(s[12 * 33], s[13 * 33], s[14 * 33], s[15 * 33]);
        *(v4u*)(WT + (size_t)(n0 + n) * K + k0 + 16 * c) = o; }
    LDS_WAIT(); asm volatile("" ::: "memory");
}

DI void ph0_prologue(const Ctx& F, const Args& a, int reps) {
    const int gw = F.vcu * NWAVES + F.wave, NGW = F.G * NWAVES, lane = lane_id();
    float* mod = (float*)(F.ws + WS_CTL) + CW_MOD;
    {
        const float* cvec = ARG(I_C); const float* wada = ARG(I_WADA); const float* bada = ARG(I_BADA);
        const int r8 = lane >> 3, c4 = lane & 7;
        for (int item0 = gw; item0 < 768 * reps; item0 += NGW) {
            const int item = item0 % 768; const int cc = item % 192, kq = item / 192;
            f32x4 acc = {0.f, 0.f, 0.f, 0.f};
#pragma unroll 8
            for (int i = 0; i < 32; ++i) { const int k = kq * 256 + i * 8 + r8; const float cv = cvec[k]; const float s = siluf_(cv);
                const f32x4 w = *(const f32x4*)(wada + (size_t)k * (6 * D) + cc * 32 + c4 * 4); acc += s * w; }
#pragma unroll
            for (int j = 0; j < 4; ++j) { float v = acc[j]; v += __shfl_xor(v, 8); v += __shfl_xor(v, 16); v += __shfl_xor(v, 32); acc[j] = v; }
            if (lane < 8) {
#pragma unroll
                for (int j = 0; j < 4; ++j) { float v = acc[j]; if (kq == 0) v += bada[cc * 32 + c4 * 4 + j]; mod[kq * 6144 + cc * 32 + c4 * 4 + j] = v; }
            }
        }
    }
    LAS float* scr = (LAS float*)(F.lds + F.wave * 16384);
    const float* win = ARG(I_WIN); const float* wcv = ARG(I_WCV); const float* wmix = ARG(I_WMIX); const float* wssm = ARG(I_WSSM);
    bf16* Win_t = (bf16*)(F.ws + WS_WIN); bf16* Wdt_t = (bf16*)(F.ws + WS_WDT); bf16* Wcv_t = (bf16*)(F.ws + WS_WCV);
    bf16* Wmix_t = (bf16*)(F.ws + WS_WMIX); bf16* Wssm_t = (bf16*)(F.ws + WS_WSSM);
    constexpr int I_IN = 16 * 288, I_DT = 16, I_CV = 16 * 32, I_MX = 16 * 32, I_SS = 32 * 32, I_RT = 16 * 3 * 2;
    constexpr int NITEMS = I_IN + I_DT + I_CV + I_MX + I_SS + I_RT;
    const float* wer = ARG(I_WER); const float* wgrp = ARG(I_WGRP); const float* sng0 = ARG(I_SNG);
    for (int it0 = gw; it0 < NITEMS * reps; it0 += NGW) {
        int r = it0 % NITEMS;
        if (r < I_IN) { const int kb = r / 288, nb = r % 288;
            const int npp = nb * 32 + (lane & 31), col = win_col(npp);
            float mx = 0.f;
#pragma unroll 8
            for (int i = 0; i < 32; ++i) mx = __builtin_fmaxf(mx, __builtin_fabsf(win[(size_t)(64 * kb + 2 * i + (lane >> 5)) * WIN_LD + col]));
            mx = __builtin_fmaxf(mx, __shfl_xor(mx, 32));
            if (lane < 32) atomicMax((unsigned*)(F.ws + WS_CTL) + CW_WMAX + npp, __float_as_uint(mx));
            continue; } r -= I_IN;
        if (r < I_DT) { transpose_item([&](int k, int np) -> float { return win[(size_t)k * WIN_LD + 7168 + np]; }, D, Wdt_t, scr, r, 0, lane); continue; } r -= I_DT;
        if (r < I_CV) { transpose_item([&](int k, int np) -> float { return wcv[(size_t)k * D + np]; }, D, Wcv_t, scr, r / 32, (r % 32) * 32, lane); continue; } r -= I_CV;
        if (r < I_MX) { transpose_item([&](int k, int np) -> float { return wmix[(size_t)k * D + np]; }, D, Wmix_t, scr, r / 32, (r % 32) * 32, lane); continue; } r -= I_MX;
        if (r < I_SS) { transpose_item8([&](int k, int np) -> float { return wssm[(size_t)k * D + np] * sng0[k]; }, DIN, (unsigned char*)Wssm_t, scr, r / 32, (r % 32) * 32, lane); continue; } r -= I_SS;
        {
            const int lo = r / 48, rr = r % 48, kb = rr / 3, nb = rr % 3;
            auto wsrc = [&](int k, int np) -> float { float w = 0.f; if (np < 64) w = wer[(size_t)k * NE + np]; else if (np < 72) w = wgrp[(size_t)k * 8 + (np - 64)];
                const float hi = bflo(pk2(w, 0.f)); return lo ? (w - hi) : hi; };
            transpose_item(wsrc, D, (bf16*)(F.ws + (lo ? WS_WRL : WS_WRH)), scr, kb, nb * 32, lane);
        }
    }
}

DI void convert_experts(const Ctx& F, const Args& a) {
    const int gw = F.vcu * NWAVES + F.wave, NGW = F.G * NWAVES, lane = lane_id();
    LAS float* scr = (LAS float*)(F.lds + F.wave * 17408);
    const float* w1 = ARG(I_W1); const float* w3 = ARG(I_W3); const float* w2 = ARG(I_W2);
    unsigned char* W13_t = F.ws + WS_W13; unsigned char* W2_t = F.ws + WS_W2;
    constexpr int I_13 = NE * 4 * 16, I_2 = NE * 2 * 16, NIT = I_13 + I_2;
    const int ch = lane & 15, kq = lane >> 4;
    for (int it = gw; it < NIT; it += NGW) {
        const float* src; size_t ld; unsigned char* dst;
        if (it < I_13) { const int e = it >> 6, r = it & 63, kb = r >> 4, cb = r & 15;
            src = ((ch & 1) ? w3 : w1) + (size_t)e * D * DFF + (size_t)(256 * kb + kq) * DFF + 32 * cb + 4 * (ch >> 1); ld = DFF;
            dst = W13_t + (size_t)e * D * D + (size_t)(64 * cb + lane) * D + 256 * kb;
        } else { const int r0 = it - I_13, e = r0 >> 5, r = r0 & 31, kb = r >> 4, nb = r & 15;
            src = w2 + (size_t)e * DFF * D + (size_t)(256 * kb + kq) * D + 64 * nb + 4 * ch; ld = D;
            dst = W2_t + (size_t)e * D * DFF + (size_t)(64 * nb + lane) * DFF + 256 * kb;
        }
        f32x4 va[16], vb[16]; v4u o[16];
#pragma unroll
        for (int i = 0; i < 16; ++i) va[i] = __builtin_nontemporal_load((const f32x4*)(src + (size_t)(4 * i) * ld));
#pragma unroll
        for (int sub = 0; sub < 4; ++sub) {
            f32x4 (&cur)[16] = (sub & 1) ? vb : va; f32x4 (&nxt)[16] = (sub & 1) ? va : vb;
            if (sub < 3) {
#pragma unroll
                for (int i = 0; i < 16; ++i) nxt[i] = __builtin_nontemporal_load((const f32x4*)(src + (size_t)(64 * (sub + 1) + 4 * i) * ld));
            }
#pragma unroll
            for (int i = 0; i < 16; ++i) *(LAS f32x4*)(scr + (4 * i + kq) * 68 + 4 * ch) = cur[i] * 64.0f;
            LDS_WAIT(); asm volatile("" ::: "memory");
#pragma unroll
            for (int j = 0; j < 4; ++j) {
                unsigned w[4];
#pragma unroll
                for (int q = 0; q < 4; ++q) { const LAS float* sp = scr + (16 * j + 4 * q) * 68 + lane; w[q] = pk4_fp8(sp[0], sp[68], sp[136], sp[204]); }
                o[4 * sub + j].x = w[0]; o[4 * sub + j].y = w[1]; o[4 * sub + j].z = w[2]; o[4 * sub + j].w = w[3];
            }
            LDS_WAIT(); asm volatile("" ::: "memory");
        }
#pragma unroll
        for (int j = 0; j < 16; ++j) *(v4u*)(dst + 16 * j) = o[j];
    }
}

DI void ph1_norm_dt(const Ctx& F, const Args& a) {
    const float* mod = (const float*)(F.ws + WS_CTL) + CW_MOD;
    const float* x = ARG(I_X); const float* n1g = ARG(I_N1G); const float* dtb = ARG(I_DTB);
    bf16* XN = (bf16*)(F.ws + WS_XN); const bf16* Wdt_t = (const bf16*)(F.ws + WS_WDT); float* DT = (float*)(F.ws + WS_DT);
    const int lane = lane_id(), wave = F.wave;
    f32x4 gm[4], ga[4];
#pragma unroll
    for (int j = 0; j < 4; ++j) { const int k = 256 * j + 4 * lane; const f32x4 g = *(const f32x4*)(n1g + k), sc = mod4(mod, 1024 + k);
        gm[j] = g * (sc + 1.0f); ga[j] = mod4(mod, k); }
    if (F.vcu == 0) { float* modc = (float*)(F.ws + WS_CTL) + CW_MODC; for (int k = (F.wave * 64 + lane_id()) * 4; k < 6 * D; k += NTHREADS * 4) *(f32x4*)(modc + k) = mod4(mod, k); }
    for (int unit = F.vcu; unit < M / 64; unit += F.G) {
        const int row0 = unit * 64;
#pragma unroll 1
        for (int rh = 0; rh < 2; ++rh) {
            f32x4 v[4][4];
#pragma unroll
            for (int rr = 0; rr < 4; ++rr)
#pragma unroll
                for (int j = 0; j < 4; ++j) v[rr][j] = __builtin_nontemporal_load((const f32x4*)(x + (size_t)(row0 + wave * 8 + rh * 4 + rr) * D + 256 * j + 4 * lane));
#pragma unroll
            for (int rr = 0; rr < 4; ++rr) {
                const int rl = wave * 8 + rh * 4 + rr, row = row0 + rl; float ss = 0.f;
#pragma unroll
                for (int j = 0; j < 4; ++j) ss += (v[rr][j].x * v[rr][j].x + v[rr][j].y * v[rr][j].y) + (v[rr][j].z * v[rr][j].z + v[rr][j].w * v[rr][j].w);
                const float rstd = 1.0f / sqrtf(wave_sum(ss) * (1.0f / D) + EPS);
                float am = 0.f;
#pragma unroll
                for (int j = 0; j < 4; ++j) { const f32x4 n = v[rr][j] * rstd * gm[j] + ga[j]; v[rr][j] = n;
                    am = __builtin_fmaxf(__builtin_fmaxf(am, __builtin_fmaxf(__builtin_fabsf(n.x), __builtin_fabsf(n.y))), __builtin_fmaxf(__builtin_fabsf(n.z), __builtin_fabsf(n.w)));
                    v2u w; w.x = pk2(n.x, n.y); w.y = pk2(n.z, n.w);
                    const int chunk = (32 * j + (lane >> 1)) ^ (rl & 15);
                    *(LAS v2u*)(F.lds + rl * 2048 + chunk * 16 + 8 * (lane & 1)) = w; }
#pragma unroll
                for (int o = 1; o < 64; o <<= 1) am = __builtin_fmaxf(am, __shfl_xor(am, o));
                const float inv = am > 0.f ? 127.0f / am : 0.f;
#pragma unroll
                for (int j = 0; j < 4; ++j) *(unsigned*)(F.ws + WS_XN8 + (size_t)row * D + 256 * j + 4 * lane) = pk4_i8(v[rr][j].x * inv, v[rr][j].y * inv, v[rr][j].z * inv, v[rr][j].w * inv);
                if (lane == 0) ((float*)(F.ws + WS_SA))[row] = am * (1.0f / 127.0f);
            }
        }
        __syncthreads();
        {
            const int rt = wave & 3, ct = wave >> 2, fr = lane & 15, fq = lane >> 4;
            pg8::f32x4 acc = {0.f, 0.f, 0.f, 0.f};
            const bf16* wrow = Wdt_t + (size_t)(16 * ct + fr) * D + 8 * fq;
#pragma unroll 4
            for (int ks = 0; ks < 32; ++ks) {
                const bf16x8 av = *(const LAS bf16x8*)(F.lds + (16 * rt + fr) * 2048 + (((4 * ks + fq) ^ fr) * 16));
                const bf16x8 bv = *(const bf16x8*)(wrow + 32 * ks);
                acc = __builtin_amdgcn_mfma_f32_16x16x32_bf16(av, bv, acc, 0, 0, 0);
            }
            const float bias = dtb[16 * ct + fr];
#pragma unroll
            for (int r = 0; r < 4; ++r) { const float v = acc[r] + bias; const float sp = v > 20.f ? v : log1pf(__expf(v));
                DT[(size_t)(row0 + 16 * rt + 4 * fq + r) * NH + 16 * ct + fr] = sp; }
        }
        __syncthreads();
    }
    {
        const float* win = ARG(I_WIN); const unsigned* wmax = (const unsigned*)(F.ws + WS_CTL) + CW_WMAX;
        const int gw = F.vcu * NWAVES + F.wave, NGW = F.G * NWAVES;
        LAS float* scr = (LAS float*)(F.lds + F.wave * 16384);
        for (int r = gw; r < 16 * 288; r += NGW) { const int kb = r / 288, nb = r % 288;
            const int npp = nb * 32 + (lane & 31), col = win_col(npp);
            const float mx = __uint_as_float(wmax[npp]); const float inv = mx > 0.f ? 127.0f / mx : 0.f;
            if (kb == 0 && lane < 32) ((float*)(F.ws + WS_SW))[npp] = mx * (1.0f / 127.0f);
            transpose_item_i8([&](int k, int) -> float { return win[(size_t)k * WIN_LD + col]; }, inv, D, F.ws + WS_W8IN, scr, kb, nb * 32, lane);
        }
    }
}

DI void ph3_convbranch(const Ctx& F, const Args& a, int reps) {
    const bf16* U = (const bf16*)(F.ws + WS_U); bf16* UC = (bf16*)(F.ws + WS_XN);
    const float* cw = ARG(I_CVW); const float* cb = ARG(I_CVB); const float* lg = ARG(I_LNG); const float* lb = ARG(I_LNB);
    const int tid = F.wave * 64 + lane_id(), lane = lane_id(), wave = F.wave;
    LAS unsigned char* tile = F.lds;
    LAS float* red = (LAS float*)(F.lds + 62 * 2048);
    LAS float* stat = red + 32 * 8 * 2;
    f2v w[31];
#pragma unroll
    for (int j = 0; j < 31; ++j) w[j] = *(const f2v*)(cw + j * D + 2 * tid);
    const f2v bias = *(const f2v*)(cb + 2 * tid), gam = *(const f2v*)(lg + 2 * tid), bet = *(const f2v*)(lb + 2 * tid);
    const int RU = (M / 32 + F.G - 1) / F.G;
    for (int it = 0; it < RU * reps; ++it) {
        const int unit = xcd_unit(F.xcd, F.xj, F.G >> 3, (it >= RU ? it - RU : it), M / 32); if (unit < 0) break; const int t0 = unit * 32;
        {
            v4u v[16];
#pragma unroll
            for (int i = 0; i < 16; ++i) { const int piece = tid + i * NTHREADS, r = piece >> 7, cch = piece & 127, t = t0 - 30 + r;
                v[i] = (v4u){0u, 0u, 0u, 0u}; if (piece < 62 * 128 && t >= 0) v[i] = *(const v4u*)(U + (size_t)t * D + cch * 8); }
#pragma unroll
            for (int i = 0; i < 16; ++i) { const int piece = tid + i * NTHREADS, r = piece >> 7, cch = piece & 127;
                if (piece < 62 * 128) *(LAS v4u*)(tile + r * 2048 + cch * 16) = v[i]; }
        }
        __syncthreads();
        f2v o[32];
#pragma unroll
        for (int tg = 0; tg < 8; ++tg) {
            f2v acc[4];
#pragma unroll
            for (int i = 0; i < 4; ++i) acc[i] = bias;
#pragma unroll
            for (int j = 0; j < 34; ++j) {
                const unsigned uu = *(const LAS unsigned*)(tile + (4 * tg + j) * 2048 + tid * 4);
                const f2v u2 = {bflo(uu), bfhi(uu)};
#pragma unroll
                for (int i = 0; i < 4; ++i) { const int jj = j - i; if (jj >= 0 && jj <= 30) acc[i] = __builtin_elementwise_fma(w[jj], u2, acc[i]); }
            }
#pragma unroll
            for (int i = 0; i < 4; ++i) o[4 * tg + i] = acc[i];
        }
        {
            float r5[64];
#pragma unroll
            for (int tk = 0; tk < 32; ++tk) { r5[2 * tk] = o[tk].x + o[tk].y; r5[2 * tk + 1] = o[tk].x * o[tk].x + o[tk].y * o[tk].y; }
            float r4[32], r3[16], r2[8], r1[4], r0[2];
            { const bool up = (lane & 32) != 0;
#pragma unroll
              for (int i = 0; i < 32; ++i) { const float keep = up ? r5[i + 32] : r5[i], send = up ? r5[i] : r5[i + 32]; r4[i] = keep + __shfl_xor(send, 32); } }
            { const bool up = (lane & 16) != 0;
#pragma unroll
              for (int i = 0; i < 16; ++i) { const float keep = up ? r4[i + 16] : r4[i], send = up ? r4[i] : r4[i + 16]; r3[i] = keep + __shfl_xor(send, 16); } }
            { const bool up = (lane & 8) != 0;
#pragma unroll
              for (int i = 0; i < 8; ++i) { const float keep = up ? r3[i + 8] : r3[i], send = up ? r3[i] : r3[i + 8]; r2[i] = keep + __shfl_xor(send, 8); } }
            { const bool up = (lane & 4) != 0;
#pragma unroll
              for (int i = 0; i < 4; ++i) { const float keep = up ? r2[i + 4] : r2[i], send = up ? r2[i] : r2[i + 4]; r1[i] = keep + __shfl_xor(send, 4); } }
            { const bool up = (lane & 2) != 0;
#pragma unroll
              for (int i = 0; i < 2; ++i) { const float keep = up ? r1[i + 2] : r1[i], send = up ? r1[i] : r1[i + 2]; r0[i] = keep + __shfl_xor(send, 2); } }
            const bool up0 = (lane & 1) != 0;
            const float tot = (up0 ? r0[1] : r0[0]) + __shfl_xor(up0 ? r0[0] : r0[1], 1);
            red[((lane >> 1) * 8 + wave) * 2 + (lane & 1)] = tot;
        }
        __syncthreads();
        if (tid < 32) { float s = 0.f, q = 0.f;
#pragma unroll
            for (int wv = 0; wv < 8; ++wv) { s += red[(tid * 8 + wv) * 2]; q += red[(tid * 8 + wv) * 2 + 1]; }
            const float mean = s * (1.0f / D); const float var = fmaxf(q * (1.0f / D) - mean * mean, 0.f);
            stat[tid * 2] = mean; stat[tid * 2 + 1] = 1.0f / sqrtf(var + EPS); }
        __syncthreads();
#pragma unroll
        for (int tk = 0; tk < 32; ++tk) { const float mean = stat[tk * 2], rstd = stat[tk * 2 + 1];
            const float y0 = (o[tk].x - mean) * rstd * gam.x + bet.x, y1 = (o[tk].y - mean) * rstd * gam.y + bet.y;
            *(unsigned*)(UC + (size_t)(t0 + tk) * D + 2 * tid) = pk2(siluf_(y0), siluf_(y1)); }
        __syncthreads();
    }
}

DI void conv_block(const bf16* XBC, const float* cw, const float* cb, int t_first, int col, float (&o)[8][8]) {
    v4u raw[11];
#pragma unroll
    for (int r = 0; r < 11; ++r) { const int t = t_first - 3 + r; const int tc = t < 0 ? 0 : t; v4u v = *(const v4u*)(XBC + (size_t)tc * XBCW + col);
        const unsigned msk = t < 0 ? 0u : 0xffffffffu; v.x &= msk; v.y &= msk; v.z &= msk; v.w &= msk; raw[r] = v; }
    float w[4][8], b[8];
#pragma unroll
    for (int j = 0; j < 4; ++j) { const f32x4 lo = *(const f32x4*)(cw + j * XBCW + col), hi = *(const f32x4*)(cw + j * XBCW + col + 4);
        w[j][0] = lo.x; w[j][1] = lo.y; w[j][2] = lo.z; w[j][3] = lo.w; w[j][4] = hi.x; w[j][5] = hi.y; w[j][6] = hi.z; w[j][7] = hi.w; }
    { const f32x4 lo = *(const f32x4*)(cb + col), hi = *(const f32x4*)(cb + col + 4); b[0] = lo.x; b[1] = lo.y; b[2] = lo.z; b[3] = lo.w; b[4] = hi.x; b[5] = hi.y; b[6] = hi.z; b[7] = hi.w; }
#pragma unroll
    for (int tk = 0; tk < 8; ++tk)
#pragma unroll
        for (int ch = 0; ch < 8; ++ch) {
            float acc = b[ch];
#pragma unroll
            for (int j = 0; j < 4; ++j) { const unsigned wd = raw[tk + j][ch >> 1]; const float xv = (ch & 1) ? bfhi(wd) : bflo(wd); acc += w[j][ch] * xv; }
            o[tk][ch] = siluf_(acc);
        }
}
DI float head_scan(const float* DT, const float* alog, int t0, int h, int lane, LAS float* acs_h, LAS float* dtv_h, float& d0o, float& d1o, float& c0o, float& c1o) {
    const float d0 = DT[(size_t)(t0 + 2 * lane) * NH + h], d1 = DT[(size_t)(t0 + 2 * lane + 1) * NH + h];
    const float A2 = -__expf(alog[h]) * LOG2E;
    const float a0 = d0 * A2, a1 = d1 * A2; float inc = a0 + a1;
#pragma unroll
    for (int o = 1; o < 64; o <<= 1) { const float t = __shfl_up(inc, o); if (lane >= o) inc += t; }
    acs_h[2 * lane] = inc - a1; acs_h[2 * lane + 1] = inc; dtv_h[2 * lane] = d0; dtv_h[2 * lane + 1] = d1;
    d0o = d0; d1o = d1; c0o = inc - a1; c1o = inc;
    return __shfl(inc, 63);
}

constexpr int S_CN = 0, S_BN = 32768, S_XT = 65536, S_ACS = 131072, S_DTV = 135168, S_SSQ = 139264, S_FS = 139776;

DI void ph3_chunk_states(const Ctx& F, const Args& a, int reps) {
    const bf16* XBC = (const bf16*)(F.ws + WS_XBC); const float* DT = (const float*)(F.ws + WS_DT);
    bf16* ST = (bf16*)(F.ws + WS_ST); float* CD = (float*)(F.ws + WS_CD);
    const float* scw = ARG(I_SCW); const float* scb = ARG(I_SCB); const float* alog = ARG(I_ALOG);
    const int tid = F.wave * 64 + lane_id(), lane = lane_id(), wave = F.wave, hh = lane >> 5;
    LAS unsigned char* lds = F.lds;
    LAS float* acs = (LAS float*)(lds + S_ACS); LAS float* wsc = (LAS float*)(lds + S_DTV);
    const int RU = (NCH * NGRP + F.G - 1) / F.G;
    for (int it = 0; it < RU * reps; ++it) {
        const int unit = xcd_unit(F.xcd, F.xj, F.G >> 3, (it >= RU ? it - RU : it), NCH * NGRP); if (unit < 0) break; const int c = unit >> 2, g = unit & 3, t0 = c * LCH;
        {
            const int h = 8 * g + wave; float d0, d1, c0, c1;
            const float total = head_scan(DT, alog, t0, h, lane, acs + wave * 128, wsc + wave * 128, d0, d1, c0, c1);
            wsc[wave * 128 + 2 * lane] = d0 * __builtin_amdgcn_exp2f(total - c0); wsc[wave * 128 + 2 * lane + 1] = d1 * __builtin_amdgcn_exp2f(total - c1);
            if (lane == 0) CD[c * NH + h] = __builtin_amdgcn_exp2f(total);
        }
        __syncthreads();
        if (tid < 256) { const int co = tid & 15, to = tid >> 4; float o[8][8];
            conv_block(XBC, scw, scb, t0 + 8 * to, 2048 + 128 * g + 8 * co, o);
#pragma unroll
            for (int ch = 0; ch < 8; ++ch) { const int row = 8 * co + ch;
                v4u w; w.x = pk2(o[0][ch], o[1][ch]); w.y = pk2(o[2][ch], o[3][ch]); w.z = pk2(o[4][ch], o[5][ch]); w.w = pk2(o[6][ch], o[7][ch]);
                *(LAS v4u*)(lds + S_BN + row * 256 + swz(row, to) * 16) = w; } }
        for (int ps = 0; ps < 2; ++ps) {
            {
                const int co = tid & 31, to = tid >> 5, hd = co >> 3, p0 = (co & 7) * 8; float o[8][8];
                conv_block(XBC, scw, scb, t0 + 8 * to, 512 * g + 64 * (4 * ps + hd) + p0, o);
                float sc[8];
#pragma unroll
                for (int tk = 0; tk < 8; ++tk) sc[tk] = wsc[(4 * ps + hd) * 128 + 8 * to + tk];
#pragma unroll
                for (int ch = 0; ch < 8; ++ch) { const int row = hd * 64 + p0 + ch;
                    v4u w; w.x = pk2(o[0][ch] * sc[0], o[1][ch] * sc[1]); w.y = pk2(o[2][ch] * sc[2], o[3][ch] * sc[3]);
                    w.z = pk2(o[4][ch] * sc[4], o[5][ch] * sc[5]); w.w = pk2(o[6][ch] * sc[6], o[7][ch] * sc[7]);
                    *(LAS v4u*)(lds + S_XT + row * 256 + swz(row, to) * 16) = w; }
            }
            __syncthreads();
            {
                const int hd = wave & 3, ph = wave >> 2, h = 8 * g + 4 * ps + hd;
                f32x16 acc[4];
#pragma unroll
                for (int nt = 0; nt < 4; ++nt)
#pragma unroll
                    for (int i = 0; i < 16; ++i) acc[nt][i] = 0.f;
                const int arow = hd * 64 + 32 * ph + (lane & 31);
#pragma unroll
                for (int ks = 0; ks < 8; ++ks) {
                    const bf16x8 av = *(const LAS bf16x8*)(lds + S_XT + arow * 256 + swz(arow, 2 * ks + hh) * 16);
#pragma unroll
                    for (int nt = 0; nt < 4; ++nt) { const int brow = 32 * nt + (lane & 31);
                        const bf16x8 bv = *(const LAS bf16x8*)(lds + S_BN + brow * 256 + swz(brow, 2 * ks + hh) * 16);
                        acc[nt] = MFMA32(av, bv, acc[nt]); }
                }
                unsigned char* dst = (unsigned char*)ST + ((size_t)(c * NH + h) * HD) * NST;
#pragma unroll
                for (int nt = 0; nt < 4; ++nt)
#pragma unroll
                    for (int i = 0; i < 16; i += 2) { const int p = 32 * ph + crow(i, hh); const unsigned pk = pk2_fp8(acc[nt][i], acc[nt][i + 1]);
                        dst[(size_t)p * NST + 32 * nt + (lane & 31)] = (unsigned char)(pk & 0xffu); dst[(size_t)(p + 1) * NST + 32 * nt + (lane & 31)] = (unsigned char)(pk >> 8); }
            }
            __syncthreads();
        }
    }
}

DI void ph4_scan(const Ctx& F, size_t dst_off) {
    unsigned short* ST16 = (unsigned short*)(F.ws + WS_ST); unsigned short* DST16 = (unsigned short*)(F.ws + dst_off); const float* CD = (const float*)(F.ws + WS_CD);
    constexpr int NPAIR = NH * HD * NST / 2;
    for (int e = F.vcu * NTHREADS + (F.wave * 64 + lane_id()); e < NPAIR; e += F.G * NTHREADS) {
        const int h = e >> 12; float c0 = 0.f, c1 = 0.f;
#pragma unroll 1
        for (int cb = 0; cb < NCH; cb += 32) {
            unsigned v[32]; float dec[32];
#pragma unroll
            for (int i = 0; i < 32; ++i) { v[i] = __builtin_nontemporal_load(ST16 + (size_t)(cb + i) * NPAIR + e); dec[i] = CD[(cb + i) * NH + h]; }
#pragma unroll
            for (int i = 0; i < 32; ++i) { DST16[(size_t)(cb + i) * NPAIR + e] = (unsigned short)pk2_fp8(c0, c1);
                c0 = c0 * dec[i] + __builtin_amdgcn_cvt_f32_fp8(v[i], 0); c1 = c1 * dec[i] + __builtin_amdgcn_cvt_f32_fp8(v[i], 1); }
        }
    }
}

DI void ph5_ssd_out(const Ctx& F, const Args& a, int reps) {
    const bf16* XBC = (const bf16*)(F.ws + WS_XBC); const float* DT = (const float*)(F.ws + WS_DT);
    const bf16* ST = (const bf16*)(F.ws + WS_ST); const bf16* ZS = (const bf16*)(F.ws + WS_ZS); bf16* YS = (bf16*)(F.ws + WS_YS);
    const float* scw = ARG(I_SCW); const float* scb = ARG(I_SCB); const float* alog = ARG(I_ALOG); const float* dskip = ARG(I_DSKIP);
    const int tid = F.wave * 64 + lane_id(), lane = lane_id(), wave = F.wave, hh = lane >> 5, l31 = lane & 31;
    LAS unsigned char* lds = F.lds;
    LAS float* acs = (LAS float*)(lds + S_ACS); LAS float* dtv = (LAS float*)(lds + S_DTV); LAS float* ssq = (LAS float*)(lds + S_SSQ);
    const int RU = (NCH * NGRP + F.G - 1) / F.G;
    for (int it = 0; it < RU * reps; ++it) {
        const int unit = xcd_unit(F.xcd, F.xj, F.G >> 3, (it >= RU ? it - RU : it), NCH * NGRP); if (unit < 0) break; const int c = unit >> 2, g = unit & 3, t0 = c * LCH;
        { const int h = 8 * g + wave; float d0, d1, c0, c1; (void)head_scan(DT, alog, t0, h, lane, acs + wave * 128, dtv + wave * 128, d0, d1, c0, c1);
          const float cend = __shfl(c1, (lane & 48) | 15);
          LAS float* fsw = (LAS float*)(lds + S_FS) + wave * 128;
          fsw[2 * lane] = d0 * __builtin_amdgcn_exp2f(cend - c0); fsw[2 * lane + 1] = d1 * __builtin_amdgcn_exp2f(cend - c1); }
        if (tid < 128) ssq[tid] = 0.f;
        { const int which = tid >> 8, t8 = tid & 255, co = t8 & 15; int to = t8 >> 4; asm volatile("" : "+v"(to)); float o[8][8];
            conv_block(XBC, scw, scb, t0 + 8 * to, (which ? 2560 : 2048) + 128 * g + 8 * co, o);
            const int base = which ? S_CN : S_BN;
#pragma unroll
            for (int tk = 0; tk < 8; ++tk) { const int row = 8 * to + tk;
                v4u w; w.x = pk2(o[tk][0], o[tk][1]); w.y = pk2(o[tk][2], o[tk][3]); w.z = pk2(o[tk][4], o[tk][5]); w.w = pk2(o[tk][6], o[tk][7]);
                *(LAS v4u*)(lds + base + row * 256 + swz(row, co) * 16) = w; } }
#pragma unroll 1
        for (int ps = 0; ps < 2; ++ps) {
            {
                const int co = tid & 31; int to = tid >> 5; asm volatile("" : "+v"(to));
                const int hd = co >> 3, p0 = (co & 7) * 8; float o[8][8];
                conv_block(XBC, scw, scb, t0 + 8 * to, 512 * g + 64 * (4 * ps + hd) + p0, o);
#pragma unroll
                for (int ch = 0; ch < 8; ++ch) { const int row = hd * 64 + p0 + ch;
                    v4u w; w.x = pk2(o[0][ch], o[1][ch]); w.y = pk2(o[2][ch], o[3][ch]); w.z = pk2(o[4][ch], o[5][ch]); w.w = pk2(o[6][ch], o[7][ch]);
                    *(LAS v4u*)(lds + S_XT + row * 256 + swz(row, to) * 16) = w; }
            }
            __syncthreads();
            const int hd = wave & 3, lp = wave >> 2, hl = 4 * ps + hd, h = 8 * g + hl;
            const float Dh = dskip[h];
            const LAS float* acs_h = acs + hl * 128; const LAS float* dt_h = dtv + hl * 128; const LAS float* fs_h = (const LAS float*)(lds + S_FS) + hl * 128;
            const unsigned char* prev = (const unsigned char*)ST + ((size_t)(c * NH + h) * HD) * NST;
            const int erow = lane >> 1, ehalf = lane & 1;
            f32x16 acc[2][2];
            {
#pragma unroll
                for (int which = 0; which < 2; ++which)
#pragma unroll
                    for (int pt = 0; pt < 2; ++pt)
#pragma unroll
                        for (int i = 0; i < 16; ++i) acc[which][pt][i] = 0.f;
                const int rowA = 32 * lp + l31, rowB = 32 * (3 - lp) + l31;
#pragma unroll
                for (int ks = 0; ks < 8; ++ks) {
                    const bf16x8 b0 = fp8x8_to_bf16(*(const v2u*)(prev + (size_t)l31 * NST + 16 * ks + 8 * hh)), b1 = fp8x8_to_bf16(*(const v2u*)(prev + (size_t)(32 + l31) * NST + 16 * ks + 8 * hh));
                    const bf16x8 a0 = *(const LAS bf16x8*)(lds + S_CN + rowA * 256 + swz(rowA, 2 * ks + hh) * 16);
                    const bf16x8 a1 = *(const LAS bf16x8*)(lds + S_CN + rowB * 256 + swz(rowB, 2 * ks + hh) * 16);
                    acc[0][0] = MFMA32(a0, b0, acc[0][0]); acc[0][1] = MFMA32(a0, b1, acc[0][1]);
                    acc[1][0] = MFMA32(a1, b0, acc[1][0]); acc[1][1] = MFMA32(a1, b1, acc[1][1]);
                }
#pragma unroll
                for (int which = 0; which < 2; ++which) { const int li = which == 0 ? lp : 3 - lp;
#pragma unroll
                    for (int i = 0; i < 16; ++i) { const float e = __builtin_amdgcn_exp2f(acs_h[32 * li + crow(i, hh)]); acc[which][0][i] *= e; acc[which][1][i] *= e; } }
            }
            {
                const int liA = lp, liB = 3 - lp;
                const int rowA = 32 * liA + l31, rowB = 32 * liB + l31;
                const float alA = acs_h[rowA], alB = acs_h[rowB];
#pragma unroll 1
                for (int sj = 0; sj <= liB; ++sj) {
                    const bool doA = sj <= liA;
                    f32x16 GA, GB;
#pragma unroll
                    for (int i = 0; i < 16; ++i) { GA[i] = 0.f; GB[i] = 0.f; }
                    const int brow = 32 * sj + l31;
                    if (doA) {
#pragma unroll 2
                        for (int ks = 0; ks < 8; ++ks) {
                            const bf16x8 av = *(const LAS bf16x8*)(lds + S_BN + brow * 256 + swz(brow, 2 * ks + hh) * 16);
                            const bf16x8 ca = *(const LAS bf16x8*)(lds + S_CN + rowA * 256 + swz(rowA, 2 * ks + hh) * 16);
                            const bf16x8 cb = *(const LAS bf16x8*)(lds + S_CN + rowB * 256 + swz(rowB, 2 * ks + hh) * 16);
                            GA = MFMA32(av, ca, GA); GB = MFMA32(av, cb, GB);
                        }
                    } else {
#pragma unroll 2
                        for (int ks = 0; ks < 8; ++ks) {
                            const bf16x8 av = *(const LAS bf16x8*)(lds + S_BN + brow * 256 + swz(brow, 2 * ks + hh) * 16);
                            const bf16x8 cb = *(const LAS bf16x8*)(lds + S_CN + rowB * 256 + swz(rowB, 2 * ks + hh) * 16);
                            GB = MFMA32(av, cb, GB);
                        }
                    }
                    auto mask = [&](f32x16& G, int li, int row_l, float al) {
                        if (sj < li) {
                            const float fl = __builtin_amdgcn_exp2f(al - acs_h[32 * sj + 31]);
#pragma unroll
                            for (int i = 0; i < 16; ++i) G[i] = G[i] * (fs_h[32 * sj + crow(i, hh)] * fl);
                        } else {
#pragma unroll
                            for (int i = 0; i < 16; ++i) { const int s = 32 * sj + crow(i, hh);
                                float v = G[i] * __builtin_amdgcn_exp2f(fminf(al - acs_h[s], 0.f)) * dt_h[s];
                                v = (s > row_l) ? 0.f : v; v = (s == row_l) ? v + Dh : v; G[i] = v; }
                        }
                    };
                    auto pv = [&](const f32x16& G, f32x16 (&ac)[2]) {
#pragma unroll
                        for (int s2 = 0; s2 < 2; ++s2) {
                            v4u fa; fa.x = pk2(G[8 * s2 + 0], G[8 * s2 + 1]); fa.y = pk2(G[8 * s2 + 2], G[8 * s2 + 3]); fa.z = pk2(G[8 * s2 + 4], G[8 * s2 + 5]); fa.w = pk2(G[8 * s2 + 6], G[8 * s2 + 7]);
#pragma unroll
                            for (int pt = 0; pt < 2; ++pt) { const int xrow = hd * 64 + 32 * pt + l31; const int sc0 = 32 * sj + 16 * s2;
                                const v2u lo = *(const LAS v2u*)(lds + S_XT + xrow * 256 + swz(xrow, (sc0 >> 3)) * 16 + 8 * hh);
                                const v2u hi = *(const LAS v2u*)(lds + S_XT + xrow * 256 + swz(xrow, (sc0 >> 3) + 1) * 16 + 8 * hh);
                                v4u bfr; bfr.x = lo.x; bfr.y = lo.y; bfr.z = hi.x; bfr.w = hi.y;
                                ac[pt] = MFMA32(__builtin_bit_cast(bf16x8, fa), __builtin_bit_cast(bf16x8, bfr), ac[pt]); }
                        }
                    };
                    if (doA) { mask(GA, liA, rowA, alA); pv(GA, acc[0]); }
                    mask(GB, liB, rowB, alB); pv(GB, acc[1]);
                }
            }
            asm volatile("" ::: "memory");
            v4u zs[2][4];
#pragma unroll
            for (int which = 0; which < 2; ++which) { const int li = which == 0 ? lp : 3 - lp; const size_t t = (size_t)(t0 + 32 * li + erow);
#pragma unroll
                for (int j = 0; j < 4; ++j) zs[which][j] = *(const v4u*)(ZS + t * DIN + 64 * h + 32 * ehalf + 8 * j); }
            __syncthreads();
            {
                LAS unsigned char* stg = lds + S_XT + wave * 8192;
#pragma unroll
                for (int which = 0; which < 2; ++which)
#pragma unroll
                    for (int pt = 0; pt < 2; ++pt)
#pragma unroll
                        for (int i = 0; i < 16; ++i) *(LAS bf16*)(stg + ((which * 32 + crow(i, hh)) * 64 + 32 * pt + l31) * 2) = (bf16)(pk2(acc[which][pt][i], 0.f) & 0xffffu);
                LDS_WAIT(); asm volatile("" ::: "memory");
#pragma unroll
                for (int which = 0; which < 2; ++which) { const int li = which == 0 ? lp : 3 - lp; const int l = 32 * li + erow; const size_t t = (size_t)(t0 + l);
                    float q = 0.f; unsigned w8[8];
#pragma unroll
                    for (int j = 0; j < 4; ++j) { const v4u yv = *(const LAS v4u*)(stg + ((which * 32 + erow) * 64 + 32 * ehalf + 8 * j) * 2); const v4u zv = zs[which][j];
                        float y[8] = {bflo(yv.x) * bflo(zv.x), bfhi(yv.x) * bfhi(zv.x), bflo(yv.y) * bflo(zv.y), bfhi(yv.y) * bfhi(zv.y), bflo(yv.z) * bflo(zv.z), bfhi(yv.z) * bfhi(zv.z), bflo(yv.w) * bflo(zv.w), bfhi(yv.w) * bfhi(zv.w)};
#pragma unroll
                        for (int k = 0; k < 8; ++k) q += y[k] * y[k];
                        w8[2 * j] = pk4_fp8(y[0], y[1], y[2], y[3]); w8[2 * j + 1] = pk4_fp8(y[4], y[5], y[6], y[7]); }
                    { unsigned char* yp = (unsigned char*)YS + t * DIN + 64 * h + 32 * ehalf;
                      *(v4u*)yp = (v4u){w8[0], w8[1], w8[2], w8[3]}; *(v4u*)(yp + 16) = (v4u){w8[4], w8[5], w8[6], w8[7]}; }
                    q += __shfl_xor(q, 1);
                    if (ehalf == 0) __hip_atomic_fetch_add(ssq + l, q, __ATOMIC_RELAXED, __HIP_MEMORY_SCOPE_WORKGROUP);
                }
            }
            __syncthreads();
        }
        if (tid < 128) ((float*)(F.ws + WS_RSTD))[(size_t)(t0 + tid) * 4 + g] = 1.0f / sqrtf(ssq[tid] * (1.0f / 512.f) + EPS);
        __syncthreads();
    }
}

constexpr int RT_LD = 1028;
DI void ph8_router(const Ctx& F, const Args& a, int reps) {
    const float* mod = (const float*)(F.ws + WS_CTL) + CW_MODC;
    const bf16* H = (const bf16*)(F.ws + WS_H16); const float* n2g = ARG(I_N2G); const float* bgrp = ARG(I_BGRP); const float* ber = ARG(I_BER);
    unsigned char* XN2 = F.ws + WS_XN; int* cnt0 = (int*)(F.ws + WS_CTL) + CW_CNT;
    int* RE = (int*)(F.ws + WS_ROUTE); int* RP = RE + 2 * M; float* RW = (float*)(RP + 2 * M); int* LIST = (int*)(F.ws + WS_LIST);
    const int lane = lane_id(), wave = F.wave;
    LAS float* tile = (LAS float*)F.lds;
    LAS float* pe = (LAS float*)F.lds;
    f32x4 gm[4], ga[4];
#pragma unroll
    for (int j = 0; j < 4; ++j) { const int k = 256 * j + 4 * lane; const f32x4 g = *(const f32x4*)(n2g + k), sc = *(const f32x4*)(mod + 4096 + k);
        gm[j] = g * (sc + 1.0f); ga[j] = *(const f32x4*)(mod + 3072 + k); }
    const int RU = (M / 32 + F.G - 1) / F.G;
    for (int it = 0; it < RU * reps; ++it) {
        const int unit = xcd_unit(F.xcd, F.xj, F.G >> 3, (it >= RU ? it - RU : it), M / 32); if (unit < 0) break; int* cnt = cnt0 + ((it >= RU * (reps - 1)) ? 0 : 4096);
        const int row0 = unit * 32;
        {
            f32x4 v[4][4];
#pragma unroll
            for (int rr = 0; rr < 4; ++rr)
#pragma unroll
                for (int j = 0; j < 4; ++j) { const v2u hw = *(const v2u*)(H + (size_t)(row0 + wave * 4 + rr) * D + 256 * j + 4 * lane); v[rr][j] = (f32x4){bflo(hw.x), bfhi(hw.x), bflo(hw.y), bfhi(hw.y)}; }
#pragma unroll
            for (int rr = 0; rr < 4; ++rr) { const int rl = wave * 4 + rr, row = row0 + rl; float ss = 0.f;
#pragma unroll
                for (int j = 0; j < 4; ++j) ss += (v[rr][j].x * v[rr][j].x + v[rr][j].y * v[rr][j].y) + (v[rr][j].z * v[rr][j].z + v[rr][j].w * v[rr][j].w);
                const float rstd = 1.0f / sqrtf(wave_sum(ss) * (1.0f / D) + EPS);
#pragma unroll
                for (int j = 0; j < 4; ++j) { const f32x4 n = v[rr][j] * rstd * gm[j] + ga[j];
                    *(LAS f32x4*)(tile + rl * RT_LD + 256 * j + 4 * lane) = n;
                    *(unsigned*)(XN2 + (size_t)row * D + 256 * j + 4 * lane) = pk4_fp8(n.x, n.y, n.z, n.w); }
            }
        }
        __syncthreads();
        pg8::f32x4 acc[2][5];
#pragma unroll
        for (int rt = 0; rt < 2; ++rt)
#pragma unroll
            for (int ct = 0; ct < 5; ++ct) acc[rt][ct] = (pg8::f32x4){0.f, 0.f, 0.f, 0.f};
        const int kb = wave * 128, fr = lane & 15, kq = lane >> 4;
        const bf16* WRH = (const bf16*)(F.ws + WS_WRH); const bf16* WRL = (const bf16*)(F.ws + WS_WRL);
#pragma unroll 2
        for (int ks = 0; ks < 4; ++ks) {
            const int k0 = kb + 32 * ks + 8 * kq;
            bf16x8 bh[5], bl[5];
#pragma unroll
            for (int ct = 0; ct < 5; ++ct) { bh[ct] = *(const bf16x8*)(WRH + (size_t)(16 * ct + fr) * D + k0); bl[ct] = *(const bf16x8*)(WRL + (size_t)(16 * ct + fr) * D + k0); }
#pragma unroll
            for (int rt = 0; rt < 2; ++rt) {
                const f32x4 x0 = *(const LAS f32x4*)(tile + (16 * rt + fr) * RT_LD + k0), x1 = *(const LAS f32x4*)(tile + (16 * rt + fr) * RT_LD + k0 + 4);
                v4u hv, lv;
                hv.x = pk2(x0.x, x0.y); hv.y = pk2(x0.z, x0.w); hv.z = pk2(x1.x, x1.y); hv.w = pk2(x1.z, x1.w);
                lv.x = pk2(x0.x - bflo(hv.x), x0.y - bfhi(hv.x)); lv.y = pk2(x0.z - bflo(hv.y), x0.w - bfhi(hv.y));
                lv.z = pk2(x1.x - bflo(hv.z), x1.y - bfhi(hv.z)); lv.w = pk2(x1.z - bflo(hv.w), x1.w - bfhi(hv.w));
                const bf16x8 ah = __builtin_bit_cast(bf16x8, hv), al = __builtin_bit_cast(bf16x8, lv);
#pragma unroll
                for (int ct = 0; ct < 5; ++ct) {
                    acc[rt][ct] = __builtin_amdgcn_mfma_f32_16x16x32_bf16(ah, bh[ct], acc[rt][ct], 0, 0, 0);
                    acc[rt][ct] = __builtin_amdgcn_mfma_f32_16x16x32_bf16(ah, bl[ct], acc[rt][ct], 0, 0, 0);
                    acc[rt][ct] = __builtin_amdgcn_mfma_f32_16x16x32_bf16(al, bh[ct], acc[rt][ct], 0, 0, 0); }
            }
        }
        __syncthreads();
#pragma unroll
        for (int rt = 0; rt < 2; ++rt)
#pragma unroll
            for (int ct = 0; ct < 5; ++ct)
#pragma unroll
                for (int r = 0; r < 4; ++r) pe[(wave * 32 + 16 * rt + 4 * kq + r) * 80 + 16 * ct + fr] = acc[rt][ct][r];
        __syncthreads();
        int e0s[4], e1s[4]; float w0s[4], w1s[4];
#pragma unroll
        for (int rr = 0; rr < 4; ++rr) { const int rl = wave * 4 + rr;
            float le = ber[lane], lgv = (lane < 8) ? bgrp[lane] : 0.f;
#pragma unroll
            for (int wv = 0; wv < 8; ++wv) { le += pe[(wv * 32 + rl) * 80 + lane]; if (lane < 8) lgv += pe[(wv * 32 + rl) * 80 + 64 + lane]; }
            float gl[8];
#pragma unroll
            for (int i = 0; i < 8; ++i) gl[i] = __shfl(lgv, i);
            int gi = 0; float gmax = gl[0];
#pragma unroll
            for (int i = 1; i < 8; ++i) if (gl[i] > gmax) { gmax = gl[i]; gi = i; }
            float den = 0.f;
#pragma unroll
            for (int i = 0; i < 8; ++i) den += __expf(gl[i] - gmax);
            const float gp = 1.0f / den;
            float el[8];
#pragma unroll
            for (int i = 0; i < 8; ++i) el[i] = __shfl(le, gi * 8 + i);
            int i0 = 0; float m0 = el[0];
#pragma unroll
            for (int i = 1; i < 8; ++i) if (el[i] > m0) { m0 = el[i]; i0 = i; }
            int i1 = -1; float m1 = -INFINITY;
#pragma unroll
            for (int i = 0; i < 8; ++i) if (i != i0 && el[i] > m1) { m1 = el[i]; i1 = i; }
            const float dd = __expf(m1 - m0);
            w0s[rr] = gp / (1.0f + dd); w1s[rr] = gp * dd / (1.0f + dd); e0s[rr] = gi * 8 + i0; e1s[rr] = gi * 8 + i1;
        }
        if (lane == 0) {
            int p0[4], p1[4];
#pragma unroll
            for (int rr = 0; rr < 4; ++rr) { p0[rr] = atomicAdd(cnt + 64 * e0s[rr], 1); p1[rr] = atomicAdd(cnt + 64 * e1s[rr], 1); }
#pragma unroll
            for (int rr = 0; rr < 4; ++rr) { const int row = row0 + wave * 4 + rr;
                RE[2 * row] = e0s[rr]; RE[2 * row + 1] = e1s[rr]; RP[2 * row] = p0[rr]; RP[2 * row + 1] = p1[rr]; RW[2 * row] = w0s[rr]; RW[2 * row + 1] = w1s[rr];
                LIST[e0s[rr] * 16384 + p0[rr]] = row; LIST[e1s[rr] * 16384 + p1[rr]] = row; }
        }
        __syncthreads();
    }
}

DI void build_tilebase(const Ctx& F) {
    const int* cnt = (const int*)(F.ws + WS_CTL) + CW_CNT; LAS int* tb = (LAS int*)(F.lds + TB_OFF);
    if (F.wave == 0) {
        const int lane = lane_id(); const int tiles = (cnt[64 * lane] + 255) >> 8; int inc = tiles;
#pragma unroll
        for (int o = 1; o < 64; o <<= 1) { const int t = __shfl_up(inc, o); if (lane >= o) inc += t; }
        tb[lane] = inc - tiles; if (lane == 63) tb[NE] = inc; ((LAS int*)(F.lds + CNTL_OFF))[lane] = cnt[64 * lane];
    }
    __syncthreads();
}
DI void fill_tokl(const Ctx& F, const MoeOrder& S) {
    const LAS int* tb = (const LAS int*)(F.lds + TB_OFF); const LAS int* cntl = (const LAS int*)(F.lds + CNTL_OFF); LAS int* tokl = (LAS int*)(F.lds + TOKL_OFF);
    const int* LIST = (const int*)(F.ws + WS_LIST); const int tid = F.wave * 64 + lane_id();
    for (int i = 0; i < 4; ++i) { pg8::Unit u; if (!S.next(i, u)) break;
        const int e = u.pn >> 2, r = 256 * (u.pm - tb[e]) + tid;
        if (tid < 256) tokl[256 * i + tid] = (r < cntl[e]) ? LIST[e * 16384 + r] : 0; }
    asm volatile("s_waitcnt vmcnt(0) lgkmcnt(0)" ::: "memory"); __syncthreads();
}
DI void ph12_final(const Ctx& F, const Args& a, int reps) {
    const float* mod = (const float*)(F.ws + WS_CTL) + CW_MODC; float* H = (float*)argp<N_IN>(); const bf16* H16 = (const bf16*)(F.ws + WS_H16); const float* fg = ARG(I_FG);
    const unsigned char* YE = F.ws + WS_YEXP; const int* RE = (const int*)(F.ws + WS_ROUTE); const int* RP = RE + 2 * M; const float* RW = (const float*)(F.ws + WS_ROUTE) + 4 * M;
    const LAS int* tb = (const LAS int*)(F.lds + TB_OFF);
    float* OUT2 = (float*)(F.ws + WS_U);
    const int gw = F.vcu * NWAVES + F.wave, NGW = F.G * NWAVES, lane = lane_id();
    f32x4 g2[4], fgv[4];
#pragma unroll
    for (int j = 0; j < 4; ++j) { g2[j] = *(const f32x4*)(mod + 5 * 1024 + 256 * j + 4 * lane); fgv[j] = *(const f32x4*)(fg + 256 * j + 4 * lane); }
    const int RT = (M / 2 + NGW - 1) / NGW;
    for (int it = 0; it < RT * reps; ++it) {
        const int t0 = 2 * xcd_unit(F.xcd, F.xj * NWAVES + F.wave, NGW >> 3, (it >= RT ? it - RT : it), M / 2); if (t0 < 0) break;
        float* O = (it >= RT * (reps - 1)) ? H : OUT2;
        int tt[2], d0[2], d1[2]; float w0[2], w1[2];
#pragma unroll
        for (int u = 0; u < 2; ++u) { tt[u] = (t0 + u) % M; d0[u] = 256 * tb[RE[2 * tt[u]]] + RP[2 * tt[u]]; d1[u] = 256 * tb[RE[2 * tt[u] + 1]] + RP[2 * tt[u] + 1]; w0[u] = RW[2 * tt[u]]; w1[u] = RW[2 * tt[u] + 1]; }
        f32x4 hv[2][4]; unsigned ya[2][4], yb[2][4];
#pragma unroll
        for (int u = 0; u < 2; ++u)
#pragma unroll
            for (int j = 0; j < 4; ++j) { const v2u hw = *(const v2u*)(H16 + (size_t)tt[u] * D + 256 * j + 4 * lane); hv[u][j] = (f32x4){bflo(hw.x), bfhi(hw.x), bflo(hw.y), bfhi(hw.y)};
                ya[u][j] = *(const unsigned*)(YE + (size_t)d0[u] * D + 256 * j + 4 * lane); yb[u][j] = *(const unsigned*)(YE + (size_t)d1[u] * D + 256 * j + 4 * lane); }
#pragma unroll
        for (int u = 0; u < 2; ++u) {
            f32x4 v[4]; float ss = 0.f;
#pragma unroll
            for (int j = 0; j < 4; ++j) { const unsigned a4 = ya[u][j], b4 = yb[u][j];
                const f2v a01 = __builtin_amdgcn_cvt_pk_f32_fp8(a4, false), a23 = __builtin_amdgcn_cvt_pk_f32_fp8(a4, true), b01 = __builtin_amdgcn_cvt_pk_f32_fp8(b4, false), b23 = __builtin_amdgcn_cvt_pk_f32_fp8(b4, true);
                f32x4 mo; mo.x = w0[u] * a01.x + w1[u] * b01.x; mo.y = w0[u] * a01.y + w1[u] * b01.y; mo.z = w0[u] * a23.x + w1[u] * b23.x; mo.w = w0[u] * a23.y + w1[u] * b23.y;
                mo = mo * 0.0625f;
                v[j] = hv[u][j] + g2[j] * mo; ss += (v[j].x * v[j].x + v[j].y * v[j].y) + (v[j].z * v[j].z + v[j].w * v[j].w); }
            const float rstd = 1.0f / sqrtf(wave_sum(ss) * (1.0f / D) + EPS);
#pragma unroll
            for (int j = 0; j < 4; ++j) *(f32x4*)(O + (size_t)tt[u] * D + 256 * j + 4 * lane) = v[j] * rstd * fgv[j];
        }
    }
}

constexpr int N_PHASES = 13;
#ifndef REP_MASK
#define REP_MASK 0
#endif
#define REPS(k) (((REP_MASK >> (k)) & 1) ? 2 : 1)
#ifndef MK_ONE_LAUNCH
#define MK_ONE_LAUNCH 1
#endif

struct InProjOrder { pg8::StaticOrder s; int n, reps; const unsigned char* ws; LAS unsigned char* lds; int wave; static constexpr bool HALFSKIP = false;
    DI bool next(int i, pg8::Unit& u) const { if (i >= n * reps) return false; u.aux = i & 1; return s.next(i % n, u); }
    DI void a_ready(const pg8::Unit& u) const {
        if (wave < 2) { const float* g = (wave == 0) ? (const float*)(ws + WS_SA) + u.pm * 256 : (const float*)(ws + WS_SW) + u.pn * 256;
            __builtin_amdgcn_global_load_lds((const unsigned*)((const char*)g + (unsigned)(lane_id() << 4)), (LAS unsigned*)(lds + SCL_OFF + (u.aux & 1) * 2048 + wave * 1024), 16, 0, 0); }
    }
    DI void done(const pg8::Unit&) const {} };
struct RepOrder { pg8::StaticOrder s; int n, reps;
    DI bool next(int i, pg8::Unit& u) const { if (i >= n * reps) return false; return s.next(i % n, u); }
    DI void a_ready(const pg8::Unit&) const {}
    DI void done(const pg8::Unit&) const {} };

__global__ void __launch_bounds__(NTHREADS, 2) fwd_kernel(Args args) {
    extern __shared__ __attribute__((aligned(16))) unsigned char lds_raw[];
    Ctx F;
    F.lds = (LAS unsigned char*)lds_raw;
    F.wave = __builtin_amdgcn_readfirstlane((int)threadIdx.x >> 6);
    F.G = gridDim.x; { const int bx = blockIdx.x; F.xcd = bx & 7; F.xj = bx >> 3; F.vcu = F.xcd * (F.G >> 3) + F.xj; }
    F.ws = (unsigned char*)argp<N_IN + 1>();
    volatile LAS unsigned* MISC = (volatile LAS unsigned*)(F.lds + LDSCTL_OFF);
    for (int u = threadIdx.x; u < (LDS_BYTES - LDSCTL_OFF) / 4; u += NTHREADS) ((LAS unsigned*)(F.lds + LDSCTL_OFF))[u] = 0u;
    __syncthreads();
    const int lo = args.ph_lo, hi = args.ph_hi;
    unsigned* barw = (unsigned*)(F.ws + WS_CTL) + CW_BAR;
    XcdBarrier bar; bar.bar = barw; bar.x = 0; bar.st = nullptr;
    if (hi - lo > 1) bar = xcd_barrier_post(barw, MISC + 8);
    bar.wave = F.wave;
#define IN(k) (lo <= (k) && (k) < hi)
#define SEAM(k) do { if (IN(k) && IN((k) + 1)) { xcd_barrier(bar); if (REPS(14) > 1) xcd_barrier(bar); } } while (0)
    unsigned char* ws = F.ws;
    bf16* XN = (bf16*)(ws + WS_XN);
    const float* mod = (const float*)(ws + WS_CTL) + CW_MOD;

    if (IN(0)) { ph0_prologue(F, args, REPS(0)); SEAM(0); }
    if (IN(1)) { for (int rep = 0; rep < REPS(1); ++rep) { ph1_norm_dt(F, args); __syncthreads(); } SEAM(1); }
    if (IN(2)) {
        pg8::Gemm g{(const bf16*)(ws + WS_XN8), (const bf16*)(ws + WS_W8IN), M, NPROJ, D / 2}; pg8::StaticOrder S; S.init(M, NPROJ, F.G, (int)blockIdx.x);
        EpiInProj E{ws, F.lds};
        InProjOrder R{S, (S.nwg - S.c + S.G - 1) / S.G, REPS(2), ws, F.lds, F.wave};
        pg8::gemm_phase<EpiInProj, InProjOrder, true, true, false, false, true>(F.lds, g, R, E, F.wave);
        SEAM(2);
    }
    if (IN(3)) { ph3_convbranch(F, args, REPS(3)); __syncthreads(); ph3_chunk_states(F, args, REPS(13)); __syncthreads(); SEAM(3); }
    if (IN(4)) {
        if (REPS(4) > 1) ph4_scan(F, WS_YS);
        ph4_scan(F, WS_ST);
        pg8::Gemm g{XN, (const bf16*)(ws + WS_WCV), M, D, D}; pg8::StaticOrder S; S.init(M, D, F.G, (int)blockIdx.x);
        EpiGate<false> E{(bf16*)(ws + WS_TMP), nullptr, (const bf16*)(ws + WS_GATE), 0, nullptr};
        RepOrder R{S, (S.nwg - S.c + S.G - 1) / S.G, REPS(15)};
        pg8::gemm_phase<EpiGate<false>, RepOrder, false, true>(F.lds, g, R, E, F.wave);
        SEAM(4);
    }
    if (IN(5)) { ph5_ssd_out(F, args, REPS(5)); SEAM(5); }
    if (IN(6)) {
        pg8::Gemm g{(const bf16*)(ws + WS_YS), (const bf16*)(ws + WS_WSSM), M, D, DIN / 2}; pg8::StaticOrder S; S.init(M, D, F.G, (int)blockIdx.x);
        LAS float* rt = (LAS float*)(F.lds + RT_OFF);
        EpiGate<true> E{(bf16*)(ws + WS_MG), (const bf16*)(ws + WS_TMP), (const bf16*)(ws + WS_GATE), 1024, rt};
        for (int i = 0;; ++i) {
            OneUnit S1; if (!S.next(i, S1.u)) break;
            if (F.wave < 4) { const int tid = F.wave * 64 + lane_id(); const f32x4 r = *(const f32x4*)((const float*)(ws + WS_RSTD) + (size_t)(S1.u.pm * 256 + tid) * 4);
                *(LAS f32x4*)(rt + tid * 4) = (f32x4){r.x / r.y, r.y / r.z, r.z / r.w, r.w}; }
            asm volatile("s_waitcnt vmcnt(0) lgkmcnt(0)" ::: "memory"); __syncthreads();
            pg8::gemm_phase<EpiGate<true>, OneUnit, false, true, true>(F.lds, g, S1, E, F.wave);
            __syncthreads();
        }
        SEAM(6);
    }
    if (IN(7)) {
        pg8::Gemm g{(const bf16*)(ws + WS_MG), (const bf16*)(ws + WS_WMIX), M, D, D}; pg8::StaticOrder S; S.init(M, D, F.G, (int)blockIdx.x);
        EpiMix E{(bf16*)(ws + WS_H16), ARG(I_X), (const float*)(ws + WS_CTL) + CW_MODC + 2 * 1024};
        RepOrder R{S, (S.nwg - S.c + S.G - 1) / S.G, REPS(7)};
        pg8::gemm_phase<EpiMix, RepOrder, false, true>(F.lds, g, R, E, F.wave);
        SEAM(7);
    }
    if (IN(8)) { for (int rep = 0; rep < REPS(8); ++rep) { convert_experts(F, args); __syncthreads(); } ph8_router(F, args, REPS(9)); if (IN(8) && IN(10)) xcd_barrier(bar); }
    if (IN(10)) {
        build_tilebase(F);
        const LAS int* tb = (const LAS int*)(F.lds + TB_OFF);
        pg8::Gemm g{(const bf16*)(ws + WS_XN), (const bf16*)(ws + WS_W13), M, NE * 1024, D / 2};
        MoeOrder S{tb, F.G, F.vcu, tb[NE] * 4, 1, (const LAS int*)(F.lds + TOKL_OFF)};
        fill_tokl(F, S);
        EpiUp E{ws + WS_HDN};
        pg8::gemm_phase<EpiUp, MoeOrder, true, true, true, true>(F.lds, g, S, E, F.wave);
        SEAM(10);
    }
    if (IN(11)) {
        build_tilebase(F);
        const LAS int* tb = (const LAS int*)(F.lds + TB_OFF);
        pg8::Gemm g{(const bf16*)(ws + WS_HDN), (const bf16*)(ws + WS_W2), 49152, NE * 1024, DFF / 2};
        MoeOrder S{tb, F.G, F.vcu, tb[NE] * 4, 1, nullptr};
        EpiDown E{ws + WS_YEXP};
        pg8::gemm_phase<EpiDown, MoeOrder, true, true, true>(F.lds, g, S, E, F.wave);
        SEAM(11);
    }
    if (IN(12)) { build_tilebase(F); ph12_final(F, args, REPS(12)); }
#undef IN
#undef SEAM
}

extern "C" void kernel_launch(void* const* d_in, const int* in_sizes, int n_in, void* d_out, int out_size, void* d_ws, size_t ws_size, hipStream_t stream) {
    static int grid = 0;
    if (grid == 0) {
        if (n_in != N_IN || in_sizes[0] != M * D || out_size != M * D || ws_size < WS_END) {
            fprintf(stderr, "kernel_launch: unexpected shapes: n_in %d in0 %d out %d ws %zu (need %zu)\n", n_in, n_in > 0 ? in_sizes[0] : -1, out_size, ws_size, (size_t)WS_END); grid = -1; return; }
        int dev = 0, cus = 0, per_cu = 0;
        if (hipGetDevice(&dev) != hipSuccess || hipDeviceGetAttribute(&cus, hipDeviceAttributeMultiprocessorCount, dev) != hipSuccess) { fprintf(stderr, "kernel_launch: device query failed\n"); grid = -1; return; }
        if (hipFuncSetAttribute((const void*)fwd_kernel, hipFuncAttributeMaxDynamicSharedMemorySize, LDS_BYTES) != hipSuccess) { fprintf(stderr, "kernel_launch: hipFuncSetAttribute failed\n"); grid = -1; return; }
        if (hipOccupancyMaxActiveBlocksPerMultiprocessor(&per_cu, (const void*)fwd_kernel, NTHREADS, LDS_BYTES) != hipSuccess || per_cu < 1) {
            fprintf(stderr, "kernel_launch: the occupancy query admits no workgroup of this kernel per CU (%d); nothing launched\n", per_cu); (void)hipGetLastError(); grid = -1; return; }
        grid = cus;
        if (cus < 192 || (cus & 7)) { fprintf(stderr, "kernel_launch: built for a 256-CU device (the MoE unit table holds 4 units per workgroup); %d CUs: nothing launched\n", cus); grid = -1; return; }
        fprintf(stderr, "kernel_launch: grid %d (cus %d, per_cu %d)\n", grid, cus, per_cu);
    }
    if (grid < 0) return;
    (void)hipMemsetAsync((char*)d_ws + WS_CTL, 0, CTL_ZERO_BYTES, stream);
    Args a{};
    for (int i = 0; i < N_IN; ++i) a.in[i] = (const float*)d_in[i];
    a.out = (float*)d_out; a.ws = (unsigned char*)d_ws;
#if MK_ONE_LAUNCH
    a.ph_lo = 0; a.ph_hi = N_PHASES;
    void* kargs[] = {&a};
    hipError_t e = hipLaunchCooperativeKernel((const void*)fwd_kernel, dim3(grid), dim3(NTHREADS), kargs, LDS_BYTES, stream);
    if (e != hipSuccess) fprintf(stderr, "kernel_launch: cooperative launch failed: %s\n", hipGetErrorString(e));
#else
    for (int ph = 0; ph < N_PHASES; ++ph) {
        a.ph_lo = ph; a.ph_hi = ph + 1;
        hipLaunchKernelGGL(fwd_kernel, dim3(grid), dim3(NTHREADS), LDS_BYTES, stream, a);
    }
#endif
}
```

```cpp
#include <hip/hip_runtime.h>
#include <hip/hip_cooperative_groups.h>
#include <cstdio>
#include <cstdint>
namespace pg8 {
#define PG8_LAS __attribute__((address_space(3)))
typedef unsigned short bf16_t;
typedef short bf16x8 __attribute__((ext_vector_type(8)));
typedef float f32x4 __attribute__((ext_vector_type(4)));
typedef unsigned u32x4 __attribute__((ext_vector_type(4)));
typedef int v4i_ __attribute__((ext_vector_type(4)));
typedef int v8i_ __attribute__((ext_vector_type(8)));
constexpr int BM = 256, BK = 64, HALF = 128, HTB = HALF * BK * 2  , STAGE_BYTES = 8 * HTB, NXCD = 8, WGM = 8;

__host__ __device__ __forceinline__ int lds_byte(int r, int c) { const int st = (r >> 4) * 2 + (c >> 5), rr = r & 15, cc = c & 31, ob = rr * 64 + cc * 2; return st * 1024 + (ob ^ (((ob >> 9) & 1) << 5)); }
__host__ __device__ __forceinline__ void stage_rc(int b, int& R, int& C) { const int st = b / 1024, sb = b % 1024, swz = sb ^ (((sb >> 9) & 1) << 5); R = (st >> 1) * 16 + swz / 64; C = (st & 1) * 32 + (swz % 64) / 2; }
__host__ __device__ __forceinline__ int perm32(int rho) { const int n = rho >> 4, i = rho & 15; return 8 * (i >> 2) + 4 * n + (i & 3); }

struct Unit { int pm, pn, aux; };
struct Gemm { const bf16_t* A; const bf16_t* Bt; int M, N, K; };

struct StaticOrder {
    int nM, nN, nwg, G, c;
    __host__ __device__ void init(int M, int N, int G_, int c_) { nM = M / BM; nN = N / BM; nwg = nM * nN; G = G_; c = c_; }
    __host__ __device__ bool next(int i, Unit& u) const {
        const long L = (long)i * G + c; if (L >= nwg) return false;
        int wgid = (int)L; { const int q = nwg / NXCD, r = nwg % NXCD, xcd = wgid % NXCD, off = wgid / NXCD; wgid = (xcd < r ? xcd * (q + 1) : r * (q + 1) + (xcd - r) * q) + off; }
        const int nig = WGM * nN, gid = wgid / nig, fm = gid * WGM, gsz = (nM - fm) < WGM ? (nM - fm) : WGM;
        u.pm = fm + ((wgid % nig) % gsz); u.pn = (wgid % nig) / gsz; return true;
    }
    __device__ __forceinline__ void a_ready(const Unit&) const {}
    __device__ __forceinline__ void done(const Unit&) const {}
};

__device__ __forceinline__ unsigned cvt_pk_bf16(float lo, float hi) { unsigned r; asm volatile("v_cvt_pk_bf16_f32 %0, %1, %2" : "=v"(r) : "v"(lo), "v"(hi)); return r; }
typedef float f32x2 __attribute__((ext_vector_type(2)));
template <class Epi, class Sched, bool ALIGN_EPI = false, bool SP2 = false, bool FP8 = false, bool GATHER = false, bool I8 = false>
__device__ __forceinline__ void gemm_phase(PG8_LAS unsigned char* lds, const Gemm g, const Sched& S, const Epi& E, const int wave_in) {
    const int lane = (int)__builtin_amdgcn_mbcnt_hi(~0u, __builtin_amdgcn_mbcnt_lo(~0u, 0u)), wid = wave_in, tid = wid * 64 + lane, wr = wid >> 2, wc = wid & 3, fr = lane & 15, fq = lane >> 4;
    const int K = g.K, nt = K / BK;
    unsigned voffA[2], voffB[2];
#pragma unroll
    for (int i = 0; i < 2; ++i) { int R, C; stage_rc(tid * 16 + i * 8192, R, C); const int Rb = Epi::PERM ? ((R & ~31) + perm32(R & 31)) : R;
        voffA[i] = (unsigned)(R * K + C) * 2u; voffB[i] = (unsigned)(Rb * K + C) * 2u; }
    static_assert(!GATHER || SP2, "GATHER is implemented in the SP2 loop");
    unsigned gA[2][2], ngA[2][2]; int RA[2]; unsigned CA2[2];
#pragma unroll
    for (int i = 0; i < 2; ++i) { int R, C; stage_rc(tid * 16 + i * 8192, R, C); RA[i] = R; CA2[i] = (unsigned)C * 2u; }
    auto load_g = [&](int ui_, unsigned (&dst)[2][2]) {
        if constexpr (GATHER) {
#pragma unroll
            for (int h = 0; h < 2; ++h)
#pragma unroll
                for (int i = 0; i < 2; ++i) dst[h][i] = (unsigned)S.tokl[ui_ * 256 + 128 * h + RA[i]] * (unsigned)(K * 2) + CA2[i];
        }
    };
    const size_t kstep = (size_t)(BK * 2);
    const size_t hstep = (size_t)HALF * K * 2;
    const size_t tstep = 2 * hstep;
    const size_t hstepA = GATHER ? (size_t)0 : hstep, tstepA = GATHER ? (size_t)0 : 2 * hstep;
    const unsigned ldsw = (unsigned)wid * 1024u;
    const int aoff = lds_byte(wr * 64 + fr, fq * 8), boff = lds_byte(wc * 32 + fr, fq * 8);
#define PG8_SA(b, h) (((b) * 2 + (h)) * HTB)
#define PG8_SB(b, h) ((4 + (b) * 2 + (h)) * HTB)
#define PG8_STAGE(bufoff, gbase, voff) do { _Pragma("unroll") for (int _i = 0; _i < 2; ++_i) \
        __builtin_amdgcn_global_load_lds((const unsigned*)((const char*)(gbase) + (voff)[_i]), (PG8_LAS unsigned*)(lds + (bufoff) + ldsw + _i * 8192), 16, 0, 0); } while (0)
#define PG8_STAGE_A(bufoff, gbase, gvoff) do { if constexpr (GATHER) { PG8_STAGE(bufoff, gbase, gvoff); } else { PG8_STAGE(bufoff, gbase, voffA); } } while (0)
#define PG8_LDA(dst, b, h) do { if constexpr (FP8) { _Pragma("unroll") for (int m = 0; m < 4; ++m) dst##8[m] = __builtin_shufflevector(*(const PG8_LAS v4i_*)(lds + PG8_SA(b, h) + aoff + m * 2048), *(const PG8_LAS v4i_*)(lds + PG8_SA(b, h) + aoff + m * 2048 + 1024), 0, 1, 2, 3, 4, 5, 6, 7); } \
        else { _Pragma("unroll") for (int m = 0; m < 4; ++m) _Pragma("unroll") for (int k = 0; k < 2; ++k) dst[m][k] = *(const PG8_LAS bf16x8*)(lds + PG8_SA(b, h) + aoff + m * 2048 + k * 1024); } } while (0)
#define PG8_LDB(dst, b, h) do { if constexpr (FP8) { _Pragma("unroll") for (int n = 0; n < 2; ++n) dst##8[n] = __builtin_shufflevector(*(const PG8_LAS v4i_*)(lds + PG8_SB(b, h) + boff + n * 2048), *(const PG8_LAS v4i_*)(lds + PG8_SB(b, h) + boff + n * 2048 + 1024), 0, 1, 2, 3, 4, 5, 6, 7); } \
        else { _Pragma("unroll") for (int n = 0; n < 2; ++n) _Pragma("unroll") for (int k = 0; k < 2; ++k) dst[n][k] = *(const PG8_LAS bf16x8*)(lds + PG8_SB(b, h) + boff + n * 2048 + k * 1024); } } while (0)
#define PG8_MMA(ai, bj, At, Bt) do { __builtin_amdgcn_s_setprio(1); \
        if constexpr (FP8) {   \
              \
            _Pragma("unroll") for (int m = 0; m < 4; ++m) _Pragma("unroll") for (int n = 0; n < 2; ++n) \
                asm volatile("v_mfma_scale_f32_16x16x128_f8f6f4 %0, %1, %2, %0, %3, %4 op_sel_hi:[0,0,0]" : "+v"(acc[ai][bj][m][n]) : "v"(Bt##8[n]), "v"(At##8[m]), "v"(scale_w), "v"(scale_x)); \
        } else { \
        _Pragma("unroll") for (int m = 0; m < 4; ++m) _Pragma("unroll") for (int n = 0; n < 2; ++n) _Pragma("unroll") for (int k = 0; k < 2; ++k) { \
        if constexpr (I8) acc[ai][bj][m][n] = __builtin_bit_cast(f32x4, __builtin_amdgcn_mfma_i32_16x16x64_i8(__builtin_bit_cast(v4i_, Bt[n][k]), __builtin_bit_cast(v4i_, At[m][k]), __builtin_bit_cast(v4i_, acc[ai][bj][m][n]), 0, 0, 0)); \
        else acc[ai][bj][m][n] = __builtin_amdgcn_mfma_f32_16x16x32_bf16(Bt[n][k], At[m][k], acc[ai][bj][m][n], 0, 0, 0); } } __builtin_amdgcn_s_setprio(0); } while (0)
#define PG8_WAIT_V(n) asm volatile("s_waitcnt vmcnt(" #n ")" ::: "memory")
#define PG8_WAIT_L(n) asm volatile("s_waitcnt lgkmcnt(" #n ")" ::: "memory")
#define PG8_BAR __builtin_amdgcn_s_barrier()
#define PG8_SCHED __builtin_amdgcn_sched_barrier(0)
    Unit cur, nxt; int ui = 0;
    if (!S.next(0, cur)) return;
    f32x4 acc[2][2][4][2];
#pragma unroll
    for (int a = 0; a < 2; ++a)
#pragma unroll
        for (int b = 0; b < 2; ++b)
#pragma unroll
            for (int m = 0; m < 4; ++m)
#pragma unroll
                for (int n = 0; n < 2; ++n) acc[a][b][m][n] = (f32x4){0.f, 0.f, 0.f, 0.f};
    auto xdl_settle = [&]() {
        asm volatile("s_nop 15\n\ts_nop 15" : "+v"(acc[0][0][0][0]), "+v"(acc[0][0][0][1]), "+v"(acc[0][0][1][0]), "+v"(acc[0][0][1][1]), "+v"(acc[0][0][2][0]), "+v"(acc[0][0][2][1]), "+v"(acc[0][0][3][0]), "+v"(acc[0][0][3][1]), "+v"(acc[0][1][0][0]), "+v"(acc[0][1][0][1]), "+v"(acc[0][1][1][0]), "+v"(acc[0][1][1][1]), "+v"(acc[0][1][2][0]), "+v"(acc[0][1][2][1]), "+v"(acc[0][1][3][0]), "+v"(acc[0][1][3][1]));
        asm volatile("s_nop 0" : "+v"(acc[1][0][0][0]), "+v"(acc[1][0][0][1]), "+v"(acc[1][0][1][0]), "+v"(acc[1][0][1][1]), "+v"(acc[1][0][2][0]), "+v"(acc[1][0][2][1]), "+v"(acc[1][0][3][0]), "+v"(acc[1][0][3][1]), "+v"(acc[1][1][0][0]), "+v"(acc[1][1][0][1]), "+v"(acc[1][1][1][0]), "+v"(acc[1][1][1][1]), "+v"(acc[1][1][2][0]), "+v"(acc[1][1][2][1]), "+v"(acc[1][1][3][0]), "+v"(acc[1][1][3][1]));
    };
    const int scale_w = 0x79797979, scale_x = 0x7f7f7f7f;
    bf16x8 At[4][2], B0[2][2], B1[2][2]; v8i_ At8[4], B08[2], B18[2];
    const char* cA = (const char*)g.A + (size_t)cur.pm * tstepA; const char* cB = (const char*)g.Bt + (size_t)cur.pn * tstep;
    load_g(0, gA);
    S.a_ready(cur);
    if constexpr (SP2) {
        PG8_STAGE(PG8_SB(0, 0), cB, voffB); PG8_STAGE(PG8_SB(0, 1), cB + hstep, voffB); PG8_STAGE_A(PG8_SA(0, 0), cA, gA[0]); PG8_STAGE_A(PG8_SA(0, 1), cA + hstepA, gA[1]);
        if (wr == 1) PG8_BAR;
        PG8_WAIT_V(2); PG8_BAR;
        PG8_STAGE(PG8_SB(1, 0), cB + kstep, voffB); PG8_STAGE_A(PG8_SA(1, 0), cA + kstep, gA[0]); PG8_STAGE(PG8_SB(1, 1), cB + hstep + kstep, voffB);
        PG8_WAIT_V(6); PG8_BAR;
    } else {
        PG8_STAGE(PG8_SB(0, 0), cB, voffB); PG8_STAGE(PG8_SA(0, 0), cA, voffA); PG8_STAGE(PG8_SB(0, 1), cB + hstep, voffB); PG8_STAGE(PG8_SA(0, 1), cA + hstep, voffA);
        if (wr == 1) PG8_BAR;
        PG8_WAIT_V(4); PG8_BAR;
        PG8_STAGE(PG8_SB(1, 0), cB + kstep, voffB); PG8_STAGE(PG8_SA(1, 0), cA + kstep, voffA); PG8_STAGE(PG8_SB(1, 1), cB + hstep + kstep, voffB);
        PG8_WAIT_V(6); PG8_BAR;
    }
    for (;;) {
        const bool has_next = S.next(ui + 1, nxt);
        const char* nA = has_next ? (const char*)g.A + (size_t)nxt.pm * tstepA : cA; const char* nB = has_next ? (const char*)g.Bt + (size_t)nxt.pn * tstep : cB;
        if constexpr (GATHER) { if (has_next) load_g(ui + 1, ngA); else {
#pragma unroll
            for (int h = 0; h < 2; ++h)
#pragma unroll
                for (int i = 0; i < 2; ++i) ngA[h][i] = gA[h][i]; } }
        for (int t = 0; t < nt; t += 2) {
            const bool last = (t == nt - 2);
            const char* a1 = cA + (size_t)(t + 1) * kstep;
            const char* a2 = last ? nA : cA + (size_t)(t + 2) * kstep; const char* b2 = last ? nB : cB + (size_t)(t + 2) * kstep;
            const char* a3 = a2 + kstep; const char* b3 = b2 + kstep;
            if (last && has_next) S.a_ready(nxt);
            unsigned sN[2][2];
#pragma unroll
            for (int h = 0; h < 2; ++h)
#pragma unroll
                for (int i = 0; i < 2; ++i) sN[h][i] = last ? ngA[h][i] : gA[h][i];
            if constexpr (SP2) {
            PG8_LDB(B0, 0, 0); PG8_LDB(B1, 0, 1); PG8_SCHED; PG8_LDA(At, 0, 0); PG8_STAGE_A(PG8_SA(1, 1), a1 + hstepA, gA[1]);
            PG8_WAIT_V(8); PG8_WAIT_L(0); PG8_BAR; PG8_MMA(0, 0, At, B0); PG8_MMA(0, 1, At, B1); PG8_BAR; PG8_SCHED;
            PG8_LDA(At, 0, 1); PG8_STAGE(PG8_SB(0, 0), b2, voffB); PG8_STAGE(PG8_SB(0, 1), b2 + hstep, voffB); PG8_STAGE_A(PG8_SA(0, 0), a2, sN[0]);
            PG8_WAIT_V(8); PG8_WAIT_L(0); PG8_BAR; PG8_MMA(1, 0, At, B0); PG8_MMA(1, 1, At, B1); PG8_BAR; PG8_SCHED;
            PG8_LDB(B0, 1, 0); PG8_LDB(B1, 1, 1); PG8_SCHED; PG8_LDA(At, 1, 0); PG8_STAGE_A(PG8_SA(0, 1), a2 + hstepA, sN[1]);
            PG8_WAIT_V(8); PG8_WAIT_L(0); PG8_BAR; PG8_MMA(0, 0, At, B0); PG8_MMA(0, 1, At, B1); PG8_BAR; PG8_SCHED;
            PG8_LDA(At, 1, 1); PG8_STAGE(PG8_SB(1, 0), b3, voffB); PG8_STAGE(PG8_SB(1, 1), b3 + hstep, voffB); PG8_STAGE_A(PG8_SA(1, 0), a3, sN[0]);
            PG8_WAIT_V(8); PG8_WAIT_L(0); PG8_BAR; PG8_MMA(1, 0, At, B0); PG8_MMA(1, 1, At, B1); PG8_BAR; PG8_SCHED;
            } else {
            PG8_LDB(B0, 0, 0); PG8_SCHED; PG8_LDA(At, 0, 0); PG8_STAGE(PG8_SA(1, 1), a1 + hstep, voffA);
            PG8_WAIT_L(8); PG8_BAR; PG8_WAIT_L(0); PG8_MMA(0, 0, At, B0); PG8_BAR; PG8_SCHED;
            PG8_LDB(B1, 0, 1); PG8_STAGE(PG8_SB(0, 0), b2, voffB);
            PG8_BAR; PG8_WAIT_L(0); PG8_MMA(0, 1, At, B1); PG8_BAR;
            PG8_LDA(At, 0, 1); PG8_STAGE(PG8_SA(0, 0), a2, voffA);
            PG8_BAR; PG8_WAIT_L(0); PG8_MMA(1, 0, At, B0); PG8_BAR; PG8_SCHED;
            PG8_STAGE(PG8_SB(0, 1), b2 + hstep, voffB);
            PG8_WAIT_V(6); PG8_BAR; PG8_MMA(1, 1, At, B1); PG8_BAR;
            PG8_LDB(B0, 1, 0); PG8_SCHED; PG8_LDA(At, 1, 0); PG8_STAGE(PG8_SA(0, 1), a2 + hstep, voffA);
            PG8_WAIT_L(8); PG8_BAR; PG8_WAIT_L(0); PG8_MMA(0, 0, At, B0); PG8_BAR; PG8_SCHED;
            PG8_LDB(B1, 1, 1); PG8_STAGE(PG8_SB(1, 0), b3, voffB);
            PG8_BAR; PG8_WAIT_L(0); PG8_MMA(0, 1, At, B1); PG8_BAR;
            PG8_LDA(At, 1, 1); PG8_STAGE(PG8_SA(1, 0), a3, voffA);
            PG8_BAR; PG8_WAIT_L(0); PG8_MMA(1, 0, At, B0); PG8_BAR; PG8_SCHED;
            PG8_STAGE(PG8_SB(1, 1), b3 + hstep, voffB);
            PG8_WAIT_V(6); PG8_BAR; PG8_MMA(1, 1, At, B1); PG8_BAR;
            }
            if constexpr (Epi::KHOOK) { constexpr int HK = FP8 ? 4 : 8, HS = FP8 ? 2 : 3;
                if ((((t + 2) & (HK - 1)) == 0) && (t + 2 < nt)) { if constexpr (FP8) xdl_settle(); E.khook(acc, ((t + 2) >> HS) - 1, wr, fr); if constexpr (FP8) xdl_settle(); } }
        }
        if constexpr (ALIGN_EPI) { if (wr == 0) PG8_BAR; }
        if constexpr (FP8) {
            xdl_settle();
        }
        if constexpr (!Epi::AFTER_DRAIN) { E(acc, cur, wr, wc, fr, fq); S.done(cur); }
        if (!has_next) break;
#pragma unroll
        for (int a = 0; a < 2; ++a)
#pragma unroll
            for (int b = 0; b < 2; ++b)
#pragma unroll
                for (int m = 0; m < 4; ++m)
#pragma unroll
                    for (int n = 0; n < 2; ++n) acc[a][b][m][n] = (f32x4){0.f, 0.f, 0.f, 0.f};
        cur = nxt; cA = nA; cB = nB; ++ui;
        if constexpr (GATHER) {
#pragma unroll
            for (int h = 0; h < 2; ++h)
#pragma unroll
                for (int i = 0; i < 2; ++i) gA[h][i] = ngA[h][i]; }
        if constexpr (ALIGN_EPI) { if (wr == 1) PG8_BAR; }
    }
    PG8_WAIT_V(0);
    if constexpr (!ALIGN_EPI) { if (wr == 0) PG8_BAR; }
    PG8_BAR;
    if constexpr (Epi::AFTER_DRAIN) { E.fused(acc, cur, wr, wc, fr, fq, lds, wid, lane); S.done(cur); }
#undef PG8_SA
#undef PG8_SB
#undef PG8_STAGE
#undef PG8_STAGE_A
#undef PG8_LDA
#undef PG8_LDB
#undef PG8_MMA
#undef PG8_WAIT_V
#undef PG8_WAIT_L
#undef PG8_BAR
#undef PG8_SCHED
}
}

#define DI __device__ __forceinline__
#define GAS __attribute__((address_space(1)))
#define LAS __attribute__((address_space(3)))
typedef unsigned short bf16;
typedef unsigned v4u __attribute__((ext_vector_type(4)));
typedef unsigned v2u __attribute__((ext_vector_type(2)));
typedef float f32x4 __attribute__((ext_vector_type(4)));
typedef float f32x16 __attribute__((ext_vector_type(16)));
typedef short bf16x8 __attribute__((ext_vector_type(8)));
typedef __bf16 bf2v __attribute__((ext_vector_type(2)));
typedef float f2v __attribute__((ext_vector_type(2)));
typedef GAS unsigned gu32;

constexpr int NWAVES = 8, NTHREADS = 512;
constexpr int M = 16384, D = 1024, DIN = 2048, NH = 32, HD = 64, NGRP = 4, NST = 128, XBCW = 3072;
constexpr int NPROJ = 9216, WIN_LD = 9248;
constexpr int LCH = 128, NCH = M / LCH;
constexpr int NE = 64, DFF = 512;
constexpr float EPS = 1e-6f;
constexpr float LOG2E = 1.4426950408889634f;

constexpr size_t MiB = 1u << 20;
constexpr size_t WS_CTL = 0, CTL_ZERO_BYTES = 262144;
constexpr size_t WS_WIN = 1 * MiB, WS_WDT = 19 * MiB, WS_WCV = 20 * MiB, WS_WMIX = 22 * MiB, WS_WSSM = 24 * MiB;
constexpr size_t WS_RSTD = 31 * MiB + 524288;
constexpr size_t WS_DT = 28 * MiB, WS_CD = 30 * MiB, WS_WRH = 30 * MiB + 65536, WS_WRL = WS_WRH + 262144, WS_ROUTE = 31 * MiB;
constexpr size_t WS_ST = 32 * MiB, WS_YS = 96 * MiB, WS_TMP = 160 * MiB, WS_MG = 192 * MiB;
constexpr size_t WS_W13 = 32 * MiB, WS_W2 = 160 * MiB, WS_H16 = 96 * MiB;
constexpr size_t WS_XN8 = 32 * MiB, WS_W8IN = 48 * MiB, WS_SA = 60 * MiB, WS_SW = 61 * MiB;
constexpr size_t WS_XN = 224 * MiB;
constexpr size_t WS_U = 256 * MiB, WS_ZS = 288 * MiB, WS_XBC = 352 * MiB, WS_GATE = 448 * MiB;
constexpr size_t WS_LIST = 256 * MiB, WS_HDN = 352 * MiB, WS_YEXP = 400 * MiB;
constexpr size_t WS_END = 512 * MiB;
constexpr int CW_BAR = 4096;
constexpr int CW_CNT = 8192;
constexpr int CW_MODC = 40960;
constexpr int CW_WMAX = 49152;
constexpr int CW_MOD = 16384;

constexpr int RING_BYTES = 131072;
constexpr int LDSCTL_OFF = 147456;
constexpr int TB_OFF = LDSCTL_OFF + 256;
constexpr int CNTL_OFF = TB_OFF + 320;
constexpr int TOKL_OFF = LDSCTL_OFF + 1024;
constexpr int RT_OFF = 148480;
constexpr int SCL_OFF = 131072;
constexpr int LDS_BYTES = 152576;

#define LDS_WAIT() asm volatile("s_waitcnt lgkmcnt(0)" ::: "memory")
#define VM_WAIT() asm volatile("s_waitcnt vmcnt(0)" ::: "memory")

DI unsigned pk2(float lo, float hi) { f2v v = {lo, hi}; return __builtin_bit_cast(unsigned, __builtin_convertvector(v, bf2v)); }
DI unsigned pk4_fp8(float a, float b, float c, float d) {
    a = __builtin_fminf(__builtin_fmaxf(a, -448.f), 448.f); b = __builtin_fminf(__builtin_fmaxf(b, -448.f), 448.f);
    c = __builtin_fminf(__builtin_fmaxf(c, -448.f), 448.f); d = __builtin_fminf(__builtin_fmaxf(d, -448.f), 448.f);
    unsigned w = 0u; w = __builtin_amdgcn_cvt_pk_fp8_f32(a, b, w, false); w = __builtin_amdgcn_cvt_pk_fp8_f32(c, d, w, true); return w; }
DI unsigned pk4_fp8_nc(float a, float b, float c, float d) { unsigned w = 0u; w = __builtin_amdgcn_cvt_pk_fp8_f32(a, b, w, false); w = __builtin_amdgcn_cvt_pk_fp8_f32(c, d, w, true); return w; }
DI unsigned pk4_i8(float a, float b, float c, float d) {
    const int ia = (int)__builtin_rintf(a), ib = (int)__builtin_rintf(b), ic = (int)__builtin_rintf(c), id = (int)__builtin_rintf(d);
    return ((unsigned)ia & 255u) | (((unsigned)ib & 255u) << 8) | (((unsigned)ic & 255u) << 16) | ((unsigned)id << 24); }
DI unsigned pk2_fp8(float a, float b) {
    a = __builtin_fminf(__builtin_fmaxf(a, -448.f), 448.f); b = __builtin_fminf(__builtin_fmaxf(b, -448.f), 448.f);
    return __builtin_amdgcn_cvt_pk_fp8_f32(a, b, 0u, false) & 0xffffu; }
DI bf16x8 fp8x8_to_bf16(v2u w) {
    v4u o; o.x = pk2(__builtin_amdgcn_cvt_f32_fp8(w.x, 0), __builtin_amdgcn_cvt_f32_fp8(w.x, 1)); o.y = pk2(__builtin_amdgcn_cvt_f32_fp8(w.x, 2), __builtin_amdgcn_cvt_f32_fp8(w.x, 3));
    o.z = pk2(__builtin_amdgcn_cvt_f32_fp8(w.y, 0), __builtin_amdgcn_cvt_f32_fp8(w.y, 1)); o.w = pk2(__builtin_amdgcn_cvt_f32_fp8(w.y, 2), __builtin_amdgcn_cvt_f32_fp8(w.y, 3));
    return __builtin_bit_cast(bf16x8, o); }
DI float bflo(unsigned u) { return __uint_as_float(u << 16); }
DI float bfhi(unsigned u) { return __uint_as_float(u & 0xffff0000u); }
DI float sigmoidf_(float x) { return __builtin_amdgcn_rcpf(1.f + __builtin_amdgcn_exp2f(x * -LOG2E)); }
DI float siluf_(float x) { return x * __builtin_amdgcn_rcpf(1.f + __builtin_amdgcn_exp2f(x * -LOG2E)); }
DI float wave_sum(float v) {
#pragma unroll
    for (int o = 1; o < 64; o <<= 1) v += __shfl_xor(v, o);
    return v;
}
DI f32x4 mod4(const float* modp, int k) { return (*(const f32x4*)(modp + k) + *(const f32x4*)(modp + 6144 + k)) + (*(const f32x4*)(modp + 2 * 6144 + k) + *(const f32x4*)(modp + 3 * 6144 + k)); }
DI int crow(int reg, int hh) { return (reg & 3) + 8 * (reg >> 2) + 4 * hh; }
DI int swz(int row, int chunk) { return chunk ^ ((row ^ (row >> 3)) & 15); }
#define MFMA32(a, b, c) __builtin_amdgcn_mfma_f32_32x32x16_bf16((a), (b), (c), 0, 0, 0)

DI int lane_id() { return (int)__builtin_amdgcn_mbcnt_hi(~0u, __builtin_amdgcn_mbcnt_lo(~0u, 0u)); }
#define XB_TMO      128
#define XB_XCNT(j)  (256  + 64 * (j))
#define XB_XSUB(j)  (1280 + 64 * (j))
#define XB_XGEN(j)  (2304 + 64 * (j))
#define XB_TOP      3328
#define XB_TOPGEN   3392
#define XCD_BAR_WORDS 3456
#define XB_SPIN_CAP (1u << 18)
DI unsigned xb_ld(unsigned* p)              { return __hip_atomic_load(p, __ATOMIC_RELAXED, __HIP_MEMORY_SCOPE_AGENT); }
DI unsigned xb_add(unsigned* p, unsigned v) { return __hip_atomic_fetch_add(p, v, __ATOMIC_RELAXED, __HIP_MEMORY_SCOPE_AGENT); }
DI unsigned xb_xcc_id() { return (unsigned)__builtin_amdgcn_s_getreg((3 << 11) | 20) & 0xFu; }
#define XB_SPIN(cond, bar) do { unsigned _sp = 0; while (cond) { __builtin_amdgcn_s_sleep(1); \
    if ((++_sp & 255u) == 0u) { if (xb_ld(&(bar)[XB_TMO])) break; if (_sp > XB_SPIN_CAP) { atomicAdd(&(bar)[XB_TMO], 1u); break; } } } } while (0)
struct XcdBarrier { unsigned* bar; unsigned x; volatile LAS unsigned* st; int wave; };
DI XcdBarrier xcd_barrier_post(unsigned* bar, volatile LAS unsigned* st) {
    XcdBarrier b; b.bar = bar; b.x = xb_xcc_id(); b.st = st; b.wave = 0;
    if (threadIdx.x == 0) (void)xb_add(&bar[XB_XCNT(b.x)], 1u);
    return b;
}
DI void xcd_barrier_complete(unsigned* bar, unsigned x, unsigned& nloc, unsigned& nx) {
    const unsigned G = gridDim.x * gridDim.y * gridDim.z;
    unsigned sum, cnt, mine, sp = 0u;
    for (;;) {
        sum = 0u; cnt = 0u; mine = 0u;
#pragma unroll
        for (unsigned j = 0; j < 16; ++j) { const unsigned c = xb_ld(&bar[XB_XCNT(j)]); sum += c; cnt += (c > 0u) ? 1u : 0u; mine = (j == x) ? c : mine; }
        if (sum == G) break;
        __builtin_amdgcn_s_sleep(1);
        if ((++sp & 255u) == 0u) { if (xb_ld(&bar[XB_TMO])) break; if (sp > XB_SPIN_CAP) { atomicAdd(&bar[XB_TMO], 1u); break; } }
    }
    nloc = mine > 0u ? mine : 1u; nx = cnt > 0u ? cnt : 1u;
}
DI void xcd_barrier(const XcdBarrier& b) {
    asm volatile("s_waitcnt vmcnt(0)" ::: "memory");
    __syncthreads();
    if (b.wave == 0 && lane_id() == 0) {
        unsigned* bar = b.bar;
        __builtin_amdgcn_s_waitcnt(0);
        unsigned nloc = b.st[0], nx = b.st[1];
        if (nloc == 0u) { xcd_barrier_complete(bar, b.x, nloc, nx); b.st[0] = nloc; b.st[1] = nx; }
        const unsigned old = xb_add(&bar[XB_XSUB(b.x)], 1u);
        const unsigned gen = old / nloc;
        if (old + 1u == (gen + 1u) * nloc) {
            __builtin_amdgcn_fence(__ATOMIC_RELEASE, "agent");
            asm volatile("s_waitcnt vmcnt(0)" ::: "memory");
            const unsigned og = xb_add(&bar[XB_TOP], 1u);
            const unsigned tg = og / nx;
            if (og + 1u == (tg + 1u) * nx) xb_add(&bar[XB_TOPGEN], 1u);
            else XB_SPIN(xb_ld(&bar[XB_TOPGEN]) == tg, bar);
            __builtin_amdgcn_fence(__ATOMIC_ACQUIRE, "agent");
            xb_add(&bar[XB_XGEN(b.x)], 1u);
            asm volatile("s_waitcnt vmcnt(0)" ::: "memory");
        } else {
            XB_SPIN(xb_ld(&bar[XB_XGEN(b.x)]) == gen, bar);
            __builtin_amdgcn_fence(__ATOMIC_ACQUIRE, "agent");
            asm volatile("s_waitcnt vmcnt(0)" ::: "memory");
        }
    }
    __syncthreads();
}

enum { I_X = 0, I_C, I_WADA, I_BADA, I_N1G, I_WIN, I_CVW, I_CVB, I_LNG, I_LNB, I_WCV, I_SCW, I_SCB, I_DTB, I_ALOG, I_DSKIP, I_SNG, I_WSSM, I_WMIX,
       I_N2G, I_WGRP, I_BGRP, I_WER, I_BER, I_W1, I_W3, I_W2, I_FG, N_IN };
struct Args { const float* in[N_IN]; float* out; unsigned char* ws; int ph_lo, ph_hi; };

template <int I> DI const float* argp() {
    auto kp = __builtin_amdgcn_kernarg_segment_ptr();
    unsigned long long v;
    asm volatile("s_load_dwordx2 %0, %1, %2\n\ts_waitcnt lgkmcnt(0)" : "=s"(v) : "s"(kp), "i"(I * 8));
    return (const float*)(const GAS float*)v;
}
#define ARG(i) argp<i>()
struct Ctx {
    LAS unsigned char* lds;
    int wave, vcu, G, xcd, xj;
    unsigned char* ws;
};

DI int xcd_unit(int x, int j, int gx, int i, int N) { const int u = i * gx + j; return (u < (N >> 3)) ? x * (N >> 3) + u : -1; }
DI int inproj_tile(int p) { return p < 8 ? p + 28 : p - 8; }
DI int win_col(int npp) { const int np = inproj_tile(npp >> 8) * 256 + (npp & 255);
    if (np < 2048) { const int q = np >> 3, rr = np & 7; return (rr >> 2) * 1024 + 4 * q + (rr & 3); } return np < 7168 ? np : np + 32; }
struct EpiInProj {
    static constexpr bool PERM = true, AFTER_DRAIN = false, KHOOK = false; static constexpr int NPF = 0;
    unsigned char* ws; LAS unsigned char* lds;
    DI static pg8::f32x4 cvt(const pg8::f32x4& a, float sr, const f32x4& sc) { const pg8::v4i_ q = __builtin_bit_cast(pg8::v4i_, a);
        return (pg8::f32x4){(float)q[0] * (sr * sc.x), (float)q[1] * (sr * sc.y), (float)q[2] * (sr * sc.z), (float)q[3] * (sr * sc.w)}; }
    DI void operator()(const pg8::f32x4 (&acc)[2][2][4][2], const pg8::Unit& u, int wr, int wc, int fr, int fq) const {
        const int pn = inproj_tile(u.pn), row0 = u.pm * 256 + wr * 64 + fr;
        const LAS float* SAl = (const LAS float*)(lds + SCL_OFF + (u.aux & 1) * 2048); const LAS float* SWl = SAl + 256 + wc * 32 + fq * 8;
        f32x4 sc[2][2];
#pragma unroll
        for (int bj = 0; bj < 2; ++bj) { sc[bj][0] = *(const LAS f32x4*)(SWl + bj * 128); sc[bj][1] = *(const LAS f32x4*)(SWl + bj * 128 + 4); }
        float sr[2][4];
#pragma unroll
        for (int ai = 0; ai < 2; ++ai)
#pragma unroll
            for (int m = 0; m < 4; ++m) sr[ai][m] = SAl[wr * 64 + fr + ai * 128 + m * 16];
        if (pn < 8) {
            bf16* U = (bf16*)(ws + WS_U);
#pragma unroll
            for (int ai = 0; ai < 2; ++ai)
#pragma unroll
                for (int m = 0; m < 4; ++m) {
                    bf16* rowp = U + (size_t)(row0 + ai * 128 + m * 16) * D + pn * 128 + wc * 16 + fq * 4;
#pragma unroll
                    for (int bj = 0; bj < 2; ++bj) { const pg8::f32x4 a = cvt(acc[ai][bj][m][0], sr[ai][m], sc[bj][0]), b = cvt(acc[ai][bj][m][1], sr[ai][m], sc[bj][1]);
                        v2u w; w.x = pk2(a[0] * sigmoidf_(b[0]), a[1] * sigmoidf_(b[1])); w.y = pk2(a[2] * sigmoidf_(b[2]), a[3] * sigmoidf_(b[3]));
                        *(v2u*)(rowp + bj * 64) = w; } }
        } else {
            const bool isz = pn < 16, isx = (pn >= 16) && (pn < 28);
            const size_t boff = isz ? WS_ZS : (isx ? WS_XBC : WS_GATE);
            const int ldc = isx ? XBCW : DIN;
            const int colt = (pn - (isz ? 8 : (isx ? 16 : 28))) * 256;
            bf16* base = (bf16*)(ws + boff);
            const int col0 = colt + wc * 32 + fq * 8;
#pragma unroll
            for (int ai = 0; ai < 2; ++ai)
#pragma unroll
                for (int m = 0; m < 4; ++m) {
                    bf16* rowp = base + (size_t)(row0 + ai * 128 + m * 16) * ldc + col0;
#pragma unroll
                    for (int bj = 0; bj < 2; ++bj) { pg8::f32x4 v0 = cvt(acc[ai][bj][m][0], sr[ai][m], sc[bj][0]), v1 = cvt(acc[ai][bj][m][1], sr[ai][m], sc[bj][1]);
                        if (isz) {
#pragma unroll
                            for (int i = 0; i < 4; ++i) { v0[i] = v0[i] * sigmoidf_(v0[i]); v1[i] = v1[i] * sigmoidf_(v1[i]); }
                        }
                        if (!isz && !isx) {
                            v2u w8; w8.x = pk4_fp8(v0[0], v0[1], v0[2], v0[3]); w8.y = pk4_fp8(v1[0], v1[1], v1[2], v1[3]);
                            *(v2u*)((unsigned char*)base + (size_t)(row0 + ai * 128 + m * 16) * ldc + col0 + bj * 128) = w8;
                        } else {
                        v4u w; w.x = pk2(v0[0], v0[1]); w.y = pk2(v0[2], v0[3]); w.z = pk2(v1[0], v1[1]); w.w = pk2(v1[2], v1[3]);
                        *(v4u*)(rowp + bj * 128) = w; } } }
        }
    }
};
template <bool NORM> struct EpiGate {
    static constexpr bool PERM = true, AFTER_DRAIN = false, KHOOK = NORM;
    bf16* O; const bf16* P; const bf16* GATE; int gcol; const LAS float* rt;
    DI void khook(pg8::f32x4 (&acc)[2][2][4][2], int b, int wr, int fr) const {
#pragma unroll
        for (int ai = 0; ai < 2; ++ai)
#pragma unroll
            for (int m = 0; m < 4; ++m) { const float f = rt[(ai * 128 + wr * 64 + m * 16 + fr) * 4 + b];
#pragma unroll
                for (int bj = 0; bj < 2; ++bj)
#pragma unroll
                    for (int n = 0; n < 2; ++n) acc[ai][bj][m][n] = acc[ai][bj][m][n] * f; }
    }
    DI void operator()(const pg8::f32x4 (&acc)[2][2][4][2], const pg8::Unit& u, int wr, int wc, int fr, int fq) const {
        const int row0 = u.pm * 256 + wr * 64 + fr, col0 = u.pn * 256 + wc * 32 + fq * 8;
        v2u g[4]; v4u p[4], wA[4], wB[4];
        auto loadq = [&](int bj, int ai) {
#pragma unroll
            for (int m = 0; m < 4; ++m) { const size_t r = (size_t)(row0 + ai * 128 + m * 16); const int c = col0 + bj * 128;
                g[m] = *(const v2u*)((const unsigned char*)GATE + r * (2 * D) + gcol + c); if (NORM) p[m] = *(const v4u*)(P + r * D + c); }
        };
        auto calcq = [&](int bj, int ai, v4u (&w)[4]) {
#pragma unroll
            for (int m = 0; m < 4; ++m) {
                float f = 1.0f; if (NORM) f = rt[(ai * 128 + wr * 64 + m * 16 + fr) * 4 + 3];
                const v2u gg = g[m];
                pg8::f32x4 v0 = acc[ai][bj][m][0] * f, v1 = acc[ai][bj][m][1] * f;
                float o[8] = {v0[0] * sigmoidf_(__builtin_amdgcn_cvt_f32_fp8(gg.x, 0)), v0[1] * sigmoidf_(__builtin_amdgcn_cvt_f32_fp8(gg.x, 1)), v0[2] * sigmoidf_(__builtin_amdgcn_cvt_f32_fp8(gg.x, 2)), v0[3] * sigmoidf_(__builtin_amdgcn_cvt_f32_fp8(gg.x, 3)),
                              v1[0] * sigmoidf_(__builtin_amdgcn_cvt_f32_fp8(gg.y, 0)), v1[1] * sigmoidf_(__builtin_amdgcn_cvt_f32_fp8(gg.y, 1)), v1[2] * sigmoidf_(__builtin_amdgcn_cvt_f32_fp8(gg.y, 2)), v1[3] * sigmoidf_(__builtin_amdgcn_cvt_f32_fp8(gg.y, 3))};
                if (NORM) { const v4u pp = p[m];
                    o[0] += bflo(pp.x); o[1] += bfhi(pp.x); o[2] += bflo(pp.y); o[3] += bfhi(pp.y); o[4] += bflo(pp.z); o[5] += bfhi(pp.z); o[6] += bflo(pp.w); o[7] += bfhi(pp.w); }
                w[m].x = pk2(o[0], o[1]); w[m].y = pk2(o[2], o[3]); w[m].z = pk2(o[4], o[5]); w[m].w = pk2(o[6], o[7]); }
        };
        auto storeq = [&](int bj, int ai, const v4u (&w)[4]) {
#pragma unroll
            for (int m = 0; m < 4; ++m) *(v4u*)(O + (size_t)(row0 + ai * 128 + m * 16) * D + col0 + bj * 128) = w[m];
        };
        loadq(0, 0); calcq(0, 0, wA); loadq(0, 1); storeq(0, 0, wA); calcq(0, 1, wB); loadq(1, 0); storeq(0, 1, wB); calcq(1, 0, wA); loadq(1, 1); storeq(1, 0, wA); calcq(1, 1, wB); storeq(1, 1, wB);
    }
};
struct EpiMix {
    static constexpr bool PERM = true, AFTER_DRAIN = false, KHOOK = false;
    bf16* H; const float* X; const float* g1;
    DI void operator()(const pg8::f32x4 (&acc)[2][2][4][2], const pg8::Unit& u, int wr, int wc, int fr, int fq) const {
        const int row0 = u.pm * 256 + wr * 64 + fr, col0 = u.pn * 256 + wc * 32 + fq * 8;
        f32x4 xa[4], xb[4]; v4u wA[4], wB[4];
        auto loadq = [&](int bj, int ai) {
#pragma unroll
            for (int m = 0; m < 4; ++m) { const size_t off = (size_t)(row0 + ai * 128 + m * 16) * D + col0 + bj * 128;
                xa[m] = __builtin_nontemporal_load((const f32x4*)(X + off)); xb[m] = __builtin_nontemporal_load((const f32x4*)(X + off + 4)); }
        };
        auto calcq = [&](int bj, int ai, v4u (&w)[4]) { const int c = col0 + bj * 128;
            const f32x4 ga = *(const f32x4*)(g1 + c), gb = *(const f32x4*)(g1 + c + 4);
#pragma unroll
            for (int m = 0; m < 4; ++m) { const f32x4 ha = xa[m] + ga * acc[ai][bj][m][0], hb = xb[m] + gb * acc[ai][bj][m][1];
                w[m].x = pk2(ha.x, ha.y); w[m].y = pk2(ha.z, ha.w); w[m].z = pk2(hb.x, hb.y); w[m].w = pk2(hb.z, hb.w); }
        };
        auto storeq = [&](int bj, int ai, const v4u (&w)[4]) {
#pragma unroll
            for (int m = 0; m < 4; ++m) *(v4u*)(H + (size_t)(row0 + ai * 128 + m * 16) * D + col0 + bj * 128) = w[m];
        };
        loadq(0, 0); calcq(0, 0, wA); loadq(0, 1); storeq(0, 0, wA); calcq(0, 1, wB); loadq(1, 0); storeq(0, 1, wB); calcq(1, 0, wA); loadq(1, 1); storeq(1, 0, wA); calcq(1, 1, wB); storeq(1, 1, wB);
    }
};
struct EpiUp {
    static constexpr bool PERM = true, AFTER_DRAIN = false, KHOOK = false;
    unsigned char* HDN;
    DI void operator()(const pg8::f32x4 (&acc)[2][2][4][2], const pg8::Unit& u, int wr, int wc, int fr, int fq) const {
        const int j = u.pn & 3, row0 = u.pm * 256 + wr * 64 + fr, col0 = j * 128 + wc * 16 + fq * 4;
#pragma unroll
        for (int ai = 0; ai < 2; ++ai)
#pragma unroll
            for (int m = 0; m < 4; ++m) { unsigned char* rowp = HDN + (size_t)(row0 + ai * 128 + m * 16) * DFF + col0;
#pragma unroll
                for (int bj = 0; bj < 2; ++bj) { const pg8::f32x4 a = acc[ai][bj][m][0], b = acc[ai][bj][m][1];
                    *(unsigned*)(rowp + bj * 64) = pk4_fp8(siluf_(a[0]) * b[0], siluf_(a[1]) * b[1], siluf_(a[2]) * b[2], siluf_(a[3]) * b[3]); } }
    }
};
struct EpiDown {
    static constexpr bool PERM = true, AFTER_DRAIN = false, KHOOK = false;
    unsigned char* Y;
    DI void operator()(const pg8::f32x4 (&acc)[2][2][4][2], const pg8::Unit& u, int wr, int wc, int fr, int fq) const {
        const int j = u.pn & 3, row0 = u.pm * 256 + wr * 64 + fr, col0 = j * 256 + wc * 32 + fq * 8;
#pragma unroll
        for (int ai = 0; ai < 2; ++ai)
#pragma unroll
            for (int m = 0; m < 4; ++m) { unsigned char* rowp = Y + (size_t)(row0 + ai * 128 + m * 16) * D + col0;
#pragma unroll
                for (int bj = 0; bj < 2; ++bj) { const pg8::f32x4 v0 = acc[ai][bj][m][0] * 16.0f, v1 = acc[ai][bj][m][1] * 16.0f;
                    v2u w; w.x = pk4_fp8(v0[0], v0[1], v0[2], v0[3]); w.y = pk4_fp8(v1[0], v1[1], v1[2], v1[3]);
                    *(v2u*)(rowp + bj * 128) = w; } }
    }
};
struct MoeOrder {
    const LAS int* tb; int G, c, total, reps; const LAS int* tokl;
    DI bool next(int i, pg8::Unit& u) const {
        const int full = total / G, rem = total - full * G;
        int uu;
        if (i < full) uu = i * G + c;
        else if (i == full) { const int gx = G >> 3, x = c / gx, j = c - x * gx; const int s = (j >> 2) * 32 + x * 4 + (j & 3); if (s >= rem) return false; uu = full * G + s; }
        else return false;
        const int T = uu >> 2; int e = 0;
        while (e < NE - 1 && tb[e + 1] <= T) ++e;
        u.pm = T; u.pn = 4 * e + (uu & 3); return true;
    }
    DI void a_ready(const pg8::Unit&) const {}
    DI void done(const pg8::Unit&) const {}
};

struct OneUnit { pg8::Unit u;
    DI bool next(int i, pg8::Unit& o) const { if (i != 0) return false; o = u; return true; }
    DI void a_ready(const pg8::Unit&) const {}
    DI void done(const pg8::Unit&) const {} };

template <class SrcF>
DI void transpose_item(SrcF src, int K, bf16* WT, LAS float* scr, int kb, int n0, int lane) {
    const int k0 = 64 * kb;
#pragma unroll 8
    for (int i = 0; i < 32; ++i) { const int kk = 2 * i + (lane >> 5); scr[kk * 33 + (lane & 31)] = src(k0 + kk, n0 + (lane & 31)); }
    LDS_WAIT(); asm volatile("" ::: "memory");
    const int c = lane & 7;
#pragma unroll
    for (int j = 0; j < 4; ++j) { const int n = (lane >> 3) + 8 * j; const LAS float* s = scr + (8 * c) * 33 + n;
        v4u o; o.x = pk2(s[0 * 33], s[1 * 33]); o.y = pk2(s[2 * 33], s[3 * 33]); o.z = pk2(s[4 * 33], s[5 * 33]); o.w = pk2(s[6 * 33], s[7 * 33]);
        *(v4u*)(WT + (size_t)(n0 + n) * K + k0 + 8 * c) = o; }
    LDS_WAIT(); asm volatile("" ::: "memory");
}

template <class SrcF>
DI void transpose_item8(SrcF src, int K, unsigned char* WT, LAS float* scr, int kb, int n0, int lane) {
    const int k0 = 64 * kb;
#pragma unroll 8
    for (int i = 0; i < 32; ++i) { const int kk = 2 * i + (lane >> 5); scr[kk * 33 + (lane & 31)] = src(k0 + kk, n0 + (lane & 31)) * 64.0f; }
    LDS_WAIT(); asm volatile("" ::: "memory");
#pragma unroll
    for (int i = 0; i < 2; ++i) { const int p = lane + 64 * i, n = p >> 2, c = p & 3; const LAS float* s = scr + (16 * c) * 33 + n;
        v4u o; o.x = pk4_fp8(s[0 * 33], s[1 * 33], s[2 * 33], s[3 * 33]); o.y = pk4_fp8(s[4 * 33], s[5 * 33], s[6 * 33], s[7 * 33]);
        o.z = pk4_fp8(s[8 * 33], s[9 * 33], s[10 * 33], s[11 * 33]); o.w = pk4_fp8(s[12 * 33], s[13 * 33], s[14 * 33], s[15 * 33]);
        *(v4u*)(WT + (size_t)(n0 + n) * K + k0 + 16 * c) = o; }
    LDS_WAIT(); asm volatile("" ::: "memory");
}

template <class SrcF>
DI void transpose_item_i8(SrcF src, float inv, int K, unsigned char* WT, LAS float* scr, int kb, int n0, int lane) {
    const int k0 = 64 * kb;
#pragma unroll 8
    for (int i = 0; i < 32; ++i) { const int kk = 2 * i + (lane >> 5); scr[kk * 33 + (lane & 31)] = src(k0 + kk, n0 + (lane & 31)) * inv; }
    LDS_WAIT(); asm volatile("" ::: "memory");
#pragma unroll
    for (int i = 0; i < 2; ++i) { const int p = lane + 64 * i, n = p >> 2, c = p & 3; const LAS float* s = scr + (16 * c) * 33 + n;
        v4u o; o.x = pk4_i8(s[0 * 33], s[1 * 33], s[2 * 33], s[3 * 33]); o.y = pk4_i8(s[4 * 33], s[5 * 33], s[6 * 33], s[7 * 33]);
        o.z = pk4_i8(s[8 * 33], s[9 * 33], s[10 * 33], s[11 * 33]); o.w = pk4_i8(s[12 * 33], s[13 * 33], s[14 * 33], s[15 * 33]);
        *(v4u*)(WT + (size_t)(n0 + n) * K + k0 + 16 * c) = o; }
    LDS_WAIT(); asm volatile("" ::: "memory");
}

DI void ph0_prologue(const Ctx& F, const Args& a, int reps) {
    const int gw = F.vcu * NWAVES + F.wave, NGW = F.G * NWAVES, lane = lane_id();
    float* mod = (float*)(F.ws + WS_CTL) + CW_MOD;
    {
        const float* cvec = ARG(I_C); const float* wada = ARG(I_WADA); const float* bada = ARG(I_BADA);
        const int r8 = lane >> 3, c4 = lane & 7;
        for (int item0 = gw; item0 < 768 * reps; item0 += NGW) {
            const int item = item0 % 768; const int cc = item % 192, kq = item / 192;
            f32x4 acc = {0.f, 0.f, 0.f, 0.f};
#pragma unroll 8
            for (int i = 0; i < 32; ++i) { const int k = kq * 256 + i * 8 + r8; const float cv = cvec[k]; const float s = siluf_(cv);
                const f32x4 w = *(const f32x4*)(wada + (size_t)k * (6 * D) + cc * 32 + c4 * 4); acc += s * w; }
#pragma unroll
            for (int j = 0; j < 4; ++j) { float v = acc[j]; v += __shfl_xor(v, 8); v += __shfl_xor(v, 16); v += __shfl_xor(v, 32); acc[j] = v; }
            if (lane < 8) {
#pragma unroll
                for (int j = 0; j < 4; ++j) { float v = acc[j]; if (kq == 0) v += bada[cc * 32 + c4 * 4 + j]; mod[kq * 6144 + cc * 32 + c4 * 4 + j] = v; }
            }
        }
    }
    LAS float* scr = (LAS float*)(F.lds + F.wave * 16384);
    const float* win = ARG(I_WIN); const float* wcv = ARG(I_WCV); const float* wmix = ARG(I_WMIX); const float* wssm = ARG(I_WSSM);
    bf16* Win_t = (bf16*)(F.ws + WS_WIN); bf16* Wdt_t = (bf16*)(F.ws + WS_WDT); bf16* Wcv_t = (bf16*)(F.ws + WS_WCV);
    bf16* Wmix_t = (bf16*)(F.ws + WS_WMIX); bf16* Wssm_t = (bf16*)(F.ws + WS_WSSM);
    constexpr int I_IN = 16 * 288, I_DT = 16, I_CV = 16 * 32, I_MX = 16 * 32, I_SS = 32 * 32, I_RT = 16 * 3;
    constexpr int NITEMS = I_IN + I_DT + I_CV + I_MX + I_SS + I_RT;
    const float* wer = ARG(I_WER); const float* wgrp = ARG(I_WGRP); const float* sng0 = ARG(I_SNG);
    for (int it0 = gw; it0 < NITEMS * reps; it0 += NGW) {
        int r = it0 % NITEMS;
        if (r < I_IN) { const int kb = r / 288, nb = r % 288;
            const int npp = nb * 32 + (lane & 31), col = win_col(npp);
            float mx = 0.f;
#pragma unroll 8
            for (int i = 0; i < 32; ++i) mx = __builtin_fmaxf(mx, __builtin_fabsf(win[(size_t)(64 * kb + 2 * i + (lane >> 5)) * WIN_LD + col]));
            mx = __builtin_fmaxf(mx, __shfl_xor(mx, 32));
            if (lane < 32) atomicMax((unsigned*)(F.ws + WS_CTL) + CW_WMAX + npp, __float_as_uint(mx));
            continue; } r -= I_IN;
        if (r < I_DT) { transpose_item([&](int k, int np) -> float { return win[(size_t)k * WIN_LD + 7168 + np]; }, D, Wdt_t, scr, r, 0, lane); continue; } r -= I_DT;
        if (r < I_CV) { transpose_item([&](int k, int np) -> float { return wcv[(size_t)k * D + np]; }, D, Wcv_t, scr, r / 32, (r % 32) * 32, lane); continue; } r -= I_CV;
        if (r < I_MX) { transpose_item([&](int k, int np) -> float { return wmix[(size_t)k * D + np]; }, D, Wmix_t, scr, r / 32, (r % 32) * 32, lane); continue; } r -= I_MX;
        if (r < I_SS) { transpose_item8([&](int k, int np) -> float { return wssm[(size_t)k * D + np] * sng0[k]; }, DIN, (unsigned char*)Wssm_t, scr, r / 32, (r % 32) * 32, lane); continue; } r -= I_SS;
        {
            const int kb = r / 3, nb = r % 3;
            auto wsrc = [&](int k, int np) -> float { float w = 0.f; if (np < 64) w = wer[(size_t)k * NE + np]; else if (np < 72) w = wgrp[(size_t)k * 8 + (np - 64)]; return w; };
            transpose_item(wsrc, D, (bf16*)(F.ws + WS_WRH), scr, kb, nb * 32, lane);
        }
    }
}

DI void convert_experts(const Ctx& F, const Args& a) {
    const int gw = F.vcu * NWAVES + F.wave, NGW = F.G * NWAVES, lane = lane_id();
    LAS float* scr = (LAS float*)(F.lds + F.wave * 17408);
    const float* w1 = ARG(I_W1); const float* w3 = ARG(I_W3); const float* w2 = ARG(I_W2);
    unsigned char* W13_t = F.ws + WS_W13; unsigned char* W2_t = F.ws + WS_W2;
    constexpr int I_13 = NE * 4 * 16, I_2 = NE * 2 * 16, NIT = I_13 + I_2;
    const int ch = lane & 15, kq = lane >> 4;
    for (int it = gw; it < NIT; it += NGW) {
        const float* src; size_t ld; unsigned char* dst;
        if (it < I_13) { const int e = it >> 6, r = it & 63, kb = r >> 4, cb = r & 15;
            src = ((ch & 1) ? w3 : w1) + (size_t)e * D * DFF + (size_t)(256 * kb + kq) * DFF + 32 * cb + 4 * (ch >> 1); ld = DFF;
            dst = W13_t + (size_t)e * D * D + (size_t)(64 * cb + lane) * D + 256 * kb;
        } else { const int r0 = it - I_13, e = r0 >> 5, r = r0 & 31, kb = r >> 4, nb = r & 15;
            src = w2 + (size_t)e * DFF * D + (size_t)(256 * kb + kq) * D + 64 * nb + 4 * ch; ld = D;
            dst = W2_t + (size_t)e * D * DFF + (size_t)(64 * nb + lane) * DFF + 256 * kb;
        }
        f32x4 va[16], vb[16]; v4u o[16];
#pragma unroll
        for (int i = 0; i < 16; ++i) va[i] = __builtin_nontemporal_load((const f32x4*)(src + (size_t)(4 * i) * ld));
#pragma unroll
        for (int sub = 0; sub < 4; ++sub) {
            f32x4 (&cur)[16] = (sub & 1) ? vb : va; f32x4 (&nxt)[16] = (sub & 1) ? va : vb;
            if (sub < 3) {
#pragma unroll
                for (int i = 0; i < 16; ++i) nxt[i] = __builtin_nontemporal_load((const f32x4*)(src + (size_t)(64 * (sub + 1) + 4 * i) * ld));
            }
#pragma unroll
            for (int i = 0; i < 16; ++i) *(LAS f32x4*)(scr + (4 * i + kq) * 68 + 4 * ch) = cur[i] * 64.0f;
            LDS_WAIT(); asm volatile("" ::: "memory");
#pragma unroll
            for (int j = 0; j < 4; ++j) {
                unsigned w[4];
#pragma unroll
                for (int q = 0; q < 4; ++q) { const LAS float* sp = scr + (16 * j + 4 * q) * 68 + lane; w[q] = pk4_fp8(sp[0], sp[68], sp[136], sp[204]); }
                o[4 * sub + j].x = w[0]; o[4 * sub + j].y = w[1]; o[4 * sub + j].z = w[2]; o[4 * sub + j].w = w[3];
            }
            LDS_WAIT(); asm volatile("" ::: "memory");
        }
#pragma unroll
        for (int j = 0; j < 16; ++j) *(v4u*)(dst + 16 * j) = o[j];
    }
}

DI void ph1_norm_dt(const Ctx& F, const Args& a) {
    const float* mod = (const float*)(F.ws + WS_CTL) + CW_MOD;
    const float* x = ARG(I_X); const float* n1g = ARG(I_N1G); const float* dtb = ARG(I_DTB);
    bf16* XN = (bf16*)(F.ws + WS_XN); const bf16* Wdt_t = (const bf16*)(F.ws + WS_WDT); float* DT = (float*)(F.ws + WS_DT);
    const int lane = lane_id(), wave = F.wave;
    f32x4 gm[4], ga[4];
#pragma unroll
    for (int j = 0; j < 4; ++j) { const int k = 256 * j + 4 * lane; const f32x4 g = *(const f32x4*)(n1g + k), sc = mod4(mod, 1024 + k);
        gm[j] = g * (sc + 1.0f); ga[j] = mod4(mod, k); }
    if (F.vcu == 0) { float* modc = (float*)(F.ws + WS_CTL) + CW_MODC; for (int k = (F.wave * 64 + lane_id()) * 4; k < 6 * D; k += NTHREADS * 4) *(f32x4*)(modc + k) = mod4(mod, k); }
    for (int unit = F.vcu; unit < M / 64; unit += F.G) {
        const int row0 = unit * 64;
#pragma unroll 1
        for (int rh = 0; rh < 2; ++rh) {
            f32x4 v[4][4];
#pragma unroll
            for (int rr = 0; rr < 4; ++rr)
#pragma unroll
                for (int j = 0; j < 4; ++j) v[rr][j] = __builtin_nontemporal_load((const f32x4*)(x + (size_t)(row0 + wave * 8 + rh * 4 + rr) * D + 256 * j + 4 * lane));
#pragma unroll
            for (int rr = 0; rr < 4; ++rr) {
                const int rl = wave * 8 + rh * 4 + rr, row = row0 + rl; float ss = 0.f;
#pragma unroll
                for (int j = 0; j < 4; ++j) ss += (v[rr][j].x * v[rr][j].x + v[rr][j].y * v[rr][j].y) + (v[rr][j].z * v[rr][j].z + v[rr][j].w * v[rr][j].w);
                const float rstd = 1.0f / sqrtf(wave_sum(ss) * (1.0f / D) + EPS);
                float am = 0.f;
#pragma unroll
                for (int j = 0; j < 4; ++j) { const f32x4 n = v[rr][j] * rstd * gm[j] + ga[j]; v[rr][j] = n;
                    am = __builtin_fmaxf(__builtin_fmaxf(am, __builtin_fmaxf(__builtin_fabsf(n.x), __builtin_fabsf(n.y))), __builtin_fmaxf(__builtin_fabsf(n.z), __builtin_fabsf(n.w)));
                    v2u w; w.x = pk2(n.x, n.y); w.y = pk2(n.z, n.w);
                    const int chunk = (32 * j + (lane >> 1)) ^ (rl & 15);
                    *(LAS v2u*)(F.lds + rl * 2048 + chunk * 16 + 8 * (lane & 1)) = w; }
#pragma unroll
                for (int o = 1; o < 64; o <<= 1) am = __builtin_fmaxf(am, __shfl_xor(am, o));
                const float inv = am > 0.f ? 127.0f / am : 0.f;
#pragma unroll
                for (int j = 0; j < 4; ++j) *(unsigned*)(F.ws + WS_XN8 + (size_t)row * D + 256 * j + 4 * lane) = pk4_i8(v[rr][j].x * inv, v[rr][j].y * inv, v[rr][j].z * inv, v[rr][j].w * inv);
                if (lane == 0) ((float*)(F.ws + WS_SA))[row] = am * (1.0f / 127.0f);
            }
        }
        __syncthreads();
        {
            const int rt = wave & 3, ct = wave >> 2, fr = lane & 15, fq = lane >> 4;
            pg8::f32x4 acc = {0.f, 0.f, 0.f, 0.f};
            const bf16* wrow = Wdt_t + (size_t)(16 * ct + fr) * D + 8 * fq;
#pragma unroll 4
            for (int ks = 0; ks < 32; ++ks) {
                const bf16x8 av = *(const LAS bf16x8*)(F.lds + (16 * rt + fr) * 2048 + (((4 * ks + fq) ^ fr) * 16));
                const bf16x8 bv = *(const bf16x8*)(wrow + 32 * ks);
                acc = __builtin_amdgcn_mfma_f32_16x16x32_bf16(av, bv, acc, 0, 0, 0);
            }
            const float bias = dtb[16 * ct + fr];
#pragma unroll
            for (int r = 0; r < 4; ++r) { const float v = acc[r] + bias; const float sp = v > 20.f ? v : log1pf(__expf(v));
                DT[(size_t)(row0 + 16 * rt + 4 * fq + r) * NH + 16 * ct + fr] = sp; }
        }
        __syncthreads();
    }
    {
        const float* win = ARG(I_WIN); const unsigned* wmax = (const unsigned*)(F.ws + WS_CTL) + CW_WMAX;
        const int gw = F.vcu * NWAVES + F.wave, NGW = F.G * NWAVES;
        LAS float* scr = (LAS float*)(F.lds + F.wave * 16384);
        for (int r = gw; r < 16 * 288; r += NGW) { const int kb = r / 288, nb = r % 288;
            const int npp = nb * 32 + (lane & 31), col = win_col(npp);
            const float mx = __uint_as_float(wmax[npp]); const float inv = mx > 0.f ? 127.0f / mx : 0.f;
            if (kb == 0 && lane < 32) ((float*)(F.ws + WS_SW))[npp] = mx * (1.0f / 127.0f);
            transpose_item_i8([&](int k, int) -> float { return win[(size_t)k * WIN_LD + col]; }, inv, D, F.ws + WS_W8IN, scr, kb, nb * 32, lane);
        }
    }
}

DI void ph3_convbranch(const Ctx& F, const Args& a, int reps) {
    const bf16* U = (const bf16*)(F.ws + WS_U); bf16* UC = (bf16*)(F.ws + WS_XN);
    const float* cw = ARG(I_CVW); const float* cb = ARG(I_CVB); const float* lg = ARG(I_LNG); const float* lb = ARG(I_LNB);
    const int tid = F.wave * 64 + lane_id(), lane = lane_id(), wave = F.wave;
    LAS unsigned char* tile = F.lds;
    LAS float* red = (LAS float*)(F.lds + 62 * 2048);
    LAS float* stat = red + 32 * 8 * 2;
    f2v w[31];
#pragma unroll
    for (int j = 0; j < 31; ++j) w[j] = *(const f2v*)(cw + j * D + 2 * tid);
    const f2v bias = *(const f2v*)(cb + 2 * tid), gam = *(const f2v*)(lg + 2 * tid), bet = *(const f2v*)(lb + 2 * tid);
    const int RU = (M / 32 + F.G - 1) / F.G;
    for (int it = 0; it < RU * reps; ++it) {
        const int unit = xcd_unit(F.xcd, F.xj, F.G >> 3, (it >= RU ? it - RU : it), M / 32); if (unit < 0) break; const int t0 = unit * 32;
        {
            v4u v[16];
#pragma unroll
            for (int i = 0; i < 16; ++i) { const int piece = tid + i * NTHREADS, r = piece >> 7, cch = piece & 127, t = t0 - 30 + r;
                v[i] = (v4u){0u, 0u, 0u, 0u}; if (piece < 62 * 128 && t >= 0) v[i] = *(const v4u*)(U + (size_t)t * D + cch * 8); }
#pragma unroll
            for (int i = 0; i < 16; ++i) { const int piece = tid + i * NTHREADS, r = piece >> 7, cch = piece & 127;
                if (piece < 62 * 128) *(LAS v4u*)(tile + r * 2048 + cch * 16) = v[i]; }
        }
        __syncthreads();
        f2v o[32];
#pragma unroll
        for (int tg = 0; tg < 8; ++tg) {
            f2v acc[4];
#pragma unroll
            for (int i = 0; i < 4; ++i) acc[i] = bias;
#pragma unroll
            for (int j = 0; j < 34; ++j) {
                const unsigned uu = *(const LAS unsigned*)(tile + (4 * tg + j) * 2048 + tid * 4);
                const f2v u2 = {bflo(uu), bfhi(uu)};
#pragma unroll
                for (int i = 0; i < 4; ++i) { const int jj = j - i; if (jj >= 0 && jj <= 30) acc[i] = __builtin_elementwise_fma(w[jj], u2, acc[i]); }
            }
#pragma unroll
            for (int i = 0; i < 4; ++i) o[4 * tg + i] = acc[i];
        }
        {
            float r5[64];
#pragma unroll
            for (int tk = 0; tk < 32; ++tk) { r5[2 * tk] = o[tk].x + o[tk].y; r5[2 * tk + 1] = o[tk].x * o[tk].x + o[tk].y * o[tk].y; }
            float r4[32], r3[16], r2[8], r1[4], r0[2];
            { const bool up = (lane & 32) != 0;
#pragma unroll
              for (int i = 0; i < 32; ++i) { const float keep = up ? r5[i + 32] : r5[i], send = up ? r5[i] : r5[i + 32]; r4[i] = keep + __shfl_xor(send, 32); } }
            { const bool up = (lane & 16) != 0;
#pragma unroll
              for (int i = 0; i < 16; ++i) { const float keep = up ? r4[i + 16] : r4[i], send = up ? r4[i] : r4[i + 16]; r3[i] = keep + __shfl_xor(send, 16); } }
            { const bool up = (lane & 8) != 0;
#pragma unroll
              for (int i = 0; i < 8; ++i) { const float keep = up ? r3[i + 8] : r3[i], send = up ? r3[i] : r3[i + 8]; r2[i] = keep + __shfl_xor(send, 8); } }
            { const bool up = (lane & 4) != 0;
#pragma unroll
              for (int i = 0; i < 4; ++i) { const float keep = up ? r2[i + 4] : r2[i], send = up ? r2[i] : r2[i + 4]; r1[i] = keep + __shfl_xor(send, 4); } }
            { const bool up = (lane & 2) != 0;
#pragma unroll
              for (int i = 0; i < 2; ++i) { const float keep = up ? r1[i + 2] : r1[i], send = up ? r1[i] : r1[i + 2]; r0[i] = keep + __shfl_xor(send, 2); } }
            const bool up0 = (lane & 1) != 0;
            const float tot = (up0 ? r0[1] : r0[0]) + __shfl_xor(up0 ? r0[0] : r0[1], 1);
            red[((lane >> 1) * 8 + wave) * 2 + (lane & 1)] = tot;
        }
        __syncthreads();
        if (tid < 32) { float s = 0.f, q = 0.f;
#pragma unroll
            for (int wv = 0; wv < 8; ++wv) { s += red[(tid * 8 + wv) * 2]; q += red[(tid * 8 + wv) * 2 + 1]; }
            const float mean = s * (1.0f / D); const float var = fmaxf(q * (1.0f / D) - mean * mean, 0.f);
            stat[tid * 2] = mean; stat[tid * 2 + 1] = 1.0f / sqrtf(var + EPS); }
        __syncthreads();
#pragma unroll
        for (int tk = 0; tk < 32; ++tk) { const float mean = stat[tk * 2], rstd = stat[tk * 2 + 1];
            const float y0 = (o[tk].x - mean) * rstd * gam.x + bet.x, y1 = (o[tk].y - mean) * rstd * gam.y + bet.y;
            *(unsigned*)(UC + (size_t)(t0 + tk) * D + 2 * tid) = pk2(siluf_(y0), siluf_(y1)); }
        __syncthreads();
    }
}

DI __amdgpu_buffer_rsrc_t xbc_rsrc(const bf16* XBC) { return __builtin_amdgcn_make_buffer_rsrc((void*)((const char*)XBC - 3 * XBCW * 2), 0, (M + 3) * XBCW * 2, 0x00020000); }
DI void conv_load(__amdgpu_buffer_rsrc_t rs, int t_first, int col, v4u (&raw)[11]) {
    const unsigned voff = (unsigned)(t_first * (XBCW * 2) + col * 2);
#pragma unroll
    for (int r = 0; r < 11; ++r) { v4u v = __builtin_amdgcn_raw_buffer_load_b128(rs, voff, r * (XBCW * 2), 0);
        const unsigned msk = (t_first - 3 + r) < 0 ? 0u : 0xffffffffu; v.x &= msk; v.y &= msk; v.z &= msk; v.w &= msk; raw[r] = v; }
}
DI void conv_compute(const v4u (&raw)[11], const float* cw, const float* cb, int col, float (&o)[8][8]) {
    float w[4][8], b[8];
#pragma unroll
    for (int j = 0; j < 4; ++j) { const f32x4 lo = *(const f32x4*)(cw + j * XBCW + col), hi = *(const f32x4*)(cw + j * XBCW + col + 4);
        w[j][0] = lo.x; w[j][1] = lo.y; w[j][2] = lo.z; w[j][3] = lo.w; w[j][4] = hi.x; w[j][5] = hi.y; w[j][6] = hi.z; w[j][7] = hi.w; }
    { const f32x4 lo = *(const f32x4*)(cb + col), hi = *(const f32x4*)(cb + col + 4); b[0] = lo.x; b[1] = lo.y; b[2] = lo.z; b[3] = lo.w; b[4] = hi.x; b[5] = hi.y; b[6] = hi.z; b[7] = hi.w; }
#pragma unroll
    for (int tk = 0; tk < 8; ++tk)
#pragma unroll
        for (int ch = 0; ch < 8; ++ch) {
            float acc = b[ch];
#pragma unroll
            for (int j = 0; j < 4; ++j) { const unsigned wd = raw[tk + j][ch >> 1]; const float xv = (ch & 1) ? bfhi(wd) : bflo(wd); acc += w[j][ch] * xv; }
            o[tk][ch] = siluf_(acc);
        }
}
DI void conv_block(const bf16* XBC, const float* cw, const float* cb, int t_first, int col, float (&o)[8][8]) {
    v4u raw[11]; conv_load(xbc_rsrc(XBC), t_first, col, raw); conv_compute(raw, cw, cb, col, o);
}
DI float head_scan(const float* DT, const float* alog, int t0, int h, int lane, LAS float* acs_h, LAS float* dtv_h, float& d0o, float& d1o, float& c0o, float& c1o) {
    const float d0 = DT[(size_t)(t0 + 2 * lane) * NH + h], d1 = DT[(size_t)(t0 + 2 * lane + 1) * NH + h];
    const float A2 = -__expf(alog[h]) * LOG2E;
    const float a0 = d0 * A2, a1 = d1 * A2; float inc = a0 + a1;
#pragma unroll
    for (int o = 1; o < 64; o <<= 1) { const float t = __shfl_up(inc, o); if (lane >= o) inc += t; }
    acs_h[2 * lane] = inc - a1; acs_h[2 * lane + 1] = inc; dtv_h[2 * lane] = d0; dtv_h[2 * lane + 1] = d1;
    d0o = d0; d1o = d1; c0o = inc - a1; c1o = inc;
    return __shfl(inc, 63);
}

constexpr int S_CN = 0, S_BN = 32768, S_XT = 65536, S_ACS = 131072, S_DTV = 135168, S_SSQ = 139264, S_FS = 139776;

DI void ph3_chunk_states(const Ctx& F, const Args& a, int reps) {
    const bf16* XBC = (const bf16*)(F.ws + WS_XBC); const float* DT = (const float*)(F.ws + WS_DT);
    bf16* ST = (bf16*)(F.ws + WS_ST); float* CD = (float*)(F.ws + WS_CD);
    const float* scw = ARG(I_SCW); const float* scb = ARG(I_SCB); const float* alog = ARG(I_ALOG);
    const int tid = F.wave * 64 + lane_id(), lane = lane_id(), wave = F.wave, hh = lane >> 5;
    LAS unsigned char* lds = F.lds;
    LAS float* acs = (LAS float*)(lds + S_ACS); LAS float* wsc = (LAS float*)(lds + S_DTV);
    const int RU = (NCH * NGRP + F.G - 1) / F.G;
    for (int it = 0; it < RU * reps; ++it) {
        const int unit = xcd_unit(F.xcd, F.xj, F.G >> 3, (it >= RU ? it - RU : it), NCH * NGRP); if (unit < 0) break; const int c = unit >> 2, g = unit & 3, t0 = c * LCH;
        {
            const int h = 8 * g + wave; float d0, d1, c0, c1;
            const float total = head_scan(DT, alog, t0, h, lane, acs + wave * 128, wsc + wave * 128, d0, d1, c0, c1);
            wsc[wave * 128 + 2 * lane] = d0 * __builtin_amdgcn_exp2f(total - c0); wsc[wave * 128 + 2 * lane + 1] = d1 * __builtin_amdgcn_exp2f(total - c1);
            if (lane == 0) CD[c * NH + h] = __builtin_amdgcn_exp2f(total);
        }
        __syncthreads();
        if (tid < 256) { const int co = tid & 15, to = tid >> 4; float o[8][8];
            conv_block(XBC, scw, scb, t0 + 8 * to, 2048 + 128 * g + 8 * co, o);
#pragma unroll
            for (int ch = 0; ch < 8; ++ch) { const int nn = 8 * co + ch, row = 32 * (nn & 3) + (nn >> 2);
                v4u w; w.x = pk2(o[0][ch], o[1][ch]); w.y = pk2(o[2][ch], o[3][ch]); w.z = pk2(o[4][ch], o[5][ch]); w.w = pk2(o[6][ch], o[7][ch]);
                *(LAS v4u*)(lds + S_BN + row * 256 + swz(row, to) * 16) = w; } }
        for (int ps = 0; ps < 2; ++ps) {
            {
                const int co = tid & 31, to = tid >> 5, hd = co >> 3, p0 = (co & 7) * 8; float o[8][8];
                conv_block(XBC, scw, scb, t0 + 8 * to, 512 * g + 64 * (4 * ps + hd) + p0, o);
                float sc[8];
#pragma unroll
                for (int tk = 0; tk < 8; ++tk) sc[tk] = wsc[(4 * ps + hd) * 128 + 8 * to + tk];
#pragma unroll
                for (int ch = 0; ch < 8; ++ch) { const int row = hd * 64 + p0 + ch;
                    v4u w; w.x = pk2(o[0][ch] * sc[0], o[1][ch] * sc[1]); w.y = pk2(o[2][ch] * sc[2], o[3][ch] * sc[3]);
                    w.z = pk2(o[4][ch] * sc[4], o[5][ch] * sc[5]); w.w = pk2(o[6][ch] * sc[6], o[7][ch] * sc[7]);
                    *(LAS v4u*)(lds + S_XT + row * 256 + swz(row, to) * 16) = w; }
            }
            __syncthreads();
            {
                const int hd = wave & 3, ph = wave >> 2, h = 8 * g + 4 * ps + hd;
                f32x16 acc[4];
#pragma unroll
                for (int nt = 0; nt < 4; ++nt)
#pragma unroll
                    for (int i = 0; i < 16; ++i) acc[nt][i] = 0.f;
                const int arow = hd * 64 + 32 * ph + (lane & 31);
#pragma unroll
                for (int ks = 0; ks < 8; ++ks) {
                    const bf16x8 av = *(const LAS bf16x8*)(lds + S_XT + arow * 256 + swz(arow, 2 * ks + hh) * 16);
#pragma unroll
                    for (int nt = 0; nt < 4; ++nt) { const int brow = 32 * nt + (lane & 31);
                        const bf16x8 bv = *(const LAS bf16x8*)(lds + S_BN + brow * 256 + swz(brow, 2 * ks + hh) * 16);
                        acc[nt] = MFMA32(av, bv, acc[nt]); }
                }
                unsigned char* dst = (unsigned char*)ST + ((size_t)(c * NH + h) * HD) * NST;
#pragma unroll
                for (int i = 0; i < 16; ++i) { const int p = 32 * ph + crow(i, hh);
                    *(unsigned*)(dst + (size_t)p * NST + 4 * (lane & 31)) = pk4_fp8(acc[0][i], acc[1][i], acc[2][i], acc[3][i]); }
            }
            __syncthreads();
        }
    }
}

DI void ph4_scan(const Ctx& F, size_t dst_off) {
    unsigned short* ST16 = (unsigned short*)(F.ws + WS_ST); unsigned short* DST16 = (unsigned short*)(F.ws + dst_off); const float* CD = (const float*)(F.ws + WS_CD);
    constexpr int NPAIR = NH * HD * NST / 2;
    for (int e = F.vcu * NTHREADS + (F.wave * 64 + lane_id()); e < NPAIR; e += F.G * NTHREADS) {
        const int h = e >> 12; float c0 = 0.f, c1 = 0.f;
#pragma unroll 1
        for (int cb = 0; cb < NCH; cb += 32) {
            unsigned v[32]; float dec[32];
#pragma unroll
            for (int i = 0; i < 32; ++i) { v[i] = __builtin_nontemporal_load(ST16 + (size_t)(cb + i) * NPAIR + e); dec[i] = CD[(cb + i) * NH + h]; }
#pragma unroll
            for (int i = 0; i < 32; ++i) { DST16[(size_t)(cb + i) * NPAIR + e] = (unsigned short)pk2_fp8(c0, c1);
                c0 = c0 * dec[i] + __builtin_amdgcn_cvt_f32_fp8(v[i], 0); c1 = c1 * dec[i] + __builtin_amdgcn_cvt_f32_fp8(v[i], 1); }
        }
    }
}

DI void ph5_ssd_out(const Ctx& F, const Args& a, int reps) {
    const bf16* XBC = (const bf16*)(F.ws + WS_XBC); const float* DT = (const float*)(F.ws + WS_DT);
    const bf16* ST = (const bf16*)(F.ws + WS_ST); const bf16* ZS = (const bf16*)(F.ws + WS_ZS); bf16* YS = (bf16*)(F.ws + WS_YS);
    const float* scw = ARG(I_SCW); const float* scb = ARG(I_SCB); const float* alog = ARG(I_ALOG); const float* dskip = ARG(I_DSKIP);
    const int wave = F.wave;
    LAS unsigned char* lds = F.lds;
    LAS float* acs = (LAS float*)(lds + S_ACS); LAS float* dtv = (LAS float*)(lds + S_DTV); LAS float* ssq = (LAS float*)(lds + S_SSQ);
    const int RU = (NCH * NGRP + F.G - 1) / F.G;
    for (int it = 0; it < RU * reps; ++it) {
        int lane = lane_id(); asm volatile("" : "+v"(lane));
        const int tid = wave * 64 + lane, hh = lane >> 5, l31 = lane & 31;
        const int unit = xcd_unit(F.xcd, F.xj, F.G >> 3, (it >= RU ? it - RU : it), NCH * NGRP); if (unit < 0) break; const int c = unit >> 2, g = unit & 3, t0 = c * LCH;
        v4u cbraw[11];
        { const int which = tid >> 8, t8 = tid & 255, co = t8 & 15; int to = t8 >> 4; asm volatile("" : "+v"(to)); conv_load(xbc_rsrc(XBC), t0 + 8 * to, (which ? 2560 : 2048) + 128 * g + 8 * co, cbraw); }
        { const int h = 8 * g + wave; float d0, d1, c0, c1; (void)head_scan(DT, alog, t0, h, lane, acs + wave * 128, dtv + wave * 128, d0, d1, c0, c1);
          const float cend = __shfl(c1, (lane & 48) | 15);
          LAS float* fsw = (LAS float*)(lds + S_FS) + wave * 128;
          fsw[2 * lane] = d0 * __builtin_amdgcn_exp2f(cend - c0); fsw[2 * lane + 1] = d1 * __builtin_amdgcn_exp2f(cend - c1); }
        if (tid < 128) ssq[tid] = 0.f;
        { const int which = tid >> 8, t8 = tid & 255, co = t8 & 15; int to = t8 >> 4; asm volatile("" : "+v"(to)); float o[8][8];
            conv_compute(cbraw, scw, scb, (which ? 2560 : 2048) + 128 * g + 8 * co, o);
            const int base = which ? S_CN : S_BN;
#pragma unroll
            for (int tk = 0; tk < 8; ++tk) { const int row = 8 * to + tk;
                v4u w; w.x = pk2(o[tk][0], o[tk][1]); w.y = pk2(o[tk][2], o[tk][3]); w.z = pk2(o[tk][4], o[tk][5]); w.w = pk2(o[tk][6], o[tk][7]);
                *(LAS v4u*)(lds + base + row * 256 + swz(row, co) * 16) = w; } }
        __syncthreads();
        {
            f32x16 G0, G1;
#pragma unroll
            for (int i = 0; i < 16; ++i) { G0[i] = 0.f; G1[i] = 0.f; }
            auto gtile = [&](int tI, f32x16& G) {
                const int li = tI < 1 ? 0 : (tI < 3 ? 1 : (tI < 6 ? 2 : 3)), sj = tI - li * (li + 1) / 2;
                const int brow = 32 * sj + l31, lrow = 32 * li + l31;
#pragma unroll
                for (int ks = 0; ks < 8; ++ks) {
                    const bf16x8 av = *(const LAS bf16x8*)(lds + S_BN + brow * 256 + swz(brow, 2 * ks + hh) * 16);
                    const bf16x8 cv = *(const LAS bf16x8*)(lds + S_CN + lrow * 256 + swz(lrow, 2 * ks + hh) * 16);
                    G = MFMA32(av, cv, G); }
            };
            gtile(wave, G0); if (wave < 2) gtile(8 + wave, G1);
            __syncthreads();
            auto gstore = [&](int tI, const f32x16& G) { LAS unsigned char* gp = lds + S_BN + tI * 2048 + lane * 16;
                v4u a, b; a.x = pk2(G[0], G[1]); a.y = pk2(G[2], G[3]); a.z = pk2(G[4], G[5]); a.w = pk2(G[6], G[7]); b.x = pk2(G[8], G[9]); b.y = pk2(G[10], G[11]); b.z = pk2(G[12], G[13]); b.w = pk2(G[14], G[15]);
                *(LAS v4u*)gp = a; *(LAS v4u*)(gp + 1024) = b; };
            gstore(wave, G0); if (wave < 2) gstore(8 + wave, G1);
        }
#pragma unroll 1
        for (int ps = 0; ps < 2; ++ps) {
            v2u bst[8][2];
            {
                const int co = tid & 31; int to = tid >> 5; asm volatile("" : "+v"(to));
                const int hd = co >> 3, p0 = (co & 7) * 8; float o[8][8];
                conv_block(XBC, scw, scb, t0 + 8 * to, 512 * g + 64 * (4 * ps + hd) + p0, o);
#pragma unroll
                for (int ch = 0; ch < 8; ++ch) { const int row = hd * 64 + p0 + ch;
                    v4u w; w.x = pk2(o[0][ch], o[1][ch]); w.y = pk2(o[2][ch], o[3][ch]); w.z = pk2(o[4][ch], o[5][ch]); w.w = pk2(o[6][ch], o[7][ch]);
                    *(LAS v4u*)(lds + S_XT + row * 256 + swz(row, to) * 16) = w; }
            }
            { const unsigned char* prev0 = (const unsigned char*)ST + ((size_t)(c * NH + 8 * g + 4 * ps + (wave & 3)) * HD) * NST;
#pragma unroll
              for (int ks = 0; ks < 8; ++ks) { bst[ks][0] = *(const v2u*)(prev0 + (size_t)l31 * NST + 16 * ks + 8 * hh); bst[ks][1] = *(const v2u*)(prev0 + (size_t)(32 + l31) * NST + 16 * ks + 8 * hh); } }
            __syncthreads();
            const int hd = wave & 3, lp = wave >> 2, hl = 4 * ps + hd, h = 8 * g + hl;
            const float Dh = dskip[h];
            const LAS float* acs_h = acs + hl * 128; const LAS float* dt_h = dtv + hl * 128; const LAS float* fs_h = (const LAS float*)(lds + S_FS) + hl * 128;
            const unsigned char* prev = (const unsigned char*)ST + ((size_t)(c * NH + h) * HD) * NST;
            const int erow = lane >> 1, ehalf = lane & 1;
            f32x16 acc[2][2];
            {
#pragma unroll
                for (int which = 0; which < 2; ++which)
#pragma unroll
                    for (int pt = 0; pt < 2; ++pt)
#pragma unroll
                        for (int i = 0; i < 16; ++i) acc[which][pt][i] = 0.f;
                const int rowA = 32 * lp + l31, rowB = 32 * (3 - lp) + l31;
#pragma unroll
                for (int ks = 0; ks < 8; ++ks) {
                    const bf16x8 b0 = fp8x8_to_bf16(bst[ks][0]), b1 = fp8x8_to_bf16(bst[ks][1]);
                    const bf16x8 a0 = *(const LAS bf16x8*)(lds + S_CN + rowA * 256 + swz(rowA, 2 * ks + hh) * 16);
                    const bf16x8 a1 = *(const LAS bf16x8*)(lds + S_CN + rowB * 256 + swz(rowB, 2 * ks + hh) * 16);
                    acc[0][0] = MFMA32(a0, b0, acc[0][0]); acc[0][1] = MFMA32(a0, b1, acc[0][1]);
                    acc[1][0] = MFMA32(a1, b0, acc[1][0]); acc[1][1] = MFMA32(a1, b1, acc[1][1]);
                }
#pragma unroll
                for (int which = 0; which < 2; ++which) { const int li = which == 0 ? lp : 3 - lp;
#pragma unroll
                    for (int i = 0; i < 16; ++i) { const float e = __builtin_amdgcn_exp2f(acs_h[32 * li + crow(i, hh)]); acc[which][0][i] *= e; acc[which][1][i] *= e; } }
            }
            {
                const int liA = lp, liB = 3 - lp;
                const int rowA = 32 * liA + l31, rowB = 32 * liB + l31;
                const float alA = acs_h[rowA], alB = acs_h[rowB];
#pragma unroll 1
                for (int sj = 0; sj <= liB; ++sj) {
                    const bool doA = sj <= liA;
                    f32x16 GA, GB;
                    auto gload = [&](int li, f32x16& G) { const LAS unsigned char* gp = lds + S_BN + (li * (li + 1) / 2 + sj) * 2048 + lane * 16;
                        const v4u a = *(const LAS v4u*)gp, b = *(const LAS v4u*)(gp + 1024);
                        G[0] = bflo(a.x); G[1] = bfhi(a.x); G[2] = bflo(a.y); G[3] = bfhi(a.y); G[4] = bflo(a.z); G[5] = bfhi(a.z); G[6] = bflo(a.w); G[7] = bfhi(a.w);
                        G[8] = bflo(b.x); G[9] = bfhi(b.x); G[10] = bflo(b.y); G[11] = bfhi(b.y); G[12] = bflo(b.z); G[13] = bfhi(b.z); G[14] = bflo(b.w); G[15] = bfhi(b.w); };
                    if (doA) gload(liA, GA);
                    gload(liB, GB);
                    auto mask = [&](f32x16& G, int li, int row_l, float al) {
                        if (sj < li) {
                            const float fl = __builtin_amdgcn_exp2f(al - acs_h[32 * sj + 31]);
#pragma unroll
                            for (int i = 0; i < 16; ++i) G[i] = G[i] * (fs_h[32 * sj + crow(i, hh)] * fl);
                        } else {
#pragma unroll
                            for (int i = 0; i < 16; ++i) { const int s = 32 * sj + crow(i, hh);
                                float v = G[i] * __builtin_amdgcn_exp2f(fminf(al - acs_h[s], 0.f)) * dt_h[s];
                                v = (s > row_l) ? 0.f : v; v = (s == row_l) ? v + Dh : v; G[i] = v; }
                        }
                    };
                    auto pv = [&](const f32x16& G, f32x16 (&ac)[2]) {
#pragma unroll
                        for (int s2 = 0; s2 < 2; ++s2) {
                            v4u fa; fa.x = pk2(G[8 * s2 + 0], G[8 * s2 + 1]); fa.y = pk2(G[8 * s2 + 2], G[8 * s2 + 3]); fa.z = pk2(G[8 * s2 + 4], G[8 * s2 + 5]); fa.w = pk2(G[8 * s2 + 6], G[8 * s2 + 7]);
#pragma unroll
                            for (int pt = 0; pt < 2; ++pt) { const int xrow = hd * 64 + 32 * pt + l31; const int sc0 = 32 * sj + 16 * s2;
                                const v2u lo = *(const LAS v2u*)(lds + S_XT + xrow * 256 + swz(xrow, (sc0 >> 3)) * 16 + 8 * hh);
                                const v2u hi = *(const LAS v2u*)(lds + S_XT + xrow * 256 + swz(xrow, (sc0 >> 3) + 1) * 16 + 8 * hh);
                                v4u bfr; bfr.x = lo.x; bfr.y = lo.y; bfr.z = hi.x; bfr.w = hi.y;
                                ac[pt] = MFMA32(__builtin_bit_cast(bf16x8, fa), __builtin_bit_cast(bf16x8, bfr), ac[pt]); }
                        }
                    };
                    if (doA) { mask(GA, liA, rowA, alA); pv(GA, acc[0]); }
                    mask(GB, liB, rowB, alB); pv(GB, acc[1]);
                }
            }
            asm volatile("" ::: "memory");
            v4u zs[2][4];
#pragma unroll
            for (int which = 0; which < 2; ++which) { const int li = which == 0 ? lp : 3 - lp; const size_t t = (size_t)(t0 + 32 * li + erow);
#pragma unroll
                for (int j = 0; j < 4; ++j) zs[which][j] = *(const v4u*)(ZS + t * DIN + 64 * h + 32 * ehalf + 8 * j); }
            __syncthreads();
            {
                LAS unsigned char* stg = lds + S_XT + wave * 8192;
#pragma unroll
                for (int which = 0; which < 2; ++which)
#pragma unroll
                    for (int pt = 0; pt < 2; ++pt)
#pragma unroll
                        for (int i = 0; i < 16; ++i) *(LAS bf16*)(stg + ((which * 32 + crow(i, hh)) * 64 + 32 * pt + l31) * 2) = (bf16)(pk2(acc[which][pt][i], 0.f) & 0xffffu);
                LDS_WAIT(); asm volatile("" ::: "memory");
#pragma unroll
                for (int which = 0; which < 2; ++which) { const int li = which == 0 ? lp : 3 - lp; const int l = 32 * li + erow; const size_t t = (size_t)(t0 + l);
                    float q = 0.f; unsigned w8[8];
#pragma unroll
                    for (int j = 0; j < 4; ++j) { const v4u yv = *(const LAS v4u*)(stg + ((which * 32 + erow) * 64 + 32 * ehalf + 8 * j) * 2); const v4u zv = zs[which][j];
                        float y[8] = {bflo(yv.x) * bflo(zv.x), bfhi(yv.x) * bfhi(zv.x), bflo(yv.y) * bflo(zv.y), bfhi(yv.y) * bfhi(zv.y), bflo(yv.z) * bflo(zv.z), bfhi(yv.z) * bfhi(zv.z), bflo(yv.w) * bflo(zv.w), bfhi(yv.w) * bfhi(zv.w)};
#pragma unroll
                        for (int k = 0; k < 8; ++k) q += y[k] * y[k];
                        w8[2 * j] = pk4_fp8(y[0], y[1], y[2], y[3]); w8[2 * j + 1] = pk4_fp8(y[4], y[5], y[6], y[7]); }
                    { unsigned char* yp = (unsigned char*)YS + t * DIN + 64 * h + 32 * ehalf;
                      *(v4u*)yp = (v4u){w8[0], w8[1], w8[2], w8[3]}; *(v4u*)(yp + 16) = (v4u){w8[4], w8[5], w8[6], w8[7]}; }
                    q += __shfl_xor(q, 1);
                    if (ehalf == 0) __hip_atomic_fetch_add(ssq + l, q, __ATOMIC_RELAXED, __HIP_MEMORY_SCOPE_WORKGROUP);
                }
            }
            __syncthreads();
        }
        if (tid < 128) ((float*)(F.ws + WS_RSTD))[(size_t)(t0 + tid) * 4 + g] = 1.0f / sqrtf(ssq[tid] * (1.0f / 512.f) + EPS);
        __syncthreads();
    }
}

constexpr int RT_LD = 1028;
DI void ph8_router(const Ctx& F, const Args& a, int reps) {
    const float* mod = (const float*)(F.ws + WS_CTL) + CW_MODC;
    const bf16* H = (const bf16*)(F.ws + WS_H16); const float* n2g = ARG(I_N2G); const float* bgrp = ARG(I_BGRP); const float* ber = ARG(I_BER);
    unsigned char* XN2 = F.ws + WS_XN; int* cnt0 = (int*)(F.ws + WS_CTL) + CW_CNT;
    int* RE = (int*)(F.ws + WS_ROUTE); int* RP = RE + 2 * M; float* RW = (float*)(RP + 2 * M); int* LIST = (int*)(F.ws + WS_LIST);
    const int lane = lane_id(), wave = F.wave;
    LAS float* tile = (LAS float*)F.lds;
    LAS float* pe = (LAS float*)F.lds;
    f32x4 gm[4], ga[4];
#pragma unroll
    for (int j = 0; j < 4; ++j) { const int k = 256 * j + 4 * lane; const f32x4 g = *(const f32x4*)(n2g + k), sc = *(const f32x4*)(mod + 4096 + k);
        gm[j] = g * (sc + 1.0f); ga[j] = *(const f32x4*)(mod + 3072 + k); }
    const int RU = (M / 32 + F.G - 1) / F.G;
    for (int it = 0; it < RU * reps; ++it) {
        const int unit = xcd_unit(F.xcd, F.xj, F.G >> 3, (it >= RU ? it - RU : it), M / 32); if (unit < 0) break; int* cnt = cnt0 + ((it >= RU * (reps - 1)) ? 0 : 4096);
        const int row0 = unit * 32;
        {
            f32x4 v[4][4];
#pragma unroll
            for (int rr = 0; rr < 4; ++rr)
#pragma unroll
                for (int j = 0; j < 4; ++j) { const v2u hw = *(const v2u*)(H + (size_t)(row0 + wave * 4 + rr) * D + 256 * j + 4 * lane); v[rr][j] = (f32x4){bflo(hw.x), bfhi(hw.x), bflo(hw.y), bfhi(hw.y)}; }
#pragma unroll
            for (int rr = 0; rr < 4; ++rr) { const int rl = wave * 4 + rr, row = row0 + rl; float ss = 0.f;
#pragma unroll
                for (int j = 0; j < 4; ++j) ss += (v[rr][j].x * v[rr][j].x + v[rr][j].y * v[rr][j].y) + (v[rr][j].z * v[rr][j].z + v[rr][j].w * v[rr][j].w);
                const float rstd = 1.0f / sqrtf(wave_sum(ss) * (1.0f / D) + EPS);
#pragma unroll
                for (int j = 0; j < 4; ++j) { const f32x4 n = v[rr][j] * rstd * gm[j] + ga[j];
                    *(LAS f32x4*)(tile + rl * RT_LD + 256 * j + 4 * lane) = n;
                    *(unsigned*)(XN2 + (size_t)row * D + 256 * j + 4 * lane) = pk4_fp8(n.x, n.y, n.z, n.w); }
            }
        }
        __syncthreads();
        pg8::f32x4 acc[2][5];
#pragma unroll
        for (int rt = 0; rt < 2; ++rt)
#pragma unroll
            for (int ct = 0; ct < 5; ++ct) acc[rt][ct] = (pg8::f32x4){0.f, 0.f, 0.f, 0.f};
        const int kb = wave * 128, fr = lane & 15, kq = lane >> 4;
        const bf16* WRH = (const bf16*)(F.ws + WS_WRH);
#pragma unroll 2
        for (int ks = 0; ks < 4; ++ks) {
            const int k0 = kb + 32 * ks + 8 * kq;
            bf16x8 bh[5];
#pragma unroll
            for (int ct = 0; ct < 5; ++ct) bh[ct] = *(const bf16x8*)(WRH + (size_t)(16 * ct + fr) * D + k0);
#pragma unroll
            for (int rt = 0; rt < 2; ++rt) {
                const f32x4 x0 = *(const LAS f32x4*)(tile + (16 * rt + fr) * RT_LD + k0), x1 = *(const LAS f32x4*)(tile + (16 * rt + fr) * RT_LD + k0 + 4);
                v4u hv, lv;
                hv.x = pk2(x0.x, x0.y); hv.y = pk2(x0.z, x0.w); hv.z = pk2(x1.x, x1.y); hv.w = pk2(x1.z, x1.w);
                lv.x = pk2(x0.x - bflo(hv.x), x0.y - bfhi(hv.x)); lv.y = pk2(x0.z - bflo(hv.y), x0.w - bfhi(hv.y));
                lv.z = pk2(x1.x - bflo(hv.z), x1.y - bfhi(hv.z)); lv.w = pk2(x1.z - bflo(hv.w), x1.w - bfhi(hv.w));
                const bf16x8 ah = __builtin_bit_cast(bf16x8, hv), al = __builtin_bit_cast(bf16x8, lv);
#pragma unroll
                for (int ct = 0; ct < 5; ++ct) {
                    acc[rt][ct] = __builtin_amdgcn_mfma_f32_16x16x32_bf16(ah, bh[ct], acc[rt][ct], 0, 0, 0);
                    acc[rt][ct] = __builtin_amdgcn_mfma_f32_16x16x32_bf16(al, bh[ct], acc[rt][ct], 0, 0, 0); }
            }
        }
        __syncthreads();
#pragma unroll
        for (int rt = 0; rt < 2; ++rt)
#pragma unroll
            for (int ct = 0; ct < 5; ++ct)
#pragma unroll
                for (int r = 0; r < 4; ++r) pe[(wave * 32 + 16 * rt + 4 * kq + r) * 80 + 16 * ct + fr] = acc[rt][ct][r];
        __syncthreads();
        int e0s[4], e1s[4]; float w0s[4], w1s[4];
#pragma unroll
        for (int rr = 0; rr < 4; ++rr) { const int rl = wave * 4 + rr;
            float le = ber[lane], lgv = (lane < 8) ? bgrp[lane] : 0.f;
#pragma unroll
            for (int wv = 0; wv < 8; ++wv) { le += pe[(wv * 32 + rl) * 80 + lane]; if (lane < 8) lgv += pe[(wv * 32 + rl) * 80 + 64 + lane]; }
            float gl[8];
#pragma unroll
            for (int i = 0; i < 8; ++i) gl[i] = __shfl(lgv, i);
            int gi = 0; float gmax = gl[0];
#pragma unroll
            for (int i = 1; i < 8; ++i) if (gl[i] > gmax) { gmax = gl[i]; gi = i; }
            float den = 0.f;
#pragma unroll
            for (int i = 0; i < 8; ++i) den += __expf(gl[i] - gmax);
            const float gp = 1.0f / den;
            float el[8];
#pragma unroll
            for (int i = 0; i < 8; ++i) el[i] = __shfl(le, gi * 8 + i);
            int i0 = 0; float m0 = el[0];
#pragma unroll
            for (int i = 1; i < 8; ++i) if (el[i] > m0) { m0 = el[i]; i0 = i; }
            int i1 = -1; float m1 = -INFINITY;
#pragma unroll
            for (int i = 0; i < 8; ++i) if (i != i0 && el[i] > m1) { m1 = el[i]; i1 = i; }
            const float dd = __expf(m1 - m0);
            w0s[rr] = gp / (1.0f + dd); w1s[rr] = gp * dd / (1.0f + dd); e0s[rr] = gi * 8 + i0; e1s[rr] = gi * 8 + i1;
        }
        if (lane == 0) {
            int p0[4], p1[4];
#pragma unroll
            for (int rr = 0; rr < 4; ++rr) { p0[rr] = atomicAdd(cnt + 64 * e0s[rr], 1); p1[rr] = atomicAdd(cnt + 64 * e1s[rr], 1); }
#pragma unroll
            for (int rr = 0; rr < 4; ++rr) { const int row = row0 + wave * 4 + rr;
                RE[2 * row] = e0s[rr]; RE[2 * row + 1] = e1s[rr]; RP[2 * row] = p0[rr]; RP[2 * row + 1] = p1[rr]; RW[2 * row] = w0s[rr]; RW[2 * row + 1] = w1s[rr];
                LIST[e0s[rr] * 16384 + p0[rr]] = row; LIST[e1s[rr] * 16384 + p1[rr]] = row; }
        }
        __syncthreads();
    }
}

DI void build_tilebase(const Ctx& F) {
    const int* cnt = (const int*)(F.ws + WS_CTL) + CW_CNT; LAS int* tb = (LAS int*)(F.lds + TB_OFF);
    if (F.wave == 0) {
        const int lane = lane_id(); const int tiles = (cnt[64 * lane] + 255) >> 8; int inc = tiles;
#pragma unroll
        for (int o = 1; o < 64; o <<= 1) { const int t = __shfl_up(inc, o); if (lane >= o) inc += t; }
        tb[lane] = inc - tiles; if (lane == 63) tb[NE] = inc; ((LAS int*)(F.lds + CNTL_OFF))[lane] = cnt[64 * lane];
    }
    __syncthreads();
}
DI void fill_tokl(const Ctx& F, const MoeOrder& S) {
    const LAS int* tb = (const LAS int*)(F.lds + TB_OFF); const LAS int* cntl = (const LAS int*)(F.lds + CNTL_OFF); LAS int* tokl = (LAS int*)(F.lds + TOKL_OFF);
    const int* LIST = (const int*)(F.ws + WS_LIST); const int tid = F.wave * 64 + lane_id();
    for (int i = 0; i < 4; ++i) { pg8::Unit u; if (!S.next(i, u)) break;
        const int e = u.pn >> 2, r = 256 * (u.pm - tb[e]) + tid;
        if (tid < 256) tokl[256 * i + tid] = (r < cntl[e]) ? LIST[e * 16384 + r] : 0; }
    asm volatile("s_waitcnt vmcnt(0) lgkmcnt(0)" ::: "memory"); __syncthreads();
}
DI void ph12_final(const Ctx& F, const Args& a, int reps) {
    const float* mod = (const float*)(F.ws + WS_CTL) + CW_MODC; float* H = (float*)argp<N_IN>(); const bf16* H16 = (const bf16*)(F.ws + WS_H16); const float* fg = ARG(I_FG);
    const unsigned char* YE = F.ws + WS_YEXP; const int* RE = (const int*)(F.ws + WS_ROUTE); const int* RP = RE + 2 * M; const float* RW = (const float*)(F.ws + WS_ROUTE) + 4 * M;
    const LAS int* tb = (const LAS int*)(F.lds + TB_OFF);
    float* OUT2 = (float*)(F.ws + WS_U);
    const int gw = F.vcu * NWAVES + F.wave, NGW = F.G * NWAVES, lane = lane_id();
    f32x4 g2[4], fgv[4];
#pragma unroll
    for (int j = 0; j < 4; ++j) { g2[j] = *(const f32x4*)(mod + 5 * 1024 + 256 * j + 4 * lane); fgv[j] = *(const f32x4*)(fg + 256 * j + 4 * lane); }
    const int RT = (M / 2 + NGW - 1) / NGW;
    for (int it = 0; it < RT * reps; ++it) {
        const int t0 = 2 * xcd_unit(F.xcd, F.xj * NWAVES + F.wave, NGW >> 3, (it >= RT ? it - RT : it), M / 2); if (t0 < 0) break;
        float* O = (it >= RT * (reps - 1)) ? H : OUT2;
        int tt[2], d0[2], d1[2]; float w0[2], w1[2];
#pragma unroll
        for (int u = 0; u < 2; ++u) { tt[u] = (t0 + u) % M; d0[u] = 256 * tb[RE[2 * tt[u]]] + RP[2 * tt[u]]; d1[u] = 256 * tb[RE[2 * tt[u] + 1]] + RP[2 * tt[u] + 1]; w0[u] = RW[2 * tt[u]]; w1[u] = RW[2 * tt[u] + 1]; }
        f32x4 hv[2][4]; unsigned ya[2][4], yb[2][4];
#pragma unroll
        for (int u = 0; u < 2; ++u)
#pragma unroll
            for (int j = 0; j < 4; ++j) { const v2u hw = *(const v2u*)(H16 + (size_t)tt[u] * D + 256 * j + 4 * lane); hv[u][j] = (f32x4){bflo(hw.x), bfhi(hw.x), bflo(hw.y), bfhi(hw.y)};
                ya[u][j] = *(const unsigned*)(YE + (size_t)d0[u] * D + 256 * j + 4 * lane); yb[u][j] = *(const unsigned*)(YE + (size_t)d1[u] * D + 256 * j + 4 * lane); }
#pragma unroll
        for (int u = 0; u < 2; ++u) {
            f32x4 v[4]; float ss = 0.f;
#pragma unroll
            for (int j = 0; j < 4; ++j) { const unsigned a4 = ya[u][j], b4 = yb[u][j];
                const f2v a01 = __builtin_amdgcn_cvt_pk_f32_fp8(a4, false), a23 = __builtin_amdgcn_cvt_pk_f32_fp8(a4, true), b01 = __builtin_amdgcn_cvt_pk_f32_fp8(b4, false), b23 = __builtin_amdgcn_cvt_pk_f32_fp8(b4, true);
                f32x4 mo; mo.x = w0[u] * a01.x + w1[u] * b01.x; mo.y = w0[u] * a01.y + w1[u] * b01.y; mo.z = w0[u] * a23.x + w1[u] * b23.x; mo.w = w0[u] * a23.y + w1[u] * b23.y;
                mo = mo * 0.0625f;
                v[j] = hv[u][j] + g2[j] * mo; ss += (v[j].x * v[j].x + v[j].y * v[j].y) + (v[j].z * v[j].z + v[j].w * v[j].w); }
            const float rstd = 1.0f / sqrtf(wave_sum(ss) * (1.0f / D) + EPS);
#pragma unroll
            for (int j = 0; j < 4; ++j) *(f32x4*)(O + (size_t)tt[u] * D + 256 * j + 4 * lane) = v[j] * rstd * fgv[j];
        }
    }
}

constexpr int N_PHASES = 13;
#ifndef REP_MASK
#define REP_MASK 0
#endif
#define REPS(k) (((REP_MASK >> (k)) & 1) ? 2 : 1)
#ifndef MK_ONE_LAUNCH
#define MK_ONE_LAUNCH 1
#endif

struct InProjOrder { pg8::StaticOrder s; int n, reps; const unsigned char* ws; LAS unsigned char* lds; int wave; static constexpr bool HALFSKIP = false;
    DI bool next(int i, pg8::Unit& u) const { if (i >= n * reps) return false; u.aux = i & 1; return s.next(i % n, u); }
    DI void a_ready(const pg8::Unit& u) const {
        if (wave < 2) { const float* g = (wave == 0) ? (const float*)(ws + WS_SA) + u.pm * 256 : (const float*)(ws + WS_SW) + u.pn * 256;
            __builtin_amdgcn_global_load_lds((const unsigned*)((const char*)g + (unsigned)(lane_id() << 4)), (LAS unsigned*)(lds + SCL_OFF + (u.aux & 1) * 2048 + wave * 1024), 16, 0, 0); }
    }
    DI void done(const pg8::Unit&) const {} };
struct RepOrder { pg8::StaticOrder s; int n, reps;
    DI bool next(int i, pg8::Unit& u) const { if (i >= n * reps) return false; return s.next(i % n, u); }
    DI void a_ready(const pg8::Unit&) const {}
    DI void done(const pg8::Unit&) const {} };

__global__ void __launch_bounds__(NTHREADS, 2) fwd_kernel(Args args) {
    extern __shared__ __attribute__((aligned(16))) unsigned char lds_raw[];
    Ctx F;
    F.lds = (LAS unsigned char*)lds_raw;
    F.wave = __builtin_amdgcn_readfirstlane((int)threadIdx.x >> 6);
    F.G = gridDim.x; { const int bx = blockIdx.x; F.xcd = bx & 7; F.xj = bx >> 3; F.vcu = F.xcd * (F.G >> 3) + F.xj; }
    F.ws = (unsigned char*)argp<N_IN + 1>();
    volatile LAS unsigned* MISC = (volatile LAS unsigned*)(F.lds + LDSCTL_OFF);
    for (int u = threadIdx.x; u < (LDS_BYTES - LDSCTL_OFF) / 4; u += NTHREADS) ((LAS unsigned*)(F.lds + LDSCTL_OFF))[u] = 0u;
    __syncthreads();
    const int lo = args.ph_lo, hi = args.ph_hi;
    unsigned* barw = (unsigned*)(F.ws + WS_CTL) + CW_BAR;
    XcdBarrier bar; bar.bar = barw; bar.x = 0; bar.st = nullptr;
    if (hi - lo > 1) bar = xcd_barrier_post(barw, MISC + 8);
    bar.wave = F.wave;
#define IN(k) (lo <= (k) && (k) < hi)
#define SEAM(k) do { if (IN(k) && IN((k) + 1)) { xcd_barrier(bar); if (REPS(14) > 1) xcd_barrier(bar); } } while (0)
    unsigned char* ws = F.ws;
    bf16* XN = (bf16*)(ws + WS_XN);
    const float* mod = (const float*)(ws + WS_CTL) + CW_MOD;

    if (IN(0)) { ph0_prologue(F, args, REPS(0)); SEAM(0); }
    if (IN(1)) { for (int rep = 0; rep < REPS(1); ++rep) { ph1_norm_dt(F, args); __syncthreads(); } SEAM(1); }
    if (IN(2)) {
        pg8::Gemm g{(const bf16*)(ws + WS_XN8), (const bf16*)(ws + WS_W8IN), M, NPROJ, D / 2}; pg8::StaticOrder S; S.init(M, NPROJ, F.G, (int)blockIdx.x);
        EpiInProj E{ws, F.lds};
        InProjOrder R{S, (S.nwg - S.c + S.G - 1) / S.G, REPS(2), ws, F.lds, F.wave};
        pg8::gemm_phase<EpiInProj, InProjOrder, true, true, false, false, true>(F.lds, g, R, E, F.wave);
        SEAM(2);
    }
    if (IN(3)) { ph3_chunk_states(F, args, REPS(13)); __syncthreads(); SEAM(3); }
    if (IN(4)) {
        if (REPS(4) > 1) ph4_scan(F, WS_YS);
        ph4_scan(F, WS_ST);
        SEAM(4);
    }
    if (IN(5)) { ph5_ssd_out(F, args, REPS(5)); __syncthreads(); ph3_convbranch(F, args, REPS(3)); __syncthreads(); SEAM(5); }
    if (IN(6)) {
        {
            pg8::Gemm g{XN, (const bf16*)(ws + WS_WCV), M, D, D}; pg8::StaticOrder S; S.init(M, D, F.G, (int)blockIdx.x);
            EpiGate<false> E{(bf16*)(ws + WS_TMP), nullptr, (const bf16*)(ws + WS_GATE), 0, nullptr};
            RepOrder R{S, (S.nwg - S.c + S.G - 1) / S.G, REPS(15)};
            pg8::gemm_phase<EpiGate<false>, RepOrder, false, true>(F.lds, g, R, E, F.wave);
            __syncthreads();
        }
        pg8::Gemm g{(const bf16*)(ws + WS_YS), (const bf16*)(ws + WS_WSSM), M, D, DIN / 2}; pg8::StaticOrder S; S.init(M, D, F.G, (int)blockIdx.x);
        LAS float* rt = (LAS float*)(F.lds + RT_OFF);
        EpiGate<true> E{(bf16*)(ws + WS_MG), (const bf16*)(ws + WS_TMP), (const bf16*)(ws + WS_GATE), 1024, rt};
        for (int i = 0;; ++i) {
            OneUnit S1; if (!S.next(i, S1.u)) break;
            if (F.wave < 4) { const int tid = F.wave * 64 + lane_id(); const f32x4 r = *(const f32x4*)((const float*)(ws + WS_RSTD) + (size_t)(S1.u.pm * 256 + tid) * 4);
                *(LAS f32x4*)(rt + tid * 4) = (f32x4){r.x / r.y, r.y / r.z, r.z / r.w, r.w}; }
            asm volatile("s_waitcnt vmcnt(0) lgkmcnt(0)" ::: "memory"); __syncthreads();
            pg8::gemm_phase<EpiGate<true>, OneUnit, false, true, true>(F.lds, g, S1, E, F.wave);
            __syncthreads();
        }
        SEAM(6);
    }
    if (IN(7)) {
        pg8::Gemm g{(const bf16*)(ws + WS_MG), (const bf16*)(ws + WS_WMIX), M, D, D}; pg8::StaticOrder S; S.init(M, D, F.G, (int)blockIdx.x);
        EpiMix E{(bf16*)(ws + WS_H16), ARG(I_X), (const float*)(ws + WS_CTL) + CW_MODC + 2 * 1024};
        RepOrder R{S, (S.nwg - S.c + S.G - 1) / S.G, REPS(7)};
        pg8::gemm_phase<EpiMix, RepOrder, false, true>(F.lds, g, R, E, F.wave);
        SEAM(7);
    }
    if (IN(8)) { for (int rep = 0; rep < REPS(8); ++rep) { convert_experts(F, args); __syncthreads(); } ph8_router(F, args, REPS(9)); if (IN(8) && IN(10)) xcd_barrier(bar); }
    if (IN(10)) {
        build_tilebase(F);
        const LAS int* tb = (const LAS int*)(F.lds + TB_OFF);
        pg8::Gemm g{(const bf16*)(ws + WS_XN), (const bf16*)(ws + WS_W13), M, NE * 1024, D / 2};
        MoeOrder S{tb, F.G, F.vcu, tb[NE] * 4, 1, (const LAS int*)(F.lds + TOKL_OFF)};
        fill_tokl(F, S);
        EpiUp E{ws + WS_HDN};
        pg8::gemm_phase<EpiUp, MoeOrder, true, true, true, true>(F.lds, g, S, E, F.wave);
        SEAM(10);
    }
    if (IN(11)) {
        build_tilebase(F);
        const LAS int* tb = (const LAS int*)(F.lds + TB_OFF);
        pg8::Gemm g{(const bf16*)(ws + WS_HDN), (const bf16*)(ws + WS_W2), 49152, NE * 1024, DFF / 2};
        MoeOrder S{tb, F.G, F.vcu, tb[NE] * 4, 1, nullptr};
        EpiDown E{ws + WS_YEXP};
        pg8::gemm_phase<EpiDown, MoeOrder, true, true, true>(F.lds, g, S, E, F.wave);
        SEAM(11);
    }
    if (IN(12)) { build_tilebase(F); ph12_final(F, args, REPS(12)); }
#undef IN
#undef SEAM
}

extern "C" void kernel_launch(void* const* d_in, const int* in_sizes, int n_in, void* d_out, int out_size, void* d_ws, size_t ws_size, hipStream_t stream) {
    static int grid = 0;
    if (grid == 0) {
        if (n_in != N_IN || in_sizes[0] != M * D || out_size != M * D || ws_size < WS_END) {
            fprintf(stderr, "kernel_launch: unexpected shapes: n_in %d in0 %d out %d ws %zu (need %zu)\n", n_in, n_in > 0 ? in_sizes[0] : -1, out_size, ws_size, (size_t)WS_END); grid = -1; return; }
        int dev = 0, cus = 0, per_cu = 0;
        if (hipGetDevice(&dev) != hipSuccess || hipDeviceGetAttribute(&cus, hipDeviceAttributeMultiprocessorCount, dev) != hipSuccess) { fprintf(stderr, "kernel_launch: device query failed\n"); grid = -1; return; }
        if (hipFuncSetAttribute((const void*)fwd_kernel, hipFuncAttributeMaxDynamicSharedMemorySize, LDS_BYTES) != hipSuccess) { fprintf(stderr, "kernel_launch: hipFuncSetAttribute failed\n"); grid = -1; return; }
        if (hipOccupancyMaxActiveBlocksPerMultiprocessor(&per_cu, (const void*)fwd_kernel, NTHREADS, LDS_BYTES) != hipSuccess || per_cu < 1) {
            fprintf(stderr, "kernel_launch: the occupancy query admits no workgroup of this kernel per CU (%d); nothing launched\n", per_cu); (void)hipGetLastError(); grid = -1; return; }
        grid = cus;
        if (cus < 192 || (cus & 7)) { fprintf(stderr, "kernel_launch: built for a 256-CU device (the MoE unit table holds 4 units per workgroup); %d CUs: nothing launched\n", cus); grid = -1; return; }
        fprintf(stderr, "kernel_launch: grid %d (cus %d, per_cu %d)\n", grid, cus, per_cu);
    }
    if (grid < 0) return;
    (void)hipMemsetAsync((char*)d_ws + WS_CTL, 0, CTL_ZERO_BYTES, stream);
    Args a{};
    for (int i = 0; i < N_IN; ++i) a.in[i] = (const float*)d_in[i];
    a.out = (float*)d_out; a.ws = (unsigned char*)d_ws;
#if MK_ONE_LAUNCH
    a.ph_lo = 0; a.ph_hi = N_PHASES;
    void* kargs[] = {&a};
    hipError_t e = hipLaunchCooperativeKernel((const void*)fwd_kernel, dim3(grid), dim3(NTHREADS), kargs, LDS_BYTES, stream);
    if (e != hipSuccess) fprintf(stderr, "kernel_launch: cooperative launch failed: %s\n", hipGetErrorString(e));
#else
    for (int ph = 0; ph < N_PHASES; ++ph) {
        a.ph_lo = ph; a.ph_hi = ph + 1;
        hipLaunchKernelGGL(fwd_kernel, dim3(grid), dim3(NTHREADS), LDS_BYTES, stream, a);
    }
#endif
}
```
